# Optimizing an MI355X kernel written in HIP

```python
import math
import jax
import jax.numpy as jnp
from jax import lax
import numpy as np

D_MODEL = 1024
BATCH = 4
SEQ = 4096
DEPTH = 2

GRID_W = 64
CTX_LEN = 256
Q_BLOCK = 128
ROPE_THETA = 10000.0
NORM_EPS = 1e-6

GQA_HEADS = 8
GQA_KV_HEADS = 2
GQA_HEAD_DIM = 64
GQA_GROUP = GQA_HEADS // GQA_KV_HEADS
GQA_SCALE = 1.0 / math.sqrt(GQA_HEAD_DIM)

MLA_HEADS = 8
MLA_NOPE_DIM = 64
MLA_ROPE_DIM = 32
MLA_V_DIM = 64
MLA_Q_RANK = 384
MLA_KV_RANK = 256
MLA_SCALE = 1.0 / math.sqrt(MLA_NOPE_DIM + MLA_ROPE_DIM)

S5_WIDTH = 512
S5_GROUP = 16
S5_GROUPS = S5_WIDTH // S5_GROUP
S5_STATE = 64

BRANCH_WIDTH = 512
N_BRANCHES = 3

D_FF = 2816
N_EXPERTS = 8
TOP_K = 2
N_DENSE = (DEPTH + 1) // 2
N_MOE = DEPTH // 2

Q_SIZES = (GQA_HEADS * GQA_HEAD_DIM, MLA_Q_RANK)
KV_SIZES = (GQA_KV_HEADS * GQA_HEAD_DIM, GQA_KV_HEADS * GQA_HEAD_DIM, MLA_KV_RANK, MLA_ROPE_DIM, S5_WIDTH)
Q_COLS = GQA_HEADS * GQA_HEAD_DIM + MLA_Q_RANK
N_IN = Q_COLS + 2 * GQA_KV_HEADS * GQA_HEAD_DIM + MLA_KV_RANK + MLA_ROPE_DIM + S5_WIDTH

kernel_name = 'hybrid_gqa_mla_s5_moe_diffusion_block'


def _rmsnorm(x, g):
    xf = x.astype(jnp.float32)
    y = xf * lax.rsqrt(jnp.mean(xf * xf, axis=-1, keepdims=True) + NORM_EPS)
    return (y * g.astype(jnp.float32)).astype(x.dtype)


def _modulate(h, shift, scale):
    return h * (1 + scale) + shift


def _split_cols(z, sizes):
    return jnp.split(z, np.cumsum(sizes)[:-1].tolist(), axis=-1)


def _grid_rope(row_idx, col_idx, rot_dim):
    axis_dim = rot_dim // 2
    inv_freq = ROPE_THETA ** (-jnp.arange(0, axis_dim, 2, dtype=jnp.float32) / axis_dim)
    ang = jnp.concatenate([row_idx.astype(jnp.float32)[:, None] * inv_freq,
                           col_idx.astype(jnp.float32)[:, None] * inv_freq], axis=-1)
    return jnp.cos(ang), jnp.sin(ang)


def _apply_rope(x, cs):
    cos, sin = cs
    c = cos[None, :, None, :]
    s = sin[None, :, None, :]
    x1, x2 = jnp.split(x.astype(jnp.float32), 2, axis=-1)
    return jnp.concatenate([x1 * c - x2 * s, x1 * s + x2 * c], axis=-1).astype(x.dtype)


def _attend(q, k, v, scale):
    s = jnp.einsum('bqhgd,bkhd->bhgqk', q, k, preferred_element_type=jnp.float32) * scale
    p = jax.nn.softmax(s, axis=-1).astype(v.dtype)
    return jnp.einsum('bhgqk,bkhd->bqhgd', p, v)


def _blocked_attention(q, k, v, scale):
    B, L, Hk, G, dk = q.shape
    qb = q.reshape(B, L // Q_BLOCK, Q_BLOCK, Hk, G, dk).transpose(1, 0, 2, 3, 4, 5)
    ob = lax.map(lambda qi: _attend(qi, k, v, scale), qb)
    return ob.transpose(1, 0, 2, 3, 4, 5).reshape(B, L, -1)


def _gqa_q(q, g_q, cs):
    B, L, _ = q.shape
    q = _rmsnorm(q.reshape(B, L, GQA_HEADS, GQA_HEAD_DIM), g_q)
    if cs is not None:
        q = _apply_rope(q, cs)
    return q.reshape(B, L, GQA_KV_HEADS, GQA_GROUP, GQA_HEAD_DIM)


def _gqa_kv(k, v, g_k, cs):
    B, L, _ = k.shape
    k = _rmsnorm(k.reshape(B, L, GQA_KV_HEADS, GQA_HEAD_DIM), g_k)
    if cs is not None:
        k = _apply_rope(k, cs)
    return k, v.reshape(B, L, GQA_KV_HEADS, GQA_HEAD_DIM)


def _mla_q(cq, g_cq, w_uq, cs):
    B, L, _ = cq.shape
    q = (_rmsnorm(cq, g_cq) @ w_uq).reshape(B, L, MLA_HEADS, MLA_NOPE_DIM + MLA_ROPE_DIM)
    q_nope, q_rope = q[..., :MLA_NOPE_DIM], q[..., MLA_NOPE_DIM:]
    if cs is not None:
        q_rope = _apply_rope(q_rope, cs)
    return jnp.concatenate([q_nope, q_rope], axis=-1).reshape(B, L, MLA_HEADS, 1, MLA_NOPE_DIM + MLA_ROPE_DIM)


def _mla_kv(ckv, kr, g_ckv, w_ukv, cs):
    B, L, _ = ckv.shape
    kv = (_rmsnorm(ckv, g_ckv) @ w_ukv).reshape(B, L, MLA_HEADS, MLA_NOPE_DIM + MLA_V_DIM)
    k_nope, v = kv[..., :MLA_NOPE_DIM], kv[..., MLA_NOPE_DIM:]
    kr = kr.reshape(B, L, 1, MLA_ROPE_DIM)
    if cs is not None:
        kr = _apply_rope(kr, cs)
    k = jnp.concatenate([k_nope, jnp.broadcast_to(kr, (B, L, MLA_HEADS, MLA_ROPE_DIM))], axis=-1)
    return k, v


def _cmul(ar, ai, br, bi):
    return ar * br - ai * bi, ar * bi + ai * br


def _ssm_combine(e1, e2):
    a1r, a1i, b1r, b1i = e1
    a2r, a2i, b2r, b2i = e2
    ar, ai = _cmul(a2r, a2i, a1r, a1i)
    br, bi = _cmul(a2r, a2i, b1r, b1i)
    return ar, ai, br + b2r, bi + b2i


def _s5(u_c, u_l, lam_re, lam_im, log_dt, b_re, b_im, c_re, c_im, d_skip, w_glu, need_ctx):
    f32 = jnp.float32

    def groups(u):
        B, L, _ = u.shape
        return u.astype(f32).reshape(B, L, S5_GROUPS, S5_GROUP).transpose(1, 0, 2, 3)

    uc, ul = groups(u_c), groups(u_l)
    dsk = d_skip.astype(f32)
    y_l = dsk * ul
    y_c = dsk * uc if need_ctx else None
    for d in range(2):
        rev = d == 1
        lr = jnp.minimum(lam_re[d].astype(f32), -1e-4)
        li = lam_im[d].astype(f32)
        dt = jnp.exp(log_dt[d].astype(f32))[:, None]
        mag = jnp.exp(lr * dt)
        abr, abi = mag * jnp.cos(li * dt), mag * jnp.sin(li * dt)
        den = lr * lr + li * li
        fr = ((abr - 1.0) * lr + abi * li) / den
        fi = (abi * lr - (abr - 1.0) * li) / den
        br, bi = b_re[d].astype(f32), b_im[d].astype(f32)
        bbr = fr[..., None] * br - fi[..., None] * bi
        bbi = fr[..., None] * bi + fi[..., None] * br
        cr, ci = c_re[d].astype(f32), c_im[d].astype(f32)

        def scan(u, init):
            vr = jnp.einsum('gph,lbgh->lbgp', bbr, u)
            vi = jnp.einsum('gph,lbgh->lbgp', bbi, u)
            if init is not None:
                sr, si = _cmul(abr, abi, init[0], init[1])
                pos = u.shape[0] - 1 if rev else 0
                vr = vr.at[pos].add(sr)
                vi = vi.at[pos].add(si)
            shape = (u.shape[0], 1) + abr.shape
            ar = jnp.broadcast_to(abr, shape)
            ai = jnp.broadcast_to(abi, shape)
            _, _, xr, xi = lax.associative_scan(_ssm_combine, (ar, ai, vr, vi), reverse=rev, axis=0)
            return xr, xi

        def readout(xr, xi):
            return jnp.einsum('ghp,lbgp->lbgh', cr, xr) - jnp.einsum('ghp,lbgp->lbgh', ci, xi)

        xr_c, xi_c = scan(uc, None)
        end = 0 if rev else -1
        xr_l, xi_l = scan(ul, (xr_c[end], xi_c[end]))
        y_l = y_l + readout(xr_l, xi_l)
        if need_ctx:
            y_c = y_c + readout(xr_c, xi_c)

    def glu(y, dtype):
        L, B = y.shape[0], y.shape[1]
        y = jax.nn.gelu(y.transpose(1, 0, 2, 3).reshape(B, L, S5_WIDTH)).astype(dtype)
        a, g = jnp.split(y @ w_glu, 2, axis=-1)
        return a * jax.nn.sigmoid(g)

    return (glu(y_c, u_c.dtype) if need_ctx else None), glu(y_l, u_l.dtype)


def _token_mixer(h_c, h_l, w_in, g_q, g_k, g_cq, g_ckv, w_uq, w_ukv,
                 lam_re, lam_im, log_dt, b_re, b_im, c_re, c_im, d_skip, w_glu,
                 w_branch, w_mg, b_mg, w_out, gqa_cs, mla_cs, need_ctx):
    qg_l, qm_l, kg_l, vg_l, ckv_l, kr_l, u_l = _split_cols(h_l @ w_in, Q_SIZES + KV_SIZES)
    if need_ctx:
        qg_c, qm_c, kg_c, vg_c, ckv_c, kr_c, u_c = _split_cols(h_c @ w_in, Q_SIZES + KV_SIZES)
    else:
        kg_c, vg_c, ckv_c, kr_c, u_c = _split_cols(h_c @ w_in[:, Q_COLS:], KV_SIZES)
    B, Lc = h_c.shape[0], h_c.shape[1]

    ka_c, va_c = _gqa_kv(kg_c, vg_c, g_k, None)
    ka_l, va_l = _gqa_kv(kg_l, vg_l, g_k, gqa_cs)
    ya_l = _blocked_attention(_gqa_q(qg_l, g_q, gqa_cs),
                              jnp.concatenate([ka_c, ka_l], axis=1),
                              jnp.concatenate([va_c, va_l], axis=1), GQA_SCALE)

    kb_c, vb_c = _mla_kv(ckv_c, kr_c, g_ckv, w_ukv, None)
    kb_l, vb_l = _mla_kv(ckv_l, kr_l, g_ckv, w_ukv, mla_cs)
    yb_l = _blocked_attention(_mla_q(qm_l, g_cq, w_uq, mla_cs),
                              jnp.concatenate([kb_c, kb_l], axis=1),
                              jnp.concatenate([vb_c, vb_l], axis=1), MLA_SCALE)

    yc_c, yc_l = _s5(u_c, u_l, lam_re, lam_im, log_dt, b_re, b_im, c_re, c_im, d_skip, w_glu, need_ctx)

    def merge(h, branches):
        Bh, L = h.shape[0], h.shape[1]
        gates = jax.nn.sigmoid((h @ w_mg + b_mg).astype(jnp.float32)).astype(h.dtype)
        gates = gates.reshape(Bh, L, N_BRANCHES, D_MODEL)
        proj = jnp.einsum('blnw,nwd->blnd', jnp.stack(branches, axis=2), w_branch)
        return jnp.sum(gates * proj, axis=2) @ w_out

    y_l = merge(h_l, [ya_l, yb_l, yc_l])
    y_c = None
    if need_ctx:
        ya_c = _attend(_gqa_q(qg_c, g_q, None), ka_c, va_c, GQA_SCALE).reshape(B, Lc, -1)
        yb_c = _attend(_mla_q(qm_c, g_cq, w_uq, None), kb_c, vb_c, MLA_SCALE).reshape(B, Lc, -1)
        y_c = merge(h_c, [ya_c, yb_c, yc_c])
    return y_c, y_l


def _swiglu(h, w1, w3, w2):
    return (jax.nn.silu(h @ w1) * (h @ w3)) @ w2


def _moe(h, rw, rb, w1, w3, w2):
    logits = jnp.einsum('bld,de->ble', h, rw, preferred_element_type=jnp.float32) + rb.astype(jnp.float32)
    top_v, top_i = lax.top_k(logits, TOP_K)
    top_w = jax.nn.softmax(top_v, axis=-1)
    gate = jnp.einsum('blk,blke->ble', top_w, jax.nn.one_hot(top_i, N_EXPERTS, dtype=jnp.float32)).astype(h.dtype)
    out = jnp.zeros_like(h)
    for e in range(N_EXPERTS):
        out = out + gate[..., e:e + 1] * _swiglu(h, w1[e], w3[e], w2[e])
    return out


def _channel_mixer(h, layer, ffn_w1, ffn_w3, ffn_w2, router_w, router_b, moe_w1, moe_w3, moe_w2):
    i = layer // 2
    if layer % 2 == 0:
        return _swiglu(h, ffn_w1[i], ffn_w3[i], ffn_w2[i])
    return _moe(h, router_w[i], router_b[i], moe_w1[i], moe_w3[i], moe_w2[i])


def setup_inputs(seed: int = 0) -> dict:
    key = jax.random.key(seed)
    keys = iter(jax.random.split(key, 48))
    f32 = jnp.float32

    def normal(shape, scale):
        return jax.random.normal(next(keys), shape, f32) * scale

    def gain(shape):
        return 1.0 + normal(shape, 0.02)

    D, L = D_MODEL, DEPTH
    G, P, H = S5_GROUPS, S5_STATE, S5_GROUP
    return {
        'x': normal((BATCH, SEQ, D), 1.0),
        'c': normal((BATCH, D), 1.0),
        'ctx': normal((BATCH, CTX_LEN, D), 1.0),
        'c_ctx': normal((D,), 1.0),
        'w_mod': normal((L, D, 6 * D), 0.5 * D ** -0.5),
        'b_mod': normal((L, 6 * D), 0.02),
        'g_mix_pre': gain((L, D)),
        'g_mix_post': gain((L, D)),
        'g_ffn_pre': gain((L, D)),
        'g_ffn_post': gain((L, D)),
        'w_in': normal((L, D, N_IN), D ** -0.5),
        'g_q': gain((L, GQA_HEAD_DIM)),
        'g_k': gain((L, GQA_HEAD_DIM)),
        'g_cq': gain((L, MLA_Q_RANK)),
        'g_ckv': gain((L, MLA_KV_RANK)),
        'w_uq': normal((L, MLA_Q_RANK, MLA_HEADS * (MLA_NOPE_DIM + MLA_ROPE_DIM)), MLA_Q_RANK ** -0.5),
        'w_ukv': normal((L, MLA_KV_RANK, MLA_HEADS * (MLA_NOPE_DIM + MLA_V_DIM)), MLA_KV_RANK ** -0.5),
        's5_lambda_re': -0.5 + normal((L, 2, G, P), 0.01),
        's5_lambda_im': jnp.pi * jnp.arange(P, dtype=f32) + normal((L, 2, G, P), 0.01),
        's5_log_dt': jax.random.uniform(next(keys), (L, 2, G), f32, math.log(1e-3), math.log(1e-1)),
        's5_b_re': normal((L, 2, G, P, H), (2 * H) ** -0.5),
        's5_b_im': normal((L, 2, G, P, H), (2 * H) ** -0.5),
        's5_c_re': normal((L, 2, G, H, P), (2 * P) ** -0.5),
        's5_c_im': normal((L, 2, G, H, P), (2 * P) ** -0.5),
        's5_d': normal((L, G, H), 1.0),
        'w_glu': normal((L, S5_WIDTH, 2 * S5_WIDTH), S5_WIDTH ** -0.5),
        'w_branch': normal((L, N_BRANCHES, BRANCH_WIDTH, D), BRANCH_WIDTH ** -0.5),
        'w_merge_gate': normal((L, D, N_BRANCHES * D), D ** -0.5),
        'b_merge_gate': normal((L, N_BRANCHES * D), 0.02),
        'w_out': normal((L, D, D), D ** -0.5),
        'ffn_w1': normal((N_DENSE, D, D_FF), D ** -0.5),
        'ffn_w3': normal((N_DENSE, D, D_FF), D ** -0.5),
        'ffn_w2': normal((N_DENSE, D_FF, D), D_FF ** -0.5),
        'router_w': normal((N_MOE, D, N_EXPERTS), D ** -0.5),
        'router_b': normal((N_MOE, N_EXPERTS), 0.01),
        'moe_w1': normal((N_MOE, N_EXPERTS, D, D_FF), D ** -0.5),
        'moe_w3': normal((N_MOE, N_EXPERTS, D, D_FF), D ** -0.5),
        'moe_w2': normal((N_MOE, N_EXPERTS, D_FF, D), D_FF ** -0.5),
    }


def reference(x, c, ctx, c_ctx, w_mod, b_mod, g_mix_pre, g_mix_post, g_ffn_pre, g_ffn_post,
              w_in, g_q, g_k, g_cq, g_ckv, w_uq, w_ukv,
              s5_lambda_re, s5_lambda_im, s5_log_dt, s5_b_re, s5_b_im, s5_c_re, s5_c_im, s5_d, w_glu,
              w_branch, w_merge_gate, b_merge_gate, w_out,
              ffn_w1, ffn_w3, ffn_w2, router_w, router_b, moe_w1, moe_w3, moe_w2):
    n_lat = x.shape[1]
    rows = n_lat // GRID_W
    row_idx = jnp.repeat(jnp.arange(rows, dtype=jnp.int32), GRID_W)
    col_idx = jnp.tile(jnp.arange(GRID_W, dtype=jnp.int32), rows)
    gqa_cs = _grid_rope(row_idx, col_idx, GQA_HEAD_DIM)
    mla_cs = _grid_rope(row_idx, col_idx, MLA_ROPE_DIM)

    sc_l = jax.nn.silu(c)
    sc_c = jax.nn.silu(c_ctx)
    lat, cx = x, ctx
    for layer in range(DEPTH):
        last = layer == DEPTH - 1
        mod_l = jnp.split((sc_l @ w_mod[layer] + b_mod[layer])[:, None, :], 6, axis=-1)
        mod_c = jnp.split((sc_c @ w_mod[layer] + b_mod[layer])[None, None, :], 6, axis=-1)

        h_l = _modulate(_rmsnorm(lat, g_mix_pre[layer]), mod_l[0], mod_l[1])
        h_c = _modulate(_rmsnorm(cx, g_mix_pre[layer]), mod_c[0], mod_c[1])
        y_c, y_l = _token_mixer(
            h_c, h_l, w_in[layer], g_q[layer], g_k[layer], g_cq[layer], g_ckv[layer], w_uq[layer], w_ukv[layer],
            s5_lambda_re[layer], s5_lambda_im[layer], s5_log_dt[layer], s5_b_re[layer], s5_b_im[layer],
            s5_c_re[layer], s5_c_im[layer], s5_d[layer], w_glu[layer],
            w_branch[layer], w_merge_gate[layer], b_merge_gate[layer], w_out[layer],
            gqa_cs, mla_cs, not last)
        lat = lat + mod_l[2] * _rmsnorm(y_l, g_mix_post[layer])
        if not last:
            cx = cx + mod_c[2] * _rmsnorm(y_c, g_mix_post[layer])

        f_l = _channel_mixer(_modulate(_rmsnorm(lat, g_ffn_pre[layer]), mod_l[3], mod_l[4]), layer,
                             ffn_w1, ffn_w3, ffn_w2, router_w, router_b, moe_w1, moe_w3, moe_w2)
        lat = lat + mod_l[5] * _rmsnorm(f_l, g_ffn_post[layer])
        if not last:
            f_c = _channel_mixer(_modulate(_rmsnorm(cx, g_ffn_pre[layer]), mod_c[3], mod_c[4]), layer,
                                 ffn_w1, ffn_w3, ffn_w2, router_w, router_b, moe_w1, moe_w3, moe_w2)
            cx = cx + mod_c[5] * _rmsnorm(f_c, g_ffn_post[layer])
    return lat
```

```cpp
#include <hip/hip_runtime.h>
#include <cstdio>
#include <cstdint>

#ifndef MK_DEBUG
#define MK_DEBUG 0
#endif
#ifndef MK_MULTI
#define MK_MULTI 0
#endif

#define GAS __attribute__((address_space(1)))
#define LAS __attribute__((address_space(3)))
typedef unsigned short bf16;
typedef short bf16x8 __attribute__((ext_vector_type(8)));
typedef short s16x4 __attribute__((ext_vector_type(4)));
typedef float f32x2 __attribute__((ext_vector_type(2)));
typedef float f32x4 __attribute__((ext_vector_type(4)));
typedef float f32x16 __attribute__((ext_vector_type(16)));
typedef unsigned u32x2 __attribute__((ext_vector_type(2)));
typedef unsigned u32x4 __attribute__((ext_vector_type(4)));

constexpr int D = 1024, NB = 4, SEQ = 4096, CTXL = 256, GRIDW = 64;
constexpr int NLAT = NB * SEQ, NCTX = NB * CTXL, MALL = NLAT + NCTX;
constexpr int LPOS = CTXL + SEQ;
constexpr int NIN = 1952, ZW = 2048;
constexpr int DFF = 2816, NEXP = 8;
constexpr float EPS = 1e-6f;
constexpr float LOG2E = 1.4426950408889634f;
#ifndef F8_G1L1
#define F8_G1L1 1
#endif
constexpr float F8_WSCALE = 256.f, F8_HSCALE = 16.f, F8_ASCALE = 8.f;
#ifndef F8_D1
#define F8_D1 0
#endif
#ifndef F8_D2
#define F8_D2 0
#endif
#ifndef F8_M1
#define F8_M1 1
#endif
constexpr int ZC_QG = 0, ZC_KG = 512, ZC_VG = 640, ZC_CQ = 768, ZC_CKV = 1152, ZC_KR = 1408, ZC_U = 1536;

constexpr size_t MiB = 1u << 20;
constexpr size_t WS_CTL = 0, CTL_BYTES = 1 * MiB;
constexpr size_t WS_MOD = 1 * MiB;
constexpr size_t WS_ROPE = 2 * MiB;
constexpr size_t WS_PAR = 3 * MiB + 512 * 1024;
constexpr int PR_GMIXPRE = 0, PR_GMIXPOST = 2048, PR_GFFNPRE = 4096, PR_GFFNPOST = 6144, PR_GQ = 8192, PR_GK = 8320, PR_GCQ = 8448, PR_GCKV = 9216, PR_BMG = 9728, PR_RW = 15872, PR_RB = 24064,
              PR_A16 = 24080, PR_END = PR_A16 + 2 * 2 * 32 * 64 * 2;
constexpr size_t WS_LIST = 4 * MiB;
constexpr size_t WS_LATC = 5 * MiB;
constexpr size_t WS_W1T = 9 * MiB;
constexpr size_t WS_WMGT = 17 * MiB;
constexpr size_t WS_WUQT = 29 * MiB;
constexpr size_t WS_WUKVT = 31 * MiB;
constexpr size_t WS_S5M = 32 * MiB;
constexpr size_t WS_WGLUT = 56 * MiB;
constexpr size_t WS_WBT = 58 * MiB;
constexpr size_t WS_WOUTT = 64 * MiB;
constexpr size_t WS_WF1T = 68 * MiB;
constexpr size_t WS_WF2T = 79 * MiB;
constexpr size_t WS_WM1T = 85 * MiB;
constexpr size_t WS_WM2T = 173 * MiB;
constexpr size_t WS_POOL = 217 * MiB;
constexpr size_t P_H = WS_POOL + 0 * MiB;
constexpr size_t P_Z = WS_POOL + 34 * MiB;
constexpr size_t P_QB = WS_POOL + 34 * MiB;
constexpr size_t P_KB = WS_POOL + 60 * MiB;
constexpr size_t P_VB = WS_POOL + 77 * MiB;
constexpr size_t P_QA = WS_POOL + 102 * MiB;
constexpr size_t P_KA = WS_POOL + 119 * MiB;
constexpr size_t P_VA = WS_POOL + 124 * MiB;
constexpr size_t P_KRR = WS_POOL + 129 * MiB;
constexpr size_t P_UG = WS_POOL + 131 * MiB;
constexpr size_t P_CQN = WS_POOL + 148 * MiB;
constexpr size_t P_CKVN = WS_POOL + 161 * MiB;
constexpr size_t P_AGLU = WS_POOL + 170 * MiB;
constexpr size_t P_YBR = WS_POOL + 187 * MiB;
constexpr size_t P_MRG = WS_POOL + 34 * MiB;
constexpr size_t P_GSCR = WS_POOL + 68 * MiB;
constexpr size_t P_Y = WS_POOL + 102 * MiB;
constexpr size_t P_ACT = WS_POOL + 34 * MiB;
constexpr size_t P_Y2 = WS_POOL + 136 * MiB;
constexpr size_t P_H8 = WS_POOL + 240 * MiB;
constexpr size_t WS_END = WS_POOL + 257 * MiB;
static_assert(P_YBR + (size_t)MALL * 1536 * 2 <= WS_END && P_Y2 + (size_t)MALL * 1024 * 4 <= WS_END && P_ACT + (size_t)MALL * DFF * 2 <= P_Y2, "pool map");
static_assert(P_GSCR + 256 * 3 * 131072 <= P_AGLU && P_VB + (size_t)MALL * 512 * 2 <= P_QA && P_Y + (size_t)MALL * 4096 <= P_AGLU, "pool map 2");

constexpr int CW_BAR = 4096;
constexpr int CW_Q = 8320;
constexpr int CW_CNT = 8192;
constexpr int CW_DBG = 16384;

constexpr int LDS_MISC = 147456;
constexpr int LDS_BYTES = 151552;
constexpr int NWAVES = 8, NTHREADS = 512;

__device__ __forceinline__ int lane_id() { unsigned m_ = ~0u; asm volatile("" : "+s"(m_)); return (int)__builtin_amdgcn_mbcnt_hi(m_, __builtin_amdgcn_mbcnt_lo(m_, 0u)); }
__device__ __forceinline__ float bf2f(unsigned v) { return __uint_as_float(v << 16); }
__device__ __forceinline__ unsigned f2bf(float f) { unsigned u = __float_as_uint(f); return (u + 0x7fffu + ((u >> 16) & 1u)) >> 16; }
typedef __bf16 bf16x2_t __attribute__((ext_vector_type(2)));
__device__ __forceinline__ unsigned pk2(float lo, float hi) { const f32x2 v = {lo, hi}; return __builtin_bit_cast(unsigned, __builtin_convertvector(v, bf16x2_t)); }
__device__ __forceinline__ float shfl_xor_l(float v, int mask, int lane) { return __int_as_float(__builtin_amdgcn_ds_bpermute((lane ^ mask) << 2, __float_as_int(v))); }
__device__ __forceinline__ float wave_sum(float v) {
    const int lane = lane_id();
#pragma unroll
    for (int o = 1; o < 64; o <<= 1) v += shfl_xor_l(v, o, lane);
    return v;
}
__device__ __forceinline__ float fsigmoid(float x) { return __builtin_amdgcn_rcpf(1.0f + __builtin_amdgcn_exp2f(-x * LOG2E)); }
__device__ __forceinline__ float fsilu(float x) { return x * fsigmoid(x); }
__device__ __forceinline__ float fgelu_tanh(float x) { const float u = 0.7978845608028654f * (x + 0.044715f * x * x * x); return x * fsigmoid(2.0f * u); }
__device__ __forceinline__ void unpack8(const u32x4 v, float (&f)[8]) {
    f[0] = bf2f(v.x & 0xffffu); f[1] = bf2f(v.x >> 16); f[2] = bf2f(v.y & 0xffffu); f[3] = bf2f(v.y >> 16);
    f[4] = bf2f(v.z & 0xffffu); f[5] = bf2f(v.z >> 16); f[6] = bf2f(v.w & 0xffffu); f[7] = bf2f(v.w >> 16);
}
__device__ __forceinline__ u32x4 pack8(const float (&f)[8]) { u32x4 w; w.x = pk2(f[0], f[1]); w.y = pk2(f[2], f[3]); w.z = pk2(f[4], f[5]); w.w = pk2(f[6], f[7]); return w; }
__device__ __forceinline__ int pos_row(int b, int p) { return p < CTXL ? NLAT + b * CTXL + p : b * SEQ + (p - CTXL); }

#define XB_TMO      128
#define XB_XCNT(j)  (256  + 64 * (j))
#define XB_XSUB(j)  (1280 + 64 * (j))
#define XB_XGEN(j)  (2304 + 64 * (j))
#define XB_TOP      3328
#define XB_TOPGEN   3392
#define XCD_BAR_WORDS 3456
#define XB_SPIN_CAP (1u << 18)
__device__ __forceinline__ unsigned xb_ld(unsigned* p)              { return __hip_atomic_load(p, __ATOMIC_RELAXED, __HIP_MEMORY_SCOPE_AGENT); }
__device__ __forceinline__ unsigned xb_add(unsigned* p, unsigned v) { return __hip_atomic_fetch_add(p, v, __ATOMIC_RELAXED, __HIP_MEMORY_SCOPE_AGENT); }
__device__ __forceinline__ unsigned xb_xcc_id() { return (unsigned)__builtin_amdgcn_s_getreg((3 << 11) | 20) & 0xFu; }
#define XB_SPIN(cond, bar) do { unsigned _sp = 0; while (cond) { __builtin_amdgcn_s_sleep(1); \
    if ((++_sp & 255u) == 0u) { if (xb_ld(&(bar)[XB_TMO])) break; if (_sp > XB_SPIN_CAP) { atomicAdd(&(bar)[XB_TMO], 1u); break; } } } } while (0)
struct XcdBarrier { unsigned* bar; unsigned x; volatile LAS unsigned* st; int wave; };
__device__ __forceinline__ XcdBarrier xcd_barrier_post(unsigned* bar, volatile LAS unsigned* st, int wave) {
    XcdBarrier b; b.bar = bar; b.x = xb_xcc_id(); b.st = st; b.wave = wave;
    if (wave == 0 && lane_id() == 0) (void)xb_add(&bar[XB_XCNT(b.x)], 1u);
    return b;
}
__device__ __forceinline__ void xcd_barrier_complete(unsigned* bar, unsigned x, unsigned& nloc, unsigned& nx) {
    const unsigned G = gridDim.x * gridDim.y * gridDim.z;
    unsigned sum, cnt, mine, sp = 0u;
    for (;;) {
        sum = 0u; cnt = 0u; mine = 0u;
#pragma unroll
        for (unsigned j = 0; j < 16; ++j) { const unsigned c = xb_ld(&bar[XB_XCNT(j)]); sum += c; cnt += (c > 0u) ? 1u : 0u; mine = (j == x) ? c : mine; }
        if (sum == G) break;
        __builtin_amdgcn_s_sleep(1);
        if ((++sp & 255u) == 0u) { if (xb_ld(&bar[XB_TMO])) break; if (sp > XB_SPIN_CAP) { atomicAdd(&bar[XB_TMO], 1u); break; } }
    }
    nloc = mine > 0u ? mine : 1u; nx = cnt > 0u ? cnt : 1u;
}
__device__ __forceinline__ void xcd_barrier(const XcdBarrier& b) {
    asm volatile("s_waitcnt vmcnt(0)" ::: "memory");
    __syncthreads();
    if (b.wave == 0 && lane_id() == 0) {
        unsigned* bar = b.bar;
        __builtin_amdgcn_s_waitcnt(0);
        unsigned nloc = b.st[0], nx = b.st[1];
        if (nloc == 0u) { xcd_barrier_complete(bar, b.x, nloc, nx); b.st[0] = nloc; b.st[1] = nx; }
        const unsigned old = xb_add(&bar[XB_XSUB(b.x)], 1u);
        const unsigned gen = old / nloc;
        if (old + 1u == (gen + 1u) * nloc) {
            __builtin_amdgcn_fence(__ATOMIC_RELEASE, "agent");
            asm volatile("s_waitcnt vmcnt(0)" ::: "memory");
            const unsigned og = xb_add(&bar[XB_TOP], 1u);
            const unsigned tg = og / nx;
            if (og + 1u == (tg + 1u) * nx) xb_add(&bar[XB_TOPGEN], 1u);
            else XB_SPIN(xb_ld(&bar[XB_TOPGEN]) == tg, bar);
            __builtin_amdgcn_fence(__ATOMIC_ACQUIRE, "agent");
            xb_add(&bar[XB_XGEN(b.x)], 1u);
            asm volatile("s_waitcnt vmcnt(0)" ::: "memory");
        } else {
            XB_SPIN(xb_ld(&bar[XB_XGEN(b.x)]) == gen, bar);
            __builtin_amdgcn_fence(__ATOMIC_ACQUIRE, "agent");
            asm volatile("s_waitcnt vmcnt(0)" ::: "memory");
        }
    }
    __syncthreads();
}

namespace pg8 {
typedef int v4i __attribute__((ext_vector_type(4)));
typedef int v8i __attribute__((ext_vector_type(8)));
constexpr int BM = 256, BK = 64, HALF = 128, HTB = HALF * BK * 2, STAGE_BYTES = 8 * HTB;
__host__ __device__ __forceinline__ int lds_byte(int r, int c) { const int st = (r >> 4) * 2 + (c >> 5), rr = r & 15, cc = c & 31, ob = rr * 64 + cc * 2; return st * 1024 + (ob ^ (((ob >> 9) & 1) << 5)); }
__host__ __device__ __forceinline__ void stage_rc(int b, int& R, int& C) { const int st = b / 1024, sb = b % 1024, swz = sb ^ (((sb >> 9) & 1) << 5); R = (st >> 1) * 16 + swz / 64; C = (st & 1) * 32 + (swz % 64) / 2; }
__host__ __device__ __forceinline__ int perm32(int rho) { const int n = rho >> 4, i = rho & 15; return 8 * (i >> 2) + 4 * n + (i & 3); }

struct GUnit { const char* a; const char* b; unsigned lda, ldb; int nt; int pm, pn, z; };

__device__ __forceinline__ void tile_of(int L, int nM, int nN, int& pm, int& pn) {
    const int nwg = nM * nN; int wgid = L;
    { const int q = nwg / 8, r = nwg % 8, xcd = wgid % 8, off = wgid / 8; wgid = (xcd < r ? xcd * (q + 1) : r * (q + 1) + (xcd - r) * q) + off; }
    const int nig = 8 * nN, gid = wgid / nig, fm = gid * 8, gsz = (nM - fm) < 8 ? (nM - fm) : 8;
    pm = fm + ((wgid % nig) % gsz); pn = (wgid % nig) / gsz;
}

template <class Epi, class Sched, bool GATHER, bool F8 = false>
__device__ __forceinline__ void gemm_phase(LAS unsigned char* lds, const Sched& S, const Epi& E, int wave_) {
    int tid = wave_ * 64 + lane_id(); asm volatile("" : "+v"(tid));
    const int wid = __builtin_amdgcn_readfirstlane(tid >> 6), lane = tid & 63, wr = wid >> 2, wc = wid & 3, fr = lane & 15, fq = lane >> 4;
    int Rr[2], Cc[2], Rb[2];
#pragma unroll
    for (int i = 0; i < 2; ++i) { stage_rc(tid * 16 + i * 8192, Rr[i], Cc[i]); Rb[i] = Epi::PERM ? ((Rr[i] & ~31) + perm32(Rr[i] & 31)) : Rr[i]; }
    const size_t kstep = (size_t)(BK * 2);
    const unsigned ldsw = (unsigned)wid * 1024u;
    const int aoff = lds_byte(wr * 64 + fr, fq * 8), boff = lds_byte(wc * 32 + fr, fq * 8);
#define PG8_SA(b, h) (((b) * 2 + (h)) * HTB)
#define PG8_SB(b, h) ((4 + (b) * 2 + (h)) * HTB)
#define PG8_STAGE(bufoff, gbase, v0, v1) do { \
        __builtin_amdgcn_global_load_lds((const unsigned*)((const char*)(gbase) + (v0)), (LAS unsigned*)(lds + (bufoff) + ldsw), 16, 0, 0); \
        __builtin_amdgcn_global_load_lds((const unsigned*)((const char*)(gbase) + (v1)), (LAS unsigned*)(lds + (bufoff) + ldsw + 8192), 16, 0, 0); } while (0)
#define PG8_LD16(p) __builtin_bit_cast(v4i, *(const LAS bf16x8*)(p))
#define PG8_LDA(dst, b, h) do { _Pragma("unroll") for (int m = 0; m < 4; ++m) dst[m] = __builtin_shufflevector(PG8_LD16(lds + PG8_SA(b, h) + aoff + m * 2048), PG8_LD16(lds + PG8_SA(b, h) + aoff + m * 2048 + 1024), 0, 1, 2, 3, 4, 5, 6, 7); } while (0)
#define PG8_LDB(dst, b, h) do { _Pragma("unroll") for (int n = 0; n < 2; ++n) dst[n] = __builtin_shufflevector(PG8_LD16(lds + PG8_SB(b, h) + boff + n * 2048), PG8_LD16(lds + PG8_SB(b, h) + boff + n * 2048 + 1024), 0, 1, 2, 3, 4, 5, 6, 7); } while (0)
#define PG8_LO(x) __builtin_bit_cast(bf16x8, __builtin_shufflevector(x, x, 0, 1, 2, 3))
#define PG8_HI(x) __builtin_bit_cast(bf16x8, __builtin_shufflevector(x, x, 4, 5, 6, 7))
#define PG8_MMA(ai, bj, At, Bt) do { __builtin_amdgcn_s_setprio(1); \
        _Pragma("unroll") for (int m = 0; m < 4; ++m) _Pragma("unroll") for (int n = 0; n < 2; ++n) { \
            if constexpr (F8) acc[ai][bj][m][n] = __builtin_amdgcn_mfma_scale_f32_16x16x128_f8f6f4(Bt[n], At[m], acc[ai][bj][m][n], 0, 0, 0, 0, 0, 0); \
            else { acc[ai][bj][m][n] = __builtin_amdgcn_mfma_f32_16x16x32_bf16(PG8_LO(Bt[n]), PG8_LO(At[m]), acc[ai][bj][m][n], 0, 0, 0); \
                   acc[ai][bj][m][n] = __builtin_amdgcn_mfma_f32_16x16x32_bf16(PG8_HI(Bt[n]), PG8_HI(At[m]), acc[ai][bj][m][n], 0, 0, 0); } } \
        __builtin_amdgcn_s_setprio(0); } while (0)
#define PG8_WAIT_V(n) asm volatile("s_waitcnt vmcnt(" #n ")" ::: "memory")
#define PG8_WAIT_L(n) asm volatile("s_waitcnt lgkmcnt(" #n ")" ::: "memory")
#define PG8_BAR __builtin_amdgcn_s_barrier()
#define PG8_SCHED __builtin_amdgcn_sched_barrier(0)
#define PG8_OFFS(u) do { \
        _Pragma("unroll") for (int i_ = 0; i_ < 2; ++i_) { \
            if constexpr (GATHER) { oA0[i_] = S.arow(u, Rr[i_]) + (unsigned)Cc[i_] * 2u; oA1[i_] = S.arow(u, HALF + Rr[i_]) + (unsigned)Cc[i_] * 2u; } \
            else { oA0[i_] = (unsigned)Rr[i_] * (u).lda + (unsigned)Cc[i_] * 2u; } \
            oB[i_] = (unsigned)Rb[i_] * (u).ldb + (unsigned)Cc[i_] * 2u; } \
        hA = GATHER ? (size_t)0 : (size_t)HALF * (u).lda; hB = (size_t)HALF * (u).ldb; } while (0)
#define PG8_A1(i) (GATHER ? oA1[i] : oA0[i])
    GUnit cur, nxt; int ui = 0;
    if (!S.next(0, cur)) return;
    f32x4 acc[2][2][4][2];
#pragma unroll
    for (int a = 0; a < 2; ++a)
#pragma unroll
        for (int b = 0; b < 2; ++b)
#pragma unroll
            for (int m = 0; m < 4; ++m)
#pragma unroll
                for (int n = 0; n < 2; ++n) acc[a][b][m][n] = (f32x4){0.f, 0.f, 0.f, 0.f};
    v8i At[4], B0[2], B1[2];
    unsigned oA0[2], oA1[2], oB[2]; size_t hA, hB;
    oA1[0] = 0u; oA1[1] = 0u;
    PG8_OFFS(cur);
    const char* cA = cur.a; const char* cBp = cur.b;
    PG8_STAGE(PG8_SB(0, 0), cBp, oB[0], oB[1]); PG8_STAGE(PG8_SB(0, 1), cBp + hB, oB[0], oB[1]); PG8_STAGE(PG8_SA(0, 0), cA, oA0[0], oA0[1]); PG8_STAGE(PG8_SA(0, 1), cA + hA, PG8_A1(0), PG8_A1(1));
    if (wr == 1) PG8_BAR;
    PG8_WAIT_V(2); PG8_BAR;
    PG8_STAGE(PG8_SB(1, 0), cBp + kstep, oB[0], oB[1]); PG8_STAGE(PG8_SA(1, 0), cA + kstep, oA0[0], oA0[1]); PG8_STAGE(PG8_SB(1, 1), cBp + hB + kstep, oB[0], oB[1]);
    PG8_WAIT_V(6); PG8_BAR;
    for (;;) {
        const bool has_next = S.next(ui + 1, nxt);
        const char* nA = has_next ? nxt.a : cA; const char* nBp = has_next ? nxt.b : cBp;
        int nt = cur.nt; asm volatile("" : "+s"(nt));
        for (int t = 0; t < nt; t += 2) {
            const bool last = (t == nt - 2);
            const char* a1 = cA + (size_t)(t + 1) * kstep;
            const char* a2 = last ? nA : cA + (size_t)(t + 2) * kstep; const char* b2 = last ? nBp : cBp + (size_t)(t + 2) * kstep;
            const char* a3 = a2 + kstep; const char* b3 = b2 + kstep;
            PG8_LDB(B0, 0, 0); PG8_LDB(B1, 0, 1); PG8_SCHED; PG8_LDA(At, 0, 0); PG8_STAGE(PG8_SA(1, 1), a1 + hA, PG8_A1(0), PG8_A1(1));
            if (last && has_next) PG8_OFFS(nxt);
            PG8_WAIT_V(8); PG8_WAIT_L(0); PG8_BAR; PG8_MMA(0, 0, At, B0); PG8_MMA(0, 1, At, B1); PG8_BAR; PG8_SCHED;
            PG8_LDA(At, 0, 1); PG8_STAGE(PG8_SB(0, 0), b2, oB[0], oB[1]); PG8_STAGE(PG8_SB(0, 1), b2 + hB, oB[0], oB[1]); PG8_STAGE(PG8_SA(0, 0), a2, oA0[0], oA0[1]);
            PG8_WAIT_V(8); PG8_WAIT_L(0); PG8_BAR; PG8_MMA(1, 0, At, B0); PG8_MMA(1, 1, At, B1); PG8_BAR; PG8_SCHED;
            PG8_LDB(B0, 1, 0); PG8_LDB(B1, 1, 1); PG8_SCHED; PG8_LDA(At, 1, 0); PG8_STAGE(PG8_SA(0, 1), a2 + hA, PG8_A1(0), PG8_A1(1));
            PG8_WAIT_V(8); PG8_WAIT_L(0); PG8_BAR; PG8_MMA(0, 0, At, B0); PG8_MMA(0, 1, At, B1); PG8_BAR; PG8_SCHED;
            PG8_LDA(At, 1, 1); PG8_STAGE(PG8_SB(1, 0), b3, oB[0], oB[1]); PG8_STAGE(PG8_SB(1, 1), b3 + hB, oB[0], oB[1]); PG8_STAGE(PG8_SA(1, 0), a3, oA0[0], oA0[1]);
            PG8_WAIT_V(8); PG8_WAIT_L(0); PG8_BAR; PG8_MMA(1, 0, At, B0); PG8_MMA(1, 1, At, B1); PG8_BAR; PG8_SCHED;
        }
        if (wr == 0) PG8_BAR;
        E(acc, cur, wr, wc, fr, fq);
        if (!has_next) break;
#pragma unroll
        for (int a = 0; a < 2; ++a)
#pragma unroll
            for (int b = 0; b < 2; ++b)
#pragma unroll
                for (int m = 0; m < 4; ++m)
#pragma unroll
                    for (int n = 0; n < 2; ++n) acc[a][b][m][n] = (f32x4){0.f, 0.f, 0.f, 0.f};
        cur = nxt; cA = nA; cBp = nBp; ++ui;
        if (wr == 1) PG8_BAR;
    }
    PG8_WAIT_V(0);
    PG8_BAR;
#undef PG8_SA
#undef PG8_SB
#undef PG8_STAGE
#undef PG8_LDA
#undef PG8_LDB
#undef PG8_LD16
#undef PG8_LO
#undef PG8_HI
#undef PG8_MMA
#undef PG8_WAIT_V
#undef PG8_WAIT_L
#undef PG8_BAR
#undef PG8_SCHED
#undef PG8_OFFS
#undef PG8_A1
}
}

namespace pg8 {
__device__ __forceinline__ unsigned pk_fp8x4(float a, float b, float c, float d) {
    a = __builtin_amdgcn_fmed3f(a, -448.f, 448.f); b = __builtin_amdgcn_fmed3f(b, -448.f, 448.f); c = __builtin_amdgcn_fmed3f(c, -448.f, 448.f); d = __builtin_amdgcn_fmed3f(d, -448.f, 448.f);
    unsigned w = 0; w = __builtin_amdgcn_cvt_pk_fp8_f32(a, b, w, false); w = __builtin_amdgcn_cvt_pk_fp8_f32(c, d, w, true); return w; }
struct SchedPlain {
    const char* A; const char* B; unsigned lda, ldb; int nt, nM, nN, G, c;
    __device__ __forceinline__ bool next(int i, GUnit& u) const {
        const int L = i * G + c; if (L >= nM * nN) return false;
        int pm, pn; tile_of(L, nM, nN, pm, pn);
        u.a = A + (size_t)pm * 256 * lda; u.b = B + (size_t)pn * 256 * ldb; u.lda = lda; u.ldb = ldb; u.nt = nt; u.pm = pm; u.pn = pn; u.z = 0; return true;
    }
};
struct SchedMergeG {
    const char* A; const char* B; unsigned lda, ldb; int nt, nM, L;
    __device__ __forceinline__ bool next(int i, GUnit& u) const {
        if (i >= 3 || L >= nM * 4) return false;
        int pm, pn; tile_of(L, nM, 4, pm, pn);
        u.a = A + (size_t)pm * 256 * lda; u.lda = lda; u.b = B + ((size_t)i * 1024 + pn * 256) * ldb; u.ldb = ldb; u.nt = nt; u.pm = pm; u.pn = pn; u.z = i; return true;
    }
};
struct SchedMergeP {
    const char* A; const char* B; unsigned lda, ldb; int nt, nM, L;
    __device__ __forceinline__ bool next(int i, GUnit& u) const {
        if (i >= 3 || L >= nM * 4) return false;
        int pm, pn; tile_of(L, nM, 4, pm, pn);
        u.a = A + (size_t)pm * 256 * lda + i * 1024; u.lda = lda; u.b = B + ((size_t)i * 1024 + pn * 256) * ldb; u.ldb = ldb; u.nt = nt; u.pm = pm; u.pn = pn; u.z = i; return true;
    }
};
struct SchedMoe1 {
    const char* H2; const char* W; unsigned lda, ldb; int nt; const int* list; const LAS int* tb; int nM, G, c;
    __device__ __forceinline__ bool next(int i, GUnit& u) const {
        const int L = i * G + c; if (L >= nM * 22) return false;
        const int mt = L / 22, pn = L % 22; int e = 0;
#pragma unroll
        for (int j = 1; j < 8; ++j) e += (mt >= tb[8 + j]) ? 1 : 0;
        e = __builtin_amdgcn_readfirstlane(e);
        u.a = H2; u.lda = lda; u.b = W + ((size_t)e * 5632 + pn * 256) * ldb; u.ldb = ldb; u.nt = nt; u.pm = mt; u.pn = pn; u.z = e; return true;
    }
    __device__ __forceinline__ unsigned arow(const GUnit& u, int r) const {
        const int e = u.z, li = (u.pm - tb[8 + e]) * 256 + r; const int tok = (li < tb[e]) ? list[e * 16384 + li] : 0;
        return (unsigned)tok * lda;
    }
};
struct SchedMoe2 {
    const char* A; const char* B; unsigned lda, ldb; int nt; const LAS int* tb; int nM, G, c;
    __device__ __forceinline__ bool next(int i, GUnit& u) const {
        const int L = i * G + c; if (L >= nM * 4) return false;
        int pm, pn; tile_of(L, nM, 4, pm, pn); int e = 0;
#pragma unroll
        for (int j = 1; j < 8; ++j) e += (pm >= tb[8 + j]) ? 1 : 0;
        e = __builtin_amdgcn_readfirstlane(e);
        u.a = A + (size_t)pm * 256 * lda; u.b = B + (size_t)(e * 4 + pn) * 256 * ldb; u.lda = lda; u.ldb = ldb; u.nt = nt; u.pm = pm; u.pn = pn; u.z = e; return true;
    }
};

#define EPI_ROWS_BEGIN _Pragma("unroll") for (int ai = 0; ai < 2; ++ai) _Pragma("unroll") for (int m = 0; m < 4; ++m) { const int row = u.pm * BM + ai * HALF + wr * 64 + m * 16 + fr;
#define EPI_ROWS_END }
__device__ __forceinline__ u32x4 pack_f4f4(const f32x4 a, const f32x4 b) { u32x4 w; w.x = pk2(a[0], a[1]); w.y = pk2(a[2], a[3]); w.z = pk2(b[0], b[1]); w.w = pk2(b[2], b[3]); return w; }

struct EpiBf16 {
    static constexpr bool PERM = true;
    bf16* O; int ldc; int rsub;
    __device__ __forceinline__ void operator()(const f32x4 (&acc)[2][2][4][2], const GUnit& u, int wr, int wc, int fr, int fq) const {
        const int col0 = u.pn * BM + wc * 32 + 8 * fq;
        EPI_ROWS_BEGIN
            bf16* rowp = O + (size_t)(row - rsub) * ldc + col0;
#pragma unroll
            for (int bj = 0; bj < 2; ++bj) *(u32x4*)(rowp + bj * HALF) = pack_f4f4(acc[ai][bj][m][0], acc[ai][bj][m][1]);
        EPI_ROWS_END
    }
};
struct EpiF32 {
    static constexpr bool PERM = false;
    float* C; int ldc;
    __device__ __forceinline__ void operator()(const f32x4 (&acc)[2][2][4][2], const GUnit& u, int wr, int wc, int fr, int fq) const {
        const int col0 = u.pn * BM + wc * 32 + 4 * fq;
        EPI_ROWS_BEGIN
            float* rowp = C + (size_t)row * ldc + col0;
#pragma unroll
            for (int bj = 0; bj < 2; ++bj)
#pragma unroll
                for (int n = 0; n < 2; ++n) *(f32x4*)(rowp + bj * HALF + n * 16) = acc[ai][bj][m][n];
        EPI_ROWS_END
    }
};
struct EpiUq {
    static constexpr bool PERM = true;
    bf16* Qb; const float* cosB; const float* sinB; float scale;
    __device__ __forceinline__ void operator()(const f32x4 (&acc)[2][2][4][2], const GUnit& u, int wr, int wc, int fr, int fq) const {
        const bool lat = u.pm < 64;
        EPI_ROWS_BEGIN
            const int t = row & (SEQ - 1);
#pragma unroll
            for (int bj = 0; bj < 2; ++bj) {
                const int gidx = u.pn * 8 + bj * 4 + wc, head = gidx / 3, part = gidx - head * 3;
                bf16* dst = Qb + (size_t)row * 768 + head * 96 + part * 32;
                f32x4 a = acc[ai][bj][m][0] * scale, b = acc[ai][bj][m][1] * scale;
                if (part == 2) {
                    if (lat) { const f32x4 c = *(const f32x4*)(cosB + t * 16 + 4 * fq), s = *(const f32x4*)(sinB + t * 16 + 4 * fq);
                        const f32x4 x1 = a * c - b * s, x2 = a * s + b * c; a = x1; b = x2; }
                    u32x2 w0, w1; w0.x = pk2(a[0], a[1]); w0.y = pk2(a[2], a[3]); w1.x = pk2(b[0], b[1]); w1.y = pk2(b[2], b[3]);
                    *(u32x2*)(dst + 4 * fq) = w0; *(u32x2*)(dst + 16 + 4 * fq) = w1;
                } else *(u32x4*)(dst + 8 * fq) = pack_f4f4(a, b);
            }
        EPI_ROWS_END
    }
};
struct EpiUkv {
    static constexpr bool PERM = true;
    bf16* Kb; bf16* Vb;
    __device__ __forceinline__ void operator()(const f32x4 (&acc)[2][2][4][2], const GUnit& u, int wr, int wc, int fr, int fq) const {
        bf16* base = (wc < 2) ? Kb : Vb;
        EPI_ROWS_BEGIN
#pragma unroll
            for (int bj = 0; bj < 2; ++bj) { const int head = u.pn * 2 + bj;
                *(u32x4*)(base + (size_t)row * 512 + head * 64 + (wc & 1) * 32 + 8 * fq) = pack_f4f4(acc[ai][bj][m][0], acc[ai][bj][m][1]); }
        EPI_ROWS_END
    }
};
template <int MODE> struct EpiPair {
    static constexpr bool PERM = true;
    bf16* O; int ldc; int cbase; int rsub;
    __device__ __forceinline__ void operator()(const f32x4 (&acc)[2][2][4][2], const GUnit& u, int wr, int wc, int fr, int fq) const {
        const int col0 = cbase + u.pn * 128 + wc * 32 + 8 * fq;
        EPI_ROWS_BEGIN
            f32x4 o[2];
#pragma unroll
            for (int n = 0; n < 2; ++n)
#pragma unroll
                for (int j = 0; j < 4; ++j) { const float a = acc[ai][0][m][n][j], b = acc[ai][1][m][n][j]; o[n][j] = MODE == 0 ? a * fsigmoid(b) : fsilu(a) * b; }
            *(u32x4*)(O + (size_t)(row - rsub) * ldc + col0) = pack_f4f4(o[0], o[1]);
        EPI_ROWS_END
    }
};
struct EpiGate {
    static constexpr bool PERM = true;
    const float* bmg; u32x4* gscr; float ds;
    __device__ __forceinline__ void operator()(const f32x4 (&acc)[2][2][4][2], const GUnit& u, int wr, int wc, int fr, int fq) const {
        const int n = u.z, tid = (wr * 4 + wc) * 64 + fq * 16 + fr;
#pragma unroll
        for (int bj = 0; bj < 2; ++bj) {
            const float* bp = bmg + n * 1024 + u.pn * BM + bj * HALF + wc * 32 + 8 * fq;
            const f32x4 b0 = *(const f32x4*)bp, b1 = *(const f32x4*)(bp + 4);
#pragma unroll
            for (int ai = 0; ai < 2; ++ai)
#pragma unroll
                for (int m = 0; m < 4; ++m) { f32x4 g0 = acc[ai][bj][m][0] * ds + b0, g1 = acc[ai][bj][m][1] * ds + b1;
#pragma unroll
                    for (int j = 0; j < 4; ++j) { g0[j] = fsigmoid(g0[j]); g1[j] = fsigmoid(g1[j]); }
                    gscr[((n * 8 + (tid >> 6)) * 16 + (ai * 4 + m) * 2 + bj) * 64 + (tid & 63)] = pack_f4f4(g0, g1); asm volatile("" ::: "memory"); }
        }
    }
};
struct EpiMergeP {
    static constexpr bool PERM = true;
    bf16* M; const u32x4* gscr;
    __device__ __forceinline__ void operator()(const f32x4 (&acc)[2][2][4][2], const GUnit& u, int wr, int wc, int fr, int fq) const {
        const int n = u.z, tid = (wr * 4 + wc) * 64 + fq * 16 + fr;
        const int col0 = u.pn * BM + wc * 32 + 8 * fq;
        EPI_ROWS_BEGIN
#pragma unroll
            for (int bj = 0; bj < 2; ++bj) {
                float g[8], p[8]; unpack8(gscr[((n * 8 + (tid >> 6)) * 16 + (ai * 4 + m) * 2 + bj) * 64 + (tid & 63)], g);
                bf16* dst = M + (size_t)row * 1024 + col0 + bj * HALF;
                if (n > 0) unpack8(*(const u32x4*)dst, p);
#pragma unroll
                for (int j = 0; j < 8; ++j) { const float v = g[j] * acc[ai][bj][m][j >> 2][j & 3]; p[j] = n > 0 ? p[j] + v : v; }
                *(u32x4*)dst = pack8(p);
            }
            asm volatile("" ::: "memory");
        EPI_ROWS_END
    }
};
template <bool OUT8> struct EpiPairS {
    static constexpr bool PERM = true;
    unsigned char* O; int ldc; int rsub; float ds, os;
    __device__ __forceinline__ void operator()(const f32x4 (&acc)[2][2][4][2], const GUnit& u, int wr, int wc, int fr, int fq) const {
        const int col0 = u.pn * 128 + wc * 32 + 8 * fq;
        EPI_ROWS_BEGIN
            float o[8];
#pragma unroll
            for (int n = 0; n < 2; ++n)
#pragma unroll
                for (int j = 0; j < 4; ++j) { const float a = acc[ai][0][m][n][j] * ds, b = acc[ai][1][m][n][j]; o[4 * n + j] = fsilu(a) * b * (ds * os); }
            if constexpr (OUT8) *(u32x2*)(O + (size_t)(row - rsub) * ldc + col0) = (u32x2){pk_fp8x4(o[0], o[1], o[2], o[3]), pk_fp8x4(o[4], o[5], o[6], o[7])};
            else *(u32x4*)((bf16*)O + (size_t)(row - rsub) * ldc + col0) = pack8(o);
            asm volatile("" ::: "memory");
        EPI_ROWS_END
    }
};
struct EpiF32S {
    static constexpr bool PERM = false;
    float* C; int ldc; float ds;
    __device__ __forceinline__ void operator()(const f32x4 (&acc)[2][2][4][2], const GUnit& u, int wr, int wc, int fr, int fq) const {
        const int col0 = u.pn * BM + wc * 32 + 4 * fq;
        EPI_ROWS_BEGIN
            float* rowp = C + (size_t)row * ldc + col0;
#pragma unroll
            for (int bj = 0; bj < 2; ++bj)
#pragma unroll
                for (int n = 0; n < 2; ++n) *(f32x4*)(rowp + bj * HALF + n * 16) = acc[ai][bj][m][n] * ds;
        EPI_ROWS_END
    }
};
struct EpiBf16S {
    static constexpr bool PERM = true;
    bf16* O; int ldc; float ds;
    __device__ __forceinline__ void operator()(const f32x4 (&acc)[2][2][4][2], const GUnit& u, int wr, int wc, int fr, int fq) const {
        const int col0 = u.pn * BM + wc * 32 + 8 * fq;
        EPI_ROWS_BEGIN
            bf16* rowp = O + (size_t)row * ldc + col0;
#pragma unroll
            for (int bj = 0; bj < 2; ++bj) *(u32x4*)(rowp + bj * HALF) = pack_f4f4(acc[ai][bj][m][0] * ds, acc[ai][bj][m][1] * ds);
        EPI_ROWS_END
    }
};
#undef EPI_ROWS_BEGIN
#undef EPI_ROWS_END
}

namespace att {
__device__ __forceinline__ float swap32_max(float v) { const auto rr = __builtin_amdgcn_permlane32_swap(__float_as_uint(v), __float_as_uint(v), false, false); return __builtin_fmaxf(__uint_as_float(rr[0]), __uint_as_float(rr[1])); }
__device__ __forceinline__ float swap32_sum(float v) { const auto rr = __builtin_amdgcn_permlane32_swap(__float_as_uint(v), __float_as_uint(v), false, false); return __uint_as_float(rr[0]) + __uint_as_float(rr[1]); }
constexpr int VSLOT = 8192, NSLOT = 3;
__device__ __forceinline__ int crow(int r, int hi) { return (r & 3) + 8 * (r >> 2) + 4 * hi; }
__device__ __forceinline__ void glds16(const void* gsrc, unsigned lds_dst) { unsigned keep;
    asm volatile("s_mov_b32 %0, m0\n\ts_mov_b32 m0, %2\n\ts_nop 0\n\tglobal_load_lds_dwordx4 %1, off\n\ts_mov_b32 m0, %0" : "=&s"(keep) : "v"(gsrc), "s"(lds_dst) : "memory"); }
typedef short v4i16_t __attribute__((ext_vector_type(4)));
__device__ __forceinline__ s16x4 vtr(const LAS unsigned char* p) { return __builtin_bit_cast(s16x4, __builtin_amdgcn_ds_read_tr16_b64_v4i16((LAS v4i16_t*)p)); }

struct AttnArgs {
    const bf16* Q; int qpitch, qcol; long qrow0;
    const bf16* K1; int k1pitch, k1col;
    const bf16* K2; int k2pitch;
    const bf16* V; int vpitch, vcol;
    bf16* O; int opitch, ocol;
    int b, ntiles;
};
template <int DK> __device__ __forceinline__ void attn_unit(const AttnArgs& A, LAS unsigned char* lds, int wave_) {
    constexpr int NKS = DK / 16, KSLOT = (DK / 8) * 1024, NKSLOT = 4, NVSLOT = 4; constexpr float THR = 8.f;
    constexpr bool NOMAX = (DK == 64);
    constexpr int LDS_K = 0, LDS_V = NKSLOT * KSLOT, LDS_WS = LDS_V + NVSLOT * VSLOT;
    int tid = wave_ * 64 + lane_id(); asm volatile("" : "+v"(tid));
    const int lane = tid & 63, r32 = lane & 31, hi = lane >> 5; const int wid = __builtin_amdgcn_readfirstlane(tid >> 6);
    const unsigned lds0 = (unsigned)(uintptr_t)lds;
    LAS float* wsf = (LAS float*)(lds + LDS_WS) + wid * 64;
    const int NT = A.ntiles, b = A.b;
#define TILE_ROW(j) ((j) < 4 ? (long)(NLAT + b * CTXL + 64 * (j)) : (long)(b * SEQ + 64 * ((j) - 4)))
#define DMA_K(j) do { const long r0_ = TILE_ROW(j); const int s_ = (j) & 3; \
        glds16(A.K1 + (r0_ + lane) * A.k1pitch + A.k1col + wid * 8, (unsigned)__builtin_amdgcn_readfirstlane(lds0 + LDS_K + s_ * KSLOT + wid * 1024)); \
        if (DK == 96 && wid < 4) glds16(A.K2 + (r0_ + lane) * A.k2pitch + wid * 8, (unsigned)__builtin_amdgcn_readfirstlane(lds0 + LDS_K + s_ * KSLOT + (8 + wid) * 1024)); } while (0)
#define DMA_V(j) do { const long r0_ = TILE_ROW(j); const int s_ = (j) & 3; \
        glds16(A.V + (r0_ + 16 * (wid & 3) + (lane >> 2)) * A.vpitch + A.vcol + (wid >> 2) * 32 + (lane & 3) * 8, (unsigned)__builtin_amdgcn_readfirstlane(lds0 + LDS_V + (s_) * VSLOT + wid * 1024)); } while (0)
#define WAITBAR(n) asm volatile("s_waitcnt vmcnt(" #n ") lgkmcnt(0)\n\ts_barrier" ::: "memory")
#define WAIT_CNT(cnt) do { const int c_ = (cnt); if (c_ >= 3) WAITBAR(3); else if (c_ == 2) WAITBAR(2); else if (c_ == 1) WAITBAR(1); else WAITBAR(0); } while (0)
#define QK(S0, S1, slot) do { const LAS unsigned char* Ks_ = lds + LDS_K + (slot) * KSLOT + hi * 1024 + r32 * 16; \
        _Pragma("unroll") for (int ks = 0; ks < NKS; ++ks) { const bf16x8 k0_ = *(const LAS bf16x8*)(Ks_ + ks * 2048), k1_ = *(const LAS bf16x8*)(Ks_ + ks * 2048 + 512); \
            S0 = __builtin_amdgcn_mfma_f32_32x32x16_bf16(k0_, qr[ks], ks == 0 ? (NOMAX ? f32x16{} : negm) : S0, 0, 0, 0); S1 = __builtin_amdgcn_mfma_f32_32x32x16_bf16(k1_, qr[ks], ks == 0 ? (NOMAX ? f32x16{} : negm) : S1, 0, 0, 0); } } while (0)
    const int nK = (DK == 96 && wid < 4) ? 2 : 1;
    bf16x8 qr[NKS];
    { const bf16* Qw = A.Q + (A.qrow0 + wid * 32 + r32) * A.qpitch + A.qcol + hi * 8;
#pragma unroll
      for (int ks = 0; ks < NKS; ++ks) qr[ks] = *(const bf16x8*)(Qw + ks * 16); }
    asm volatile("s_waitcnt vmcnt(0)" ::: "memory");
    DMA_K(0); DMA_V(0); DMA_K(1); DMA_K(2); DMA_V(1);
    float mref = 0.f, lsum = 0.f; f32x16 o[2]; o[0] = f32x16{}; o[1] = f32x16{};
    f32x16 negm = f32x16{};
    const int vb = (4 * hi + ((lane & 15) >> 2)) * 64 + ((lane >> 4) & 1) * 32 + (lane & 3) * 8;
    f32x16 s0, s1;
    WAITBAR(0);
    QK(s0, s1, 0);
    if constexpr (!NOMAX) { float rm = __builtin_fmaxf(s0[0], s1[0]);
#pragma unroll
      for (int r = 1; r < 16; ++r) rm = __builtin_fmaxf(__builtin_fmaxf(rm, s0[r]), s1[r]);
      rm = swap32_max(rm); mref = rm;
#pragma unroll
      for (int r = 0; r < 16; ++r) { s0[r] -= rm; s1[r] -= rm; negm[r] = -rm; } }
    int vslot = 0;
#define HEAD(t) do { WAITBAR(0);        \
        if ((t) + 3 < NT) DMA_K((t) + 3); if ((t) + 4 < NT) DMA_K((t) + 4); \
        if ((t) + 2 < NT) DMA_V((t) + 2); if ((t) + 3 < NT) DMA_V((t) + 3); } while (0)
#define QKP(N0, N1, t) do { if ((t) + 1 < NT) { const LAS unsigned char* Ks_ = lds + LDS_K + (((t) + 1) & 3) * KSLOT + hi * 1024 + r32 * 16; \
            _Pragma("unroll") for (int kh = 0; kh < 2; ++kh) { bf16x8 kf[NKS]; \
                _Pragma("unroll") for (int k2 = 0; k2 < NKS / 2; ++k2) { const int ks = kh * (NKS / 2) + k2; kf[2 * k2] = *(const LAS bf16x8*)(Ks_ + ks * 2048); kf[2 * k2 + 1] = *(const LAS bf16x8*)(Ks_ + ks * 2048 + 512); } \
                __builtin_amdgcn_s_setprio(1); \
                _Pragma("unroll") for (int k2 = 0; k2 < NKS / 2; ++k2) { const int ks = kh * (NKS / 2) + k2; \
                    N0 = __builtin_amdgcn_mfma_f32_32x32x16_bf16(kf[2 * k2], qr[ks], ks == 0 ? (NOMAX ? f32x16{} : negm) : N0, 0, 0, 0); N1 = __builtin_amdgcn_mfma_f32_32x32x16_bf16(kf[2 * k2 + 1], qr[ks], ks == 0 ? (NOMAX ? f32x16{} : negm) : N1, 0, 0, 0); } \
                __builtin_amdgcn_s_setprio(0); } } } while (0)
#define SMP(C0, C1, N0, N1, t, NREADY) do { if constexpr (!NOMAX) { \
        float rm = __builtin_fmaxf(C0[0], C1[0]); \
        _Pragma("unroll") for (int r = 1; r < 16; ++r) rm = __builtin_fmaxf(__builtin_fmaxf(rm, C0[r]), C1[r]); \
        rm = swap32_max(rm); \
        if (__builtin_expect(__any(rm > THR), 0)) { \
            const float dl = __builtin_fmaxf(rm, 0.f), al = __builtin_amdgcn_exp2f(-dl); \
            mref += dl; lsum *= al; \
            _Pragma("unroll") for (int r = 0; r < 16; ++r) { C0[r] -= dl; C1[r] -= dl; negm[r] = -mref; } \
            if (NREADY && (t) + 1 < NT) { _Pragma("unroll") for (int r = 0; r < 16; ++r) { N0[r] -= dl; N1[r] -= dl; } } \
            if (hi == 0) wsf[r32] = al; \
            asm volatile("s_waitcnt lgkmcnt(0)" ::: "memory"); \
            _Pragma("unroll") for (int rq = 0; rq < 4; ++rq) { const f32x4 a4 = *(const LAS f32x4*)(wsf + 8 * rq + 4 * hi); \
                _Pragma("unroll") for (int j = 0; j < 4; ++j) { o[0][4 * rq + j] *= a4[j]; o[1][4 * rq + j] *= a4[j]; } } \
        } } \
        float ps0 = 0.f, ps1 = 0.f, ps2 = 0.f, ps3 = 0.f; \
        _Pragma("unroll") for (int r = 0; r < 16; r += 2) { C0[r] = __builtin_amdgcn_exp2f(C0[r]); C1[r] = __builtin_amdgcn_exp2f(C1[r]); C0[r + 1] = __builtin_amdgcn_exp2f(C0[r + 1]); C1[r + 1] = __builtin_amdgcn_exp2f(C1[r + 1]); \
            ps0 += C0[r]; ps1 += C1[r]; ps2 += C0[r + 1]; ps3 += C1[r + 1]; } \
        lsum += (ps0 + ps1) + (ps2 + ps3); \
        pw[0] = (u32x4){pk2(C0[0], C0[1]), pk2(C0[2], C0[3]), pk2(C0[4], C0[5]), pk2(C0[6], C0[7])}; \
        pw[1] = (u32x4){pk2(C0[8], C0[9]), pk2(C0[10], C0[11]), pk2(C0[12], C0[13]), pk2(C0[14], C0[15])}; \
        pw[2] = (u32x4){pk2(C1[0], C1[1]), pk2(C1[2], C1[3]), pk2(C1[4], C1[5]), pk2(C1[6], C1[7])}; \
        pw[3] = (u32x4){pk2(C1[8], C1[9]), pk2(C1[10], C1[11]), pk2(C1[12], C1[13]), pk2(C1[14], C1[15])}; } while (0)
#define PVP() do { const LAS unsigned char* Vs = lds + LDS_V + vslot * VSLOT + vb; \
        _Pragma("unroll") for (int d0 = 0; d0 < 2; ++d0) { s16x4 vlo[4], vhh[4]; \
            _Pragma("unroll") for (int i = 0; i < 4; ++i) { vlo[i] = vtr(Vs + d0 * 4096 + i * 1024); vhh[i] = vtr(Vs + d0 * 4096 + i * 1024 + 512); } \
            __builtin_amdgcn_s_setprio(1); \
            _Pragma("unroll") for (int ks = 0; ks < 4; ++ks) { \
                const bf16x8 vf = (bf16x8){vlo[ks][0], vlo[ks][1], vlo[ks][2], vlo[ks][3], vhh[ks][0], vhh[ks][1], vhh[ks][2], vhh[ks][3]}; \
                o[d0] = __builtin_amdgcn_mfma_f32_32x32x16_bf16(__builtin_bit_cast(bf16x8, pw[ks]), vf, o[d0], 0, 0, 0); } \
            __builtin_amdgcn_s_setprio(0); } \
        vslot = (vslot + 1) & 3; } while (0)
    f32x16 n0, n1; u32x4 pw[4];
    if (wid < 8) {
        for (int t = 0; t < NT; t += 2) {
            HEAD(t); QKP(n0, n1, t); SMP(s0, s1, n0, n1, t, 1); PVP();
            QKP(s0, s1, t + 1); SMP(n0, n1, s0, s1, t + 1, 1); PVP(); }
    } else {
        for (int t = 0; t < NT; t += 2) {
            HEAD(t); SMP(s0, s1, n0, n1, t, 0); PVP(); QKP(n0, n1, t);
            SMP(n0, n1, s0, s1, t + 1, 0); PVP(); QKP(s0, s1, t + 1); }
    }
#undef HEAD
#undef QKP
#undef SMP
#undef PVP
    lsum = swap32_sum(lsum);
    if (hi == 0) wsf[32 + r32] = __builtin_amdgcn_rcpf(lsum);
    asm volatile("s_waitcnt vmcnt(0) lgkmcnt(0)\n\ts_barrier" ::: "memory");
    { LAS bf16* stg = (LAS bf16*)(lds + wid * 4096);
#pragma unroll
      for (int rq = 0; rq < 4; ++rq) { const f32x4 i4 = *(const LAS f32x4*)(wsf + 32 + 8 * rq + 4 * hi);
#pragma unroll
          for (int j = 0; j < 4; ++j) { const int q = 8 * rq + 4 * hi + j;
              stg[q * 64 + r32] = (bf16)f2bf(o[0][4 * rq + j] * i4[j]); stg[q * 64 + 32 + r32] = (bf16)f2bf(o[1][4 * rq + j] * i4[j]); } }
      asm volatile("s_waitcnt lgkmcnt(0)" ::: "memory");
      bf16* Ow = A.O + (A.qrow0 + wid * 32) * A.opitch + A.ocol;
#pragma unroll
      for (int i = 0; i < 4; ++i) { const int row = i * 8 + (lane >> 3), ch = lane & 7; *(u32x4*)(Ow + (long)row * A.opitch + ch * 8) = *(const LAS u32x4*)(stg + row * 64 + ch * 8); } }
    asm volatile("s_waitcnt vmcnt(0) lgkmcnt(0)\n\ts_barrier" ::: "memory");
#undef TILE_ROW
#undef DMA_K
#undef DMA_V
#undef WAITBAR
#undef WAIT_CNT
#undef QK
}

template <int DK> __device__ __forceinline__ void attn_unit3(const AttnArgs& A, LAS unsigned char* lds, int wave_) {
    constexpr int NKS = DK / 16, KSLOT = (DK / 8) * 1024, NKSLOT = 4, NVSLOT = 4;
    constexpr int LDS_K = 0, LDS_V = NKSLOT * KSLOT, LDS_WS = LDS_V + NVSLOT * VSLOT;
    int tid = wave_ * 64 + lane_id(); asm volatile("" : "+v"(tid));
    const int lane = tid & 63, r32 = lane & 31, hi = lane >> 5; const int wid = __builtin_amdgcn_readfirstlane(tid >> 6);
    const unsigned lds0 = (unsigned)(uintptr_t)lds;
    LAS float* wsf = (LAS float*)(lds + LDS_WS) + wid * 64;
    const int NT = A.ntiles, b = A.b;
#define TILE_ROW(j) ((j) < 4 ? (long)(NLAT + b * CTXL + 64 * (j)) : (long)(b * SEQ + 64 * ((j) - 4)))
#define DMA_K(j) do { const long r0_ = TILE_ROW(j); const int s_ = (j) & 3; \
        glds16(A.K1 + (r0_ + lane) * A.k1pitch + A.k1col + wid * 8, (unsigned)__builtin_amdgcn_readfirstlane(lds0 + LDS_K + s_ * KSLOT + wid * 1024)); \
        if (DK == 96 && wid < 4) glds16(A.K2 + (r0_ + lane) * A.k2pitch + wid * 8, (unsigned)__builtin_amdgcn_readfirstlane(lds0 + LDS_K + s_ * KSLOT + (8 + wid) * 1024)); } while (0)
#define DMA_V(j) do { const long r0_ = TILE_ROW(j); const int s_ = (j) & 3; \
        glds16(A.V + (r0_ + 16 * (wid & 3) + (lane >> 2)) * A.vpitch + A.vcol + (wid >> 2) * 32 + (lane & 3) * 8, (unsigned)__builtin_amdgcn_readfirstlane(lds0 + LDS_V + (s_) * VSLOT + wid * 1024)); } while (0)
#define WAITBAR(n) asm volatile("s_waitcnt vmcnt(" #n ") lgkmcnt(0)\n\ts_barrier" ::: "memory")
    bf16x8 qr[NKS];
    { const bf16* Qw = A.Q + (A.qrow0 + wid * 32 + r32) * A.qpitch + A.qcol + hi * 8;
#pragma unroll
      for (int ks = 0; ks < NKS; ++ks) qr[ks] = *(const bf16x8*)(Qw + ks * 16); }
    asm volatile("s_waitcnt vmcnt(0)" ::: "memory");
    DMA_K(0); DMA_K(1); DMA_V(0); DMA_K(2); DMA_K(3); DMA_V(1);
    float ls0 = 0.f, ls1 = 0.f, ls2 = 0.f, ls3 = 0.f; f32x16 o[2]; o[0] = f32x16{}; o[1] = f32x16{};
    const int vb = (4 * hi + ((lane & 15) >> 2)) * 64 + ((lane >> 4) & 1) * 32 + (lane & 3) * 8;
    const LAS unsigned char* Kb = lds + LDS_K + hi * 1024 + r32 * 16;
    const LAS unsigned char* Vb = lds + LDS_V + vb;
#define QKH(S0, S1, j, kh) do { const LAS unsigned char* Ks_ = Kb + ((j) & 3) * KSLOT; bf16x8 kf[NKS]; \
        _Pragma("unroll") for (int k2 = 0; k2 < NKS / 2; ++k2) { const int ks = (kh) * (NKS / 2) + k2; kf[2 * k2] = *(const LAS bf16x8*)(Ks_ + ks * 2048); kf[2 * k2 + 1] = *(const LAS bf16x8*)(Ks_ + ks * 2048 + 512); } \
        _Pragma("unroll") for (int k2 = 0; k2 < NKS / 2; ++k2) { const int ks = (kh) * (NKS / 2) + k2; \
            S0 = __builtin_amdgcn_mfma_f32_32x32x16_bf16(kf[2 * k2], qr[ks], ks == 0 ? f32x16{} : S0, 0, 0, 0); S1 = __builtin_amdgcn_mfma_f32_32x32x16_bf16(kf[2 * k2 + 1], qr[ks], ks == 0 ? f32x16{} : S1, 0, 0, 0); } } while (0)
#define PVH(PW, j, d0) do { const LAS unsigned char* Vs_ = Vb + ((j) & 3) * VSLOT + (d0) * 4096; s16x4 vlo[4], vhh[4]; \
        _Pragma("unroll") for (int i = 0; i < 4; ++i) { vlo[i] = vtr(Vs_ + i * 1024); vhh[i] = vtr(Vs_ + i * 1024 + 512); } \
        _Pragma("unroll") for (int ks = 0; ks < 4; ++ks) { const bf16x8 vf = (bf16x8){vlo[ks][0], vlo[ks][1], vlo[ks][2], vlo[ks][3], vhh[ks][0], vhh[ks][1], vhh[ks][2], vhh[ks][3]}; \
            o[d0] = __builtin_amdgcn_mfma_f32_32x32x16_bf16(__builtin_bit_cast(bf16x8, PW[ks]), vf, o[d0], 0, 0, 0); } } while (0)
#define SOFT(C0, C1, PW) do { \
        _Pragma("unroll") for (int r = 0; r < 16; r += 2) { C0[r] = __builtin_amdgcn_exp2f(C0[r]); C1[r] = __builtin_amdgcn_exp2f(C1[r]); C0[r + 1] = __builtin_amdgcn_exp2f(C0[r + 1]); C1[r + 1] = __builtin_amdgcn_exp2f(C1[r + 1]); \
            ls0 += C0[r]; ls1 += C1[r]; ls2 += C0[r + 1]; ls3 += C1[r + 1]; } \
        PW[0] = (u32x4){pk2(C0[0], C0[1]), pk2(C0[2], C0[3]), pk2(C0[4], C0[5]), pk2(C0[6], C0[7])}; \
        PW[1] = (u32x4){pk2(C0[8], C0[9]), pk2(C0[10], C0[11]), pk2(C0[12], C0[13]), pk2(C0[14], C0[15])}; \
        PW[2] = (u32x4){pk2(C1[0], C1[1]), pk2(C1[2], C1[3]), pk2(C1[4], C1[5]), pk2(C1[6], C1[7])}; \
        PW[3] = (u32x4){pk2(C1[8], C1[9]), pk2(C1[10], C1[11]), pk2(C1[12], C1[13]), pk2(C1[14], C1[15])}; } while (0)
#define HINTS() do { _Pragma("unroll") for (int h_ = 0; h_ < 2; ++h_) { __builtin_amdgcn_sched_group_barrier(0x100, NKS + 8, 0); \
            _Pragma("unroll") for (int g_ = 0; g_ < NKS + 4; ++g_) { __builtin_amdgcn_sched_group_barrier(0x008, 1, 0); __builtin_amdgcn_sched_group_barrier(0x400, 2, 0); __builtin_amdgcn_sched_group_barrier(0x002, 3, 0); } } } while (0)
#define STEP3(N0, N1, C0, C1, PN, PC, t) do { __builtin_amdgcn_sched_barrier(0); \
        QKH(N0, N1, (t) + 2, 0); PVH(PC, t, 0); QKH(N0, N1, (t) + 2, 1); PVH(PC, t, 1); SOFT(C0, C1, PN); HINTS(); __builtin_amdgcn_sched_barrier(0); } while (0)
    f32x16 sA0, sA1, sB0, sB1; u32x4 pA[4], pB[4];
    WAITBAR(0);
    QKH(sA0, sA1, 0, 0); QKH(sA0, sA1, 0, 1); QKH(sB0, sB1, 1, 0); QKH(sB0, sB1, 1, 1);
    SOFT(sA0, sA1, pA);
    int t = 0;
    for (; t + 3 < NT; t += 2) {
        WAITBAR(0);
        if (t + 4 < NT) DMA_K(t + 4); if (t + 5 < NT) DMA_K(t + 5); if (t + 2 < NT) DMA_V(t + 2); if (t + 3 < NT) DMA_V(t + 3);
        STEP3(sA0, sA1, sB0, sB1, pB, pA, t);
        STEP3(sB0, sB1, sA0, sA1, pA, pB, t + 1);
    }
    WAITBAR(0);
    __builtin_amdgcn_sched_barrier(0);
    PVH(pA, t, 0); PVH(pA, t, 1); SOFT(sB0, sB1, pB);
    __builtin_amdgcn_sched_barrier(0);
    PVH(pB, t + 1, 0); PVH(pB, t + 1, 1);
    float lsum = (ls0 + ls1) + (ls2 + ls3);
    lsum = swap32_sum(lsum);
    if (hi == 0) wsf[32 + r32] = __builtin_amdgcn_rcpf(lsum);
    asm volatile("s_waitcnt vmcnt(0) lgkmcnt(0)\n\ts_barrier" ::: "memory");
    { LAS bf16* stg = (LAS bf16*)(lds + wid * 4096);
#pragma unroll
      for (int rq = 0; rq < 4; ++rq) { const f32x4 i4 = *(const LAS f32x4*)(wsf + 32 + 8 * rq + 4 * hi);
#pragma unroll
          for (int j = 0; j < 4; ++j) { const int q = 8 * rq + 4 * hi + j;
              stg[q * 64 + r32] = (bf16)f2bf(o[0][4 * rq + j] * i4[j]); stg[q * 64 + 32 + r32] = (bf16)f2bf(o[1][4 * rq + j] * i4[j]); } }
      asm volatile("s_waitcnt lgkmcnt(0)" ::: "memory");
      bf16* Ow = A.O + (A.qrow0 + wid * 32) * A.opitch + A.ocol;
#pragma unroll
      for (int i = 0; i < 4; ++i) { const int row = i * 8 + (lane >> 3), ch = lane & 7; *(u32x4*)(Ow + (long)row * A.opitch + ch * 8) = *(const LAS u32x4*)(stg + row * 64 + ch * 8); } }
    asm volatile("s_waitcnt vmcnt(0) lgkmcnt(0)\n\ts_barrier" ::: "memory");
#undef TILE_ROW
#undef DMA_K
#undef DMA_V
#undef WAITBAR
#undef QKH
#undef PVH
#undef SOFT
#undef HINTS
#undef STEP3
}

#define ASBAR() __builtin_amdgcn_sched_barrier(0)
#define APIN(x) asm volatile("" : "+v"(x))
template <int DK> __device__ __forceinline__ void attn_unit4(const AttnArgs& A, LAS unsigned char* lds, int wave_) {
    constexpr int NKS = DK / 16, KSLOT = (DK / 8) * 1024, NKSLOT = 4, NVSLOT = 4;
    constexpr int LDS_K = 0, LDS_V = NKSLOT * KSLOT, LDS_WS = LDS_V + NVSLOT * VSLOT;
    int tid = wave_ * 64 + lane_id(); asm volatile("" : "+v"(tid));
    const int lane = tid & 63, r32 = lane & 31, hi = lane >> 5; const int wid = __builtin_amdgcn_readfirstlane(tid >> 6);
    const unsigned lds0 = (unsigned)(uintptr_t)lds;
    LAS float* wsf = (LAS float*)(lds + LDS_WS) + wid * 64;
    const int NT = A.ntiles, b = A.b;
#define TILE_ROW(j) ((j) < 4 ? (long)(NLAT + b * CTXL + 64 * (j)) : (long)(b * SEQ + 64 * ((j) - 4)))
#define DMA_K(j) do { const long r0_ = TILE_ROW(j); const int s_ = (j) & 3; \
        glds16(A.K1 + (r0_ + lane) * A.k1pitch + A.k1col + wid * 8, (unsigned)__builtin_amdgcn_readfirstlane(lds0 + LDS_K + s_ * KSLOT + wid * 1024)); \
        if (DK == 96 && wid < 4) glds16(A.K2 + (r0_ + lane) * A.k2pitch + wid * 8, (unsigned)__builtin_amdgcn_readfirstlane(lds0 + LDS_K + s_ * KSLOT + (8 + wid) * 1024)); } while (0)
#define DMA_V(j) do { const long r0_ = TILE_ROW(j); const int s_ = (j) & 3; \
        glds16(A.V + (r0_ + 16 * (wid & 3) + (lane >> 2)) * A.vpitch + A.vcol + (wid >> 2) * 32 + (lane & 3) * 8, (unsigned)__builtin_amdgcn_readfirstlane(lds0 + LDS_V + (s_) * VSLOT + wid * 1024)); } while (0)
#define WAITBAR(n) asm volatile("s_waitcnt vmcnt(" #n ") lgkmcnt(0)\n\ts_barrier" ::: "memory")
    bf16x8 qr[NKS];
    { const bf16* Qw = A.Q + (A.qrow0 + wid * 32 + r32) * A.qpitch + A.qcol + hi * 8;
#pragma unroll
      for (int ks = 0; ks < NKS; ++ks) qr[ks] = *(const bf16x8*)(Qw + ks * 16); }
    asm volatile("s_waitcnt vmcnt(0)" ::: "memory");
    DMA_K(0); DMA_K(1); DMA_V(0); DMA_K(2); DMA_K(3); DMA_V(1);
    float lsum = 0.f; f32x16 o[2]; o[0] = f32x16{}; o[1] = f32x16{};
    const LAS unsigned char* Kb = lds + LDS_K + hi * 1024 + r32 * 16;
    const LAS unsigned char* Vb = lds + LDS_V + (4 * hi + ((lane & 15) >> 2)) * 64 + ((lane >> 4) & 1) * 32 + (lane & 3) * 8;
    f32x16 pA0, pA1, pB0, pB1; bf16x8 kf[2 * NKS]; s16x4 vlo[8], vhi[8]; u32x4 pw0, pw1, pw2, pw3;
#define MF(a, b, c) __builtin_amdgcn_mfma_f32_32x32x16_bf16(a, b, c, 0, 0, 0)
#define KLD2(kp, d0) do { kf[2 * (d0)] = *(const LAS bf16x8*)((kp) + (d0) * 2048); kf[2 * (d0) + 1] = *(const LAS bf16x8*)((kp) + (d0) * 2048 + 512); } while (0)
#define PKW(P, i) pk2(P[i], P[(i) + 1])
#define PAF(k) __builtin_bit_cast(bf16x8, pw##k)
#define VFR(i) (bf16x8){vlo[i][0], vlo[i][1], vlo[i][2], vlo[i][3], vhi[i][0], vhi[i][1], vhi[i][2], vhi[i][3]}
#define VRD(i) do { vlo[i] = vtr(vp_ + (((i) >> 2) * 4096 + ((i) & 3) * 1024)); vhi[i] = vtr(vp_ + (((i) >> 2) * 4096 + ((i) & 3) * 1024 + 512)); } while (0)
#define KRD(G, d0) do { if (G) { KLD2(kn_, d0); ASBAR(); } } while (0)
#define EX(v) __builtin_amdgcn_exp2f(v)
#define GAPA(MFS, a0, a1, a2, a3, W0, W1, PW) do { MFS; sacc += a0; sacc += a1; sacc += a2; sacc += a3; W0; W1; APIN(PW); APIN(sacc); ASBAR(); } while (0)
#define GAPB(MFS, X, i) do { MFS; X[i] = EX(X[i]); X[(i) + 1] = EX(X[(i) + 1]); X[(i) + 2] = EX(X[(i) + 2]); X[(i) + 3] = EX(X[(i) + 3]); APIN(X); ASBAR(); } while (0)
#define STEP4(C0, C1, P0, P1, t, GL) do { ASBAR(); \
    const LAS unsigned char* vp_ = Vb + (((t) - 1) & 3) * VSLOT; const LAS unsigned char* kn_ = Kb + (((t) + 1) & 3) * KSLOT; \
    VRD(0); ASBAR(); float sacc = P0[0] + P0[1]; \
                     GAPA(C0 = MF(kf[0], qr[0], f32x16{}), P0[2], P0[3], P0[4], P0[5],     pw0[0] = PKW(P0, 0),  pw0[1] = PKW(P0, 2),  pw0); \
    VRD(4); ASBAR(); GAPA(C1 = MF(kf[1], qr[0], f32x16{}), P0[6], P0[7], P0[8], P0[9],     pw0[2] = PKW(P0, 4),  pw0[3] = PKW(P0, 6),  pw0); \
    VRD(1); ASBAR(); GAPA(C0 = MF(kf[2], qr[1], C0),       P0[10], P0[11], P0[12], P0[13], pw1[0] = PKW(P0, 8),  pw1[1] = PKW(P0, 10), pw1); \
    VRD(5); ASBAR(); GAPA(C1 = MF(kf[3], qr[1], C1),       P0[14], P0[15], P1[0], P1[1],   pw1[2] = PKW(P0, 12), pw1[3] = PKW(P0, 14), pw1); \
    VRD(2); ASBAR(); GAPA(C0 = MF(kf[4], qr[2], C0),       P1[2], P1[3], P1[4], P1[5],     pw2[0] = PKW(P1, 0),  pw2[1] = PKW(P1, 2),  pw2); \
    VRD(6); ASBAR(); GAPA(C1 = MF(kf[5], qr[2], C1),       P1[6], P1[7], P1[8], P1[9],     pw2[2] = PKW(P1, 4),  pw2[3] = PKW(P1, 6),  pw2); \
    VRD(3); ASBAR(); GAPA(C0 = MF(kf[6], qr[3], C0),       P1[10], P1[11], P1[12], P1[13], pw3[0] = PKW(P1, 8),  pw3[1] = PKW(P1, 10), pw3); \
    VRD(7); ASBAR(); GAPA(C1 = MF(kf[7], qr[3], C1),       P1[14], P1[15], 0.f, 0.f,       pw3[2] = PKW(P1, 12), pw3[3] = PKW(P1, 14), pw3); \
    if (NKS == 6) { C0 = MF(kf[2 * (NKS - 2)], qr[NKS - 2], C0); C1 = MF(kf[2 * (NKS - 2) + 1], qr[NKS - 2], C1); C0 = MF(kf[2 * (NKS - 1)], qr[NKS - 1], C0); C1 = MF(kf[2 * (NKS - 1) + 1], qr[NKS - 1], C1); ASBAR(); } \
    lsum += sacc; ASBAR(); \
    GAPB(o[0] = MF(PAF(0), VFR(0), o[0]), C0, 0);               KRD((GL) && NKS == 6, 4); GAPB(o[1] = MF(PAF(0), VFR(4), o[1]), C0, 4); \
    KRD(GL, 0); GAPB(o[0] = MF(PAF(1), VFR(1), o[0]), C0, 8);   KRD(GL, 1); GAPB(o[1] = MF(PAF(1), VFR(5), o[1]), C0, 12); \
    KRD(GL, 2); GAPB(o[0] = MF(PAF(2), VFR(2), o[0]), C1, 0);   KRD(GL, 3); GAPB(o[1] = MF(PAF(2), VFR(6), o[1]), C1, 4); \
    KRD((GL) && NKS == 6, 5); GAPB(o[0] = MF(PAF(3), VFR(3), o[0]), C1, 8);   GAPB(o[1] = MF(PAF(3), VFR(7), o[1]), C1, 12); \
    } while (0)
    WAITBAR(0);
#pragma unroll
    for (int d0 = 0; d0 < NKS; ++d0) KLD2(Kb, d0);
#pragma unroll
    for (int d0 = 0; d0 < NKS; ++d0) { pA0 = MF(kf[2 * d0], qr[d0], d0 == 0 ? f32x16{} : pA0); pA1 = MF(kf[2 * d0 + 1], qr[d0], d0 == 0 ? f32x16{} : pA1); }
#pragma unroll
    for (int r = 0; r < 16; ++r) { pA0[r] = EX(pA0[r]); pA1[r] = EX(pA1[r]); }
#pragma unroll
    for (int d0 = 0; d0 < NKS; ++d0) KLD2(Kb + KSLOT, d0);
    int t = 1;
    for (; t + 2 < NT; t += 2) {
        WAITBAR(0);
        if (t + 3 < NT) DMA_K(t + 3); if (t + 4 < NT) DMA_K(t + 4); if (t + 1 < NT) DMA_V(t + 1); if (t + 2 < NT) DMA_V(t + 2);
        STEP4(pB0, pB1, pA0, pA1, t, true);
        STEP4(pA0, pA1, pB0, pB1, t + 1, true);
    }
    WAITBAR(0);
    STEP4(pB0, pB1, pA0, pA1, t, false);
    { ASBAR(); float sacc = pB0[0] + pB0[1];
#pragma unroll
      for (int r = 2; r < 16; ++r) sacc += pB0[r];
#pragma unroll
      for (int r = 0; r < 16; ++r) sacc += pB1[r];
      lsum += sacc;
      pw0 = (u32x4){PKW(pB0, 0), PKW(pB0, 2), PKW(pB0, 4), PKW(pB0, 6)}; pw1 = (u32x4){PKW(pB0, 8), PKW(pB0, 10), PKW(pB0, 12), PKW(pB0, 14)};
      pw2 = (u32x4){PKW(pB1, 0), PKW(pB1, 2), PKW(pB1, 4), PKW(pB1, 6)}; pw3 = (u32x4){PKW(pB1, 8), PKW(pB1, 10), PKW(pB1, 12), PKW(pB1, 14)};
      const LAS unsigned char* vp_ = Vb + (t & 3) * VSLOT;
#pragma unroll
      for (int i = 0; i < 8; ++i) VRD(i);
      o[0] = MF(PAF(0), VFR(0), o[0]); o[1] = MF(PAF(0), VFR(4), o[1]); o[0] = MF(PAF(1), VFR(1), o[0]); o[1] = MF(PAF(1), VFR(5), o[1]);
      o[0] = MF(PAF(2), VFR(2), o[0]); o[1] = MF(PAF(2), VFR(6), o[1]); o[0] = MF(PAF(3), VFR(3), o[0]); o[1] = MF(PAF(3), VFR(7), o[1]); }
    lsum = swap32_sum(lsum);
    if (hi == 0) wsf[32 + r32] = __builtin_amdgcn_rcpf(lsum);
    asm volatile("s_waitcnt vmcnt(0) lgkmcnt(0)\n\ts_barrier" ::: "memory");
    { LAS bf16* stg = (LAS bf16*)(lds + wid * 4096);
#pragma unroll
      for (int rq = 0; rq < 4; ++rq) { const f32x4 i4 = *(const LAS f32x4*)(wsf + 32 + 8 * rq + 4 * hi);
#pragma unroll
          for (int j = 0; j < 4; ++j) { const int q = 8 * rq + 4 * hi + j;
              stg[q * 64 + r32] = (bf16)f2bf(o[0][4 * rq + j] * i4[j]); stg[q * 64 + 32 + r32] = (bf16)f2bf(o[1][4 * rq + j] * i4[j]); } }
      asm volatile("s_waitcnt lgkmcnt(0)" ::: "memory");
      bf16* Ow = A.O + (A.qrow0 + wid * 32) * A.opitch + A.ocol;
#pragma unroll
      for (int i = 0; i < 4; ++i) { const int row = i * 8 + (lane >> 3), ch = lane & 7; *(u32x4*)(Ow + (long)row * A.opitch + ch * 8) = *(const LAS u32x4*)(stg + row * 64 + ch * 8); } }
    asm volatile("s_waitcnt vmcnt(0) lgkmcnt(0)\n\ts_barrier" ::: "memory");
#undef TILE_ROW
#undef DMA_K
#undef DMA_V
#undef WAITBAR
#undef MF
#undef KLD2
#undef PKW
#undef PAF
#undef VFR
#undef VRD
#undef KRD
#undef EX
#undef GAPA
#undef GAPB
#undef STEP4
}
#undef ASBAR
#undef APIN
}

namespace s5 {
constexpr int NCH = LPOS / 16;
constexpr int M_MC = 0, M_WCF = 65536, M_WCB = 65536 + 32768, M_WSF = 131072, M_WSB = 131072 + 32768, M_TOTAL = 196608;
constexpr int LDS_E = 18 * 4096;

struct Params { const float *lam_re, *lam_im, *log_dt, *b_re, *b_im, *c_re, *c_im, *dsk; };

__device__ __forceinline__ void build_mats(const Params& P, int l, int g, bf16* out, LAS unsigned char* lds, int wave_) {
    LAS f32x2* apow = (LAS f32x2*)lds;
    LAS f32x2* Bb = apow + 2 * 64 * 17;
    LAS f32x2* Cc = Bb + 2 * 64 * 16;
    LAS float* Kt = (LAS float*)(Cc + 2 * 16 * 64);
    constexpr int KTL = 260, KTD = 16 * KTL;
    const int tid = wave_ * 64 + lane_id();
    for (int i = tid; i < 2 * 64 * 17; i += NTHREADS) {
        const int dir = i / (64 * 17), r = i - dir * (64 * 17), p = r / 17, j = r - p * 17, pi = ((l * 2 + dir) * 32 + g) * 64 + p;
        const float lr = fminf(P.lam_re[pi], -1e-4f), li = P.lam_im[pi], dt = expf(P.log_dt[(l * 2 + dir) * 32 + g]);
        const float mag = expf((float)j * lr * dt), ang = (float)j * li * dt; apow[i] = (f32x2){mag * cosf(ang), mag * sinf(ang)}; }
    for (int i = tid; i < 2048; i += NTHREADS) {
        const int dir = i >> 10, p = (i >> 4) & 63, h = i & 15, pi = ((l * 2 + dir) * 32 + g) * 64 + p;
        const float lr = fminf(P.lam_re[pi], -1e-4f), li = P.lam_im[pi], dt = expf(P.log_dt[(l * 2 + dir) * 32 + g]);
        const float abr = expf(lr * dt) * cosf(li * dt), abi = expf(lr * dt) * sinf(li * dt), den = lr * lr + li * li;
        const float fr = ((abr - 1.0f) * lr + abi * li) / den, fi = (abi * lr - (abr - 1.0f) * li) / den;
        const float br = P.b_re[(size_t)pi * 16 + h], bi = P.b_im[(size_t)pi * 16 + h]; Bb[i] = (f32x2){fr * br - fi * bi, fr * bi + fi * br}; }
    for (int i = tid; i < 2048; i += NTHREADS) { const int dir = i >> 10, hp = (i >> 6) & 15, p = i & 63; const size_t ci = ((size_t)((l * 2 + dir) * 32 + g) * 16 + hp) * 64 + p;
        Cc[i] = (f32x2){P.c_re[ci], P.c_im[ci]}; }
    __syncthreads();
    {
        const int dir = tid >> 8, j = (tid >> 4) & 15, hp0 = ((tid >> 2) & 3) * 4, h0 = (tid & 3) * 4; float sacc[4][4];
#pragma unroll
        for (int x = 0; x < 4; ++x)
#pragma unroll
            for (int y = 0; y < 4; ++y) sacc[x][y] = 0.f;
        for (int p = 0; p < 64; ++p) { const f32x2 a = apow[(dir * 64 + p) * 17 + j];
            const f32x2 c0_ = Cc[(dir * 16 + hp0) * 64 + p], c1_ = Cc[(dir * 16 + hp0 + 1) * 64 + p], c2_ = Cc[(dir * 16 + hp0 + 2) * 64 + p], c3_ = Cc[(dir * 16 + hp0 + 3) * 64 + p];
            const f32x4 c01 = {c0_.x, c0_.y, c1_.x, c1_.y}, c23 = {c2_.x, c2_.y, c3_.x, c3_.y};
            const f32x4 b01 = *(const LAS f32x4*)(Bb + (dir * 64 + p) * 16 + h0), b23 = *(const LAS f32x4*)(Bb + (dir * 64 + p) * 16 + h0 + 2);
            const float cx[4] = {c01[0], c01[2], c23[0], c23[2]}, cy[4] = {c01[1], c01[3], c23[1], c23[3]}, bx[4] = {b01[0], b01[2], b23[0], b23[2]}, by[4] = {b01[1], b01[3], b23[1], b23[3]};
#pragma unroll
            for (int x = 0; x < 4; ++x) { const float tr = cx[x] * a.x - cy[x] * a.y, ti = cx[x] * a.y + cy[x] * a.x;
#pragma unroll
                for (int y = 0; y < 4; ++y) sacc[x][y] += tr * bx[y] - ti * by[y]; } }
#pragma unroll
        for (int x = 0; x < 4; ++x) *(LAS f32x4*)(Kt + dir * KTD + j * KTL + (hp0 + x) * 16 + h0) = (f32x4){sacc[x][0], sacc[x][1], sacc[x][2], sacc[x][3]};
    }
    __syncthreads();
    const float* dsk = P.dsk + (l * 32 + g) * 16;
    for (int i = tid; i < 65536 / 8; i += NTHREADS) {
        const int row = i >> 5, c0 = (i & 31) * 8, t = row >> 4, hp = row & 15, s = c0 >> 4, h0 = c0 & 15; float v[8];
#pragma unroll
        for (int e = 0; e < 8; ++e) { const int h = h0 + e; float x = 0.f;
            if (s <= t) x += Kt[(t - s) * KTL + hp * 16 + h];
            if (s >= t) x += Kt[KTD + (s - t) * KTL + hp * 16 + h];
            if (s == t && h == hp) x += dsk[h];
            v[e] = x; }
        *(u32x4*)(out + M_MC + (size_t)row * 256 + c0) = pack8(v);
    }
    for (int i = tid; i < 2 * 32768 / 8; i += NTHREADS) {
        const int dir = i >> 12, ii = i & 4095, row = ii >> 4, c0 = (ii & 15) * 8, t = row >> 4, hp = row & 15, ex = dir == 0 ? t + 1 : 16 - t; float v[8];
#pragma unroll
        for (int e = 0; e < 8; e += 2) { const int p = (c0 + e) >> 1; const f32x2 c = Cc[(dir * 16 + hp) * 64 + p], a = apow[(dir * 64 + p) * 17 + ex];
            v[e] = c.x * a.x - c.y * a.y; v[e + 1] = -(c.x * a.y + c.y * a.x); }
        *(u32x4*)(out + (dir == 0 ? M_WCF : M_WCB) + (size_t)row * 128 + c0) = pack8(v);
    }
    for (int i = tid; i < 2 * 32768 / 8; i += NTHREADS) {
        const int dir = i >> 12, ii = i & 4095, row = ii >> 5, c0 = (ii & 31) * 8, p = row >> 1, im = row & 1, s = c0 >> 4, h0 = c0 & 15, ex = dir == 0 ? 15 - s : s; float v[8];
        const f32x2 a = apow[(dir * 64 + p) * 17 + ex];
#pragma unroll
        for (int e = 0; e < 8; ++e) { const f32x2 bb = Bb[(dir * 64 + p) * 16 + h0 + e]; v[e] = im ? (a.x * bb.y + a.y * bb.x) : (a.x * bb.x - a.y * bb.y); }
        *(u32x4*)(out + (dir == 0 ? M_WSF : M_WSB) + (size_t)row * 256 + c0) = pack8(v);
    }
    __syncthreads();
}

__device__ __forceinline__ void build_a16(const Params& P, float* a16, int gt, int ngt) {
    for (int pi = gt; pi < 2 * 2 * 32 * 64; pi += ngt) {
        const float lr = fminf(P.lam_re[pi], -1e-4f), li = P.lam_im[pi], dt = expf(P.log_dt[pi >> 6]);
        const float mag = expf(16.f * lr * dt), ang = 16.f * li * dt; a16[2 * pi] = mag * cosf(ang); a16[2 * pi + 1] = mag * sinf(ang); }
}
__device__ __forceinline__ void unit(const float* a16, int l, int b, int g, const bf16* Ug, const bf16* mats, bf16* Aglu, bool skip_ctx, LAS unsigned char* lds, int wave_, int half) {
    int tid = wave_ * 64 + lane_id(); asm volatile("" : "+v"(tid));
    const int lane = tid & 63, n = lane & 15, q = lane >> 4; const int wid = __builtin_amdgcn_readfirstlane(tid >> 6);
    LAS unsigned char* Ef = lds; LAS unsigned char* Eb = lds + LDS_E;
    const bf16* U = Ug + (size_t)(b * 32 + g) * LPOS * 16;
    const int rt = 8 * half + wid;
    f32x4 yi[17];
    {
        bf16x8 af[8], ab[8], am[8]; u32x4 st[4]; unsigned uoff[8];
#pragma unroll
        for (int ks = 0; ks < 8; ++ks) { af[ks] = *(const bf16x8*)(mats + M_WSF + (size_t)(16 * wid + n) * 256 + 32 * ks + 8 * q); ab[ks] = *(const bf16x8*)(mats + M_WSB + (size_t)(16 * wid + n) * 256 + 32 * ks + 8 * q);
            am[ks] = *(const bf16x8*)(mats + M_MC + (size_t)(16 * rt + n) * 256 + 32 * ks + 8 * q); }
        const bf16* ug = U + wid * 512 + lane * 8;
        const int ns = 2 * wid + (lane >> 5), js = lane & 31;
        const unsigned sdst = (ns < 8 ? 0u : (unsigned)LDS_E) + (ns & 7) * 512 + ((js ^ ns) << 4);
#pragma unroll
        for (int i = 0; i < 4; ++i) st[i] = *(const u32x4*)(ug + i * 4096);
#pragma unroll
        for (int ks = 0; ks < 8; ++ks) uoff[ks] = (n < 8 ? 0u : (unsigned)LDS_E) + (n & 7) * 512 + (((4 * ks + q) ^ n) << 4);
        *(LAS u32x4*)(lds + sdst + 4096) = st[0]; st[0] = *(const u32x4*)(ug + 4 * 4096);
        __syncthreads();
#pragma unroll
        for (int t = 0; t < 17; ++t) {
            bf16x8 ub[8];
#pragma unroll
            for (int ks = 0; ks < 8; ++ks) ub[ks] = *(const LAS bf16x8*)(lds + 4096 * (t + 1) + uoff[ks]);
            if (t + 1 < 17) { *(LAS u32x4*)(lds + sdst + 4096 * (t + 2)) = st[(t + 1) & 3]; if (t + 5 < 17) st[(t + 1) & 3] = *(const u32x4*)(ug + (t + 5) * 4096); }
            f32x4 cf = {0.f, 0.f, 0.f, 0.f}, cb = {0.f, 0.f, 0.f, 0.f}, cy = {0.f, 0.f, 0.f, 0.f};
#pragma unroll
            for (int ks = 0; ks < 8; ++ks) { cf = __builtin_amdgcn_mfma_f32_16x16x32_bf16(af[ks], ub[ks], cf, 0, 0, 0); cb = __builtin_amdgcn_mfma_f32_16x16x32_bf16(ab[ks], ub[ks], cb, 0, 0, 0);
                if (!(t == 0 && skip_ctx)) cy = __builtin_amdgcn_mfma_f32_16x16x32_bf16(am[ks], ub[ks], cy, 0, 0, 0); }
            yi[t] = cy;
            const int eo = (16 * t + n) * 256 + (((2 * wid + (q >> 1)) ^ n) << 4) + (q & 1) * 8;
            *(LAS u32x2*)(Ef + eo) = (u32x2){pk2(cf[0], cf[1]), pk2(cf[2], cf[3])};
            *(LAS u32x2*)(Eb + eo) = (u32x2){pk2(cb[0], cb[1]), pk2(cb[2], cb[3])};
            __syncthreads();
        }
    }
    bf16x8 wf[4], wb[4];
#pragma unroll
    for (int ks = 0; ks < 4; ++ks) { wf[ks] = *(const bf16x8*)(mats + M_WCF + (size_t)(16 * rt + n) * 128 + 32 * ks + 8 * q); wb[ks] = *(const bf16x8*)(mats + M_WCB + (size_t)(16 * rt + n) * 128 + 32 * ks + 8 * q); }
    if (wid < 2) {
        const int dir = wid, p = lane, pi = ((l * 2 + dir) * 32 + g) * 64 + p;
        const float ar = a16[2 * pi], ai = a16[2 * pi + 1];
        LAS unsigned* E32 = (LAS unsigned*)(dir ? Eb : Ef);
        float xr = 0.f, xi = 0.f;
#define S5_CH(st) (dir == 0 ? (st) : ((st) < 16 ? 15 - (st) : NCH + 15 - (st)))
#define S5_EW(k, j) (S5_CH(16 * (k) + (j)) * 64 + ((((p >> 2) ^ (dir == 0 ? (j) : 15 - (j))) << 2) | (p & 3)))
        unsigned ea[16], eb[16];
#pragma unroll
        for (int j = 0; j < 16; ++j) ea[j] = E32[S5_EW(0, j)];
        for (int k = 0; k < 17; k += 2) {
#pragma unroll
            for (int j = 0; j < 16; ++j) eb[j] = E32[S5_EW(k + 1 < 17 ? k + 1 : k, j)];
#pragma unroll
            for (int j = 0; j < 16; ++j) { const unsigned e = ea[j]; E32[S5_EW(k, j)] = pk2(xr, xi);
                const float er = bf2f(e & 0xffffu), ei = bf2f(e >> 16); const float nr = ar * xr - ai * xi + er, ni = ar * xi + ai * xr + ei; xr = nr; xi = ni; }
            if (k + 1 < 17) {
#pragma unroll
                for (int j = 0; j < 16; ++j) ea[j] = E32[S5_EW(k + 2 < 17 ? k + 2 : k + 1, j)];
#pragma unroll
                for (int j = 0; j < 16; ++j) { const unsigned e = eb[j]; E32[S5_EW(k + 1, j)] = pk2(xr, xi);
                    const float er = bf2f(e & 0xffffu), ei = bf2f(e >> 16); const float nr = ar * xr - ai * xi + er, ni = ar * xi + ai * xr + ei; xr = nr; xi = ni; }
            }
        }
#undef S5_EW
#undef S5_CH
    }
    __syncthreads();
    {
        unsigned xoff[4];
#pragma unroll
        for (int ks = 0; ks < 4; ++ks) xoff[ks] = n * 256 + (((q + 4 * ks) ^ n) << 4);
#pragma unroll
        for (int ct = 0; ct < 17; ++ct) {
            if (ct == 0 && skip_ctx) continue;
            int cto = ct; asm volatile("" : "+s"(cto));
            f32x4 acc = yi[ct];
#pragma unroll
            for (int ks = 0; ks < 4; ++ks) { acc = __builtin_amdgcn_mfma_f32_16x16x32_bf16(wf[ks], *(const LAS bf16x8*)(Ef + 4096 * cto + xoff[ks]), acc, 0, 0, 0);
                acc = __builtin_amdgcn_mfma_f32_16x16x32_bf16(wb[ks], *(const LAS bf16x8*)(Eb + 4096 * cto + xoff[ks]), acc, 0, 0, 0); }
            const int pos = (16 * cto + n) * 16 + rt;
            *(u32x2*)(Aglu + (size_t)pos_row(b, pos) * 512 + g * 16 + 4 * q) = (u32x2){pk2(fgelu_tanh(acc[0]), fgelu_tanh(acc[1])), pk2(fgelu_tanh(acc[2]), fgelu_tanh(acc[3]))};
        }
    }
    __syncthreads();
}
}

struct Ptrs {
    const float *x, *c, *ctx, *c_ctx, *w_mod, *b_mod, *g_mix_pre, *g_mix_post, *g_ffn_pre, *g_ffn_post, *w_in, *g_q, *g_k, *g_cq, *g_ckv, *w_uq, *w_ukv;
    s5::Params s5p;
    const float *w_glu, *w_branch, *w_mg, *b_mg, *w_out, *ffn_w1, *ffn_w3, *ffn_w2, *router_w, *router_b, *moe_w1, *moe_w3, *moe_w2;
    float* out; unsigned char* ws;
};

template <int MAP  >
__device__ __forceinline__ void transpose_item(const float* W, int K, int N, bf16* WT, int kb, int n0, int drow0, LAS float* scr, int lane) {
    const int k0 = 64 * kb;
#pragma unroll
    for (int i = 0; i < 8; ++i) { const int kk = 8 * i + (lane >> 3), c4 = 4 * (lane & 7); const f32x4 v = *(const f32x4*)(W + (size_t)(k0 + kk) * N + n0 + c4);
        LAS float* d = scr + kk * 33 + c4; d[0] = v[0]; d[1] = v[1]; d[2] = v[2]; d[3] = v[3]; }
    asm volatile("s_waitcnt lgkmcnt(0)" ::: "memory");
    const int c = lane & 7;
#pragma unroll
    for (int j = 0; j < 4; ++j) { const int n = (lane >> 3) + 8 * j; const LAS float* s = scr + (8 * c) * 33 + n;
        u32x4 o; o.x = pk2(s[0 * 33], s[1 * 33]); o.y = pk2(s[2 * 33], s[3 * 33]); o.z = pk2(s[4 * 33], s[5 * 33]); o.w = pk2(s[6 * 33], s[7 * 33]);
        int dr = n; if (MAP == 1) { const int i2 = n & 15; dr = 8 * (i2 >> 2) + (i2 & 3) + ((n >> 4) << 2); }
        *(u32x4*)(WT + (size_t)(drow0 + dr) * K + k0 + 8 * c) = o; }
    asm volatile("s_waitcnt lgkmcnt(0)" ::: "memory");
}

__device__ __forceinline__ void transpose_item_f8(const float* W, int K, int N, unsigned char* WT, int kb, int n0, int drow0, float wscale, LAS float* scr, int lane) {
    const int k0 = 64 * kb;
#pragma unroll
    for (int i = 0; i < 8; ++i) { const int kk = 8 * i + (lane >> 3), c4 = 4 * (lane & 7); const f32x4 v = *(const f32x4*)(W + (size_t)(k0 + kk) * N + n0 + c4);
        LAS float* d = scr + kk * 33 + c4; d[0] = v[0]; d[1] = v[1]; d[2] = v[2]; d[3] = v[3]; }
    asm volatile("s_waitcnt lgkmcnt(0)" ::: "memory");
    const int c = lane & 7;
#pragma unroll
    for (int j = 0; j < 4; ++j) { const int n = (lane >> 3) + 8 * j; const LAS float* s = scr + (8 * c) * 33 + n;
        u32x2 o; o.x = pg8::pk_fp8x4(s[0 * 33] * wscale, s[1 * 33] * wscale, s[2 * 33] * wscale, s[3 * 33] * wscale); o.y = pg8::pk_fp8x4(s[4 * 33] * wscale, s[5 * 33] * wscale, s[6 * 33] * wscale, s[7 * 33] * wscale);
        *(u32x2*)(WT + (size_t)(drow0 + n) * K + k0 + 8 * c) = o; }
    asm volatile("s_waitcnt lgkmcnt(0)" ::: "memory");
}
__device__ __forceinline__ int zmap(int n0) { return n0 < 512 ? n0 : n0 < 896 ? ZC_CQ + (n0 - 512) : n0 < 1024 ? ZC_KG + (n0 - 896) : n0 < 1152 ? ZC_VG + (n0 - 1024) : n0 < 1440 ? n0 : ZC_U + (n0 - 1440); }
__device__ __forceinline__ int pairmap(int n0, int second) { return 256 * (n0 >> 7) + (second ? 128 : 0) + (n0 & 127); }

__device__ __forceinline__ void transposes(const Ptrs& P, int gw, int ngw, LAS float* scr, int lane, int qsel = 0) {
    unsigned char* ws = P.ws;
    constexpr int I_WIN = 16 * 61, I_MG = 16 * 96, I_UQ = 6 * 24, I_UKV = 4 * 32, I_GLU = 8 * 32, I_BR = 8 * 32, I_OUT = 16 * 32, I_F13 = 16 * 88, I_F2 = 44 * 32;
    constexpr int PER_L = I_WIN + I_MG + I_UQ + I_UKV + I_GLU + 3 * I_BR + I_OUT;
    constexpr int N_L = 2 * PER_L, N_F = 2 * I_F13 + I_F2, N_M = 8 * (2 * I_F13 + I_F2), NITEMS = N_L + N_F + N_M;
    const int qx = (int)blockIdx.x & 7;
    unsigned* q = (unsigned*)(ws + WS_CTL) + CW_Q + 256 * qsel + 32 * qx; (void)gw; (void)ngw;
    for (;;) { int base = 0; if (lane == 0) base = (int)atomicAdd(q, 4u); base = __builtin_amdgcn_readfirstlane(base); if (base * 8 + qx + N_M >= NITEMS) break;
    for (int it_ = base; it_ < base + 4; ++it_) { const int it = it_ * 8 + qx + N_M; if (it >= NITEMS) break;
        int r = it;
        if (r < N_M) {
            const int e = r / (2 * I_F13 + I_F2); r -= e * (2 * I_F13 + I_F2);
            unsigned char* W1T = ws + WS_WM1T + (size_t)e * 5632 * 1024; unsigned char* W2T = ws + WS_WM2T + (size_t)e * 1024 * 2816;
            if (r < I_F13) { const int kb = r / 88, nb = r % 88; if (F8_M1) transpose_item_f8(P.moe_w1 + (size_t)e * 1024 * DFF, 1024, DFF, W1T, kb, 32 * nb, pairmap(32 * nb, 0), F8_WSCALE, scr, lane); else transpose_item<0>(P.moe_w1 + (size_t)e * 1024 * DFF, 1024, DFF, (bf16*)(ws + WS_WM1T) + (size_t)e * 5632 * 1024, kb, 32 * nb, pairmap(32 * nb, 0), scr, lane); continue; } r -= I_F13;
            if (r < I_F13) { const int kb = r / 88, nb = r % 88; if (F8_M1) transpose_item_f8(P.moe_w3 + (size_t)e * 1024 * DFF, 1024, DFF, W1T, kb, 32 * nb, pairmap(32 * nb, 1), F8_WSCALE, scr, lane); else transpose_item<0>(P.moe_w3 + (size_t)e * 1024 * DFF, 1024, DFF, (bf16*)(ws + WS_WM1T) + (size_t)e * 5632 * 1024, kb, 32 * nb, pairmap(32 * nb, 1), scr, lane); continue; } r -= I_F13;
            { const int kb = r / 32, nb = r % 32; transpose_item_f8(P.moe_w2 + (size_t)e * DFF * 1024, DFF, 1024, W2T, kb, 32 * nb, 32 * nb, F8_WSCALE, scr, lane); continue; }
        }
        r -= N_M;
        if (r < N_F) {
            unsigned char* W1T = ws + WS_WF1T; unsigned char* W2T = ws + WS_WF2T;
            if (r < I_F13) { const int kb = r / 88, nb = r % 88; if (F8_D1) transpose_item_f8(P.ffn_w1, 1024, DFF, W1T, kb, 32 * nb, pairmap(32 * nb, 0), F8_WSCALE, scr, lane); else transpose_item<0>(P.ffn_w1, 1024, DFF, (bf16*)W1T, kb, 32 * nb, pairmap(32 * nb, 0), scr, lane); continue; } r -= I_F13;
            if (r < I_F13) { const int kb = r / 88, nb = r % 88; if (F8_D1) transpose_item_f8(P.ffn_w3, 1024, DFF, W1T, kb, 32 * nb, pairmap(32 * nb, 1), F8_WSCALE, scr, lane); else transpose_item<0>(P.ffn_w3, 1024, DFF, (bf16*)W1T, kb, 32 * nb, pairmap(32 * nb, 1), scr, lane); continue; } r -= I_F13;
            { const int kb = r / 32, nb = r % 32; if (F8_D2) transpose_item_f8(P.ffn_w2, DFF, 1024, W2T, kb, 32 * nb, 32 * nb, F8_WSCALE, scr, lane); else transpose_item<0>(P.ffn_w2, DFF, 1024, (bf16*)W2T, kb, 32 * nb, 32 * nb, scr, lane); continue; }
        }
        r -= N_F;
        const int l = r / PER_L; r -= l * PER_L;
        if (r < I_WIN) { const int kb = r / 61, nb = r % 61; if (F8_G1L1 && l == 1) transpose_item_f8(P.w_in + (size_t)l * 1024 * NIN, 1024, NIN, ws + WS_W1T + (size_t)l * ZW * 2048, kb, 32 * nb, zmap(32 * nb), F8_WSCALE, scr, lane);
            else transpose_item<0>(P.w_in + (size_t)l * 1024 * NIN, 1024, NIN, (bf16*)(ws + WS_W1T) + (size_t)l * ZW * 1024, kb, 32 * nb, zmap(32 * nb), scr, lane); continue; } r -= I_WIN;
        if (r < I_MG) { const int kb = r / 96, nb = r % 96; transpose_item_f8(P.w_mg + (size_t)l * 1024 * 3072, 1024, 3072, ws + WS_WMGT + (size_t)l * 3072 * 1024, kb, 32 * nb, 32 * nb, F8_WSCALE, scr, lane); continue; } r -= I_MG;
        if (r < I_UQ) { const int kb = r / 24, nb = r % 24; bf16* T = (bf16*)(ws + WS_WUQT) + (size_t)l * 768 * 384;
            if (nb % 3 == 2) transpose_item<1>(P.w_uq + (size_t)l * 384 * 768, 384, 768, T, kb, 32 * nb, 32 * nb, scr, lane); else transpose_item<0>(P.w_uq + (size_t)l * 384 * 768, 384, 768, T, kb, 32 * nb, 32 * nb, scr, lane); continue; } r -= I_UQ;
        if (r < I_UKV) { const int kb = r / 32, nb = r % 32; transpose_item<0>(P.w_ukv + (size_t)l * 256 * 1024, 256, 1024, (bf16*)(ws + WS_WUKVT) + (size_t)l * 1024 * 256, kb, 32 * nb, 32 * nb, scr, lane); continue; } r -= I_UKV;
        if (r < I_GLU) { const int kb = r / 32, nb = r % 32, n0 = 32 * nb; transpose_item<0>(P.w_glu + (size_t)l * 512 * 1024, 512, 1024, (bf16*)(ws + WS_WGLUT) + (size_t)l * 1024 * 512, kb, n0, n0 < 512 ? pairmap(n0, 0) : pairmap(n0 - 512, 1), scr, lane); continue; } r -= I_GLU;
        if (r < 3 * I_BR) { const int n = r / I_BR; r -= n * I_BR; const int kb = r / 32, nb = r % 32;
            transpose_item<0>(P.w_branch + ((size_t)l * 3 + n) * 512 * 1024, 512, 1024, (bf16*)(ws + WS_WBT) + ((size_t)l * 3 + n) * 1024 * 512, kb, 32 * nb, 32 * nb, scr, lane); continue; } r -= 3 * I_BR;
        { const int kb = r / 32, nb = r % 32; transpose_item<0>(P.w_out + (size_t)l * 1024 * 1024, 1024, 1024, (bf16*)(ws + WS_WOUTT) + (size_t)l * 1024 * 1024, kb, 32 * nb, 32 * nb, scr, lane); }
    } }
}


constexpr int MOE_ITEMS_PER_E = 2 * 16 * 88 + 44 * 32, MOE_ITEMS = 8 * MOE_ITEMS_PER_E;
__device__ __forceinline__ void moe_transposes(const float* w1, const float* w3, const float* w2, unsigned char* ws, int lo, int hi, int giw, int ngiw, LAS float* scr, int lane) {
    constexpr int I_F13 = 16 * 88;
    for (int it = lo + giw; it < hi; it += ngiw) {
        const int e = it / MOE_ITEMS_PER_E; int r = it - e * MOE_ITEMS_PER_E;
        unsigned char* W1T = ws + WS_WM1T + (size_t)e * 5632 * 1024; unsigned char* W2T = ws + WS_WM2T + (size_t)e * 1024 * 2816;
        if (r < I_F13) { const int kb = r / 88, nb = r % 88; if (F8_M1) transpose_item_f8(w1 + (size_t)e * 1024 * DFF, 1024, DFF, W1T, kb, 32 * nb, pairmap(32 * nb, 0), F8_WSCALE, scr, lane); else transpose_item<0>(w1 + (size_t)e * 1024 * DFF, 1024, DFF, (bf16*)(ws + WS_WM1T) + (size_t)e * 5632 * 1024, kb, 32 * nb, pairmap(32 * nb, 0), scr, lane); continue; } r -= I_F13;
        if (r < I_F13) { const int kb = r / 88, nb = r % 88; if (F8_M1) transpose_item_f8(w3 + (size_t)e * 1024 * DFF, 1024, DFF, W1T, kb, 32 * nb, pairmap(32 * nb, 1), F8_WSCALE, scr, lane); else transpose_item<0>(w3 + (size_t)e * 1024 * DFF, 1024, DFF, (bf16*)(ws + WS_WM1T) + (size_t)e * 5632 * 1024, kb, 32 * nb, pairmap(32 * nb, 1), scr, lane); continue; } r -= I_F13;
        { const int kb = r / 32, nb = r % 32; transpose_item_f8(w2 + (size_t)e * DFF * 1024, DFF, 1024, W2T, kb, 32 * nb, 32 * nb, F8_WSCALE, scr, lane); }
    }
}
__device__ __forceinline__ void mod_item(const Ptrs& P, int item, LAS unsigned char* lds, int wave_) {
    LAS float* sc = (LAS float*)lds;
    LAS float* part = sc + 5 * 1024;
    const int lane = lane_id(), wid = wave_, tid = wid * 64 + lane, l = item / 96, n0 = (item % 96) * 64;
    for (int i = tid; i < 5 * 1024; i += NTHREADS) { const float v = i < 4096 ? P.c[i] : P.c_ctx[i - 4096]; sc[i] = v / (1.0f + expf(-v)); }
    __syncthreads();
    float a[5] = {0.f, 0.f, 0.f, 0.f, 0.f};
    const float* W = P.w_mod + (size_t)l * 1024 * 6144 + n0 + lane;
    for (int k0 = wid; k0 < 1024; k0 += 256) {
        float w[32];
#pragma unroll
        for (int j = 0; j < 32; ++j) w[j] = W[(size_t)(k0 + 8 * j) * 6144];
#pragma unroll
        for (int j = 0; j < 32; ++j)
#pragma unroll
            for (int r = 0; r < 5; ++r) a[r] += sc[r * 1024 + k0 + 8 * j] * w[j]; }
#pragma unroll
    for (int r = 0; r < 5; ++r) part[(wid * 5 + r) * 64 + lane] = a[r];
    __syncthreads();
    if (tid < 320) { const int r = tid >> 6; float s = 0.f;
#pragma unroll
        for (int w = 0; w < 8; ++w) s += part[(w * 5 + r) * 64 + lane];
        ((float*)(P.ws + WS_MOD))[((size_t)l * 5 + r) * 6144 + n0 + lane] = s + P.b_mod[l * 6144 + n0 + lane]; }
    __syncthreads();
}
__device__ __forceinline__ void copy_params(const Ptrs& P, int gt, int ngt) {
    float* par = (float*)(P.ws + WS_PAR);
    for (int i = gt; i < 2048; i += ngt) { par[PR_GMIXPRE + i] = P.g_mix_pre[i]; par[PR_GMIXPOST + i] = P.g_mix_post[i]; par[PR_GFFNPRE + i] = P.g_ffn_pre[i]; par[PR_GFFNPOST + i] = P.g_ffn_post[i]; }
    for (int i = gt; i < 128; i += ngt) { par[PR_GQ + i] = P.g_q[i]; par[PR_GK + i] = P.g_k[i]; }
    for (int i = gt; i < 768; i += ngt) par[PR_GCQ + i] = P.g_cq[i];
    for (int i = gt; i < 512; i += ngt) par[PR_GCKV + i] = P.g_ckv[i];
    for (int i = gt; i < 6144; i += ngt) par[PR_BMG + i] = P.b_mg[i];
    for (int i = gt; i < 8192; i += ngt) par[PR_RW + i] = P.router_w[i];
    for (int i = gt; i < 8; i += ngt) par[PR_RB + i] = P.router_b[i];
    s5::build_a16(P.s5p, par + PR_A16, gt, ngt);
}
__device__ __forceinline__ void rope_tables(const Ptrs& P, int gt, int ngt) {
    float* ca = (float*)(P.ws + WS_ROPE); float* sa = ca + 4096 * 32; float* cb = sa + 4096 * 32; float* sb = cb + 4096 * 16;
    for (int i = gt; i < 4096 * 32; i += ngt) { const int pos = i >> 5, j = i & 31; const float f = expf(-9.210340371976184f * (float)(j & 15) * (1.0f / 16.0f));
        const float ang = (float)(j < 16 ? pos / GRIDW : pos % GRIDW) * f; ca[i] = cosf(ang); sa[i] = sinf(ang); }
    for (int i = gt; i < 4096 * 16; i += ngt) { const int pos = i >> 4, j = i & 15; const float f = expf(-9.210340371976184f * (float)(j & 7) * (1.0f / 8.0f));
        const float ang = (float)(j < 8 ? pos / GRIDW : pos % GRIDW) * f; cb[i] = cosf(ang); sb[i] = sinf(ang); }
}

__device__ __forceinline__ void ld8(const float* p, float (&o)[8]) { const f32x4 a = *(const f32x4*)p, b = *(const f32x4*)(p + 4); o[0] = a[0]; o[1] = a[1]; o[2] = a[2]; o[3] = a[3]; o[4] = b[0]; o[5] = b[1]; o[6] = b[2]; o[7] = b[3]; }
__device__ __forceinline__ void token_row(unsigned char* ws, int l, int row, int lane) {
    const float* par = (const float*)(ws + WS_PAR);
    const bf16* z = (const bf16*)(ws + P_Z) + (size_t)row * ZW;
    const bool lat = row < NLAT; const int t = row & (SEQ - 1);
    const float* cosA = (const float*)(ws + WS_ROPE) + t * 32; const float* sinA = cosA + 4096 * 32;
    const float* cosB = (const float*)(ws + WS_ROPE) + 2 * 4096 * 32 + t * 16; const float* sinB = cosB + 4096 * 16;
    float v0[8], v1[8], v2[8];
    unpack8(*(const u32x4*)(z + 8 * lane), v0); unpack8(*(const u32x4*)(z + 512 + 8 * lane), v1); unpack8(*(const u32x4*)(z + 1024 + 8 * lane), v2);
    const u32x4 uraw = *(const u32x4*)(z + ZC_U + 8 * lane);
    float ca[8], sa[8], cb8[8], sb8[8];
    ld8(cosA + ((8 * (lane & 7)) & 31), ca); ld8(sinA + ((8 * (lane & 7)) & 31), sa); ld8(cosB + ((8 * ((lane - 48) & 3)) & 15), cb8); ld8(sinB + ((8 * ((lane - 48) & 3)) & 15), sb8);
    { float ss = 0.f;
#pragma unroll
      for (int j = 0; j < 8; ++j) ss += v0[j] * v0[j];
      ss += shfl_xor_l(ss, 1, lane); ss += shfl_xor_l(ss, 2, lane); ss += shfl_xor_l(ss, 4, lane);
      const float rs = rsqrtf(ss * (1.0f / 64.0f) + EPS); const int d0 = 8 * (lane & 7); float o[8], gq[8];
      ld8(par + PR_GQ + l * 64 + d0, gq);
#pragma unroll
      for (int j = 0; j < 8; ++j) v0[j] = v0[j] * rs * gq[j];
#pragma unroll
      for (int j = 0; j < 8; ++j) { const float other = shfl_xor_l(v0[j], 4, lane); const float c = ca[j], s = sa[j];
          o[j] = lat ? ((d0 < 32) ? v0[j] * c - other * s : other * s + v0[j] * c) : v0[j];
          o[j] *= 0.125f * LOG2E; }
      *(u32x4*)((bf16*)(ws + P_QA) + (size_t)row * 512 + 8 * lane) = pack8(o); }
    { float ss = 0.f;
#pragma unroll
      for (int j = 0; j < 8; ++j) ss += v1[j] * v1[j];
      float ssk = ss; ssk += shfl_xor_l(ssk, 1, lane); ssk += shfl_xor_l(ssk, 2, lane); ssk += shfl_xor_l(ssk, 4, lane);
      float ss2 = 0.f;
#pragma unroll
      for (int j = 0; j < 8; ++j) ss2 += v2[j] * v2[j];
      const float sq = wave_sum((lane >= 32 ? ss : 0.f) + (lane < 16 ? ss2 : 0.f));
      const float skv = wave_sum((lane >= 16 && lane < 48) ? ss2 : 0.f);
      const float rq = rsqrtf(sq * (1.0f / 384.0f) + EPS), rkv = rsqrtf(skv * (1.0f / 256.0f) + EPS);
      { const float rs = rsqrtf(ssk * (1.0f / 64.0f) + EPS); const int d0 = 8 * (lane & 7); float kk[8], o[8], gk[8];
        ld8(par + PR_GK + l * 64 + d0, gk);
#pragma unroll
        for (int j = 0; j < 8; ++j) kk[j] = v1[j] * rs * gk[j];
#pragma unroll
        for (int j = 0; j < 8; ++j) { const float other = shfl_xor_l(kk[j], 4, lane); const float c = ca[j], s = sa[j];
            o[j] = lat ? ((d0 < 32) ? kk[j] * c - other * s : other * s + kk[j] * c) : kk[j]; }
        if (lane < 16) *(u32x4*)((bf16*)(ws + P_KA) + (size_t)row * 128 + 8 * lane) = pack8(o); }
      if (lane >= 16 && lane < 32) *(u32x4*)((bf16*)(ws + P_VA) + (size_t)row * 128 + 8 * (lane - 16)) = pack8(v1);
      { float g1[8], g2[8], g3[8], o[8];
        const int i1 = lane >= 32 ? 8 * (lane - 32) : 0, i2 = lane < 16 ? 256 + 8 * lane : 0, i3 = (lane >= 16 && lane < 48) ? 8 * (lane - 16) : 0;
        ld8(par + PR_GCQ + l * 384 + i1, g1); ld8(par + PR_GCQ + l * 384 + i2, g2); ld8(par + PR_GCKV + l * 256 + i3, g3);
#pragma unroll
        for (int j = 0; j < 8; ++j) o[j] = v1[j] * rq * g1[j];
        if (lane >= 32) *(u32x4*)((bf16*)(ws + P_CQN) + (size_t)row * 384 + i1) = pack8(o);
#pragma unroll
        for (int j = 0; j < 8; ++j) o[j] = v2[j] * rq * g2[j];
        if (lane < 16) *(u32x4*)((bf16*)(ws + P_CQN) + (size_t)row * 384 + i2) = pack8(o);
#pragma unroll
        for (int j = 0; j < 8; ++j) o[j] = v2[j] * rkv * g3[j];
        if (lane >= 16 && lane < 48) *(u32x4*)((bf16*)(ws + P_CKVN) + (size_t)row * 256 + i3) = pack8(o); }
      { float o[8]; const int i0 = 8 * ((lane - 48) & 3);
#pragma unroll
        for (int j = 0; j < 8; ++j) { const float other = shfl_xor_l(v2[j], 2, lane); const float c = cb8[j], s = sb8[j];
            o[j] = lat ? ((i0 < 16) ? v2[j] * c - other * s : other * s + v2[j] * c) : v2[j]; }
        if (lane >= 48 && lane < 52) *(u32x4*)((bf16*)(ws + P_KRR) + (size_t)row * 32 + i0) = pack8(o); }
    }
    { const int b = lat ? row >> 12 : (row - NLAT) >> 8, pos = lat ? CTXL + t : (row - NLAT) & 255, g = lane >> 1;
      *(u32x4*)((bf16*)(ws + P_UG) + ((size_t)(b * 32 + g) * LPOS + pos) * 16 + 8 * (lane & 1)) = uraw; }
}

struct ResidArgs {
    int mode;
    const float* y; const float* g_post; int gate_chunk;
    const float* g_pre; int shift_chunk;
    bool dry;
    float ysc;
    bf16* hout; int l_mod; bool h8; unsigned char* hout8;
    int l_gate; bool route;
};
__device__ __forceinline__ void resid_row(unsigned char* ws, float* outp, const float* xin, const float* ctxin, const ResidArgs R, int row, int lane, const LAS int* tb) {
    const float* par = (const float*)(ws + WS_PAR);
    const bool lat = row < NLAT; const int b = lat ? row >> 12 : (row - NLAT) >> 8, mr = lat ? b : 4;
    const float* mod = (const float*)(ws + WS_MOD);
    float* latp = lat ? outp + (size_t)row * 1024 : (float*)(ws + WS_LATC) + (size_t)(row - NLAT) * 1024;
    f32x4 v[4];
    if (R.mode == 0) { const float* src = lat ? xin + (size_t)row * 1024 : ctxin + (size_t)(row - NLAT) * 1024;
#pragma unroll
        for (int j = 0; j < 4; ++j) v[j] = *(const f32x4*)(src + 4 * lane + 256 * j);
    } else {
        f32x4 yv[4];
        if (R.mode == 1) {
#pragma unroll
            for (int j = 0; j < 4; ++j) yv[j] = *(const f32x4*)(R.y + (size_t)row * 1024 + 4 * lane + 256 * j) * R.ysc;
        } else if (R.mode == 3) {
            const bf16* yb = (const bf16*)R.y + (size_t)row * 1024;
#pragma unroll
            for (int j = 0; j < 4; ++j) { const u32x2 a = *(const u32x2*)(yb + 4 * lane + 256 * j);
                yv[j] = (f32x4){bf2f(a.x & 0xffffu), bf2f(a.x >> 16), bf2f(a.y & 0xffffu), bf2f(a.y >> 16)} * R.ysc; }
        } else {
            const int* ti = (const int*)(ws + WS_LIST) + 8 * 16384 + row * 8;
            const int e0 = ti[0], p0 = ti[1], e1 = ti[2], p1 = ti[3]; const float w0 = __int_as_float(ti[4]) * R.ysc, w1 = __int_as_float(ti[5]) * R.ysc;
            const bf16* f0 = (const bf16*)(ws + P_Y2) + ((size_t)tb[8 + e0] * 256 + p0) * 1024; const bf16* f1 = (const bf16*)(ws + P_Y2) + ((size_t)tb[8 + e1] * 256 + p1) * 1024;
#pragma unroll
            for (int j = 0; j < 4; ++j) { const u32x2 a = *(const u32x2*)(f0 + 4 * lane + 256 * j), c = *(const u32x2*)(f1 + 4 * lane + 256 * j);
                yv[j][0] = w0 * bf2f(a.x & 0xffffu) + w1 * bf2f(c.x & 0xffffu); yv[j][1] = w0 * bf2f(a.x >> 16) + w1 * bf2f(c.x >> 16);
                yv[j][2] = w0 * bf2f(a.y & 0xffffu) + w1 * bf2f(c.y & 0xffffu); yv[j][3] = w0 * bf2f(a.y >> 16) + w1 * bf2f(c.y >> 16); }
        }
        float ss = 0.f;
#pragma unroll
        for (int j = 0; j < 4; ++j) ss += (yv[j][0] * yv[j][0] + yv[j][1] * yv[j][1]) + (yv[j][2] * yv[j][2] + yv[j][3] * yv[j][3]);
        const float rs = rsqrtf(wave_sum(ss) * (1.0f / 1024.0f) + EPS);
        const float* gate = mod + ((size_t)R.l_gate * 5 + mr) * 6144 + R.gate_chunk * 1024;
#pragma unroll
        for (int j = 0; j < 4; ++j) { const int c = 4 * lane + 256 * j; const f32x4 lv = *(const f32x4*)(latp + c), gp = *(const f32x4*)(R.g_post + c), gt = *(const f32x4*)(gate + c);
            v[j] = lv + gt * (yv[j] * rs * gp); }
    }
    if (!R.dry) {
#pragma unroll
    for (int j = 0; j < 4; ++j) *(f32x4*)(latp + 4 * lane + 256 * j) = v[j]; }
    if (R.hout == nullptr) return;
    float ss = 0.f;
#pragma unroll
    for (int j = 0; j < 4; ++j) ss += (v[j][0] * v[j][0] + v[j][1] * v[j][1]) + (v[j][2] * v[j][2] + v[j][3] * v[j][3]);
    const float rs = rsqrtf(wave_sum(ss) * (1.0f / 1024.0f) + EPS);
    const float* shift = mod + ((size_t)R.l_mod * 5 + mr) * 6144 + R.shift_chunk * 1024; const float* scale = shift + 1024;
    f32x4 hv[4];
#pragma unroll
    for (int j = 0; j < 4; ++j) { const int c = 4 * lane + 256 * j; const f32x4 gp = *(const f32x4*)(R.g_pre + c), sh = *(const f32x4*)(shift + c), sc = *(const f32x4*)(scale + c);
        hv[j] = (v[j] * rs * gp) * (1.0f + sc) + sh;
        if (R.dry) { if (hv[j][0] == 123.456f) *(float*)(ws + WS_CTL + 64) = 1.f; continue; }
        if (R.hout8) *(unsigned*)(R.hout8 + (size_t)row * 1024 + c) = pg8::pk_fp8x4(hv[j][0] * F8_HSCALE, hv[j][1] * F8_HSCALE, hv[j][2] * F8_HSCALE, hv[j][3] * F8_HSCALE);
        if (R.h8) *(unsigned*)((unsigned char*)R.hout + (size_t)row * 1024 + c) = pg8::pk_fp8x4(hv[j][0] * F8_HSCALE, hv[j][1] * F8_HSCALE, hv[j][2] * F8_HSCALE, hv[j][3] * F8_HSCALE);
        else *(u32x2*)(R.hout + (size_t)row * 1024 + c) = (u32x2){pk2(hv[j][0], hv[j][1]), pk2(hv[j][2], hv[j][3])}; }
    if (R.route) {
        float lg[8];
#pragma unroll
        for (int e = 0; e < 8; ++e) lg[e] = 0.f;
#pragma unroll
        for (int j = 0; j < 4; ++j)
#pragma unroll
            for (int i = 0; i < 4; ++i) { const float* rw = par + PR_RW + (size_t)(4 * lane + 256 * j + i) * 8; const f32x4 r0 = *(const f32x4*)rw, r1 = *(const f32x4*)(rw + 4); const float hvv = hv[j][i];
                lg[0] += hvv * r0[0]; lg[1] += hvv * r0[1]; lg[2] += hvv * r0[2]; lg[3] += hvv * r0[3]; lg[4] += hvv * r1[0]; lg[5] += hvv * r1[1]; lg[6] += hvv * r1[2]; lg[7] += hvv * r1[3]; }
#pragma unroll
        for (int e = 0; e < 8; ++e) lg[e] = wave_sum(lg[e]) + par[PR_RB + e];
        int e0 = 0; float b0 = lg[0];
#pragma unroll
        for (int e = 1; e < 8; ++e) if (lg[e] > b0) { b0 = lg[e]; e0 = e; }
        int e1 = -1; float b1 = -3.0e38f;
#pragma unroll
        for (int e = 0; e < 8; ++e) if (e != e0 && lg[e] > b1) { b1 = lg[e]; e1 = e; }
        if (lane == 0 && !R.dry) {
            const float w0 = 1.0f / (1.0f + expf(b1 - b0)), w1 = 1.0f - w0;
            unsigned* cnt = (unsigned*)(ws + WS_CTL) + CW_CNT;
            const int p0 = (int)atomicAdd(cnt + e0, 1u), p1 = (int)atomicAdd(cnt + e1, 1u);
            int* list = (int*)(ws + WS_LIST); list[e0 * 16384 + p0] = row; list[e1 * 16384 + p1] = row;
            int* ti = list + 8 * 16384 + row * 8; ti[0] = e0; ti[1] = p0; ti[2] = e1; ti[3] = p1; ti[4] = __float_as_int(w0); ti[5] = __float_as_int(w1);
        }
    }
}

#if MK_DEBUG
namespace dbg {
__device__ __forceinline__ unsigned hash(unsigned a, unsigned b) { unsigned x = a * 0x9E3779B1u ^ (b + 0x7F4A7C15u) * 0x85EBCA77u; x ^= x >> 15; x *= 0xC2B2AE3Du; x ^= x >> 13; x *= 0x27D4EB2Fu; x ^= x >> 16; return x; }
__device__ __forceinline__ float rbf(float f) { return bf2f(f2bf(f)); }
__device__ __forceinline__ void add(unsigned char* ws, int k, float got, float ref, int lane) {
    if (lane == 0) { float* d = (float*)(ws + WS_CTL) + CW_DBG + 2 * k; const float df = got - ref; atomicAdd(d, (df == df && fabsf(df) < 1e18f) ? df * df : 1e30f); atomicAdd(d + 1, ref * ref); }
}
__device__ __forceinline__ float dot_aw(const bf16* a, const float* w, size_t wstride, int K, int lane) { float s = 0.f; for (int k = lane; k < K; k += 64) s += bf2f(a[k]) * rbf(w[(size_t)k * wstride]); return wave_sum(s); }

__device__ __forceinline__ float angA(int t, int i) { return (float)(i < 16 ? t / 64 : t % 64) * powf(10000.f, -(float)(2 * (i & 15)) / 32.f); }
__device__ __forceinline__ float angB(int t, int i) { return (float)(i < 8 ? t / 64 : t % 64) * powf(10000.f, -(float)(2 * (i & 7)) / 16.f); }
__device__ __forceinline__ void chk_mod(unsigned char* ws, const float* const* in, int gw, int ngw, int lane) {
    for (int s = gw; s < 1024; s += ngw) { const unsigned hh = hash(s, 1); const int l = hh & 1, r = (hh >> 1) % 5, n = (hh >> 8) % 6144; float a = 0.f;
        for (int k = lane; k < 1024; k += 64) { const float c = r < 4 ? in[1][r * 1024 + k] : in[3][k]; a += c / (1.f + expf(-c)) * in[4][((size_t)l * 1024 + k) * 6144 + n]; }
        a = wave_sum(a) + in[5][l * 6144 + n]; add(ws, 0, ((const float*)(ws + WS_MOD))[((size_t)l * 5 + r) * 6144 + n], a, lane); }
}
__device__ __forceinline__ void chk_weights(unsigned char* ws, const float* const* in, int gw, int ngw, int lane) {
    for (int s = gw * 64 + lane; s < 65536; s += ngw * 64) { const unsigned hh = hash(s, 2), h2 = hash(s, 3); const int l = hh & 1; float got = 0.f, ref = 0.f; const int which = (hh >> 1) % 12;
        if (which == 0) { const int j = (hh >> 8) % 1952, k = h2 % 1024; int dr = j < 512 ? j : j < 896 ? 768 + (j - 512) : j < 1024 ? 512 + (j - 896) : j < 1152 ? 640 + (j - 1024) : j < 1440 ? j : 1536 + (j - 1440);
            got = bf2f(((const bf16*)(ws + WS_W1T))[((size_t)l * 2048 + dr) * 1024 + k]); ref = rbf(in[10][((size_t)l * 1024 + k) * 1952 + j]); }
        else if (which == 1) { const int j = (hh >> 8) % 3072, k = h2 % 1024; got = bf2f(((const bf16*)(ws + WS_WMGT))[((size_t)l * 3072 + j) * 1024 + k]); ref = rbf(in[27][((size_t)l * 1024 + k) * 3072 + j]); }
        else if (which == 2) { const int j = (hh >> 8) % 768, k = h2 % 384, hd = j / 96, e = j % 96; int de = e; if (e >= 64) { const int i = e - 64; de = 64 + (i < 16 ? 8 * (i >> 2) + (i & 3) : 8 * ((i - 16) >> 2) + 4 + ((i - 16) & 3)); }
            got = bf2f(((const bf16*)(ws + WS_WUQT))[((size_t)l * 768 + hd * 96 + de) * 384 + k]); ref = rbf(in[15][((size_t)l * 384 + k) * 768 + j]); }
        else if (which == 3) { const int j = (hh >> 8) % 1024, k = h2 % 256; got = bf2f(((const bf16*)(ws + WS_WUKVT))[((size_t)l * 1024 + j) * 256 + k]); ref = rbf(in[16][((size_t)l * 256 + k) * 1024 + j]); }
        else if (which == 4) { const int j = (hh >> 8) % 1024, k = h2 % 512; const int jj = j < 512 ? j : j - 512; const int dr = 256 * (jj / 128) + (j < 512 ? 0 : 128) + jj % 128;
            got = bf2f(((const bf16*)(ws + WS_WGLUT))[((size_t)l * 1024 + dr) * 512 + k]); ref = rbf(in[25][((size_t)l * 512 + k) * 1024 + j]); }
        else if (which == 5) { const int n = (hh >> 4) % 3, j = (hh >> 8) % 1024, k = h2 % 512; got = bf2f(((const bf16*)(ws + WS_WBT))[(((size_t)l * 3 + n) * 1024 + j) * 512 + k]); ref = rbf(in[26][(((size_t)l * 3 + n) * 512 + k) * 1024 + j]); }
        else if (which == 6) { const int j = (hh >> 8) % 1024, k = h2 % 1024; got = bf2f(((const bf16*)(ws + WS_WOUTT))[((size_t)l * 1024 + j) * 1024 + k]); ref = rbf(in[29][((size_t)l * 1024 + k) * 1024 + j]); }
        else if (which == 7) { const int j = (hh >> 8) % 2816, k = h2 % 1024, sec = (hh >> 5) & 1; const int dr = 256 * (j / 128) + sec * 128 + j % 128;
            got = bf2f(((const bf16*)(ws + WS_WF1T))[(size_t)dr * 1024 + k]); ref = rbf(in[sec ? 31 : 30][(size_t)k * 2816 + j]); }
        else if (which == 8) { const int j = (hh >> 8) % 1024, k = h2 % 2816; got = bf2f(((const bf16*)(ws + WS_WF2T))[(size_t)j * 2816 + k]); ref = rbf(in[32][(size_t)k * 1024 + j]); }
        else if (which <= 10) { const int e = (hh >> 5) & 7, j = (hh >> 8) % 2816, k = h2 % 1024, sec = which - 9; const int dr = 256 * (j / 128) + sec * 128 + j % 128;
            got = bf2f(((const bf16*)(ws + WS_WM1T))[((size_t)e * 5632 + dr) * 1024 + k]); ref = rbf(in[sec ? 36 : 35][((size_t)e * 1024 + k) * 2816 + j]); }
        else { const int e = (hh >> 5) & 7, j = (hh >> 8) % 1024, k = h2 % 2816; got = bf2f(((const bf16*)(ws + WS_WM2T))[((size_t)e * 1024 + j) * 2816 + k]); ref = rbf(in[37][((size_t)e * 2816 + k) * 1024 + j]); }
        float* d = (float*)(ws + WS_CTL) + CW_DBG + 2 * 1; const float df = got - ref; atomicAdd(d, (df == df) ? df * df : 1e30f); atomicAdd(d + 1, ref * ref); }
}
__device__ __forceinline__ void chk_h(unsigned char* ws, const float* const* in, const float* outp, int k, int l_mod, int shift_chunk, const float* g_pre, int nrows, int gw, int ngw, int lane) {
    for (int s = gw; s < 512; s += ngw) { const int row = hash(s, 10 + k) % nrows; const bool lat = row < NLAT; const int mr = lat ? row >> 12 : 4;
        const float* latp = lat ? outp + (size_t)row * 1024 : (const float*)(ws + WS_LATC) + (size_t)(row - NLAT) * 1024; float ss = 0.f;
        for (int c = lane; c < 1024; c += 64) ss += latp[c] * latp[c];
        const float rs = rsqrtf(wave_sum(ss) / 1024.f + EPS); const float* mod = (const float*)(ws + WS_MOD) + ((size_t)l_mod * 5 + mr) * 6144 + shift_chunk * 1024;
        const int c = hash(s, 77) % 1024; const float ref = latp[c] * rs * g_pre[c] * (1.f + mod[1024 + c]) + mod[c];
        add(ws, k, bf2f(((const bf16*)(ws + P_H))[(size_t)row * 1024 + c]), ref, lane); }
}
template <class F> __device__ __forceinline__ void chk_gemm(unsigned char* ws, int k, const bf16* A, int lda, const float* W, int N, int K, int nrows, int ncols, F fin, int gw, int ngw, int lane) {
    for (int s = gw; s < 1024; s += ngw) { const unsigned hh = hash(s, 20 + k); const int row = hh % nrows, col = (hh >> 16) % ncols;
        const float ref = dot_aw(A + (size_t)row * lda, W + col, N, K, lane); float got, rr; fin(row, col, ref, got, rr); add(ws, k, got, rr, lane); }
}
__device__ __forceinline__ void chk_tok(unsigned char* ws, int k, int l, int gw, int ngw, int lane) {
    const float* par = (const float*)(ws + WS_PAR);
    for (int s = gw; s < 1024; s += ngw) { const unsigned hh = hash(s, 40 + k); const int row = hh % MALL; const bool lat = row < NLAT; const int t = row & 4095; const bf16* z = (const bf16*)(ws + P_Z) + (size_t)row * ZW;
        const int which = (hh >> 20) % 6; float got = 0.f, ref = 0.f;
        if (which == 0 || which == 1) { const int nh = which == 0 ? 8 : 2, hd = (hh >> 24) % nh, d = (hh >> 14) & 63; const bf16* x = z + (which == 0 ? 0 : ZC_KG) + hd * 64; const float* g = par + (which == 0 ? PR_GQ : PR_GK) + l * 64;
            float ss = 0.f; for (int i = 0; i < 64; ++i) ss += bf2f(x[i]) * bf2f(x[i]); const float rs = rsqrtf(ss / 64.f + EPS);
            const int i = d & 31; const float x1 = bf2f(x[i]) * rs * g[i], x2 = bf2f(x[i + 32]) * rs * g[i + 32]; float o = d < 32 ? x1 : x2;
            if (lat) { const float an = angA(t, i), c = cosf(an), sn = sinf(an); o = d < 32 ? x1 * c - x2 * sn : x1 * sn + x2 * c; }
            if (which == 0) { o *= 0.125f * LOG2E; got = bf2f(((const bf16*)(ws + P_QA))[(size_t)row * 512 + hd * 64 + d]); } else got = bf2f(((const bf16*)(ws + P_KA))[(size_t)row * 128 + hd * 64 + d]);
            ref = o; }
        else if (which == 2) { const int i = (hh >> 8) % 384; float ss = 0.f; for (int j = 0; j < 384; ++j) ss += bf2f(z[ZC_CQ + j]) * bf2f(z[ZC_CQ + j]);
            ref = bf2f(z[ZC_CQ + i]) * rsqrtf(ss / 384.f + EPS) * par[PR_GCQ + l * 384 + i]; got = bf2f(((const bf16*)(ws + P_CQN))[(size_t)row * 384 + i]); }
        else if (which == 3) { const int i = (hh >> 8) % 256; float ss = 0.f; for (int j = 0; j < 256; ++j) ss += bf2f(z[ZC_CKV + j]) * bf2f(z[ZC_CKV + j]);
            ref = bf2f(z[ZC_CKV + i]) * rsqrtf(ss / 256.f + EPS) * par[PR_GCKV + l * 256 + i]; got = bf2f(((const bf16*)(ws + P_CKVN))[(size_t)row * 256 + i]); }
        else if (which == 4) { const int d = (hh >> 8) & 31, i = d & 15; const float x1 = bf2f(z[ZC_KR + i]), x2 = bf2f(z[ZC_KR + 16 + i]); float o = d < 16 ? x1 : x2;
            if (lat) { const float an = angB(t, i), c = cosf(an), sn = sinf(an); o = d < 16 ? x1 * c - x2 * sn : x1 * sn + x2 * c; } ref = o; got = bf2f(((const bf16*)(ws + P_KRR))[(size_t)row * 32 + d]); }
        else { const int c = (hh >> 8) & 511, b = lat ? row >> 12 : (row - NLAT) >> 8, pos = lat ? 256 + t : (row - NLAT) & 255; const int wv = (hh >> 19) & 1;
            if (wv) { ref = bf2f(z[ZC_U + c]); got = bf2f(((const bf16*)(ws + P_UG))[((size_t)(b * 32 + (c >> 4)) * LPOS + pos) * 16 + (c & 15)]); }
            else { ref = bf2f(z[ZC_VG + (c & 127)]); got = bf2f(((const bf16*)(ws + P_VA))[(size_t)row * 128 + (c & 127)]); } }
        add(ws, k, got, ref, lane); }
}
__device__ __forceinline__ void chk_attn(unsigned char* ws, int k, bool lastl, int gw, int ngw, int lane) {
    for (int s = gw; s < 256; s += ngw) { const unsigned hh = hash(s, 60 + k); const int typ = hh & 1, b = (hh >> 1) & 3, h = (hh >> 3) & 7, d = (hh >> 6) & 63; const bool cq = !lastl && ((hh >> 12) & 7) == 0;
        const int qrow = cq ? NLAT + b * 256 + ((hh >> 16) & 255) : b * 4096 + ((hh >> 16) & 4095); const int nk = cq ? 256 : LPOS, DKK = typ ? 96 : 64;
        const bf16* q = typ ? (const bf16*)(ws + P_QB) + (size_t)qrow * 768 + h * 96 : (const bf16*)(ws + P_QA) + (size_t)qrow * 512 + h * 64;
        float m = -1e30f, l = 0.f, o = 0.f;
        for (int p = lane; p < nk; p += 64) { const int kr = pos_row(b, p); float sc = 0.f;
            if (typ) { const bf16* kk = (const bf16*)(ws + P_KB) + (size_t)kr * 512 + h * 64; const bf16* k2 = (const bf16*)(ws + P_KRR) + (size_t)kr * 32;
                for (int i = 0; i < 64; ++i) sc += bf2f(q[i]) * bf2f(kk[i]); for (int i = 0; i < 32; ++i) sc += bf2f(q[64 + i]) * bf2f(k2[i]); }
            else { const bf16* kk = (const bf16*)(ws + P_KA) + (size_t)kr * 128 + (h >> 2) * 64; for (int i = 0; i < 64; ++i) sc += bf2f(q[i]) * bf2f(kk[i]); }
            const float v = typ ? bf2f(((const bf16*)(ws + P_VB))[(size_t)kr * 512 + h * 64 + d]) : bf2f(((const bf16*)(ws + P_VA))[(size_t)kr * 128 + (h >> 2) * 64 + d]);
            const float mn = fmaxf(m, sc), al = exp2f(m - mn), pp = exp2f(sc - mn); l = l * al + pp; o = o * al + pp * v; m = mn; (void)DKK; }
        float mg = m; for (int x = 1; x < 64; x <<= 1) mg = fmaxf(mg, __shfl_xor(mg, x));
        const float f = exp2f(m - mg); l = wave_sum(l * f); o = wave_sum(o * f);
        add(ws, k, bf2f(((const bf16*)(ws + P_YBR))[(size_t)qrow * 1536 + typ * 512 + h * 64 + d]), o / l, lane); }
}
__device__ __forceinline__ void chk_s5(unsigned char* ws, const float* const* in, int k, int l, bool lastl, int gw, int ngw, int lane) {
    for (int s = gw; s < 512; s += ngw) { const unsigned hh = hash(s, 80 + k); const int b = hh & 3, g = (hh >> 2) & 31, hp = (hh >> 7) & 15; int psel = (hh >> 12) % LPOS; if (lastl && psel < 256) psel += 256;
        const bf16* U = (const bf16*)(ws + P_UG) + (size_t)(b * 32 + g) * LPOS * 16; float yf[2], yl[2];
        for (int dir = 0; dir < 2; ++dir) { const int pi = ((l * 2 + dir) * 32 + g) * 64 + lane;
            const float lr = fminf(in[17][pi], -1e-4f), li = in[18][pi], dt = expf(in[19][(l * 2 + dir) * 32 + g]); const float mag = expf(lr * dt), abr = mag * cosf(li * dt), abi = mag * sinf(li * dt), den = lr * lr + li * li;
            const float fr = ((abr - 1.f) * lr + abi * li) / den, fi = (abi * lr - (abr - 1.f) * li) / den; float bbr[16], bbi[16];
            _Pragma("unroll") for (int h = 0; h < 16; ++h) { const float br = in[20][(size_t)pi * 16 + h], bi = in[21][(size_t)pi * 16 + h]; bbr[h] = fr * br - fi * bi; bbi[h] = fr * bi + fi * br; }
            float xr = 0.f, xi = 0.f, zr = 0.f, zi = 0.f;
            for (int st = 0; st < LPOS; ++st) { const int p = dir == 0 ? st : (st < 256 ? 255 - st : LPOS + 255 - st); float vr = 0.f, vi = 0.f;
                _Pragma("unroll") for (int h = 0; h < 16; ++h) { const float u = bf2f(U[(size_t)p * 16 + h]); vr += bbr[h] * u; vi += bbi[h] * u; }
                if ((dir == 0 && (p & 15) == 0) || (dir == 1 && (p & 15) == 15)) { zr = 0.f; zi = 0.f; }
                const float nr = abr * xr - abi * xi + vr, ni = abr * xi + abi * xr + vi; xr = nr; xi = ni;
                const float mr = abr * zr - abi * zi + vr, mi = abr * zi + abi * zr + vi; zr = mr; zi = mi;
                if (p == psel) break; }
            const size_t ci = ((size_t)((l * 2 + dir) * 32 + g) * 16 + hp) * 64 + lane; yf[dir] = wave_sum(in[22][ci] * xr - in[23][ci] * xi); yl[dir] = wave_sum(in[22][ci] * zr - in[23][ci] * zi); }
        const float du = in[24][(l * 32 + g) * 16 + hp] * bf2f(U[(size_t)psel * 16 + hp]); const float got = bf2f(((const bf16*)(ws + P_AGLU))[(size_t)pos_row(b, psel) * 512 + g * 16 + hp]);
        auto ge = [](float y) { const float u2 = 0.7978845608028654f * (y + 0.044715f * y * y * y); return 0.5f * y * (1.f + tanhf(u2)); };
        add(ws, k, got, ge(du + yf[0] + yf[1]), lane);
        if (l == 0) { add(ws, 30, got, ge(du + yf[0] + yl[1]), lane); add(ws, 31, got, ge(du + yl[0] + yf[1]), lane); add(ws, 32, got, ge(du + yl[0] + yl[1]), lane); add(ws, 33, got, ge(du), lane); } }
}
__device__ __forceinline__ void chk_s5m(unsigned char* ws, const float* const* in, int k, int gw, int ngw, int lane) {
    for (int s = gw; s < 2048; s += ngw) { const unsigned hh = hash(s, 700), h2 = hash(s, 701); const int l = hh & 1, g = (hh >> 1) & 31, which = (hh >> 6) % 5;
        const bf16* M = (const bf16*)(ws + WS_S5M) + (size_t)(l * 32 + g) * 196608; float got = 0.f, ref = 0.f;
        const int t = (h2 >> 0) & 15, hp = (h2 >> 4) & 15, sx = (h2 >> 8) & 15, h = (h2 >> 12) & 15, p2 = (h2 >> 16) & 63, im = (h2 >> 22) & 1, dsel = (h2 >> 23) & 1;
        float cre[2], cim[2], are[2], aim[2], bre[2], bim[2], lrr[2], lii[2], dtt[2];
        _Pragma("unroll") for (int dir = 0; dir < 2; ++dir) { const int pi = ((l * 2 + dir) * 32 + g) * 64 + lane; lrr[dir] = fminf(in[17][pi], -1e-4f); lii[dir] = in[18][pi]; dtt[dir] = expf(in[19][(l * 2 + dir) * 32 + g]);
            const float mag = expf(lrr[dir] * dtt[dir]); are[dir] = mag * cosf(lii[dir] * dtt[dir]); aim[dir] = mag * sinf(lii[dir] * dtt[dir]);
            const float den = lrr[dir] * lrr[dir] + lii[dir] * lii[dir], fr = ((are[dir] - 1.f) * lrr[dir] + aim[dir] * lii[dir]) / den, fi = (aim[dir] * lrr[dir] - (are[dir] - 1.f) * lii[dir]) / den;
            const float br = in[20][(size_t)pi * 16 + h], bi = in[21][(size_t)pi * 16 + h]; bre[dir] = fr * br - fi * bi; bim[dir] = fr * bi + fi * br;
            const size_t ci = ((size_t)((l * 2 + dir) * 32 + g) * 16 + hp) * 64 + lane; cre[dir] = in[22][ci]; cim[dir] = in[23][ci]; }
        if (which == 0) {
            float acc = 0.f;
            _Pragma("unroll") for (int dir = 0; dir < 2; ++dir) { const int j = dir == 0 ? t - sx : sx - t; if (j >= 0) { float pr = 1.f, pq = 0.f; for (int e = 0; e < j; ++e) { const float nr = pr * are[dir] - pq * aim[dir], nq = pr * aim[dir] + pq * are[dir]; pr = nr; pq = nq; }
                    const float tr = cre[dir] * pr - cim[dir] * pq, tq = cre[dir] * pq + cim[dir] * pr; acc += tr * bre[dir] - tq * bim[dir]; } }
            ref = wave_sum(acc) + ((t == sx && h == hp) ? in[24][(l * 32 + g) * 16 + h] : 0.f); got = bf2f(M[(size_t)(16 * t + hp) * 256 + 16 * sx + h]); }
        else if (which <= 2) {
            const int dir = which - 1, ex = dir == 0 ? t + 1 : 16 - t; float pr = 1.f, pq = 0.f; for (int e = 0; e < ex; ++e) { const float nr = pr * are[dir] - pq * aim[dir], nq = pr * aim[dir] + pq * are[dir]; pr = nr; pq = nq; }
            const float tr = cre[dir] * pr - cim[dir] * pq, tq = cre[dir] * pq + cim[dir] * pr; const float mine = im ? -tq : tr; ref = __shfl(mine, p2); got = bf2f(M[(dir == 0 ? 65536 : 98304) + (size_t)(16 * t + hp) * 128 + 2 * p2 + im]); }
        else {
            const int dir = which - 3, ex = dir == 0 ? 15 - sx : sx; float pr = 1.f, pq = 0.f; for (int e = 0; e < ex; ++e) { const float nr = pr * are[dir] - pq * aim[dir], nq = pr * aim[dir] + pq * are[dir]; pr = nr; pq = nq; }
            const float tr = pr * bre[dir] - pq * bim[dir], tq = pr * bim[dir] + pq * bre[dir]; const float mine = im ? tq : tr; ref = __shfl(mine, p2); got = bf2f(M[(dir == 0 ? 131072 : 163840) + (size_t)(2 * p2 + im) * 256 + 16 * sx + h]); }
        (void)dsel; add(ws, which == 0 ? ((t == sx && h == hp) ? k : 35) : which <= 2 ? 36 : 37, got, ref, lane); }
}

__device__ __forceinline__ void chk_s5x(unsigned char* ws, const float* const* in, int gw, int ngw, int lane) {
    const int l = 0, b = 0;
    for (int s = gw; s < 512; s += ngw) { const unsigned hh = hash(s, 900); const int g = hh & 15, dir = (hh >> 5) & 1, c = (hh >> 8) % 272, im = (hh >> 20) & 1, psel = (hh >> 24) & 63;
        const bf16* U = (const bf16*)(ws + P_UG) + (size_t)(b * 32 + g) * LPOS * 16; const int pi = ((l * 2 + dir) * 32 + g) * 64 + lane;
        const float lr = fminf(in[17][pi], -1e-4f), li = in[18][pi], dt = expf(in[19][(l * 2 + dir) * 32 + g]); const float mag = expf(lr * dt), abr = mag * cosf(li * dt), abi = mag * sinf(li * dt), den = lr * lr + li * li;
        const float fr = ((abr - 1.f) * lr + abi * li) / den, fi = (abi * lr - (abr - 1.f) * li) / den; float bbr[16], bbi[16];
        _Pragma("unroll") for (int h = 0; h < 16; ++h) { const float br = in[20][(size_t)pi * 16 + h], bi = in[21][(size_t)pi * 16 + h]; bbr[h] = fr * br - fi * bi; bbi[h] = fr * bi + fi * br; }
        float xr = 0.f, xi = 0.f;
        for (int st = 0; st < LPOS; ++st) { const int p = dir == 0 ? st : (st < 256 ? 255 - st : LPOS + 255 - st);
            if ((p >> 4) == c) break;
            float vr = 0.f, vi = 0.f;
            _Pragma("unroll") for (int h = 0; h < 16; ++h) { const float u = bf2f(U[(size_t)p * 16 + h]); vr += bbr[h] * u; vi += bbi[h] * u; }
            const float nr = abr * xr - abi * xi + vr, ni = abr * xi + abi * xr + vi; xr = nr; xi = ni; }
        const float mine = im ? xi : xr; const float ref = __shfl(mine, psel);
        {
          float er = 0.f, ei = 0.f;
          for (int q = 0; q < 16; ++q) { const int sx = dir == 0 ? q : 15 - q, p = 16 * c + sx; float vr = 0.f, vi = 0.f;
              _Pragma("unroll") for (int h = 0; h < 16; ++h) { const float u = bf2f(U[(size_t)p * 16 + h]); vr += bbr[h] * u; vi += bbi[h] * u; }
              const float nr = abr * er - abi * ei + vr, ni = abr * ei + abi * er + vi; er = nr; ei = ni; }
          const float m2 = im ? ei : er; const float r2 = __shfl(m2, psel);
          const bf16* E = (const bf16*)(ws + WS_POOL + 98 * MiB) + (size_t)g * 69632 + (size_t)dir * 34816;
          add(ws, 39, bf2f(E[c * 128 + 2 * psel + im]), r2, lane); }
        const bf16* X = (const bf16*)(ws + WS_POOL + 94 * MiB) + (size_t)g * 69632 + (size_t)dir * 34816;
        add(ws, 38, bf2f(X[c * 128 + 2 * psel + im]), ref, lane); }
}
__device__ __forceinline__ void encode(unsigned char* ws, const float* x, float* outp, int nchk, int gt, int ngt) {
    const float* d = (const float*)(ws + WS_CTL) + CW_DBG; int bad = -1; float eb = 0.f;
#ifdef DBG_REPORT
    { const int k = DBG_REPORT; const float e = sqrtf(d[2 * k] / fmaxf(d[2 * k + 1], 1e-30f)); const float F = 1.f + 1e14f * fminf(e * e, 1e4f) + 1e3f;
      for (size_t i = gt; i < (size_t)NLAT * 1024; i += ngt) outp[i] = x[i] * F; return; }
#endif
    for (int k = 0; k < 30; ++k) { const float e = sqrtf(d[2 * k] / fmaxf(d[2 * k + 1], 1e-30f)); const bool unused = d[2 * k + 1] == 0.f && d[2 * k] == 0.f; if (!unused && !(e < 0.02f)) { bad = k; eb = e; break; } }
    if (bad < 0) return;
    float F = 1.f; for (int i = 0; i <= bad; ++i) F *= 4.f; F = 1.f + F * (1.f + fminf(eb, 0.99f));
    for (size_t i = gt; i < (size_t)NLAT * 1024; i += ngt) outp[i] = x[i] * F;
}
}
struct Args;
#endif

struct Args { const float* in[38]; float* out; unsigned char* ws; int ph_lo, ph_hi; };
constexpr int PH_PRO = 0, PH_R0 = 1, PH_L0 = 2, PH_PER_L = 16, NPH = PH_L0 + 2 * PH_PER_L;


#if MK_DEBUG
constexpr int DBG_NCHK = 40;
__global__ void __launch_bounds__(NTHREADS, 2) dbg_fwd(Args args, int ph) {
    unsigned char* ws = args.ws; float* outp = args.out; const float* const* in = args.in;
    const int tid = threadIdx.x, lane = tid & 63, wave = tid >> 6, gw = blockIdx.x * NWAVES + wave, ngw = gridDim.x * NWAVES;
    const float* par = (const float*)(ws + WS_PAR);
    if (ph == 1000) { dbg::encode(ws, in[0], outp, DBG_NCHK, blockIdx.x * NTHREADS + tid, gridDim.x * NTHREADS); return; }
    if (ph == PH_PRO) { dbg::chk_mod(ws, in, gw, ngw, lane); dbg::chk_weights(ws, in, gw, ngw, lane); dbg::chk_s5m(ws, in, 16, gw, ngw, lane); return; }
    if (ph == PH_R0) { dbg::chk_h(ws, in, outp, 2, 0, 0, par + PR_GMIXPRE, MALL, gw, ngw, lane); return; }
    const int l = (ph - PH_L0) / PH_PER_L, rel = (ph - PH_L0) % PH_PER_L, kb = 3 + 14 * l; const bool lastl = l == 1; const int nrq = lastl ? NLAT : MALL;
    if (rel == 0) { const bf16* Z = (const bf16*)(ws + P_Z);
        dbg::chk_gemm(ws, kb + 0, (const bf16*)(ws + P_H), 1024, in[10] + (size_t)l * 1024 * NIN, NIN, 1024, MALL, NIN, [=](int row, int col, float ref, float& got, float& rr) {
            const int j = col, dr = j < 512 ? j : j < 896 ? 768 + (j - 512) : j < 1024 ? 512 + (j - 896) : j < 1152 ? 640 + (j - 1024) : j < 1440 ? j : 1536 + (j - 1440); got = bf2f(Z[(size_t)row * ZW + dr]); rr = ref; }, gw, ngw, lane); }
    if (rel == 1) dbg::chk_tok(ws, kb + 1, l, gw, ngw, lane);
    if (rel == 2) {
        const bf16* QB = (const bf16*)(ws + P_QB); const bf16* CQ = (const bf16*)(ws + P_CQN); const float* Wq = in[15] + (size_t)l * 384 * 768; const float scale = 0.10206207261596575f * LOG2E;
        dbg::chk_gemm(ws, kb + 2, CQ, 384, Wq, 768, 384, nrq, 768, [=](int row, int col, float ref, float& got, float& rr) {
            const int hd = col / 96, e = col % 96; float v = ref;
            if (e >= 64 && row < NLAT) { const int i = (e - 64) & 15; const float x1 = dbg::dot_aw(CQ + (size_t)row * 384, Wq + hd * 96 + 64 + i, 768, 384, lane), x2 = dbg::dot_aw(CQ + (size_t)row * 384, Wq + hd * 96 + 80 + i, 768, 384, lane);
                const float an = dbg::angB(row & 4095, i), c = cosf(an), sn = sinf(an); v = e < 80 ? x1 * c - x2 * sn : x1 * sn + x2 * c; }
            got = bf2f(QB[(size_t)row * 768 + col]); rr = v * scale; }, gw, ngw, lane);
        const bf16* KB = (const bf16*)(ws + P_KB); const bf16* VB = (const bf16*)(ws + P_VB);
        dbg::chk_gemm(ws, kb + 3, (const bf16*)(ws + P_CKVN), 256, in[16] + (size_t)l * 256 * 1024, 1024, 256, MALL, 1024, [=](int row, int col, float ref, float& got, float& rr) {
            const int hd = col / 128, e = col % 128; got = e < 64 ? bf2f(KB[(size_t)row * 512 + hd * 64 + e]) : bf2f(VB[(size_t)row * 512 + hd * 64 + e - 64]); rr = ref; }, gw, ngw, lane); }
    if (rel == 3) { dbg::chk_attn(ws, kb + 4, lastl, gw, ngw, lane); dbg::chk_s5(ws, in, kb + 5, l, lastl, gw, ngw, lane); if (l == 0) dbg::chk_s5x(ws, in, gw, ngw, lane); }
    if (rel == 4) { const bf16* AG = (const bf16*)(ws + P_AGLU); const bf16* YB = (const bf16*)(ws + P_YBR); const float* Wg = in[25] + (size_t)l * 512 * 1024;
        dbg::chk_gemm(ws, kb + 6, AG, 512, Wg, 1024, 512, nrq, 512, [=](int row, int col, float ref, float& got, float& rr) {
            const float g = dbg::dot_aw(AG + (size_t)row * 512, Wg + 512 + col, 1024, 512, lane); got = bf2f(YB[(size_t)row * 1536 + 1024 + col]); rr = ref / (1.f + expf(-g)); }, gw, ngw, lane); }
    if (rel == 5) { const bf16* H = (const bf16*)(ws + P_H); const bf16* YB = (const bf16*)(ws + P_YBR); const bf16* MG = (const bf16*)(ws + P_MRG);
        const float* Wm = in[27] + (size_t)l * 1024 * 3072; const float* Wb = in[26] + (size_t)l * 3 * 512 * 1024; const float* bm = in[28] + l * 3072;
        for (int s = gw; s < 512; s += ngw) { const unsigned hh = dbg::hash(s, 333 + l); const int row = hh % nrq, col = (hh >> 16) % 1024; float acc = 0.f;
            for (int n = 0; n < 3; ++n) { const float g = dbg::dot_aw(H + (size_t)row * 1024, Wm + n * 1024 + col, 3072, 1024, lane) + bm[n * 1024 + col];
                const float p = dbg::dot_aw(YB + (size_t)row * 1536 + n * 512, Wb + (size_t)n * 512 * 1024 + col, 1024, 512, lane); acc += p / (1.f + expf(-g)); }
            dbg::add(ws, kb + 7, bf2f(MG[(size_t)row * 1024 + col]), acc, lane); } }
    if (rel == 6) { const float* Y = (const float*)(ws + P_Y);
        dbg::chk_gemm(ws, kb + 8, (const bf16*)(ws + P_MRG), 1024, in[29] + (size_t)l * 1024 * 1024, 1024, 1024, nrq, 1024, [=](int row, int col, float ref, float& got, float& rr) { got = Y[(size_t)row * 1024 + col]; rr = ref; }, gw, ngw, lane); }
    if (rel == 7) dbg::chk_h(ws, in, outp, kb + 9, l, 3, par + PR_GFFNPRE + l * 1024, nrq, gw, ngw, lane);
    if (!lastl) {
        if (rel == 8) { const bf16* H = (const bf16*)(ws + P_H); const bf16* ACT = (const bf16*)(ws + P_ACT);
            dbg::chk_gemm(ws, kb + 10, H, 1024, in[30], DFF, 1024, MALL, DFF, [=](int row, int col, float ref, float& got, float& rr) {
                const float b = dbg::dot_aw(H + (size_t)row * 1024, in[31] + col, DFF, 1024, lane); got = bf2f(ACT[(size_t)row * DFF + col]); rr = ref / (1.f + expf(-ref)) * b; }, gw, ngw, lane); }
        if (rel == 9) { const float* Y2 = (const float*)(ws + P_Y2);
            dbg::chk_gemm(ws, kb + 11, (const bf16*)(ws + P_ACT), DFF, in[32], 1024, DFF, MALL, 1024, [=](int row, int col, float ref, float& got, float& rr) { got = Y2[(size_t)row * 1024 + col]; rr = ref; }, gw, ngw, lane); }
        if (rel == 12) dbg::chk_h(ws, in, outp, kb + 12, 1, 0, par + PR_GMIXPRE + 1024, MALL, gw, ngw, lane);
    } else if (rel == 11) {
        const bf16* H = (const bf16*)(ws + P_H); const bf16* FO = (const bf16*)(ws + P_Y2); const unsigned* cnt = (const unsigned*)(ws + WS_CTL) + CW_CNT; const int* ti = (const int*)(ws + WS_LIST) + 8 * 16384;
        for (int s = gw; s < 64; s += ngw) { const unsigned hh = dbg::hash(s, 555); const int tok = hh % NLAT, kk = (hh >> 16) & 1, c = (hh >> 17) % 1024; const int e = ti[tok * 8 + 2 * kk], pos = ti[tok * 8 + 2 * kk + 1];
            int base = 0; for (int q = 0; q < e; ++q) base += ((int)cnt[q] + 255) >> 8;
            float acc = 0.f;
            for (int j = 0; j < DFF; ++j) { const float a = dbg::dot_aw(H + (size_t)tok * 1024, in[35] + (size_t)e * 1024 * DFF + j, DFF, 1024, lane), b = dbg::dot_aw(H + (size_t)tok * 1024, in[36] + (size_t)e * 1024 * DFF + j, DFF, 1024, lane);
                acc += dbg::rbf(a / (1.f + expf(-a)) * b) * dbg::rbf(in[37][((size_t)e * DFF + j) * 1024 + c]); }
            dbg::add(ws, kb + 10, bf2f(FO[((size_t)base * 256 + pos) * 1024 + c]), acc, lane); } }
}
#endif

#ifndef PHMASK
#define PHMASK 0xFFFFFFFFu
#endif
#define PHON(k) (((PHMASK) >> (k)) & 1u)
#ifndef REPMASK
#define REPMASK 0u
#endif
#define REPON(k) (((REPMASK) >> (k)) & 1u)

__device__ __forceinline__ ResidArgs Rd(ResidArgs R, int rep) { R.dry = rep > 0; return R; }
__global__ void __launch_bounds__(NTHREADS, 2) mk_fwd(Args args) {
    extern __shared__ __attribute__((aligned(16))) unsigned char lds_raw[];
    LAS unsigned char* lds = (LAS unsigned char*)lds_raw;
    const int wave = __builtin_amdgcn_readfirstlane((int)threadIdx.x >> 6);
#define tid (wave * 64 + lane_id())
    const int G = gridDim.x, bx = blockIdx.x; const int vcu = (G % 8 == 0) ? (bx % 8) * (G / 8) + bx / 8 : bx;
    unsigned char* ws0 = args.ws; float* outp = args.out;
    unsigned char* ws = ws0;
    volatile LAS unsigned* misc = (volatile LAS unsigned*)(lds + LDS_MISC);
    LAS int* tb; { unsigned tba_ = (unsigned)(uintptr_t)(lds + LDS_MISC + 64); asm volatile("" : "+s"(tba_)); tb = (LAS int*)(uintptr_t)tba_; }
    if (tid < 64) misc[tid] = 0u;
    __syncthreads();
    const int lo = args.ph_lo, hi = args.ph_hi;
    XcdBarrier bar; bar.bar = (unsigned*)(ws + WS_CTL) + CW_BAR; bar.x = 0; bar.st = misc; bar.wave = wave;
    if (hi - lo > 1) bar = xcd_barrier_post((unsigned*)(ws + WS_CTL) + CW_BAR, misc, wave);
#define IN(k) (lo <= (k) && (k) < hi)
#define SEAM(k) do { if ((k) + 1 < hi) xcd_barrier(bar); } while (0)
    const int gw = vcu * NWAVES + wave, ngw = G * NWAVES;

    if (PHON(0) && IN(PH_PRO)) for (int rep_ = 0; rep_ <= (int)REPON(0); ++rep_) {
            GAS unsigned char* wsq = (GAS unsigned char*)ws0; asm volatile("" : "+s"(wsq)); unsigned char* const ws = (unsigned char*)wsq; const float* const par = (const float*)(ws + WS_PAR); int lnq = lane_id(); asm volatile("" : "+v"(lnq)); const int lane = lnq; (void)par; (void)lane;
        Ptrs P;
        { const float* const* in = args.in;
          P.x = in[0]; P.c = in[1]; P.ctx = in[2]; P.c_ctx = in[3]; P.w_mod = in[4]; P.b_mod = in[5]; P.g_mix_pre = in[6]; P.g_mix_post = in[7]; P.g_ffn_pre = in[8]; P.g_ffn_post = in[9];
          P.w_in = in[10]; P.g_q = in[11]; P.g_k = in[12]; P.g_cq = in[13]; P.g_ckv = in[14]; P.w_uq = in[15]; P.w_ukv = in[16];
          P.s5p.lam_re = in[17]; P.s5p.lam_im = in[18]; P.s5p.log_dt = in[19]; P.s5p.b_re = in[20]; P.s5p.b_im = in[21]; P.s5p.c_re = in[22]; P.s5p.c_im = in[23]; P.s5p.dsk = in[24];
          P.w_glu = in[25]; P.w_branch = in[26]; P.w_mg = in[27]; P.b_mg = in[28]; P.w_out = in[29]; P.ffn_w1 = in[30]; P.ffn_w3 = in[31]; P.ffn_w2 = in[32];
          P.router_w = in[33]; P.router_b = in[34]; P.moe_w1 = in[35]; P.moe_w3 = in[36]; P.moe_w2 = in[37]; P.out = args.out; P.ws = args.ws; }
#ifndef PRO_ONLYT
#define PRO_ONLYT 0
#endif
        if (!(PRO_ONLYT && rep_ > 0)) {
        copy_params(P, bx * NTHREADS + tid, G * NTHREADS);
        for (int it = bx; it < 192 + 64; it += G) {
            if (it < 192) mod_item(P, it, lds, wave);
            else { const int q = it - 192, l = q >> 5, g = q & 31; s5::build_mats(P.s5p, l, g, (bf16*)(ws + WS_S5M) + (size_t)(l * 32 + g) * s5::M_TOTAL, lds, wave); }
        }
        rope_tables(P, bx * NTHREADS + tid, G * NTHREADS);
        }
        __syncthreads();
        transposes(P, gw, ngw, (LAS float*)(lds + wave * 16384), lane, rep_);
        SEAM(PH_PRO);
    }
    if (PHON(1) && IN(PH_R0)) for (int rep_ = 0; rep_ <= (int)REPON(1); ++rep_) {
            GAS unsigned char* wsq = (GAS unsigned char*)ws0; asm volatile("" : "+s"(wsq)); unsigned char* const ws = (unsigned char*)wsq; const float* const par = (const float*)(ws + WS_PAR); int lnq = lane_id(); asm volatile("" : "+v"(lnq)); const int lane = lnq; (void)par; (void)lane;
        ResidArgs R{}; R.mode = 0; R.g_pre = par + PR_GMIXPRE; R.shift_chunk = 0; R.hout = (bf16*)(ws + P_H); R.l_mod = 0; R.route = false; R.hout8 = ws + P_H8;
        const float* xin = args.in[0]; const float* ctxin = args.in[2];
        { int row = gw; for (; row + ngw < MALL; row += 2 * ngw) { resid_row(ws, outp, xin, ctxin, Rd(R, rep_), row, lane, tb); resid_row(ws, outp, xin, ctxin, Rd(R, rep_), row + ngw, lane, tb); } if (row < MALL) resid_row(ws, outp, xin, ctxin, Rd(R, rep_), row, lane, tb); }
        SEAM(PH_R0);
    }
#define MOE_TAIL(lo_pm, hi_pm) do { if (l == 0 && bx >= 16) { const int lane_ = lane_id(); \
            moe_transposes(args.in[35], args.in[36], args.in[37], ws, (int)((long)MOE_ITEMS * (lo_pm) / 1000), (int)((long)MOE_ITEMS * (hi_pm) / 1000), (bx - 16) * NWAVES + wave, (G - 16) * NWAVES, (LAS float*)(lds + wave * 16384), lane_); } } while (0)
    for (int l = 0; l < 2; ++l) {
        const int pb = PH_L0 + l * PH_PER_L; const bool lastl = (l == 1);
        const int nMall = 68, nMq = lastl ? 64 : 68;
        if (PHON(2) && IN(pb + 0)) for (int rep_ = 0; rep_ <= (int)REPON(2); ++rep_) {
            GAS unsigned char* wsq = (GAS unsigned char*)ws0; asm volatile("" : "+s"(wsq)); unsigned char* const ws = (unsigned char*)wsq; const float* const par = (const float*)(ws + WS_PAR); int lnq = lane_id(); asm volatile("" : "+v"(lnq)); const int lane = lnq; (void)par; (void)lane;
            if (F8_G1L1 && lastl) {
                pg8::SchedPlain S{(const char*)(ws + P_H8), (const char*)(ws + WS_W1T) + (size_t)l * ZW * 2048, 1024u, 1024u, 8, nMall, 8, G, bx};
                pg8::EpiBf16S E{(bf16*)(ws + P_Z), ZW, 1.0f / (F8_HSCALE * F8_WSCALE)};
                pg8::gemm_phase<pg8::EpiBf16S, pg8::SchedPlain, false, true>(lds, S, E, wave);
            } else {
            pg8::SchedPlain S{(const char*)(ws + P_H), (const char*)(ws + WS_W1T) + (size_t)l * ZW * 2048, 2048u, 2048u, 16, nMall, 8, G, bx};
            pg8::EpiBf16 E{(bf16*)(ws + P_Z), ZW, 0};
            pg8::gemm_phase<pg8::EpiBf16, pg8::SchedPlain, false>(lds, S, E, wave); }
            SEAM(pb + 0);
        }
        if (PHON(3) && IN(pb + 1)) for (int rep_ = 0; rep_ <= (int)REPON(3); ++rep_) {
            GAS unsigned char* wsq = (GAS unsigned char*)ws0; asm volatile("" : "+s"(wsq)); unsigned char* const ws = (unsigned char*)wsq; const float* const par = (const float*)(ws + WS_PAR); int lnq = lane_id(); asm volatile("" : "+v"(lnq)); const int lane = lnq; (void)par; (void)lane;
            { int row = gw; for (; row + ngw < MALL; row += 2 * ngw) { token_row(ws, l, row, lane); token_row(ws, l, row + ngw, lane); } if (row < MALL) token_row(ws, l, row, lane); }
            SEAM(pb + 1);
        }
        if (PHON(4) && IN(pb + 2)) for (int rep_ = 0; rep_ <= (int)REPON(4); ++rep_) {
            GAS unsigned char* wsq = (GAS unsigned char*)ws0; asm volatile("" : "+s"(wsq)); unsigned char* const ws = (unsigned char*)wsq; const float* const par = (const float*)(ws + WS_PAR); int lnq = lane_id(); asm volatile("" : "+v"(lnq)); const int lane = lnq; (void)par; (void)lane;
            { pg8::SchedPlain S{(const char*)(ws + P_CQN), (const char*)(ws + WS_WUQT) + (size_t)l * 768 * 768, 768u, 768u, 6, nMq, 3, G, bx};
              pg8::EpiUq E{(bf16*)(ws + P_QB), (const float*)(ws + WS_ROPE) + 2 * 4096 * 32, (const float*)(ws + WS_ROPE) + 2 * 4096 * 32 + 4096 * 16, 0.10206207261596575f * LOG2E};
              pg8::gemm_phase<pg8::EpiUq, pg8::SchedPlain, false>(lds, S, E, wave); }
            { pg8::SchedPlain S{(const char*)(ws + P_CKVN), (const char*)(ws + WS_WUKVT) + (size_t)l * 1024 * 512, 512u, 512u, 4, nMall, 4, G, bx};
              pg8::EpiUkv E{(bf16*)(ws + P_KB), (bf16*)(ws + P_VB)};
              pg8::gemm_phase<pg8::EpiUkv, pg8::SchedPlain, false>(lds, S, E, wave); }
            SEAM(pb + 2);
        }
        if (PHON(5) && IN(pb + 3)) for (int rep_ = 0; rep_ <= (int)REPON(5); ++rep_) {
            GAS unsigned char* wsq = (GAS unsigned char*)ws0; asm volatile("" : "+s"(wsq)); unsigned char* const ws = (unsigned char*)wsq; const float* const par = (const float*)(ws + WS_PAR); int lnq = lane_id(); asm volatile("" : "+v"(lnq)); const int lane = lnq; (void)par; (void)lane;
            const int nlatu = 1024, nctxu = lastl ? 0 : 64;
            for (int it = vcu; it < nlatu + nctxu; it += G) {
                att::AttnArgs A; int typ, b, h;
                if (it < nlatu) { const int u = it >> 1; typ = (it ^ (it >> 8)) & 1;
                    b = u >> 7; h = (u >> 4) & 7; const int qb = u & 15; A.qrow0 = (long)b * SEQ + qb * 256; A.ntiles = 68; }
                else { const int u = it - nlatu; typ = u & 1; b = (u >> 1) >> 3; h = (u >> 1) & 7; A.qrow0 = NLAT + (long)b * CTXL; A.ntiles = 4; }
                A.b = b; A.O = (bf16*)(ws + P_YBR); A.opitch = 1536;
                if (typ == 0) { A.Q = (const bf16*)(ws + P_QA); A.qpitch = 512; A.qcol = h * 64; A.K1 = (const bf16*)(ws + P_KA); A.k1pitch = 128; A.k1col = (h >> 2) * 64; A.K2 = nullptr; A.k2pitch = 0;
                    A.V = (const bf16*)(ws + P_VA); A.vpitch = 128; A.vcol = (h >> 2) * 64; A.ocol = h * 64; att::attn_unit4<64>(A, lds, wave); }
                else { A.Q = (const bf16*)(ws + P_QB); A.qpitch = 768; A.qcol = h * 96; A.K1 = (const bf16*)(ws + P_KB); A.k1pitch = 512; A.k1col = h * 64; A.K2 = (const bf16*)(ws + P_KRR); A.k2pitch = 32;
                    A.V = (const bf16*)(ws + P_VB); A.vpitch = 512; A.vcol = h * 64; A.ocol = 512 + h * 64; att::attn_unit4<96>(A, lds, wave); }
            }
            __syncthreads();
#ifndef S5REP
#define S5REP 1
#endif
            for (int s5r_ = 0; s5r_ < S5REP; ++s5r_)
            for (int it = G - 1 - vcu; it < 256; it += G) { const int b = it >> 6, g = (it >> 1) & 31, half = it & 1;
                s5::unit(par + PR_A16, l, b, g, (const bf16*)(ws + P_UG), (const bf16*)(ws + WS_S5M) + (size_t)(l * 32 + g) * s5::M_TOTAL, (bf16*)(ws + P_AGLU), lastl, lds, wave, half); }
            SEAM(pb + 3);
        }
        if (PHON(6) && IN(pb + 4)) for (int rep_ = 0; rep_ <= (int)REPON(6); ++rep_) {
            GAS unsigned char* wsq = (GAS unsigned char*)ws0; asm volatile("" : "+s"(wsq)); unsigned char* const ws = (unsigned char*)wsq; const float* const par = (const float*)(ws + WS_PAR); int lnq = lane_id(); asm volatile("" : "+v"(lnq)); const int lane = lnq; (void)par; (void)lane;
            pg8::SchedPlain S{(const char*)(ws + P_AGLU), (const char*)(ws + WS_WGLUT) + (size_t)l * 1024 * 1024, 1024u, 1024u, 8, nMq, 4, G, bx};
            pg8::EpiPair<0> E{(bf16*)(ws + P_YBR), 1536, 1024, 0};
            pg8::gemm_phase<pg8::EpiPair<0>, pg8::SchedPlain, false>(lds, S, E, wave);
            SEAM(pb + 4);
        }
        if (PHON(7) && IN(pb + 5)) for (int rep_ = 0; rep_ <= (int)REPON(7); ++rep_) {
            GAS unsigned char* wsq = (GAS unsigned char*)ws0; asm volatile("" : "+s"(wsq)); unsigned char* const ws = (unsigned char*)wsq; const float* const par = (const float*)(ws + WS_PAR); int lnq = lane_id(); asm volatile("" : "+v"(lnq)); const int lane = lnq; (void)par; (void)lane;
#define MRG_ROUND(r) do { \
                { pg8::SchedMergeG S{(const char*)(ws + P_H8), (const char*)(ws + WS_WMGT) + (size_t)l * 3072 * 1024, 1024u, 1024u, 8, nMq, (r) * G + bx}; \
                  pg8::EpiGate E{par + PR_BMG + l * 3072, (u32x4*)(ws + P_GSCR + (size_t)bx * 3 * 131072), 1.0f / (F8_HSCALE * F8_WSCALE)}; \
                  pg8::gemm_phase<pg8::EpiGate, pg8::SchedMergeG, false, true>(lds, S, E, wave); } \
                { pg8::SchedMergeP S{(const char*)(ws + P_YBR), (const char*)(ws + WS_WBT) + (size_t)l * 3 * 1024 * 1024, 3072u, 1024u, 8, nMq, (r) * G + bx}; \
                  pg8::EpiMergeP E{(bf16*)(ws + P_MRG), (const u32x4*)(ws + P_GSCR + (size_t)bx * 3 * 131072)}; \
                  pg8::gemm_phase<pg8::EpiMergeP, pg8::SchedMergeP, false, false>(lds, S, E, wave); } } while (0)
            MRG_ROUND(0);
            if (G < nMq * 4) MRG_ROUND(1);
#undef MRG_ROUND
            MOE_TAIL(0, 480);
            SEAM(pb + 5);
        }
        if (PHON(8) && IN(pb + 6)) for (int rep_ = 0; rep_ <= (int)REPON(8); ++rep_) {
            GAS unsigned char* wsq = (GAS unsigned char*)ws0; asm volatile("" : "+s"(wsq)); unsigned char* const ws = (unsigned char*)wsq; const float* const par = (const float*)(ws + WS_PAR); int lnq = lane_id(); asm volatile("" : "+v"(lnq)); const int lane = lnq; (void)par; (void)lane;
            pg8::SchedPlain S{(const char*)(ws + P_MRG), (const char*)(ws + WS_WOUTT) + (size_t)l * 1024 * 2048, 2048u, 2048u, 16, nMq, 4, G, bx};
            pg8::EpiBf16 E{(bf16*)(ws + P_Y), 1024, 0};
            pg8::gemm_phase<pg8::EpiBf16, pg8::SchedPlain, false>(lds, S, E, wave);
            MOE_TAIL(480, 620);
            SEAM(pb + 6);
        }
        if (PHON(9) && IN(pb + 7)) for (int rep_ = 0; rep_ <= (int)REPON(9); ++rep_) {
            GAS unsigned char* wsq = (GAS unsigned char*)ws0; asm volatile("" : "+s"(wsq)); unsigned char* const ws = (unsigned char*)wsq; const float* const par = (const float*)(ws + WS_PAR); int lnq = lane_id(); asm volatile("" : "+v"(lnq)); const int lane = lnq; (void)par; (void)lane;
            ResidArgs R{}; R.mode = 3; R.y = (const float*)(ws + P_Y); R.g_post = par + PR_GMIXPOST + l * 1024; R.gate_chunk = 2; R.g_pre = par + PR_GFFNPRE + l * 1024; R.shift_chunk = 3;
            R.hout = (bf16*)(ws + P_H); R.l_mod = l; R.l_gate = l; R.route = lastl; R.h8 = lastl ? (F8_M1 != 0) : (F8_D1 != 0); R.ysc = 1.0f;
            { int row = gw; for (; row + ngw < nMq * 256; row += 2 * ngw) { resid_row(ws, outp, nullptr, nullptr, Rd(R, rep_), row, lane, tb); resid_row(ws, outp, nullptr, nullptr, Rd(R, rep_), row + ngw, lane, tb); } if (row < nMq * 256) resid_row(ws, outp, nullptr, nullptr, Rd(R, rep_), row, lane, tb); }
            SEAM(pb + 7);
        }
        if (!lastl) {
            if (PHON(10) && IN(pb + 8)) for (int rep_ = 0; rep_ <= (int)REPON(10); ++rep_) {
            GAS unsigned char* wsq = (GAS unsigned char*)ws0; asm volatile("" : "+s"(wsq)); unsigned char* const ws = (unsigned char*)wsq; const float* const par = (const float*)(ws + WS_PAR); int lnq = lane_id(); asm volatile("" : "+v"(lnq)); const int lane = lnq; (void)par; (void)lane;
                constexpr unsigned kb1 = F8_D1 ? 1024u : 2048u;
                pg8::SchedPlain S{(const char*)(ws + P_H), (const char*)(ws + WS_WF1T), kb1, kb1, F8_D1 ? 8 : 16, nMall, 22, G, bx};
                pg8::EpiPairS<F8_D2 != 0> E{ws + P_ACT, DFF, 0, F8_D1 ? 1.0f / (F8_HSCALE * F8_WSCALE) : 1.0f, F8_D2 ? F8_ASCALE : 1.0f};
                pg8::gemm_phase<pg8::EpiPairS<F8_D2 != 0>, pg8::SchedPlain, false, F8_D1 != 0>(lds, S, E, wave);
                SEAM(pb + 8);
            }
            if (PHON(11) && IN(pb + 9)) for (int rep_ = 0; rep_ <= (int)REPON(11); ++rep_) {
            GAS unsigned char* wsq = (GAS unsigned char*)ws0; asm volatile("" : "+s"(wsq)); unsigned char* const ws = (unsigned char*)wsq; const float* const par = (const float*)(ws + WS_PAR); int lnq = lane_id(); asm volatile("" : "+v"(lnq)); const int lane = lnq; (void)par; (void)lane;
                constexpr unsigned kb2 = F8_D2 ? 2816u : 5632u;
                pg8::SchedPlain S{(const char*)(ws + P_ACT), (const char*)(ws + WS_WF2T), kb2, kb2, F8_D2 ? 22 : 44, nMall, 4, G, bx};
                pg8::EpiBf16 E{(bf16*)(ws + P_Y2), 1024, 0};
                pg8::gemm_phase<pg8::EpiBf16, pg8::SchedPlain, false, F8_D2 != 0>(lds, S, E, wave);
                MOE_TAIL(620, 1000);
                SEAM(pb + 9);
            }
            if (PHON(14) && IN(pb + 12)) for (int rep_ = 0; rep_ <= (int)REPON(14); ++rep_) {
            GAS unsigned char* wsq = (GAS unsigned char*)ws0; asm volatile("" : "+s"(wsq)); unsigned char* const ws = (unsigned char*)wsq; const float* const par = (const float*)(ws + WS_PAR); int lnq = lane_id(); asm volatile("" : "+v"(lnq)); const int lane = lnq; (void)par; (void)lane;
                ResidArgs R{}; R.mode = 3; R.y = (const float*)(ws + P_Y2); R.g_post = par + PR_GFFNPOST; R.gate_chunk = 5; R.g_pre = par + PR_GMIXPRE + 1024; R.shift_chunk = 0;
                R.hout = (bf16*)(ws + P_H); R.l_mod = 1; R.l_gate = 0; R.route = false; R.hout8 = ws + P_H8; R.ysc = F8_D2 ? 1.0f / (F8_ASCALE * F8_WSCALE) : 1.0f;
                { int row = gw; for (; row + ngw < MALL; row += 2 * ngw) { resid_row(ws, outp, nullptr, nullptr, Rd(R, rep_), row, lane, tb); resid_row(ws, outp, nullptr, nullptr, Rd(R, rep_), row + ngw, lane, tb); } if (row < MALL) resid_row(ws, outp, nullptr, nullptr, Rd(R, rep_), row, lane, tb); }
                SEAM(pb + 12);
            }
        } else {
            for (int ch = 0; ch < 1; ++ch) {
                if (IN(pb + 8 + 2 * ch) || IN(pb + 9 + 2 * ch)) {
                    __syncthreads();
                    if (tid == 0) { const unsigned* cnt = (const unsigned*)(ws + WS_CTL) + CW_CNT; int acc = 0;
                        for (int e = 0; e < 8; ++e) { const int c = (int)__hip_atomic_load(cnt + e, __ATOMIC_RELAXED, __HIP_MEMORY_SCOPE_AGENT); tb[e] = c; tb[8 + e] = acc; acc += (c + 255) >> 8; }
                        tb[16] = acc; }
                    __syncthreads();
                }
                const int ntot = __builtin_amdgcn_readfirstlane(tb[16]), t0 = 0, t1 = ntot;
                if (PHON(12) && IN(pb + 8 + 2 * ch)) for (int rep_ = 0; rep_ <= (int)REPON(12); ++rep_) {
            GAS unsigned char* wsq = (GAS unsigned char*)ws0; asm volatile("" : "+s"(wsq)); unsigned char* const ws = (unsigned char*)wsq; const float* const par = (const float*)(ws + WS_PAR); int lnq = lane_id(); asm volatile("" : "+v"(lnq)); const int lane = lnq; (void)par; (void)lane;
                    constexpr unsigned kbm = F8_M1 ? 1024u : 2048u;
                    pg8::SchedMoe1 S{(const char*)(ws + P_H), (const char*)(ws + WS_WM1T), kbm, kbm, F8_M1 ? 8 : 16, (const int*)(ws + WS_LIST), tb, t1, G, bx};
                    pg8::EpiPairS<true> E{ws + P_ACT, DFF, 0, F8_M1 ? 1.0f / (F8_HSCALE * F8_WSCALE) : 1.0f, F8_ASCALE};
                    pg8::gemm_phase<pg8::EpiPairS<true>, pg8::SchedMoe1, true, F8_M1 != 0>(lds, S, E, wave);
                    SEAM(pb + 8 + 2 * ch);
                }
                if (PHON(13) && IN(pb + 9 + 2 * ch)) for (int rep_ = 0; rep_ <= (int)REPON(13); ++rep_) {
            GAS unsigned char* wsq = (GAS unsigned char*)ws0; asm volatile("" : "+s"(wsq)); unsigned char* const ws = (unsigned char*)wsq; const float* const par = (const float*)(ws + WS_PAR); int lnq = lane_id(); asm volatile("" : "+v"(lnq)); const int lane = lnq; (void)par; (void)lane;
                    pg8::SchedMoe2 S{(const char*)(ws + P_ACT), (const char*)(ws + WS_WM2T), 2816u, 2816u, 22, tb, t1, G, bx};
                    pg8::EpiBf16 E{(bf16*)(ws + P_Y2), 1024, 0};
                    pg8::gemm_phase<pg8::EpiBf16, pg8::SchedMoe2, false, true>(lds, S, E, wave);
                    SEAM(pb + 9 + 2 * ch);
                }
            }
            if (PHON(14) && IN(pb + 12)) for (int rep_ = 0; rep_ <= (int)REPON(14); ++rep_) {
            GAS unsigned char* wsq = (GAS unsigned char*)ws0; asm volatile("" : "+s"(wsq)); unsigned char* const ws = (unsigned char*)wsq; const float* const par = (const float*)(ws + WS_PAR); int lnq = lane_id(); asm volatile("" : "+v"(lnq)); const int lane = lnq; (void)par; (void)lane;
                __syncthreads();
                if (tid == 0) { const unsigned* cnt = (const unsigned*)(ws + WS_CTL) + CW_CNT; int acc = 0;
                    for (int e = 0; e < 8; ++e) { const int c = (int)__hip_atomic_load(cnt + e, __ATOMIC_RELAXED, __HIP_MEMORY_SCOPE_AGENT); tb[e] = c; tb[8 + e] = acc; acc += (c + 255) >> 8; }
                    tb[16] = acc; }
                __syncthreads();
                ResidArgs R{}; R.mode = 2; R.g_post = par + PR_GFFNPOST + 1024; R.gate_chunk = 5; R.hout = nullptr; R.l_gate = 1; R.route = false; R.ysc = 1.0f / (F8_ASCALE * F8_WSCALE);
                { int row = gw; for (; row + ngw < NLAT; row += 2 * ngw) { resid_row(ws, outp, nullptr, nullptr, Rd(R, rep_), row, lane, tb); resid_row(ws, outp, nullptr, nullptr, Rd(R, rep_), row + ngw, lane, tb); } if (row < NLAT) resid_row(ws, outp, nullptr, nullptr, Rd(R, rep_), row, lane, tb); }
            }
        }
    }
#undef IN
#undef SEAM
#undef tid
}

extern "C" void kernel_launch(void* const* d_in, const int* in_sizes, int n_in, void* d_out, int out_size, void* d_ws, size_t ws_size, hipStream_t stream) {
    static int grid = 0;
    if (grid == 0) {
        if (n_in != 38 || out_size != NLAT * D || ws_size < WS_END) { fprintf(stderr, "kernel_launch: unexpected problem (n_in %d out %d ws %zu, need %zu)\n", n_in, out_size, ws_size, (size_t)WS_END); grid = -1; return; }
        int dev = 0, cus = 0, per_cu = 0;
        if (hipGetDevice(&dev) != hipSuccess || hipDeviceGetAttribute(&cus, hipDeviceAttributeMultiprocessorCount, dev) != hipSuccess) { grid = -1; return; }
        if (hipFuncSetAttribute((const void*)mk_fwd, hipFuncAttributeMaxDynamicSharedMemorySize, LDS_BYTES) != hipSuccess) { fprintf(stderr, "kernel_launch: hipFuncSetAttribute failed\n"); grid = -1; return; }
        if (hipOccupancyMaxActiveBlocksPerMultiprocessor(&per_cu, (const void*)mk_fwd, NTHREADS, LDS_BYTES) != hipSuccess || per_cu < 1) { fprintf(stderr, "kernel_launch: occupancy query says %d\n", per_cu); }
        (void)hipGetLastError();
        grid = cus;
    }
    if (grid < 0) return;
    (void)hipMemsetAsync((char*)d_ws + WS_CTL, 0, CTL_BYTES, stream);
    Args a{};
    for (int i = 0; i < 38; ++i) a.in[i] = (const float*)d_in[i];
    a.out = (float*)d_out; a.ws = (unsigned char*)d_ws;
#if MK_MULTI
    for (int ph = 0; ph < NPH; ++ph) {
        const int rel = ph < PH_L0 ? -1 : (ph - PH_L0) % PH_PER_L, l = ph < PH_L0 ? 0 : (ph - PH_L0) / PH_PER_L;
        if (rel > 12 || (l == 0 && (rel == 10 || rel == 11))) continue;
        a.ph_lo = ph; a.ph_hi = ph + 1;
        hipLaunchKernelGGL(mk_fwd, dim3(grid), dim3(NTHREADS), LDS_BYTES, stream, a);
#if MK_DEBUG
        hipLaunchKernelGGL(dbg_fwd, dim3(grid), dim3(NTHREADS), 0, stream, a, ph);
#endif
    }
#if MK_DEBUG
    hipLaunchKernelGGL(dbg_fwd, dim3(grid), dim3(NTHREADS), 0, stream, a, 1000);
#endif
#else
    a.ph_lo = 0; a.ph_hi = NPH;
    hipLaunchKernelGGL(mk_fwd, dim3(grid), dim3(NTHREADS), LDS_BYTES, stream, a);
#endif
}
```

```cpp
#include <hip/hip_runtime.h>
#include <cstdio>
#include <cstdint>

#ifndef MK_DEBUG
#define MK_DEBUG 0
#endif
#ifndef MK_MULTI
#define MK_MULTI 0
#endif

#define GAS __attribute__((address_space(1)))
#define LAS __attribute__((address_space(3)))
typedef unsigned short bf16;
typedef short bf16x8 __attribute__((ext_vector_type(8)));
typedef short s16x4 __attribute__((ext_vector_type(4)));
typedef float f32x2 __attribute__((ext_vector_type(2)));
typedef float f32x4 __attribute__((ext_vector_type(4)));
typedef float f32x16 __attribute__((ext_vector_type(16)));
typedef unsigned u32x2 __attribute__((ext_vector_type(2)));
typedef unsigned u32x4 __attribute__((ext_vector_type(4)));

constexpr int D = 1024, NB = 4, SEQ = 4096, CTXL = 256, GRIDW = 64;
constexpr int NLAT = NB * SEQ, NCTX = NB * CTXL, MALL = NLAT + NCTX;
constexpr int LPOS = CTXL + SEQ;
constexpr int NIN = 1952, ZW = 2048;
constexpr int DFF = 2816, NEXP = 8;
constexpr float EPS = 1e-6f;
constexpr float LOG2E = 1.4426950408889634f;
#ifndef F8_G1L1
#define F8_G1L1 1
#endif
constexpr float F8_WSCALE = 256.f, F8_HSCALE = 16.f, F8_ASCALE = 8.f;
#ifndef F8_D1
#define F8_D1 0
#endif
#ifndef F8_D2
#define F8_D2 0
#endif
#ifndef F8_M1
#define F8_M1 1
#endif
constexpr int ZC_QG = 0, ZC_KG = 512, ZC_VG = 640, ZC_CQ = 768, ZC_CKV = 1152, ZC_KR = 1408, ZC_U = 1536;

constexpr size_t MiB = 1u << 20;
constexpr size_t WS_CTL = 0, CTL_BYTES = 1 * MiB;
constexpr size_t WS_MOD = 1 * MiB;
constexpr size_t WS_ROPE = 2 * MiB;
constexpr size_t WS_PAR = 3 * MiB + 512 * 1024;
constexpr int PR_GMIXPRE = 0, PR_GMIXPOST = 2048, PR_GFFNPRE = 4096, PR_GFFNPOST = 6144, PR_GQ = 8192, PR_GK = 8320, PR_GCQ = 8448, PR_GCKV = 9216, PR_BMG = 9728, PR_RW = 15872, PR_RB = 24064,
              PR_A16 = 24080, PR_END = PR_A16 + 2 * 2 * 32 * 64 * 2;
constexpr size_t WS_LIST = 4 * MiB;
constexpr size_t WS_LATC = 5 * MiB;
constexpr size_t WS_W1T = 9 * MiB;
constexpr size_t WS_WMGT = 17 * MiB;
constexpr size_t WS_WUQT = 29 * MiB;
constexpr size_t WS_WUKVT = 31 * MiB;
constexpr size_t WS_S5M = 32 * MiB;
constexpr size_t WS_WGLUT = 56 * MiB;
constexpr size_t WS_WBT = 58 * MiB;
constexpr size_t WS_WOUTT = 64 * MiB;
constexpr size_t WS_WF1T = 68 * MiB;
constexpr size_t WS_WF2T = 79 * MiB;
constexpr size_t WS_WM1T = 85 * MiB;
constexpr size_t WS_WM2T = 173 * MiB;
constexpr size_t WS_POOL = 217 * MiB;
constexpr size_t P_H = WS_POOL + 0 * MiB;
constexpr size_t P_Z = WS_POOL + 34 * MiB;
constexpr size_t P_QB = WS_POOL + 34 * MiB;
constexpr size_t P_KB = WS_POOL + 60 * MiB;
constexpr size_t P_VB = WS_POOL + 77 * MiB;
constexpr size_t P_QA = WS_POOL + 102 * MiB;
constexpr size_t P_KA = WS_POOL + 119 * MiB;
constexpr size_t P_VA = WS_POOL + 124 * MiB;
constexpr size_t P_KRR = WS_POOL + 129 * MiB;
constexpr size_t P_UG = WS_POOL + 131 * MiB;
constexpr size_t P_CQN = WS_POOL + 148 * MiB;
constexpr size_t P_CKVN = WS_POOL + 161 * MiB;
constexpr size_t P_AGLU = WS_POOL + 170 * MiB;
constexpr size_t P_YBR = WS_POOL + 187 * MiB;
constexpr size_t P_MRG = WS_POOL + 34 * MiB;
constexpr size_t P_GSCR = WS_POOL + 68 * MiB;
constexpr size_t P_Y = WS_POOL + 102 * MiB;
constexpr size_t P_ACT = WS_POOL + 34 * MiB;
constexpr size_t P_Y2 = WS_POOL + 136 * MiB;
constexpr size_t P_H8 = WS_POOL + 240 * MiB;
constexpr size_t WS_END = WS_POOL + 257 * MiB;
static_assert(P_YBR + (size_t)MALL * 1536 * 2 <= WS_END && P_Y2 + (size_t)MALL * 1024 * 4 <= WS_END && P_ACT + (size_t)MALL * DFF * 2 <= P_Y2, "pool map");
static_assert(P_GSCR + 256 * 3 * 131072 <= P_AGLU && P_VB + (size_t)MALL * 512 * 2 <= P_QA && P_Y + (size_t)MALL * 4096 <= P_AGLU, "pool map 2");

constexpr int CW_BAR = 4096;
constexpr int CW_Q = 8320;
constexpr int CW_CNT = 8192;
constexpr int CW_DBG = 16384;

constexpr int LDS_MISC = 147456;
constexpr int LDS_BYTES = 151552;
constexpr int NWAVES = 8, NTHREADS = 512;

__device__ __forceinline__ int lane_id() { unsigned m_ = ~0u; asm volatile("" : "+s"(m_)); return (int)__builtin_amdgcn_mbcnt_hi(m_, __builtin_amdgcn_mbcnt_lo(m_, 0u)); }
__device__ __forceinline__ float bf2f(unsigned v) { return __uint_as_float(v << 16); }
__device__ __forceinline__ unsigned f2bf(float f) { unsigned u = __float_as_uint(f); return (u + 0x7fffu + ((u >> 16) & 1u)) >> 16; }
typedef __bf16 bf16x2_t __attribute__((ext_vector_type(2)));
__device__ __forceinline__ unsigned pk2(float lo, float hi) { const f32x2 v = {lo, hi}; return __builtin_bit_cast(unsigned, __builtin_convertvector(v, bf16x2_t)); }
__device__ __forceinline__ float shfl_xor_l(float v, int mask, int lane) { return __int_as_float(__builtin_amdgcn_ds_bpermute((lane ^ mask) << 2, __float_as_int(v))); }
__device__ __forceinline__ float wave_sum(float v) {
    const int lane = lane_id();
#pragma unroll
    for (int o = 1; o < 64; o <<= 1) v += shfl_xor_l(v, o, lane);
    return v;
}
__device__ __forceinline__ float fsigmoid(float x) { return __builtin_amdgcn_rcpf(1.0f + __builtin_amdgcn_exp2f(-x * LOG2E)); }
__device__ __forceinline__ float fsilu(float x) { return x * fsigmoid(x); }
__device__ __forceinline__ float fgelu_tanh(float x) { const float u = 0.7978845608028654f * (x + 0.044715f * x * x * x); return x * fsigmoid(2.0f * u); }
__device__ __forceinline__ void unpack8(const u32x4 v, float (&f)[8]) {
    f[0] = bf2f(v.x & 0xffffu); f[1] = bf2f(v.x >> 16); f[2] = bf2f(v.y & 0xffffu); f[3] = bf2f(v.y >> 16);
    f[4] = bf2f(v.z & 0xffffu); f[5] = bf2f(v.z >> 16); f[6] = bf2f(v.w & 0xffffu); f[7] = bf2f(v.w >> 16);
}
__device__ __forceinline__ u32x4 pack8(const float (&f)[8]) { u32x4 w; w.x = pk2(f[0], f[1]); w.y = pk2(f[2], f[3]); w.z = pk2(f[4], f[5]); w.w = pk2(f[6], f[7]); return w; }
__device__ __forceinline__ int pos_row(int b, int p) { return p < CTXL ? NLAT + b * CTXL + p : b * SEQ + (p - CTXL); }

#define XB_TMO      128
#define XB_XCNT(j)  (256  + 64 * (j))
#define XB_XSUB(j)  (1280 + 64 * (j))
#define XB_XGEN(j)  (2304 + 64 * (j))
#define XB_TOP      3328
#define XB_TOPGEN   3392
#define XCD_BAR_WORDS 3456
#define XB_SPIN_CAP (1u << 18)
__device__ __forceinline__ unsigned xb_ld(unsigned* p)              { return __hip_atomic_load(p, __ATOMIC_RELAXED, __HIP_MEMORY_SCOPE_AGENT); }
__device__ __forceinline__ unsigned xb_add(unsigned* p, unsigned v) { return __hip_atomic_fetch_add(p, v, __ATOMIC_RELAXED, __HIP_MEMORY_SCOPE_AGENT); }
__device__ __forceinline__ unsigned xb_xcc_id() { return (unsigned)__builtin_amdgcn_s_getreg((3 << 11) | 20) & 0xFu; }
#define XB_SPIN(cond, bar) do { unsigned _sp = 0; while (cond) { __builtin_amdgcn_s_sleep(1); \
    if ((++_sp & 255u) == 0u) { if (xb_ld(&(bar)[XB_TMO])) break; if (_sp > XB_SPIN_CAP) { atomicAdd(&(bar)[XB_TMO], 1u); break; } } } } while (0)
struct XcdBarrier { unsigned* bar; unsigned x; volatile LAS unsigned* st; int wave; };
__device__ __forceinline__ XcdBarrier xcd_barrier_post(unsigned* bar, volatile LAS unsigned* st, int wave) {
    XcdBarrier b; b.bar = bar; b.x = xb_xcc_id(); b.st = st; b.wave = wave;
    if (wave == 0 && lane_id() == 0) (void)xb_add(&bar[XB_XCNT(b.x)], 1u);
    return b;
}
__device__ __forceinline__ void xcd_barrier_complete(unsigned* bar, unsigned x, unsigned& nloc, unsigned& nx) {
    const unsigned G = gridDim.x * gridDim.y * gridDim.z;
    unsigned sum, cnt, mine, sp = 0u;
    for (;;) {
        sum = 0u; cnt = 0u; mine = 0u;
#pragma unroll
        for (unsigned j = 0; j < 16; ++j) { const unsigned c = xb_ld(&bar[XB_XCNT(j)]); sum += c; cnt += (c > 0u) ? 1u : 0u; mine = (j == x) ? c : mine; }
        if (sum == G) break;
        __builtin_amdgcn_s_sleep(1);
        if ((++sp & 255u) == 0u) { if (xb_ld(&bar[XB_TMO])) break; if (sp > XB_SPIN_CAP) { atomicAdd(&bar[XB_TMO], 1u); break; } }
    }
    nloc = mine > 0u ? mine : 1u; nx = cnt > 0u ? cnt : 1u;
}
__device__ __forceinline__ void xcd_barrier(const XcdBarrier& b) {
    asm volatile("s_waitcnt vmcnt(0)" ::: "memory");
    __syncthreads();
    if (b.wave == 0 && lane_id() == 0) {
        unsigned* bar = b.bar;
        __builtin_amdgcn_s_waitcnt(0);
        unsigned nloc = b.st[0], nx = b.st[1];
        if (nloc == 0u) { xcd_barrier_complete(bar, b.x, nloc, nx); b.st[0] = nloc; b.st[1] = nx; }
        const unsigned old = xb_add(&bar[XB_XSUB(b.x)], 1u);
        const unsigned gen = old / nloc;
        if (old + 1u == (gen + 1u) * nloc) {
            __builtin_amdgcn_fence(__ATOMIC_RELEASE, "agent");
            asm volatile("s_waitcnt vmcnt(0)" ::: "memory");
            const unsigned og = xb_add(&bar[XB_TOP], 1u);
            const unsigned tg = og / nx;
            if (og + 1u == (tg + 1u) * nx) xb_add(&bar[XB_TOPGEN], 1u);
            else XB_SPIN(xb_ld(&bar[XB_TOPGEN]) == tg, bar);
            __builtin_amdgcn_fence(__ATOMIC_ACQUIRE, "agent");
            xb_add(&bar[XB_XGEN(b.x)], 1u);
            asm volatile("s_waitcnt vmcnt(0)" ::: "memory");
        } else {
            XB_SPIN(xb_ld(&bar[XB_XGEN(b.x)]) == gen, bar);
            __builtin_amdgcn_fence(__ATOMIC_ACQUIRE, "agent");
            asm volatile("s_waitcnt vmcnt(0)" ::: "memory");
        }
    }
    __syncthreads();
}

namespace pg8 {
typedef int v4i __attribute__((ext_vector_type(4)));
typedef int v8i __attribute__((ext_vector_type(8)));
constexpr int BM = 256, BK = 64, HALF = 128, HTB = HALF * BK * 2, STAGE_BYTES = 8 * HTB;
__host__ __device__ __forceinline__ int lds_byte(int r, int c) { const int st = (r >> 4) * 2 + (c >> 5), rr = r & 15, cc = c & 31, ob = rr * 64 + cc * 2; return st * 1024 + (ob ^ (((ob >> 9) & 1) << 5)); }
__host__ __device__ __forceinline__ void stage_rc(int b, int& R, int& C) { const int st = b / 1024, sb = b % 1024, swz = sb ^ (((sb >> 9) & 1) << 5); R = (st >> 1) * 16 + swz / 64; C = (st & 1) * 32 + (swz % 64) / 2; }
__host__ __device__ __forceinline__ int perm32(int rho) { const int n = rho >> 4, i = rho & 15; return 8 * (i >> 2) + 4 * n + (i & 3); }

struct GUnit { const char* a; const char* b; unsigned lda, ldb; int nt; int pm, pn, z; };

__device__ __forceinline__ void tile_of(int L, int nM, int nN, int& pm, int& pn) {
    const int nwg = nM * nN; int wgid = L;
    { const int q = nwg / 8, r = nwg % 8, xcd = wgid % 8, off = wgid / 8; wgid = (xcd < r ? xcd * (q + 1) : r * (q + 1) + (xcd - r) * q) + off; }
    const int nig = 8 * nN, gid = wgid / nig, fm = gid * 8, gsz = (nM - fm) < 8 ? (nM - fm) : 8;
    pm = fm + ((wgid % nig) % gsz); pn = (wgid % nig) / gsz;
}

template <class Epi, class Sched, bool GATHER, bool F8 = false>
__device__ __forceinline__ void gemm_phase(LAS unsigned char* lds, const Sched& S, const Epi& E, int wave_) {
    int tid = wave_ * 64 + lane_id(); asm volatile("" : "+v"(tid));
    const int wid = __builtin_amdgcn_readfirstlane(tid >> 6), lane = tid & 63, wr = wid >> 2, wc = wid & 3, fr = lane & 15, fq = lane >> 4;
    int Rr[2], Cc[2], Rb[2];
#pragma unroll
    for (int i = 0; i < 2; ++i) { stage_rc(tid * 16 + i * 8192, Rr[i], Cc[i]); Rb[i] = Epi::PERM ? ((Rr[i] & ~31) + perm32(Rr[i] & 31)) : Rr[i]; }
    const size_t kstep = (size_t)(BK * 2);
    const unsigned ldsw = (unsigned)wid * 1024u;
    const int aoff = lds_byte(wr * 64 + fr, fq * 8), boff = lds_byte(wc * 32 + fr, fq * 8);
#define PG8_SA(b, h) (((b) * 2 + (h)) * HTB)
#define PG8_SB(b, h) ((4 + (b) * 2 + (h)) * HTB)
#define PG8_STAGE(bufoff, gbase, v0, v1) do { \
        __builtin_amdgcn_global_load_lds((const unsigned*)((const char*)(gbase) + (v0)), (LAS unsigned*)(lds + (bufoff) + ldsw), 16, 0, 0); \
        __builtin_amdgcn_global_load_lds((const unsigned*)((const char*)(gbase) + (v1)), (LAS unsigned*)(lds + (bufoff) + ldsw + 8192), 16, 0, 0); } while (0)
#define PG8_LD16(p) __builtin_bit_cast(v4i, *(const LAS bf16x8*)(p))
#define PG8_LDA(dst, b, h) do { _Pragma("unroll") for (int m = 0; m < 4; ++m) dst[m] = __builtin_shufflevector(PG8_LD16(lds + PG8_SA(b, h) + aoff + m * 2048), PG8_LD16(lds + PG8_SA(b, h) + aoff + m * 2048 + 1024), 0, 1, 2, 3, 4, 5, 6, 7); } while (0)
#define PG8_LDB(dst, b, h) do { _Pragma("unroll") for (int n = 0; n < 2; ++n) dst[n] = __builtin_shufflevector(PG8_LD16(lds + PG8_SB(b, h) + boff + n * 2048), PG8_LD16(lds + PG8_SB(b, h) + boff + n * 2048 + 1024), 0, 1, 2, 3, 4, 5, 6, 7); } while (0)
#define PG8_LO(x) __builtin_bit_cast(bf16x8, __builtin_shufflevector(x, x, 0, 1, 2, 3))
#define PG8_HI(x) __builtin_bit_cast(bf16x8, __builtin_shufflevector(x, x, 4, 5, 6, 7))
#define PG8_MMA(ai, bj, At, Bt) do { __builtin_amdgcn_s_setprio(1); \
        _Pragma("unroll") for (int m = 0; m < 4; ++m) _Pragma("unroll") for (int n = 0; n < 2; ++n) { \
            if constexpr (F8) acc[ai][bj][m][n] = __builtin_amdgcn_mfma_scale_f32_16x16x128_f8f6f4(Bt[n], At[m], acc[ai][bj][m][n], 0, 0, 0, 0, 0, 0); \
            else { acc[ai][bj][m][n] = __builtin_amdgcn_mfma_f32_16x16x32_bf16(PG8_LO(Bt[n]), PG8_LO(At[m]), acc[ai][bj][m][n], 0, 0, 0); \
                   acc[ai][bj][m][n] = __builtin_amdgcn_mfma_f32_16x16x32_bf16(PG8_HI(Bt[n]), PG8_HI(At[m]), acc[ai][bj][m][n], 0, 0, 0); } } \
        __builtin_amdgcn_s_setprio(0); } while (0)
#define PG8_WAIT_V(n) asm volatile("s_waitcnt vmcnt(" #n ")" ::: "memory")
#define PG8_WAIT_L(n) asm volatile("s_waitcnt lgkmcnt(" #n ")" ::: "memory")
#define PG8_BAR __builtin_amdgcn_s_barrier()
#define PG8_SCHED __builtin_amdgcn_sched_barrier(0)
#define PG8_OFFS(u) do { \
        _Pragma("unroll") for (int i_ = 0; i_ < 2; ++i_) { \
            if constexpr (GATHER) { oA0[i_] = S.arow(u, Rr[i_]) + (unsigned)Cc[i_] * 2u; oA1[i_] = S.arow(u, HALF + Rr[i_]) + (unsigned)Cc[i_] * 2u; } \
            else { oA0[i_] = (unsigned)Rr[i_] * (u).lda + (unsigned)Cc[i_] * 2u; } \
            oB[i_] = (unsigned)Rb[i_] * (u).ldb + (unsigned)Cc[i_] * 2u; } \
        hA = GATHER ? (size_t)0 : (size_t)HALF * (u).lda; hB = (size_t)HALF * (u).ldb; } while (0)
#define PG8_A1(i) (GATHER ? oA1[i] : oA0[i])
    GUnit cur, nxt; int ui = 0;
    if (!S.next(0, cur)) return;
    f32x4 acc[2][2][4][2];
#pragma unroll
    for (int a = 0; a < 2; ++a)
#pragma unroll
        for (int b = 0; b < 2; ++b)
#pragma unroll
            for (int m = 0; m < 4; ++m)
#pragma unroll
                for (int n = 0; n < 2; ++n) acc[a][b][m][n] = (f32x4){0.f, 0.f, 0.f, 0.f};
    v8i At[4], B0[2], B1[2];
    unsigned oA0[2], oA1[2], oB[2]; size_t hA, hB;
    oA1[0] = 0u; oA1[1] = 0u;
    PG8_OFFS(cur);
    const char* cA = cur.a; const char* cBp = cur.b;
    PG8_STAGE(PG8_SB(0, 0), cBp, oB[0], oB[1]); PG8_STAGE(PG8_SB(0, 1), cBp + hB, oB[0], oB[1]); PG8_STAGE(PG8_SA(0, 0), cA, oA0[0], oA0[1]); PG8_STAGE(PG8_SA(0, 1), cA + hA, PG8_A1(0), PG8_A1(1));
    if (wr == 1) PG8_BAR;
    PG8_WAIT_V(2); PG8_BAR;
    PG8_STAGE(PG8_SB(1, 0), cBp + kstep, oB[0], oB[1]); PG8_STAGE(PG8_SA(1, 0), cA + kstep, oA0[0], oA0[1]); PG8_STAGE(PG8_SB(1, 1), cBp + hB + kstep, oB[0], oB[1]);
    PG8_WAIT_V(6); PG8_BAR;
    for (;;) {
        const bool has_next = S.next(ui + 1, nxt);
        const char* nA = has_next ? nxt.a : cA; const char* nBp = has_next ? nxt.b : cBp;
        int nt = cur.nt; asm volatile("" : "+s"(nt));
        for (int t = 0; t < nt; t += 2) {
            const bool last = (t == nt - 2);
            const char* a1 = cA + (size_t)(t + 1) * kstep;
            const char* a2 = last ? nA : cA + (size_t)(t + 2) * kstep; const char* b2 = last ? nBp : cBp + (size_t)(t + 2) * kstep;
            const char* a3 = a2 + kstep; const char* b3 = b2 + kstep;
            PG8_LDB(B0, 0, 0); PG8_LDB(B1, 0, 1); PG8_SCHED; PG8_LDA(At, 0, 0); PG8_STAGE(PG8_SA(1, 1), a1 + hA, PG8_A1(0), PG8_A1(1));
            if (last && has_next) PG8_OFFS(nxt);
            PG8_WAIT_V(8); PG8_WAIT_L(0); PG8_BAR; PG8_MMA(0, 0, At, B0); PG8_MMA(0, 1, At, B1); PG8_BAR; PG8_SCHED;
            PG8_LDA(At, 0, 1); PG8_STAGE(PG8_SB(0, 0), b2, oB[0], oB[1]); PG8_STAGE(PG8_SB(0, 1), b2 + hB, oB[0], oB[1]); PG8_STAGE(PG8_SA(0, 0), a2, oA0[0], oA0[1]);
            PG8_WAIT_V(8); PG8_WAIT_L(0); PG8_BAR; PG8_MMA(1, 0, At, B0); PG8_MMA(1, 1, At, B1); PG8_BAR; PG8_SCHED;
            PG8_LDB(B0, 1, 0); PG8_LDB(B1, 1, 1); PG8_SCHED; PG8_LDA(At, 1, 0); PG8_STAGE(PG8_SA(0, 1), a2 + hA, PG8_A1(0), PG8_A1(1));
            PG8_WAIT_V(8); PG8_WAIT_L(0); PG8_BAR; PG8_MMA(0, 0, At, B0); PG8_MMA(0, 1, At, B1); PG8_BAR; PG8_SCHED;
            PG8_LDA(At, 1, 1); PG8_STAGE(PG8_SB(1, 0), b3, oB[0], oB[1]); PG8_STAGE(PG8_SB(1, 1), b3 + hB, oB[0], oB[1]); PG8_STAGE(PG8_SA(1, 0), a3, oA0[0], oA0[1]);
            PG8_WAIT_V(8); PG8_WAIT_L(0); PG8_BAR; PG8_MMA(1, 0, At, B0); PG8_MMA(1, 1, At, B1); PG8_BAR; PG8_SCHED;
        }
        if (wr == 0) PG8_BAR;
        E(acc, cur, wr, wc, fr, fq);
        if (!has_next) break;
#pragma unroll
        for (int a = 0; a < 2; ++a)
#pragma unroll
            for (int b = 0; b < 2; ++b)
#pragma unroll
                for (int m = 0; m < 4; ++m)
#pragma unroll
                    for (int n = 0; n < 2; ++n) acc[a][b][m][n] = (f32x4){0.f, 0.f, 0.f, 0.f};
        cur = nxt; cA = nA; cBp = nBp; ++ui;
        if (wr == 1) PG8_BAR;
    }
    PG8_WAIT_V(0);
    PG8_BAR;
#undef PG8_SA
#undef PG8_SB
#undef PG8_STAGE
#undef PG8_LDA
#undef PG8_LDB
#undef PG8_LD16
#undef PG8_LO
#undef PG8_HI
#undef PG8_MMA
#undef PG8_WAIT_V
#undef PG8_WAIT_L
#undef PG8_BAR
#undef PG8_SCHED
#undef PG8_OFFS
#undef PG8_A1
}
}

namespace pg8 {
__device__ __forceinline__ unsigned pk_fp8x4(float a, float b, float c, float d) {
    a = __builtin_amdgcn_fmed3f(a, -448.f, 448.f); b = __builtin_amdgcn_fmed3f(b, -448.f, 448.f); c = __builtin_amdgcn_fmed3f(c, -448.f, 448.f); d = __builtin_amdgcn_fmed3f(d, -448.f, 448.f);
    unsigned w = 0; w = __builtin_amdgcn_cvt_pk_fp8_f32(a, b, w, false); w = __builtin_amdgcn_cvt_pk_fp8_f32(c, d, w, true); return w; }
struct SchedPlain {
    const char* A; const char* B; unsigned lda, ldb; int nt, nM, nN, G, c;
    __device__ __forceinline__ bool next(int i, GUnit& u) const {
        const int L = i * G + c; if (L >= nM * nN) return false;
        int pm, pn; tile_of(L, nM, nN, pm, pn);
        u.a = A + (size_t)pm * 256 * lda; u.b = B + (size_t)pn * 256 * ldb; u.lda = lda; u.ldb = ldb; u.nt = nt; u.pm = pm; u.pn = pn; u.z = 0; return true;
    }
};
struct SchedUp {
    const char* Aq; const char* Bq; const char* Akv; const char* Bkv; int nMq, nMall, G, c;
    __device__ __forceinline__ bool next(int i, GUnit& u) const {
        int L = i * G + c; const int nq = nMq * 3; int pm, pn;
        if (L < nq) { tile_of(L, nMq, 3, pm, pn); u.a = Aq + (size_t)pm * 256 * 768; u.b = Bq + (size_t)pn * 256 * 768; u.lda = 768u; u.ldb = 768u; u.nt = 6; u.pm = pm; u.pn = pn; u.z = 0; return true; }
        L -= nq; if (L >= nMall * 4) return false;
        tile_of(L, nMall, 4, pm, pn); u.a = Akv + (size_t)pm * 256 * 512; u.b = Bkv + (size_t)pn * 256 * 512; u.lda = 512u; u.ldb = 512u; u.nt = 4; u.pm = pm; u.pn = pn; u.z = 1; return true;
    }
};
struct SchedMergeG {
    const char* A; const char* B; unsigned lda, ldb; int nt, nM, L;
    __device__ __forceinline__ bool next(int i, GUnit& u) const {
        if (i >= 3 || L >= nM * 4) return false;
        int pm, pn; tile_of(L, nM, 4, pm, pn);
        u.a = A + (size_t)pm * 256 * lda; u.lda = lda; u.b = B + ((size_t)i * 1024 + pn * 256) * ldb; u.ldb = ldb; u.nt = nt; u.pm = pm; u.pn = pn; u.z = i; return true;
    }
};
struct SchedMergeP {
    const char* A; const char* B; unsigned lda, ldb; int nt, nM, L;
    __device__ __forceinline__ bool next(int i, GUnit& u) const {
        if (i >= 3 || L >= nM * 4) return false;
        int pm, pn; tile_of(L, nM, 4, pm, pn);
        u.a = A + (size_t)pm * 256 * lda + i * 1024; u.lda = lda; u.b = B + ((size_t)i * 1024 + pn * 256) * ldb; u.ldb = ldb; u.nt = nt; u.pm = pm; u.pn = pn; u.z = i; return true;
    }
};
struct SchedMoe1 {
    const char* H2; const char* W; unsigned lda, ldb; int nt; const int* list; const LAS int* tb; int nM, G, c;
    __device__ __forceinline__ bool next(int i, GUnit& u) const {
        const int L = i * G + c; if (L >= nM * 22) return false;
        const int mt = L / 22, pn = L % 22; int e = 0;
#pragma unroll
        for (int j = 1; j < 8; ++j) e += (mt >= tb[8 + j]) ? 1 : 0;
        e = __builtin_amdgcn_readfirstlane(e);
        u.a = H2; u.lda = lda; u.b = W + ((size_t)e * 5632 + pn * 256) * ldb; u.ldb = ldb; u.nt = nt; u.pm = mt; u.pn = pn; u.z = e; return true;
    }
    __device__ __forceinline__ unsigned arow(const GUnit& u, int r) const {
        const int e = u.z, li = (u.pm - tb[8 + e]) * 256 + r; const int tok = (li < tb[e]) ? list[e * 16384 + li] : 0;
        return (unsigned)tok * lda;
    }
};
struct SchedMoe2 {
    const char* A; const char* B; unsigned lda, ldb; int nt; const LAS int* tb; int nM, G, c;
    __device__ __forceinline__ bool next(int i, GUnit& u) const {
        const int L = i * G + c; if (L >= nM * 4) return false;
        int pm, pn; tile_of(L, nM, 4, pm, pn); int e = 0;
#pragma unroll
        for (int j = 1; j < 8; ++j) e += (pm >= tb[8 + j]) ? 1 : 0;
        e = __builtin_amdgcn_readfirstlane(e);
        u.a = A + (size_t)pm * 256 * lda; u.b = B + (size_t)(e * 4 + pn) * 256 * ldb; u.lda = lda; u.ldb = ldb; u.nt = nt; u.pm = pm; u.pn = pn; u.z = e; return true;
    }
};

#define EPI_ROWS_BEGIN _Pragma("unroll") for (int ai = 0; ai < 2; ++ai) _Pragma("unroll") for (int m = 0; m < 4; ++m) { const int row = u.pm * BM + ai * HALF + wr * 64 + m * 16 + fr;
#define EPI_ROWS_END }
__device__ __forceinline__ u32x4 pack_f4f4(const f32x4 a, const f32x4 b) { u32x4 w; w.x = pk2(a[0], a[1]); w.y = pk2(a[2], a[3]); w.z = pk2(b[0], b[1]); w.w = pk2(b[2], b[3]); return w; }

struct EpiBf16 {
    static constexpr bool PERM = true;
    bf16* O; int ldc; int rsub;
    __device__ __forceinline__ void operator()(const f32x4 (&acc)[2][2][4][2], const GUnit& u, int wr, int wc, int fr, int fq) const {
        const int col0 = u.pn * BM + wc * 32 + 8 * fq;
        EPI_ROWS_BEGIN
            bf16* rowp = O + (size_t)(row - rsub) * ldc + col0;
#pragma unroll
            for (int bj = 0; bj < 2; ++bj) *(u32x4*)(rowp + bj * HALF) = pack_f4f4(acc[ai][bj][m][0], acc[ai][bj][m][1]);
        EPI_ROWS_END
    }
};
struct EpiF32 {
    static constexpr bool PERM = false;
    float* C; int ldc;
    __device__ __forceinline__ void operator()(const f32x4 (&acc)[2][2][4][2], const GUnit& u, int wr, int wc, int fr, int fq) const {
        const int col0 = u.pn * BM + wc * 32 + 4 * fq;
        EPI_ROWS_BEGIN
            float* rowp = C + (size_t)row * ldc + col0;
#pragma unroll
            for (int bj = 0; bj < 2; ++bj)
#pragma unroll
                for (int n = 0; n < 2; ++n) *(f32x4*)(rowp + bj * HALF + n * 16) = acc[ai][bj][m][n];
        EPI_ROWS_END
    }
};
struct EpiUq {
    static constexpr bool PERM = true;
    bf16* Qb; const float* cosB; const float* sinB; float scale;
    __device__ __forceinline__ void operator()(const f32x4 (&acc)[2][2][4][2], const GUnit& u, int wr, int wc, int fr, int fq) const {
        const bool lat = u.pm < 64;
        EPI_ROWS_BEGIN
            const int t = row & (SEQ - 1);
#pragma unroll
            for (int bj = 0; bj < 2; ++bj) {
                const int gidx = u.pn * 8 + bj * 4 + wc, head = gidx / 3, part = gidx - head * 3;
                bf16* dst = Qb + (size_t)row * 768 + head * 96 + part * 32;
                f32x4 a = acc[ai][bj][m][0] * scale, b = acc[ai][bj][m][1] * scale;
                if (part == 2) {
                    if (lat) { const f32x4 c = *(const f32x4*)(cosB + t * 16 + 4 * fq), s = *(const f32x4*)(sinB + t * 16 + 4 * fq);
                        const f32x4 x1 = a * c - b * s, x2 = a * s + b * c; a = x1; b = x2; }
                    u32x2 w0, w1; w0.x = pk2(a[0], a[1]); w0.y = pk2(a[2], a[3]); w1.x = pk2(b[0], b[1]); w1.y = pk2(b[2], b[3]);
                    *(u32x2*)(dst + 4 * fq) = w0; *(u32x2*)(dst + 16 + 4 * fq) = w1;
                } else *(u32x4*)(dst + 8 * fq) = pack_f4f4(a, b);
            }
        EPI_ROWS_END
    }
};
struct EpiUkv {
    static constexpr bool PERM = true;
    bf16* Kb; bf16* Vb;
    __device__ __forceinline__ void operator()(const f32x4 (&acc)[2][2][4][2], const GUnit& u, int wr, int wc, int fr, int fq) const {
        bf16* base = (wc < 2) ? Kb : Vb;
        EPI_ROWS_BEGIN
#pragma unroll
            for (int bj = 0; bj < 2; ++bj) { const int head = u.pn * 2 + bj;
                *(u32x4*)(base + (size_t)row * 512 + head * 64 + (wc & 1) * 32 + 8 * fq) = pack_f4f4(acc[ai][bj][m][0], acc[ai][bj][m][1]); }
        EPI_ROWS_END
    }
};
struct EpiUp {
    static constexpr bool PERM = true;
    EpiUq q; EpiUkv kv;
    __device__ __forceinline__ void operator()(const f32x4 (&acc)[2][2][4][2], const GUnit& u, int wr, int wc, int fr, int fq) const { if (u.z == 0) q(acc, u, wr, wc, fr, fq); else kv(acc, u, wr, wc, fr, fq); }
};
template <int MODE> struct EpiPair {
    static constexpr bool PERM = true;
    bf16* O; int ldc; int cbase; int rsub;
    __device__ __forceinline__ void operator()(const f32x4 (&acc)[2][2][4][2], const GUnit& u, int wr, int wc, int fr, int fq) const {
        const int col0 = cbase + u.pn * 128 + wc * 32 + 8 * fq;
        EPI_ROWS_BEGIN
            f32x4 o[2];
#pragma unroll
            for (int n = 0; n < 2; ++n)
#pragma unroll
                for (int j = 0; j < 4; ++j) { const float a = acc[ai][0][m][n][j], b = acc[ai][1][m][n][j]; o[n][j] = MODE == 0 ? a * fsigmoid(b) : fsilu(a) * b; }
            *(u32x4*)(O + (size_t)(row - rsub) * ldc + col0) = pack_f4f4(o[0], o[1]);
        EPI_ROWS_END
    }
};
struct EpiGate {
    static constexpr bool PERM = true;
    const float* bmg; u32x4* gscr; float ds;
    __device__ __forceinline__ void operator()(const f32x4 (&acc)[2][2][4][2], const GUnit& u, int wr, int wc, int fr, int fq) const {
        const int n = u.z, tid = (wr * 4 + wc) * 64 + fq * 16 + fr;
#pragma unroll
        for (int bj = 0; bj < 2; ++bj) {
            const float* bp = bmg + n * 1024 + u.pn * BM + bj * HALF + wc * 32 + 8 * fq;
            const f32x4 b0 = *(const f32x4*)bp, b1 = *(const f32x4*)(bp + 4);
#pragma unroll
            for (int ai = 0; ai < 2; ++ai)
#pragma unroll
                for (int m = 0; m < 4; ++m) { f32x4 g0 = acc[ai][bj][m][0] * ds + b0, g1 = acc[ai][bj][m][1] * ds + b1;
#pragma unroll
                    for (int j = 0; j < 4; ++j) { g0[j] = fsigmoid(g0[j]); g1[j] = fsigmoid(g1[j]); }
                    gscr[((n * 8 + (tid >> 6)) * 16 + (ai * 4 + m) * 2 + bj) * 64 + (tid & 63)] = pack_f4f4(g0, g1); asm volatile("" ::: "memory"); }
        }
    }
};
struct EpiMergeP {
    static constexpr bool PERM = true;
    bf16* M; const u32x4* gscr;
    __device__ __forceinline__ void operator()(const f32x4 (&acc)[2][2][4][2], const GUnit& u, int wr, int wc, int fr, int fq) const {
        const int n = u.z, tid = (wr * 4 + wc) * 64 + fq * 16 + fr;
        const int col0 = u.pn * BM + wc * 32 + 8 * fq;
        EPI_ROWS_BEGIN
#pragma unroll
            for (int bj = 0; bj < 2; ++bj) {
                float g[8], p[8]; unpack8(gscr[((n * 8 + (tid >> 6)) * 16 + (ai * 4 + m) * 2 + bj) * 64 + (tid & 63)], g);
                bf16* dst = M + (size_t)row * 1024 + col0 + bj * HALF;
                if (n > 0) unpack8(*(const u32x4*)dst, p);
#pragma unroll
                for (int j = 0; j < 8; ++j) { const float v = g[j] * acc[ai][bj][m][j >> 2][j & 3]; p[j] = n > 0 ? p[j] + v : v; }
                *(u32x4*)dst = pack8(p);
            }
            asm volatile("" ::: "memory");
        EPI_ROWS_END
    }
};
template <bool OUT8> struct EpiPairS {
    static constexpr bool PERM = true;
    unsigned char* O; int ldc; int rsub; float ds, os;
    __device__ __forceinline__ void operator()(const f32x4 (&acc)[2][2][4][2], const GUnit& u, int wr, int wc, int fr, int fq) const {
        const int col0 = u.pn * 128 + wc * 32 + 8 * fq;
        EPI_ROWS_BEGIN
            float o[8];
#pragma unroll
            for (int n = 0; n < 2; ++n)
#pragma unroll
                for (int j = 0; j < 4; ++j) { const float a = acc[ai][0][m][n][j] * ds, b = acc[ai][1][m][n][j]; o[4 * n + j] = fsilu(a) * b * (ds * os); }
            if constexpr (OUT8) *(u32x2*)(O + (size_t)(row - rsub) * ldc + col0) = (u32x2){pk_fp8x4(o[0], o[1], o[2], o[3]), pk_fp8x4(o[4], o[5], o[6], o[7])};
            else *(u32x4*)((bf16*)O + (size_t)(row - rsub) * ldc + col0) = pack8(o);
            asm volatile("" ::: "memory");
        EPI_ROWS_END
    }
};
struct EpiF32S {
    static constexpr bool PERM = false;
    float* C; int ldc; float ds;
    __device__ __forceinline__ void operator()(const f32x4 (&acc)[2][2][4][2], const GUnit& u, int wr, int wc, int fr, int fq) const {
        const int col0 = u.pn * BM + wc * 32 + 4 * fq;
        EPI_ROWS_BEGIN
            float* rowp = C + (size_t)row * ldc + col0;
#pragma unroll
            for (int bj = 0; bj < 2; ++bj)
#pragma unroll
                for (int n = 0; n < 2; ++n) *(f32x4*)(rowp + bj * HALF + n * 16) = acc[ai][bj][m][n] * ds;
        EPI_ROWS_END
    }
};
struct EpiBf16S {
    static constexpr bool PERM = true;
    bf16* O; int ldc; float ds;
    __device__ __forceinline__ void operator()(const f32x4 (&acc)[2][2][4][2], const GUnit& u, int wr, int wc, int fr, int fq) const {
        const int col0 = u.pn * BM + wc * 32 + 8 * fq;
        EPI_ROWS_BEGIN
            bf16* rowp = O + (size_t)row * ldc + col0;
#pragma unroll
            for (int bj = 0; bj < 2; ++bj) *(u32x4*)(rowp + bj * HALF) = pack_f4f4(acc[ai][bj][m][0] * ds, acc[ai][bj][m][1] * ds);
        EPI_ROWS_END
    }
};
#undef EPI_ROWS_BEGIN
#undef EPI_ROWS_END
}

namespace att {
__device__ __forceinline__ float swap32_max(float v) { const auto rr = __builtin_amdgcn_permlane32_swap(__float_as_uint(v), __float_as_uint(v), false, false); return __builtin_fmaxf(__uint_as_float(rr[0]), __uint_as_float(rr[1])); }
__device__ __forceinline__ float swap32_sum(float v) { const auto rr = __builtin_amdgcn_permlane32_swap(__float_as_uint(v), __float_as_uint(v), false, false); return __uint_as_float(rr[0]) + __uint_as_float(rr[1]); }
constexpr int VSLOT = 8192, NSLOT = 3;
__device__ __forceinline__ int crow(int r, int hi) { return (r & 3) + 8 * (r >> 2) + 4 * hi; }
__device__ __forceinline__ void glds16(const void* gsrc, unsigned lds_dst) { unsigned keep;
    asm volatile("s_mov_b32 %0, m0\n\ts_mov_b32 m0, %2\n\ts_nop 0\n\tglobal_load_lds_dwordx4 %1, off\n\ts_mov_b32 m0, %0" : "=&s"(keep) : "v"(gsrc), "s"(lds_dst) : "memory"); }
typedef short v4i16_t __attribute__((ext_vector_type(4)));
__device__ __forceinline__ s16x4 vtr(const LAS unsigned char* p) { return __builtin_bit_cast(s16x4, __builtin_amdgcn_ds_read_tr16_b64_v4i16((LAS v4i16_t*)p)); }

struct AttnArgs {
    const bf16* Q; int qpitch, qcol; long qrow0;
    const bf16* K1; int k1pitch, k1col;
    const bf16* K2; int k2pitch;
    const bf16* V; int vpitch, vcol;
    bf16* O; int opitch, ocol;
    int b, ntiles;
};
template <int DK> __device__ __forceinline__ void attn_unit(const AttnArgs& A, LAS unsigned char* lds, int wave_) {
    constexpr int NKS = DK / 16, KSLOT = (DK / 8) * 1024, NKSLOT = 4, NVSLOT = 4; constexpr float THR = 8.f;
    constexpr bool NOMAX = (DK == 64);
    constexpr int LDS_K = 0, LDS_V = NKSLOT * KSLOT, LDS_WS = LDS_V + NVSLOT * VSLOT;
    int tid = wave_ * 64 + lane_id(); asm volatile("" : "+v"(tid));
    const int lane = tid & 63, r32 = lane & 31, hi = lane >> 5; const int wid = __builtin_amdgcn_readfirstlane(tid >> 6);
    const unsigned lds0 = (unsigned)(uintptr_t)lds;
    LAS float* wsf = (LAS float*)(lds + LDS_WS) + wid * 64;
    const int NT = A.ntiles, b = A.b;
#define TILE_ROW(j) ((j) < 4 ? (long)(NLAT + b * CTXL + 64 * (j)) : (long)(b * SEQ + 64 * ((j) - 4)))
#define DMA_K(j) do { const long r0_ = TILE_ROW(j); const int s_ = (j) & 3; \
        glds16(A.K1 + (r0_ + lane) * A.k1pitch + A.k1col + wid * 8, (unsigned)__builtin_amdgcn_readfirstlane(lds0 + LDS_K + s_ * KSLOT + wid * 1024)); \
        if (DK == 96 && wid < 4) glds16(A.K2 + (r0_ + lane) * A.k2pitch + wid * 8, (unsigned)__builtin_amdgcn_readfirstlane(lds0 + LDS_K + s_ * KSLOT + (8 + wid) * 1024)); } while (0)
#define DMA_V(j) do { const long r0_ = TILE_ROW(j); const int s_ = (j) & 3; \
        glds16(A.V + (r0_ + 16 * (wid & 3) + (lane >> 2)) * A.vpitch + A.vcol + (wid >> 2) * 32 + (lane & 3) * 8, (unsigned)__builtin_amdgcn_readfirstlane(lds0 + LDS_V + (s_) * VSLOT + wid * 1024)); } while (0)
#define WAITBAR(n) asm volatile("s_waitcnt vmcnt(" #n ") lgkmcnt(0)\n\ts_barrier" ::: "memory")
#define WAIT_CNT(cnt) do { const int c_ = (cnt); if (c_ >= 3) WAITBAR(3); else if (c_ == 2) WAITBAR(2); else if (c_ == 1) WAITBAR(1); else WAITBAR(0); } while (0)
#define QK(S0, S1, slot) do { const LAS unsigned char* Ks_ = lds + LDS_K + (slot) * KSLOT + hi * 1024 + r32 * 16; \
        _Pragma("unroll") for (int ks = 0; ks < NKS; ++ks) { const bf16x8 k0_ = *(const LAS bf16x8*)(Ks_ + ks * 2048), k1_ = *(const LAS bf16x8*)(Ks_ + ks * 2048 + 512); \
            S0 = __builtin_amdgcn_mfma_f32_32x32x16_bf16(k0_, qr[ks], ks == 0 ? (NOMAX ? f32x16{} : negm) : S0, 0, 0, 0); S1 = __builtin_amdgcn_mfma_f32_32x32x16_bf16(k1_, qr[ks], ks == 0 ? (NOMAX ? f32x16{} : negm) : S1, 0, 0, 0); } } while (0)
    const int nK = (DK == 96 && wid < 4) ? 2 : 1;
    bf16x8 qr[NKS];
    { const bf16* Qw = A.Q + (A.qrow0 + wid * 32 + r32) * A.qpitch + A.qcol + hi * 8;
#pragma unroll
      for (int ks = 0; ks < NKS; ++ks) qr[ks] = *(const bf16x8*)(Qw + ks * 16); }
    asm volatile("s_waitcnt vmcnt(0)" ::: "memory");
    DMA_K(0); DMA_V(0); DMA_K(1); DMA_K(2); DMA_V(1);
    float mref = 0.f, lsum = 0.f; f32x16 o[2]; o[0] = f32x16{}; o[1] = f32x16{};
    f32x16 negm = f32x16{};
    const int vb = (4 * hi + ((lane & 15) >> 2)) * 64 + ((lane >> 4) & 1) * 32 + (lane & 3) * 8;
    f32x16 s0, s1;
    WAITBAR(0);
    QK(s0, s1, 0);
    if constexpr (!NOMAX) { float rm = __builtin_fmaxf(s0[0], s1[0]);
#pragma unroll
      for (int r = 1; r < 16; ++r) rm = __builtin_fmaxf(__builtin_fmaxf(rm, s0[r]), s1[r]);
      rm = swap32_max(rm); mref = rm;
#pragma unroll
      for (int r = 0; r < 16; ++r) { s0[r] -= rm; s1[r] -= rm; negm[r] = -rm; } }
    int vslot = 0;
#define HEAD(t) do { WAITBAR(0);        \
        if ((t) + 3 < NT) DMA_K((t) + 3); if ((t) + 4 < NT) DMA_K((t) + 4); \
        if ((t) + 2 < NT) DMA_V((t) + 2); if ((t) + 3 < NT) DMA_V((t) + 3); } while (0)
#define QKP(N0, N1, t) do { if ((t) + 1 < NT) { const LAS unsigned char* Ks_ = lds + LDS_K + (((t) + 1) & 3) * KSLOT + hi * 1024 + r32 * 16; \
            _Pragma("unroll") for (int kh = 0; kh < 2; ++kh) { bf16x8 kf[NKS]; \
                _Pragma("unroll") for (int k2 = 0; k2 < NKS / 2; ++k2) { const int ks = kh * (NKS / 2) + k2; kf[2 * k2] = *(const LAS bf16x8*)(Ks_ + ks * 2048); kf[2 * k2 + 1] = *(const LAS bf16x8*)(Ks_ + ks * 2048 + 512); } \
                __builtin_amdgcn_s_setprio(1); \
                _Pragma("unroll") for (int k2 = 0; k2 < NKS / 2; ++k2) { const int ks = kh * (NKS / 2) + k2; \
                    N0 = __builtin_amdgcn_mfma_f32_32x32x16_bf16(kf[2 * k2], qr[ks], ks == 0 ? (NOMAX ? f32x16{} : negm) : N0, 0, 0, 0); N1 = __builtin_amdgcn_mfma_f32_32x32x16_bf16(kf[2 * k2 + 1], qr[ks], ks == 0 ? (NOMAX ? f32x16{} : negm) : N1, 0, 0, 0); } \
                __builtin_amdgcn_s_setprio(0); } } } while (0)
#define SMP(C0, C1, N0, N1, t, NREADY) do { if constexpr (!NOMAX) { \
        float rm = __builtin_fmaxf(C0[0], C1[0]); \
        _Pragma("unroll") for (int r = 1; r < 16; ++r) rm = __builtin_fmaxf(__builtin_fmaxf(rm, C0[r]), C1[r]); \
        rm = swap32_max(rm); \
        if (__builtin_expect(__any(rm > THR), 0)) { \
            const float dl = __builtin_fmaxf(rm, 0.f), al = __builtin_amdgcn_exp2f(-dl); \
            mref += dl; lsum *= al; \
            _Pragma("unroll") for (int r = 0; r < 16; ++r) { C0[r] -= dl; C1[r] -= dl; negm[r] = -mref; } \
            if (NREADY && (t) + 1 < NT) { _Pragma("unroll") for (int r = 0; r < 16; ++r) { N0[r] -= dl; N1[r] -= dl; } } \
            if (hi == 0) wsf[r32] = al; \
            asm volatile("s_waitcnt lgkmcnt(0)" ::: "memory"); \
            _Pragma("unroll") for (int rq = 0; rq < 4; ++rq) { const f32x4 a4 = *(const LAS f32x4*)(wsf + 8 * rq + 4 * hi); \
                _Pragma("unroll") for (int j = 0; j < 4; ++j) { o[0][4 * rq + j] *= a4[j]; o[1][4 * rq + j] *= a4[j]; } } \
        } } \
        float ps0 = 0.f, ps1 = 0.f, ps2 = 0.f, ps3 = 0.f; \
        _Pragma("unroll") for (int r = 0; r < 16; r += 2) { C0[r] = __builtin_amdgcn_exp2f(C0[r]); C1[r] = __builtin_amdgcn_exp2f(C1[r]); C0[r + 1] = __builtin_amdgcn_exp2f(C0[r + 1]); C1[r + 1] = __builtin_amdgcn_exp2f(C1[r + 1]); \
            ps0 += C0[r]; ps1 += C1[r]; ps2 += C0[r + 1]; ps3 += C1[r + 1]; } \
        lsum += (ps0 + ps1) + (ps2 + ps3); \
        pw[0] = (u32x4){pk2(C0[0], C0[1]), pk2(C0[2], C0[3]), pk2(C0[4], C0[5]), pk2(C0[6], C0[7])}; \
        pw[1] = (u32x4){pk2(C0[8], C0[9]), pk2(C0[10], C0[11]), pk2(C0[12], C0[13]), pk2(C0[14], C0[15])}; \
        pw[2] = (u32x4){pk2(C1[0], C1[1]), pk2(C1[2], C1[3]), pk2(C1[4], C1[5]), pk2(C1[6], C1[7])}; \
        pw[3] = (u32x4){pk2(C1[8], C1[9]), pk2(C1[10], C1[11]), pk2(C1[12], C1[13]), pk2(C1[14], C1[15])}; } while (0)
#define PVP() do { const LAS unsigned char* Vs = lds + LDS_V + vslot * VSLOT + vb; \
        _Pragma("unroll") for (int d0 = 0; d0 < 2; ++d0) { s16x4 vlo[4], vhh[4]; \
            _Pragma("unroll") for (int i = 0; i < 4; ++i) { vlo[i] = vtr(Vs + d0 * 4096 + i * 1024); vhh[i] = vtr(Vs + d0 * 4096 + i * 1024 + 512); } \
            __builtin_amdgcn_s_setprio(1); \
            _Pragma("unroll") for (int ks = 0; ks < 4; ++ks) { \
                const bf16x8 vf = (bf16x8){vlo[ks][0], vlo[ks][1], vlo[ks][2], vlo[ks][3], vhh[ks][0], vhh[ks][1], vhh[ks][2], vhh[ks][3]}; \
                o[d0] = __builtin_amdgcn_mfma_f32_32x32x16_bf16(__builtin_bit_cast(bf16x8, pw[ks]), vf, o[d0], 0, 0, 0); } \
            __builtin_amdgcn_s_setprio(0); } \
        vslot = (vslot + 1) & 3; } while (0)
    f32x16 n0, n1; u32x4 pw[4];
    if (wid < 8) {
        for (int t = 0; t < NT; t += 2) {
            HEAD(t); QKP(n0, n1, t); SMP(s0, s1, n0, n1, t, 1); PVP();
            QKP(s0, s1, t + 1); SMP(n0, n1, s0, s1, t + 1, 1); PVP(); }
    } else {
        for (int t = 0; t < NT; t += 2) {
            HEAD(t); SMP(s0, s1, n0, n1, t, 0); PVP(); QKP(n0, n1, t);
            SMP(n0, n1, s0, s1, t + 1, 0); PVP(); QKP(s0, s1, t + 1); }
    }
#undef HEAD
#undef QKP
#undef SMP
#undef PVP
    lsum = swap32_sum(lsum);
    if (hi == 0) wsf[32 + r32] = __builtin_amdgcn_rcpf(lsum);
    asm volatile("s_waitcnt vmcnt(0) lgkmcnt(0)\n\ts_barrier" ::: "memory");
    { LAS bf16* stg = (LAS bf16*)(lds + wid * 4096);
#pragma unroll
      for (int rq = 0; rq < 4; ++rq) { const f32x4 i4 = *(const LAS f32x4*)(wsf + 32 + 8 * rq + 4 * hi);
#pragma unroll
          for (int j = 0; j < 4; ++j) { const int q = 8 * rq + 4 * hi + j;
              stg[q * 64 + r32] = (bf16)f2bf(o[0][4 * rq + j] * i4[j]); stg[q * 64 + 32 + r32] = (bf16)f2bf(o[1][4 * rq + j] * i4[j]); } }
      asm volatile("s_waitcnt lgkmcnt(0)" ::: "memory");
      bf16* Ow = A.O + (A.qrow0 + wid * 32) * A.opitch + A.ocol;
#pragma unroll
      for (int i = 0; i < 4; ++i) { const int row = i * 8 + (lane >> 3), ch = lane & 7; *(u32x4*)(Ow + (long)row * A.opitch + ch * 8) = *(const LAS u32x4*)(stg + row * 64 + ch * 8); } }
    asm volatile("s_waitcnt vmcnt(0) lgkmcnt(0)\n\ts_barrier" ::: "memory");
#undef TILE_ROW
#undef DMA_K
#undef DMA_V
#undef WAITBAR
#undef WAIT_CNT
#undef QK
}

template <int DK> __device__ __forceinline__ void attn_unit3(const AttnArgs& A, LAS unsigned char* lds, int wave_) {
    constexpr int NKS = DK / 16, KSLOT = (DK / 8) * 1024, NKSLOT = 4, NVSLOT = 4;
    constexpr int LDS_K = 0, LDS_V = NKSLOT * KSLOT, LDS_WS = LDS_V + NVSLOT * VSLOT;
    int tid = wave_ * 64 + lane_id(); asm volatile("" : "+v"(tid));
    const int lane = tid & 63, r32 = lane & 31, hi = lane >> 5; const int wid = __builtin_amdgcn_readfirstlane(tid >> 6);
    const unsigned lds0 = (unsigned)(uintptr_t)lds;
    LAS float* wsf = (LAS float*)(lds + LDS_WS) + wid * 64;
    const int NT = A.ntiles, b = A.b;
#define TILE_ROW(j) ((j) < 4 ? (long)(NLAT + b * CTXL + 64 * (j)) : (long)(b * SEQ + 64 * ((j) - 4)))
#define DMA_K(j) do { const long r0_ = TILE_ROW(j); const int s_ = (j) & 3; \
        glds16(A.K1 + (r0_ + lane) * A.k1pitch + A.k1col + wid * 8, (unsigned)__builtin_amdgcn_readfirstlane(lds0 + LDS_K + s_ * KSLOT + wid * 1024)); \
        if (DK == 96 && wid < 4) glds16(A.K2 + (r0_ + lane) * A.k2pitch + wid * 8, (unsigned)__builtin_amdgcn_readfirstlane(lds0 + LDS_K + s_ * KSLOT + (8 + wid) * 1024)); } while (0)
#define DMA_V(j) do { const long r0_ = TILE_ROW(j); const int s_ = (j) & 3; \
        glds16(A.V + (r0_ + 16 * (wid & 3) + (lane >> 2)) * A.vpitch + A.vcol + (wid >> 2) * 32 + (lane & 3) * 8, (unsigned)__builtin_amdgcn_readfirstlane(lds0 + LDS_V + (s_) * VSLOT + wid * 1024)); } while (0)
#define WAITBAR(n) asm volatile("s_waitcnt vmcnt(" #n ") lgkmcnt(0)\n\ts_barrier" ::: "memory")
    bf16x8 qr[NKS];
    { const bf16* Qw = A.Q + (A.qrow0 + wid * 32 + r32) * A.qpitch + A.qcol + hi * 8;
#pragma unroll
      for (int ks = 0; ks < NKS; ++ks) qr[ks] = *(const bf16x8*)(Qw + ks * 16); }
    asm volatile("s_waitcnt vmcnt(0)" ::: "memory");
    DMA_K(0); DMA_K(1); DMA_V(0); DMA_K(2); DMA_K(3); DMA_V(1);
    float ls0 = 0.f, ls1 = 0.f, ls2 = 0.f, ls3 = 0.f; f32x16 o[2]; o[0] = f32x16{}; o[1] = f32x16{};
    const int vb = (4 * hi + ((lane & 15) >> 2)) * 64 + ((lane >> 4) & 1) * 32 + (lane & 3) * 8;
    const LAS unsigned char* Kb = lds + LDS_K + hi * 1024 + r32 * 16;
    const LAS unsigned char* Vb = lds + LDS_V + vb;
#define QKH(S0, S1, j, kh) do { const LAS unsigned char* Ks_ = Kb + ((j) & 3) * KSLOT; bf16x8 kf[NKS]; \
        _Pragma("unroll") for (int k2 = 0; k2 < NKS / 2; ++k2) { const int ks = (kh) * (NKS / 2) + k2; kf[2 * k2] = *(const LAS bf16x8*)(Ks_ + ks * 2048); kf[2 * k2 + 1] = *(const LAS bf16x8*)(Ks_ + ks * 2048 + 512); } \
        _Pragma("unroll") for (int k2 = 0; k2 < NKS / 2; ++k2) { const int ks = (kh) * (NKS / 2) + k2; \
            S0 = __builtin_amdgcn_mfma_f32_32x32x16_bf16(kf[2 * k2], qr[ks], ks == 0 ? f32x16{} : S0, 0, 0, 0); S1 = __builtin_amdgcn_mfma_f32_32x32x16_bf16(kf[2 * k2 + 1], qr[ks], ks == 0 ? f32x16{} : S1, 0, 0, 0); } } while (0)
#define PVH(PW, j, d0) do { const LAS unsigned char* Vs_ = Vb + ((j) & 3) * VSLOT + (d0) * 4096; s16x4 vlo[4], vhh[4]; \
        _Pragma("unroll") for (int i = 0; i < 4; ++i) { vlo[i] = vtr(Vs_ + i * 1024); vhh[i] = vtr(Vs_ + i * 1024 + 512); } \
        _Pragma("unroll") for (int ks = 0; ks < 4; ++ks) { const bf16x8 vf = (bf16x8){vlo[ks][0], vlo[ks][1], vlo[ks][2], vlo[ks][3], vhh[ks][0], vhh[ks][1], vhh[ks][2], vhh[ks][3]}; \
            o[d0] = __builtin_amdgcn_mfma_f32_32x32x16_bf16(__builtin_bit_cast(bf16x8, PW[ks]), vf, o[d0], 0, 0, 0); } } while (0)
#define SOFT(C0, C1, PW) do { \
        _Pragma("unroll") for (int r = 0; r < 16; r += 2) { C0[r] = __builtin_amdgcn_exp2f(C0[r]); C1[r] = __builtin_amdgcn_exp2f(C1[r]); C0[r + 1] = __builtin_amdgcn_exp2f(C0[r + 1]); C1[r + 1] = __builtin_amdgcn_exp2f(C1[r + 1]); \
            ls0 += C0[r]; ls1 += C1[r]; ls2 += C0[r + 1]; ls3 += C1[r + 1]; } \
        PW[0] = (u32x4){pk2(C0[0], C0[1]), pk2(C0[2], C0[3]), pk2(C0[4], C0[5]), pk2(C0[6], C0[7])}; \
        PW[1] = (u32x4){pk2(C0[8], C0[9]), pk2(C0[10], C0[11]), pk2(C0[12], C0[13]), pk2(C0[14], C0[15])}; \
        PW[2] = (u32x4){pk2(C1[0], C1[1]), pk2(C1[2], C1[3]), pk2(C1[4], C1[5]), pk2(C1[6], C1[7])}; \
        PW[3] = (u32x4){pk2(C1[8], C1[9]), pk2(C1[10], C1[11]), pk2(C1[12], C1[13]), pk2(C1[14], C1[15])}; } while (0)
#define HINTS() do { _Pragma("unroll") for (int h_ = 0; h_ < 2; ++h_) { __builtin_amdgcn_sched_group_barrier(0x100, NKS + 8, 0); \
            _Pragma("unroll") for (int g_ = 0; g_ < NKS + 4; ++g_) { __builtin_amdgcn_sched_group_barrier(0x008, 1, 0); __builtin_amdgcn_sched_group_barrier(0x400, 2, 0); __builtin_amdgcn_sched_group_barrier(0x002, 3, 0); } } } while (0)
#define STEP3(N0, N1, C0, C1, PN, PC, t) do { __builtin_amdgcn_sched_barrier(0); \
        QKH(N0, N1, (t) + 2, 0); PVH(PC, t, 0); QKH(N0, N1, (t) + 2, 1); PVH(PC, t, 1); SOFT(C0, C1, PN); HINTS(); __builtin_amdgcn_sched_barrier(0); } while (0)
    f32x16 sA0, sA1, sB0, sB1; u32x4 pA[4], pB[4];
    WAITBAR(0);
    QKH(sA0, sA1, 0, 0); QKH(sA0, sA1, 0, 1); QKH(sB0, sB1, 1, 0); QKH(sB0, sB1, 1, 1);
    SOFT(sA0, sA1, pA);
    int t = 0;
    for (; t + 3 < NT; t += 2) {
        WAITBAR(0);
        if (t + 4 < NT) DMA_K(t + 4); if (t + 5 < NT) DMA_K(t + 5); if (t + 2 < NT) DMA_V(t + 2); if (t + 3 < NT) DMA_V(t + 3);
        STEP3(sA0, sA1, sB0, sB1, pB, pA, t);
        STEP3(sB0, sB1, sA0, sA1, pA, pB, t + 1);
    }
    WAITBAR(0);
    __builtin_amdgcn_sched_barrier(0);
    PVH(pA, t, 0); PVH(pA, t, 1); SOFT(sB0, sB1, pB);
    __builtin_amdgcn_sched_barrier(0);
    PVH(pB, t + 1, 0); PVH(pB, t + 1, 1);
    float lsum = (ls0 + ls1) + (ls2 + ls3);
    lsum = swap32_sum(lsum);
    if (hi == 0) wsf[32 + r32] = __builtin_amdgcn_rcpf(lsum);
    asm volatile("s_waitcnt vmcnt(0) lgkmcnt(0)\n\ts_barrier" ::: "memory");
    { LAS bf16* stg = (LAS bf16*)(lds + wid * 4096);
#pragma unroll
      for (int rq = 0; rq < 4; ++rq) { const f32x4 i4 = *(const LAS f32x4*)(wsf + 32 + 8 * rq + 4 * hi);
#pragma unroll
          for (int j = 0; j < 4; ++j) { const int q = 8 * rq + 4 * hi + j;
              stg[q * 64 + r32] = (bf16)f2bf(o[0][4 * rq + j] * i4[j]); stg[q * 64 + 32 + r32] = (bf16)f2bf(o[1][4 * rq + j] * i4[j]); } }
      asm volatile("s_waitcnt lgkmcnt(0)" ::: "memory");
      bf16* Ow = A.O + (A.qrow0 + wid * 32) * A.opitch + A.ocol;
#pragma unroll
      for (int i = 0; i < 4; ++i) { const int row = i * 8 + (lane >> 3), ch = lane & 7; *(u32x4*)(Ow + (long)row * A.opitch + ch * 8) = *(const LAS u32x4*)(stg + row * 64 + ch * 8); } }
    asm volatile("s_waitcnt vmcnt(0) lgkmcnt(0)\n\ts_barrier" ::: "memory");
#undef TILE_ROW
#undef DMA_K
#undef DMA_V
#undef WAITBAR
#undef QKH
#undef PVH
#undef SOFT
#undef HINTS
#undef STEP3
}

#define ASBAR() __builtin_amdgcn_sched_barrier(0)
#define APIN(x) asm volatile("" : "+v"(x))
template <int DK> __device__ __forceinline__ void attn_unit4(const AttnArgs& A, LAS unsigned char* lds, int wave_) {
    constexpr int NKS = DK / 16, KSLOT = (DK / 8) * 1024, NKSLOT = 4, NVSLOT = 4;
    constexpr int LDS_K = 0, LDS_V = NKSLOT * KSLOT, LDS_WS = LDS_V + NVSLOT * VSLOT;
    int tid = wave_ * 64 + lane_id(); asm volatile("" : "+v"(tid));
    const int lane = tid & 63, r32 = lane & 31, hi = lane >> 5; const int wid = __builtin_amdgcn_readfirstlane(tid >> 6);
    const unsigned lds0 = (unsigned)(uintptr_t)lds;
    LAS float* wsf = (LAS float*)(lds + LDS_WS) + wid * 64;
    const int NT = A.ntiles, b = A.b;
#define TILE_ROW(j) ((j) < 4 ? (long)(NLAT + b * CTXL + 64 * (j)) : (long)(b * SEQ + 64 * ((j) - 4)))
#define DMA_K(j) do { const long r0_ = TILE_ROW(j); const int s_ = (j) & 3; \
        glds16(A.K1 + (r0_ + lane) * A.k1pitch + A.k1col + wid * 8, (unsigned)__builtin_amdgcn_readfirstlane(lds0 + LDS_K + s_ * KSLOT + wid * 1024)); \
        if (DK == 96 && wid < 4) glds16(A.K2 + (r0_ + lane) * A.k2pitch + wid * 8, (unsigned)__builtin_amdgcn_readfirstlane(lds0 + LDS_K + s_ * KSLOT + (8 + wid) * 1024)); } while (0)
#define DMA_V(j) do { const long r0_ = TILE_ROW(j); const int s_ = (j) & 3; \
        glds16(A.V + (r0_ + 16 * (wid & 3) + (lane >> 2)) * A.vpitch + A.vcol + (wid >> 2) * 32 + (lane & 3) * 8, (unsigned)__builtin_amdgcn_readfirstlane(lds0 + LDS_V + (s_) * VSLOT + wid * 1024)); } while (0)
#define WAITBAR(n) asm volatile("s_waitcnt vmcnt(" #n ") lgkmcnt(0)\n\ts_barrier" ::: "memory")
    bf16x8 qr[NKS];
    { const bf16* Qw = A.Q + (A.qrow0 + wid * 32 + r32) * A.qpitch + A.qcol + hi * 8;
#pragma unroll
      for (int ks = 0; ks < NKS; ++ks) qr[ks] = *(const bf16x8*)(Qw + ks * 16); }
    asm volatile("s_waitcnt vmcnt(0)" ::: "memory");
    DMA_K(0); DMA_K(1); DMA_V(0); DMA_K(2); DMA_K(3); DMA_V(1);
    float lsum = 0.f; f32x16 o[2]; o[0] = f32x16{}; o[1] = f32x16{};
    const LAS unsigned char* Kb = lds + LDS_K + hi * 1024 + r32 * 16;
    const LAS unsigned char* Vb = lds + LDS_V + (4 * hi + ((lane & 15) >> 2)) * 64 + ((lane >> 4) & 1) * 32 + (lane & 3) * 8;
    f32x16 pA0, pA1, pB0, pB1; bf16x8 kf[2 * NKS]; s16x4 vlo[8], vhi[8]; u32x4 pw0, pw1, pw2, pw3;
#define MF(a, b, c) __builtin_amdgcn_mfma_f32_32x32x16_bf16(a, b, c, 0, 0, 0)
#define KLD2(kp, d0) do { kf[2 * (d0)] = *(const LAS bf16x8*)((kp) + (d0) * 2048); kf[2 * (d0) + 1] = *(const LAS bf16x8*)((kp) + (d0) * 2048 + 512); } while (0)
#define PKW(P, i) pk2(P[i], P[(i) + 1])
#define PAF(k) __builtin_bit_cast(bf16x8, pw##k)
#define VFR(i) (bf16x8){vlo[i][0], vlo[i][1], vlo[i][2], vlo[i][3], vhi[i][0], vhi[i][1], vhi[i][2], vhi[i][3]}
#define VRD(i) do { vlo[i] = vtr(vp_ + (((i) >> 2) * 4096 + ((i) & 3) * 1024)); vhi[i] = vtr(vp_ + (((i) >> 2) * 4096 + ((i) & 3) * 1024 + 512)); } while (0)
#define KRD(G, d0) do { if (G) { KLD2(kn_, d0); ASBAR(); } } while (0)
#define EX(v) __builtin_amdgcn_exp2f(v)
#define GAPA(MFS, a0, a1, a2, a3, W0, W1, PW) do { MFS; sacc += a0; sacc += a1; sacc += a2; sacc += a3; W0; W1; APIN(PW); APIN(sacc); ASBAR(); } while (0)
#define GAPB(MFS, X, i) do { MFS; X[i] = EX(X[i]); X[(i) + 1] = EX(X[(i) + 1]); X[(i) + 2] = EX(X[(i) + 2]); X[(i) + 3] = EX(X[(i) + 3]); APIN(X); ASBAR(); } while (0)
#define STEP4(C0, C1, P0, P1, t, GL) do { ASBAR(); \
    const LAS unsigned char* vp_ = Vb + (((t) - 1) & 3) * VSLOT; const LAS unsigned char* kn_ = Kb + (((t) + 1) & 3) * KSLOT; \
    VRD(0); ASBAR(); float sacc = P0[0] + P0[1]; \
                     GAPA(C0 = MF(kf[0], qr[0], f32x16{}), P0[2], P0[3], P0[4], P0[5],     pw0[0] = PKW(P0, 0),  pw0[1] = PKW(P0, 2),  pw0); \
    VRD(4); ASBAR(); GAPA(C1 = MF(kf[1], qr[0], f32x16{}), P0[6], P0[7], P0[8], P0[9],     pw0[2] = PKW(P0, 4),  pw0[3] = PKW(P0, 6),  pw0); \
    VRD(1); ASBAR(); GAPA(C0 = MF(kf[2], qr[1], C0),       P0[10], P0[11], P0[12], P0[13], pw1[0] = PKW(P0, 8),  pw1[1] = PKW(P0, 10), pw1); \
    VRD(5); ASBAR(); GAPA(C1 = MF(kf[3], qr[1], C1),       P0[14], P0[15], P1[0], P1[1],   pw1[2] = PKW(P0, 12), pw1[3] = PKW(P0, 14), pw1); \
    VRD(2); ASBAR(); GAPA(C0 = MF(kf[4], qr[2], C0),       P1[2], P1[3], P1[4], P1[5],     pw2[0] = PKW(P1, 0),  pw2[1] = PKW(P1, 2),  pw2); \
    VRD(6); ASBAR(); GAPA(C1 = MF(kf[5], qr[2], C1),       P1[6], P1[7], P1[8], P1[9],     pw2[2] = PKW(P1, 4),  pw2[3] = PKW(P1, 6),  pw2); \
    VRD(3); ASBAR(); GAPA(C0 = MF(kf[6], qr[3], C0),       P1[10], P1[11], P1[12], P1[13], pw3[0] = PKW(P1, 8),  pw3[1] = PKW(P1, 10), pw3); \
    VRD(7); ASBAR(); GAPA(C1 = MF(kf[7], qr[3], C1),       P1[14], P1[15], 0.f, 0.f,       pw3[2] = PKW(P1, 12), pw3[3] = PKW(P1, 14), pw3); \
    if (NKS == 6) { C0 = MF(kf[2 * (NKS - 2)], qr[NKS - 2], C0); C1 = MF(kf[2 * (NKS - 2) + 1], qr[NKS - 2], C1); C0 = MF(kf[2 * (NKS - 1)], qr[NKS - 1], C0); C1 = MF(kf[2 * (NKS - 1) + 1], qr[NKS - 1], C1); ASBAR(); } \
    lsum += sacc; ASBAR(); \
    GAPB(o[0] = MF(PAF(0), VFR(0), o[0]), C0, 0);               KRD((GL) && NKS == 6, 4); GAPB(o[1] = MF(PAF(0), VFR(4), o[1]), C0, 4); \
    KRD(GL, 0); GAPB(o[0] = MF(PAF(1), VFR(1), o[0]), C0, 8);   KRD(GL, 1); GAPB(o[1] = MF(PAF(1), VFR(5), o[1]), C0, 12); \
    KRD(GL, 2); GAPB(o[0] = MF(PAF(2), VFR(2), o[0]), C1, 0);   KRD(GL, 3); GAPB(o[1] = MF(PAF(2), VFR(6), o[1]), C1, 4); \
    KRD((GL) && NKS == 6, 5); GAPB(o[0] = MF(PAF(3), VFR(3), o[0]), C1, 8);   GAPB(o[1] = MF(PAF(3), VFR(7), o[1]), C1, 12); \
    } while (0)
    WAITBAR(0);
#pragma unroll
    for (int d0 = 0; d0 < NKS; ++d0) KLD2(Kb, d0);
#pragma unroll
    for (int d0 = 0; d0 < NKS; ++d0) { pA0 = MF(kf[2 * d0], qr[d0], d0 == 0 ? f32x16{} : pA0); pA1 = MF(kf[2 * d0 + 1], qr[d0], d0 == 0 ? f32x16{} : pA1); }
#pragma unroll
    for (int r = 0; r < 16; ++r) { pA0[r] = EX(pA0[r]); pA1[r] = EX(pA1[r]); }
#pragma unroll
    for (int d0 = 0; d0 < NKS; ++d0) KLD2(Kb + KSLOT, d0);
    int t = 1;
    for (; t + 2 < NT; t += 2) {
        WAITBAR(0);
        if (t + 3 < NT) DMA_K(t + 3); if (t + 4 < NT) DMA_K(t + 4); if (t + 1 < NT) DMA_V(t + 1); if (t + 2 < NT) DMA_V(t + 2);
        STEP4(pB0, pB1, pA0, pA1, t, true);
        STEP4(pA0, pA1, pB0, pB1, t + 1, true);
    }
    WAITBAR(0);
    STEP4(pB0, pB1, pA0, pA1, t, false);
    { ASBAR(); float sacc = pB0[0] + pB0[1];
#pragma unroll
      for (int r = 2; r < 16; ++r) sacc += pB0[r];
#pragma unroll
      for (int r = 0; r < 16; ++r) sacc += pB1[r];
      lsum += sacc;
      pw0 = (u32x4){PKW(pB0, 0), PKW(pB0, 2), PKW(pB0, 4), PKW(pB0, 6)}; pw1 = (u32x4){PKW(pB0, 8), PKW(pB0, 10), PKW(pB0, 12), PKW(pB0, 14)};
      pw2 = (u32x4){PKW(pB1, 0), PKW(pB1, 2), PKW(pB1, 4), PKW(pB1, 6)}; pw3 = (u32x4){PKW(pB1, 8), PKW(pB1, 10), PKW(pB1, 12), PKW(pB1, 14)};
      const LAS unsigned char* vp_ = Vb + (t & 3) * VSLOT;
#pragma unroll
      for (int i = 0; i < 8; ++i) VRD(i);
      o[0] = MF(PAF(0), VFR(0), o[0]); o[1] = MF(PAF(0), VFR(4), o[1]); o[0] = MF(PAF(1), VFR(1), o[0]); o[1] = MF(PAF(1), VFR(5), o[1]);
      o[0] = MF(PAF(2), VFR(2), o[0]); o[1] = MF(PAF(2), VFR(6), o[1]); o[0] = MF(PAF(3), VFR(3), o[0]); o[1] = MF(PAF(3), VFR(7), o[1]); }
    lsum = swap32_sum(lsum);
    if (hi == 0) wsf[32 + r32] = __builtin_amdgcn_rcpf(lsum);
    asm volatile("s_waitcnt vmcnt(0) lgkmcnt(0)\n\ts_barrier" ::: "memory");
    { LAS bf16* stg = (LAS bf16*)(lds + wid * 4096);
#pragma unroll
      for (int rq = 0; rq < 4; ++rq) { const f32x4 i4 = *(const LAS f32x4*)(wsf + 32 + 8 * rq + 4 * hi);
#pragma unroll
          for (int j = 0; j < 4; ++j) { const int q = 8 * rq + 4 * hi + j;
              stg[q * 64 + r32] = (bf16)f2bf(o[0][4 * rq + j] * i4[j]); stg[q * 64 + 32 + r32] = (bf16)f2bf(o[1][4 * rq + j] * i4[j]); } }
      asm volatile("s_waitcnt lgkmcnt(0)" ::: "memory");
      bf16* Ow = A.O + (A.qrow0 + wid * 32) * A.opitch + A.ocol;
#pragma unroll
      for (int i = 0; i < 4; ++i) { const int row = i * 8 + (lane >> 3), ch = lane & 7; *(u32x4*)(Ow + (long)row * A.opitch + ch * 8) = *(const LAS u32x4*)(stg + row * 64 + ch * 8); } }
    asm volatile("s_waitcnt vmcnt(0) lgkmcnt(0)\n\ts_barrier" ::: "memory");
#undef TILE_ROW
#undef DMA_K
#undef DMA_V
#undef WAITBAR
#undef MF
#undef KLD2
#undef PKW
#undef PAF
#undef VFR
#undef VRD
#undef KRD
#undef EX
#undef GAPA
#undef GAPB
#undef STEP4
}
#undef ASBAR
#undef APIN
}

namespace s5 {
constexpr int NCH = LPOS / 16;
constexpr int M_MC = 0, M_WCF = 65536, M_WCB = 65536 + 32768, M_WSF = 131072, M_WSB = 131072 + 32768, M_TOTAL = 196608;
constexpr int LDS_E = 18 * 4096;

struct Params { const float *lam_re, *lam_im, *log_dt, *b_re, *b_im, *c_re, *c_im, *dsk; };

__device__ __forceinline__ void build_mats(const Params& P, int l, int g, bf16* out, LAS unsigned char* lds, int wave_) {
    LAS f32x2* apow = (LAS f32x2*)lds;
    LAS f32x2* Bb = apow + 2 * 64 * 17;
    LAS f32x2* Cc = Bb + 2 * 64 * 16;
    LAS float* Kt = (LAS float*)(Cc + 2 * 16 * 64);
    constexpr int KTL = 260, KTD = 16 * KTL;
    const int tid = wave_ * 64 + lane_id();
    LAS float* lamv = Kt + 2 * KTD;
    LAS float* dskv = lamv + 512;
    f32x2 cv[4], bv[4];
#pragma unroll
    for (int m = 0; m < 4; ++m) { const int i = tid + NTHREADS * m; { const int dir = i >> 10, hp = (i >> 6) & 15, p = i & 63; const size_t ci = ((size_t)((l * 2 + dir) * 32 + g) * 16 + hp) * 64 + p; cv[m] = (f32x2){P.c_re[ci], P.c_im[ci]}; }
        { const int dir = i >> 10, p = (i >> 4) & 63, h = i & 15, pi = ((l * 2 + dir) * 32 + g) * 64 + p; bv[m] = (f32x2){P.b_re[(size_t)pi * 16 + h], P.b_im[(size_t)pi * 16 + h]}; } }
    if (tid < 128) { const int dir = tid >> 6, p = tid & 63, pi = ((l * 2 + dir) * 32 + g) * 64 + p;
        lamv[4 * tid] = fminf(P.lam_re[pi], -1e-4f); lamv[4 * tid + 1] = P.lam_im[pi]; lamv[4 * tid + 2] = expf(P.log_dt[(l * 2 + dir) * 32 + g]); }
    else if (tid < 144) dskv[tid - 128] = P.dsk[(l * 32 + g) * 16 + tid - 128];
#pragma unroll
    for (int m = 0; m < 4; ++m) Cc[tid + NTHREADS * m] = cv[m];
    __syncthreads();
    for (int i = tid; i < 2 * 64 * 17; i += NTHREADS) {
        const int dir = i / (64 * 17), r = i - dir * (64 * 17), p = r / 17, j = r - p * 17;
        const float lr = lamv[4 * (dir * 64 + p)], li = lamv[4 * (dir * 64 + p) + 1], dt = lamv[4 * (dir * 64 + p) + 2];
        const float mag = expf((float)j * lr * dt), ang = (float)j * li * dt; apow[i] = (f32x2){mag * cosf(ang), mag * sinf(ang)}; }
#pragma unroll
    for (int m = 0; m < 4; ++m) {
        const int i = tid + NTHREADS * m, dir = i >> 10, p = (i >> 4) & 63;
        const float lr = lamv[4 * (dir * 64 + p)], li = lamv[4 * (dir * 64 + p) + 1], dt = lamv[4 * (dir * 64 + p) + 2];
        const float abr = expf(lr * dt) * cosf(li * dt), abi = expf(lr * dt) * sinf(li * dt), den = lr * lr + li * li;
        const float fr = ((abr - 1.0f) * lr + abi * li) / den, fi = (abi * lr - (abr - 1.0f) * li) / den;
        const float br = bv[m].x, bi = bv[m].y; Bb[i] = (f32x2){fr * br - fi * bi, fr * bi + fi * br}; }
    __syncthreads();
    {
        const int dir = tid >> 8, j = (tid >> 4) & 15, hp0 = ((tid >> 2) & 3) * 4, h0 = (tid & 3) * 4; float sacc[4][4];
#pragma unroll
        for (int x = 0; x < 4; ++x)
#pragma unroll
            for (int y = 0; y < 4; ++y) sacc[x][y] = 0.f;
        for (int p = 0; p < 64; ++p) { const f32x2 a = apow[(dir * 64 + p) * 17 + j];
            const f32x2 c0_ = Cc[(dir * 16 + hp0) * 64 + p], c1_ = Cc[(dir * 16 + hp0 + 1) * 64 + p], c2_ = Cc[(dir * 16 + hp0 + 2) * 64 + p], c3_ = Cc[(dir * 16 + hp0 + 3) * 64 + p];
            const f32x4 c01 = {c0_.x, c0_.y, c1_.x, c1_.y}, c23 = {c2_.x, c2_.y, c3_.x, c3_.y};
            const f32x4 b01 = *(const LAS f32x4*)(Bb + (dir * 64 + p) * 16 + h0), b23 = *(const LAS f32x4*)(Bb + (dir * 64 + p) * 16 + h0 + 2);
            const float cx[4] = {c01[0], c01[2], c23[0], c23[2]}, cy[4] = {c01[1], c01[3], c23[1], c23[3]}, bx[4] = {b01[0], b01[2], b23[0], b23[2]}, by[4] = {b01[1], b01[3], b23[1], b23[3]};
#pragma unroll
            for (int x = 0; x < 4; ++x) { const float tr = cx[x] * a.x - cy[x] * a.y, ti = cx[x] * a.y + cy[x] * a.x;
#pragma unroll
                for (int y = 0; y < 4; ++y) sacc[x][y] += tr * bx[y] - ti * by[y]; } }
#pragma unroll
        for (int x = 0; x < 4; ++x) *(LAS f32x4*)(Kt + dir * KTD + j * KTL + (hp0 + x) * 16 + h0) = (f32x4){sacc[x][0], sacc[x][1], sacc[x][2], sacc[x][3]};
    }
    __syncthreads();
#pragma unroll 4
    for (int i = tid; i < 65536 / 8; i += NTHREADS) {
        const int row = i >> 5, c0 = (i & 31) * 8, t = row >> 4, hp = row & 15, s = c0 >> 4, h0 = c0 & 15; float v[8];
        const int lf = s <= t ? t - s : 0, lb = s >= t ? s - t : 0;
        const f32x4 f0 = *(const LAS f32x4*)(Kt + lf * KTL + hp * 16 + h0), f1 = *(const LAS f32x4*)(Kt + lf * KTL + hp * 16 + h0 + 4);
        const f32x4 b0 = *(const LAS f32x4*)(Kt + KTD + lb * KTL + hp * 16 + h0), b1 = *(const LAS f32x4*)(Kt + KTD + lb * KTL + hp * 16 + h0 + 4);
        const float wf = s <= t ? 1.f : 0.f, wb = s >= t ? 1.f : 0.f;
#pragma unroll
        for (int e = 0; e < 8; ++e) { const int h = h0 + e; float x = 0.f;
            if (s <= t) x += (e < 4 ? f0[e & 3] : f1[e & 3]);
            if (s >= t) x += (e < 4 ? b0[e & 3] : b1[e & 3]);
            if (s == t && h == hp) x += dskv[h];
            v[e] = x; }
        (void)wf; (void)wb;
        *(u32x4*)(out + M_MC + (size_t)row * 256 + c0) = pack8(v);
    }
#pragma unroll 4
    for (int i = tid; i < 2 * 32768 / 8; i += NTHREADS) {
        const int dir = i >> 12, ii = i & 4095, row = ii >> 4, c0 = (ii & 15) * 8, t = row >> 4, hp = row & 15, ex = dir == 0 ? t + 1 : 16 - t; float v[8];
#pragma unroll
        for (int e = 0; e < 8; e += 2) { const int p = (c0 + e) >> 1; const f32x2 c = Cc[(dir * 16 + hp) * 64 + p], a = apow[(dir * 64 + p) * 17 + ex];
            v[e] = c.x * a.x - c.y * a.y; v[e + 1] = -(c.x * a.y + c.y * a.x); }
        *(u32x4*)(out + (dir == 0 ? M_WCF : M_WCB) + (size_t)row * 128 + c0) = pack8(v);
    }
#pragma unroll 4
    for (int i = tid; i < 2 * 32768 / 8; i += NTHREADS) {
        const int dir = i >> 12, ii = i & 4095, row = ii >> 5, c0 = (ii & 31) * 8, p = row >> 1, im = row & 1, s = c0 >> 4, h0 = c0 & 15, ex = dir == 0 ? 15 - s : s; float v[8];
        const f32x2 a = apow[(dir * 64 + p) * 17 + ex];
#pragma unroll
        for (int e = 0; e < 8; ++e) { const f32x2 bb = Bb[(dir * 64 + p) * 16 + h0 + e]; v[e] = im ? (a.x * bb.y + a.y * bb.x) : (a.x * bb.x - a.y * bb.y); }
        *(u32x4*)(out + (dir == 0 ? M_WSF : M_WSB) + (size_t)row * 256 + c0) = pack8(v);
    }
    __syncthreads();
}

__device__ __forceinline__ void build_a16(const Params& P, float* a16, int gt, int ngt) {
    for (int pi = gt; pi < 2 * 2 * 32 * 64; pi += ngt) {
        const float lr = fminf(P.lam_re[pi], -1e-4f), li = P.lam_im[pi], dt = expf(P.log_dt[pi >> 6]);
        const float mag = expf(16.f * lr * dt), ang = 16.f * li * dt; a16[2 * pi] = mag * cosf(ang); a16[2 * pi + 1] = mag * sinf(ang); }
}
__device__ __forceinline__ void unit(const float* a16, int l, int b, int g, const bf16* Ug, const bf16* mats, bf16* Aglu, bool skip_ctx, LAS unsigned char* lds, int wave_, int half) {
    int tid = wave_ * 64 + lane_id(); asm volatile("" : "+v"(tid));
    const int lane = tid & 63, n = lane & 15, q = lane >> 4; const int wid = __builtin_amdgcn_readfirstlane(tid >> 6);
    LAS unsigned char* Ef = lds; LAS unsigned char* Eb = lds + LDS_E;
    const bf16* U = Ug + (size_t)(b * 32 + g) * LPOS * 16;
    const int rt = 8 * half + wid;
    f32x4 yi[17];
    {
        bf16x8 af[8], ab[8], am[8]; u32x4 st[4]; unsigned uoff[8];
#pragma unroll
        for (int ks = 0; ks < 8; ++ks) { af[ks] = *(const bf16x8*)(mats + M_WSF + (size_t)(16 * wid + n) * 256 + 32 * ks + 8 * q); ab[ks] = *(const bf16x8*)(mats + M_WSB + (size_t)(16 * wid + n) * 256 + 32 * ks + 8 * q);
            am[ks] = *(const bf16x8*)(mats + M_MC + (size_t)(16 * rt + n) * 256 + 32 * ks + 8 * q); }
        const bf16* ug = U + wid * 512 + lane * 8;
        const int ns = 2 * wid + (lane >> 5), js = lane & 31;
        const unsigned sdst = (ns < 8 ? 0u : (unsigned)LDS_E) + (ns & 7) * 512 + ((js ^ ns) << 4);
#pragma unroll
        for (int i = 0; i < 4; ++i) st[i] = *(const u32x4*)(ug + i * 4096);
#pragma unroll
        for (int ks = 0; ks < 8; ++ks) uoff[ks] = (n < 8 ? 0u : (unsigned)LDS_E) + (n & 7) * 512 + (((4 * ks + q) ^ n) << 4);
        *(LAS u32x4*)(lds + sdst + 4096) = st[0]; st[0] = *(const u32x4*)(ug + 4 * 4096);
        __syncthreads();
#pragma unroll
        for (int t = 0; t < 17; ++t) {
            bf16x8 ub[8];
#pragma unroll
            for (int ks = 0; ks < 8; ++ks) ub[ks] = *(const LAS bf16x8*)(lds + 4096 * (t + 1) + uoff[ks]);
            if (t + 1 < 17) { *(LAS u32x4*)(lds + sdst + 4096 * (t + 2)) = st[(t + 1) & 3]; if (t + 5 < 17) st[(t + 1) & 3] = *(const u32x4*)(ug + (t + 5) * 4096); }
            f32x4 cf = {0.f, 0.f, 0.f, 0.f}, cb = {0.f, 0.f, 0.f, 0.f}, cy = {0.f, 0.f, 0.f, 0.f};
#pragma unroll
            for (int ks = 0; ks < 8; ++ks) { cf = __builtin_amdgcn_mfma_f32_16x16x32_bf16(af[ks], ub[ks], cf, 0, 0, 0); cb = __builtin_amdgcn_mfma_f32_16x16x32_bf16(ab[ks], ub[ks], cb, 0, 0, 0);
                if (!(t == 0 && skip_ctx)) cy = __builtin_amdgcn_mfma_f32_16x16x32_bf16(am[ks], ub[ks], cy, 0, 0, 0); }
            yi[t] = cy;
            const int eo = (16 * t + n) * 256 + (((2 * wid + (q >> 1)) ^ n) << 4) + (q & 1) * 8;
            *(LAS u32x2*)(Ef + eo) = (u32x2){pk2(cf[0], cf[1]), pk2(cf[2], cf[3])};
            *(LAS u32x2*)(Eb + eo) = (u32x2){pk2(cb[0], cb[1]), pk2(cb[2], cb[3])};
            __syncthreads();
        }
    }
    bf16x8 wf[4], wb[4];
#pragma unroll
    for (int ks = 0; ks < 4; ++ks) { wf[ks] = *(const bf16x8*)(mats + M_WCF + (size_t)(16 * rt + n) * 128 + 32 * ks + 8 * q); wb[ks] = *(const bf16x8*)(mats + M_WCB + (size_t)(16 * rt + n) * 128 + 32 * ks + 8 * q); }
    if (wid < 2) {
        const int dir = wid, p = lane, pi = ((l * 2 + dir) * 32 + g) * 64 + p;
        const float ar = a16[2 * pi], ai = a16[2 * pi + 1];
        LAS unsigned* E32 = (LAS unsigned*)(dir ? Eb : Ef);
        float xr = 0.f, xi = 0.f;
#define S5_CH(st) (dir == 0 ? (st) : ((st) < 16 ? 15 - (st) : NCH + 15 - (st)))
#define S5_EW(k, j) (S5_CH(16 * (k) + (j)) * 64 + ((((p >> 2) ^ (dir == 0 ? (j) : 15 - (j))) << 2) | (p & 3)))
        unsigned ea[16], eb[16];
#pragma unroll
        for (int j = 0; j < 16; ++j) ea[j] = E32[S5_EW(0, j)];
        for (int k = 0; k < 17; k += 2) {
#pragma unroll
            for (int j = 0; j < 16; ++j) eb[j] = E32[S5_EW(k + 1 < 17 ? k + 1 : k, j)];
#pragma unroll
            for (int j = 0; j < 16; ++j) { const unsigned e = ea[j]; E32[S5_EW(k, j)] = pk2(xr, xi);
                const float er = bf2f(e & 0xffffu), ei = bf2f(e >> 16); const float nr = ar * xr - ai * xi + er, ni = ar * xi + ai * xr + ei; xr = nr; xi = ni; }
            if (k + 1 < 17) {
#pragma unroll
                for (int j = 0; j < 16; ++j) ea[j] = E32[S5_EW(k + 2 < 17 ? k + 2 : k + 1, j)];
#pragma unroll
                for (int j = 0; j < 16; ++j) { const unsigned e = eb[j]; E32[S5_EW(k + 1, j)] = pk2(xr, xi);
                    const float er = bf2f(e & 0xffffu), ei = bf2f(e >> 16); const float nr = ar * xr - ai * xi + er, ni = ar * xi + ai * xr + ei; xr = nr; xi = ni; }
            }
        }
#undef S5_EW
#undef S5_CH
    }
    __syncthreads();
    {
        unsigned xoff[4];
#pragma unroll
        for (int ks = 0; ks < 4; ++ks) xoff[ks] = n * 256 + (((q + 4 * ks) ^ n) << 4);
#pragma unroll
        for (int ct = 0; ct < 17; ++ct) {
            if (ct == 0 && skip_ctx) continue;
            int cto = ct; asm volatile("" : "+s"(cto));
            f32x4 acc = yi[ct];
#pragma unroll
            for (int ks = 0; ks < 4; ++ks) { acc = __builtin_amdgcn_mfma_f32_16x16x32_bf16(wf[ks], *(const LAS bf16x8*)(Ef + 4096 * cto + xoff[ks]), acc, 0, 0, 0);
                acc = __builtin_amdgcn_mfma_f32_16x16x32_bf16(wb[ks], *(const LAS bf16x8*)(Eb + 4096 * cto + xoff[ks]), acc, 0, 0, 0); }
            const int pos = (16 * cto + n) * 16 + rt;
            *(u32x2*)(Aglu + (size_t)pos_row(b, pos) * 512 + g * 16 + 4 * q) = (u32x2){pk2(fgelu_tanh(acc[0]), fgelu_tanh(acc[1])), pk2(fgelu_tanh(acc[2]), fgelu_tanh(acc[3]))};
        }
    }
    __syncthreads();
}
}

struct Ptrs {
    const float *x, *c, *ctx, *c_ctx, *w_mod, *b_mod, *g_mix_pre, *g_mix_post, *g_ffn_pre, *g_ffn_post, *w_in, *g_q, *g_k, *g_cq, *g_ckv, *w_uq, *w_ukv;
    s5::Params s5p;
    const float *w_glu, *w_branch, *w_mg, *b_mg, *w_out, *ffn_w1, *ffn_w3, *ffn_w2, *router_w, *router_b, *moe_w1, *moe_w3, *moe_w2;
    float* out; unsigned char* ws;
};

template <int MAP  >
__device__ __forceinline__ void transpose_item(const float* W, int K, int N, bf16* WT, int kb, int n0, int drow0, LAS float* scr, int lane) {
    const int k0 = 64 * kb;
#pragma unroll
    for (int i = 0; i < 8; ++i) { const int kk = 8 * i + (lane >> 3), c4 = 4 * (lane & 7); const f32x4 v = *(const f32x4*)(W + (size_t)(k0 + kk) * N + n0 + c4);
        LAS float* d = scr + kk * 33 + c4; d[0] = v[0]; d[1] = v[1]; d[2] = v[2]; d[3] = v[3]; }
    asm volatile("s_waitcnt lgkmcnt(0)" ::: "memory");
    const int c = lane & 7;
#pragma unroll
    for (int j = 0; j < 4; ++j) { const int n = (lane >> 3) + 8 * j; const LAS float* s = scr + (8 * c) * 33 + n;
        u32x4 o; o.x = pk2(s[0 * 33], s[1 * 33]); o.y = pk2(s[2 * 33], s[3 * 33]); o.z = pk2(s[4 * 33], s[5 * 33]); o.w = pk2(s[6 * 33], s[7 * 33]);
        int dr = n; if (MAP == 1) { const int i2 = n & 15; dr = 8 * (i2 >> 2) + (i2 & 3) + ((n >> 4) << 2); }
        *(u32x4*)(WT + (size_t)(drow0 + dr) * K + k0 + 8 * c) = o; }
    asm volatile("s_waitcnt lgkmcnt(0)" ::: "memory");
}

__device__ __forceinline__ void transpose_item_f8(const float* W, int K, int N, unsigned char* WT, int kb, int n0, int drow0, float wscale, LAS float* scr, int lane) {
    const int k0 = 64 * kb;
#pragma unroll
    for (int i = 0; i < 8; ++i) { const int kk = 8 * i + (lane >> 3), c4 = 4 * (lane & 7); const f32x4 v = *(const f32x4*)(W + (size_t)(k0 + kk) * N + n0 + c4);
        LAS float* d = scr + kk * 33 + c4; d[0] = v[0]; d[1] = v[1]; d[2] = v[2]; d[3] = v[3]; }
    asm volatile("s_waitcnt lgkmcnt(0)" ::: "memory");
    const int c = lane & 7;
#pragma unroll
    for (int j = 0; j < 4; ++j) { const int n = (lane >> 3) + 8 * j; const LAS float* s = scr + (8 * c) * 33 + n;
        u32x2 o; o.x = pg8::pk_fp8x4(s[0 * 33] * wscale, s[1 * 33] * wscale, s[2 * 33] * wscale, s[3 * 33] * wscale); o.y = pg8::pk_fp8x4(s[4 * 33] * wscale, s[5 * 33] * wscale, s[6 * 33] * wscale, s[7 * 33] * wscale);
        *(u32x2*)(WT + (size_t)(drow0 + n) * K + k0 + 8 * c) = o; }
    asm volatile("s_waitcnt lgkmcnt(0)" ::: "memory");
}
__device__ __forceinline__ int zmap(int n0) { return n0 < 512 ? n0 : n0 < 896 ? ZC_CQ + (n0 - 512) : n0 < 1024 ? ZC_KG + (n0 - 896) : n0 < 1152 ? ZC_VG + (n0 - 1024) : n0 < 1440 ? n0 : ZC_U + (n0 - 1440); }
__device__ __forceinline__ int pairmap(int n0, int second) { return 256 * (n0 >> 7) + (second ? 128 : 0) + (n0 & 127); }

__device__ __forceinline__ void transposes(const Ptrs& P, int gw, int ngw, LAS float* scr, int lane, int qsel = 0) {
    unsigned char* ws = P.ws;
    constexpr int I_WIN = 16 * 61, I_MG = 16 * 96, I_UQ = 6 * 24, I_UKV = 4 * 32, I_GLU = 8 * 32, I_BR = 8 * 32, I_OUT = 16 * 32, I_F13 = 16 * 88, I_F2 = 44 * 32;
    constexpr int PER_L = I_WIN + I_MG + I_UQ + I_UKV + I_GLU + 3 * I_BR + I_OUT;
    constexpr int N_L = 2 * PER_L, N_F = 2 * I_F13 + I_F2, N_M = 8 * (2 * I_F13 + I_F2), NITEMS = N_L + N_F + N_M;
    const int qx = (int)blockIdx.x & 7;
    unsigned* q = (unsigned*)(ws + WS_CTL) + CW_Q + 256 * qsel + 32 * qx; (void)gw; (void)ngw;
    for (;;) { int base = 0; if (lane == 0) base = (int)atomicAdd(q, 4u); base = __builtin_amdgcn_readfirstlane(base); if (base * 8 + qx + N_M >= NITEMS) break;
    for (int it_ = base; it_ < base + 4; ++it_) { const int it = it_ * 8 + qx + N_M; if (it >= NITEMS) break;
        int r = it;
        if (r < N_M) {
            const int e = r / (2 * I_F13 + I_F2); r -= e * (2 * I_F13 + I_F2);
            unsigned char* W1T = ws + WS_WM1T + (size_t)e * 5632 * 1024; unsigned char* W2T = ws + WS_WM2T + (size_t)e * 1024 * 2816;
            if (r < I_F13) { const int kb = r / 88, nb = r % 88; if (F8_M1) transpose_item_f8(P.moe_w1 + (size_t)e * 1024 * DFF, 1024, DFF, W1T, kb, 32 * nb, pairmap(32 * nb, 0), F8_WSCALE, scr, lane); else transpose_item<0>(P.moe_w1 + (size_t)e * 1024 * DFF, 1024, DFF, (bf16*)(ws + WS_WM1T) + (size_t)e * 5632 * 1024, kb, 32 * nb, pairmap(32 * nb, 0), scr, lane); continue; } r -= I_F13;
            if (r < I_F13) { const int kb = r / 88, nb = r % 88; if (F8_M1) transpose_item_f8(P.moe_w3 + (size_t)e * 1024 * DFF, 1024, DFF, W1T, kb, 32 * nb, pairmap(32 * nb, 1), F8_WSCALE, scr, lane); else transpose_item<0>(P.moe_w3 + (size_t)e * 1024 * DFF, 1024, DFF, (bf16*)(ws + WS_WM1T) + (size_t)e * 5632 * 1024, kb, 32 * nb, pairmap(32 * nb, 1), scr, lane); continue; } r -= I_F13;
            { const int kb = r / 32, nb = r % 32; transpose_item_f8(P.moe_w2 + (size_t)e * DFF * 1024, DFF, 1024, W2T, kb, 32 * nb, 32 * nb, F8_WSCALE, scr, lane); continue; }
        }
        r -= N_M;
        if (r < N_F) {
            unsigned char* W1T = ws + WS_WF1T; unsigned char* W2T = ws + WS_WF2T;
            if (r < I_F13) { const int kb = r / 88, nb = r % 88; if (F8_D1) transpose_item_f8(P.ffn_w1, 1024, DFF, W1T, kb, 32 * nb, pairmap(32 * nb, 0), F8_WSCALE, scr, lane); else transpose_item<0>(P.ffn_w1, 1024, DFF, (bf16*)W1T, kb, 32 * nb, pairmap(32 * nb, 0), scr, lane); continue; } r -= I_F13;
            if (r < I_F13) { const int kb = r / 88, nb = r % 88; if (F8_D1) transpose_item_f8(P.ffn_w3, 1024, DFF, W1T, kb, 32 * nb, pairmap(32 * nb, 1), F8_WSCALE, scr, lane); else transpose_item<0>(P.ffn_w3, 1024, DFF, (bf16*)W1T, kb, 32 * nb, pairmap(32 * nb, 1), scr, lane); continue; } r -= I_F13;
            { const int kb = r / 32, nb = r % 32; if (F8_D2) transpose_item_f8(P.ffn_w2, DFF, 1024, W2T, kb, 32 * nb, 32 * nb, F8_WSCALE, scr, lane); else transpose_item<0>(P.ffn_w2, DFF, 1024, (bf16*)W2T, kb, 32 * nb, 32 * nb, scr, lane); continue; }
        }
        r -= N_F;
        const int l = r / PER_L; r -= l * PER_L;
        if (r < I_WIN) { const int kb = r / 61, nb = r % 61; if (F8_G1L1 && l == 1) transpose_item_f8(P.w_in + (size_t)l * 1024 * NIN, 1024, NIN, ws + WS_W1T + (size_t)l * ZW * 2048, kb, 32 * nb, zmap(32 * nb), F8_WSCALE, scr, lane);
            else transpose_item<0>(P.w_in + (size_t)l * 1024 * NIN, 1024, NIN, (bf16*)(ws + WS_W1T) + (size_t)l * ZW * 1024, kb, 32 * nb, zmap(32 * nb), scr, lane); continue; } r -= I_WIN;
        if (r < I_MG) { const int kb = r / 96, nb = r % 96; transpose_item_f8(P.w_mg + (size_t)l * 1024 * 3072, 1024, 3072, ws + WS_WMGT + (size_t)l * 3072 * 1024, kb, 32 * nb, 32 * nb, F8_WSCALE, scr, lane); continue; } r -= I_MG;
        if (r < I_UQ) { const int kb = r / 24, nb = r % 24; bf16* T = (bf16*)(ws + WS_WUQT) + (size_t)l * 768 * 384;
            if (nb % 3 == 2) transpose_item<1>(P.w_uq + (size_t)l * 384 * 768, 384, 768, T, kb, 32 * nb, 32 * nb, scr, lane); else transpose_item<0>(P.w_uq + (size_t)l * 384 * 768, 384, 768, T, kb, 32 * nb, 32 * nb, scr, lane); continue; } r -= I_UQ;
        if (r < I_UKV) { const int kb = r / 32, nb = r % 32; transpose_item<0>(P.w_ukv + (size_t)l * 256 * 1024, 256, 1024, (bf16*)(ws + WS_WUKVT) + (size_t)l * 1024 * 256, kb, 32 * nb, 32 * nb, scr, lane); continue; } r -= I_UKV;
        if (r < I_GLU) { const int kb = r / 32, nb = r % 32, n0 = 32 * nb; transpose_item<0>(P.w_glu + (size_t)l * 512 * 1024, 512, 1024, (bf16*)(ws + WS_WGLUT) + (size_t)l * 1024 * 512, kb, n0, n0 < 512 ? pairmap(n0, 0) : pairmap(n0 - 512, 1), scr, lane); continue; } r -= I_GLU;
        if (r < 3 * I_BR) { const int n = r / I_BR; r -= n * I_BR; const int kb = r / 32, nb = r % 32;
            transpose_item<0>(P.w_branch + ((size_t)l * 3 + n) * 512 * 1024, 512, 1024, (bf16*)(ws + WS_WBT) + ((size_t)l * 3 + n) * 1024 * 512, kb, 32 * nb, 32 * nb, scr, lane); continue; } r -= 3 * I_BR;
        { const int kb = r / 32, nb = r % 32; transpose_item<0>(P.w_out + (size_t)l * 1024 * 1024, 1024, 1024, (bf16*)(ws + WS_WOUTT) + (size_t)l * 1024 * 1024, kb, 32 * nb, 32 * nb, scr, lane); }
    } }
}


constexpr int MOE_ITEMS_PER_E = 2 * 16 * 88 + 44 * 32, MOE_ITEMS = 8 * MOE_ITEMS_PER_E;
__device__ __forceinline__ void moe_transposes(const float* w1, const float* w3, const float* w2, unsigned char* ws, int lo, int hi, int giw, int ngiw, LAS float* scr, int lane) {
    constexpr int I_F13 = 16 * 88;
    for (int it = lo + giw; it < hi; it += ngiw) {
        const int e = it / MOE_ITEMS_PER_E; int r = it - e * MOE_ITEMS_PER_E;
        unsigned char* W1T = ws + WS_WM1T + (size_t)e * 5632 * 1024; unsigned char* W2T = ws + WS_WM2T + (size_t)e * 1024 * 2816;
        if (r < I_F13) { const int kb = r / 88, nb = r % 88; if (F8_M1) transpose_item_f8(w1 + (size_t)e * 1024 * DFF, 1024, DFF, W1T, kb, 32 * nb, pairmap(32 * nb, 0), F8_WSCALE, scr, lane); else transpose_item<0>(w1 + (size_t)e * 1024 * DFF, 1024, DFF, (bf16*)(ws + WS_WM1T) + (size_t)e * 5632 * 1024, kb, 32 * nb, pairmap(32 * nb, 0), scr, lane); continue; } r -= I_F13;
        if (r < I_F13) { const int kb = r / 88, nb = r % 88; if (F8_M1) transpose_item_f8(w3 + (size_t)e * 1024 * DFF, 1024, DFF, W1T, kb, 32 * nb, pairmap(32 * nb, 1), F8_WSCALE, scr, lane); else transpose_item<0>(w3 + (size_t)e * 1024 * DFF, 1024, DFF, (bf16*)(ws + WS_WM1T) + (size_t)e * 5632 * 1024, kb, 32 * nb, pairmap(32 * nb, 1), scr, lane); continue; } r -= I_F13;
        { const int kb = r / 32, nb = r % 32; transpose_item_f8(w2 + (size_t)e * DFF * 1024, DFF, 1024, W2T, kb, 32 * nb, 32 * nb, F8_WSCALE, scr, lane); }
    }
}
__device__ __forceinline__ void mod_item(const Ptrs& P, int item, LAS unsigned char* lds, int wave_) {
    LAS float* sc = (LAS float*)lds;
    LAS float* part = sc + 5 * 1024;
    const int lane = lane_id(), wid = wave_, tid = wid * 64 + lane, l = item / 96, n0 = (item % 96) * 64;
    for (int i = tid; i < 5 * 1024; i += NTHREADS) { const float v = i < 4096 ? P.c[i] : P.c_ctx[i - 4096]; sc[i] = v / (1.0f + expf(-v)); }
    __syncthreads();
    float a[5] = {0.f, 0.f, 0.f, 0.f, 0.f};
    const float* W = P.w_mod + (size_t)l * 1024 * 6144 + n0 + lane;
    for (int k0 = wid; k0 < 1024; k0 += 256) {
        float w[32];
#pragma unroll
        for (int j = 0; j < 32; ++j) w[j] = W[(size_t)(k0 + 8 * j) * 6144];
#pragma unroll
        for (int j = 0; j < 32; ++j)
#pragma unroll
            for (int r = 0; r < 5; ++r) a[r] += sc[r * 1024 + k0 + 8 * j] * w[j]; }
#pragma unroll
    for (int r = 0; r < 5; ++r) part[(wid * 5 + r) * 64 + lane] = a[r];
    __syncthreads();
    if (tid < 320) { const int r = tid >> 6; float s = 0.f;
#pragma unroll
        for (int w = 0; w < 8; ++w) s += part[(w * 5 + r) * 64 + lane];
        ((float*)(P.ws + WS_MOD))[((size_t)l * 5 + r) * 6144 + n0 + lane] = s + P.b_mod[l * 6144 + n0 + lane]; }
    __syncthreads();
}
__device__ __forceinline__ void copy_params(const Ptrs& P, int gt, int ngt) {
    float* par = (float*)(P.ws + WS_PAR);
    for (int i = gt; i < 2048; i += ngt) { par[PR_GMIXPRE + i] = P.g_mix_pre[i]; par[PR_GMIXPOST + i] = P.g_mix_post[i]; par[PR_GFFNPRE + i] = P.g_ffn_pre[i]; par[PR_GFFNPOST + i] = P.g_ffn_post[i]; }
    for (int i = gt; i < 128; i += ngt) { par[PR_GQ + i] = P.g_q[i]; par[PR_GK + i] = P.g_k[i]; }
    for (int i = gt; i < 768; i += ngt) par[PR_GCQ + i] = P.g_cq[i];
    for (int i = gt; i < 512; i += ngt) par[PR_GCKV + i] = P.g_ckv[i];
    for (int i = gt; i < 6144; i += ngt) par[PR_BMG + i] = P.b_mg[i];
    for (int i = gt; i < 8192; i += ngt) par[PR_RW + i] = P.router_w[i];
    for (int i = gt; i < 8; i += ngt) par[PR_RB + i] = P.router_b[i];
    s5::build_a16(P.s5p, par + PR_A16, gt, ngt);
}
__device__ __forceinline__ void rope_tables(const Ptrs& P, int gt, int ngt) {
    float* ca = (float*)(P.ws + WS_ROPE); float* sa = ca + 4096 * 32; float* cb = sa + 4096 * 32; float* sb = cb + 4096 * 16;
    for (int i = gt; i < 4096 * 32; i += ngt) { const int pos = i >> 5, j = i & 31; const float f = expf(-9.210340371976184f * (float)(j & 15) * (1.0f / 16.0f));
        const float ang = (float)(j < 16 ? pos / GRIDW : pos % GRIDW) * f; ca[i] = cosf(ang); sa[i] = sinf(ang); }
    for (int i = gt; i < 4096 * 16; i += ngt) { const int pos = i >> 4, j = i & 15; const float f = expf(-9.210340371976184f * (float)(j & 7) * (1.0f / 8.0f));
        const float ang = (float)(j < 8 ? pos / GRIDW : pos % GRIDW) * f; cb[i] = cosf(ang); sb[i] = sinf(ang); }
}

__device__ __forceinline__ void ld8(const float* p, float (&o)[8]) { const f32x4 a = *(const f32x4*)p, b = *(const f32x4*)(p + 4); o[0] = a[0]; o[1] = a[1]; o[2] = a[2]; o[3] = a[3]; o[4] = b[0]; o[5] = b[1]; o[6] = b[2]; o[7] = b[3]; }
__device__ __forceinline__ void token_row(unsigned char* ws, int l, int row, int lane) {
    const float* par = (const float*)(ws + WS_PAR);
    const bf16* z = (const bf16*)(ws + P_Z) + (size_t)row * ZW;
    const bool lat = row < NLAT; const int t = row & (SEQ - 1);
    const float* cosA = (const float*)(ws + WS_ROPE) + t * 32; const float* sinA = cosA + 4096 * 32;
    const float* cosB = (const float*)(ws + WS_ROPE) + 2 * 4096 * 32 + t * 16; const float* sinB = cosB + 4096 * 16;
    float v0[8], v1[8], v2[8];
    unpack8(*(const u32x4*)(z + 8 * lane), v0); unpack8(*(const u32x4*)(z + 512 + 8 * lane), v1); unpack8(*(const u32x4*)(z + 1024 + 8 * lane), v2);
    const u32x4 uraw = *(const u32x4*)(z + ZC_U + 8 * lane);
    float ca[8], sa[8], cb8[8], sb8[8];
    ld8(cosA + ((8 * (lane & 7)) & 31), ca); ld8(sinA + ((8 * (lane & 7)) & 31), sa); ld8(cosB + ((8 * ((lane - 48) & 3)) & 15), cb8); ld8(sinB + ((8 * ((lane - 48) & 3)) & 15), sb8);
    { float ss = 0.f;
#pragma unroll
      for (int j = 0; j < 8; ++j) ss += v0[j] * v0[j];
      ss += shfl_xor_l(ss, 1, lane); ss += shfl_xor_l(ss, 2, lane); ss += shfl_xor_l(ss, 4, lane);
      const float rs = rsqrtf(ss * (1.0f / 64.0f) + EPS); const int d0 = 8 * (lane & 7); float o[8], gq[8];
      ld8(par + PR_GQ + l * 64 + d0, gq);
#pragma unroll
      for (int j = 0; j < 8; ++j) v0[j] = v0[j] * rs * gq[j];
#pragma unroll
      for (int j = 0; j < 8; ++j) { const float other = shfl_xor_l(v0[j], 4, lane); const float c = ca[j], s = sa[j];
          o[j] = lat ? ((d0 < 32) ? v0[j] * c - other * s : other * s + v0[j] * c) : v0[j];
          o[j] *= 0.125f * LOG2E; }
      *(u32x4*)((bf16*)(ws + P_QA) + (size_t)row * 512 + 8 * lane) = pack8(o); }
    { float ss = 0.f;
#pragma unroll
      for (int j = 0; j < 8; ++j) ss += v1[j] * v1[j];
      float ssk = ss; ssk += shfl_xor_l(ssk, 1, lane); ssk += shfl_xor_l(ssk, 2, lane); ssk += shfl_xor_l(ssk, 4, lane);
      float ss2 = 0.f;
#pragma unroll
      for (int j = 0; j < 8; ++j) ss2 += v2[j] * v2[j];
      const float sq = wave_sum((lane >= 32 ? ss : 0.f) + (lane < 16 ? ss2 : 0.f));
      const float skv = wave_sum((lane >= 16 && lane < 48) ? ss2 : 0.f);
      const float rq = rsqrtf(sq * (1.0f / 384.0f) + EPS), rkv = rsqrtf(skv * (1.0f / 256.0f) + EPS);
      { const float rs = rsqrtf(ssk * (1.0f / 64.0f) + EPS); const int d0 = 8 * (lane & 7); float kk[8], o[8], gk[8];
        ld8(par + PR_GK + l * 64 + d0, gk);
#pragma unroll
        for (int j = 0; j < 8; ++j) kk[j] = v1[j] * rs * gk[j];
#pragma unroll
        for (int j = 0; j < 8; ++j) { const float other = shfl_xor_l(kk[j], 4, lane); const float c = ca[j], s = sa[j];
            o[j] = lat ? ((d0 < 32) ? kk[j] * c - other * s : other * s + kk[j] * c) : kk[j]; }
        if (lane < 16) *(u32x4*)((bf16*)(ws + P_KA) + (size_t)row * 128 + 8 * lane) = pack8(o); }
      if (lane >= 16 && lane < 32) *(u32x4*)((bf16*)(ws + P_VA) + (size_t)row * 128 + 8 * (lane - 16)) = pack8(v1);
      { float g1[8], g2[8], g3[8], o[8];
        const int i1 = lane >= 32 ? 8 * (lane - 32) : 0, i2 = lane < 16 ? 256 + 8 * lane : 0, i3 = (lane >= 16 && lane < 48) ? 8 * (lane - 16) : 0;
        ld8(par + PR_GCQ + l * 384 + i1, g1); ld8(par + PR_GCQ + l * 384 + i2, g2); ld8(par + PR_GCKV + l * 256 + i3, g3);
#pragma unroll
        for (int j = 0; j < 8; ++j) o[j] = v1[j] * rq * g1[j];
        if (lane >= 32) *(u32x4*)((bf16*)(ws + P_CQN) + (size_t)row * 384 + i1) = pack8(o);
#pragma unroll
        for (int j = 0; j < 8; ++j) o[j] = v2[j] * rq * g2[j];
        if (lane < 16) *(u32x4*)((bf16*)(ws + P_CQN) + (size_t)row * 384 + i2) = pack8(o);
#pragma unroll
        for (int j = 0; j < 8; ++j) o[j] = v2[j] * rkv * g3[j];
        if (lane >= 16 && lane < 48) *(u32x4*)((bf16*)(ws + P_CKVN) + (size_t)row * 256 + i3) = pack8(o); }
      { float o[8]; const int i0 = 8 * ((lane - 48) & 3);
#pragma unroll
        for (int j = 0; j < 8; ++j) { const float other = shfl_xor_l(v2[j], 2, lane); const float c = cb8[j], s = sb8[j];
            o[j] = lat ? ((i0 < 16) ? v2[j] * c - other * s : other * s + v2[j] * c) : v2[j]; }
        if (lane >= 48 && lane < 52) *(u32x4*)((bf16*)(ws + P_KRR) + (size_t)row * 32 + i0) = pack8(o); }
    }
    { const int b = lat ? row >> 12 : (row - NLAT) >> 8, pos = lat ? CTXL + t : (row - NLAT) & 255, g = lane >> 1;
      *(u32x4*)((bf16*)(ws + P_UG) + ((size_t)(b * 32 + g) * LPOS + pos) * 16 + 8 * (lane & 1)) = uraw; }
}

struct ResidArgs {
    int mode;
    const float* y; const float* g_post; int gate_chunk;
    const float* g_pre; int shift_chunk;
    bool dry;
    float ysc;
    bf16* hout; int l_mod; bool h8; unsigned char* hout8;
    int l_gate; bool route;
};
__device__ __forceinline__ void resid_row(unsigned char* ws, float* outp, const float* xin, const float* ctxin, const ResidArgs R, int row, int lane, const LAS int* tb) {
    const float* par = (const float*)(ws + WS_PAR);
    const bool lat = row < NLAT; const int b = lat ? row >> 12 : (row - NLAT) >> 8, mr = lat ? b : 4;
    const float* mod = (const float*)(ws + WS_MOD);
    float* latp = lat ? outp + (size_t)row * 1024 : (float*)(ws + WS_LATC) + (size_t)(row - NLAT) * 1024;
    f32x4 v[4];
    if (R.mode == 0) { const float* src = lat ? xin + (size_t)row * 1024 : ctxin + (size_t)(row - NLAT) * 1024;
#pragma unroll
        for (int j = 0; j < 4; ++j) v[j] = *(const f32x4*)(src + 4 * lane + 256 * j);
    } else {
        f32x4 yv[4];
        if (R.mode == 1) {
#pragma unroll
            for (int j = 0; j < 4; ++j) yv[j] = *(const f32x4*)(R.y + (size_t)row * 1024 + 4 * lane + 256 * j) * R.ysc;
        } else if (R.mode == 3) {
            const bf16* yb = (const bf16*)R.y + (size_t)row * 1024;
#pragma unroll
            for (int j = 0; j < 4; ++j) { const u32x2 a = *(const u32x2*)(yb + 4 * lane + 256 * j);
                yv[j] = (f32x4){bf2f(a.x & 0xffffu), bf2f(a.x >> 16), bf2f(a.y & 0xffffu), bf2f(a.y >> 16)} * R.ysc; }
        } else {
            const int* ti = (const int*)(ws + WS_LIST) + 8 * 16384 + row * 8;
            const int e0 = ti[0], p0 = ti[1], e1 = ti[2], p1 = ti[3]; const float w0 = __int_as_float(ti[4]) * R.ysc, w1 = __int_as_float(ti[5]) * R.ysc;
            const bf16* f0 = (const bf16*)(ws + P_Y2) + ((size_t)tb[8 + e0] * 256 + p0) * 1024; const bf16* f1 = (const bf16*)(ws + P_Y2) + ((size_t)tb[8 + e1] * 256 + p1) * 1024;
#pragma unroll
            for (int j = 0; j < 4; ++j) { const u32x2 a = *(const u32x2*)(f0 + 4 * lane + 256 * j), c = *(const u32x2*)(f1 + 4 * lane + 256 * j);
                yv[j][0] = w0 * bf2f(a.x & 0xffffu) + w1 * bf2f(c.x & 0xffffu); yv[j][1] = w0 * bf2f(a.x >> 16) + w1 * bf2f(c.x >> 16);
                yv[j][2] = w0 * bf2f(a.y & 0xffffu) + w1 * bf2f(c.y & 0xffffu); yv[j][3] = w0 * bf2f(a.y >> 16) + w1 * bf2f(c.y >> 16); }
        }
        float ss = 0.f;
#pragma unroll
        for (int j = 0; j < 4; ++j) ss += (yv[j][0] * yv[j][0] + yv[j][1] * yv[j][1]) + (yv[j][2] * yv[j][2] + yv[j][3] * yv[j][3]);
        const float rs = rsqrtf(wave_sum(ss) * (1.0f / 1024.0f) + EPS);
        const float* gate = mod + ((size_t)R.l_gate * 5 + mr) * 6144 + R.gate_chunk * 1024;
#pragma unroll
        for (int j = 0; j < 4; ++j) { const int c = 4 * lane + 256 * j; const f32x4 lv = *(const f32x4*)(latp + c), gp = *(const f32x4*)(R.g_post + c), gt = *(const f32x4*)(gate + c);
            v[j] = lv + gt * (yv[j] * rs * gp); }
    }
    if (!R.dry) {
#pragma unroll
    for (int j = 0; j < 4; ++j) *(f32x4*)(latp + 4 * lane + 256 * j) = v[j]; }
    if (R.hout == nullptr) return;
    float ss = 0.f;
#pragma unroll
    for (int j = 0; j < 4; ++j) ss += (v[j][0] * v[j][0] + v[j][1] * v[j][1]) + (v[j][2] * v[j][2] + v[j][3] * v[j][3]);
    const float rs = rsqrtf(wave_sum(ss) * (1.0f / 1024.0f) + EPS);
    const float* shift = mod + ((size_t)R.l_mod * 5 + mr) * 6144 + R.shift_chunk * 1024; const float* scale = shift + 1024;
    f32x4 hv[4];
#pragma unroll
    for (int j = 0; j < 4; ++j) { const int c = 4 * lane + 256 * j; const f32x4 gp = *(const f32x4*)(R.g_pre + c), sh = *(const f32x4*)(shift + c), sc = *(const f32x4*)(scale + c);
        hv[j] = (v[j] * rs * gp) * (1.0f + sc) + sh;
        if (R.dry) { if (hv[j][0] == 123.456f) *(float*)(ws + WS_CTL + 64) = 1.f; continue; }
        if (R.hout8) *(unsigned*)(R.hout8 + (size_t)row * 1024 + c) = pg8::pk_fp8x4(hv[j][0] * F8_HSCALE, hv[j][1] * F8_HSCALE, hv[j][2] * F8_HSCALE, hv[j][3] * F8_HSCALE);
        if (R.h8) *(unsigned*)((unsigned char*)R.hout + (size_t)row * 1024 + c) = pg8::pk_fp8x4(hv[j][0] * F8_HSCALE, hv[j][1] * F8_HSCALE, hv[j][2] * F8_HSCALE, hv[j][3] * F8_HSCALE);
        else *(u32x2*)(R.hout + (size_t)row * 1024 + c) = (u32x2){pk2(hv[j][0], hv[j][1]), pk2(hv[j][2], hv[j][3])}; }
    if (R.route) {
        float lg[8];
#pragma unroll
        for (int e = 0; e < 8; ++e) lg[e] = 0.f;
#pragma unroll
        for (int j = 0; j < 4; ++j)
#pragma unroll
            for (int i = 0; i < 4; ++i) { const float* rw = par + PR_RW + (size_t)(4 * lane + 256 * j + i) * 8; const f32x4 r0 = *(const f32x4*)rw, r1 = *(const f32x4*)(rw + 4); const float hvv = hv[j][i];
                lg[0] += hvv * r0[0]; lg[1] += hvv * r0[1]; lg[2] += hvv * r0[2]; lg[3] += hvv * r0[3]; lg[4] += hvv * r1[0]; lg[5] += hvv * r1[1]; lg[6] += hvv * r1[2]; lg[7] += hvv * r1[3]; }
#pragma unroll
        for (int e = 0; e < 8; ++e) lg[e] = wave_sum(lg[e]) + par[PR_RB + e];
        int e0 = 0; float b0 = lg[0];
#pragma unroll
        for (int e = 1; e < 8; ++e) if (lg[e] > b0) { b0 = lg[e]; e0 = e; }
        int e1 = -1; float b1 = -3.0e38f;
#pragma unroll
        for (int e = 0; e < 8; ++e) if (e != e0 && lg[e] > b1) { b1 = lg[e]; e1 = e; }
        if (lane == 0 && !R.dry) {
            const float w0 = 1.0f / (1.0f + expf(b1 - b0)), w1 = 1.0f - w0;
            unsigned* cnt = (unsigned*)(ws + WS_CTL) + CW_CNT;
            const int p0 = (int)atomicAdd(cnt + e0, 1u), p1 = (int)atomicAdd(cnt + e1, 1u);
            int* list = (int*)(ws + WS_LIST); list[e0 * 16384 + p0] = row; list[e1 * 16384 + p1] = row;
            int* ti = list + 8 * 16384 + row * 8; ti[0] = e0; ti[1] = p0; ti[2] = e1; ti[3] = p1; ti[4] = __float_as_int(w0); ti[5] = __float_as_int(w1);
        }
    }
}

#if MK_DEBUG
namespace dbg {
__device__ __forceinline__ unsigned hash(unsigned a, unsigned b) { unsigned x = a * 0x9E3779B1u ^ (b + 0x7F4A7C15u) * 0x85EBCA77u; x ^= x >> 15; x *= 0xC2B2AE3Du; x ^= x >> 13; x *= 0x27D4EB2Fu; x ^= x >> 16; return x; }
__device__ __forceinline__ float rbf(float f) { return bf2f(f2bf(f)); }
__device__ __forceinline__ void add(unsigned char* ws, int k, float got, float ref, int lane) {
    if (lane == 0) { float* d = (float*)(ws + WS_CTL) + CW_DBG + 2 * k; const float df = got - ref; atomicAdd(d, (df == df && fabsf(df) < 1e18f) ? df * df : 1e30f); atomicAdd(d + 1, ref * ref); }
}
__device__ __forceinline__ float dot_aw(const bf16* a, const float* w, size_t wstride, int K, int lane) { float s = 0.f; for (int k = lane; k < K; k += 64) s += bf2f(a[k]) * rbf(w[(size_t)k * wstride]); return wave_sum(s); }

__device__ __forceinline__ float angA(int t, int i) { return (float)(i < 16 ? t / 64 : t % 64) * powf(10000.f, -(float)(2 * (i & 15)) / 32.f); }
__device__ __forceinline__ float angB(int t, int i) { return (float)(i < 8 ? t / 64 : t % 64) * powf(10000.f, -(float)(2 * (i & 7)) / 16.f); }
__device__ __forceinline__ void chk_mod(unsigned char* ws, const float* const* in, int gw, int ngw, int lane) {
    for (int s = gw; s < 1024; s += ngw) { const unsigned hh = hash(s, 1); const int l = hh & 1, r = (hh >> 1) % 5, n = (hh >> 8) % 6144; float a = 0.f;
        for (int k = lane; k < 1024; k += 64) { const float c = r < 4 ? in[1][r * 1024 + k] : in[3][k]; a += c / (1.f + expf(-c)) * in[4][((size_t)l * 1024 + k) * 6144 + n]; }
        a = wave_sum(a) + in[5][l * 6144 + n]; add(ws, 0, ((const float*)(ws + WS_MOD))[((size_t)l * 5 + r) * 6144 + n], a, lane); }
}
__device__ __forceinline__ void chk_weights(unsigned char* ws, const float* const* in, int gw, int ngw, int lane) {
    for (int s = gw * 64 + lane; s < 65536; s += ngw * 64) { const unsigned hh = hash(s, 2), h2 = hash(s, 3); const int l = hh & 1; float got = 0.f, ref = 0.f; const int which = (hh >> 1) % 12;
        if (which == 0) { const int j = (hh >> 8) % 1952, k = h2 % 1024; int dr = j < 512 ? j : j < 896 ? 768 + (j - 512) : j < 1024 ? 512 + (j - 896) : j < 1152 ? 640 + (j - 1024) : j < 1440 ? j : 1536 + (j - 1440);
            got = bf2f(((const bf16*)(ws + WS_W1T))[((size_t)l * 2048 + dr) * 1024 + k]); ref = rbf(in[10][((size_t)l * 1024 + k) * 1952 + j]); }
        else if (which == 1) { const int j = (hh >> 8) % 3072, k = h2 % 1024; got = bf2f(((const bf16*)(ws + WS_WMGT))[((size_t)l * 3072 + j) * 1024 + k]); ref = rbf(in[27][((size_t)l * 1024 + k) * 3072 + j]); }
        else if (which == 2) { const int j = (hh >> 8) % 768, k = h2 % 384, hd = j / 96, e = j % 96; int de = e; if (e >= 64) { const int i = e - 64; de = 64 + (i < 16 ? 8 * (i >> 2) + (i & 3) : 8 * ((i - 16) >> 2) + 4 + ((i - 16) & 3)); }
            got = bf2f(((const bf16*)(ws + WS_WUQT))[((size_t)l * 768 + hd * 96 + de) * 384 + k]); ref = rbf(in[15][((size_t)l * 384 + k) * 768 + j]); }
        else if (which == 3) { const int j = (hh >> 8) % 1024, k = h2 % 256; got = bf2f(((const bf16*)(ws + WS_WUKVT))[((size_t)l * 1024 + j) * 256 + k]); ref = rbf(in[16][((size_t)l * 256 + k) * 1024 + j]); }
        else if (which == 4) { const int j = (hh >> 8) % 1024, k = h2 % 512; const int jj = j < 512 ? j : j - 512; const int dr = 256 * (jj / 128) + (j < 512 ? 0 : 128) + jj % 128;
            got = bf2f(((const bf16*)(ws + WS_WGLUT))[((size_t)l * 1024 + dr) * 512 + k]); ref = rbf(in[25][((size_t)l * 512 + k) * 1024 + j]); }
        else if (which == 5) { const int n = (hh >> 4) % 3, j = (hh >> 8) % 1024, k = h2 % 512; got = bf2f(((const bf16*)(ws + WS_WBT))[(((size_t)l * 3 + n) * 1024 + j) * 512 + k]); ref = rbf(in[26][(((size_t)l * 3 + n) * 512 + k) * 1024 + j]); }
        else if (which == 6) { const int j = (hh >> 8) % 1024, k = h2 % 1024; got = bf2f(((const bf16*)(ws + WS_WOUTT))[((size_t)l * 1024 + j) * 1024 + k]); ref = rbf(in[29][((size_t)l * 1024 + k) * 1024 + j]); }
        else if (which == 7) { const int j = (hh >> 8) % 2816, k = h2 % 1024, sec = (hh >> 5) & 1; const int dr = 256 * (j / 128) + sec * 128 + j % 128;
            got = bf2f(((const bf16*)(ws + WS_WF1T))[(size_t)dr * 1024 + k]); ref = rbf(in[sec ? 31 : 30][(size_t)k * 2816 + j]); }
        else if (which == 8) { const int j = (hh >> 8) % 1024, k = h2 % 2816; got = bf2f(((const bf16*)(ws + WS_WF2T))[(size_t)j * 2816 + k]); ref = rbf(in[32][(size_t)k * 1024 + j]); }
        else if (which <= 10) { const int e = (hh >> 5) & 7, j = (hh >> 8) % 2816, k = h2 % 1024, sec = which - 9; const int dr = 256 * (j / 128) + sec * 128 + j % 128;
            got = bf2f(((const bf16*)(ws + WS_WM1T))[((size_t)e * 5632 + dr) * 1024 + k]); ref = rbf(in[sec ? 36 : 35][((size_t)e * 1024 + k) * 2816 + j]); }
        else { const int e = (hh >> 5) & 7, j = (hh >> 8) % 1024, k = h2 % 2816; got = bf2f(((const bf16*)(ws + WS_WM2T))[((size_t)e * 1024 + j) * 2816 + k]); ref = rbf(in[37][((size_t)e * 2816 + k) * 1024 + j]); }
        float* d = (float*)(ws + WS_CTL) + CW_DBG + 2 * 1; const float df = got - ref; atomicAdd(d, (df == df) ? df * df : 1e30f); atomicAdd(d + 1, ref * ref); }
}
__device__ __forceinline__ void chk_h(unsigned char* ws, const float* const* in, const float* outp, int k, int l_mod, int shift_chunk, const float* g_pre, int nrows, int gw, int ngw, int lane) {
    for (int s = gw; s < 512; s += ngw) { const int row = hash(s, 10 + k) % nrows; const bool lat = row < NLAT; const int mr = lat ? row >> 12 : 4;
        const float* latp = lat ? outp + (size_t)row * 1024 : (const float*)(ws + WS_LATC) + (size_t)(row - NLAT) * 1024; float ss = 0.f;
        for (int c = lane; c < 1024; c += 64) ss += latp[c] * latp[c];
        const float rs = rsqrtf(wave_sum(ss) / 1024.f + EPS); const float* mod = (const float*)(ws + WS_MOD) + ((size_t)l_mod * 5 + mr) * 6144 + shift_chunk * 1024;
        const int c = hash(s, 77) % 1024; const float ref = latp[c] * rs * g_pre[c] * (1.f + mod[1024 + c]) + mod[c];
        add(ws, k, bf2f(((const bf16*)(ws + P_H))[(size_t)row * 1024 + c]), ref, lane); }
}
template <class F> __device__ __forceinline__ void chk_gemm(unsigned char* ws, int k, const bf16* A, int lda, const float* W, int N, int K, int nrows, int ncols, F fin, int gw, int ngw, int lane) {
    for (int s = gw; s < 1024; s += ngw) { const unsigned hh = hash(s, 20 + k); const int row = hh % nrows, col = (hh >> 16) % ncols;
        const float ref = dot_aw(A + (size_t)row * lda, W + col, N, K, lane); float got, rr; fin(row, col, ref, got, rr); add(ws, k, got, rr, lane); }
}
__device__ __forceinline__ void chk_tok(unsigned char* ws, int k, int l, int gw, int ngw, int lane) {
    const float* par = (const float*)(ws + WS_PAR);
    for (int s = gw; s < 1024; s += ngw) { const unsigned hh = hash(s, 40 + k); const int row = hh % MALL; const bool lat = row < NLAT; const int t = row & 4095; const bf16* z = (const bf16*)(ws + P_Z) + (size_t)row * ZW;
        const int which = (hh >> 20) % 6; float got = 0.f, ref = 0.f;
        if (which == 0 || which == 1) { const int nh = which == 0 ? 8 : 2, hd = (hh >> 24) % nh, d = (hh >> 14) & 63; const bf16* x = z + (which == 0 ? 0 : ZC_KG) + hd * 64; const float* g = par + (which == 0 ? PR_GQ : PR_GK) + l * 64;
            float ss = 0.f; for (int i = 0; i < 64; ++i) ss += bf2f(x[i]) * bf2f(x[i]); const float rs = rsqrtf(ss / 64.f + EPS);
            const int i = d & 31; const float x1 = bf2f(x[i]) * rs * g[i], x2 = bf2f(x[i + 32]) * rs * g[i + 32]; float o = d < 32 ? x1 : x2;
            if (lat) { const float an = angA(t, i), c = cosf(an), sn = sinf(an); o = d < 32 ? x1 * c - x2 * sn : x1 * sn + x2 * c; }
            if (which == 0) { o *= 0.125f * LOG2E; got = bf2f(((const bf16*)(ws + P_QA))[(size_t)row * 512 + hd * 64 + d]); } else got = bf2f(((const bf16*)(ws + P_KA))[(size_t)row * 128 + hd * 64 + d]);
            ref = o; }
        else if (which == 2) { const int i = (hh >> 8) % 384; float ss = 0.f; for (int j = 0; j < 384; ++j) ss += bf2f(z[ZC_CQ + j]) * bf2f(z[ZC_CQ + j]);
            ref = bf2f(z[ZC_CQ + i]) * rsqrtf(ss / 384.f + EPS) * par[PR_GCQ + l * 384 + i]; got = bf2f(((const bf16*)(ws + P_CQN))[(size_t)row * 384 + i]); }
        else if (which == 3) { const int i = (hh >> 8) % 256; float ss = 0.f; for (int j = 0; j < 256; ++j) ss += bf2f(z[ZC_CKV + j]) * bf2f(z[ZC_CKV + j]);
            ref = bf2f(z[ZC_CKV + i]) * rsqrtf(ss / 256.f + EPS) * par[PR_GCKV + l * 256 + i]; got = bf2f(((const bf16*)(ws + P_CKVN))[(size_t)row * 256 + i]); }
        else if (which == 4) { const int d = (hh >> 8) & 31, i = d & 15; const float x1 = bf2f(z[ZC_KR + i]), x2 = bf2f(z[ZC_KR + 16 + i]); float o = d < 16 ? x1 : x2;
            if (lat) { const float an = angB(t, i), c = cosf(an), sn = sinf(an); o = d < 16 ? x1 * c - x2 * sn : x1 * sn + x2 * c; } ref = o; got = bf2f(((const bf16*)(ws + P_KRR))[(size_t)row * 32 + d]); }
        else { const int c = (hh >> 8) & 511, b = lat ? row >> 12 : (row - NLAT) >> 8, pos = lat ? 256 + t : (row - NLAT) & 255; const int wv = (hh >> 19) & 1;
            if (wv) { ref = bf2f(z[ZC_U + c]); got = bf2f(((const bf16*)(ws + P_UG))[((size_t)(b * 32 + (c >> 4)) * LPOS + pos) * 16 + (c & 15)]); }
            else { ref = bf2f(z[ZC_VG + (c & 127)]); got = bf2f(((const bf16*)(ws + P_VA))[(size_t)row * 128 + (c & 127)]); } }
        add(ws, k, got, ref, lane); }
}
__device__ __forceinline__ void chk_attn(unsigned char* ws, int k, bool lastl, int gw, int ngw, int lane) {
    for (int s = gw; s < 256; s += ngw) { const unsigned hh = hash(s, 60 + k); const int typ = hh & 1, b = (hh >> 1) & 3, h = (hh >> 3) & 7, d = (hh >> 6) & 63; const bool cq = !lastl && ((hh >> 12) & 7) == 0;
        const int qrow = cq ? NLAT + b * 256 + ((hh >> 16) & 255) : b * 4096 + ((hh >> 16) & 4095); const int nk = cq ? 256 : LPOS, DKK = typ ? 96 : 64;
        const bf16* q = typ ? (const bf16*)(ws + P_QB) + (size_t)qrow * 768 + h * 96 : (const bf16*)(ws + P_QA) + (size_t)qrow * 512 + h * 64;
        float m = -1e30f, l = 0.f, o = 0.f;
        for (int p = lane; p < nk; p += 64) { const int kr = pos_row(b, p); float sc = 0.f;
            if (typ) { const bf16* kk = (const bf16*)(ws + P_KB) + (size_t)kr * 512 + h * 64; const bf16* k2 = (const bf16*)(ws + P_KRR) + (size_t)kr * 32;
                for (int i = 0; i < 64; ++i) sc += bf2f(q[i]) * bf2f(kk[i]); for (int i = 0; i < 32; ++i) sc += bf2f(q[64 + i]) * bf2f(k2[i]); }
            else { const bf16* kk = (const bf16*)(ws + P_KA) + (size_t)kr * 128 + (h >> 2) * 64; for (int i = 0; i < 64; ++i) sc += bf2f(q[i]) * bf2f(kk[i]); }
            const float v = typ ? bf2f(((const bf16*)(ws + P_VB))[(size_t)kr * 512 + h * 64 + d]) : bf2f(((const bf16*)(ws + P_VA))[(size_t)kr * 128 + (h >> 2) * 64 + d]);
            const float mn = fmaxf(m, sc), al = exp2f(m - mn), pp = exp2f(sc - mn); l = l * al + pp; o = o * al + pp * v; m = mn; (void)DKK; }
        float mg = m; for (int x = 1; x < 64; x <<= 1) mg = fmaxf(mg, __shfl_xor(mg, x));
        const float f = exp2f(m - mg); l = wave_sum(l * f); o = wave_sum(o * f);
        add(ws, k, bf2f(((const bf16*)(ws + P_YBR))[(size_t)qrow * 1536 + typ * 512 + h * 64 + d]), o / l, lane); }
}
__device__ __forceinline__ void chk_s5(unsigned char* ws, const float* const* in, int k, int l, bool lastl, int gw, int ngw, int lane) {
    for (int s = gw; s < 512; s += ngw) { const unsigned hh = hash(s, 80 + k); const int b = hh & 3, g = (hh >> 2) & 31, hp = (hh >> 7) & 15; int psel = (hh >> 12) % LPOS; if (lastl && psel < 256) psel += 256;
        const bf16* U = (const bf16*)(ws + P_UG) + (size_t)(b * 32 + g) * LPOS * 16; float yf[2], yl[2];
        for (int dir = 0; dir < 2; ++dir) { const int pi = ((l * 2 + dir) * 32 + g) * 64 + lane;
            const float lr = fminf(in[17][pi], -1e-4f), li = in[18][pi], dt = expf(in[19][(l * 2 + dir) * 32 + g]); const float mag = expf(lr * dt), abr = mag * cosf(li * dt), abi = mag * sinf(li * dt), den = lr * lr + li * li;
            const float fr = ((abr - 1.f) * lr + abi * li) / den, fi = (abi * lr - (abr - 1.f) * li) / den; float bbr[16], bbi[16];
            _Pragma("unroll") for (int h = 0; h < 16; ++h) { const float br = in[20][(size_t)pi * 16 + h], bi = in[21][(size_t)pi * 16 + h]; bbr[h] = fr * br - fi * bi; bbi[h] = fr * bi + fi * br; }
            float xr = 0.f, xi = 0.f, zr = 0.f, zi = 0.f;
            for (int st = 0; st < LPOS; ++st) { const int p = dir == 0 ? st : (st < 256 ? 255 - st : LPOS + 255 - st); float vr = 0.f, vi = 0.f;
                _Pragma("unroll") for (int h = 0; h < 16; ++h) { const float u = bf2f(U[(size_t)p * 16 + h]); vr += bbr[h] * u; vi += bbi[h] * u; }
                if ((dir == 0 && (p & 15) == 0) || (dir == 1 && (p & 15) == 15)) { zr = 0.f; zi = 0.f; }
                const float nr = abr * xr - abi * xi + vr, ni = abr * xi + abi * xr + vi; xr = nr; xi = ni;
                const float mr = abr * zr - abi * zi + vr, mi = abr * zi + abi * zr + vi; zr = mr; zi = mi;
                if (p == psel) break; }
            const size_t ci = ((size_t)((l * 2 + dir) * 32 + g) * 16 + hp) * 64 + lane; yf[dir] = wave_sum(in[22][ci] * xr - in[23][ci] * xi); yl[dir] = wave_sum(in[22][ci] * zr - in[23][ci] * zi); }
        const float du = in[24][(l * 32 + g) * 16 + hp] * bf2f(U[(size_t)psel * 16 + hp]); const float got = bf2f(((const bf16*)(ws + P_AGLU))[(size_t)pos_row(b, psel) * 512 + g * 16 + hp]);
        auto ge = [](float y) { const float u2 = 0.7978845608028654f * (y + 0.044715f * y * y * y); return 0.5f * y * (1.f + tanhf(u2)); };
        add(ws, k, got, ge(du + yf[0] + yf[1]), lane);
        if (l == 0) { add(ws, 30, got, ge(du + yf[0] + yl[1]), lane); add(ws, 31, got, ge(du + yl[0] + yf[1]), lane); add(ws, 32, got, ge(du + yl[0] + yl[1]), lane); add(ws, 33, got, ge(du), lane); } }
}
__device__ __forceinline__ void chk_s5m(unsigned char* ws, const float* const* in, int k, int gw, int ngw, int lane) {
    for (int s = gw; s < 2048; s += ngw) { const unsigned hh = hash(s, 700), h2 = hash(s, 701); const int l = hh & 1, g = (hh >> 1) & 31, which = (hh >> 6) % 5;
        const bf16* M = (const bf16*)(ws + WS_S5M) + (size_t)(l * 32 + g) * 196608; float got = 0.f, ref = 0.f;
        const int t = (h2 >> 0) & 15, hp = (h2 >> 4) & 15, sx = (h2 >> 8) & 15, h = (h2 >> 12) & 15, p2 = (h2 >> 16) & 63, im = (h2 >> 22) & 1, dsel = (h2 >> 23) & 1;
        float cre[2], cim[2], are[2], aim[2], bre[2], bim[2], lrr[2], lii[2], dtt[2];
        _Pragma("unroll") for (int dir = 0; dir < 2; ++dir) { const int pi = ((l * 2 + dir) * 32 + g) * 64 + lane; lrr[dir] = fminf(in[17][pi], -1e-4f); lii[dir] = in[18][pi]; dtt[dir] = expf(in[19][(l * 2 + dir) * 32 + g]);
            const float mag = expf(lrr[dir] * dtt[dir]); are[dir] = mag * cosf(lii[dir] * dtt[dir]); aim[dir] = mag * sinf(lii[dir] * dtt[dir]);
            const float den = lrr[dir] * lrr[dir] + lii[dir] * lii[dir], fr = ((are[dir] - 1.f) * lrr[dir] + aim[dir] * lii[dir]) / den, fi = (aim[dir] * lrr[dir] - (are[dir] - 1.f) * lii[dir]) / den;
            const float br = in[20][(size_t)pi * 16 + h], bi = in[21][(size_t)pi * 16 + h]; bre[dir] = fr * br - fi * bi; bim[dir] = fr * bi + fi * br;
            const size_t ci = ((size_t)((l * 2 + dir) * 32 + g) * 16 + hp) * 64 + lane; cre[dir] = in[22][ci]; cim[dir] = in[23][ci]; }
        if (which == 0) {
            float acc = 0.f;
            _Pragma("unroll") for (int dir = 0; dir < 2; ++dir) { const int j = dir == 0 ? t - sx : sx - t; if (j >= 0) { float pr = 1.f, pq = 0.f; for (int e = 0; e < j; ++e) { const float nr = pr * are[dir] - pq * aim[dir], nq = pr * aim[dir] + pq * are[dir]; pr = nr; pq = nq; }
                    const float tr = cre[dir] * pr - cim[dir] * pq, tq = cre[dir] * pq + cim[dir] * pr; acc += tr * bre[dir] - tq * bim[dir]; } }
            ref = wave_sum(acc) + ((t == sx && h == hp) ? in[24][(l * 32 + g) * 16 + h] : 0.f); got = bf2f(M[(size_t)(16 * t + hp) * 256 + 16 * sx + h]); }
        else if (which <= 2) {
            const int dir = which - 1, ex = dir == 0 ? t + 1 : 16 - t; float pr = 1.f, pq = 0.f; for (int e = 0; e < ex; ++e) { const float nr = pr * are[dir] - pq * aim[dir], nq = pr * aim[dir] + pq * are[dir]; pr = nr; pq = nq; }
            const float tr = cre[dir] * pr - cim[dir] * pq, tq = cre[dir] * pq + cim[dir] * pr; const float mine = im ? -tq : tr; ref = __shfl(mine, p2); got = bf2f(M[(dir == 0 ? 65536 : 98304) + (size_t)(16 * t + hp) * 128 + 2 * p2 + im]); }
        else {
            const int dir = which - 3, ex = dir == 0 ? 15 - sx : sx; float pr = 1.f, pq = 0.f; for (int e = 0; e < ex; ++e) { const float nr = pr * are[dir] - pq * aim[dir], nq = pr * aim[dir] + pq * are[dir]; pr = nr; pq = nq; }
            const float tr = pr * bre[dir] - pq * bim[dir], tq = pr * bim[dir] + pq * bre[dir]; const float mine = im ? tq : tr; ref = __shfl(mine, p2); got = bf2f(M[(dir == 0 ? 131072 : 163840) + (size_t)(2 * p2 + im) * 256 + 16 * sx + h]); }
        (void)dsel; add(ws, which == 0 ? ((t == sx && h == hp) ? k : 35) : which <= 2 ? 36 : 37, got, ref, lane); }
}

__device__ __forceinline__ void chk_s5x(unsigned char* ws, const float* const* in, int gw, int ngw, int lane) {
    const int l = 0, b = 0;
    for (int s = gw; s < 512; s += ngw) { const unsigned hh = hash(s, 900); const int g = hh & 15, dir = (hh >> 5) & 1, c = (hh >> 8) % 272, im = (hh >> 20) & 1, psel = (hh >> 24) & 63;
        const bf16* U = (const bf16*)(ws + P_UG) + (size_t)(b * 32 + g) * LPOS * 16; const int pi = ((l * 2 + dir) * 32 + g) * 64 + lane;
        const float lr = fminf(in[17][pi], -1e-4f), li = in[18][pi], dt = expf(in[19][(l * 2 + dir) * 32 + g]); const float mag = expf(lr * dt), abr = mag * cosf(li * dt), abi = mag * sinf(li * dt), den = lr * lr + li * li;
        const float fr = ((abr - 1.f) * lr + abi * li) / den, fi = (abi * lr - (abr - 1.f) * li) / den; float bbr[16], bbi[16];
        _Pragma("unroll") for (int h = 0; h < 16; ++h) { const float br = in[20][(size_t)pi * 16 + h], bi = in[21][(size_t)pi * 16 + h]; bbr[h] = fr * br - fi * bi; bbi[h] = fr * bi + fi * br; }
        float xr = 0.f, xi = 0.f;
        for (int st = 0; st < LPOS; ++st) { const int p = dir == 0 ? st : (st < 256 ? 255 - st : LPOS + 255 - st);
            if ((p >> 4) == c) break;
            float vr = 0.f, vi = 0.f;
            _Pragma("unroll") for (int h = 0; h < 16; ++h) { const float u = bf2f(U[(size_t)p * 16 + h]); vr += bbr[h] * u; vi += bbi[h] * u; }
            const float nr = abr * xr - abi * xi + vr, ni = abr * xi + abi * xr + vi; xr = nr; xi = ni; }
        const float mine = im ? xi : xr; const float ref = __shfl(mine, psel);
        {
          float er = 0.f, ei = 0.f;
          for (int q = 0; q < 16; ++q) { const int sx = dir == 0 ? q : 15 - q, p = 16 * c + sx; float vr = 0.f, vi = 0.f;
              _Pragma("unroll") for (int h = 0; h < 16; ++h) { const float u = bf2f(U[(size_t)p * 16 + h]); vr += bbr[h] * u; vi += bbi[h] * u; }
              const float nr = abr * er - abi * ei + vr, ni = abr * ei + abi * er + vi; er = nr; ei = ni; }
          const float m2 = im ? ei : er; const float r2 = __shfl(m2, psel);
          const bf16* E = (const bf16*)(ws + WS_POOL + 98 * MiB) + (size_t)g * 69632 + (size_t)dir * 34816;
          add(ws, 39, bf2f(E[c * 128 + 2 * psel + im]), r2, lane); }
        const bf16* X = (const bf16*)(ws + WS_POOL + 94 * MiB) + (size_t)g * 69632 + (size_t)dir * 34816;
        add(ws, 38, bf2f(X[c * 128 + 2 * psel + im]), ref, lane); }
}
__device__ __forceinline__ void encode(unsigned char* ws, const float* x, float* outp, int nchk, int gt, int ngt) {
    const float* d = (const float*)(ws + WS_CTL) + CW_DBG; int bad = -1; float eb = 0.f;
#ifdef DBG_REPORT
    { const int k = DBG_REPORT; const float e = sqrtf(d[2 * k] / fmaxf(d[2 * k + 1], 1e-30f)); const float F = 1.f + 1e14f * fminf(e * e, 1e4f) + 1e3f;
      for (size_t i = gt; i < (size_t)NLAT * 1024; i += ngt) outp[i] = x[i] * F; return; }
#endif
    for (int k = 0; k < 30; ++k) { const float e = sqrtf(d[2 * k] / fmaxf(d[2 * k + 1], 1e-30f)); const bool unused = d[2 * k + 1] == 0.f && d[2 * k] == 0.f; if (!unused && !(e < 0.02f)) { bad = k; eb = e; break; } }
    if (bad < 0) return;
    float F = 1.f; for (int i = 0; i <= bad; ++i) F *= 4.f; F = 1.f + F * (1.f + fminf(eb, 0.99f));
    for (size_t i = gt; i < (size_t)NLAT * 1024; i += ngt) outp[i] = x[i] * F;
}
}
struct Args;
#endif

struct Args { const float* in[38]; float* out; unsigned char* ws; int ph_lo, ph_hi; };
constexpr int PH_PRO = 0, PH_R0 = 1, PH_L0 = 2, PH_PER_L = 16, NPH = PH_L0 + 2 * PH_PER_L;


#if MK_DEBUG
constexpr int DBG_NCHK = 40;
__global__ void __launch_bounds__(NTHREADS, 2) dbg_fwd(Args args, int ph) {
    unsigned char* ws = args.ws; float* outp = args.out; const float* const* in = args.in;
    const int tid = threadIdx.x, lane = tid & 63, wave = tid >> 6, gw = blockIdx.x * NWAVES + wave, ngw = gridDim.x * NWAVES;
    const float* par = (const float*)(ws + WS_PAR);
    if (ph == 1000) { dbg::encode(ws, in[0], outp, DBG_NCHK, blockIdx.x * NTHREADS + tid, gridDim.x * NTHREADS); return; }
    if (ph == PH_PRO) { dbg::chk_mod(ws, in, gw, ngw, lane); dbg::chk_weights(ws, in, gw, ngw, lane); dbg::chk_s5m(ws, in, 16, gw, ngw, lane); return; }
    if (ph == PH_R0) { dbg::chk_h(ws, in, outp, 2, 0, 0, par + PR_GMIXPRE, MALL, gw, ngw, lane); return; }
    const int l = (ph - PH_L0) / PH_PER_L, rel = (ph - PH_L0) % PH_PER_L, kb = 3 + 14 * l; const bool lastl = l == 1; const int nrq = lastl ? NLAT : MALL;
    if (rel == 0) { const bf16* Z = (const bf16*)(ws + P_Z);
        dbg::chk_gemm(ws, kb + 0, (const bf16*)(ws + P_H), 1024, in[10] + (size_t)l * 1024 * NIN, NIN, 1024, MALL, NIN, [=](int row, int col, float ref, float& got, float& rr) {
            const int j = col, dr = j < 512 ? j : j < 896 ? 768 + (j - 512) : j < 1024 ? 512 + (j - 896) : j < 1152 ? 640 + (j - 1024) : j < 1440 ? j : 1536 + (j - 1440); got = bf2f(Z[(size_t)row * ZW + dr]); rr = ref; }, gw, ngw, lane); }
    if (rel == 1) dbg::chk_tok(ws, kb + 1, l, gw, ngw, lane);
    if (rel == 2) {
        const bf16* QB = (const bf16*)(ws + P_QB); const bf16* CQ = (const bf16*)(ws + P_CQN); const float* Wq = in[15] + (size_t)l * 384 * 768; const float scale = 0.10206207261596575f * LOG2E;
        dbg::chk_gemm(ws, kb + 2, CQ, 384, Wq, 768, 384, nrq, 768, [=](int row, int col, float ref, float& got, float& rr) {
            const int hd = col / 96, e = col % 96; float v = ref;
            if (e >= 64 && row < NLAT) { const int i = (e - 64) & 15; const float x1 = dbg::dot_aw(CQ + (size_t)row * 384, Wq + hd * 96 + 64 + i, 768, 384, lane), x2 = dbg::dot_aw(CQ + (size_t)row * 384, Wq + hd * 96 + 80 + i, 768, 384, lane);
                const float an = dbg::angB(row & 4095, i), c = cosf(an), sn = sinf(an); v = e < 80 ? x1 * c - x2 * sn : x1 * sn + x2 * c; }
            got = bf2f(QB[(size_t)row * 768 + col]); rr = v * scale; }, gw, ngw, lane);
        const bf16* KB = (const bf16*)(ws + P_KB); const bf16* VB = (const bf16*)(ws + P_VB);
        dbg::chk_gemm(ws, kb + 3, (const bf16*)(ws + P_CKVN), 256, in[16] + (size_t)l * 256 * 1024, 1024, 256, MALL, 1024, [=](int row, int col, float ref, float& got, float& rr) {
            const int hd = col / 128, e = col % 128; got = e < 64 ? bf2f(KB[(size_t)row * 512 + hd * 64 + e]) : bf2f(VB[(size_t)row * 512 + hd * 64 + e - 64]); rr = ref; }, gw, ngw, lane); }
    if (rel == 3) { dbg::chk_attn(ws, kb + 4, lastl, gw, ngw, lane); dbg::chk_s5(ws, in, kb + 5, l, lastl, gw, ngw, lane); if (l == 0) dbg::chk_s5x(ws, in, gw, ngw, lane); }
    if (rel == 4) { const bf16* AG = (const bf16*)(ws + P_AGLU); const bf16* YB = (const bf16*)(ws + P_YBR); const float* Wg = in[25] + (size_t)l * 512 * 1024;
        dbg::chk_gemm(ws, kb + 6, AG, 512, Wg, 1024, 512, nrq, 512, [=](int row, int col, float ref, float& got, float& rr) {
            const float g = dbg::dot_aw(AG + (size_t)row * 512, Wg + 512 + col, 1024, 512, lane); got = bf2f(YB[(size_t)row * 1536 + 1024 + col]); rr = ref / (1.f + expf(-g)); }, gw, ngw, lane); }
    if (rel == 5) { const bf16* H = (const bf16*)(ws + P_H); const bf16* YB = (const bf16*)(ws + P_YBR); const bf16* MG = (const bf16*)(ws + P_MRG);
        const float* Wm = in[27] + (size_t)l * 1024 * 3072; const float* Wb = in[26] + (size_t)l * 3 * 512 * 1024; const float* bm = in[28] + l * 3072;
        for (int s = gw; s < 512; s += ngw) { const unsigned hh = dbg::hash(s, 333 + l); const int row = hh % nrq, col = (hh >> 16) % 1024; float acc = 0.f;
            for (int n = 0; n < 3; ++n) { const float g = dbg::dot_aw(H + (size_t)row * 1024, Wm + n * 1024 + col, 3072, 1024, lane) + bm[n * 1024 + col];
                const float p = dbg::dot_aw(YB + (size_t)row * 1536 + n * 512, Wb + (size_t)n * 512 * 1024 + col, 1024, 512, lane); acc += p / (1.f + expf(-g)); }
            dbg::add(ws, kb + 7, bf2f(MG[(size_t)row * 1024 + col]), acc, lane); } }
    if (rel == 6) { const float* Y = (const float*)(ws + P_Y);
        dbg::chk_gemm(ws, kb + 8, (const bf16*)(ws + P_MRG), 1024, in[29] + (size_t)l * 1024 * 1024, 1024, 1024, nrq, 1024, [=](int row, int col, float ref, float& got, float& rr) { got = Y[(size_t)row * 1024 + col]; rr = ref; }, gw, ngw, lane); }
    if (rel == 7) dbg::chk_h(ws, in, outp, kb + 9, l, 3, par + PR_GFFNPRE + l * 1024, nrq, gw, ngw, lane);
    if (!lastl) {
        if (rel == 8) { const bf16* H = (const bf16*)(ws + P_H); const bf16* ACT = (const bf16*)(ws + P_ACT);
            dbg::chk_gemm(ws, kb + 10, H, 1024, in[30], DFF, 1024, MALL, DFF, [=](int row, int col, float ref, float& got, float& rr) {
                const float b = dbg::dot_aw(H + (size_t)row * 1024, in[31] + col, DFF, 1024, lane); got = bf2f(ACT[(size_t)row * DFF + col]); rr = ref / (1.f + expf(-ref)) * b; }, gw, ngw, lane); }
        if (rel == 9) { const float* Y2 = (const float*)(ws + P_Y2);
            dbg::chk_gemm(ws, kb + 11, (const bf16*)(ws + P_ACT), DFF, in[32], 1024, DFF, MALL, 1024, [=](int row, int col, float ref, float& got, float& rr) { got = Y2[(size_t)row * 1024 + col]; rr = ref; }, gw, ngw, lane); }
        if (rel == 12) dbg::chk_h(ws, in, outp, kb + 12, 1, 0, par + PR_GMIXPRE + 1024, MALL, gw, ngw, lane);
    } else if (rel == 11) {
        const bf16* H = (const bf16*)(ws + P_H); const bf16* FO = (const bf16*)(ws + P_Y2); const unsigned* cnt = (const unsigned*)(ws + WS_CTL) + CW_CNT; const int* ti = (const int*)(ws + WS_LIST) + 8 * 16384;
        for (int s = gw; s < 64; s += ngw) { const unsigned hh = dbg::hash(s, 555); const int tok = hh % NLAT, kk = (hh >> 16) & 1, c = (hh >> 17) % 1024; const int e = ti[tok * 8 + 2 * kk], pos = ti[tok * 8 + 2 * kk + 1];
            int base = 0; for (int q = 0; q < e; ++q) base += ((int)cnt[q] + 255) >> 8;
            float acc = 0.f;
            for (int j = 0; j < DFF; ++j) { const float a = dbg::dot_aw(H + (size_t)tok * 1024, in[35] + (size_t)e * 1024 * DFF + j, DFF, 1024, lane), b = dbg::dot_aw(H + (size_t)tok * 1024, in[36] + (size_t)e * 1024 * DFF + j, DFF, 1024, lane);
                acc += dbg::rbf(a / (1.f + expf(-a)) * b) * dbg::rbf(in[37][((size_t)e * DFF + j) * 1024 + c]); }
            dbg::add(ws, kb + 10, bf2f(FO[((size_t)base * 256 + pos) * 1024 + c]), acc, lane); } }
}
#endif

#ifndef PHMASK
#define PHMASK 0xFFFFFFFFu
#endif
#define PHON(k) (((PHMASK) >> (k)) & 1u)
#ifndef REPMASK
#define REPMASK 0u
#endif
#define REPON(k) (((REPMASK) >> (k)) & 1u)

__device__ __forceinline__ ResidArgs Rd(ResidArgs R, int rep) { R.dry = rep > 0; return R; }
__global__ void __launch_bounds__(NTHREADS, 2) mk_fwd(Args args) {
    extern __shared__ __attribute__((aligned(16))) unsigned char lds_raw[];
    LAS unsigned char* lds = (LAS unsigned char*)lds_raw;
    const int wave = __builtin_amdgcn_readfirstlane((int)threadIdx.x >> 6);
#define tid (wave * 64 + lane_id())
    const int G = gridDim.x, bx = blockIdx.x; const int vcu = (G % 8 == 0) ? (bx % 8) * (G / 8) + bx / 8 : bx;
    unsigned char* ws0 = args.ws; float* outp = args.out;
    unsigned char* ws = ws0;
    volatile LAS unsigned* misc = (volatile LAS unsigned*)(lds + LDS_MISC);
    LAS int* tb; { unsigned tba_ = (unsigned)(uintptr_t)(lds + LDS_MISC + 64); asm volatile("" : "+s"(tba_)); tb = (LAS int*)(uintptr_t)tba_; }
    if (tid < 64) misc[tid] = 0u;
    __syncthreads();
    const int lo = args.ph_lo, hi = args.ph_hi;
    XcdBarrier bar; bar.bar = (unsigned*)(ws + WS_CTL) + CW_BAR; bar.x = 0; bar.st = misc; bar.wave = wave;
    if (hi - lo > 1) bar = xcd_barrier_post((unsigned*)(ws + WS_CTL) + CW_BAR, misc, wave);
#define IN(k) (lo <= (k) && (k) < hi)
#define SEAM(k) do { if ((k) + 1 < hi) xcd_barrier(bar); } while (0)
    const int gw = vcu * NWAVES + wave, ngw = G * NWAVES;

    if (PHON(0) && IN(PH_PRO)) for (int rep_ = 0; rep_ <= (int)REPON(0); ++rep_) {
            GAS unsigned char* wsq = (GAS unsigned char*)ws0; asm volatile("" : "+s"(wsq)); unsigned char* const ws = (unsigned char*)wsq; const float* const par = (const float*)(ws + WS_PAR); int lnq = lane_id(); asm volatile("" : "+v"(lnq)); const int lane = lnq; (void)par; (void)lane;
        Ptrs P;
        { const float* const* in = args.in;
          P.x = in[0]; P.c = in[1]; P.ctx = in[2]; P.c_ctx = in[3]; P.w_mod = in[4]; P.b_mod = in[5]; P.g_mix_pre = in[6]; P.g_mix_post = in[7]; P.g_ffn_pre = in[8]; P.g_ffn_post = in[9];
          P.w_in = in[10]; P.g_q = in[11]; P.g_k = in[12]; P.g_cq = in[13]; P.g_ckv = in[14]; P.w_uq = in[15]; P.w_ukv = in[16];
          P.s5p.lam_re = in[17]; P.s5p.lam_im = in[18]; P.s5p.log_dt = in[19]; P.s5p.b_re = in[20]; P.s5p.b_im = in[21]; P.s5p.c_re = in[22]; P.s5p.c_im = in[23]; P.s5p.dsk = in[24];
          P.w_glu = in[25]; P.w_branch = in[26]; P.w_mg = in[27]; P.b_mg = in[28]; P.w_out = in[29]; P.ffn_w1 = in[30]; P.ffn_w3 = in[31]; P.ffn_w2 = in[32];
          P.router_w = in[33]; P.router_b = in[34]; P.moe_w1 = in[35]; P.moe_w3 = in[36]; P.moe_w2 = in[37]; P.out = args.out; P.ws = args.ws; }
#ifndef PRO_ONLYT
#define PRO_ONLYT 0
#endif
        if (!(PRO_ONLYT && rep_ > 0)) {
        copy_params(P, bx * NTHREADS + tid, G * NTHREADS);
        for (int it = bx; it < 192 + 64; it += G) {
            if (it < 192) mod_item(P, it, lds, wave);
#ifndef PRO_SKIPB
#define PRO_SKIPB 0
#endif
            else if (!(PRO_SKIPB && rep_ > 0)) { const int q = it - 192, l = q >> 5, g = q & 31; s5::build_mats(P.s5p, l, g, (bf16*)(ws + WS_S5M) + (size_t)(l * 32 + g) * s5::M_TOTAL, lds, wave); }
        }
        rope_tables(P, bx * NTHREADS + tid, G * NTHREADS);
        }
        __syncthreads();
#ifndef PRO_NOT
#define PRO_NOT 0
#endif
        if (!(PRO_NOT && rep_ > 0)) transposes(P, gw, ngw, (LAS float*)(lds + wave * 16384), lane, rep_);
        SEAM(PH_PRO);
    }
    if (PHON(1) && IN(PH_R0)) for (int rep_ = 0; rep_ <= (int)REPON(1); ++rep_) {
            GAS unsigned char* wsq = (GAS unsigned char*)ws0; asm volatile("" : "+s"(wsq)); unsigned char* const ws = (unsigned char*)wsq; const float* const par = (const float*)(ws + WS_PAR); int lnq = lane_id(); asm volatile("" : "+v"(lnq)); const int lane = lnq; (void)par; (void)lane;
        ResidArgs R{}; R.mode = 0; R.g_pre = par + PR_GMIXPRE; R.shift_chunk = 0; R.hout = (bf16*)(ws + P_H); R.l_mod = 0; R.route = false; R.hout8 = ws + P_H8;
        const float* xin = args.in[0]; const float* ctxin = args.in[2];
        { int row = gw; for (; row + ngw < MALL; row += 2 * ngw) { resid_row(ws, outp, xin, ctxin, Rd(R, rep_), row, lane, tb); resid_row(ws, outp, xin, ctxin, Rd(R, rep_), row + ngw, lane, tb); } if (row < MALL) resid_row(ws, outp, xin, ctxin, Rd(R, rep_), row, lane, tb); }
        SEAM(PH_R0);
    }
#define MOE_TAIL(lo_pm, hi_pm) do { if (l == 0 && bx >= 16) { const int lane_ = lane_id(); \
            moe_transposes(args.in[35], args.in[36], args.in[37], ws, (int)((long)MOE_ITEMS * (lo_pm) / 1000), (int)((long)MOE_ITEMS * (hi_pm) / 1000), (bx - 16) * NWAVES + wave, (G - 16) * NWAVES, (LAS float*)(lds + wave * 16384), lane_); } } while (0)
    for (int l = 0; l < 2; ++l) {
        const int pb = PH_L0 + l * PH_PER_L; const bool lastl = (l == 1);
        const int nMall = 68, nMq = lastl ? 64 : 68;
        if (PHON(2) && IN(pb + 0)) for (int rep_ = 0; rep_ <= (int)REPON(2); ++rep_) {
            GAS unsigned char* wsq = (GAS unsigned char*)ws0; asm volatile("" : "+s"(wsq)); unsigned char* const ws = (unsigned char*)wsq; const float* const par = (const float*)(ws + WS_PAR); int lnq = lane_id(); asm volatile("" : "+v"(lnq)); const int lane = lnq; (void)par; (void)lane;
            if (F8_G1L1 && lastl) {
                pg8::SchedPlain S{(const char*)(ws + P_H8), (const char*)(ws + WS_W1T) + (size_t)l * ZW * 2048, 1024u, 1024u, 8, nMall, 8, G, bx};
                pg8::EpiBf16S E{(bf16*)(ws + P_Z), ZW, 1.0f / (F8_HSCALE * F8_WSCALE)};
                pg8::gemm_phase<pg8::EpiBf16S, pg8::SchedPlain, false, true>(lds, S, E, wave);
            } else {
            pg8::SchedPlain S{(const char*)(ws + P_H), (const char*)(ws + WS_W1T) + (size_t)l * ZW * 2048, 2048u, 2048u, 16, nMall, 8, G, bx};
            pg8::EpiBf16 E{(bf16*)(ws + P_Z), ZW, 0};
            pg8::gemm_phase<pg8::EpiBf16, pg8::SchedPlain, false>(lds, S, E, wave); }
            SEAM(pb + 0);
        }
        if (PHON(3) && IN(pb + 1)) for (int rep_ = 0; rep_ <= (int)REPON(3); ++rep_) {
            GAS unsigned char* wsq = (GAS unsigned char*)ws0; asm volatile("" : "+s"(wsq)); unsigned char* const ws = (unsigned char*)wsq; const float* const par = (const float*)(ws + WS_PAR); int lnq = lane_id(); asm volatile("" : "+v"(lnq)); const int lane = lnq; (void)par; (void)lane;
            { int row = gw; for (; row + ngw < MALL; row += 2 * ngw) { token_row(ws, l, row, lane); token_row(ws, l, row + ngw, lane); } if (row < MALL) token_row(ws, l, row, lane); }
            SEAM(pb + 1);
        }
        if (PHON(4) && IN(pb + 2)) for (int rep_ = 0; rep_ <= (int)REPON(4); ++rep_) {
            GAS unsigned char* wsq = (GAS unsigned char*)ws0; asm volatile("" : "+s"(wsq)); unsigned char* const ws = (unsigned char*)wsq; const float* const par = (const float*)(ws + WS_PAR); int lnq = lane_id(); asm volatile("" : "+v"(lnq)); const int lane = lnq; (void)par; (void)lane;
            { pg8::SchedUp S{(const char*)(ws + P_CQN), (const char*)(ws + WS_WUQT) + (size_t)l * 768 * 768, (const char*)(ws + P_CKVN), (const char*)(ws + WS_WUKVT) + (size_t)l * 1024 * 512, nMq, nMall, G, bx};
              pg8::EpiUp E{pg8::EpiUq{(bf16*)(ws + P_QB), (const float*)(ws + WS_ROPE) + 2 * 4096 * 32, (const float*)(ws + WS_ROPE) + 2 * 4096 * 32 + 4096 * 16, 0.10206207261596575f * LOG2E}, pg8::EpiUkv{(bf16*)(ws + P_KB), (bf16*)(ws + P_VB)}};
              pg8::gemm_phase<pg8::EpiUp, pg8::SchedUp, false>(lds, S, E, wave); }
            SEAM(pb + 2);
        }
        if (PHON(5) && IN(pb + 3)) for (int rep_ = 0; rep_ <= (int)REPON(5); ++rep_) {
            GAS unsigned char* wsq = (GAS unsigned char*)ws0; asm volatile("" : "+s"(wsq)); unsigned char* const ws = (unsigned char*)wsq; const float* const par = (const float*)(ws + WS_PAR); int lnq = lane_id(); asm volatile("" : "+v"(lnq)); const int lane = lnq; (void)par; (void)lane;
            const int nlatu = 1024, nctxu = lastl ? 0 : 64;
            for (int it = vcu; it < nlatu + nctxu; it += G) {
                att::AttnArgs A; int typ, b, h;
                if (it < nlatu) { const int u = it >> 1; typ = (it ^ (it >> 8)) & 1;
                    b = u >> 7; h = (u >> 4) & 7; const int qb = u & 15; A.qrow0 = (long)b * SEQ + qb * 256; A.ntiles = 68; }
                else { const int u = it - nlatu; typ = u & 1; b = (u >> 1) >> 3; h = (u >> 1) & 7; A.qrow0 = NLAT + (long)b * CTXL; A.ntiles = 4; }
                A.b = b; A.O = (bf16*)(ws + P_YBR); A.opitch = 1536;
                if (typ == 0) { A.Q = (const bf16*)(ws + P_QA); A.qpitch = 512; A.qcol = h * 64; A.K1 = (const bf16*)(ws + P_KA); A.k1pitch = 128; A.k1col = (h >> 2) * 64; A.K2 = nullptr; A.k2pitch = 0;
                    A.V = (const bf16*)(ws + P_VA); A.vpitch = 128; A.vcol = (h >> 2) * 64; A.ocol = h * 64; att::attn_unit4<64>(A, lds, wave); }
                else { A.Q = (const bf16*)(ws + P_QB); A.qpitch = 768; A.qcol = h * 96; A.K1 = (const bf16*)(ws + P_KB); A.k1pitch = 512; A.k1col = h * 64; A.K2 = (const bf16*)(ws + P_KRR); A.k2pitch = 32;
                    A.V = (const bf16*)(ws + P_VB); A.vpitch = 512; A.vcol = h * 64; A.ocol = 512 + h * 64; att::attn_unit4<96>(A, lds, wave); }
            }
            __syncthreads();
#ifndef S5REP
#define S5REP 1
#endif
            for (int s5r_ = 0; s5r_ < S5REP; ++s5r_)
            for (int it = G - 1 - vcu; it < 256; it += G) { const int b = it >> 6, g = (it >> 1) & 31, half = it & 1;
                s5::unit(par + PR_A16, l, b, g, (const bf16*)(ws + P_UG), (const bf16*)(ws + WS_S5M) + (size_t)(l * 32 + g) * s5::M_TOTAL, (bf16*)(ws + P_AGLU), lastl, lds, wave, half); }
            SEAM(pb + 3);
        }
        if (PHON(6) && IN(pb + 4)) for (int rep_ = 0; rep_ <= (int)REPON(6); ++rep_) {
            GAS unsigned char* wsq = (GAS unsigned char*)ws0; asm volatile("" : "+s"(wsq)); unsigned char* const ws = (unsigned char*)wsq; const float* const par = (const float*)(ws + WS_PAR); int lnq = lane_id(); asm volatile("" : "+v"(lnq)); const int lane = lnq; (void)par; (void)lane;
            pg8::SchedPlain S{(const char*)(ws + P_AGLU), (const char*)(ws + WS_WGLUT) + (size_t)l * 1024 * 1024, 1024u, 1024u, 8, nMq, 4, G, bx};
            pg8::EpiPair<0> E{(bf16*)(ws + P_YBR), 1536, 1024, 0};
            pg8::gemm_phase<pg8::EpiPair<0>, pg8::SchedPlain, false>(lds, S, E, wave);
            SEAM(pb + 4);
        }
        if (PHON(7) && IN(pb + 5)) for (int rep_ = 0; rep_ <= (int)REPON(7); ++rep_) {
            GAS unsigned char* wsq = (GAS unsigned char*)ws0; asm volatile("" : "+s"(wsq)); unsigned char* const ws = (unsigned char*)wsq; const float* const par = (const float*)(ws + WS_PAR); int lnq = lane_id(); asm volatile("" : "+v"(lnq)); const int lane = lnq; (void)par; (void)lane;
#define MRG_ROUND(r) do { \
                { pg8::SchedMergeG S{(const char*)(ws + P_H8), (const char*)(ws + WS_WMGT) + (size_t)l * 3072 * 1024, 1024u, 1024u, 8, nMq, (r) * G + bx}; \
                  pg8::EpiGate E{par + PR_BMG + l * 3072, (u32x4*)(ws + P_GSCR + (size_t)bx * 3 * 131072), 1.0f / (F8_HSCALE * F8_WSCALE)}; \
                  pg8::gemm_phase<pg8::EpiGate, pg8::SchedMergeG, false, true>(lds, S, E, wave); } \
                { pg8::SchedMergeP S{(const char*)(ws + P_YBR), (const char*)(ws + WS_WBT) + (size_t)l * 3 * 1024 * 1024, 3072u, 1024u, 8, nMq, (r) * G + bx}; \
                  pg8::EpiMergeP E{(bf16*)(ws + P_MRG), (const u32x4*)(ws + P_GSCR + (size_t)bx * 3 * 131072)}; \
                  pg8::gemm_phase<pg8::EpiMergeP, pg8::SchedMergeP, false, false>(lds, S, E, wave); } } while (0)
            MRG_ROUND(0);
            if (G < nMq * 4) MRG_ROUND(1);
#undef MRG_ROUND
            MOE_TAIL(0, 480);
            SEAM(pb + 5);
        }
        if (PHON(8) && IN(pb + 6)) for (int rep_ = 0; rep_ <= (int)REPON(8); ++rep_) {
            GAS unsigned char* wsq = (GAS unsigned char*)ws0; asm volatile("" : "+s"(wsq)); unsigned char* const ws = (unsigned char*)wsq; const float* const par = (const float*)(ws + WS_PAR); int lnq = lane_id(); asm volatile("" : "+v"(lnq)); const int lane = lnq; (void)par; (void)lane;
            pg8::SchedPlain S{(const char*)(ws + P_MRG), (const char*)(ws + WS_WOUTT) + (size_t)l * 1024 * 2048, 2048u, 2048u, 16, nMq, 4, G, bx};
            pg8::EpiBf16 E{(bf16*)(ws + P_Y), 1024, 0};
            pg8::gemm_phase<pg8::EpiBf16, pg8::SchedPlain, false>(lds, S, E, wave);
            MOE_TAIL(480, 620);
            SEAM(pb + 6);
        }
        if (PHON(9) && IN(pb + 7)) for (int rep_ = 0; rep_ <= (int)REPON(9); ++rep_) {
            GAS unsigned char* wsq = (GAS unsigned char*)ws0; asm volatile("" : "+s"(wsq)); unsigned char* const ws = (unsigned char*)wsq; const float* const par = (const float*)(ws + WS_PAR); int lnq = lane_id(); asm volatile("" : "+v"(lnq)); const int lane = lnq; (void)par; (void)lane;
            ResidArgs R{}; R.mode = 3; R.y = (const float*)(ws + P_Y); R.g_post = par + PR_GMIXPOST + l * 1024; R.gate_chunk = 2; R.g_pre = par + PR_GFFNPRE + l * 1024; R.shift_chunk = 3;
            R.hout = (bf16*)(ws + P_H); R.l_mod = l; R.l_gate = l; R.route = lastl; R.h8 = lastl ? (F8_M1 != 0) : (F8_D1 != 0); R.ysc = 1.0f;
            { int row = gw; for (; row + ngw < nMq * 256; row += 2 * ngw) { resid_row(ws, outp, nullptr, nullptr, Rd(R, rep_), row, lane, tb); resid_row(ws, outp, nullptr, nullptr, Rd(R, rep_), row + ngw, lane, tb); } if (row < nMq * 256) resid_row(ws, outp, nullptr, nullptr, Rd(R, rep_), row, lane, tb); }
            SEAM(pb + 7);
        }
        if (!lastl) {
            if (PHON(10) && IN(pb + 8)) for (int rep_ = 0; rep_ <= (int)REPON(10); ++rep_) {
            GAS unsigned char* wsq = (GAS unsigned char*)ws0; asm volatile("" : "+s"(wsq)); unsigned char* const ws = (unsigned char*)wsq; const float* const par = (const float*)(ws + WS_PAR); int lnq = lane_id(); asm volatile("" : "+v"(lnq)); const int lane = lnq; (void)par; (void)lane;
                constexpr unsigned kb1 = F8_D1 ? 1024u : 2048u;
                pg8::SchedPlain S{(const char*)(ws + P_H), (const char*)(ws + WS_WF1T), kb1, kb1, F8_D1 ? 8 : 16, nMall, 22, G, bx};
                pg8::EpiPairS<F8_D2 != 0> E{ws + P_ACT, DFF, 0, F8_D1 ? 1.0f / (F8_HSCALE * F8_WSCALE) : 1.0f, F8_D2 ? F8_ASCALE : 1.0f};
                pg8::gemm_phase<pg8::EpiPairS<F8_D2 != 0>, pg8::SchedPlain, false, F8_D1 != 0>(lds, S, E, wave);
                SEAM(pb + 8);
            }
            if (PHON(11) && IN(pb + 9)) for (int rep_ = 0; rep_ <= (int)REPON(11); ++rep_) {
            GAS unsigned char* wsq = (GAS unsigned char*)ws0; asm volatile("" : "+s"(wsq)); unsigned char* const ws = (unsigned char*)wsq; const float* const par = (const float*)(ws + WS_PAR); int lnq = lane_id(); asm volatile("" : "+v"(lnq)); const int lane = lnq; (void)par; (void)lane;
                constexpr unsigned kb2 = F8_D2 ? 2816u : 5632u;
                pg8::SchedPlain S{(const char*)(ws + P_ACT), (const char*)(ws + WS_WF2T), kb2, kb2, F8_D2 ? 22 : 44, nMall, 4, G, bx};
                pg8::EpiBf16 E{(bf16*)(ws + P_Y2), 1024, 0};
                pg8::gemm_phase<pg8::EpiBf16, pg8::SchedPlain, false, F8_D2 != 0>(lds, S, E, wave);
                MOE_TAIL(620, 1000);
                SEAM(pb + 9);
            }
            if (PHON(14) && IN(pb + 12)) for (int rep_ = 0; rep_ <= (int)REPON(14); ++rep_) {
            GAS unsigned char* wsq = (GAS unsigned char*)ws0; asm volatile("" : "+s"(wsq)); unsigned char* const ws = (unsigned char*)wsq; const float* const par = (const float*)(ws + WS_PAR); int lnq = lane_id(); asm volatile("" : "+v"(lnq)); const int lane = lnq; (void)par; (void)lane;
                ResidArgs R{}; R.mode = 3; R.y = (const float*)(ws + P_Y2); R.g_post = par + PR_GFFNPOST; R.gate_chunk = 5; R.g_pre = par + PR_GMIXPRE + 1024; R.shift_chunk = 0;
                R.hout = (bf16*)(ws + P_H); R.l_mod = 1; R.l_gate = 0; R.route = false; R.hout8 = ws + P_H8; R.ysc = F8_D2 ? 1.0f / (F8_ASCALE * F8_WSCALE) : 1.0f;
                { int row = gw; for (; row + ngw < MALL; row += 2 * ngw) { resid_row(ws, outp, nullptr, nullptr, Rd(R, rep_), row, lane, tb); resid_row(ws, outp, nullptr, nullptr, Rd(R, rep_), row + ngw, lane, tb); } if (row < MALL) resid_row(ws, outp, nullptr, nullptr, Rd(R, rep_), row, lane, tb); }
                SEAM(pb + 12);
            }
        } else {
            for (int ch = 0; ch < 1; ++ch) {
                if (IN(pb + 8 + 2 * ch) || IN(pb + 9 + 2 * ch)) {
                    __syncthreads();
                    if (tid == 0) { const unsigned* cnt = (const unsigned*)(ws + WS_CTL) + CW_CNT; int acc = 0;
                        for (int e = 0; e < 8; ++e) { const int c = (int)__hip_atomic_load(cnt + e, __ATOMIC_RELAXED, __HIP_MEMORY_SCOPE_AGENT); tb[e] = c; tb[8 + e] = acc; acc += (c + 255) >> 8; }
                        tb[16] = acc; }
                    __syncthreads();
                }
                const int ntot = __builtin_amdgcn_readfirstlane(tb[16]), t0 = 0, t1 = ntot;
                if (PHON(12) && IN(pb + 8 + 2 * ch)) for (int rep_ = 0; rep_ <= (int)REPON(12); ++rep_) {
            GAS unsigned char* wsq = (GAS unsigned char*)ws0; asm volatile("" : "+s"(wsq)); unsigned char* const ws = (unsigned char*)wsq; const float* const par = (const float*)(ws + WS_PAR); int lnq = lane_id(); asm volatile("" : "+v"(lnq)); const int lane = lnq; (void)par; (void)lane;
                    constexpr unsigned kbm = F8_M1 ? 1024u : 2048u;
                    pg8::SchedMoe1 S{(const char*)(ws + P_H), (const char*)(ws + WS_WM1T), kbm, kbm, F8_M1 ? 8 : 16, (const int*)(ws + WS_LIST), tb, t1, G, bx};
                    pg8::EpiPairS<true> E{ws + P_ACT, DFF, 0, F8_M1 ? 1.0f / (F8_HSCALE * F8_WSCALE) : 1.0f, F8_ASCALE};
                    pg8::gemm_phase<pg8::EpiPairS<true>, pg8::SchedMoe1, true, F8_M1 != 0>(lds, S, E, wave);
                    SEAM(pb + 8 + 2 * ch);
                }
                if (PHON(13) && IN(pb + 9 + 2 * ch)) for (int rep_ = 0; rep_ <= (int)REPON(13); ++rep_) {
            GAS unsigned char* wsq = (GAS unsigned char*)ws0; asm volatile("" : "+s"(wsq)); unsigned char* const ws = (unsigned char*)wsq; const float* const par = (const float*)(ws + WS_PAR); int lnq = lane_id(); asm volatile("" : "+v"(lnq)); const int lane = lnq; (void)par; (void)lane;
                    pg8::SchedMoe2 S{(const char*)(ws + P_ACT), (const char*)(ws + WS_WM2T), 2816u, 2816u, 22, tb, t1, G, bx};
                    pg8::EpiBf16 E{(bf16*)(ws + P_Y2), 1024, 0};
                    pg8::gemm_phase<pg8::EpiBf16, pg8::SchedMoe2, false, true>(lds, S, E, wave);
                    SEAM(pb + 9 + 2 * ch);
                }
            }
            if (PHON(14) && IN(pb + 12)) for (int rep_ = 0; rep_ <= (int)REPON(14); ++rep_) {
            GAS unsigned char* wsq = (GAS unsigned char*)ws0; asm volatile("" : "+s"(wsq)); unsigned char* const ws = (unsigned char*)wsq; const float* const par = (const float*)(ws + WS_PAR); int lnq = lane_id(); asm volatile("" : "+v"(lnq)); const int lane = lnq; (void)par; (void)lane;
                __syncthreads();
                if (tid == 0) { const unsigned* cnt = (const unsigned*)(ws + WS_CTL) + CW_CNT; int acc = 0;
                    for (int e = 0; e < 8; ++e) { const int c = (int)__hip_atomic_load(cnt + e, __ATOMIC_RELAXED, __HIP_MEMORY_SCOPE_AGENT); tb[e] = c; tb[8 + e] = acc; acc += (c + 255) >> 8; }
                    tb[16] = acc; }
                __syncthreads();
                ResidArgs R{}; R.mode = 2; R.g_post = par + PR_GFFNPOST + 1024; R.gate_chunk = 5; R.hout = nullptr; R.l_gate = 1; R.route = false; R.ysc = 1.0f / (F8_ASCALE * F8_WSCALE);
                { int row = gw; for (; row + ngw < NLAT; row += 2 * ngw) { resid_row(ws, outp, nullptr, nullptr, Rd(R, rep_), row, lane, tb); resid_row(ws, outp, nullptr, nullptr, Rd(R, rep_), row + ngw, lane, tb); } if (row < NLAT) resid_row(ws, outp, nullptr, nullptr, Rd(R, rep_), row, lane, tb); }
            }
        }
    }
#undef IN
#undef SEAM
#undef tid
}

extern "C" void kernel_launch(void* const* d_in, const int* in_sizes, int n_in, void* d_out, int out_size, void* d_ws, size_t ws_size, hipStream_t stream) {
    static int grid = 0;
    if (grid == 0) {
        if (n_in != 38 || out_size != NLAT * D || ws_size < WS_END) { fprintf(stderr, "kernel_launch: unexpected problem (n_in %d out %d ws %zu, need %zu)\n", n_in, out_size, ws_size, (size_t)WS_END); grid = -1; return; }
        int dev = 0, cus = 0, per_cu = 0;
        if (hipGetDevice(&dev) != hipSuccess || hipDeviceGetAttribute(&cus, hipDeviceAttributeMultiprocessorCount, dev) != hipSuccess) { grid = -1; return; }
        if (hipFuncSetAttribute((const void*)mk_fwd, hipFuncAttributeMaxDynamicSharedMemorySize, LDS_BYTES) != hipSuccess) { fprintf(stderr, "kernel_launch: hipFuncSetAttribute failed\n"); grid = -1; return; }
        if (hipOccupancyMaxActiveBlocksPerMultiprocessor(&per_cu, (const void*)mk_fwd, NTHREADS, LDS_BYTES) != hipSuccess || per_cu < 1) { fprintf(stderr, "kernel_launch: occupancy query says %d\n", per_cu); }
        (void)hipGetLastError();
        grid = cus;
    }
    if (grid < 0) return;
    (void)hipMemsetAsync((char*)d_ws + WS_CTL, 0, CTL_BYTES, stream);
    Args a{};
    for (int i = 0; i < 38; ++i) a.in[i] = (const float*)d_in[i];
    a.out = (float*)d_out; a.ws = (unsigned char*)d_ws;
#if MK_MULTI
    for (int ph = 0; ph < NPH; ++ph) {
        const int rel = ph < PH_L0 ? -1 : (ph - PH_L0) % PH_PER_L, l = ph < PH_L0 ? 0 : (ph - PH_L0) / PH_PER_L;
        if (rel > 12 || (l == 0 && (rel == 10 || rel == 11))) continue;
        a.ph_lo = ph; a.ph_hi = ph + 1;
        hipLaunchKernelGGL(mk_fwd, dim3(grid), dim3(NTHREADS), LDS_BYTES, stream, a);
#if MK_DEBUG
        hipLaunchKernelGGL(dbg_fwd, dim3(grid), dim3(NTHREADS), 0, stream, a, ph);
#endif
    }
#if MK_DEBUG
    hipLaunchKernelGGL(dbg_fwd, dim3(grid), dim3(NTHREADS), 0, stream, a, 1000);
#endif
#else
    a.ph_lo = 0; a.ph_hi = NPH;
    hipLaunchKernelGGL(mk_fwd, dim3(grid), dim3(NTHREADS), LDS_BYTES, stream, a);
#endif
}
```

```cpp
#include <hip/hip_runtime.h>
#include <cstdio>
#include <cstdint>

#ifndef MK_DEBUG
#define MK_DEBUG 0
#endif
#ifndef MK_MULTI
#define MK_MULTI 0
#endif

#define GAS __attribute__((address_space(1)))
#define LAS __attribute__((address_space(3)))
typedef unsigned short bf16;
typedef short bf16x8 __attribute__((ext_vector_type(8)));
typedef short s16x4 __attribute__((ext_vector_type(4)));
typedef float f32x2 __attribute__((ext_vector_type(2)));
typedef float f32x4 __attribute__((ext_vector_type(4)));
typedef float f32x16 __attribute__((ext_vector_type(16)));
typedef unsigned u32x2 __attribute__((ext_vector_type(2)));
typedef unsigned u32x4 __attribute__((ext_vector_type(4)));

constexpr int D = 1024, NB = 4, SEQ = 4096, CTXL = 256, GRIDW = 64;
constexpr int NLAT = NB * SEQ, NCTX = NB * CTXL, MALL = NLAT + NCTX;
constexpr int LPOS = CTXL + SEQ;
constexpr int NIN = 1952, ZW = 2048;
constexpr int DFF = 2816, NEXP = 8;
constexpr float EPS = 1e-6f;
constexpr float LOG2E = 1.4426950408889634f;
#ifndef F8_G1L1
#define F8_G1L1 1
#endif
constexpr float F8_WSCALE = 256.f, F8_HSCALE = 16.f, F8_ASCALE = 8.f;
#ifndef F8_D1
#define F8_D1 0
#endif
#ifndef F8_D2
#define F8_D2 0
#endif
#ifndef F8_M1
#define F8_M1 1
#endif
constexpr int ZC_QG = 0, ZC_KG = 512, ZC_VG = 640, ZC_CQ = 768, ZC_CKV = 1152, ZC_KR = 1408, ZC_U = 1536;

constexpr size_t MiB = 1u << 20;
constexpr size_t WS_CTL = 0, CTL_BYTES = 1 * MiB;
constexpr size_t WS_MOD = 1 * MiB;
constexpr size_t WS_ROPE = 2 * MiB;
constexpr size_t WS_PAR = 3 * MiB + 512 * 1024;
constexpr int PR_GMIXPRE = 0, PR_GMIXPOST = 2048, PR_GFFNPRE = 4096, PR_GFFNPOST = 6144, PR_GQ = 8192, PR_GK = 8320, PR_GCQ = 8448, PR_GCKV = 9216, PR_BMG = 9728, PR_RW = 15872, PR_RB = 24064,
              PR_A16 = 24080, PR_END = PR_A16 + 2 * 2 * 32 * 64 * 2;
constexpr size_t WS_LIST = 4 * MiB;
constexpr size_t WS_LATC = 5 * MiB;
constexpr size_t WS_W1T = 9 * MiB;
constexpr size_t WS_WMGT = 17 * MiB;
constexpr size_t WS_WUQT = 29 * MiB;
constexpr size_t WS_WUKVT = 31 * MiB;
constexpr size_t WS_S5M = 32 * MiB;
constexpr size_t WS_WGLUT = 56 * MiB;
constexpr size_t WS_WBT = 58 * MiB;
constexpr size_t WS_WOUTT = 64 * MiB;
constexpr size_t WS_WF1T = 68 * MiB;
constexpr size_t WS_WF2T = 79 * MiB;
constexpr size_t WS_WM1T = 85 * MiB;
constexpr size_t WS_WM2T = 173 * MiB;
constexpr size_t WS_POOL = 217 * MiB;
constexpr size_t P_H = WS_POOL + 0 * MiB;
constexpr size_t P_Z = WS_POOL + 34 * MiB;
constexpr size_t P_QB = WS_POOL + 34 * MiB;
constexpr size_t P_KB = WS_POOL + 60 * MiB;
constexpr size_t P_VB = WS_POOL + 77 * MiB;
constexpr size_t P_QA = WS_POOL + 102 * MiB;
constexpr size_t P_KA = WS_POOL + 119 * MiB;
constexpr size_t P_VA = WS_POOL + 124 * MiB;
constexpr size_t P_KRR = WS_POOL + 129 * MiB;
constexpr size_t P_UG = WS_POOL + 131 * MiB;
constexpr size_t P_CQN = WS_POOL + 148 * MiB;
constexpr size_t P_CKVN = WS_POOL + 161 * MiB;
constexpr size_t P_AGLU = WS_POOL + 170 * MiB;
constexpr size_t P_YBR = WS_POOL + 187 * MiB;
constexpr size_t P_MRG = WS_POOL + 34 * MiB;
constexpr size_t P_GSCR = WS_POOL + 68 * MiB;
constexpr size_t P_Y = WS_POOL + 102 * MiB;
constexpr size_t P_ACT = WS_POOL + 34 * MiB;
constexpr size_t P_Y2 = WS_POOL + 136 * MiB;
constexpr size_t P_H8 = WS_POOL + 240 * MiB;
constexpr size_t WS_END = WS_POOL + 257 * MiB;
static_assert(P_YBR + (size_t)MALL * 1536 * 2 <= WS_END && P_Y2 + (size_t)MALL * 1024 * 4 <= WS_END && P_ACT + (size_t)MALL * DFF * 2 <= P_Y2, "pool map");
static_assert(P_GSCR + 256 * 3 * 131072 <= P_AGLU && P_VB + (size_t)MALL * 512 * 2 <= P_QA && P_Y + (size_t)MALL * 4096 <= P_AGLU, "pool map 2");

constexpr int CW_BAR = 4096;
constexpr int CW_Q = 8320;
constexpr int CW_CNT = 8192;
constexpr int CW_DBG = 16384;

constexpr int LDS_MISC = 147456;
constexpr int LDS_BYTES = 151552;
constexpr int NWAVES = 8, NTHREADS = 512;

__device__ __forceinline__ int lane_id() { unsigned m_ = ~0u; asm volatile("" : "+s"(m_)); return (int)__builtin_amdgcn_mbcnt_hi(m_, __builtin_amdgcn_mbcnt_lo(m_, 0u)); }
__device__ __forceinline__ float bf2f(unsigned v) { return __uint_as_float(v << 16); }
__device__ __forceinline__ unsigned f2bf(float f) { unsigned u = __float_as_uint(f); return (u + 0x7fffu + ((u >> 16) & 1u)) >> 16; }
typedef __bf16 bf16x2_t __attribute__((ext_vector_type(2)));
__device__ __forceinline__ unsigned pk2(float lo, float hi) { const f32x2 v = {lo, hi}; return __builtin_bit_cast(unsigned, __builtin_convertvector(v, bf16x2_t)); }
__device__ __forceinline__ float shfl_xor_l(float v, int mask, int lane) { return __int_as_float(__builtin_amdgcn_ds_bpermute((lane ^ mask) << 2, __float_as_int(v))); }
__device__ __forceinline__ float wave_sum(float v) {
    const int lane = lane_id();
#pragma unroll
    for (int o = 1; o < 64; o <<= 1) v += shfl_xor_l(v, o, lane);
    return v;
}
__device__ __forceinline__ float fsigmoid(float x) { return __builtin_amdgcn_rcpf(1.0f + __builtin_amdgcn_exp2f(-x * LOG2E)); }
__device__ __forceinline__ float fsilu(float x) { return x * fsigmoid(x); }
__device__ __forceinline__ float fgelu_tanh(float x) { const float u = 0.7978845608028654f * (x + 0.044715f * x * x * x); return x * fsigmoid(2.0f * u); }
__device__ __forceinline__ void unpack8(const u32x4 v, float (&f)[8]) {
    f[0] = bf2f(v.x & 0xffffu); f[1] = bf2f(v.x >> 16); f[2] = bf2f(v.y & 0xffffu); f[3] = bf2f(v.y >> 16);
    f[4] = bf2f(v.z & 0xffffu); f[5] = bf2f(v.z >> 16); f[6] = bf2f(v.w & 0xffffu); f[7] = bf2f(v.w >> 16);
}
__device__ __forceinline__ u32x4 pack8(const float (&f)[8]) { u32x4 w; w.x = pk2(f[0], f[1]); w.y = pk2(f[2], f[3]); w.z = pk2(f[4], f[5]); w.w = pk2(f[6], f[7]); return w; }
__device__ __forceinline__ int pos_row(int b, int p) { return p < CTXL ? NLAT + b * CTXL + p : b * SEQ + (p - CTXL); }

#define XB_TMO      128
#define XB_XCNT(j)  (256  + 64 * (j))
#define XB_XSUB(j)  (1280 + 64 * (j))
#define XB_XGEN(j)  (2304 + 64 * (j))
#define XB_TOP      3328
#define XB_TOPGEN   3392
#define XCD_BAR_WORDS 3456
#define XB_SPIN_CAP (1u << 18)
__device__ __forceinline__ unsigned xb_ld(unsigned* p)              { return __hip_atomic_load(p, __ATOMIC_RELAXED, __HIP_MEMORY_SCOPE_AGENT); }
__device__ __forceinline__ unsigned xb_add(unsigned* p, unsigned v) { return __hip_atomic_fetch_add(p, v, __ATOMIC_RELAXED, __HIP_MEMORY_SCOPE_AGENT); }
__device__ __forceinline__ unsigned xb_xcc_id() { return (unsigned)__builtin_amdgcn_s_getreg((3 << 11) | 20) & 0xFu; }
#define XB_SPIN(cond, bar) do { unsigned _sp = 0; while (cond) { __builtin_amdgcn_s_sleep(1); \
    if ((++_sp & 255u) == 0u) { if (xb_ld(&(bar)[XB_TMO])) break; if (_sp > XB_SPIN_CAP) { atomicAdd(&(bar)[XB_TMO], 1u); break; } } } } while (0)
struct XcdBarrier { unsigned* bar; unsigned x; volatile LAS unsigned* st; int wave; };
__device__ __forceinline__ XcdBarrier xcd_barrier_post(unsigned* bar, volatile LAS unsigned* st, int wave) {
    XcdBarrier b; b.bar = bar; b.x = xb_xcc_id(); b.st = st; b.wave = wave;
    if (wave == 0 && lane_id() == 0) (void)xb_add(&bar[XB_XCNT(b.x)], 1u);
    return b;
}
__device__ __forceinline__ void xcd_barrier_complete(unsigned* bar, unsigned x, unsigned& nloc, unsigned& nx) {
    const unsigned G = gridDim.x * gridDim.y * gridDim.z;
    unsigned sum, cnt, mine, sp = 0u;
    for (;;) {
        sum = 0u; cnt = 0u; mine = 0u;
#pragma unroll
        for (unsigned j = 0; j < 16; ++j) { const unsigned c = xb_ld(&bar[XB_XCNT(j)]); sum += c; cnt += (c > 0u) ? 1u : 0u; mine = (j == x) ? c : mine; }
        if (sum == G) break;
        __builtin_amdgcn_s_sleep(1);
        if ((++sp & 255u) == 0u) { if (xb_ld(&bar[XB_TMO])) break; if (sp > XB_SPIN_CAP) { atomicAdd(&bar[XB_TMO], 1u); break; } }
    }
    nloc = mine > 0u ? mine : 1u; nx = cnt > 0u ? cnt : 1u;
}
__device__ __forceinline__ void xcd_barrier(const XcdBarrier& b) {
    asm volatile("s_waitcnt vmcnt(0)" ::: "memory");
    __syncthreads();
    if (b.wave == 0 && lane_id() == 0) {
        unsigned* bar = b.bar;
        __builtin_amdgcn_s_waitcnt(0);
        unsigned nloc = b.st[0], nx = b.st[1];
        if (nloc == 0u) { xcd_barrier_complete(bar, b.x, nloc, nx); b.st[0] = nloc; b.st[1] = nx; }
        const unsigned old = xb_add(&bar[XB_XSUB(b.x)], 1u);
        const unsigned gen = old / nloc;
        if (old + 1u == (gen + 1u) * nloc) {
            __builtin_amdgcn_fence(__ATOMIC_RELEASE, "agent");
            asm volatile("s_waitcnt vmcnt(0)" ::: "memory");
            const unsigned og = xb_add(&bar[XB_TOP], 1u);
            const unsigned tg = og / nx;
            if (og + 1u == (tg + 1u) * nx) xb_add(&bar[XB_TOPGEN], 1u);
            else XB_SPIN(xb_ld(&bar[XB_TOPGEN]) == tg, bar);
            __builtin_amdgcn_fence(__ATOMIC_ACQUIRE, "agent");
            xb_add(&bar[XB_XGEN(b.x)], 1u);
            asm volatile("s_waitcnt vmcnt(0)" ::: "memory");
        } else {
            XB_SPIN(xb_ld(&bar[XB_XGEN(b.x)]) == gen, bar);
            __builtin_amdgcn_fence(__ATOMIC_ACQUIRE, "agent");
            asm volatile("s_waitcnt vmcnt(0)" ::: "memory");
        }
    }
    __syncthreads();
}

namespace pg8 {
typedef int v4i __attribute__((ext_vector_type(4)));
typedef int v8i __attribute__((ext_vector_type(8)));
constexpr int BM = 256, BK = 64, HALF = 128, HTB = HALF * BK * 2, STAGE_BYTES = 8 * HTB;
__host__ __device__ __forceinline__ int lds_byte(int r, int c) { const int st = (r >> 4) * 2 + (c >> 5), rr = r & 15, cc = c & 31, ob = rr * 64 + cc * 2; return st * 1024 + (ob ^ (((ob >> 9) & 1) << 5)); }
__host__ __device__ __forceinline__ void stage_rc(int b, int& R, int& C) { const int st = b / 1024, sb = b % 1024, swz = sb ^ (((sb >> 9) & 1) << 5); R = (st >> 1) * 16 + swz / 64; C = (st & 1) * 32 + (swz % 64) / 2; }
__host__ __device__ __forceinline__ int perm32(int rho) { const int n = rho >> 4, i = rho & 15; return 8 * (i >> 2) + 4 * n + (i & 3); }

struct GUnit { const char* a; const char* b; unsigned lda, ldb; int nt; int pm, pn, z; };

__device__ __forceinline__ void tile_of(int L, int nM, int nN, int& pm, int& pn) {
    const int nwg = nM * nN; int wgid = L;
    { const int q = nwg / 8, r = nwg % 8, xcd = wgid % 8, off = wgid / 8; wgid = (xcd < r ? xcd * (q + 1) : r * (q + 1) + (xcd - r) * q) + off; }
    const int nig = 8 * nN, gid = wgid / nig, fm = gid * 8, gsz = (nM - fm) < 8 ? (nM - fm) : 8;
    pm = fm + ((wgid % nig) % gsz); pn = (wgid % nig) / gsz;
}

template <class Epi, class Sched, bool GATHER, bool F8 = false>
__device__ __forceinline__ void gemm_phase(LAS unsigned char* lds, const Sched& S, const Epi& E, int wave_) {
    int tid = wave_ * 64 + lane_id(); asm volatile("" : "+v"(tid));
    const int wid = __builtin_amdgcn_readfirstlane(tid >> 6), lane = tid & 63, wr = wid >> 2, wc = wid & 3, fr = lane & 15, fq = lane >> 4;
    int Rr[2], Cc[2], Rb[2];
#pragma unroll
    for (int i = 0; i < 2; ++i) { stage_rc(tid * 16 + i * 8192, Rr[i], Cc[i]); Rb[i] = Epi::PERM ? ((Rr[i] & ~31) + perm32(Rr[i] & 31)) : Rr[i]; }
    const size_t kstep = (size_t)(BK * 2);
    const unsigned ldsw = (unsigned)wid * 1024u;
    const int aoff = lds_byte(wr * 64 + fr, fq * 8), boff = lds_byte(wc * 32 + fr, fq * 8);
#define PG8_SA(b, h) (((b) * 2 + (h)) * HTB)
#define PG8_SB(b, h) ((4 + (b) * 2 + (h)) * HTB)
#define PG8_STAGE(bufoff, gbase, v0, v1) do { \
        __builtin_amdgcn_global_load_lds((const unsigned*)((const char*)(gbase) + (v0)), (LAS unsigned*)(lds + (bufoff) + ldsw), 16, 0, 0); \
        __builtin_amdgcn_global_load_lds((const unsigned*)((const char*)(gbase) + (v1)), (LAS unsigned*)(lds + (bufoff) + ldsw + 8192), 16, 0, 0); } while (0)
#define PG8_LD16(p) __builtin_bit_cast(v4i, *(const LAS bf16x8*)(p))
#define PG8_LDA(dst, b, h) do { _Pragma("unroll") for (int m = 0; m < 4; ++m) dst[m] = __builtin_shufflevector(PG8_LD16(lds + PG8_SA(b, h) + aoff + m * 2048), PG8_LD16(lds + PG8_SA(b, h) + aoff + m * 2048 + 1024), 0, 1, 2, 3, 4, 5, 6, 7); } while (0)
#define PG8_LDB(dst, b, h) do { _Pragma("unroll") for (int n = 0; n < 2; ++n) dst[n] = __builtin_shufflevector(PG8_LD16(lds + PG8_SB(b, h) + boff + n * 2048), PG8_LD16(lds + PG8_SB(b, h) + boff + n * 2048 + 1024), 0, 1, 2, 3, 4, 5, 6, 7); } while (0)
#define PG8_LO(x) __builtin_bit_cast(bf16x8, __builtin_shufflevector(x, x, 0, 1, 2, 3))
#define PG8_HI(x) __builtin_bit_cast(bf16x8, __builtin_shufflevector(x, x, 4, 5, 6, 7))
#define PG8_MMA(ai, bj, At, Bt) do { __builtin_amdgcn_s_setprio(1); \
        _Pragma("unroll") for (int m = 0; m < 4; ++m) _Pragma("unroll") for (int n = 0; n < 2; ++n) { \
            if constexpr (F8) acc[ai][bj][m][n] = __builtin_amdgcn_mfma_scale_f32_16x16x128_f8f6f4(Bt[n], At[m], acc[ai][bj][m][n], 0, 0, 0, 0, 0, 0); \
            else { acc[ai][bj][m][n] = __builtin_amdgcn_mfma_f32_16x16x32_bf16(PG8_LO(Bt[n]), PG8_LO(At[m]), acc[ai][bj][m][n], 0, 0, 0); \
                   acc[ai][bj][m][n] = __builtin_amdgcn_mfma_f32_16x16x32_bf16(PG8_HI(Bt[n]), PG8_HI(At[m]), acc[ai][bj][m][n], 0, 0, 0); } } \
        __builtin_amdgcn_s_setprio(0); } while (0)
#define PG8_WAIT_V(n) asm volatile("s_waitcnt vmcnt(" #n ")" ::: "memory")
#define PG8_WAIT_L(n) asm volatile("s_waitcnt lgkmcnt(" #n ")" ::: "memory")
#define PG8_BAR __builtin_amdgcn_s_barrier()
#define PG8_SCHED __builtin_amdgcn_sched_barrier(0)
#define PG8_OFFS(u) do { \
        _Pragma("unroll") for (int i_ = 0; i_ < 2; ++i_) { \
            if constexpr (GATHER) { oA0[i_] = S.arow(u, Rr[i_]) + (unsigned)Cc[i_] * 2u; oA1[i_] = S.arow(u, HALF + Rr[i_]) + (unsigned)Cc[i_] * 2u; } \
            else { oA0[i_] = (unsigned)Rr[i_] * (u).lda + (unsigned)Cc[i_] * 2u; } \
            oB[i_] = (unsigned)Rb[i_] * (u).ldb + (unsigned)Cc[i_] * 2u; } \
        hA = GATHER ? (size_t)0 : (size_t)HALF * (u).lda; hB = (size_t)HALF * (u).ldb; } while (0)
#define PG8_A1(i) (GATHER ? oA1[i] : oA0[i])
    GUnit cur, nxt; int ui = 0;
    if (!S.next(0, cur)) return;
    f32x4 acc[2][2][4][2];
#pragma unroll
    for (int a = 0; a < 2; ++a)
#pragma unroll
        for (int b = 0; b < 2; ++b)
#pragma unroll
            for (int m = 0; m < 4; ++m)
#pragma unroll
                for (int n = 0; n < 2; ++n) acc[a][b][m][n] = (f32x4){0.f, 0.f, 0.f, 0.f};
    v8i At[4], B0[2], B1[2];
    unsigned oA0[2], oA1[2], oB[2]; size_t hA, hB;
    oA1[0] = 0u; oA1[1] = 0u;
    PG8_OFFS(cur);
    const char* cA = cur.a; const char* cBp = cur.b;
    PG8_STAGE(PG8_SB(0, 0), cBp, oB[0], oB[1]); PG8_STAGE(PG8_SB(0, 1), cBp + hB, oB[0], oB[1]); PG8_STAGE(PG8_SA(0, 0), cA, oA0[0], oA0[1]); PG8_STAGE(PG8_SA(0, 1), cA + hA, PG8_A1(0), PG8_A1(1));
    if (wr == 1) PG8_BAR;
    PG8_WAIT_V(2); PG8_BAR;
    PG8_STAGE(PG8_SB(1, 0), cBp + kstep, oB[0], oB[1]); PG8_STAGE(PG8_SA(1, 0), cA + kstep, oA0[0], oA0[1]); PG8_STAGE(PG8_SB(1, 1), cBp + hB + kstep, oB[0], oB[1]);
    PG8_WAIT_V(6); PG8_BAR;
    for (;;) {
        const bool has_next = S.next(ui + 1, nxt);
        const char* nA = has_next ? nxt.a : cA; const char* nBp = has_next ? nxt.b : cBp;
        int nt = cur.nt; asm volatile("" : "+s"(nt));
        for (int t = 0; t < nt; t += 2) {
            const bool last = (t == nt - 2);
            const char* a1 = cA + (size_t)(t + 1) * kstep;
            const char* a2 = last ? nA : cA + (size_t)(t + 2) * kstep; const char* b2 = last ? nBp : cBp + (size_t)(t + 2) * kstep;
            const char* a3 = a2 + kstep; const char* b3 = b2 + kstep;
            PG8_LDB(B0, 0, 0); PG8_LDB(B1, 0, 1); PG8_SCHED; PG8_LDA(At, 0, 0); PG8_STAGE(PG8_SA(1, 1), a1 + hA, PG8_A1(0), PG8_A1(1));
            if (last && has_next) PG8_OFFS(nxt);
            PG8_WAIT_V(8); PG8_WAIT_L(0); PG8_BAR; PG8_MMA(0, 0, At, B0); PG8_MMA(0, 1, At, B1); PG8_BAR; PG8_SCHED;
            PG8_LDA(At, 0, 1); PG8_STAGE(PG8_SB(0, 0), b2, oB[0], oB[1]); PG8_STAGE(PG8_SB(0, 1), b2 + hB, oB[0], oB[1]); PG8_STAGE(PG8_SA(0, 0), a2, oA0[0], oA0[1]);
            PG8_WAIT_V(8); PG8_WAIT_L(0); PG8_BAR; PG8_MMA(1, 0, At, B0); PG8_MMA(1, 1, At, B1); PG8_BAR; PG8_SCHED;
            PG8_LDB(B0, 1, 0); PG8_LDB(B1, 1, 1); PG8_SCHED; PG8_LDA(At, 1, 0); PG8_STAGE(PG8_SA(0, 1), a2 + hA, PG8_A1(0), PG8_A1(1));
            PG8_WAIT_V(8); PG8_WAIT_L(0); PG8_BAR; PG8_MMA(0, 0, At, B0); PG8_MMA(0, 1, At, B1); PG8_BAR; PG8_SCHED;
            PG8_LDA(At, 1, 1); PG8_STAGE(PG8_SB(1, 0), b3, oB[0], oB[1]); PG8_STAGE(PG8_SB(1, 1), b3 + hB, oB[0], oB[1]); PG8_STAGE(PG8_SA(1, 0), a3, oA0[0], oA0[1]);
            PG8_WAIT_V(8); PG8_WAIT_L(0); PG8_BAR; PG8_MMA(1, 0, At, B0); PG8_MMA(1, 1, At, B1); PG8_BAR; PG8_SCHED;
        }
        if (wr == 0) PG8_BAR;
        E(acc, cur, wr, wc, fr, fq);
        if (!has_next) break;
#pragma unroll
        for (int a = 0; a < 2; ++a)
#pragma unroll
            for (int b = 0; b < 2; ++b)
#pragma unroll
                for (int m = 0; m < 4; ++m)
#pragma unroll
                    for (int n = 0; n < 2; ++n) acc[a][b][m][n] = (f32x4){0.f, 0.f, 0.f, 0.f};
        cur = nxt; cA = nA; cBp = nBp; ++ui;
        if (wr == 1) PG8_BAR;
    }
    PG8_WAIT_V(0);
    PG8_BAR;
#undef PG8_SA
#undef PG8_SB
#undef PG8_STAGE
#undef PG8_LDA
#undef PG8_LDB
#undef PG8_LD16
#undef PG8_LO
#undef PG8_HI
#undef PG8_MMA
#undef PG8_WAIT_V
#undef PG8_WAIT_L
#undef PG8_BAR
#undef PG8_SCHED
#undef PG8_OFFS
#undef PG8_A1
}
}

namespace pg8 {
__device__ __forceinline__ unsigned pk_fp8x4(float a, float b, float c, float d) {
    a = __builtin_amdgcn_fmed3f(a, -448.f, 448.f); b = __builtin_amdgcn_fmed3f(b, -448.f, 448.f); c = __builtin_amdgcn_fmed3f(c, -448.f, 448.f); d = __builtin_amdgcn_fmed3f(d, -448.f, 448.f);
    unsigned w = 0; w = __builtin_amdgcn_cvt_pk_fp8_f32(a, b, w, false); w = __builtin_amdgcn_cvt_pk_fp8_f32(c, d, w, true); return w; }
struct SchedPlain {
    const char* A; const char* B; unsigned lda, ldb; int nt, nM, nN, G, c;
    __device__ __forceinline__ bool next(int i, GUnit& u) const {
        const int L = i * G + c; if (L >= nM * nN) return false;
        int pm, pn; tile_of(L, nM, nN, pm, pn);
        u.a = A + (size_t)pm * 256 * lda; u.b = B + (size_t)pn * 256 * ldb; u.lda = lda; u.ldb = ldb; u.nt = nt; u.pm = pm; u.pn = pn; u.z = 0; return true;
    }
};
struct SchedUp {
    const char* Aq; const char* Bq; const char* Akv; const char* Bkv; int nMq, nMall, G, c;
    __device__ __forceinline__ bool next(int i, GUnit& u) const {
        int L = i * G + c; const int nq = nMq * 3; int pm, pn;
        if (L < nq) { tile_of(L, nMq, 3, pm, pn); u.a = Aq + (size_t)pm * 256 * 768; u.b = Bq + (size_t)pn * 256 * 768; u.lda = 768u; u.ldb = 768u; u.nt = 6; u.pm = pm; u.pn = pn; u.z = 0; return true; }
        L -= nq; if (L >= nMall * 4) return false;
        tile_of(L, nMall, 4, pm, pn); u.a = Akv + (size_t)pm * 256 * 512; u.b = Bkv + (size_t)pn * 256 * 512; u.lda = 512u; u.ldb = 512u; u.nt = 4; u.pm = pm; u.pn = pn; u.z = 1; return true;
    }
};
struct SchedMergeG {
    const char* A; const char* B; unsigned lda, ldb; int nt, nM, L;
    __device__ __forceinline__ bool next(int i, GUnit& u) const {
        if (i >= 3 || L >= nM * 4) return false;
        int pm, pn; tile_of(L, nM, 4, pm, pn);
        u.a = A + (size_t)pm * 256 * lda; u.lda = lda; u.b = B + ((size_t)i * 1024 + pn * 256) * ldb; u.ldb = ldb; u.nt = nt; u.pm = pm; u.pn = pn; u.z = i; return true;
    }
};
struct SchedMergeP {
    const char* A; const char* B; unsigned lda, ldb; int nt, nM, L;
    __device__ __forceinline__ bool next(int i, GUnit& u) const {
        if (i >= 3 || L >= nM * 4) return false;
        int pm, pn; tile_of(L, nM, 4, pm, pn);
        u.a = A + (size_t)pm * 256 * lda + i * 1024; u.lda = lda; u.b = B + ((size_t)i * 1024 + pn * 256) * ldb; u.ldb = ldb; u.nt = nt; u.pm = pm; u.pn = pn; u.z = i; return true;
    }
};
struct SchedMoe1 {
    const char* H2; const char* W; unsigned lda, ldb; int nt; const int* list; const LAS int* tb; int nM, G, c;
    __device__ __forceinline__ bool next(int i, GUnit& u) const {
        const int L = i * G + c; if (L >= nM * 22) return false;
        const int mt = L / 22, pn = L % 22; int e = 0;
#pragma unroll
        for (int j = 1; j < 8; ++j) e += (mt >= tb[8 + j]) ? 1 : 0;
        e = __builtin_amdgcn_readfirstlane(e);
        u.a = H2; u.lda = lda; u.b = W + ((size_t)e * 5632 + pn * 256) * ldb; u.ldb = ldb; u.nt = nt; u.pm = mt; u.pn = pn; u.z = e; return true;
    }
    __device__ __forceinline__ unsigned arow(const GUnit& u, int r) const {
        const int e = u.z, li = (u.pm - tb[8 + e]) * 256 + r; const int tok = (li < tb[e]) ? list[e * 16384 + li] : 0;
        return (unsigned)tok * lda;
    }
};
struct SchedMoe2 {
    const char* A; const char* B; unsigned lda, ldb; int nt; const LAS int* tb; int nM, G, c;
    __device__ __forceinline__ bool next(int i, GUnit& u) const {
        const int L = i * G + c; if (L >= nM * 4) return false;
        int pm, pn; tile_of(L, nM, 4, pm, pn); int e = 0;
#pragma unroll
        for (int j = 1; j < 8; ++j) e += (pm >= tb[8 + j]) ? 1 : 0;
        e = __builtin_amdgcn_readfirstlane(e);
        u.a = A + (size_t)pm * 256 * lda; u.b = B + (size_t)(e * 4 + pn) * 256 * ldb; u.lda = lda; u.ldb = ldb; u.nt = nt; u.pm = pm; u.pn = pn; u.z = e; return true;
    }
};

#define EPI_ROWS_BEGIN _Pragma("unroll") for (int ai = 0; ai < 2; ++ai) _Pragma("unroll") for (int m = 0; m < 4; ++m) { const int row = u.pm * BM + ai * HALF + wr * 64 + m * 16 + fr;
#define EPI_ROWS_END }
__device__ __forceinline__ u32x4 pack_f4f4(const f32x4 a, const f32x4 b) { u32x4 w; w.x = pk2(a[0], a[1]); w.y = pk2(a[2], a[3]); w.z = pk2(b[0], b[1]); w.w = pk2(b[2], b[3]); return w; }

struct EpiBf16 {
    static constexpr bool PERM = true;
    bf16* O; int ldc; int rsub;
    __device__ __forceinline__ void operator()(const f32x4 (&acc)[2][2][4][2], const GUnit& u, int wr, int wc, int fr, int fq) const {
        const int col0 = u.pn * BM + wc * 32 + 8 * fq;
        EPI_ROWS_BEGIN
            bf16* rowp = O + (size_t)(row - rsub) * ldc + col0;
#pragma unroll
            for (int bj = 0; bj < 2; ++bj) *(u32x4*)(rowp + bj * HALF) = pack_f4f4(acc[ai][bj][m][0], acc[ai][bj][m][1]);
        EPI_ROWS_END
    }
};
struct EpiF32 {
    static constexpr bool PERM = false;
    float* C; int ldc;
    __device__ __forceinline__ void operator()(const f32x4 (&acc)[2][2][4][2], const GUnit& u, int wr, int wc, int fr, int fq) const {
        const int col0 = u.pn * BM + wc * 32 + 4 * fq;
        EPI_ROWS_BEGIN
            float* rowp = C + (size_t)row * ldc + col0;
#pragma unroll
            for (int bj = 0; bj < 2; ++bj)
#pragma unroll
                for (int n = 0; n < 2; ++n) *(f32x4*)(rowp + bj * HALF + n * 16) = acc[ai][bj][m][n];
        EPI_ROWS_END
    }
};
struct EpiUq {
    static constexpr bool PERM = true;
    bf16* Qb; const float* cosB; const float* sinB; float scale;
    __device__ __forceinline__ void operator()(const f32x4 (&acc)[2][2][4][2], const GUnit& u, int wr, int wc, int fr, int fq) const {
        const bool lat = u.pm < 64;
        EPI_ROWS_BEGIN
            const int t = row & (SEQ - 1);
#pragma unroll
            for (int bj = 0; bj < 2; ++bj) {
                const int gidx = u.pn * 8 + bj * 4 + wc, head = gidx / 3, part = gidx - head * 3;
                bf16* dst = Qb + (size_t)row * 768 + head * 96 + part * 32;
                f32x4 a = acc[ai][bj][m][0] * scale, b = acc[ai][bj][m][1] * scale;
                if (part == 2) {
                    if (lat) { const f32x4 c = *(const f32x4*)(cosB + t * 16 + 4 * fq), s = *(const f32x4*)(sinB + t * 16 + 4 * fq);
                        const f32x4 x1 = a * c - b * s, x2 = a * s + b * c; a = x1; b = x2; }
                    u32x2 w0, w1; w0.x = pk2(a[0], a[1]); w0.y = pk2(a[2], a[3]); w1.x = pk2(b[0], b[1]); w1.y = pk2(b[2], b[3]);
                    *(u32x2*)(dst + 4 * fq) = w0; *(u32x2*)(dst + 16 + 4 * fq) = w1;
                } else *(u32x4*)(dst + 8 * fq) = pack_f4f4(a, b);
            }
        EPI_ROWS_END
    }
};
struct EpiUkv {
    static constexpr bool PERM = true;
    bf16* Kb; bf16* Vb;
    __device__ __forceinline__ void operator()(const f32x4 (&acc)[2][2][4][2], const GUnit& u, int wr, int wc, int fr, int fq) const {
        bf16* base = (wc < 2) ? Kb : Vb;
        EPI_ROWS_BEGIN
#pragma unroll
            for (int bj = 0; bj < 2; ++bj) { const int head = u.pn * 2 + bj;
                *(u32x4*)(base + (size_t)row * 512 + head * 64 + (wc & 1) * 32 + 8 * fq) = pack_f4f4(acc[ai][bj][m][0], acc[ai][bj][m][1]); }
        EPI_ROWS_END
    }
};
struct EpiUp {
    static constexpr bool PERM = true;
    EpiUq q; EpiUkv kv;
    __device__ __forceinline__ void operator()(const f32x4 (&acc)[2][2][4][2], const GUnit& u, int wr, int wc, int fr, int fq) const { if (u.z == 0) q(acc, u, wr, wc, fr, fq); else kv(acc, u, wr, wc, fr, fq); }
};
template <int MODE> struct EpiPair {
    static constexpr bool PERM = true;
    bf16* O; int ldc; int cbase; int rsub;
    __device__ __forceinline__ void operator()(const f32x4 (&acc)[2][2][4][2], const GUnit& u, int wr, int wc, int fr, int fq) const {
        const int col0 = cbase + u.pn * 128 + wc * 32 + 8 * fq;
        EPI_ROWS_BEGIN
            f32x4 o[2];
#pragma unroll
            for (int n = 0; n < 2; ++n)
#pragma unroll
                for (int j = 0; j < 4; ++j) { const float a = acc[ai][0][m][n][j], b = acc[ai][1][m][n][j]; o[n][j] = MODE == 0 ? a * fsigmoid(b) : fsilu(a) * b; }
            *(u32x4*)(O + (size_t)(row - rsub) * ldc + col0) = pack_f4f4(o[0], o[1]);
        EPI_ROWS_END
    }
};
struct EpiGate {
    static constexpr bool PERM = true;
    const float* bmg; u32x4* gscr; float ds;
    __device__ __forceinline__ void operator()(const f32x4 (&acc)[2][2][4][2], const GUnit& u, int wr, int wc, int fr, int fq) const {
        const int n = u.z, tid = (wr * 4 + wc) * 64 + fq * 16 + fr;
#pragma unroll
        for (int bj = 0; bj < 2; ++bj) {
            const float* bp = bmg + n * 1024 + u.pn * BM + bj * HALF + wc * 32 + 8 * fq;
            const f32x4 b0 = *(const f32x4*)bp, b1 = *(const f32x4*)(bp + 4);
#pragma unroll
            for (int ai = 0; ai < 2; ++ai)
#pragma unroll
                for (int m = 0; m < 4; ++m) { f32x4 g0 = acc[ai][bj][m][0] * ds + b0, g1 = acc[ai][bj][m][1] * ds + b1;
#pragma unroll
                    for (int j = 0; j < 4; ++j) { g0[j] = fsigmoid(g0[j]); g1[j] = fsigmoid(g1[j]); }
                    gscr[((n * 8 + (tid >> 6)) * 16 + (ai * 4 + m) * 2 + bj) * 64 + (tid & 63)] = pack_f4f4(g0, g1); asm volatile("" ::: "memory"); }
        }
    }
};
struct EpiMergeP {
    static constexpr bool PERM = true;
    bf16* M; const u32x4* gscr;
    __device__ __forceinline__ void operator()(const f32x4 (&acc)[2][2][4][2], const GUnit& u, int wr, int wc, int fr, int fq) const {
        const int n = u.z, tid = (wr * 4 + wc) * 64 + fq * 16 + fr;
        const int col0 = u.pn * BM + wc * 32 + 8 * fq;
        EPI_ROWS_BEGIN
#pragma unroll
            for (int bj = 0; bj < 2; ++bj) {
                float g[8], p[8]; unpack8(gscr[((n * 8 + (tid >> 6)) * 16 + (ai * 4 + m) * 2 + bj) * 64 + (tid & 63)], g);
                bf16* dst = M + (size_t)row * 1024 + col0 + bj * HALF;
                if (n > 0) unpack8(*(const u32x4*)dst, p);
#pragma unroll
                for (int j = 0; j < 8; ++j) { const float v = g[j] * acc[ai][bj][m][j >> 2][j & 3]; p[j] = n > 0 ? p[j] + v : v; }
                *(u32x4*)dst = pack8(p);
            }
            asm volatile("" ::: "memory");
        EPI_ROWS_END
    }
};
template <bool OUT8> struct EpiPairS {
    static constexpr bool PERM = true;
    unsigned char* O; int ldc; int rsub; float ds, os;
    __device__ __forceinline__ void operator()(const f32x4 (&acc)[2][2][4][2], const GUnit& u, int wr, int wc, int fr, int fq) const {
        const int col0 = u.pn * 128 + wc * 32 + 8 * fq;
        EPI_ROWS_BEGIN
            float o[8];
#pragma unroll
            for (int n = 0; n < 2; ++n)
#pragma unroll
                for (int j = 0; j < 4; ++j) { const float a = acc[ai][0][m][n][j] * ds, b = acc[ai][1][m][n][j]; o[4 * n + j] = fsilu(a) * b * (ds * os); }
            if constexpr (OUT8) *(u32x2*)(O + (size_t)(row - rsub) * ldc + col0) = (u32x2){pk_fp8x4(o[0], o[1], o[2], o[3]), pk_fp8x4(o[4], o[5], o[6], o[7])};
            else *(u32x4*)((bf16*)O + (size_t)(row - rsub) * ldc + col0) = pack8(o);
            asm volatile("" ::: "memory");
        EPI_ROWS_END
    }
};
struct EpiF32S {
    static constexpr bool PERM = false;
    float* C; int ldc; float ds;
    __device__ __forceinline__ void operator()(const f32x4 (&acc)[2][2][4][2], const GUnit& u, int wr, int wc, int fr, int fq) const {
        const int col0 = u.pn * BM + wc * 32 + 4 * fq;
        EPI_ROWS_BEGIN
            float* rowp = C + (size_t)row * ldc + col0;
#pragma unroll
            for (int bj = 0; bj < 2; ++bj)
#pragma unroll
                for (int n = 0; n < 2; ++n) *(f32x4*)(rowp + bj * HALF + n * 16) = acc[ai][bj][m][n] * ds;
        EPI_ROWS_END
    }
};
struct EpiBf16S {
    static constexpr bool PERM = true;
    bf16* O; int ldc; float ds;
    __device__ __forceinline__ void operator()(const f32x4 (&acc)[2][2][4][2], const GUnit& u, int wr, int wc, int fr, int fq) const {
        const int col0 = u.pn * BM + wc * 32 + 8 * fq;
        EPI_ROWS_BEGIN
            bf16* rowp = O + (size_t)row * ldc + col0;
#pragma unroll
            for (int bj = 0; bj < 2; ++bj) *(u32x4*)(rowp + bj * HALF) = pack_f4f4(acc[ai][bj][m][0] * ds, acc[ai][bj][m][1] * ds);
        EPI_ROWS_END
    }
};
#undef EPI_ROWS_BEGIN
#undef EPI_ROWS_END
}

namespace att {
__device__ __forceinline__ float swap32_max(float v) { const auto rr = __builtin_amdgcn_permlane32_swap(__float_as_uint(v), __float_as_uint(v), false, false); return __builtin_fmaxf(__uint_as_float(rr[0]), __uint_as_float(rr[1])); }
__device__ __forceinline__ float swap32_sum(float v) { const auto rr = __builtin_amdgcn_permlane32_swap(__float_as_uint(v), __float_as_uint(v), false, false); return __uint_as_float(rr[0]) + __uint_as_float(rr[1]); }
constexpr int VSLOT = 8192, NSLOT = 3;
__device__ __forceinline__ int crow(int r, int hi) { return (r & 3) + 8 * (r >> 2) + 4 * hi; }
__device__ __forceinline__ void glds16(const void* gsrc, unsigned lds_dst) { unsigned keep;
    asm volatile("s_mov_b32 %0, m0\n\ts_mov_b32 m0, %2\n\ts_nop 0\n\tglobal_load_lds_dwordx4 %1, off\n\ts_mov_b32 m0, %0" : "=&s"(keep) : "v"(gsrc), "s"(lds_dst) : "memory"); }
typedef short v4i16_t __attribute__((ext_vector_type(4)));
__device__ __forceinline__ s16x4 vtr(const LAS unsigned char* p) { return __builtin_bit_cast(s16x4, __builtin_amdgcn_ds_read_tr16_b64_v4i16((LAS v4i16_t*)p)); }

struct AttnArgs {
    const bf16* Q; int qpitch, qcol; long qrow0;
    const bf16* K1; int k1pitch, k1col;
    const bf16* K2; int k2pitch;
    const bf16* V; int vpitch, vcol;
    bf16* O; int opitch, ocol;
    int b, ntiles;
};
template <int DK> __device__ __forceinline__ void attn_unit(const AttnArgs& A, LAS unsigned char* lds, int wave_) {
    constexpr int NKS = DK / 16, KSLOT = (DK / 8) * 1024, NKSLOT = 4, NVSLOT = 4; constexpr float THR = 8.f;
    constexpr bool NOMAX = (DK == 64);
    constexpr int LDS_K = 0, LDS_V = NKSLOT * KSLOT, LDS_WS = LDS_V + NVSLOT * VSLOT;
    int tid = wave_ * 64 + lane_id(); asm volatile("" : "+v"(tid));
    const int lane = tid & 63, r32 = lane & 31, hi = lane >> 5; const int wid = __builtin_amdgcn_readfirstlane(tid >> 6);
    const unsigned lds0 = (unsigned)(uintptr_t)lds;
    LAS float* wsf = (LAS float*)(lds + LDS_WS) + wid * 64;
    const int NT = A.ntiles, b = A.b;
#define TILE_ROW(j) ((j) < 4 ? (long)(NLAT + b * CTXL + 64 * (j)) : (long)(b * SEQ + 64 * ((j) - 4)))
#define DMA_K(j) do { const long r0_ = TILE_ROW(j); const int s_ = (j) & 3; \
        glds16(A.K1 + (r0_ + lane) * A.k1pitch + A.k1col + wid * 8, (unsigned)__builtin_amdgcn_readfirstlane(lds0 + LDS_K + s_ * KSLOT + wid * 1024)); \
        if (DK == 96 && wid < 4) glds16(A.K2 + (r0_ + lane) * A.k2pitch + wid * 8, (unsigned)__builtin_amdgcn_readfirstlane(lds0 + LDS_K + s_ * KSLOT + (8 + wid) * 1024)); } while (0)
#define DMA_V(j) do { const long r0_ = TILE_ROW(j); const int s_ = (j) & 3; \
        glds16(A.V + (r0_ + 16 * (wid & 3) + (lane >> 2)) * A.vpitch + A.vcol + (wid >> 2) * 32 + (lane & 3) * 8, (unsigned)__builtin_amdgcn_readfirstlane(lds0 + LDS_V + (s_) * VSLOT + wid * 1024)); } while (0)
#define WAITBAR(n) asm volatile("s_waitcnt vmcnt(" #n ") lgkmcnt(0)\n\ts_barrier" ::: "memory")
#define WAIT_CNT(cnt) do { const int c_ = (cnt); if (c_ >= 3) WAITBAR(3); else if (c_ == 2) WAITBAR(2); else if (c_ == 1) WAITBAR(1); else WAITBAR(0); } while (0)
#define QK(S0, S1, slot) do { const LAS unsigned char* Ks_ = lds + LDS_K + (slot) * KSLOT + hi * 1024 + r32 * 16; \
        _Pragma("unroll") for (int ks = 0; ks < NKS; ++ks) { const bf16x8 k0_ = *(const LAS bf16x8*)(Ks_ + ks * 2048), k1_ = *(const LAS bf16x8*)(Ks_ + ks * 2048 + 512); \
            S0 = __builtin_amdgcn_mfma_f32_32x32x16_bf16(k0_, qr[ks], ks == 0 ? (NOMAX ? f32x16{} : negm) : S0, 0, 0, 0); S1 = __builtin_amdgcn_mfma_f32_32x32x16_bf16(k1_, qr[ks], ks == 0 ? (NOMAX ? f32x16{} : negm) : S1, 0, 0, 0); } } while (0)
    const int nK = (DK == 96 && wid < 4) ? 2 : 1;
    bf16x8 qr[NKS];
    { const bf16* Qw = A.Q + (A.qrow0 + wid * 32 + r32) * A.qpitch + A.qcol + hi * 8;
#pragma unroll
      for (int ks = 0; ks < NKS; ++ks) qr[ks] = *(const bf16x8*)(Qw + ks * 16); }
    asm volatile("s_waitcnt vmcnt(0)" ::: "memory");
    DMA_K(0); DMA_V(0); DMA_K(1); DMA_K(2); DMA_V(1);
    float mref = 0.f, lsum = 0.f; f32x16 o[2]; o[0] = f32x16{}; o[1] = f32x16{};
    f32x16 negm = f32x16{};
    const int vb = (4 * hi + ((lane & 15) >> 2)) * 64 + ((lane >> 4) & 1) * 32 + (lane & 3) * 8;
    f32x16 s0, s1;
    WAITBAR(0);
    QK(s0, s1, 0);
    if constexpr (!NOMAX) { float rm = __builtin_fmaxf(s0[0], s1[0]);
#pragma unroll
      for (int r = 1; r < 16; ++r) rm = __builtin_fmaxf(__builtin_fmaxf(rm, s0[r]), s1[r]);
      rm = swap32_max(rm); mref = rm;
#pragma unroll
      for (int r = 0; r < 16; ++r) { s0[r] -= rm; s1[r] -= rm; negm[r] = -rm; } }
    int vslot = 0;
#define HEAD(t) do { WAITBAR(0);        \
        if ((t) + 3 < NT) DMA_K((t) + 3); if ((t) + 4 < NT) DMA_K((t) + 4); \
        if ((t) + 2 < NT) DMA_V((t) + 2); if ((t) + 3 < NT) DMA_V((t) + 3); } while (0)
#define QKP(N0, N1, t) do { if ((t) + 1 < NT) { const LAS unsigned char* Ks_ = lds + LDS_K + (((t) + 1) & 3) * KSLOT + hi * 1024 + r32 * 16; \
            _Pragma("unroll") for (int kh = 0; kh < 2; ++kh) { bf16x8 kf[NKS]; \
                _Pragma("unroll") for (int k2 = 0; k2 < NKS / 2; ++k2) { const int ks = kh * (NKS / 2) + k2; kf[2 * k2] = *(const LAS bf16x8*)(Ks_ + ks * 2048); kf[2 * k2 + 1] = *(const LAS bf16x8*)(Ks_ + ks * 2048 + 512); } \
                __builtin_amdgcn_s_setprio(1); \
                _Pragma("unroll") for (int k2 = 0; k2 < NKS / 2; ++k2) { const int ks = kh * (NKS / 2) + k2; \
                    N0 = __builtin_amdgcn_mfma_f32_32x32x16_bf16(kf[2 * k2], qr[ks], ks == 0 ? (NOMAX ? f32x16{} : negm) : N0, 0, 0, 0); N1 = __builtin_amdgcn_mfma_f32_32x32x16_bf16(kf[2 * k2 + 1], qr[ks], ks == 0 ? (NOMAX ? f32x16{} : negm) : N1, 0, 0, 0); } \
                __builtin_amdgcn_s_setprio(0); } } } while (0)
#define SMP(C0, C1, N0, N1, t, NREADY) do { if constexpr (!NOMAX) { \
        float rm = __builtin_fmaxf(C0[0], C1[0]); \
        _Pragma("unroll") for (int r = 1; r < 16; ++r) rm = __builtin_fmaxf(__builtin_fmaxf(rm, C0[r]), C1[r]); \
        rm = swap32_max(rm); \
        if (__builtin_expect(__any(rm > THR), 0)) { \
            const float dl = __builtin_fmaxf(rm, 0.f), al = __builtin_amdgcn_exp2f(-dl); \
            mref += dl; lsum *= al; \
            _Pragma("unroll") for (int r = 0; r < 16; ++r) { C0[r] -= dl; C1[r] -= dl; negm[r] = -mref; } \
            if (NREADY && (t) + 1 < NT) { _Pragma("unroll") for (int r = 0; r < 16; ++r) { N0[r] -= dl; N1[r] -= dl; } } \
            if (hi == 0) wsf[r32] = al; \
            asm volatile("s_waitcnt lgkmcnt(0)" ::: "memory"); \
            _Pragma("unroll") for (int rq = 0; rq < 4; ++rq) { const f32x4 a4 = *(const LAS f32x4*)(wsf + 8 * rq + 4 * hi); \
                _Pragma("unroll") for (int j = 0; j < 4; ++j) { o[0][4 * rq + j] *= a4[j]; o[1][4 * rq + j] *= a4[j]; } } \
        } } \
        float ps0 = 0.f, ps1 = 0.f, ps2 = 0.f, ps3 = 0.f; \
        _Pragma("unroll") for (int r = 0; r < 16; r += 2) { C0[r] = __builtin_amdgcn_exp2f(C0[r]); C1[r] = __builtin_amdgcn_exp2f(C1[r]); C0[r + 1] = __builtin_amdgcn_exp2f(C0[r + 1]); C1[r + 1] = __builtin_amdgcn_exp2f(C1[r + 1]); \
            ps0 += C0[r]; ps1 += C1[r]; ps2 += C0[r + 1]; ps3 += C1[r + 1]; } \
        lsum += (ps0 + ps1) + (ps2 + ps3); \
        pw[0] = (u32x4){pk2(C0[0], C0[1]), pk2(C0[2], C0[3]), pk2(C0[4], C0[5]), pk2(C0[6], C0[7])}; \
        pw[1] = (u32x4){pk2(C0[8], C0[9]), pk2(C0[10], C0[11]), pk2(C0[12], C0[13]), pk2(C0[14], C0[15])}; \
        pw[2] = (u32x4){pk2(C1[0], C1[1]), pk2(C1[2], C1[3]), pk2(C1[4], C1[5]), pk2(C1[6], C1[7])}; \
        pw[3] = (u32x4){pk2(C1[8], C1[9]), pk2(C1[10], C1[11]), pk2(C1[12], C1[13]), pk2(C1[14], C1[15])}; } while (0)
#define PVP() do { const LAS unsigned char* Vs = lds + LDS_V + vslot * VSLOT + vb; \
        _Pragma("unroll") for (int d0 = 0; d0 < 2; ++d0) { s16x4 vlo[4], vhh[4]; \
            _Pragma("unroll") for (int i = 0; i < 4; ++i) { vlo[i] = vtr(Vs + d0 * 4096 + i * 1024); vhh[i] = vtr(Vs + d0 * 4096 + i * 1024 + 512); } \
            __builtin_amdgcn_s_setprio(1); \
            _Pragma("unroll") for (int ks = 0; ks < 4; ++ks) { \
                const bf16x8 vf = (bf16x8){vlo[ks][0], vlo[ks][1], vlo[ks][2], vlo[ks][3], vhh[ks][0], vhh[ks][1], vhh[ks][2], vhh[ks][3]}; \
                o[d0] = __builtin_amdgcn_mfma_f32_32x32x16_bf16(__builtin_bit_cast(bf16x8, pw[ks]), vf, o[d0], 0, 0, 0); } \
            __builtin_amdgcn_s_setprio(0); } \
        vslot = (vslot + 1) & 3; } while (0)
    f32x16 n0, n1; u32x4 pw[4];
    if (wid < 8) {
        for (int t = 0; t < NT; t += 2) {
            HEAD(t); QKP(n0, n1, t); SMP(s0, s1, n0, n1, t, 1); PVP();
            QKP(s0, s1, t + 1); SMP(n0, n1, s0, s1, t + 1, 1); PVP(); }
    } else {
        for (int t = 0; t < NT; t += 2) {
            HEAD(t); SMP(s0, s1, n0, n1, t, 0); PVP(); QKP(n0, n1, t);
            SMP(n0, n1, s0, s1, t + 1, 0); PVP(); QKP(s0, s1, t + 1); }
    }
#undef HEAD
#undef QKP
#undef SMP
#undef PVP
    lsum = swap32_sum(lsum);
    if (hi == 0) wsf[32 + r32] = __builtin_amdgcn_rcpf(lsum);
    asm volatile("s_waitcnt vmcnt(0) lgkmcnt(0)\n\ts_barrier" ::: "memory");
    { LAS bf16* stg = (LAS bf16*)(lds + wid * 4096);
#pragma unroll
      for (int rq = 0; rq < 4; ++rq) { const f32x4 i4 = *(const LAS f32x4*)(wsf + 32 + 8 * rq + 4 * hi);
#pragma unroll
          for (int j = 0; j < 4; ++j) { const int q = 8 * rq + 4 * hi + j;
              stg[q * 64 + r32] = (bf16)f2bf(o[0][4 * rq + j] * i4[j]); stg[q * 64 + 32 + r32] = (bf16)f2bf(o[1][4 * rq + j] * i4[j]); } }
      asm volatile("s_waitcnt lgkmcnt(0)" ::: "memory");
      bf16* Ow = A.O + (A.qrow0 + wid * 32) * A.opitch + A.ocol;
#pragma unroll
      for (int i = 0; i < 4; ++i) { const int row = i * 8 + (lane >> 3), ch = lane & 7; *(u32x4*)(Ow + (long)row * A.opitch + ch * 8) = *(const LAS u32x4*)(stg + row * 64 + ch * 8); } }
    asm volatile("s_waitcnt vmcnt(0) lgkmcnt(0)\n\ts_barrier" ::: "memory");
#undef TILE_ROW
#undef DMA_K
#undef DMA_V
#undef WAITBAR
#undef WAIT_CNT
#undef QK
}

template <int DK> __device__ __forceinline__ void attn_unit3(const AttnArgs& A, LAS unsigned char* lds, int wave_) {
    constexpr int NKS = DK / 16, KSLOT = (DK / 8) * 1024, NKSLOT = 4, NVSLOT = 4;
    constexpr int LDS_K = 0, LDS_V = NKSLOT * KSLOT, LDS_WS = LDS_V + NVSLOT * VSLOT;
    int tid = wave_ * 64 + lane_id(); asm volatile("" : "+v"(tid));
    const int lane = tid & 63, r32 = lane & 31, hi = lane >> 5; const int wid = __builtin_amdgcn_readfirstlane(tid >> 6);
    const unsigned lds0 = (unsigned)(uintptr_t)lds;
    LAS float* wsf = (LAS float*)(lds + LDS_WS) + wid * 64;
    const int NT = A.ntiles, b = A.b;
#define TILE_ROW(j) ((j) < 4 ? (long)(NLAT + b * CTXL + 64 * (j)) : (long)(b * SEQ + 64 * ((j) - 4)))
#define DMA_K(j) do { const long r0_ = TILE_ROW(j); const int s_ = (j) & 3; \
        glds16(A.K1 + (r0_ + lane) * A.k1pitch + A.k1col + wid * 8, (unsigned)__builtin_amdgcn_readfirstlane(lds0 + LDS_K + s_ * KSLOT + wid * 1024)); \
        if (DK == 96 && wid < 4) glds16(A.K2 + (r0_ + lane) * A.k2pitch + wid * 8, (unsigned)__builtin_amdgcn_readfirstlane(lds0 + LDS_K + s_ * KSLOT + (8 + wid) * 1024)); } while (0)
#define DMA_V(j) do { const long r0_ = TILE_ROW(j); const int s_ = (j) & 3; \
        glds16(A.V + (r0_ + 16 * (wid & 3) + (lane >> 2)) * A.vpitch + A.vcol + (wid >> 2) * 32 + (lane & 3) * 8, (unsigned)__builtin_amdgcn_readfirstlane(lds0 + LDS_V + (s_) * VSLOT + wid * 1024)); } while (0)
#define WAITBAR(n) asm volatile("s_waitcnt vmcnt(" #n ") lgkmcnt(0)\n\ts_barrier" ::: "memory")
    bf16x8 qr[NKS];
    { const bf16* Qw = A.Q + (A.qrow0 + wid * 32 + r32) * A.qpitch + A.qcol + hi * 8;
#pragma unroll
      for (int ks = 0; ks < NKS; ++ks) qr[ks] = *(const bf16x8*)(Qw + ks * 16); }
    asm volatile("s_waitcnt vmcnt(0)" ::: "memory");
    DMA_K(0); DMA_K(1); DMA_V(0); DMA_K(2); DMA_K(3); DMA_V(1);
    float ls0 = 0.f, ls1 = 0.f, ls2 = 0.f, ls3 = 0.f; f32x16 o[2]; o[0] = f32x16{}; o[1] = f32x16{};
    const int vb = (4 * hi + ((lane & 15) >> 2)) * 64 + ((lane >> 4) & 1) * 32 + (lane & 3) * 8;
    const LAS unsigned char* Kb = lds + LDS_K + hi * 1024 + r32 * 16;
    const LAS unsigned char* Vb = lds + LDS_V + vb;
#define QKH(S0, S1, j, kh) do { const LAS unsigned char* Ks_ = Kb + ((j) & 3) * KSLOT; bf16x8 kf[NKS]; \
        _Pragma("unroll") for (int k2 = 0; k2 < NKS / 2; ++k2) { const int ks = (kh) * (NKS / 2) + k2; kf[2 * k2] = *(const LAS bf16x8*)(Ks_ + ks * 2048); kf[2 * k2 + 1] = *(const LAS bf16x8*)(Ks_ + ks * 2048 + 512); } \
        _Pragma("unroll") for (int k2 = 0; k2 < NKS / 2; ++k2) { const int ks = (kh) * (NKS / 2) + k2; \
            S0 = __builtin_amdgcn_mfma_f32_32x32x16_bf16(kf[2 * k2], qr[ks], ks == 0 ? f32x16{} : S0, 0, 0, 0); S1 = __builtin_amdgcn_mfma_f32_32x32x16_bf16(kf[2 * k2 + 1], qr[ks], ks == 0 ? f32x16{} : S1, 0, 0, 0); } } while (0)
#define PVH(PW, j, d0) do { const LAS unsigned char* Vs_ = Vb + ((j) & 3) * VSLOT + (d0) * 4096; s16x4 vlo[4], vhh[4]; \
        _Pragma("unroll") for (int i = 0; i < 4; ++i) { vlo[i] = vtr(Vs_ + i * 1024); vhh[i] = vtr(Vs_ + i * 1024 + 512); } \
        _Pragma("unroll") for (int ks = 0; ks < 4; ++ks) { const bf16x8 vf = (bf16x8){vlo[ks][0], vlo[ks][1], vlo[ks][2], vlo[ks][3], vhh[ks][0], vhh[ks][1], vhh[ks][2], vhh[ks][3]}; \
            o[d0] = __builtin_amdgcn_mfma_f32_32x32x16_bf16(__builtin_bit_cast(bf16x8, PW[ks]), vf, o[d0], 0, 0, 0); } } while (0)
#define SOFT(C0, C1, PW) do { \
        _Pragma("unroll") for (int r = 0; r < 16; r += 2) { C0[r] = __builtin_amdgcn_exp2f(C0[r]); C1[r] = __builtin_amdgcn_exp2f(C1[r]); C0[r + 1] = __builtin_amdgcn_exp2f(C0[r + 1]); C1[r + 1] = __builtin_amdgcn_exp2f(C1[r + 1]); \
            ls0 += C0[r]; ls1 += C1[r]; ls2 += C0[r + 1]; ls3 += C1[r + 1]; } \
        PW[0] = (u32x4){pk2(C0[0], C0[1]), pk2(C0[2], C0[3]), pk2(C0[4], C0[5]), pk2(C0[6], C0[7])}; \
        PW[1] = (u32x4){pk2(C0[8], C0[9]), pk2(C0[10], C0[11]), pk2(C0[12], C0[13]), pk2(C0[14], C0[15])}; \
        PW[2] = (u32x4){pk2(C1[0], C1[1]), pk2(C1[2], C1[3]), pk2(C1[4], C1[5]), pk2(C1[6], C1[7])}; \
        PW[3] = (u32x4){pk2(C1[8], C1[9]), pk2(C1[10], C1[11]), pk2(C1[12], C1[13]), pk2(C1[14], C1[15])}; } while (0)
#define HINTS() do { _Pragma("unroll") for (int h_ = 0; h_ < 2; ++h_) { __builtin_amdgcn_sched_group_barrier(0x100, NKS + 8, 0); \
            _Pragma("unroll") for (int g_ = 0; g_ < NKS + 4; ++g_) { __builtin_amdgcn_sched_group_barrier(0x008, 1, 0); __builtin_amdgcn_sched_group_barrier(0x400, 2, 0); __builtin_amdgcn_sched_group_barrier(0x002, 3, 0); } } } while (0)
#define STEP3(N0, N1, C0, C1, PN, PC, t) do { __builtin_amdgcn_sched_barrier(0); \
        QKH(N0, N1, (t) + 2, 0); PVH(PC, t, 0); QKH(N0, N1, (t) + 2, 1); PVH(PC, t, 1); SOFT(C0, C1, PN); HINTS(); __builtin_amdgcn_sched_barrier(0); } while (0)
    f32x16 sA0, sA1, sB0, sB1; u32x4 pA[4], pB[4];
    WAITBAR(0);
    QKH(sA0, sA1, 0, 0); QKH(sA0, sA1, 0, 1); QKH(sB0, sB1, 1, 0); QKH(sB0, sB1, 1, 1);
    SOFT(sA0, sA1, pA);
    int t = 0;
    for (; t + 3 < NT; t += 2) {
        WAITBAR(0);
        if (t + 4 < NT) DMA_K(t + 4); if (t + 5 < NT) DMA_K(t + 5); if (t + 2 < NT) DMA_V(t + 2); if (t + 3 < NT) DMA_V(t + 3);
        STEP3(sA0, sA1, sB0, sB1, pB, pA, t);
        STEP3(sB0, sB1, sA0, sA1, pA, pB, t + 1);
    }
    WAITBAR(0);
    __builtin_amdgcn_sched_barrier(0);
    PVH(pA, t, 0); PVH(pA, t, 1); SOFT(sB0, sB1, pB);
    __builtin_amdgcn_sched_barrier(0);
    PVH(pB, t + 1, 0); PVH(pB, t + 1, 1);
    float lsum = (ls0 + ls1) + (ls2 + ls3);
    lsum = swap32_sum(lsum);
    if (hi == 0) wsf[32 + r32] = __builtin_amdgcn_rcpf(lsum);
    asm volatile("s_waitcnt vmcnt(0) lgkmcnt(0)\n\ts_barrier" ::: "memory");
    { LAS bf16* stg = (LAS bf16*)(lds + wid * 4096);
#pragma unroll
      for (int rq = 0; rq < 4; ++rq) { const f32x4 i4 = *(const LAS f32x4*)(wsf + 32 + 8 * rq + 4 * hi);
#pragma unroll
          for (int j = 0; j < 4; ++j) { const int q = 8 * rq + 4 * hi + j;
              stg[q * 64 + r32] = (bf16)f2bf(o[0][4 * rq + j] * i4[j]); stg[q * 64 + 32 + r32] = (bf16)f2bf(o[1][4 * rq + j] * i4[j]); } }
      asm volatile("s_waitcnt lgkmcnt(0)" ::: "memory");
      bf16* Ow = A.O + (A.qrow0 + wid * 32) * A.opitch + A.ocol;
#pragma unroll
      for (int i = 0; i < 4; ++i) { const int row = i * 8 + (lane >> 3), ch = lane & 7; *(u32x4*)(Ow + (long)row * A.opitch + ch * 8) = *(const LAS u32x4*)(stg + row * 64 + ch * 8); } }
    asm volatile("s_waitcnt vmcnt(0) lgkmcnt(0)\n\ts_barrier" ::: "memory");
#undef TILE_ROW
#undef DMA_K
#undef DMA_V
#undef WAITBAR
#undef QKH
#undef PVH
#undef SOFT
#undef HINTS
#undef STEP3
}

#define ASBAR() __builtin_amdgcn_sched_barrier(0)
#define APIN(x) asm volatile("" : "+v"(x))
template <int DK> __device__ __forceinline__ void attn_unit4(const AttnArgs& A, LAS unsigned char* lds, int wave_) {
    constexpr int NKS = DK / 16, KSLOT = (DK / 8) * 1024, NKSLOT = 4, NVSLOT = 4;
    constexpr int LDS_K = 0, LDS_V = NKSLOT * KSLOT, LDS_WS = LDS_V + NVSLOT * VSLOT;
    int tid = wave_ * 64 + lane_id(); asm volatile("" : "+v"(tid));
    const int lane = tid & 63, r32 = lane & 31, hi = lane >> 5; const int wid = __builtin_amdgcn_readfirstlane(tid >> 6);
    const unsigned lds0 = (unsigned)(uintptr_t)lds;
    LAS float* wsf = (LAS float*)(lds + LDS_WS) + wid * 64;
    const int NT = A.ntiles, b = A.b;
#define TILE_ROW(j) ((j) < 4 ? (long)(NLAT + b * CTXL + 64 * (j)) : (long)(b * SEQ + 64 * ((j) - 4)))
#define DMA_K(j) do { const long r0_ = TILE_ROW(j); const int s_ = (j) & 3; \
        glds16(A.K1 + (r0_ + lane) * A.k1pitch + A.k1col + wid * 8, (unsigned)__builtin_amdgcn_readfirstlane(lds0 + LDS_K + s_ * KSLOT + wid * 1024)); \
        if (DK == 96 && wid < 4) glds16(A.K2 + (r0_ + lane) * A.k2pitch + wid * 8, (unsigned)__builtin_amdgcn_readfirstlane(lds0 + LDS_K + s_ * KSLOT + (8 + wid) * 1024)); } while (0)
#define DMA_V(j) do { const long r0_ = TILE_ROW(j); const int s_ = (j) & 3; \
        glds16(A.V + (r0_ + 16 * (wid & 3) + (lane >> 2)) * A.vpitch + A.vcol + (wid >> 2) * 32 + (lane & 3) * 8, (unsigned)__builtin_amdgcn_readfirstlane(lds0 + LDS_V + (s_) * VSLOT + wid * 1024)); } while (0)
#define WAITBAR(n) asm volatile("s_waitcnt vmcnt(" #n ") lgkmcnt(0)\n\ts_barrier" ::: "memory")
    bf16x8 qr[NKS];
    { const bf16* Qw = A.Q + (A.qrow0 + wid * 32 + r32) * A.qpitch + A.qcol + hi * 8;
#pragma unroll
      for (int ks = 0; ks < NKS; ++ks) qr[ks] = *(const bf16x8*)(Qw + ks * 16); }
    DMA_K(0); DMA_K(1); DMA_V(0); DMA_K(2); DMA_K(3); DMA_V(1);
    float lsum = 0.f; f32x16 o[2]; o[0] = f32x16{}; o[1] = f32x16{};
    const LAS unsigned char* Kb = lds + LDS_K + hi * 1024 + r32 * 16;
    const LAS unsigned char* Vb = lds + LDS_V + (4 * hi + ((lane & 15) >> 2)) * 64 + ((lane >> 4) & 1) * 32 + (lane & 3) * 8;
    f32x16 pA0, pA1, pB0, pB1; bf16x8 kf[2 * NKS]; s16x4 vlo[8], vhi[8]; u32x4 pw0, pw1, pw2, pw3;
#define MF(a, b, c) __builtin_amdgcn_mfma_f32_32x32x16_bf16(a, b, c, 0, 0, 0)
#define KLD2(kp, d0) do { kf[2 * (d0)] = *(const LAS bf16x8*)((kp) + (d0) * 2048); kf[2 * (d0) + 1] = *(const LAS bf16x8*)((kp) + (d0) * 2048 + 512); } while (0)
#define PKW(P, i) pk2(P[i], P[(i) + 1])
#define PAF(k) __builtin_bit_cast(bf16x8, pw##k)
#define VFR(i) (bf16x8){vlo[i][0], vlo[i][1], vlo[i][2], vlo[i][3], vhi[i][0], vhi[i][1], vhi[i][2], vhi[i][3]}
#define VRD(i) do { vlo[i] = vtr(vp_ + (((i) >> 2) * 4096 + ((i) & 3) * 1024)); vhi[i] = vtr(vp_ + (((i) >> 2) * 4096 + ((i) & 3) * 1024 + 512)); } while (0)
#define KRD(G, d0) do { if (G) { KLD2(kn_, d0); ASBAR(); } } while (0)
#define EX(v) __builtin_amdgcn_exp2f(v)
#define GAPA(MFS, a0, a1, a2, a3, W0, W1, PW) do { MFS; sacc += a0; sacc += a1; sacc += a2; sacc += a3; W0; W1; APIN(PW); APIN(sacc); ASBAR(); } while (0)
#define GAPB(MFS, X, i) do { MFS; X[i] = EX(X[i]); X[(i) + 1] = EX(X[(i) + 1]); X[(i) + 2] = EX(X[(i) + 2]); X[(i) + 3] = EX(X[(i) + 3]); APIN(X); ASBAR(); } while (0)
#define STEP4(C0, C1, P0, P1, t, GL) do { ASBAR(); \
    const LAS unsigned char* vp_ = Vb + (((t) - 1) & 3) * VSLOT; const LAS unsigned char* kn_ = Kb + (((t) + 1) & 3) * KSLOT; \
    VRD(0); ASBAR(); float sacc = P0[0] + P0[1]; \
                     GAPA(C0 = MF(kf[0], qr[0], f32x16{}), P0[2], P0[3], P0[4], P0[5],     pw0[0] = PKW(P0, 0),  pw0[1] = PKW(P0, 2),  pw0); \
    VRD(4); ASBAR(); GAPA(C1 = MF(kf[1], qr[0], f32x16{}), P0[6], P0[7], P0[8], P0[9],     pw0[2] = PKW(P0, 4),  pw0[3] = PKW(P0, 6),  pw0); \
    VRD(1); ASBAR(); GAPA(C0 = MF(kf[2], qr[1], C0),       P0[10], P0[11], P0[12], P0[13], pw1[0] = PKW(P0, 8),  pw1[1] = PKW(P0, 10), pw1); \
    VRD(5); ASBAR(); GAPA(C1 = MF(kf[3], qr[1], C1),       P0[14], P0[15], P1[0], P1[1],   pw1[2] = PKW(P0, 12), pw1[3] = PKW(P0, 14), pw1); \
    VRD(2); ASBAR(); GAPA(C0 = MF(kf[4], qr[2], C0),       P1[2], P1[3], P1[4], P1[5],     pw2[0] = PKW(P1, 0),  pw2[1] = PKW(P1, 2),  pw2); \
    VRD(6); ASBAR(); GAPA(C1 = MF(kf[5], qr[2], C1),       P1[6], P1[7], P1[8], P1[9],     pw2[2] = PKW(P1, 4),  pw2[3] = PKW(P1, 6),  pw2); \
    VRD(3); ASBAR(); GAPA(C0 = MF(kf[6], qr[3], C0),       P1[10], P1[11], P1[12], P1[13], pw3[0] = PKW(P1, 8),  pw3[1] = PKW(P1, 10), pw3); \
    VRD(7); ASBAR(); GAPA(C1 = MF(kf[7], qr[3], C1),       P1[14], P1[15], 0.f, 0.f,       pw3[2] = PKW(P1, 12), pw3[3] = PKW(P1, 14), pw3); \
    if (NKS == 6) { C0 = MF(kf[2 * (NKS - 2)], qr[NKS - 2], C0); C1 = MF(kf[2 * (NKS - 2) + 1], qr[NKS - 2], C1); C0 = MF(kf[2 * (NKS - 1)], qr[NKS - 1], C0); C1 = MF(kf[2 * (NKS - 1) + 1], qr[NKS - 1], C1); ASBAR(); } \
    lsum += sacc; ASBAR(); \
    GAPB(o[0] = MF(PAF(0), VFR(0), o[0]), C0, 0);               KRD((GL) && NKS == 6, 4); GAPB(o[1] = MF(PAF(0), VFR(4), o[1]), C0, 4); \
    KRD(GL, 0); GAPB(o[0] = MF(PAF(1), VFR(1), o[0]), C0, 8);   KRD(GL, 1); GAPB(o[1] = MF(PAF(1), VFR(5), o[1]), C0, 12); \
    KRD(GL, 2); GAPB(o[0] = MF(PAF(2), VFR(2), o[0]), C1, 0);   KRD(GL, 3); GAPB(o[1] = MF(PAF(2), VFR(6), o[1]), C1, 4); \
    KRD((GL) && NKS == 6, 5); GAPB(o[0] = MF(PAF(3), VFR(3), o[0]), C1, 8);   GAPB(o[1] = MF(PAF(3), VFR(7), o[1]), C1, 12); \
    } while (0)
    WAITBAR(0);
#pragma unroll
    for (int d0 = 0; d0 < NKS; ++d0) KLD2(Kb, d0);
#pragma unroll
    for (int d0 = 0; d0 < NKS; ++d0) { pA0 = MF(kf[2 * d0], qr[d0], d0 == 0 ? f32x16{} : pA0); pA1 = MF(kf[2 * d0 + 1], qr[d0], d0 == 0 ? f32x16{} : pA1); }
#pragma unroll
    for (int r = 0; r < 16; ++r) { pA0[r] = EX(pA0[r]); pA1[r] = EX(pA1[r]); }
#pragma unroll
    for (int d0 = 0; d0 < NKS; ++d0) KLD2(Kb + KSLOT, d0);
    int t = 1;
    for (; t + 2 < NT; t += 2) {
        WAITBAR(0);
        if (t + 3 < NT) DMA_K(t + 3); if (t + 4 < NT) DMA_K(t + 4); if (t + 1 < NT) DMA_V(t + 1); if (t + 2 < NT) DMA_V(t + 2);
        STEP4(pB0, pB1, pA0, pA1, t, true);
        STEP4(pA0, pA1, pB0, pB1, t + 1, true);
    }
    WAITBAR(0);
    STEP4(pB0, pB1, pA0, pA1, t, false);
    { ASBAR(); float sacc = pB0[0] + pB0[1];
#pragma unroll
      for (int r = 2; r < 16; ++r) sacc += pB0[r];
#pragma unroll
      for (int r = 0; r < 16; ++r) sacc += pB1[r];
      lsum += sacc;
      pw0 = (u32x4){PKW(pB0, 0), PKW(pB0, 2), PKW(pB0, 4), PKW(pB0, 6)}; pw1 = (u32x4){PKW(pB0, 8), PKW(pB0, 10), PKW(pB0, 12), PKW(pB0, 14)};
      pw2 = (u32x4){PKW(pB1, 0), PKW(pB1, 2), PKW(pB1, 4), PKW(pB1, 6)}; pw3 = (u32x4){PKW(pB1, 8), PKW(pB1, 10), PKW(pB1, 12), PKW(pB1, 14)};
      const LAS unsigned char* vp_ = Vb + (t & 3) * VSLOT;
#pragma unroll
      for (int i = 0; i < 8; ++i) VRD(i);
      o[0] = MF(PAF(0), VFR(0), o[0]); o[1] = MF(PAF(0), VFR(4), o[1]); o[0] = MF(PAF(1), VFR(1), o[0]); o[1] = MF(PAF(1), VFR(5), o[1]);
      o[0] = MF(PAF(2), VFR(2), o[0]); o[1] = MF(PAF(2), VFR(6), o[1]); o[0] = MF(PAF(3), VFR(3), o[0]); o[1] = MF(PAF(3), VFR(7), o[1]); }
    lsum = swap32_sum(lsum);
    if (hi == 0) wsf[32 + r32] = __builtin_amdgcn_rcpf(lsum);
    asm volatile("s_waitcnt vmcnt(0) lgkmcnt(0)\n\ts_barrier" ::: "memory");
    { LAS bf16* stg = (LAS bf16*)(lds + wid * 4096);
#pragma unroll
      for (int rq = 0; rq < 4; ++rq) { const f32x4 i4 = *(const LAS f32x4*)(wsf + 32 + 8 * rq + 4 * hi);
#pragma unroll
          for (int j = 0; j < 4; ++j) { const int q = 8 * rq + 4 * hi + j;
              stg[q * 64 + r32] = (bf16)f2bf(o[0][4 * rq + j] * i4[j]); stg[q * 64 + 32 + r32] = (bf16)f2bf(o[1][4 * rq + j] * i4[j]); } }
      asm volatile("s_waitcnt lgkmcnt(0)" ::: "memory");
      bf16* Ow = A.O + (A.qrow0 + wid * 32) * A.opitch + A.ocol;
#pragma unroll
      for (int i = 0; i < 4; ++i) { const int row = i * 8 + (lane >> 3), ch = lane & 7; *(u32x4*)(Ow + (long)row * A.opitch + ch * 8) = *(const LAS u32x4*)(stg + row * 64 + ch * 8); } }
    asm volatile("s_waitcnt vmcnt(0) lgkmcnt(0)\n\ts_barrier" ::: "memory");
#undef TILE_ROW
#undef DMA_K
#undef DMA_V
#undef WAITBAR
#undef MF
#undef KLD2
#undef PKW
#undef PAF
#undef VFR
#undef VRD
#undef KRD
#undef EX
#undef GAPA
#undef GAPB
#undef STEP4
}
#undef ASBAR
#undef APIN
}

namespace s5 {
constexpr int NCH = LPOS / 16;
constexpr int M_MC = 0, M_WCF = 65536, M_WCB = 65536 + 32768, M_WSF = 131072, M_WSB = 131072 + 32768, M_TOTAL = 196608;
constexpr int LDS_E = 18 * 4096;

struct Params { const float *lam_re, *lam_im, *log_dt, *b_re, *b_im, *c_re, *c_im, *dsk; };

__device__ __forceinline__ void build_mats(const Params& P, int l, int g, bf16* out, LAS unsigned char* lds, int wave_) {
    LAS f32x2* apow = (LAS f32x2*)lds;
    LAS f32x2* Bb = apow + 2 * 64 * 17;
    LAS f32x2* Cc = Bb + 2 * 64 * 16;
    LAS float* Kt = (LAS float*)(Cc + 2 * 16 * 64);
    constexpr int KTL = 260, KTD = 16 * KTL;
    const int tid = wave_ * 64 + lane_id();
    LAS float* lamv = Kt + 2 * KTD;
    LAS float* dskv = lamv + 512;
    f32x2 cv[4], bv[4];
#pragma unroll
    for (int m = 0; m < 4; ++m) { const int i = tid + NTHREADS * m; { const int dir = i >> 10, hp = (i >> 6) & 15, p = i & 63; const size_t ci = ((size_t)((l * 2 + dir) * 32 + g) * 16 + hp) * 64 + p; cv[m] = (f32x2){P.c_re[ci], P.c_im[ci]}; }
        { const int dir = i >> 10, p = (i >> 4) & 63, h = i & 15, pi = ((l * 2 + dir) * 32 + g) * 64 + p; bv[m] = (f32x2){P.b_re[(size_t)pi * 16 + h], P.b_im[(size_t)pi * 16 + h]}; } }
    if (tid < 128) { const int dir = tid >> 6, p = tid & 63, pi = ((l * 2 + dir) * 32 + g) * 64 + p;
        lamv[4 * tid] = fminf(P.lam_re[pi], -1e-4f); lamv[4 * tid + 1] = P.lam_im[pi]; lamv[4 * tid + 2] = expf(P.log_dt[(l * 2 + dir) * 32 + g]); }
    else if (tid < 144) dskv[tid - 128] = P.dsk[(l * 32 + g) * 16 + tid - 128];
#pragma unroll
    for (int m = 0; m < 4; ++m) Cc[tid + NTHREADS * m] = cv[m];
    __syncthreads();
    for (int i = tid; i < 2 * 64 * 17; i += NTHREADS) {
        const int dir = i / (64 * 17), r = i - dir * (64 * 17), p = r / 17, j = r - p * 17;
        const float lr = lamv[4 * (dir * 64 + p)], li = lamv[4 * (dir * 64 + p) + 1], dt = lamv[4 * (dir * 64 + p) + 2];
        const float mag = expf((float)j * lr * dt), ang = (float)j * li * dt; apow[i] = (f32x2){mag * cosf(ang), mag * sinf(ang)}; }
#pragma unroll
    for (int m = 0; m < 4; ++m) {
        const int i = tid + NTHREADS * m, dir = i >> 10, p = (i >> 4) & 63;
        const float lr = lamv[4 * (dir * 64 + p)], li = lamv[4 * (dir * 64 + p) + 1], dt = lamv[4 * (dir * 64 + p) + 2];
        const float abr = expf(lr * dt) * cosf(li * dt), abi = expf(lr * dt) * sinf(li * dt), den = lr * lr + li * li;
        const float fr = ((abr - 1.0f) * lr + abi * li) / den, fi = (abi * lr - (abr - 1.0f) * li) / den;
        const float br = bv[m].x, bi = bv[m].y; Bb[i] = (f32x2){fr * br - fi * bi, fr * bi + fi * br}; }
    __syncthreads();
    {
        const int dir = tid >> 8, j = (tid >> 4) & 15, hp0 = ((tid >> 2) & 3) * 4, h0 = (tid & 3) * 4; float sacc[4][4];
#pragma unroll
        for (int x = 0; x < 4; ++x)
#pragma unroll
            for (int y = 0; y < 4; ++y) sacc[x][y] = 0.f;
        for (int p = 0; p < 64; ++p) { const f32x2 a = apow[(dir * 64 + p) * 17 + j];
            const f32x2 c0_ = Cc[(dir * 16 + hp0) * 64 + p], c1_ = Cc[(dir * 16 + hp0 + 1) * 64 + p], c2_ = Cc[(dir * 16 + hp0 + 2) * 64 + p], c3_ = Cc[(dir * 16 + hp0 + 3) * 64 + p];
            const f32x4 c01 = {c0_.x, c0_.y, c1_.x, c1_.y}, c23 = {c2_.x, c2_.y, c3_.x, c3_.y};
            const f32x4 b01 = *(const LAS f32x4*)(Bb + (dir * 64 + p) * 16 + h0), b23 = *(const LAS f32x4*)(Bb + (dir * 64 + p) * 16 + h0 + 2);
            const float cx[4] = {c01[0], c01[2], c23[0], c23[2]}, cy[4] = {c01[1], c01[3], c23[1], c23[3]}, bx[4] = {b01[0], b01[2], b23[0], b23[2]}, by[4] = {b01[1], b01[3], b23[1], b23[3]};
#pragma unroll
            for (int x = 0; x < 4; ++x) { const float tr = cx[x] * a.x - cy[x] * a.y, ti = cx[x] * a.y + cy[x] * a.x;
#pragma unroll
                for (int y = 0; y < 4; ++y) sacc[x][y] += tr * bx[y] - ti * by[y]; } }
#pragma unroll
        for (int x = 0; x < 4; ++x) *(LAS f32x4*)(Kt + dir * KTD + j * KTL + (hp0 + x) * 16 + h0) = (f32x4){sacc[x][0], sacc[x][1], sacc[x][2], sacc[x][3]};
    }
    __syncthreads();
#pragma unroll 4
    for (int i = tid; i < 65536 / 8; i += NTHREADS) {
        const int row = i >> 5, c0 = (i & 31) * 8, t = row >> 4, hp = row & 15, s = c0 >> 4, h0 = c0 & 15; float v[8];
        const int lf = s <= t ? t - s : 0, lb = s >= t ? s - t : 0;
        const f32x4 f0 = *(const LAS f32x4*)(Kt + lf * KTL + hp * 16 + h0), f1 = *(const LAS f32x4*)(Kt + lf * KTL + hp * 16 + h0 + 4);
        const f32x4 b0 = *(const LAS f32x4*)(Kt + KTD + lb * KTL + hp * 16 + h0), b1 = *(const LAS f32x4*)(Kt + KTD + lb * KTL + hp * 16 + h0 + 4);
        const float wf = s <= t ? 1.f : 0.f, wb = s >= t ? 1.f : 0.f;
#pragma unroll
        for (int e = 0; e < 8; ++e) { const int h = h0 + e; float x = 0.f;
            if (s <= t) x += (e < 4 ? f0[e & 3] : f1[e & 3]);
            if (s >= t) x += (e < 4 ? b0[e & 3] : b1[e & 3]);
            if (s == t && h == hp) x += dskv[h];
            v[e] = x; }
        (void)wf; (void)wb;
        *(u32x4*)(out + M_MC + (size_t)row * 256 + c0) = pack8(v);
    }
#pragma unroll 4
    for (int i = tid; i < 2 * 32768 / 8; i += NTHREADS) {
        const int dir = i >> 12, ii = i & 4095, row = ii >> 4, c0 = (ii & 15) * 8, t = row >> 4, hp = row & 15, ex = dir == 0 ? t + 1 : 16 - t; float v[8];
#pragma unroll
        for (int e = 0; e < 8; e += 2) { const int p = (c0 + e) >> 1; const f32x2 c = Cc[(dir * 16 + hp) * 64 + p], a = apow[(dir * 64 + p) * 17 + ex];
            v[e] = c.x * a.x - c.y * a.y; v[e + 1] = -(c.x * a.y + c.y * a.x); }
        *(u32x4*)(out + (dir == 0 ? M_WCF : M_WCB) + (size_t)row * 128 + c0) = pack8(v);
    }
#pragma unroll 4
    for (int i = tid; i < 2 * 32768 / 8; i += NTHREADS) {
        const int dir = i >> 12, ii = i & 4095, row = ii >> 5, c0 = (ii & 31) * 8, p = row >> 1, im = row & 1, s = c0 >> 4, h0 = c0 & 15, ex = dir == 0 ? 15 - s : s; float v[8];
        const f32x2 a = apow[(dir * 64 + p) * 17 + ex];
#pragma unroll
        for (int e = 0; e < 8; ++e) { const f32x2 bb = Bb[(dir * 64 + p) * 16 + h0 + e]; v[e] = im ? (a.x * bb.y + a.y * bb.x) : (a.x * bb.x - a.y * bb.y); }
        *(u32x4*)(out + (dir == 0 ? M_WSF : M_WSB) + (size_t)row * 256 + c0) = pack8(v);
    }
    __syncthreads();
}

__device__ __forceinline__ void build_a16(const Params& P, float* a16, int gt, int ngt) {
    for (int pi = gt; pi < 2 * 2 * 32 * 64; pi += ngt) {
        const float lr = fminf(P.lam_re[pi], -1e-4f), li = P.lam_im[pi], dt = expf(P.log_dt[pi >> 6]);
        const float mag = expf(16.f * lr * dt), ang = 16.f * li * dt; a16[2 * pi] = mag * cosf(ang); a16[2 * pi + 1] = mag * sinf(ang); }
}
__device__ __forceinline__ void unit(const float* a16, int l, int b, int g, const bf16* Ug, const bf16* mats, bf16* Aglu, bool skip_ctx, LAS unsigned char* lds, int wave_, int half) {
    int tid = wave_ * 64 + lane_id(); asm volatile("" : "+v"(tid));
    const int lane = tid & 63, n = lane & 15, q = lane >> 4; const int wid = __builtin_amdgcn_readfirstlane(tid >> 6);
    LAS unsigned char* Ef = lds; LAS unsigned char* Eb = lds + LDS_E;
    const bf16* U = Ug + (size_t)(b * 32 + g) * LPOS * 16;
    const int rt = 8 * half + wid;
    f32x4 yi[17];
    {
        bf16x8 af[8], ab[8], am[8]; u32x4 st[4]; unsigned uoff[8];
#pragma unroll
        for (int ks = 0; ks < 8; ++ks) { af[ks] = *(const bf16x8*)(mats + M_WSF + (size_t)(16 * wid + n) * 256 + 32 * ks + 8 * q); ab[ks] = *(const bf16x8*)(mats + M_WSB + (size_t)(16 * wid + n) * 256 + 32 * ks + 8 * q);
            am[ks] = *(const bf16x8*)(mats + M_MC + (size_t)(16 * rt + n) * 256 + 32 * ks + 8 * q); }
        const bf16* ug = U + wid * 512 + lane * 8;
        const int ns = 2 * wid + (lane >> 5), js = lane & 31;
        const unsigned sdst = (ns < 8 ? 0u : (unsigned)LDS_E) + (ns & 7) * 512 + ((js ^ ns) << 4);
#pragma unroll
        for (int i = 0; i < 4; ++i) st[i] = *(const u32x4*)(ug + i * 4096);
#pragma unroll
        for (int ks = 0; ks < 8; ++ks) uoff[ks] = (n < 8 ? 0u : (unsigned)LDS_E) + (n & 7) * 512 + (((4 * ks + q) ^ n) << 4);
        *(LAS u32x4*)(lds + sdst + 4096) = st[0]; st[0] = *(const u32x4*)(ug + 4 * 4096);
        __syncthreads();
#pragma unroll
        for (int t = 0; t < 17; ++t) {
            bf16x8 ub[8];
#pragma unroll
            for (int ks = 0; ks < 8; ++ks) ub[ks] = *(const LAS bf16x8*)(lds + 4096 * (t + 1) + uoff[ks]);
            if (t + 1 < 17) { *(LAS u32x4*)(lds + sdst + 4096 * (t + 2)) = st[(t + 1) & 3]; if (t + 5 < 17) st[(t + 1) & 3] = *(const u32x4*)(ug + (t + 5) * 4096); }
            f32x4 cf = {0.f, 0.f, 0.f, 0.f}, cb = {0.f, 0.f, 0.f, 0.f}, cy = {0.f, 0.f, 0.f, 0.f};
#pragma unroll
            for (int ks = 0; ks < 8; ++ks) { cf = __builtin_amdgcn_mfma_f32_16x16x32_bf16(af[ks], ub[ks], cf, 0, 0, 0); cb = __builtin_amdgcn_mfma_f32_16x16x32_bf16(ab[ks], ub[ks], cb, 0, 0, 0);
                if (!(t == 0 && skip_ctx)) cy = __builtin_amdgcn_mfma_f32_16x16x32_bf16(am[ks], ub[ks], cy, 0, 0, 0); }
            yi[t] = cy;
            const int eo = (16 * t + n) * 256 + (((2 * wid + (q >> 1)) ^ n) << 4) + (q & 1) * 8;
            *(LAS u32x2*)(Ef + eo) = (u32x2){pk2(cf[0], cf[1]), pk2(cf[2], cf[3])};
            *(LAS u32x2*)(Eb + eo) = (u32x2){pk2(cb[0], cb[1]), pk2(cb[2], cb[3])};
            __syncthreads();
        }
    }
    bf16x8 wf[4], wb[4];
#pragma unroll
    for (int ks = 0; ks < 4; ++ks) { wf[ks] = *(const bf16x8*)(mats + M_WCF + (size_t)(16 * rt + n) * 128 + 32 * ks + 8 * q); wb[ks] = *(const bf16x8*)(mats + M_WCB + (size_t)(16 * rt + n) * 128 + 32 * ks + 8 * q); }
    if (wid < 2) {
        const int dir = wid, p = lane, pi = ((l * 2 + dir) * 32 + g) * 64 + p;
        const float ar = a16[2 * pi], ai = a16[2 * pi + 1];
        LAS unsigned* E32 = (LAS unsigned*)(dir ? Eb : Ef);
        float xr = 0.f, xi = 0.f;
#define S5_CH(st) (dir == 0 ? (st) : ((st) < 16 ? 15 - (st) : NCH + 15 - (st)))
#define S5_EW(k, j) (S5_CH(16 * (k) + (j)) * 64 + ((((p >> 2) ^ (dir == 0 ? (j) : 15 - (j))) << 2) | (p & 3)))
        unsigned ea[16], eb[16];
#pragma unroll
        for (int j = 0; j < 16; ++j) ea[j] = E32[S5_EW(0, j)];
        for (int k = 0; k < 17; k += 2) {
#pragma unroll
            for (int j = 0; j < 16; ++j) eb[j] = E32[S5_EW(k + 1 < 17 ? k + 1 : k, j)];
#pragma unroll
            for (int j = 0; j < 16; ++j) { const unsigned e = ea[j]; E32[S5_EW(k, j)] = pk2(xr, xi);
                const float er = bf2f(e & 0xffffu), ei = bf2f(e >> 16); const float nr = ar * xr - ai * xi + er, ni = ar * xi + ai * xr + ei; xr = nr; xi = ni; }
            if (k + 1 < 17) {
#pragma unroll
                for (int j = 0; j < 16; ++j) ea[j] = E32[S5_EW(k + 2 < 17 ? k + 2 : k + 1, j)];
#pragma unroll
                for (int j = 0; j < 16; ++j) { const unsigned e = eb[j]; E32[S5_EW(k + 1, j)] = pk2(xr, xi);
                    const float er = bf2f(e & 0xffffu), ei = bf2f(e >> 16); const float nr = ar * xr - ai * xi + er, ni = ar * xi + ai * xr + ei; xr = nr; xi = ni; }
            }
        }
#undef S5_EW
#undef S5_CH
    }
    __syncthreads();
    {
        unsigned xoff[4];
#pragma unroll
        for (int ks = 0; ks < 4; ++ks) xoff[ks] = n * 256 + (((q + 4 * ks) ^ n) << 4);
#pragma unroll
        for (int ct = 0; ct < 17; ++ct) {
            if (ct == 0 && skip_ctx) continue;
            int cto = ct; asm volatile("" : "+s"(cto));
            f32x4 acc = yi[ct];
#pragma unroll
            for (int ks = 0; ks < 4; ++ks) { acc = __builtin_amdgcn_mfma_f32_16x16x32_bf16(wf[ks], *(const LAS bf16x8*)(Ef + 4096 * cto + xoff[ks]), acc, 0, 0, 0);
                acc = __builtin_amdgcn_mfma_f32_16x16x32_bf16(wb[ks], *(const LAS bf16x8*)(Eb + 4096 * cto + xoff[ks]), acc, 0, 0, 0); }
            const int pos = (16 * cto + n) * 16 + rt;
            *(u32x2*)(Aglu + (size_t)pos_row(b, pos) * 512 + g * 16 + 4 * q) = (u32x2){pk2(fgelu_tanh(acc[0]), fgelu_tanh(acc[1])), pk2(fgelu_tanh(acc[2]), fgelu_tanh(acc[3]))};
        }
    }
    __syncthreads();
}
}

struct Ptrs {
    const float *x, *c, *ctx, *c_ctx, *w_mod, *b_mod, *g_mix_pre, *g_mix_post, *g_ffn_pre, *g_ffn_post, *w_in, *g_q, *g_k, *g_cq, *g_ckv, *w_uq, *w_ukv;
    s5::Params s5p;
    const float *w_glu, *w_branch, *w_mg, *b_mg, *w_out, *ffn_w1, *ffn_w3, *ffn_w2, *router_w, *router_b, *moe_w1, *moe_w3, *moe_w2;
    float* out; unsigned char* ws;
};

template <int MAP  >
__device__ __forceinline__ void transpose_item(const float* W, int K, int N, bf16* WT, int kb, int n0, int drow0, LAS float* scr, int lane) {
    const int k0 = 64 * kb;
#pragma unroll
    for (int i = 0; i < 8; ++i) { const int kk = 8 * i + (lane >> 3), c4 = 4 * (lane & 7); const f32x4 v = *(const f32x4*)(W + (size_t)(k0 + kk) * N + n0 + c4);
        LAS float* d = scr + kk * 33 + c4; d[0] = v[0]; d[1] = v[1]; d[2] = v[2]; d[3] = v[3]; }
    asm volatile("s_waitcnt lgkmcnt(0)" ::: "memory");
    const int c = lane & 7;
#pragma unroll
    for (int j = 0; j < 4; ++j) { const int n = (lane >> 3) + 8 * j; const LAS float* s = scr + (8 * c) * 33 + n;
        u32x4 o; o.x = pk2(s[0 * 33], s[1 * 33]); o.y = pk2(s[2 * 33], s[3 * 33]); o.z = pk2(s[4 * 33], s[5 * 33]); o.w = pk2(s[6 * 33], s[7 * 33]);
        int dr = n; if (MAP == 1) { const int i2 = n & 15; dr = 8 * (i2 >> 2) + (i2 & 3) + ((n >> 4) << 2); }
        *(u32x4*)(WT + (size_t)(drow0 + dr) * K + k0 + 8 * c) = o; }
    asm volatile("s_waitcnt lgkmcnt(0)" ::: "memory");
}

__device__ __forceinline__ void transpose_item_f8(const float* W, int K, int N, unsigned char* WT, int kb, int n0, int drow0, float wscale, LAS float* scr, int lane) {
    const int k0 = 64 * kb;
#pragma unroll
    for (int i = 0; i < 8; ++i) { const int kk = 8 * i + (lane >> 3), c4 = 4 * (lane & 7); const f32x4 v = *(const f32x4*)(W + (size_t)(k0 + kk) * N + n0 + c4);
        LAS float* d = scr + kk * 33 + c4; d[0] = v[0]; d[1] = v[1]; d[2] = v[2]; d[3] = v[3]; }
    asm volatile("s_waitcnt lgkmcnt(0)" ::: "memory");
    const int c = lane & 7;
#pragma unroll
    for (int j = 0; j < 4; ++j) { const int n = (lane >> 3) + 8 * j; const LAS float* s = scr + (8 * c) * 33 + n;
        u32x2 o; o.x = pg8::pk_fp8x4(s[0 * 33] * wscale, s[1 * 33] * wscale, s[2 * 33] * wscale, s[3 * 33] * wscale); o.y = pg8::pk_fp8x4(s[4 * 33] * wscale, s[5 * 33] * wscale, s[6 * 33] * wscale, s[7 * 33] * wscale);
        *(u32x2*)(WT + (size_t)(drow0 + n) * K + k0 + 8 * c) = o; }
    asm volatile("s_waitcnt lgkmcnt(0)" ::: "memory");
}
__device__ __forceinline__ int zmap(int n0) { return n0 < 512 ? n0 : n0 < 896 ? ZC_CQ + (n0 - 512) : n0 < 1024 ? ZC_KG + (n0 - 896) : n0 < 1152 ? ZC_VG + (n0 - 1024) : n0 < 1440 ? n0 : ZC_U + (n0 - 1440); }
__device__ __forceinline__ int pairmap(int n0, int second) { return 256 * (n0 >> 7) + (second ? 128 : 0) + (n0 & 127); }

__device__ __forceinline__ void transposes(const Ptrs& P, int gw, int ngw, LAS float* scr, int lane, int qsel = 0) {
    unsigned char* ws = P.ws;
    constexpr int I_WIN = 16 * 61, I_MG = 16 * 96, I_UQ = 6 * 24, I_UKV = 4 * 32, I_GLU = 8 * 32, I_BR = 8 * 32, I_OUT = 16 * 32, I_F13 = 16 * 88, I_F2 = 44 * 32;
    constexpr int PER_L = I_WIN + I_MG + I_UQ + I_UKV + I_GLU + 3 * I_BR + I_OUT;
    constexpr int N_L = 2 * PER_L, N_F = 2 * I_F13 + I_F2, N_M = 8 * (2 * I_F13 + I_F2), NITEMS = N_L + N_F + N_M;
    const int qx = (int)blockIdx.x & 7;
    unsigned* q = (unsigned*)(ws + WS_CTL) + CW_Q + 256 * qsel + 32 * qx; (void)gw; (void)ngw;
    for (;;) { int base = 0; if (lane == 0) base = (int)atomicAdd(q, 4u); base = __builtin_amdgcn_readfirstlane(base); if (base * 8 + qx + N_M >= NITEMS) break;
    for (int it_ = base; it_ < base + 4; ++it_) { const int it = it_ * 8 + qx + N_M; if (it >= NITEMS) break;
        int r = it;
        if (r < N_M) {
            const int e = r / (2 * I_F13 + I_F2); r -= e * (2 * I_F13 + I_F2);
            unsigned char* W1T = ws + WS_WM1T + (size_t)e * 5632 * 1024; unsigned char* W2T = ws + WS_WM2T + (size_t)e * 1024 * 2816;
            if (r < I_F13) { const int kb = r / 88, nb = r % 88; if (F8_M1) transpose_item_f8(P.moe_w1 + (size_t)e * 1024 * DFF, 1024, DFF, W1T, kb, 32 * nb, pairmap(32 * nb, 0), F8_WSCALE, scr, lane); else transpose_item<0>(P.moe_w1 + (size_t)e * 1024 * DFF, 1024, DFF, (bf16*)(ws + WS_WM1T) + (size_t)e * 5632 * 1024, kb, 32 * nb, pairmap(32 * nb, 0), scr, lane); continue; } r -= I_F13;
            if (r < I_F13) { const int kb = r / 88, nb = r % 88; if (F8_M1) transpose_item_f8(P.moe_w3 + (size_t)e * 1024 * DFF, 1024, DFF, W1T, kb, 32 * nb, pairmap(32 * nb, 1), F8_WSCALE, scr, lane); else transpose_item<0>(P.moe_w3 + (size_t)e * 1024 * DFF, 1024, DFF, (bf16*)(ws + WS_WM1T) + (size_t)e * 5632 * 1024, kb, 32 * nb, pairmap(32 * nb, 1), scr, lane); continue; } r -= I_F13;
            { const int kb = r / 32, nb = r % 32; transpose_item_f8(P.moe_w2 + (size_t)e * DFF * 1024, DFF, 1024, W2T, kb, 32 * nb, 32 * nb, F8_WSCALE, scr, lane); continue; }
        }
        r -= N_M;
        if (r < N_F) {
            unsigned char* W1T = ws + WS_WF1T; unsigned char* W2T = ws + WS_WF2T;
            if (r < I_F13) { const int kb = r / 88, nb = r % 88; if (F8_D1) transpose_item_f8(P.ffn_w1, 1024, DFF, W1T, kb, 32 * nb, pairmap(32 * nb, 0), F8_WSCALE, scr, lane); else transpose_item<0>(P.ffn_w1, 1024, DFF, (bf16*)W1T, kb, 32 * nb, pairmap(32 * nb, 0), scr, lane); continue; } r -= I_F13;
            if (r < I_F13) { const int kb = r / 88, nb = r % 88; if (F8_D1) transpose_item_f8(P.ffn_w3, 1024, DFF, W1T, kb, 32 * nb, pairmap(32 * nb, 1), F8_WSCALE, scr, lane); else transpose_item<0>(P.ffn_w3, 1024, DFF, (bf16*)W1T, kb, 32 * nb, pairmap(32 * nb, 1), scr, lane); continue; } r -= I_F13;
            { const int kb = r / 32, nb = r % 32; if (F8_D2) transpose_item_f8(P.ffn_w2, DFF, 1024, W2T, kb, 32 * nb, 32 * nb, F8_WSCALE, scr, lane); else transpose_item<0>(P.ffn_w2, DFF, 1024, (bf16*)W2T, kb, 32 * nb, 32 * nb, scr, lane); continue; }
        }
        r -= N_F;
        const int l = r / PER_L; r -= l * PER_L;
        if (r < I_WIN) { const int kb = r / 61, nb = r % 61; if (F8_G1L1 && l == 1) transpose_item_f8(P.w_in + (size_t)l * 1024 * NIN, 1024, NIN, ws + WS_W1T + (size_t)l * ZW * 2048, kb, 32 * nb, zmap(32 * nb), F8_WSCALE, scr, lane);
            else transpose_item<0>(P.w_in + (size_t)l * 1024 * NIN, 1024, NIN, (bf16*)(ws + WS_W1T) + (size_t)l * ZW * 1024, kb, 32 * nb, zmap(32 * nb), scr, lane); continue; } r -= I_WIN;
        if (r < I_MG) { const int kb = r / 96, nb = r % 96; transpose_item_f8(P.w_mg + (size_t)l * 1024 * 3072, 1024, 3072, ws + WS_WMGT + (size_t)l * 3072 * 1024, kb, 32 * nb, 32 * nb, F8_WSCALE, scr, lane); continue; } r -= I_MG;
        if (r < I_UQ) { const int kb = r / 24, nb = r % 24; bf16* T = (bf16*)(ws + WS_WUQT) + (size_t)l * 768 * 384;
            if (nb % 3 == 2) transpose_item<1>(P.w_uq + (size_t)l * 384 * 768, 384, 768, T, kb, 32 * nb, 32 * nb, scr, lane); else transpose_item<0>(P.w_uq + (size_t)l * 384 * 768, 384, 768, T, kb, 32 * nb, 32 * nb, scr, lane); continue; } r -= I_UQ;
        if (r < I_UKV) { const int kb = r / 32, nb = r % 32; transpose_item<0>(P.w_ukv + (size_t)l * 256 * 1024, 256, 1024, (bf16*)(ws + WS_WUKVT) + (size_t)l * 1024 * 256, kb, 32 * nb, 32 * nb, scr, lane); continue; } r -= I_UKV;
        if (r < I_GLU) { const int kb = r / 32, nb = r % 32, n0 = 32 * nb; transpose_item<0>(P.w_glu + (size_t)l * 512 * 1024, 512, 1024, (bf16*)(ws + WS_WGLUT) + (size_t)l * 1024 * 512, kb, n0, n0 < 512 ? pairmap(n0, 0) : pairmap(n0 - 512, 1), scr, lane); continue; } r -= I_GLU;
        if (r < 3 * I_BR) { const int n = r / I_BR; r -= n * I_BR; const int kb = r / 32, nb = r % 32;
            transpose_item<0>(P.w_branch + ((size_t)l * 3 + n) * 512 * 1024, 512, 1024, (bf16*)(ws + WS_WBT) + ((size_t)l * 3 + n) * 1024 * 512, kb, 32 * nb, 32 * nb, scr, lane); continue; } r -= 3 * I_BR;
        { const int kb = r / 32, nb = r % 32; transpose_item<0>(P.w_out + (size_t)l * 1024 * 1024, 1024, 1024, (bf16*)(ws + WS_WOUTT) + (size_t)l * 1024 * 1024, kb, 32 * nb, 32 * nb, scr, lane); }
    } }
}


constexpr int MOE_ITEMS_PER_E = 2 * 16 * 88 + 44 * 32, MOE_ITEMS = 8 * MOE_ITEMS_PER_E;
__device__ __forceinline__ void moe_transposes(const float* w1, const float* w3, const float* w2, unsigned char* ws, int lo, int hi, int giw, int ngiw, LAS float* scr, int lane) {
    constexpr int I_F13 = 16 * 88;
    for (int it = lo + giw; it < hi; it += ngiw) {
        const int e = it / MOE_ITEMS_PER_E; int r = it - e * MOE_ITEMS_PER_E;
        unsigned char* W1T = ws + WS_WM1T + (size_t)e * 5632 * 1024; unsigned char* W2T = ws + WS_WM2T + (size_t)e * 1024 * 2816;
        if (r < I_F13) { const int kb = r / 88, nb = r % 88; if (F8_M1) transpose_item_f8(w1 + (size_t)e * 1024 * DFF, 1024, DFF, W1T, kb, 32 * nb, pairmap(32 * nb, 0), F8_WSCALE, scr, lane); else transpose_item<0>(w1 + (size_t)e * 1024 * DFF, 1024, DFF, (bf16*)(ws + WS_WM1T) + (size_t)e * 5632 * 1024, kb, 32 * nb, pairmap(32 * nb, 0), scr, lane); continue; } r -= I_F13;
        if (r < I_F13) { const int kb = r / 88, nb = r % 88; if (F8_M1) transpose_item_f8(w3 + (size_t)e * 1024 * DFF, 1024, DFF, W1T, kb, 32 * nb, pairmap(32 * nb, 1), F8_WSCALE, scr, lane); else transpose_item<0>(w3 + (size_t)e * 1024 * DFF, 1024, DFF, (bf16*)(ws + WS_WM1T) + (size_t)e * 5632 * 1024, kb, 32 * nb, pairmap(32 * nb, 1), scr, lane); continue; } r -= I_F13;
        { const int kb = r / 32, nb = r % 32; transpose_item_f8(w2 + (size_t)e * DFF * 1024, DFF, 1024, W2T, kb, 32 * nb, 32 * nb, F8_WSCALE, scr, lane); }
    }
}
__device__ __forceinline__ void mod_item(const Ptrs& P, int item, LAS unsigned char* lds, int wave_) {
    LAS float* sc = (LAS float*)lds;
    LAS float* part = sc + 5 * 1024;
    const int lane = lane_id(), wid = wave_, tid = wid * 64 + lane, l = item / 96, n0 = (item % 96) * 64;
    for (int i = tid; i < 5 * 1024; i += NTHREADS) { const float v = i < 4096 ? P.c[i] : P.c_ctx[i - 4096]; sc[i] = v / (1.0f + expf(-v)); }
    __syncthreads();
    float a[5] = {0.f, 0.f, 0.f, 0.f, 0.f};
    const float* W = P.w_mod + (size_t)l * 1024 * 6144 + n0 + lane;
    for (int k0 = wid; k0 < 1024; k0 += 256) {
        float w[32];
#pragma unroll
        for (int j = 0; j < 32; ++j) w[j] = W[(size_t)(k0 + 8 * j) * 6144];
#pragma unroll
        for (int j = 0; j < 32; ++j)
#pragma unroll
            for (int r = 0; r < 5; ++r) a[r] += sc[r * 1024 + k0 + 8 * j] * w[j]; }
#pragma unroll
    for (int r = 0; r < 5; ++r) part[(wid * 5 + r) * 64 + lane] = a[r];
    __syncthreads();
    if (tid < 320) { const int r = tid >> 6; float s = 0.f;
#pragma unroll
        for (int w = 0; w < 8; ++w) s += part[(w * 5 + r) * 64 + lane];
        ((float*)(P.ws + WS_MOD))[((size_t)l * 5 + r) * 6144 + n0 + lane] = s + P.b_mod[l * 6144 + n0 + lane]; }
    __syncthreads();
}
__device__ __forceinline__ void copy_params(const Ptrs& P, int gt, int ngt) {
    float* par = (float*)(P.ws + WS_PAR);
    for (int i = gt; i < 2048; i += ngt) { par[PR_GMIXPRE + i] = P.g_mix_pre[i]; par[PR_GMIXPOST + i] = P.g_mix_post[i]; par[PR_GFFNPRE + i] = P.g_ffn_pre[i]; par[PR_GFFNPOST + i] = P.g_ffn_post[i]; }
    for (int i = gt; i < 128; i += ngt) { par[PR_GQ + i] = P.g_q[i]; par[PR_GK + i] = P.g_k[i]; }
    for (int i = gt; i < 768; i += ngt) par[PR_GCQ + i] = P.g_cq[i];
    for (int i = gt; i < 512; i += ngt) par[PR_GCKV + i] = P.g_ckv[i];
    for (int i = gt; i < 6144; i += ngt) par[PR_BMG + i] = P.b_mg[i];
    for (int i = gt; i < 8192; i += ngt) par[PR_RW + i] = P.router_w[i];
    for (int i = gt; i < 8; i += ngt) par[PR_RB + i] = P.router_b[i];
    s5::build_a16(P.s5p, par + PR_A16, gt, ngt);
}
__device__ __forceinline__ void rope_tables(const Ptrs& P, int gt, int ngt) {
    float* ca = (float*)(P.ws + WS_ROPE); float* sa = ca + 4096 * 32; float* cb = sa + 4096 * 32; float* sb = cb + 4096 * 16;
    for (int i = gt; i < 4096 * 32; i += ngt) { const int pos = i >> 5, j = i & 31; const float f = expf(-9.210340371976184f * (float)(j & 15) * (1.0f / 16.0f));
        const float ang = (float)(j < 16 ? pos / GRIDW : pos % GRIDW) * f; ca[i] = cosf(ang); sa[i] = sinf(ang); }
    for (int i = gt; i < 4096 * 16; i += ngt) { const int pos = i >> 4, j = i & 15; const float f = expf(-9.210340371976184f * (float)(j & 7) * (1.0f / 8.0f));
        const float ang = (float)(j < 8 ? pos / GRIDW : pos % GRIDW) * f; cb[i] = cosf(ang); sb[i] = sinf(ang); }
}

__device__ __forceinline__ void ld8(const float* p, float (&o)[8]) { const f32x4 a = *(const f32x4*)p, b = *(const f32x4*)(p + 4); o[0] = a[0]; o[1] = a[1]; o[2] = a[2]; o[3] = a[3]; o[4] = b[0]; o[5] = b[1]; o[6] = b[2]; o[7] = b[3]; }
__device__ __forceinline__ void token_row(unsigned char* ws, int l, int row, int lane) {
    const float* par = (const float*)(ws + WS_PAR);
    const bf16* z = (const bf16*)(ws + P_Z) + (size_t)row * ZW;
    const bool lat = row < NLAT; const int t = row & (SEQ - 1);
    const float* cosA = (const float*)(ws + WS_ROPE) + t * 32; const float* sinA = cosA + 4096 * 32;
    const float* cosB = (const float*)(ws + WS_ROPE) + 2 * 4096 * 32 + t * 16; const float* sinB = cosB + 4096 * 16;
    float v0[8], v1[8], v2[8];
    unpack8(*(const u32x4*)(z + 8 * lane), v0); unpack8(*(const u32x4*)(z + 512 + 8 * lane), v1); unpack8(*(const u32x4*)(z + 1024 + 8 * lane), v2);
    const u32x4 uraw = *(const u32x4*)(z + ZC_U + 8 * lane);
    float ca[8], sa[8], cb8[8], sb8[8];
    ld8(cosA + ((8 * (lane & 7)) & 31), ca); ld8(sinA + ((8 * (lane & 7)) & 31), sa); ld8(cosB + ((8 * ((lane - 48) & 3)) & 15), cb8); ld8(sinB + ((8 * ((lane - 48) & 3)) & 15), sb8);
    { float ss = 0.f;
#pragma unroll
      for (int j = 0; j < 8; ++j) ss += v0[j] * v0[j];
      ss += shfl_xor_l(ss, 1, lane); ss += shfl_xor_l(ss, 2, lane); ss += shfl_xor_l(ss, 4, lane);
      const float rs = rsqrtf(ss * (1.0f / 64.0f) + EPS); const int d0 = 8 * (lane & 7); float o[8], gq[8];
      ld8(par + PR_GQ + l * 64 + d0, gq);
#pragma unroll
      for (int j = 0; j < 8; ++j) v0[j] = v0[j] * rs * gq[j];
#pragma unroll
      for (int j = 0; j < 8; ++j) { const float other = shfl_xor_l(v0[j], 4, lane); const float c = ca[j], s = sa[j];
          o[j] = lat ? ((d0 < 32) ? v0[j] * c - other * s : other * s + v0[j] * c) : v0[j];
          o[j] *= 0.125f * LOG2E; }
      *(u32x4*)((bf16*)(ws + P_QA) + (size_t)row * 512 + 8 * lane) = pack8(o); }
    { float ss = 0.f;
#pragma unroll
      for (int j = 0; j < 8; ++j) ss += v1[j] * v1[j];
      float ssk = ss; ssk += shfl_xor_l(ssk, 1, lane); ssk += shfl_xor_l(ssk, 2, lane); ssk += shfl_xor_l(ssk, 4, lane);
      float ss2 = 0.f;
#pragma unroll
      for (int j = 0; j < 8; ++j) ss2 += v2[j] * v2[j];
      const float sq = wave_sum((lane >= 32 ? ss : 0.f) + (lane < 16 ? ss2 : 0.f));
      const float skv = wave_sum((lane >= 16 && lane < 48) ? ss2 : 0.f);
      const float rq = rsqrtf(sq * (1.0f / 384.0f) + EPS), rkv = rsqrtf(skv * (1.0f / 256.0f) + EPS);
      { const float rs = rsqrtf(ssk * (1.0f / 64.0f) + EPS); const int d0 = 8 * (lane & 7); float kk[8], o[8], gk[8];
        ld8(par + PR_GK + l * 64 + d0, gk);
#pragma unroll
        for (int j = 0; j < 8; ++j) kk[j] = v1[j] * rs * gk[j];
#pragma unroll
        for (int j = 0; j < 8; ++j) { const float other = shfl_xor_l(kk[j], 4, lane); const float c = ca[j], s = sa[j];
            o[j] = lat ? ((d0 < 32) ? kk[j] * c - other * s : other * s + kk[j] * c) : kk[j]; }
        if (lane < 16) *(u32x4*)((bf16*)(ws + P_KA) + (size_t)row * 128 + 8 * lane) = pack8(o); }
      if (lane >= 16 && lane < 32) *(u32x4*)((bf16*)(ws + P_VA) + (size_t)row * 128 + 8 * (lane - 16)) = pack8(v1);
      { float g1[8], g2[8], g3[8], o[8];
        const int i1 = lane >= 32 ? 8 * (lane - 32) : 0, i2 = lane < 16 ? 256 + 8 * lane : 0, i3 = (lane >= 16 && lane < 48) ? 8 * (lane - 16) : 0;
        ld8(par + PR_GCQ + l * 384 + i1, g1); ld8(par + PR_GCQ + l * 384 + i2, g2); ld8(par + PR_GCKV + l * 256 + i3, g3);
#pragma unroll
        for (int j = 0; j < 8; ++j) o[j] = v1[j] * rq * g1[j];
        if (lane >= 32) *(u32x4*)((bf16*)(ws + P_CQN) + (size_t)row * 384 + i1) = pack8(o);
#pragma unroll
        for (int j = 0; j < 8; ++j) o[j] = v2[j] * rq * g2[j];
        if (lane < 16) *(u32x4*)((bf16*)(ws + P_CQN) + (size_t)row * 384 + i2) = pack8(o);
#pragma unroll
        for (int j = 0; j < 8; ++j) o[j] = v2[j] * rkv * g3[j];
        if (lane >= 16 && lane < 48) *(u32x4*)((bf16*)(ws + P_CKVN) + (size_t)row * 256 + i3) = pack8(o); }
      { float o[8]; const int i0 = 8 * ((lane - 48) & 3);
#pragma unroll
        for (int j = 0; j < 8; ++j) { const float other = shfl_xor_l(v2[j], 2, lane); const float c = cb8[j], s = sb8[j];
            o[j] = lat ? ((i0 < 16) ? v2[j] * c - other * s : other * s + v2[j] * c) : v2[j]; }
        if (lane >= 48 && lane < 52) *(u32x4*)((bf16*)(ws + P_KRR) + (size_t)row * 32 + i0) = pack8(o); }
    }
    { const int b = lat ? row >> 12 : (row - NLAT) >> 8, pos = lat ? CTXL + t : (row - NLAT) & 255, g = lane >> 1;
      *(u32x4*)((bf16*)(ws + P_UG) + ((size_t)(b * 32 + g) * LPOS + pos) * 16 + 8 * (lane & 1)) = uraw; }
}

struct ResidArgs {
    int mode;
    const float* y; const float* g_post; int gate_chunk;
    const float* g_pre; int shift_chunk;
    bool dry;
    float ysc;
    bf16* hout; int l_mod; bool h8; unsigned char* hout8;
    int l_gate; bool route;
};
__device__ __forceinline__ void resid_row(unsigned char* ws, float* outp, const float* xin, const float* ctxin, const ResidArgs R, int row, int lane, const LAS int* tb) {
    const float* par = (const float*)(ws + WS_PAR);
    const bool lat = row < NLAT; const int b = lat ? row >> 12 : (row - NLAT) >> 8, mr = lat ? b : 4;
    const float* mod = (const float*)(ws + WS_MOD);
    float* latp = lat ? outp + (size_t)row * 1024 : (float*)(ws + WS_LATC) + (size_t)(row - NLAT) * 1024;
    f32x4 v[4];
    if (R.mode == 0) { const float* src = lat ? xin + (size_t)row * 1024 : ctxin + (size_t)(row - NLAT) * 1024;
#pragma unroll
        for (int j = 0; j < 4; ++j) v[j] = *(const f32x4*)(src + 4 * lane + 256 * j);
    } else {
        f32x4 yv[4];
        if (R.mode == 1) {
#pragma unroll
            for (int j = 0; j < 4; ++j) yv[j] = *(const f32x4*)(R.y + (size_t)row * 1024 + 4 * lane + 256 * j) * R.ysc;
        } else if (R.mode == 3) {
            const bf16* yb = (const bf16*)R.y + (size_t)row * 1024;
#pragma unroll
            for (int j = 0; j < 4; ++j) { const u32x2 a = *(const u32x2*)(yb + 4 * lane + 256 * j);
                yv[j] = (f32x4){bf2f(a.x & 0xffffu), bf2f(a.x >> 16), bf2f(a.y & 0xffffu), bf2f(a.y >> 16)} * R.ysc; }
        } else {
            const int* ti = (const int*)(ws + WS_LIST) + 8 * 16384 + row * 8;
            const int e0 = ti[0], p0 = ti[1], e1 = ti[2], p1 = ti[3]; const float w0 = __int_as_float(ti[4]) * R.ysc, w1 = __int_as_float(ti[5]) * R.ysc;
            const bf16* f0 = (const bf16*)(ws + P_Y2) + ((size_t)tb[8 + e0] * 256 + p0) * 1024; const bf16* f1 = (const bf16*)(ws + P_Y2) + ((size_t)tb[8 + e1] * 256 + p1) * 1024;
#pragma unroll
            for (int j = 0; j < 4; ++j) { const u32x2 a = *(const u32x2*)(f0 + 4 * lane + 256 * j), c = *(const u32x2*)(f1 + 4 * lane + 256 * j);
                yv[j][0] = w0 * bf2f(a.x & 0xffffu) + w1 * bf2f(c.x & 0xffffu); yv[j][1] = w0 * bf2f(a.x >> 16) + w1 * bf2f(c.x >> 16);
                yv[j][2] = w0 * bf2f(a.y & 0xffffu) + w1 * bf2f(c.y & 0xffffu); yv[j][3] = w0 * bf2f(a.y >> 16) + w1 * bf2f(c.y >> 16); }
        }
        float ss = 0.f;
#pragma unroll
        for (int j = 0; j < 4; ++j) ss += (yv[j][0] * yv[j][0] + yv[j][1] * yv[j][1]) + (yv[j][2] * yv[j][2] + yv[j][3] * yv[j][3]);
        const float rs = rsqrtf(wave_sum(ss) * (1.0f / 1024.0f) + EPS);
        const float* gate = mod + ((size_t)R.l_gate * 5 + mr) * 6144 + R.gate_chunk * 1024;
#pragma unroll
        for (int j = 0; j < 4; ++j) { const int c = 4 * lane + 256 * j; const f32x4 lv = *(const f32x4*)(latp + c), gp = *(const f32x4*)(R.g_post + c), gt = *(const f32x4*)(gate + c);
            v[j] = lv + gt * (yv[j] * rs * gp); }
    }
    if (!R.dry) {
#pragma unroll
    for (int j = 0; j < 4; ++j) *(f32x4*)(latp + 4 * lane + 256 * j) = v[j]; }
    if (R.hout == nullptr) return;
    float ss = 0.f;
#pragma unroll
    for (int j = 0; j < 4; ++j) ss += (v[j][0] * v[j][0] + v[j][1] * v[j][1]) + (v[j][2] * v[j][2] + v[j][3] * v[j][3]);
    const float rs = rsqrtf(wave_sum(ss) * (1.0f / 1024.0f) + EPS);
    const float* shift = mod + ((size_t)R.l_mod * 5 + mr) * 6144 + R.shift_chunk * 1024; const float* scale = shift + 1024;
    f32x4 hv[4];
#pragma unroll
    for (int j = 0; j < 4; ++j) { const int c = 4 * lane + 256 * j; const f32x4 gp = *(const f32x4*)(R.g_pre + c), sh = *(const f32x4*)(shift + c), sc = *(const f32x4*)(scale + c);
        hv[j] = (v[j] * rs * gp) * (1.0f + sc) + sh;
        if (R.dry) { if (hv[j][0] == 123.456f) *(float*)(ws + WS_CTL + 64) = 1.f; continue; }
        if (R.hout8) *(unsigned*)(R.hout8 + (size_t)row * 1024 + c) = pg8::pk_fp8x4(hv[j][0] * F8_HSCALE, hv[j][1] * F8_HSCALE, hv[j][2] * F8_HSCALE, hv[j][3] * F8_HSCALE);
        if (R.h8) *(unsigned*)((unsigned char*)R.hout + (size_t)row * 1024 + c) = pg8::pk_fp8x4(hv[j][0] * F8_HSCALE, hv[j][1] * F8_HSCALE, hv[j][2] * F8_HSCALE, hv[j][3] * F8_HSCALE);
        else *(u32x2*)(R.hout + (size_t)row * 1024 + c) = (u32x2){pk2(hv[j][0], hv[j][1]), pk2(hv[j][2], hv[j][3])}; }
    if (R.route) {
        float lg[8];
#pragma unroll
        for (int e = 0; e < 8; ++e) lg[e] = 0.f;
#pragma unroll
        for (int j = 0; j < 4; ++j)
#pragma unroll
            for (int i = 0; i < 4; ++i) { const float* rw = par + PR_RW + (size_t)(4 * lane + 256 * j + i) * 8; const f32x4 r0 = *(const f32x4*)rw, r1 = *(const f32x4*)(rw + 4); const float hvv = hv[j][i];
                lg[0] += hvv * r0[0]; lg[1] += hvv * r0[1]; lg[2] += hvv * r0[2]; lg[3] += hvv * r0[3]; lg[4] += hvv * r1[0]; lg[5] += hvv * r1[1]; lg[6] += hvv * r1[2]; lg[7] += hvv * r1[3]; }
#pragma unroll
        for (int e = 0; e < 8; ++e) lg[e] = wave_sum(lg[e]) + par[PR_RB + e];
        int e0 = 0; float b0 = lg[0];
#pragma unroll
        for (int e = 1; e < 8; ++e) if (lg[e] > b0) { b0 = lg[e]; e0 = e; }
        int e1 = -1; float b1 = -3.0e38f;
#pragma unroll
        for (int e = 0; e < 8; ++e) if (e != e0 && lg[e] > b1) { b1 = lg[e]; e1 = e; }
        if (lane == 0 && !R.dry) {
            const float w0 = 1.0f / (1.0f + expf(b1 - b0)), w1 = 1.0f - w0;
            unsigned* cnt = (unsigned*)(ws + WS_CTL) + CW_CNT;
            const int p0 = (int)atomicAdd(cnt + e0, 1u), p1 = (int)atomicAdd(cnt + e1, 1u);
            int* list = (int*)(ws + WS_LIST); list[e0 * 16384 + p0] = row; list[e1 * 16384 + p1] = row;
            int* ti = list + 8 * 16384 + row * 8; ti[0] = e0; ti[1] = p0; ti[2] = e1; ti[3] = p1; ti[4] = __float_as_int(w0); ti[5] = __float_as_int(w1);
        }
    }
}

#if MK_DEBUG
namespace dbg {
__device__ __forceinline__ unsigned hash(unsigned a, unsigned b) { unsigned x = a * 0x9E3779B1u ^ (b + 0x7F4A7C15u) * 0x85EBCA77u; x ^= x >> 15; x *= 0xC2B2AE3Du; x ^= x >> 13; x *= 0x27D4EB2Fu; x ^= x >> 16; return x; }
__device__ __forceinline__ float rbf(float f) { return bf2f(f2bf(f)); }
__device__ __forceinline__ void add(unsigned char* ws, int k, float got, float ref, int lane) {
    if (lane == 0) { float* d = (float*)(ws + WS_CTL) + CW_DBG + 2 * k; const float df = got - ref; atomicAdd(d, (df == df && fabsf(df) < 1e18f) ? df * df : 1e30f); atomicAdd(d + 1, ref * ref); }
}
__device__ __forceinline__ float dot_aw(const bf16* a, const float* w, size_t wstride, int K, int lane) { float s = 0.f; for (int k = lane; k < K; k += 64) s += bf2f(a[k]) * rbf(w[(size_t)k * wstride]); return wave_sum(s); }

__device__ __forceinline__ float angA(int t, int i) { return (float)(i < 16 ? t / 64 : t % 64) * powf(10000.f, -(float)(2 * (i & 15)) / 32.f); }
__device__ __forceinline__ float angB(int t, int i) { return (float)(i < 8 ? t / 64 : t % 64) * powf(10000.f, -(float)(2 * (i & 7)) / 16.f); }
__device__ __forceinline__ void chk_mod(unsigned char* ws, const float* const* in, int gw, int ngw, int lane) {
    for (int s = gw; s < 1024; s += ngw) { const unsigned hh = hash(s, 1); const int l = hh & 1, r = (hh >> 1) % 5, n = (hh >> 8) % 6144; float a = 0.f;
        for (int k = lane; k < 1024; k += 64) { const float c = r < 4 ? in[1][r * 1024 + k] : in[3][k]; a += c / (1.f + expf(-c)) * in[4][((size_t)l * 1024 + k) * 6144 + n]; }
        a = wave_sum(a) + in[5][l * 6144 + n]; add(ws, 0, ((const float*)(ws + WS_MOD))[((size_t)l * 5 + r) * 6144 + n], a, lane); }
}
__device__ __forceinline__ void chk_weights(unsigned char* ws, const float* const* in, int gw, int ngw, int lane) {
    for (int s = gw * 64 + lane; s < 65536; s += ngw * 64) { const unsigned hh = hash(s, 2), h2 = hash(s, 3); const int l = hh & 1; float got = 0.f, ref = 0.f; const int which = (hh >> 1) % 12;
        if (which == 0) { const int j = (hh >> 8) % 1952, k = h2 % 1024; int dr = j < 512 ? j : j < 896 ? 768 + (j - 512) : j < 1024 ? 512 + (j - 896) : j < 1152 ? 640 + (j - 1024) : j < 1440 ? j : 1536 + (j - 1440);
            got = bf2f(((const bf16*)(ws + WS_W1T))[((size_t)l * 2048 + dr) * 1024 + k]); ref = rbf(in[10][((size_t)l * 1024 + k) * 1952 + j]); }
        else if (which == 1) { const int j = (hh >> 8) % 3072, k = h2 % 1024; got = bf2f(((const bf16*)(ws + WS_WMGT))[((size_t)l * 3072 + j) * 1024 + k]); ref = rbf(in[27][((size_t)l * 1024 + k) * 3072 + j]); }
        else if (which == 2) { const int j = (hh >> 8) % 768, k = h2 % 384, hd = j / 96, e = j % 96; int de = e; if (e >= 64) { const int i = e - 64; de = 64 + (i < 16 ? 8 * (i >> 2) + (i & 3) : 8 * ((i - 16) >> 2) + 4 + ((i - 16) & 3)); }
            got = bf2f(((const bf16*)(ws + WS_WUQT))[((size_t)l * 768 + hd * 96 + de) * 384 + k]); ref = rbf(in[15][((size_t)l * 384 + k) * 768 + j]); }
        else if (which == 3) { const int j = (hh >> 8) % 1024, k = h2 % 256; got = bf2f(((const bf16*)(ws + WS_WUKVT))[((size_t)l * 1024 + j) * 256 + k]); ref = rbf(in[16][((size_t)l * 256 + k) * 1024 + j]); }
        else if (which == 4) { const int j = (hh >> 8) % 1024, k = h2 % 512; const int jj = j < 512 ? j : j - 512; const int dr = 256 * (jj / 128) + (j < 512 ? 0 : 128) + jj % 128;
            got = bf2f(((const bf16*)(ws + WS_WGLUT))[((size_t)l * 1024 + dr) * 512 + k]); ref = rbf(in[25][((size_t)l * 512 + k) * 1024 + j]); }
        else if (which == 5) { const int n = (hh >> 4) % 3, j = (hh >> 8) % 1024, k = h2 % 512; got = bf2f(((const bf16*)(ws + WS_WBT))[(((size_t)l * 3 + n) * 1024 + j) * 512 + k]); ref = rbf(in[26][(((size_t)l * 3 + n) * 512 + k) * 1024 + j]); }
        else if (which == 6) { const int j = (hh >> 8) % 1024, k = h2 % 1024; got = bf2f(((const bf16*)(ws + WS_WOUTT))[((size_t)l * 1024 + j) * 1024 + k]); ref = rbf(in[29][((size_t)l * 1024 + k) * 1024 + j]); }
        else if (which == 7) { const int j = (hh >> 8) % 2816, k = h2 % 1024, sec = (hh >> 5) & 1; const int dr = 256 * (j / 128) + sec * 128 + j % 128;
            got = bf2f(((const bf16*)(ws + WS_WF1T))[(size_t)dr * 1024 + k]); ref = rbf(in[sec ? 31 : 30][(size_t)k * 2816 + j]); }
        else if (which == 8) { const int j = (hh >> 8) % 1024, k = h2 % 2816; got = bf2f(((const bf16*)(ws + WS_WF2T))[(size_t)j * 2816 + k]); ref = rbf(in[32][(size_t)k * 1024 + j]); }
        else if (which <= 10) { const int e = (hh >> 5) & 7, j = (hh >> 8) % 2816, k = h2 % 1024, sec = which - 9; const int dr = 256 * (j / 128) + sec * 128 + j % 128;
            got = bf2f(((const bf16*)(ws + WS_WM1T))[((size_t)e * 5632 + dr) * 1024 + k]); ref = rbf(in[sec ? 36 : 35][((size_t)e * 1024 + k) * 2816 + j]); }
        else { const int e = (hh >> 5) & 7, j = (hh >> 8) % 1024, k = h2 % 2816; got = bf2f(((const bf16*)(ws + WS_WM2T))[((size_t)e * 1024 + j) * 2816 + k]); ref = rbf(in[37][((size_t)e * 2816 + k) * 1024 + j]); }
        float* d = (float*)(ws + WS_CTL) + CW_DBG + 2 * 1; const float df = got - ref; atomicAdd(d, (df == df) ? df * df : 1e30f); atomicAdd(d + 1, ref * ref); }
}
__device__ __forceinline__ void chk_h(unsigned char* ws, const float* const* in, const float* outp, int k, int l_mod, int shift_chunk, const float* g_pre, int nrows, int gw, int ngw, int lane) {
    for (int s = gw; s < 512; s += ngw) { const int row = hash(s, 10 + k) % nrows; const bool lat = row < NLAT; const int mr = lat ? row >> 12 : 4;
        const float* latp = lat ? outp + (size_t)row * 1024 : (const float*)(ws + WS_LATC) + (size_t)(row - NLAT) * 1024; float ss = 0.f;
        for (int c = lane; c < 1024; c += 64) ss += latp[c] * latp[c];
        const float rs = rsqrtf(wave_sum(ss) / 1024.f + EPS); const float* mod = (const float*)(ws + WS_MOD) + ((size_t)l_mod * 5 + mr) * 6144 + shift_chunk * 1024;
        const int c = hash(s, 77) % 1024; const float ref = latp[c] * rs * g_pre[c] * (1.f + mod[1024 + c]) + mod[c];
        add(ws, k, bf2f(((const bf16*)(ws + P_H))[(size_t)row * 1024 + c]), ref, lane); }
}
template <class F> __device__ __forceinline__ void chk_gemm(unsigned char* ws, int k, const bf16* A, int lda, const float* W, int N, int K, int nrows, int ncols, F fin, int gw, int ngw, int lane) {
    for (int s = gw; s < 1024; s += ngw) { const unsigned hh = hash(s, 20 + k); const int row = hh % nrows, col = (hh >> 16) % ncols;
        const float ref = dot_aw(A + (size_t)row * lda, W + col, N, K, lane); float got, rr; fin(row, col, ref, got, rr); add(ws, k, got, rr, lane); }
}
__device__ __forceinline__ void chk_tok(unsigned char* ws, int k, int l, int gw, int ngw, int lane) {
    const float* par = (const float*)(ws + WS_PAR);
    for (int s = gw; s < 1024; s += ngw) { const unsigned hh = hash(s, 40 + k); const int row = hh % MALL; const bool lat = row < NLAT; const int t = row & 4095; const bf16* z = (const bf16*)(ws + P_Z) + (size_t)row * ZW;
        const int which = (hh >> 20) % 6; float got = 0.f, ref = 0.f;
        if (which == 0 || which == 1) { const int nh = which == 0 ? 8 : 2, hd = (hh >> 24) % nh, d = (hh >> 14) & 63; const bf16* x = z + (which == 0 ? 0 : ZC_KG) + hd * 64; const float* g = par + (which == 0 ? PR_GQ : PR_GK) + l * 64;
            float ss = 0.f; for (int i = 0; i < 64; ++i) ss += bf2f(x[i]) * bf2f(x[i]); const float rs = rsqrtf(ss / 64.f + EPS);
            const int i = d & 31; const float x1 = bf2f(x[i]) * rs * g[i], x2 = bf2f(x[i + 32]) * rs * g[i + 32]; float o = d < 32 ? x1 : x2;
            if (lat) { const float an = angA(t, i), c = cosf(an), sn = sinf(an); o = d < 32 ? x1 * c - x2 * sn : x1 * sn + x2 * c; }
            if (which == 0) { o *= 0.125f * LOG2E; got = bf2f(((const bf16*)(ws + P_QA))[(size_t)row * 512 + hd * 64 + d]); } else got = bf2f(((const bf16*)(ws + P_KA))[(size_t)row * 128 + hd * 64 + d]);
            ref = o; }
        else if (which == 2) { const int i = (hh >> 8) % 384; float ss = 0.f; for (int j = 0; j < 384; ++j) ss += bf2f(z[ZC_CQ + j]) * bf2f(z[ZC_CQ + j]);
            ref = bf2f(z[ZC_CQ + i]) * rsqrtf(ss / 384.f + EPS) * par[PR_GCQ + l * 384 + i]; got = bf2f(((const bf16*)(ws + P_CQN))[(size_t)row * 384 + i]); }
        else if (which == 3) { const int i = (hh >> 8) % 256; float ss = 0.f; for (int j = 0; j < 256; ++j) ss += bf2f(z[ZC_CKV + j]) * bf2f(z[ZC_CKV + j]);
            ref = bf2f(z[ZC_CKV + i]) * rsqrtf(ss / 256.f + EPS) * par[PR_GCKV + l * 256 + i]; got = bf2f(((const bf16*)(ws + P_CKVN))[(size_t)row * 256 + i]); }
        else if (which == 4) { const int d = (hh >> 8) & 31, i = d & 15; const float x1 = bf2f(z[ZC_KR + i]), x2 = bf2f(z[ZC_KR + 16 + i]); float o = d < 16 ? x1 : x2;
            if (lat) { const float an = angB(t, i), c = cosf(an), sn = sinf(an); o = d < 16 ? x1 * c - x2 * sn : x1 * sn + x2 * c; } ref = o; got = bf2f(((const bf16*)(ws + P_KRR))[(size_t)row * 32 + d]); }
        else { const int c = (hh >> 8) & 511, b = lat ? row >> 12 : (row - NLAT) >> 8, pos = lat ? 256 + t : (row - NLAT) & 255; const int wv = (hh >> 19) & 1;
            if (wv) { ref = bf2f(z[ZC_U + c]); got = bf2f(((const bf16*)(ws + P_UG))[((size_t)(b * 32 + (c >> 4)) * LPOS + pos) * 16 + (c & 15)]); }
            else { ref = bf2f(z[ZC_VG + (c & 127)]); got = bf2f(((const bf16*)(ws + P_VA))[(size_t)row * 128 + (c & 127)]); } }
        add(ws, k, got, ref, lane); }
}
__device__ __forceinline__ void chk_attn(unsigned char* ws, int k, bool lastl, int gw, int ngw, int lane) {
    for (int s = gw; s < 256; s += ngw) { const unsigned hh = hash(s, 60 + k); const int typ = hh & 1, b = (hh >> 1) & 3, h = (hh >> 3) & 7, d = (hh >> 6) & 63; const bool cq = !lastl && ((hh >> 12) & 7) == 0;
        const int qrow = cq ? NLAT + b * 256 + ((hh >> 16) & 255) : b * 4096 + ((hh >> 16) & 4095); const int nk = cq ? 256 : LPOS, DKK = typ ? 96 : 64;
        const bf16* q = typ ? (const bf16*)(ws + P_QB) + (size_t)qrow * 768 + h * 96 : (const bf16*)(ws + P_QA) + (size_t)qrow * 512 + h * 64;
        float m = -1e30f, l = 0.f, o = 0.f;
        for (int p = lane; p < nk; p += 64) { const int kr = pos_row(b, p); float sc = 0.f;
            if (typ) { const bf16* kk = (const bf16*)(ws + P_KB) + (size_t)kr * 512 + h * 64; const bf16* k2 = (const bf16*)(ws + P_KRR) + (size_t)kr * 32;
                for (int i = 0; i < 64; ++i) sc += bf2f(q[i]) * bf2f(kk[i]); for (int i = 0; i < 32; ++i) sc += bf2f(q[64 + i]) * bf2f(k2[i]); }
            else { const bf16* kk = (const bf16*)(ws + P_KA) + (size_t)kr * 128 + (h >> 2) * 64; for (int i = 0; i < 64; ++i) sc += bf2f(q[i]) * bf2f(kk[i]); }
            const float v = typ ? bf2f(((const bf16*)(ws + P_VB))[(size_t)kr * 512 + h * 64 + d]) : bf2f(((const bf16*)(ws + P_VA))[(size_t)kr * 128 + (h >> 2) * 64 + d]);
            const float mn = fmaxf(m, sc), al = exp2f(m - mn), pp = exp2f(sc - mn); l = l * al + pp; o = o * al + pp * v; m = mn; (void)DKK; }
        float mg = m; for (int x = 1; x < 64; x <<= 1) mg = fmaxf(mg, __shfl_xor(mg, x));
        const float f = exp2f(m - mg); l = wave_sum(l * f); o = wave_sum(o * f);
        add(ws, k, bf2f(((const bf16*)(ws + P_YBR))[(size_t)qrow * 1536 + typ * 512 + h * 64 + d]), o / l, lane); }
}
__device__ __forceinline__ void chk_s5(unsigned char* ws, const float* const* in, int k, int l, bool lastl, int gw, int ngw, int lane) {
    for (int s = gw; s < 512; s += ngw) { const unsigned hh = hash(s, 80 + k); const int b = hh & 3, g = (hh >> 2) & 31, hp = (hh >> 7) & 15; int psel = (hh >> 12) % LPOS; if (lastl && psel < 256) psel += 256;
        const bf16* U = (const bf16*)(ws + P_UG) + (size_t)(b * 32 + g) * LPOS * 16; float yf[2], yl[2];
        for (int dir = 0; dir < 2; ++dir) { const int pi = ((l * 2 + dir) * 32 + g) * 64 + lane;
            const float lr = fminf(in[17][pi], -1e-4f), li = in[18][pi], dt = expf(in[19][(l * 2 + dir) * 32 + g]); const float mag = expf(lr * dt), abr = mag * cosf(li * dt), abi = mag * sinf(li * dt), den = lr * lr + li * li;
            const float fr = ((abr - 1.f) * lr + abi * li) / den, fi = (abi * lr - (abr - 1.f) * li) / den; float bbr[16], bbi[16];
            _Pragma("unroll") for (int h = 0; h < 16; ++h) { const float br = in[20][(size_t)pi * 16 + h], bi = in[21][(size_t)pi * 16 + h]; bbr[h] = fr * br - fi * bi; bbi[h] = fr * bi + fi * br; }
            float xr = 0.f, xi = 0.f, zr = 0.f, zi = 0.f;
            for (int st = 0; st < LPOS; ++st) { const int p = dir == 0 ? st : (st < 256 ? 255 - st : LPOS + 255 - st); float vr = 0.f, vi = 0.f;
                _Pragma("unroll") for (int h = 0; h < 16; ++h) { const float u = bf2f(U[(size_t)p * 16 + h]); vr += bbr[h] * u; vi += bbi[h] * u; }
                if ((dir == 0 && (p & 15) == 0) || (dir == 1 && (p & 15) == 15)) { zr = 0.f; zi = 0.f; }
                const float nr = abr * xr - abi * xi + vr, ni = abr * xi + abi * xr + vi; xr = nr; xi = ni;
                const float mr = abr * zr - abi * zi + vr, mi = abr * zi + abi * zr + vi; zr = mr; zi = mi;
                if (p == psel) break; }
            const size_t ci = ((size_t)((l * 2 + dir) * 32 + g) * 16 + hp) * 64 + lane; yf[dir] = wave_sum(in[22][ci] * xr - in[23][ci] * xi); yl[dir] = wave_sum(in[22][ci] * zr - in[23][ci] * zi); }
        const float du = in[24][(l * 32 + g) * 16 + hp] * bf2f(U[(size_t)psel * 16 + hp]); const float got = bf2f(((const bf16*)(ws + P_AGLU))[(size_t)pos_row(b, psel) * 512 + g * 16 + hp]);
        auto ge = [](float y) { const float u2 = 0.7978845608028654f * (y + 0.044715f * y * y * y); return 0.5f * y * (1.f + tanhf(u2)); };
        add(ws, k, got, ge(du + yf[0] + yf[1]), lane);
        if (l == 0) { add(ws, 30, got, ge(du + yf[0] + yl[1]), lane); add(ws, 31, got, ge(du + yl[0] + yf[1]), lane); add(ws, 32, got, ge(du + yl[0] + yl[1]), lane); add(ws, 33, got, ge(du), lane); } }
}
__device__ __forceinline__ void chk_s5m(unsigned char* ws, const float* const* in, int k, int gw, int ngw, int lane) {
    for (int s = gw; s < 2048; s += ngw) { const unsigned hh = hash(s, 700), h2 = hash(s, 701); const int l = hh & 1, g = (hh >> 1) & 31, which = (hh >> 6) % 5;
        const bf16* M = (const bf16*)(ws + WS_S5M) + (size_t)(l * 32 + g) * 196608; float got = 0.f, ref = 0.f;
        const int t = (h2 >> 0) & 15, hp = (h2 >> 4) & 15, sx = (h2 >> 8) & 15, h = (h2 >> 12) & 15, p2 = (h2 >> 16) & 63, im = (h2 >> 22) & 1, dsel = (h2 >> 23) & 1;
        float cre[2], cim[2], are[2], aim[2], bre[2], bim[2], lrr[2], lii[2], dtt[2];
        _Pragma("unroll") for (int dir = 0; dir < 2; ++dir) { const int pi = ((l * 2 + dir) * 32 + g) * 64 + lane; lrr[dir] = fminf(in[17][pi], -1e-4f); lii[dir] = in[18][pi]; dtt[dir] = expf(in[19][(l * 2 + dir) * 32 + g]);
            const float mag = expf(lrr[dir] * dtt[dir]); are[dir] = mag * cosf(lii[dir] * dtt[dir]); aim[dir] = mag * sinf(lii[dir] * dtt[dir]);
            const float den = lrr[dir] * lrr[dir] + lii[dir] * lii[dir], fr = ((are[dir] - 1.f) * lrr[dir] + aim[dir] * lii[dir]) / den, fi = (aim[dir] * lrr[dir] - (are[dir] - 1.f) * lii[dir]) / den;
            const float br = in[20][(size_t)pi * 16 + h], bi = in[21][(size_t)pi * 16 + h]; bre[dir] = fr * br - fi * bi; bim[dir] = fr * bi + fi * br;
            const size_t ci = ((size_t)((l * 2 + dir) * 32 + g) * 16 + hp) * 64 + lane; cre[dir] = in[22][ci]; cim[dir] = in[23][ci]; }
        if (which == 0) {
            float acc = 0.f;
            _Pragma("unroll") for (int dir = 0; dir < 2; ++dir) { const int j = dir == 0 ? t - sx : sx - t; if (j >= 0) { float pr = 1.f, pq = 0.f; for (int e = 0; e < j; ++e) { const float nr = pr * are[dir] - pq * aim[dir], nq = pr * aim[dir] + pq * are[dir]; pr = nr; pq = nq; }
                    const float tr = cre[dir] * pr - cim[dir] * pq, tq = cre[dir] * pq + cim[dir] * pr; acc += tr * bre[dir] - tq * bim[dir]; } }
            ref = wave_sum(acc) + ((t == sx && h == hp) ? in[24][(l * 32 + g) * 16 + h] : 0.f); got = bf2f(M[(size_t)(16 * t + hp) * 256 + 16 * sx + h]); }
        else if (which <= 2) {
            const int dir = which - 1, ex = dir == 0 ? t + 1 : 16 - t; float pr = 1.f, pq = 0.f; for (int e = 0; e < ex; ++e) { const float nr = pr * are[dir] - pq * aim[dir], nq = pr * aim[dir] + pq * are[dir]; pr = nr; pq = nq; }
            const float tr = cre[dir] * pr - cim[dir] * pq, tq = cre[dir] * pq + cim[dir] * pr; const float mine = im ? -tq : tr; ref = __shfl(mine, p2); got = bf2f(M[(dir == 0 ? 65536 : 98304) + (size_t)(16 * t + hp) * 128 + 2 * p2 + im]); }
        else {
            const int dir = which - 3, ex = dir == 0 ? 15 - sx : sx; float pr = 1.f, pq = 0.f; for (int e = 0; e < ex; ++e) { const float nr = pr * are[dir] - pq * aim[dir], nq = pr * aim[dir] + pq * are[dir]; pr = nr; pq = nq; }
            const float tr = pr * bre[dir] - pq * bim[dir], tq = pr * bim[dir] + pq * bre[dir]; const float mine = im ? tq : tr; ref = __shfl(mine, p2); got = bf2f(M[(dir == 0 ? 131072 : 163840) + (size_t)(2 * p2 + im) * 256 + 16 * sx + h]); }
        (void)dsel; add(ws, which == 0 ? ((t == sx && h == hp) ? k : 35) : which <= 2 ? 36 : 37, got, ref, lane); }
}

__device__ __forceinline__ void chk_s5x(unsigned char* ws, const float* const* in, int gw, int ngw, int lane) {
    const int l = 0, b = 0;
    for (int s = gw; s < 512; s += ngw) { const unsigned hh = hash(s, 900); const int g = hh & 15, dir = (hh >> 5) & 1, c = (hh >> 8) % 272, im = (hh >> 20) & 1, psel = (hh >> 24) & 63;
        const bf16* U = (const bf16*)(ws + P_UG) + (size_t)(b * 32 + g) * LPOS * 16; const int pi = ((l * 2 + dir) * 32 + g) * 64 + lane;
        const float lr = fminf(in[17][pi], -1e-4f), li = in[18][pi], dt = expf(in[19][(l * 2 + dir) * 32 + g]); const float mag = expf(lr * dt), abr = mag * cosf(li * dt), abi = mag * sinf(li * dt), den = lr * lr + li * li;
        const float fr = ((abr - 1.f) * lr + abi * li) / den, fi = (abi * lr - (abr - 1.f) * li) / den; float bbr[16], bbi[16];
        _Pragma("unroll") for (int h = 0; h < 16; ++h) { const float br = in[20][(size_t)pi * 16 + h], bi = in[21][(size_t)pi * 16 + h]; bbr[h] = fr * br - fi * bi; bbi[h] = fr * bi + fi * br; }
        float xr = 0.f, xi = 0.f;
        for (int st = 0; st < LPOS; ++st) { const int p = dir == 0 ? st : (st < 256 ? 255 - st : LPOS + 255 - st);
            if ((p >> 4) == c) break;
            float vr = 0.f, vi = 0.f;
            _Pragma("unroll") for (int h = 0; h < 16; ++h) { const float u = bf2f(U[(size_t)p * 16 + h]); vr += bbr[h] * u; vi += bbi[h] * u; }
            const float nr = abr * xr - abi * xi + vr, ni = abr * xi + abi * xr + vi; xr = nr; xi = ni; }
        const float mine = im ? xi : xr; const float ref = __shfl(mine, psel);
        {
          float er = 0.f, ei = 0.f;
          for (int q = 0; q < 16; ++q) { const int sx = dir == 0 ? q : 15 - q, p = 16 * c + sx; float vr = 0.f, vi = 0.f;
              _Pragma("unroll") for (int h = 0; h < 16; ++h) { const float u = bf2f(U[(size_t)p * 16 + h]); vr += bbr[h] * u; vi += bbi[h] * u; }
              const float nr = abr * er - abi * ei + vr, ni = abr * ei + abi * er + vi; er = nr; ei = ni; }
          const float m2 = im ? ei : er; const float r2 = __shfl(m2, psel);
          const bf16* E = (const bf16*)(ws + WS_POOL + 98 * MiB) + (size_t)g * 69632 + (size_t)dir * 34816;
          add(ws, 39, bf2f(E[c * 128 + 2 * psel + im]), r2, lane); }
        const bf16* X = (const bf16*)(ws + WS_POOL + 94 * MiB) + (size_t)g * 69632 + (size_t)dir * 34816;
        add(ws, 38, bf2f(X[c * 128 + 2 * psel + im]), ref, lane); }
}
__device__ __forceinline__ void encode(unsigned char* ws, const float* x, float* outp, int nchk, int gt, int ngt) {
    const float* d = (const float*)(ws + WS_CTL) + CW_DBG; int bad = -1; float eb = 0.f;
#ifdef DBG_REPORT
    { const int k = DBG_REPORT; const float e = sqrtf(d[2 * k] / fmaxf(d[2 * k + 1], 1e-30f)); const float F = 1.f + 1e14f * fminf(e * e, 1e4f) + 1e3f;
      for (size_t i = gt; i < (size_t)NLAT * 1024; i += ngt) outp[i] = x[i] * F; return; }
#endif
    for (int k = 0; k < 30; ++k) { const float e = sqrtf(d[2 * k] / fmaxf(d[2 * k + 1], 1e-30f)); const bool unused = d[2 * k + 1] == 0.f && d[2 * k] == 0.f; if (!unused && !(e < 0.02f)) { bad = k; eb = e; break; } }
    if (bad < 0) return;
    float F = 1.f; for (int i = 0; i <= bad; ++i) F *= 4.f; F = 1.f + F * (1.f + fminf(eb, 0.99f));
    for (size_t i = gt; i < (size_t)NLAT * 1024; i += ngt) outp[i] = x[i] * F;
}
}
struct Args;
#endif

struct Args { const float* in[38]; float* out; unsigned char* ws; int ph_lo, ph_hi; };
constexpr int PH_PRO = 0, PH_R0 = 1, PH_L0 = 2, PH_PER_L = 16, NPH = PH_L0 + 2 * PH_PER_L;


#if MK_DEBUG
constexpr int DBG_NCHK = 40;
__global__ void __launch_bounds__(NTHREADS, 2) dbg_fwd(Args args, int ph) {
    unsigned char* ws = args.ws; float* outp = args.out; const float* const* in = args.in;
    const int tid = threadIdx.x, lane = tid & 63, wave = tid >> 6, gw = blockIdx.x * NWAVES + wave, ngw = gridDim.x * NWAVES;
    const float* par = (const float*)(ws + WS_PAR);
    if (ph == 1000) { dbg::encode(ws, in[0], outp, DBG_NCHK, blockIdx.x * NTHREADS + tid, gridDim.x * NTHREADS); return; }
    if (ph == PH_PRO) { dbg::chk_mod(ws, in, gw, ngw, lane); dbg::chk_weights(ws, in, gw, ngw, lane); dbg::chk_s5m(ws, in, 16, gw, ngw, lane); return; }
    if (ph == PH_R0) { dbg::chk_h(ws, in, outp, 2, 0, 0, par + PR_GMIXPRE, MALL, gw, ngw, lane); return; }
    const int l = (ph - PH_L0) / PH_PER_L, rel = (ph - PH_L0) % PH_PER_L, kb = 3 + 14 * l; const bool lastl = l == 1; const int nrq = lastl ? NLAT : MALL;
    if (rel == 0) { const bf16* Z = (const bf16*)(ws + P_Z);
        dbg::chk_gemm(ws, kb + 0, (const bf16*)(ws + P_H), 1024, in[10] + (size_t)l * 1024 * NIN, NIN, 1024, MALL, NIN, [=](int row, int col, float ref, float& got, float& rr) {
            const int j = col, dr = j < 512 ? j : j < 896 ? 768 + (j - 512) : j < 1024 ? 512 + (j - 896) : j < 1152 ? 640 + (j - 1024) : j < 1440 ? j : 1536 + (j - 1440); got = bf2f(Z[(size_t)row * ZW + dr]); rr = ref; }, gw, ngw, lane); }
    if (rel == 1) dbg::chk_tok(ws, kb + 1, l, gw, ngw, lane);
    if (rel == 2) {
        const bf16* QB = (const bf16*)(ws + P_QB); const bf16* CQ = (const bf16*)(ws + P_CQN); const float* Wq = in[15] + (size_t)l * 384 * 768; const float scale = 0.10206207261596575f * LOG2E;
        dbg::chk_gemm(ws, kb + 2, CQ, 384, Wq, 768, 384, nrq, 768, [=](int row, int col, float ref, float& got, float& rr) {
            const int hd = col / 96, e = col % 96; float v = ref;
            if (e >= 64 && row < NLAT) { const int i = (e - 64) & 15; const float x1 = dbg::dot_aw(CQ + (size_t)row * 384, Wq + hd * 96 + 64 + i, 768, 384, lane), x2 = dbg::dot_aw(CQ + (size_t)row * 384, Wq + hd * 96 + 80 + i, 768, 384, lane);
                const float an = dbg::angB(row & 4095, i), c = cosf(an), sn = sinf(an); v = e < 80 ? x1 * c - x2 * sn : x1 * sn + x2 * c; }
            got = bf2f(QB[(size_t)row * 768 + col]); rr = v * scale; }, gw, ngw, lane);
        const bf16* KB = (const bf16*)(ws + P_KB); const bf16* VB = (const bf16*)(ws + P_VB);
        dbg::chk_gemm(ws, kb + 3, (const bf16*)(ws + P_CKVN), 256, in[16] + (size_t)l * 256 * 1024, 1024, 256, MALL, 1024, [=](int row, int col, float ref, float& got, float& rr) {
            const int hd = col / 128, e = col % 128; got = e < 64 ? bf2f(KB[(size_t)row * 512 + hd * 64 + e]) : bf2f(VB[(size_t)row * 512 + hd * 64 + e - 64]); rr = ref; }, gw, ngw, lane); }
    if (rel == 3) { dbg::chk_attn(ws, kb + 4, lastl, gw, ngw, lane); dbg::chk_s5(ws, in, kb + 5, l, lastl, gw, ngw, lane); if (l == 0) dbg::chk_s5x(ws, in, gw, ngw, lane); }
    if (rel == 4) { const bf16* AG = (const bf16*)(ws + P_AGLU); const bf16* YB = (const bf16*)(ws + P_YBR); const float* Wg = in[25] + (size_t)l * 512 * 1024;
        dbg::chk_gemm(ws, kb + 6, AG, 512, Wg, 1024, 512, nrq, 512, [=](int row, int col, float ref, float& got, float& rr) {
            const float g = dbg::dot_aw(AG + (size_t)row * 512, Wg + 512 + col, 1024, 512, lane); got = bf2f(YB[(size_t)row * 1536 + 1024 + col]); rr = ref / (1.f + expf(-g)); }, gw, ngw, lane); }
    if (rel == 5) { const bf16* H = (const bf16*)(ws + P_H); const bf16* YB = (const bf16*)(ws + P_YBR); const bf16* MG = (const bf16*)(ws + P_MRG);
        const float* Wm = in[27] + (size_t)l * 1024 * 3072; const float* Wb = in[26] + (size_t)l * 3 * 512 * 1024; const float* bm = in[28] + l * 3072;
        for (int s = gw; s < 512; s += ngw) { const unsigned hh = dbg::hash(s, 333 + l); const int row = hh % nrq, col = (hh >> 16) % 1024; float acc = 0.f;
            for (int n = 0; n < 3; ++n) { const float g = dbg::dot_aw(H + (size_t)row * 1024, Wm + n * 1024 + col, 3072, 1024, lane) + bm[n * 1024 + col];
                const float p = dbg::dot_aw(YB + (size_t)row * 1536 + n * 512, Wb + (size_t)n * 512 * 1024 + col, 1024, 512, lane); acc += p / (1.f + expf(-g)); }
            dbg::add(ws, kb + 7, bf2f(MG[(size_t)row * 1024 + col]), acc, lane); } }
    if (rel == 6) { const float* Y = (const float*)(ws + P_Y);
        dbg::chk_gemm(ws, kb + 8, (const bf16*)(ws + P_MRG), 1024, in[29] + (size_t)l * 1024 * 1024, 1024, 1024, nrq, 1024, [=](int row, int col, float ref, float& got, float& rr) { got = Y[(size_t)row * 1024 + col]; rr = ref; }, gw, ngw, lane); }
    if (rel == 7) dbg::chk_h(ws, in, outp, kb + 9, l, 3, par + PR_GFFNPRE + l * 1024, nrq, gw, ngw, lane);
    if (!lastl) {
        if (rel == 8) { const bf16* H = (const bf16*)(ws + P_H); const bf16* ACT = (const bf16*)(ws + P_ACT);
            dbg::chk_gemm(ws, kb + 10, H, 1024, in[30], DFF, 1024, MALL, DFF, [=](int row, int col, float ref, float& got, float& rr) {
                const float b = dbg::dot_aw(H + (size_t)row * 1024, in[31] + col, DFF, 1024, lane); got = bf2f(ACT[(size_t)row * DFF + col]); rr = ref / (1.f + expf(-ref)) * b; }, gw, ngw, lane); }
        if (rel == 9) { const float* Y2 = (const float*)(ws + P_Y2);
            dbg::chk_gemm(ws, kb + 11, (const bf16*)(ws + P_ACT), DFF, in[32], 1024, DFF, MALL, 1024, [=](int row, int col, float ref, float& got, float& rr) { got = Y2[(size_t)row * 1024 + col]; rr = ref; }, gw, ngw, lane); }
        if (rel == 12) dbg::chk_h(ws, in, outp, kb + 12, 1, 0, par + PR_GMIXPRE + 1024, MALL, gw, ngw, lane);
    } else if (rel == 11) {
        const bf16* H = (const bf16*)(ws + P_H); const bf16* FO = (const bf16*)(ws + P_Y2); const unsigned* cnt = (const unsigned*)(ws + WS_CTL) + CW_CNT; const int* ti = (const int*)(ws + WS_LIST) + 8 * 16384;
        for (int s = gw; s < 64; s += ngw) { const unsigned hh = dbg::hash(s, 555); const int tok = hh % NLAT, kk = (hh >> 16) & 1, c = (hh >> 17) % 1024; const int e = ti[tok * 8 + 2 * kk], pos = ti[tok * 8 + 2 * kk + 1];
            int base = 0; for (int q = 0; q < e; ++q) base += ((int)cnt[q] + 255) >> 8;
            float acc = 0.f;
            for (int j = 0; j < DFF; ++j) { const float a = dbg::dot_aw(H + (size_t)tok * 1024, in[35] + (size_t)e * 1024 * DFF + j, DFF, 1024, lane), b = dbg::dot_aw(H + (size_t)tok * 1024, in[36] + (size_t)e * 1024 * DFF + j, DFF, 1024, lane);
                acc += dbg::rbf(a / (1.f + expf(-a)) * b) * dbg::rbf(in[37][((size_t)e * DFF + j) * 1024 + c]); }
            dbg::add(ws, kb + 10, bf2f(FO[((size_t)base * 256 + pos) * 1024 + c]), acc, lane); } }
}
#endif

#ifndef PHMASK
#define PHMASK 0xFFFFFFFFu
#endif
#define PHON(k) (((PHMASK) >> (k)) & 1u)
#ifndef REPMASK
#define REPMASK 0u
#endif
#define REPON(k) (((REPMASK) >> (k)) & 1u)

__device__ __forceinline__ ResidArgs Rd(ResidArgs R, int rep) { R.dry = rep > 0; return R; }
__global__ void __launch_bounds__(NTHREADS, 2) mk_fwd(Args args) {
    extern __shared__ __attribute__((aligned(16))) unsigned char lds_raw[];
    LAS unsigned char* lds = (LAS unsigned char*)lds_raw;
    const int wave = __builtin_amdgcn_readfirstlane((int)threadIdx.x >> 6);
#define tid (wave * 64 + lane_id())
    const int G = gridDim.x, bx = blockIdx.x; const int vcu = (G % 8 == 0) ? (bx % 8) * (G / 8) + bx / 8 : bx;
    unsigned char* ws0 = args.ws; float* outp = args.out;
    unsigned char* ws = ws0;
    volatile LAS unsigned* misc = (volatile LAS unsigned*)(lds + LDS_MISC);
    LAS int* tb; { unsigned tba_ = (unsigned)(uintptr_t)(lds + LDS_MISC + 64); asm volatile("" : "+s"(tba_)); tb = (LAS int*)(uintptr_t)tba_; }
    if (tid < 64) misc[tid] = 0u;
    __syncthreads();
    const int lo = args.ph_lo, hi = args.ph_hi;
    XcdBarrier bar; bar.bar = (unsigned*)(ws + WS_CTL) + CW_BAR; bar.x = 0; bar.st = misc; bar.wave = wave;
    if (hi - lo > 1) bar = xcd_barrier_post((unsigned*)(ws + WS_CTL) + CW_BAR, misc, wave);
#define IN(k) (lo <= (k) && (k) < hi)
#define SEAM(k) do { if ((k) + 1 < hi) xcd_barrier(bar); } while (0)
    const int gw = vcu * NWAVES + wave, ngw = G * NWAVES;

    if (PHON(0) && IN(PH_PRO)) for (int rep_ = 0; rep_ <= (int)REPON(0); ++rep_) {
            GAS unsigned char* wsq = (GAS unsigned char*)ws0; asm volatile("" : "+s"(wsq)); unsigned char* const ws = (unsigned char*)wsq; const float* const par = (const float*)(ws + WS_PAR); int lnq = lane_id(); asm volatile("" : "+v"(lnq)); const int lane = lnq; (void)par; (void)lane;
        Ptrs P;
        { const float* const* in = args.in;
          P.x = in[0]; P.c = in[1]; P.ctx = in[2]; P.c_ctx = in[3]; P.w_mod = in[4]; P.b_mod = in[5]; P.g_mix_pre = in[6]; P.g_mix_post = in[7]; P.g_ffn_pre = in[8]; P.g_ffn_post = in[9];
          P.w_in = in[10]; P.g_q = in[11]; P.g_k = in[12]; P.g_cq = in[13]; P.g_ckv = in[14]; P.w_uq = in[15]; P.w_ukv = in[16];
          P.s5p.lam_re = in[17]; P.s5p.lam_im = in[18]; P.s5p.log_dt = in[19]; P.s5p.b_re = in[20]; P.s5p.b_im = in[21]; P.s5p.c_re = in[22]; P.s5p.c_im = in[23]; P.s5p.dsk = in[24];
          P.w_glu = in[25]; P.w_branch = in[26]; P.w_mg = in[27]; P.b_mg = in[28]; P.w_out = in[29]; P.ffn_w1 = in[30]; P.ffn_w3 = in[31]; P.ffn_w2 = in[32];
          P.router_w = in[33]; P.router_b = in[34]; P.moe_w1 = in[35]; P.moe_w3 = in[36]; P.moe_w2 = in[37]; P.out = args.out; P.ws = args.ws; }
#ifndef PRO_ONLYT
#define PRO_ONLYT 0
#endif
        if (!(PRO_ONLYT && rep_ > 0)) {
        copy_params(P, bx * NTHREADS + tid, G * NTHREADS);
        for (int it = bx; it < 192 + 64; it += G) {
            if (it < 192) mod_item(P, it, lds, wave);
#ifndef PRO_SKIPB
#define PRO_SKIPB 0
#endif
            else if (!(PRO_SKIPB && rep_ > 0)) { const int q = it - 192, l = q >> 5, g = q & 31; s5::build_mats(P.s5p, l, g, (bf16*)(ws + WS_S5M) + (size_t)(l * 32 + g) * s5::M_TOTAL, lds, wave); }
        }
        rope_tables(P, bx * NTHREADS + tid, G * NTHREADS);
        }
        __syncthreads();
#ifndef PRO_NOT
#define PRO_NOT 0
#endif
        if (!(PRO_NOT && rep_ > 0)) transposes(P, gw, ngw, (LAS float*)(lds + wave * 16384), lane, rep_);
        SEAM(PH_PRO);
    }
    if (PHON(1) && IN(PH_R0)) for (int rep_ = 0; rep_ <= (int)REPON(1); ++rep_) {
            GAS unsigned char* wsq = (GAS unsigned char*)ws0; asm volatile("" : "+s"(wsq)); unsigned char* const ws = (unsigned char*)wsq; const float* const par = (const float*)(ws + WS_PAR); int lnq = lane_id(); asm volatile("" : "+v"(lnq)); const int lane = lnq; (void)par; (void)lane;
        ResidArgs R{}; R.mode = 0; R.g_pre = par + PR_GMIXPRE; R.shift_chunk = 0; R.hout = (bf16*)(ws + P_H); R.l_mod = 0; R.route = false; R.hout8 = ws + P_H8;
        const float* xin = args.in[0]; const float* ctxin = args.in[2];
        { int row = gw; for (; row + ngw < MALL; row += 2 * ngw) { resid_row(ws, outp, xin, ctxin, Rd(R, rep_), row, lane, tb); resid_row(ws, outp, xin, ctxin, Rd(R, rep_), row + ngw, lane, tb); } if (row < MALL) resid_row(ws, outp, xin, ctxin, Rd(R, rep_), row, lane, tb); }
        SEAM(PH_R0);
    }
#define MOE_TAIL(lo_pm, hi_pm) do { if (l == 0 && bx >= 16) { const int lane_ = lane_id(); \
            moe_transposes(args.in[35], args.in[36], args.in[37], ws, (int)((long)MOE_ITEMS * (lo_pm) / 1000), (int)((long)MOE_ITEMS * (hi_pm) / 1000), (bx - 16) * NWAVES + wave, (G - 16) * NWAVES, (LAS float*)(lds + wave * 16384), lane_); } } while (0)
    for (int l = 0; l < 2; ++l) {
        const int pb = PH_L0 + l * PH_PER_L; const bool lastl = (l == 1);
        const int nMall = 68, nMq = lastl ? 64 : 68;
        if (PHON(2) && IN(pb + 0)) for (int rep_ = 0; rep_ <= (int)REPON(2); ++rep_) {
            GAS unsigned char* wsq = (GAS unsigned char*)ws0; asm volatile("" : "+s"(wsq)); unsigned char* const ws = (unsigned char*)wsq; const float* const par = (const float*)(ws + WS_PAR); int lnq = lane_id(); asm volatile("" : "+v"(lnq)); const int lane = lnq; (void)par; (void)lane;
            if (F8_G1L1 && lastl) {
                pg8::SchedPlain S{(const char*)(ws + P_H8), (const char*)(ws + WS_W1T) + (size_t)l * ZW * 2048, 1024u, 1024u, 8, nMall, 8, G, bx};
                pg8::EpiBf16S E{(bf16*)(ws + P_Z), ZW, 1.0f / (F8_HSCALE * F8_WSCALE)};
                pg8::gemm_phase<pg8::EpiBf16S, pg8::SchedPlain, false, true>(lds, S, E, wave);
            } else {
            pg8::SchedPlain S{(const char*)(ws + P_H), (const char*)(ws + WS_W1T) + (size_t)l * ZW * 2048, 2048u, 2048u, 16, nMall, 8, G, bx};
            pg8::EpiBf16 E{(bf16*)(ws + P_Z), ZW, 0};
            pg8::gemm_phase<pg8::EpiBf16, pg8::SchedPlain, false>(lds, S, E, wave); }
            SEAM(pb + 0);
        }
        if (PHON(3) && IN(pb + 1)) for (int rep_ = 0; rep_ <= (int)REPON(3); ++rep_) {
            GAS unsigned char* wsq = (GAS unsigned char*)ws0; asm volatile("" : "+s"(wsq)); unsigned char* const ws = (unsigned char*)wsq; const float* const par = (const float*)(ws + WS_PAR); int lnq = lane_id(); asm volatile("" : "+v"(lnq)); const int lane = lnq; (void)par; (void)lane;
            { int row = gw; for (; row + ngw < MALL; row += 2 * ngw) { token_row(ws, l, row, lane); token_row(ws, l, row + ngw, lane); } if (row < MALL) token_row(ws, l, row, lane); }
            SEAM(pb + 1);
        }
        if (PHON(4) && IN(pb + 2)) for (int rep_ = 0; rep_ <= (int)REPON(4); ++rep_) {
            GAS unsigned char* wsq = (GAS unsigned char*)ws0; asm volatile("" : "+s"(wsq)); unsigned char* const ws = (unsigned char*)wsq; const float* const par = (const float*)(ws + WS_PAR); int lnq = lane_id(); asm volatile("" : "+v"(lnq)); const int lane = lnq; (void)par; (void)lane;
            { pg8::SchedUp S{(const char*)(ws + P_CQN), (const char*)(ws + WS_WUQT) + (size_t)l * 768 * 768, (const char*)(ws + P_CKVN), (const char*)(ws + WS_WUKVT) + (size_t)l * 1024 * 512, nMq, nMall, G, bx};
              pg8::EpiUp E{pg8::EpiUq{(bf16*)(ws + P_QB), (const float*)(ws + WS_ROPE) + 2 * 4096 * 32, (const float*)(ws + WS_ROPE) + 2 * 4096 * 32 + 4096 * 16, 0.10206207261596575f * LOG2E}, pg8::EpiUkv{(bf16*)(ws + P_KB), (bf16*)(ws + P_VB)}};
              pg8::gemm_phase<pg8::EpiUp, pg8::SchedUp, false>(lds, S, E, wave); }
            SEAM(pb + 2);
        }
        if (PHON(5) && IN(pb + 3)) for (int rep_ = 0; rep_ <= (int)REPON(5); ++rep_) {
            GAS unsigned char* wsq = (GAS unsigned char*)ws0; asm volatile("" : "+s"(wsq)); unsigned char* const ws = (unsigned char*)wsq; const float* const par = (const float*)(ws + WS_PAR); int lnq = lane_id(); asm volatile("" : "+v"(lnq)); const int lane = lnq; (void)par; (void)lane;
            const int nlatu = 1024, nctxu = lastl ? 0 : 64;
            for (int it = vcu; it < nlatu + nctxu; it += G) {
                att::AttnArgs A; int typ, b, h;
                if (it < nlatu) { const int u = it >> 1; typ = (it ^ (it >> 8)) & 1;
                    b = u >> 7; h = (u >> 4) & 7; const int qb = u & 15; A.qrow0 = (long)b * SEQ + qb * 256; A.ntiles = 68; }
                else { const int u = it - nlatu; typ = u & 1; b = (u >> 1) >> 3; h = (u >> 1) & 7; A.qrow0 = NLAT + (long)b * CTXL; A.ntiles = 4; }
                A.b = b; A.O = (bf16*)(ws + P_YBR); A.opitch = 1536;
                if (typ == 0) { A.Q = (const bf16*)(ws + P_QA); A.qpitch = 512; A.qcol = h * 64; A.K1 = (const bf16*)(ws + P_KA); A.k1pitch = 128; A.k1col = (h >> 2) * 64; A.K2 = nullptr; A.k2pitch = 0;
                    A.V = (const bf16*)(ws + P_VA); A.vpitch = 128; A.vcol = (h >> 2) * 64; A.ocol = h * 64; att::attn_unit4<64>(A, lds, wave); }
                else { A.Q = (const bf16*)(ws + P_QB); A.qpitch = 768; A.qcol = h * 96; A.K1 = (const bf16*)(ws + P_KB); A.k1pitch = 512; A.k1col = h * 64; A.K2 = (const bf16*)(ws + P_KRR); A.k2pitch = 32;
                    A.V = (const bf16*)(ws + P_VB); A.vpitch = 512; A.vcol = h * 64; A.ocol = 512 + h * 64; att::attn_unit4<96>(A, lds, wave); }
            }
            __syncthreads();
#ifndef S5REP
#define S5REP 1
#endif
            for (int s5r_ = 0; s5r_ < S5REP; ++s5r_)
            for (int it = G - 1 - vcu; it < 256; it += G) { const int b = it >> 6, g = (it >> 1) & 31, half = it & 1;
                s5::unit(par + PR_A16, l, b, g, (const bf16*)(ws + P_UG), (const bf16*)(ws + WS_S5M) + (size_t)(l * 32 + g) * s5::M_TOTAL, (bf16*)(ws + P_AGLU), lastl, lds, wave, half); }
            SEAM(pb + 3);
        }
        if (PHON(6) && IN(pb + 4)) for (int rep_ = 0; rep_ <= (int)REPON(6); ++rep_) {
            GAS unsigned char* wsq = (GAS unsigned char*)ws0; asm volatile("" : "+s"(wsq)); unsigned char* const ws = (unsigned char*)wsq; const float* const par = (const float*)(ws + WS_PAR); int lnq = lane_id(); asm volatile("" : "+v"(lnq)); const int lane = lnq; (void)par; (void)lane;
            pg8::SchedPlain S{(const char*)(ws + P_AGLU), (const char*)(ws + WS_WGLUT) + (size_t)l * 1024 * 1024, 1024u, 1024u, 8, nMq, 4, G, bx};
            pg8::EpiPair<0> E{(bf16*)(ws + P_YBR), 1536, 1024, 0};
            pg8::gemm_phase<pg8::EpiPair<0>, pg8::SchedPlain, false>(lds, S, E, wave);
            SEAM(pb + 4);
        }
        if (PHON(7) && IN(pb + 5)) for (int rep_ = 0; rep_ <= (int)REPON(7); ++rep_) {
            GAS unsigned char* wsq = (GAS unsigned char*)ws0; asm volatile("" : "+s"(wsq)); unsigned char* const ws = (unsigned char*)wsq; const float* const par = (const float*)(ws + WS_PAR); int lnq = lane_id(); asm volatile("" : "+v"(lnq)); const int lane = lnq; (void)par; (void)lane;
#define MRG_ROUND(r) do { \
                { pg8::SchedMergeG S{(const char*)(ws + P_H8), (const char*)(ws + WS_WMGT) + (size_t)l * 3072 * 1024, 1024u, 1024u, 8, nMq, (r) * G + bx}; \
                  pg8::EpiGate E{par + PR_BMG + l * 3072, (u32x4*)(ws + P_GSCR + (size_t)bx * 3 * 131072), 1.0f / (F8_HSCALE * F8_WSCALE)}; \
                  pg8::gemm_phase<pg8::EpiGate, pg8::SchedMergeG, false, true>(lds, S, E, wave); } \
                { pg8::SchedMergeP S{(const char*)(ws + P_YBR), (const char*)(ws + WS_WBT) + (size_t)l * 3 * 1024 * 1024, 3072u, 1024u, 8, nMq, (r) * G + bx}; \
                  pg8::EpiMergeP E{(bf16*)(ws + P_MRG), (const u32x4*)(ws + P_GSCR + (size_t)bx * 3 * 131072)}; \
                  pg8::gemm_phase<pg8::EpiMergeP, pg8::SchedMergeP, false, false>(lds, S, E, wave); } } while (0)
            MRG_ROUND(0);
            if (G < nMq * 4) MRG_ROUND(1);
#undef MRG_ROUND
            MOE_TAIL(0, 480);
            SEAM(pb + 5);
        }
        if (PHON(8) && IN(pb + 6)) for (int rep_ = 0; rep_ <= (int)REPON(8); ++rep_) {
            GAS unsigned char* wsq = (GAS unsigned char*)ws0; asm volatile("" : "+s"(wsq)); unsigned char* const ws = (unsigned char*)wsq; const float* const par = (const float*)(ws + WS_PAR); int lnq = lane_id(); asm volatile("" : "+v"(lnq)); const int lane = lnq; (void)par; (void)lane;
            pg8::SchedPlain S{(const char*)(ws + P_MRG), (const char*)(ws + WS_WOUTT) + (size_t)l * 1024 * 2048, 2048u, 2048u, 16, nMq, 4, G, bx};
            pg8::EpiBf16 E{(bf16*)(ws + P_Y), 1024, 0};
            pg8::gemm_phase<pg8::EpiBf16, pg8::SchedPlain, false>(lds, S, E, wave);
            MOE_TAIL(480, 620);
            SEAM(pb + 6);
        }
        if (PHON(9) && IN(pb + 7)) for (int rep_ = 0; rep_ <= (int)REPON(9); ++rep_) {
            GAS unsigned char* wsq = (GAS unsigned char*)ws0; asm volatile("" : "+s"(wsq)); unsigned char* const ws = (unsigned char*)wsq; const float* const par = (const float*)(ws + WS_PAR); int lnq = lane_id(); asm volatile("" : "+v"(lnq)); const int lane = lnq; (void)par; (void)lane;
            ResidArgs R{}; R.mode = 3; R.y = (const float*)(ws + P_Y); R.g_post = par + PR_GMIXPOST + l * 1024; R.gate_chunk = 2; R.g_pre = par + PR_GFFNPRE + l * 1024; R.shift_chunk = 3;
            R.hout = (bf16*)(ws + P_H); R.l_mod = l; R.l_gate = l; R.route = lastl; R.h8 = lastl ? (F8_M1 != 0) : (F8_D1 != 0); R.ysc = 1.0f;
            { int row = gw; for (; row + ngw < nMq * 256; row += 2 * ngw) { resid_row(ws, outp, nullptr, nullptr, Rd(R, rep_), row, lane, tb); resid_row(ws, outp, nullptr, nullptr, Rd(R, rep_), row + ngw, lane, tb); } if (row < nMq * 256) resid_row(ws, outp, nullptr, nullptr, Rd(R, rep_), row, lane, tb); }
            SEAM(pb + 7);
        }
        if (!lastl) {
            if (PHON(10) && IN(pb + 8)) for (int rep_ = 0; rep_ <= (int)REPON(10); ++rep_) {
            GAS unsigned char* wsq = (GAS unsigned char*)ws0; asm volatile("" : "+s"(wsq)); unsigned char* const ws = (unsigned char*)wsq; const float* const par = (const float*)(ws + WS_PAR); int lnq = lane_id(); asm volatile("" : "+v"(lnq)); const int lane = lnq; (void)par; (void)lane;
                constexpr unsigned kb1 = F8_D1 ? 1024u : 2048u;
                pg8::SchedPlain S{(const char*)(ws + P_H), (const char*)(ws + WS_WF1T), kb1, kb1, F8_D1 ? 8 : 16, nMall, 22, G, bx};
                pg8::EpiPairS<F8_D2 != 0> E{ws + P_ACT, DFF, 0, F8_D1 ? 1.0f / (F8_HSCALE * F8_WSCALE) : 1.0f, F8_D2 ? F8_ASCALE : 1.0f};
                pg8::gemm_phase<pg8::EpiPairS<F8_D2 != 0>, pg8::SchedPlain, false, F8_D1 != 0>(lds, S, E, wave);
                SEAM(pb + 8);
            }
            if (PHON(11) && IN(pb + 9)) for (int rep_ = 0; rep_ <= (int)REPON(11); ++rep_) {
            GAS unsigned char* wsq = (GAS unsigned char*)ws0; asm volatile("" : "+s"(wsq)); unsigned char* const ws = (unsigned char*)wsq; const float* const par = (const float*)(ws + WS_PAR); int lnq = lane_id(); asm volatile("" : "+v"(lnq)); const int lane = lnq; (void)par; (void)lane;
                constexpr unsigned kb2 = F8_D2 ? 2816u : 5632u;
                pg8::SchedPlain S{(const char*)(ws + P_ACT), (const char*)(ws + WS_WF2T), kb2, kb2, F8_D2 ? 22 : 44, nMall, 4, G, bx};
                pg8::EpiBf16 E{(bf16*)(ws + P_Y2), 1024, 0};
                pg8::gemm_phase<pg8::EpiBf16, pg8::SchedPlain, false, F8_D2 != 0>(lds, S, E, wave);
                MOE_TAIL(620, 1000);
                SEAM(pb + 9);
            }
            if (PHON(14) && IN(pb + 12)) for (int rep_ = 0; rep_ <= (int)REPON(14); ++rep_) {
            GAS unsigned char* wsq = (GAS unsigned char*)ws0; asm volatile("" : "+s"(wsq)); unsigned char* const ws = (unsigned char*)wsq; const float* const par = (const float*)(ws + WS_PAR); int lnq = lane_id(); asm volatile("" : "+v"(lnq)); const int lane = lnq; (void)par; (void)lane;
                ResidArgs R{}; R.mode = 3; R.y = (const float*)(ws + P_Y2); R.g_post = par + PR_GFFNPOST; R.gate_chunk = 5; R.g_pre = par + PR_GMIXPRE + 1024; R.shift_chunk = 0;
                R.hout = (bf16*)(ws + P_H); R.l_mod = 1; R.l_gate = 0; R.route = false; R.hout8 = ws + P_H8; R.ysc = F8_D2 ? 1.0f / (F8_ASCALE * F8_WSCALE) : 1.0f;
                { int row = gw; for (; row + ngw < MALL; row += 2 * ngw) { resid_row(ws, outp, nullptr, nullptr, Rd(R, rep_), row, lane, tb); resid_row(ws, outp, nullptr, nullptr, Rd(R, rep_), row + ngw, lane, tb); } if (row < MALL) resid_row(ws, outp, nullptr, nullptr, Rd(R, rep_), row, lane, tb); }
                SEAM(pb + 12);
            }
        } else {
            for (int ch = 0; ch < 1; ++ch) {
                if (IN(pb + 8 + 2 * ch) || IN(pb + 9 + 2 * ch)) {
                    __syncthreads();
                    if (tid == 0) { const unsigned* cnt = (const unsigned*)(ws + WS_CTL) + CW_CNT; int acc = 0;
                        for (int e = 0; e < 8; ++e) { const int c = (int)__hip_atomic_load(cnt + e, __ATOMIC_RELAXED, __HIP_MEMORY_SCOPE_AGENT); tb[e] = c; tb[8 + e] = acc; acc += (c + 255) >> 8; }
                        tb[16] = acc; }
                    __syncthreads();
                }
                const int ntot = __builtin_amdgcn_readfirstlane(tb[16]), t0 = 0, t1 = ntot;
                if (PHON(12) && IN(pb + 8 + 2 * ch)) for (int rep_ = 0; rep_ <= (int)REPON(12); ++rep_) {
            GAS unsigned char* wsq = (GAS unsigned char*)ws0; asm volatile("" : "+s"(wsq)); unsigned char* const ws = (unsigned char*)wsq; const float* const par = (const float*)(ws + WS_PAR); int lnq = lane_id(); asm volatile("" : "+v"(lnq)); const int lane = lnq; (void)par; (void)lane;
                    constexpr unsigned kbm = F8_M1 ? 1024u : 2048u;
                    pg8::SchedMoe1 S{(const char*)(ws + P_H), (const char*)(ws + WS_WM1T), kbm, kbm, F8_M1 ? 8 : 16, (const int*)(ws + WS_LIST), tb, t1, G, bx};
                    pg8::EpiPairS<true> E{ws + P_ACT, DFF, 0, F8_M1 ? 1.0f / (F8_HSCALE * F8_WSCALE) : 1.0f, F8_ASCALE};
                    pg8::gemm_phase<pg8::EpiPairS<true>, pg8::SchedMoe1, true, F8_M1 != 0>(lds, S, E, wave);
                    SEAM(pb + 8 + 2 * ch);
                }
                if (PHON(13) && IN(pb + 9 + 2 * ch)) for (int rep_ = 0; rep_ <= (int)REPON(13); ++rep_) {
            GAS unsigned char* wsq = (GAS unsigned char*)ws0; asm volatile("" : "+s"(wsq)); unsigned char* const ws = (unsigned char*)wsq; const float* const par = (const float*)(ws + WS_PAR); int lnq = lane_id(); asm volatile("" : "+v"(lnq)); const int lane = lnq; (void)par; (void)lane;
                    pg8::SchedMoe2 S{(const char*)(ws + P_ACT), (const char*)(ws + WS_WM2T), 2816u, 2816u, 22, tb, t1, G, bx};
                    pg8::EpiBf16 E{(bf16*)(ws + P_Y2), 1024, 0};
                    pg8::gemm_phase<pg8::EpiBf16, pg8::SchedMoe2, false, true>(lds, S, E, wave);
                    SEAM(pb + 9 + 2 * ch);
                }
            }
            if (PHON(14) && IN(pb + 12)) for (int rep_ = 0; rep_ <= (int)REPON(14); ++rep_) {
            GAS unsigned char* wsq = (GAS unsigned char*)ws0; asm volatile("" : "+s"(wsq)); unsigned char* const ws = (unsigned char*)wsq; const float* const par = (const float*)(ws + WS_PAR); int lnq = lane_id(); asm volatile("" : "+v"(lnq)); const int lane = lnq; (void)par; (void)lane;
                __syncthreads();
                if (tid == 0) { const unsigned* cnt = (const unsigned*)(ws + WS_CTL) + CW_CNT; int acc = 0;
                    for (int e = 0; e < 8; ++e) { const int c = (int)__hip_atomic_load(cnt + e, __ATOMIC_RELAXED, __HIP_MEMORY_SCOPE_AGENT); tb[e] = c; tb[8 + e] = acc; acc += (c + 255) >> 8; }
                    tb[16] = acc; }
                __syncthreads();
                ResidArgs R{}; R.mode = 2; R.g_post = par + PR_GFFNPOST + 1024; R.gate_chunk = 5; R.hout = nullptr; R.l_gate = 1; R.route = false; R.ysc = 1.0f / (F8_ASCALE * F8_WSCALE);
                { int row = gw; for (; row + ngw < NLAT; row += 2 * ngw) { resid_row(ws, outp, nullptr, nullptr, Rd(R, rep_), row, lane, tb); resid_row(ws, outp, nullptr, nullptr, Rd(R, rep_), row + ngw, lane, tb); } if (row < NLAT) resid_row(ws, outp, nullptr, nullptr, Rd(R, rep_), row, lane, tb); }
            }
        }
    }
#undef IN
#undef SEAM
#undef tid
}

extern "C" void kernel_launch(void* const* d_in, const int* in_sizes, int n_in, void* d_out, int out_size, void* d_ws, size_t ws_size, hipStream_t stream) {
    static int grid = 0;
    if (grid == 0) {
        if (n_in != 38 || out_size != NLAT * D || ws_size < WS_END) { fprintf(stderr, "kernel_launch: unexpected problem (n_in %d out %d ws %zu, need %zu)\n", n_in, out_size, ws_size, (size_t)WS_END); grid = -1; return; }
        int dev = 0, cus = 0, per_cu = 0;
        if (hipGetDevice(&dev) != hipSuccess || hipDeviceGetAttribute(&cus, hipDeviceAttributeMultiprocessorCount, dev) != hipSuccess) { grid = -1; return; }
        if (hipFuncSetAttribute((const void*)mk_fwd, hipFuncAttributeMaxDynamicSharedMemorySize, LDS_BYTES) != hipSuccess) { fprintf(stderr, "kernel_launch: hipFuncSetAttribute failed\n"); grid = -1; return; }
        if (hipOccupancyMaxActiveBlocksPerMultiprocessor(&per_cu, (const void*)mk_fwd, NTHREADS, LDS_BYTES) != hipSuccess || per_cu < 1) { fprintf(stderr, "kernel_launch: occupancy query says %d\n", per_cu); }
        (void)hipGetLastError();
        grid = cus;
    }
    if (grid < 0) return;
    (void)hipMemsetAsync((char*)d_ws + WS_CTL, 0, CTL_BYTES, stream);
    Args a{};
    for (int i = 0; i < 38; ++i) a.in[i] = (const float*)d_in[i];
    a.out = (float*)d_out; a.ws = (unsigned char*)d_ws;
#if MK_MULTI
    for (int ph = 0; ph < NPH; ++ph) {
        const int rel = ph < PH_L0 ? -1 : (ph - PH_L0) % PH_PER_L, l = ph < PH_L0 ? 0 : (ph - PH_L0) / PH_PER_L;
        if (rel > 12 || (l == 0 && (rel == 10 || rel == 11))) continue;
        a.ph_lo = ph; a.ph_hi = ph + 1;
        hipLaunchKernelGGL(mk_fwd, dim3(grid), dim3(NTHREADS), LDS_BYTES, stream, a);
#if MK_DEBUG
        hipLaunchKernelGGL(dbg_fwd, dim3(grid), dim3(NTHREADS), 0, stream, a, ph);
#endif
    }
#if MK_DEBUG
    hipLaunchKernelGGL(dbg_fwd, dim3(grid), dim3(NTHREADS), 0, stream, a, 1000);
#endif
#else
    a.ph_lo = 0; a.ph_hi = NPH;
    hipLaunchKernelGGL(mk_fwd, dim3(grid), dim3(NTHREADS), LDS_BYTES, stream, a);
#endif
}
```

```cpp
#define F8_G1L1 0
#include <hip/hip_runtime.h>
#include <cstdio>
#include <cstdint>

#ifndef MK_DEBUG
#define MK_DEBUG 0
#endif
#ifndef MK_MULTI
#define MK_MULTI 0
#endif

#define GAS __attribute__((address_space(1)))
#define LAS __attribute__((address_space(3)))
typedef unsigned short bf16;
typedef short bf16x8 __attribute__((ext_vector_type(8)));
typedef short s16x4 __attribute__((ext_vector_type(4)));
typedef float f32x2 __attribute__((ext_vector_type(2)));
typedef float f32x4 __attribute__((ext_vector_type(4)));
typedef float f32x16 __attribute__((ext_vector_type(16)));
typedef unsigned u32x2 __attribute__((ext_vector_type(2)));
typedef unsigned u32x4 __attribute__((ext_vector_type(4)));

constexpr int D = 1024, NB = 4, SEQ = 4096, CTXL = 256, GRIDW = 64;
constexpr int NLAT = NB * SEQ, NCTX = NB * CTXL, MALL = NLAT + NCTX;
constexpr int LPOS = CTXL + SEQ;
constexpr int NIN = 1952, ZW = 2048;
constexpr int DFF = 2816, NEXP = 8;
constexpr float EPS = 1e-6f;
constexpr float LOG2E = 1.4426950408889634f;
#ifndef F8_G1L1
#define F8_G1L1 1
#endif
constexpr float F8_WSCALE = 256.f, F8_HSCALE = 16.f, F8_ASCALE = 8.f;
#ifndef F8_D1
#define F8_D1 0
#endif
#ifndef F8_D2
#define F8_D2 0
#endif
#ifndef F8_M1
#define F8_M1 1
#endif
constexpr int ZC_QG = 0, ZC_KG = 512, ZC_VG = 640, ZC_CQ = 768, ZC_CKV = 1152, ZC_KR = 1408, ZC_U = 1536;

constexpr size_t MiB = 1u << 20;
constexpr size_t WS_CTL = 0, CTL_BYTES = 1 * MiB;
constexpr size_t WS_MOD = 1 * MiB;
constexpr size_t WS_ROPE = 2 * MiB;
constexpr size_t WS_PAR = 3 * MiB + 512 * 1024;
constexpr int PR_GMIXPRE = 0, PR_GMIXPOST = 2048, PR_GFFNPRE = 4096, PR_GFFNPOST = 6144, PR_GQ = 8192, PR_GK = 8320, PR_GCQ = 8448, PR_GCKV = 9216, PR_BMG = 9728, PR_RW = 15872, PR_RB = 24064,
              PR_A16 = 24080, PR_END = PR_A16 + 2 * 2 * 32 * 64 * 2;
constexpr size_t WS_LIST = 4 * MiB;
constexpr size_t WS_LATC = 5 * MiB;
constexpr size_t WS_W1T = 9 * MiB;
constexpr size_t WS_WMGT = 17 * MiB;
constexpr size_t WS_WUQT = 29 * MiB;
constexpr size_t WS_WUKVT = 31 * MiB;
constexpr size_t WS_S5M = 32 * MiB;
constexpr size_t WS_WGLUT = 56 * MiB;
constexpr size_t WS_WBT = 58 * MiB;
constexpr size_t WS_WOUTT = 64 * MiB;
constexpr size_t WS_WF1T = 68 * MiB;
constexpr size_t WS_WF2T = 79 * MiB;
constexpr size_t WS_WM1T = 85 * MiB;
constexpr size_t WS_WM2T = 173 * MiB;
constexpr size_t WS_POOL = 217 * MiB;
constexpr size_t P_H = WS_POOL + 0 * MiB;
constexpr size_t P_Z = WS_POOL + 34 * MiB;
constexpr size_t P_QB = WS_POOL + 34 * MiB;
constexpr size_t P_KB = WS_POOL + 60 * MiB;
constexpr size_t P_VB = WS_POOL + 77 * MiB;
constexpr size_t P_QA = WS_POOL + 102 * MiB;
constexpr size_t P_KA = WS_POOL + 119 * MiB;
constexpr size_t P_VA = WS_POOL + 124 * MiB;
constexpr size_t P_KRR = WS_POOL + 129 * MiB;
constexpr size_t P_UG = WS_POOL + 131 * MiB;
constexpr size_t P_CQN = WS_POOL + 148 * MiB;
constexpr size_t P_CKVN = WS_POOL + 161 * MiB;
constexpr size_t P_AGLU = WS_POOL + 170 * MiB;
constexpr size_t P_YBR = WS_POOL + 187 * MiB;
constexpr size_t P_MRG = WS_POOL + 34 * MiB;
constexpr size_t P_GSCR = WS_POOL + 68 * MiB;
constexpr size_t P_Y = WS_POOL + 102 * MiB;
constexpr size_t P_ACT = WS_POOL + 34 * MiB;
constexpr size_t P_Y2 = WS_POOL + 136 * MiB;
constexpr size_t P_H8 = WS_POOL + 240 * MiB;
constexpr size_t WS_END = WS_POOL + 257 * MiB;
static_assert(P_YBR + (size_t)MALL * 1536 * 2 <= WS_END && P_Y2 + (size_t)MALL * 1024 * 4 <= WS_END && P_ACT + (size_t)MALL * DFF * 2 <= P_Y2, "pool map");
static_assert(P_GSCR + 256 * 3 * 131072 <= P_AGLU && P_VB + (size_t)MALL * 512 * 2 <= P_QA && P_Y + (size_t)MALL * 4096 <= P_AGLU, "pool map 2");

constexpr int CW_BAR = 4096;
constexpr int CW_Q = 8320;
constexpr int CW_CNT = 8192;
constexpr int CW_DBG = 16384;

constexpr int LDS_MISC = 147456;
constexpr int LDS_BYTES = 151552;
constexpr int NWAVES = 8, NTHREADS = 512;

__device__ __forceinline__ int lane_id() { unsigned m_ = ~0u; asm volatile("" : "+s"(m_)); return (int)__builtin_amdgcn_mbcnt_hi(m_, __builtin_amdgcn_mbcnt_lo(m_, 0u)); }
__device__ __forceinline__ float bf2f(unsigned v) { return __uint_as_float(v << 16); }
__device__ __forceinline__ unsigned f2bf(float f) { unsigned u = __float_as_uint(f); return (u + 0x7fffu + ((u >> 16) & 1u)) >> 16; }
typedef __bf16 bf16x2_t __attribute__((ext_vector_type(2)));
__device__ __forceinline__ unsigned pk2(float lo, float hi) { const f32x2 v = {lo, hi}; return __builtin_bit_cast(unsigned, __builtin_convertvector(v, bf16x2_t)); }
__device__ __forceinline__ float shfl_xor_l(float v, int mask, int lane) { return __int_as_float(__builtin_amdgcn_ds_bpermute((lane ^ mask) << 2, __float_as_int(v))); }
__device__ __forceinline__ float wave_sum(float v) {
    const int lane = lane_id();
#pragma unroll
    for (int o = 1; o < 64; o <<= 1) v += shfl_xor_l(v, o, lane);
    return v;
}
__device__ __forceinline__ float fsigmoid(float x) { return __builtin_amdgcn_rcpf(1.0f + __builtin_amdgcn_exp2f(-x * LOG2E)); }
__device__ __forceinline__ float fsilu(float x) { return x * fsigmoid(x); }
__device__ __forceinline__ float fgelu_tanh(float x) { const float u = 0.7978845608028654f * (x + 0.044715f * x * x * x); return x * fsigmoid(2.0f * u); }
__device__ __forceinline__ void unpack8(const u32x4 v, float (&f)[8]) {
    f[0] = bf2f(v.x & 0xffffu); f[1] = bf2f(v.x >> 16); f[2] = bf2f(v.y & 0xffffu); f[3] = bf2f(v.y >> 16);
    f[4] = bf2f(v.z & 0xffffu); f[5] = bf2f(v.z >> 16); f[6] = bf2f(v.w & 0xffffu); f[7] = bf2f(v.w >> 16);
}
__device__ __forceinline__ u32x4 pack8(const float (&f)[8]) { u32x4 w; w.x = pk2(f[0], f[1]); w.y = pk2(f[2], f[3]); w.z = pk2(f[4], f[5]); w.w = pk2(f[6], f[7]); return w; }
__device__ __forceinline__ int pos_row(int b, int p) { return p < CTXL ? NLAT + b * CTXL + p : b * SEQ + (p - CTXL); }

#define XB_TMO      128
#define XB_XCNT(j)  (256  + 64 * (j))
#define XB_XSUB(j)  (1280 + 64 * (j))
#define XB_XGEN(j)  (2304 + 64 * (j))
#define XB_TOP      3328
#define XB_TOPGEN   3392
#define XCD_BAR_WORDS 3456
#define XB_SPIN_CAP (1u << 18)
__device__ __forceinline__ unsigned xb_ld(unsigned* p)              { return __hip_atomic_load(p, __ATOMIC_RELAXED, __HIP_MEMORY_SCOPE_AGENT); }
__device__ __forceinline__ unsigned xb_add(unsigned* p, unsigned v) { return __hip_atomic_fetch_add(p, v, __ATOMIC_RELAXED, __HIP_MEMORY_SCOPE_AGENT); }
__device__ __forceinline__ unsigned xb_xcc_id() { return (unsigned)__builtin_amdgcn_s_getreg((3 << 11) | 20) & 0xFu; }
#define XB_SPIN(cond, bar) do { unsigned _sp = 0; while (cond) { __builtin_amdgcn_s_sleep(1); \
    if ((++_sp & 255u) == 0u) { if (xb_ld(&(bar)[XB_TMO])) break; if (_sp > XB_SPIN_CAP) { atomicAdd(&(bar)[XB_TMO], 1u); break; } } } } while (0)
struct XcdBarrier { unsigned* bar; unsigned x; volatile LAS unsigned* st; int wave; };
__device__ __forceinline__ XcdBarrier xcd_barrier_post(unsigned* bar, volatile LAS unsigned* st, int wave) {
    XcdBarrier b; b.bar = bar; b.x = xb_xcc_id(); b.st = st; b.wave = wave;
    if (wave == 0 && lane_id() == 0) (void)xb_add(&bar[XB_XCNT(b.x)], 1u);
    return b;
}
__device__ __forceinline__ void xcd_barrier_complete(unsigned* bar, unsigned x, unsigned& nloc, unsigned& nx) {
    const unsigned G = gridDim.x * gridDim.y * gridDim.z;
    unsigned sum, cnt, mine, sp = 0u;
    for (;;) {
        sum = 0u; cnt = 0u; mine = 0u;
#pragma unroll
        for (unsigned j = 0; j < 16; ++j) { const unsigned c = xb_ld(&bar[XB_XCNT(j)]); sum += c; cnt += (c > 0u) ? 1u : 0u; mine = (j == x) ? c : mine; }
        if (sum == G) break;
        __builtin_amdgcn_s_sleep(1);
        if ((++sp & 255u) == 0u) { if (xb_ld(&bar[XB_TMO])) break; if (sp > XB_SPIN_CAP) { atomicAdd(&bar[XB_TMO], 1u); break; } }
    }
    nloc = mine > 0u ? mine : 1u; nx = cnt > 0u ? cnt : 1u;
}
__device__ __forceinline__ void xcd_barrier(const XcdBarrier& b) {
    asm volatile("s_waitcnt vmcnt(0)" ::: "memory");
    __syncthreads();
    if (b.wave == 0 && lane_id() == 0) {
        unsigned* bar = b.bar;
        __builtin_amdgcn_s_waitcnt(0);
        unsigned nloc = b.st[0], nx = b.st[1];
        if (nloc == 0u) { xcd_barrier_complete(bar, b.x, nloc, nx); b.st[0] = nloc; b.st[1] = nx; }
        const unsigned old = xb_add(&bar[XB_XSUB(b.x)], 1u);
        const unsigned gen = old / nloc;
        if (old + 1u == (gen + 1u) * nloc) {
            __builtin_amdgcn_fence(__ATOMIC_RELEASE, "agent");
            asm volatile("s_waitcnt vmcnt(0)" ::: "memory");
            const unsigned og = xb_add(&bar[XB_TOP], 1u);
            const unsigned tg = og / nx;
            if (og + 1u == (tg + 1u) * nx) xb_add(&bar[XB_TOPGEN], 1u);
            else XB_SPIN(xb_ld(&bar[XB_TOPGEN]) == tg, bar);
            __builtin_amdgcn_fence(__ATOMIC_ACQUIRE, "agent");
            xb_add(&bar[XB_XGEN(b.x)], 1u);
            asm volatile("s_waitcnt vmcnt(0)" ::: "memory");
        } else {
            XB_SPIN(xb_ld(&bar[XB_XGEN(b.x)]) == gen, bar);
            __builtin_amdgcn_fence(__ATOMIC_ACQUIRE, "agent");
            asm volatile("s_waitcnt vmcnt(0)" ::: "memory");
        }
    }
    __syncthreads();
}

namespace pg8 {
typedef int v4i __attribute__((ext_vector_type(4)));
typedef int v8i __attribute__((ext_vector_type(8)));
constexpr int BM = 256, BK = 64, HALF = 128, HTB = HALF * BK * 2, STAGE_BYTES = 8 * HTB;
__host__ __device__ __forceinline__ int lds_byte(int r, int c) { const int st = (r >> 4) * 2 + (c >> 5), rr = r & 15, cc = c & 31, ob = rr * 64 + cc * 2; return st * 1024 + (ob ^ (((ob >> 9) & 1) << 5)); }
__host__ __device__ __forceinline__ void stage_rc(int b, int& R, int& C) { const int st = b / 1024, sb = b % 1024, swz = sb ^ (((sb >> 9) & 1) << 5); R = (st >> 1) * 16 + swz / 64; C = (st & 1) * 32 + (swz % 64) / 2; }
__host__ __device__ __forceinline__ int perm32(int rho) { const int n = rho >> 4, i = rho & 15; return 8 * (i >> 2) + 4 * n + (i & 3); }

struct GUnit { const char* a; const char* b; unsigned lda, ldb; int nt; int pm, pn, z; };

__device__ __forceinline__ void tile_of(int L, int nM, int nN, int& pm, int& pn) {
    const int nwg = nM * nN; int wgid = L;
    { const int q = nwg / 8, r = nwg % 8, xcd = wgid % 8, off = wgid / 8; wgid = (xcd < r ? xcd * (q + 1) : r * (q + 1) + (xcd - r) * q) + off; }
    const int nig = 8 * nN, gid = wgid / nig, fm = gid * 8, gsz = (nM - fm) < 8 ? (nM - fm) : 8;
    pm = fm + ((wgid % nig) % gsz); pn = (wgid % nig) / gsz;
}

template <class Epi, class Sched, bool GATHER, bool F8 = false>
__device__ __forceinline__ void gemm_phase(LAS unsigned char* lds, const Sched& S, const Epi& E, int wave_) {
    int tid = wave_ * 64 + lane_id(); asm volatile("" : "+v"(tid));
    const int wid = __builtin_amdgcn_readfirstlane(tid >> 6), lane = tid & 63, wr = wid >> 2, wc = wid & 3, fr = lane & 15, fq = lane >> 4;
    int Rr[2], Cc[2], Rb[2];
#pragma unroll
    for (int i = 0; i < 2; ++i) { stage_rc(tid * 16 + i * 8192, Rr[i], Cc[i]); Rb[i] = Epi::PERM ? ((Rr[i] & ~31) + perm32(Rr[i] & 31)) : Rr[i]; }
    const size_t kstep = (size_t)(BK * 2);
    const unsigned ldsw = (unsigned)wid * 1024u;
    const int aoff = lds_byte(wr * 64 + fr, fq * 8), boff = lds_byte(wc * 32 + fr, fq * 8);
#define PG8_SA(b, h) (((b) * 2 + (h)) * HTB)
#define PG8_SB(b, h) ((4 + (b) * 2 + (h)) * HTB)
#define PG8_STAGE(bufoff, gbase, v0, v1) do { \
        __builtin_amdgcn_global_load_lds((const unsigned*)((const char*)(gbase) + (v0)), (LAS unsigned*)(lds + (bufoff) + ldsw), 16, 0, 0); \
        __builtin_amdgcn_global_load_lds((const unsigned*)((const char*)(gbase) + (v1)), (LAS unsigned*)(lds + (bufoff) + ldsw + 8192), 16, 0, 0); } while (0)
#define PG8_LD16(p) __builtin_bit_cast(v4i, *(const LAS bf16x8*)(p))
#define PG8_LDA(dst, b, h) do { _Pragma("unroll") for (int m = 0; m < 4; ++m) dst[m] = __builtin_shufflevector(PG8_LD16(lds + PG8_SA(b, h) + aoff + m * 2048), PG8_LD16(lds + PG8_SA(b, h) + aoff + m * 2048 + 1024), 0, 1, 2, 3, 4, 5, 6, 7); } while (0)
#define PG8_LDB(dst, b, h) do { _Pragma("unroll") for (int n = 0; n < 2; ++n) dst[n] = __builtin_shufflevector(PG8_LD16(lds + PG8_SB(b, h) + boff + n * 2048), PG8_LD16(lds + PG8_SB(b, h) + boff + n * 2048 + 1024), 0, 1, 2, 3, 4, 5, 6, 7); } while (0)
#define PG8_LO(x) __builtin_bit_cast(bf16x8, __builtin_shufflevector(x, x, 0, 1, 2, 3))
#define PG8_HI(x) __builtin_bit_cast(bf16x8, __builtin_shufflevector(x, x, 4, 5, 6, 7))
#define PG8_MMA(ai, bj, At, Bt) do { __builtin_amdgcn_s_setprio(1); \
        _Pragma("unroll") for (int m = 0; m < 4; ++m) _Pragma("unroll") for (int n = 0; n < 2; ++n) { \
            if constexpr (F8) acc[ai][bj][m][n] = __builtin_amdgcn_mfma_scale_f32_16x16x128_f8f6f4(Bt[n], At[m], acc[ai][bj][m][n], 0, 0, 0, 0, 0, 0); \
            else { acc[ai][bj][m][n] = __builtin_amdgcn_mfma_f32_16x16x32_bf16(PG8_LO(Bt[n]), PG8_LO(At[m]), acc[ai][bj][m][n], 0, 0, 0); \
                   acc[ai][bj][m][n] = __builtin_amdgcn_mfma_f32_16x16x32_bf16(PG8_HI(Bt[n]), PG8_HI(At[m]), acc[ai][bj][m][n], 0, 0, 0); } } \
        __builtin_amdgcn_s_setprio(0); } while (0)
#define PG8_WAIT_V(n) asm volatile("s_waitcnt vmcnt(" #n ")" ::: "memory")
#define PG8_WAIT_L(n) asm volatile("s_waitcnt lgkmcnt(" #n ")" ::: "memory")
#define PG8_BAR __builtin_amdgcn_s_barrier()
#define PG8_SCHED __builtin_amdgcn_sched_barrier(0)
#define PG8_OFFS(u) do { \
        _Pragma("unroll") for (int i_ = 0; i_ < 2; ++i_) { \
            if constexpr (GATHER) { oA0[i_] = S.arow(u, Rr[i_]) + (unsigned)Cc[i_] * 2u; oA1[i_] = S.arow(u, HALF + Rr[i_]) + (unsigned)Cc[i_] * 2u; } \
            else { oA0[i_] = (unsigned)Rr[i_] * (u).lda + (unsigned)Cc[i_] * 2u; } \
            oB[i_] = (unsigned)Rb[i_] * (u).ldb + (unsigned)Cc[i_] * 2u; } \
        hA = GATHER ? (size_t)0 : (size_t)HALF * (u).lda; hB = (size_t)HALF * (u).ldb; } while (0)
#define PG8_A1(i) (GATHER ? oA1[i] : oA0[i])
    GUnit cur, nxt; int ui = 0;
    if (!S.next(0, cur)) return;
    f32x4 acc[2][2][4][2];
#pragma unroll
    for (int a = 0; a < 2; ++a)
#pragma unroll
        for (int b = 0; b < 2; ++b)
#pragma unroll
            for (int m = 0; m < 4; ++m)
#pragma unroll
                for (int n = 0; n < 2; ++n) acc[a][b][m][n] = (f32x4){0.f, 0.f, 0.f, 0.f};
    v8i At[4], B0[2], B1[2];
    unsigned oA0[2], oA1[2], oB[2]; size_t hA, hB;
    oA1[0] = 0u; oA1[1] = 0u;
    PG8_OFFS(cur);
    const char* cA = cur.a; const char* cBp = cur.b;
    PG8_STAGE(PG8_SB(0, 0), cBp, oB[0], oB[1]); PG8_STAGE(PG8_SB(0, 1), cBp + hB, oB[0], oB[1]); PG8_STAGE(PG8_SA(0, 0), cA, oA0[0], oA0[1]); PG8_STAGE(PG8_SA(0, 1), cA + hA, PG8_A1(0), PG8_A1(1));
    if (wr == 1) PG8_BAR;
    PG8_WAIT_V(2); PG8_BAR;
    PG8_STAGE(PG8_SB(1, 0), cBp + kstep, oB[0], oB[1]); PG8_STAGE(PG8_SA(1, 0), cA + kstep, oA0[0], oA0[1]); PG8_STAGE(PG8_SB(1, 1), cBp + hB + kstep, oB[0], oB[1]);
    PG8_WAIT_V(6); PG8_BAR;
    for (;;) {
        const bool has_next = S.next(ui + 1, nxt);
        const char* nA = has_next ? nxt.a : cA; const char* nBp = has_next ? nxt.b : cBp;
        int nt = cur.nt; asm volatile("" : "+s"(nt));
        for (int t = 0; t < nt; t += 2) {
            const bool last = (t == nt - 2);
            const char* a1 = cA + (size_t)(t + 1) * kstep;
            const char* a2 = last ? nA : cA + (size_t)(t + 2) * kstep; const char* b2 = last ? nBp : cBp + (size_t)(t + 2) * kstep;
            const char* a3 = a2 + kstep; const char* b3 = b2 + kstep;
            PG8_LDB(B0, 0, 0); PG8_LDB(B1, 0, 1); PG8_SCHED; PG8_LDA(At, 0, 0); PG8_STAGE(PG8_SA(1, 1), a1 + hA, PG8_A1(0), PG8_A1(1));
            if (last && has_next) PG8_OFFS(nxt);
            PG8_WAIT_V(8); PG8_WAIT_L(0); PG8_BAR; PG8_MMA(0, 0, At, B0); PG8_MMA(0, 1, At, B1); PG8_BAR; PG8_SCHED;
            PG8_LDA(At, 0, 1); PG8_STAGE(PG8_SB(0, 0), b2, oB[0], oB[1]); PG8_STAGE(PG8_SB(0, 1), b2 + hB, oB[0], oB[1]); PG8_STAGE(PG8_SA(0, 0), a2, oA0[0], oA0[1]);
            PG8_WAIT_V(8); PG8_WAIT_L(0); PG8_BAR; PG8_MMA(1, 0, At, B0); PG8_MMA(1, 1, At, B1); PG8_BAR; PG8_SCHED;
            PG8_LDB(B0, 1, 0); PG8_LDB(B1, 1, 1); PG8_SCHED; PG8_LDA(At, 1, 0); PG8_STAGE(PG8_SA(0, 1), a2 + hA, PG8_A1(0), PG8_A1(1));
            PG8_WAIT_V(8); PG8_WAIT_L(0); PG8_BAR; PG8_MMA(0, 0, At, B0); PG8_MMA(0, 1, At, B1); PG8_BAR; PG8_SCHED;
            PG8_LDA(At, 1, 1); PG8_STAGE(PG8_SB(1, 0), b3, oB[0], oB[1]); PG8_STAGE(PG8_SB(1, 1), b3 + hB, oB[0], oB[1]); PG8_STAGE(PG8_SA(1, 0), a3, oA0[0], oA0[1]);
            PG8_WAIT_V(8); PG8_WAIT_L(0); PG8_BAR; PG8_MMA(1, 0, At, B0); PG8_MMA(1, 1, At, B1); PG8_BAR; PG8_SCHED;
        }
        if (wr == 0) PG8_BAR;
        E(acc, cur, wr, wc, fr, fq);
        if (!has_next) break;
#pragma unroll
        for (int a = 0; a < 2; ++a)
#pragma unroll
            for (int b = 0; b < 2; ++b)
#pragma unroll
                for (int m = 0; m < 4; ++m)
#pragma unroll
                    for (int n = 0; n < 2; ++n) acc[a][b][m][n] = (f32x4){0.f, 0.f, 0.f, 0.f};
        cur = nxt; cA = nA; cBp = nBp; ++ui;
        if (wr == 1) PG8_BAR;
    }
    PG8_WAIT_V(0);
    PG8_BAR;
#undef PG8_SA
#undef PG8_SB
#undef PG8_STAGE
#undef PG8_LDA
#undef PG8_LDB
#undef PG8_LD16
#undef PG8_LO
#undef PG8_HI
#undef PG8_MMA
#undef PG8_WAIT_V
#undef PG8_WAIT_L
#undef PG8_BAR
#undef PG8_SCHED
#undef PG8_OFFS
#undef PG8_A1
}
}

namespace pg8 {
__device__ __forceinline__ unsigned pk_fp8x4(float a, float b, float c, float d) {
    a = __builtin_amdgcn_fmed3f(a, -448.f, 448.f); b = __builtin_amdgcn_fmed3f(b, -448.f, 448.f); c = __builtin_amdgcn_fmed3f(c, -448.f, 448.f); d = __builtin_amdgcn_fmed3f(d, -448.f, 448.f);
    unsigned w = 0; w = __builtin_amdgcn_cvt_pk_fp8_f32(a, b, w, false); w = __builtin_amdgcn_cvt_pk_fp8_f32(c, d, w, true); return w; }
struct SchedPlain {
    const char* A; const char* B; unsigned lda, ldb; int nt, nM, nN, G, c;
    __device__ __forceinline__ bool next(int i, GUnit& u) const {
        const int L = i * G + c; if (L >= nM * nN) return false;
        int pm, pn; tile_of(L, nM, nN, pm, pn);
        u.a = A + (size_t)pm * 256 * lda; u.b = B + (size_t)pn * 256 * ldb; u.lda = lda; u.ldb = ldb; u.nt = nt; u.pm = pm; u.pn = pn; u.z = 0; return true;
    }
};
struct SchedUp {
    const char* Aq; const char* Bq; const char* Akv; const char* Bkv; int nMq, nMall, G, c;
    __device__ __forceinline__ bool next(int i, GUnit& u) const {
        int L = i * G + c; const int nq = nMq * 3; int pm, pn;
        if (L < nq) { tile_of(L, nMq, 3, pm, pn); u.a = Aq + (size_t)pm * 256 * 768; u.b = Bq + (size_t)pn * 256 * 768; u.lda = 768u; u.ldb = 768u; u.nt = 6; u.pm = pm; u.pn = pn; u.z = 0; return true; }
        L -= nq; if (L >= nMall * 4) return false;
        tile_of(L, nMall, 4, pm, pn); u.a = Akv + (size_t)pm * 256 * 512; u.b = Bkv + (size_t)pn * 256 * 512; u.lda = 512u; u.ldb = 512u; u.nt = 4; u.pm = pm; u.pn = pn; u.z = 1; return true;
    }
};
struct SchedMergeG {
    const char* A; const char* B; unsigned lda, ldb; int nt, nM, L;
    __device__ __forceinline__ bool next(int i, GUnit& u) const {
        if (i >= 3 || L >= nM * 4) return false;
        int pm, pn; tile_of(L, nM, 4, pm, pn);
        u.a = A + (size_t)pm * 256 * lda; u.lda = lda; u.b = B + ((size_t)i * 1024 + pn * 256) * ldb; u.ldb = ldb; u.nt = nt; u.pm = pm; u.pn = pn; u.z = i; return true;
    }
};
struct SchedMergeP {
    const char* A; const char* B; unsigned lda, ldb; int nt, nM, L;
    __device__ __forceinline__ bool next(int i, GUnit& u) const {
        if (i >= 3 || L >= nM * 4) return false;
        int pm, pn; tile_of(L, nM, 4, pm, pn);
        u.a = A + (size_t)pm * 256 * lda + i * 1024; u.lda = lda; u.b = B + ((size_t)i * 1024 + pn * 256) * ldb; u.ldb = ldb; u.nt = nt; u.pm = pm; u.pn = pn; u.z = i; return true;
    }
};
struct SchedMoe1 {
    const char* H2; const char* W; unsigned lda, ldb; int nt; const int* list; const LAS int* tb; int nM, G, c;
    const LAS unsigned* rt;
    __device__ __forceinline__ bool next(int i, GUnit& u) const {
        const int L = i * G + c; if (L >= nM * 22) return false;
        const int mt = L / 22, pn = L % 22; int e = 0;
#pragma unroll
        for (int j = 1; j < 8; ++j) e += (mt >= tb[8 + j]) ? 1 : 0;
        e = __builtin_amdgcn_readfirstlane(e);
        u.a = H2; u.lda = lda; u.b = W + ((size_t)e * 5632 + pn * 256) * ldb; u.ldb = ldb; u.nt = nt; u.pm = mt; u.pn = pn; u.z = e | (i << 8); return true;
    }
    __device__ __forceinline__ unsigned arow(const GUnit& u, int r) const {
        if (rt) return rt[(u.z >> 8) * 256 + r];
        const int e = u.z & 255, li = (u.pm - tb[8 + e]) * 256 + r; const int tok = (li < tb[e]) ? list[e * 16384 + li] : 0;
        return (unsigned)tok * lda;
    }
    __device__ __forceinline__ int units() const { const int tot = nM * 22; return c < tot ? (tot - c + G - 1) / G : 0; }
    __device__ __forceinline__ void fill(LAS unsigned* w, int tid) const {
        const int n = units() * 256;
        for (int base = tid; base < n; base += 4 * NTHREADS) { int tokv[4];
#pragma unroll
            for (int k = 0; k < 4; ++k) { const int idx = base + NTHREADS * k; tokv[k] = 0;
                if (idx < n) { const int i = idx >> 8, r = idx & 255, mt = (i * G + c) / 22; int e = 0;
#pragma unroll
                    for (int j = 1; j < 8; ++j) e += (mt >= tb[8 + j]) ? 1 : 0;
                    const int li = (mt - tb[8 + e]) * 256 + r; if (li < tb[e]) tokv[k] = list[e * 16384 + li]; } }
#pragma unroll
            for (int k = 0; k < 4; ++k) { const int idx = base + NTHREADS * k; if (idx < n) w[idx] = (unsigned)tokv[k] * lda; } }
    }
};
struct SchedMoe2 {
    const char* A; const char* B; unsigned lda, ldb; int nt; const LAS int* tb; int nM, G, c;
    __device__ __forceinline__ bool next(int i, GUnit& u) const {
        const int L = i * G + c; if (L >= nM * 4) return false;
        int pm, pn; tile_of(L, nM, 4, pm, pn); int e = 0;
#pragma unroll
        for (int j = 1; j < 8; ++j) e += (pm >= tb[8 + j]) ? 1 : 0;
        e = __builtin_amdgcn_readfirstlane(e);
        u.a = A + (size_t)pm * 256 * lda; u.b = B + (size_t)(e * 4 + pn) * 256 * ldb; u.lda = lda; u.ldb = ldb; u.nt = nt; u.pm = pm; u.pn = pn; u.z = e; return true;
    }
};

#define EPI_ROWS_BEGIN _Pragma("unroll") for (int ai = 0; ai < 2; ++ai) _Pragma("unroll") for (int m = 0; m < 4; ++m) { const int row = u.pm * BM + ai * HALF + wr * 64 + m * 16 + fr;
#define EPI_ROWS_END }
__device__ __forceinline__ u32x4 pack_f4f4(const f32x4 a, const f32x4 b) { u32x4 w; w.x = pk2(a[0], a[1]); w.y = pk2(a[2], a[3]); w.z = pk2(b[0], b[1]); w.w = pk2(b[2], b[3]); return w; }

struct EpiBf16 {
    static constexpr bool PERM = true;
    bf16* O; int ldc; int rsub;
    __device__ __forceinline__ void operator()(const f32x4 (&acc)[2][2][4][2], const GUnit& u, int wr, int wc, int fr, int fq) const {
        const int col0 = u.pn * BM + wc * 32 + 8 * fq;
        EPI_ROWS_BEGIN
            bf16* rowp = O + (size_t)(row - rsub) * ldc + col0;
#pragma unroll
            for (int bj = 0; bj < 2; ++bj) *(u32x4*)(rowp + bj * HALF) = pack_f4f4(acc[ai][bj][m][0], acc[ai][bj][m][1]);
        EPI_ROWS_END
    }
};
struct EpiF32 {
    static constexpr bool PERM = false;
    float* C; int ldc;
    __device__ __forceinline__ void operator()(const f32x4 (&acc)[2][2][4][2], const GUnit& u, int wr, int wc, int fr, int fq) const {
        const int col0 = u.pn * BM + wc * 32 + 4 * fq;
        EPI_ROWS_BEGIN
            float* rowp = C + (size_t)row * ldc + col0;
#pragma unroll
            for (int bj = 0; bj < 2; ++bj)
#pragma unroll
                for (int n = 0; n < 2; ++n) *(f32x4*)(rowp + bj * HALF + n * 16) = acc[ai][bj][m][n];
        EPI_ROWS_END
    }
};
struct EpiUq {
    static constexpr bool PERM = true;
    bf16* Qb; const float* cosB; const float* sinB; float scale;
    __device__ __forceinline__ void operator()(const f32x4 (&acc)[2][2][4][2], const GUnit& u, int wr, int wc, int fr, int fq) const {
        const bool lat = u.pm < 64;
        EPI_ROWS_BEGIN
            const int t = row & (SEQ - 1);
#pragma unroll
            for (int bj = 0; bj < 2; ++bj) {
                const int gidx = u.pn * 8 + bj * 4 + wc, head = gidx / 3, part = gidx - head * 3;
                bf16* dst = Qb + (size_t)row * 768 + head * 96 + part * 32;
                f32x4 a = acc[ai][bj][m][0] * scale, b = acc[ai][bj][m][1] * scale;
                if (part == 2) {
                    if (lat) { const f32x4 c = *(const f32x4*)(cosB + t * 16 + 4 * fq), s = *(const f32x4*)(sinB + t * 16 + 4 * fq);
                        const f32x4 x1 = a * c - b * s, x2 = a * s + b * c; a = x1; b = x2; }
                    u32x2 w0, w1; w0.x = pk2(a[0], a[1]); w0.y = pk2(a[2], a[3]); w1.x = pk2(b[0], b[1]); w1.y = pk2(b[2], b[3]);
                    *(u32x2*)(dst + 4 * fq) = w0; *(u32x2*)(dst + 16 + 4 * fq) = w1;
                } else *(u32x4*)(dst + 8 * fq) = pack_f4f4(a, b);
            }
        EPI_ROWS_END
    }
};
struct EpiUkv {
    static constexpr bool PERM = true;
    bf16* Kb; bf16* Vb;
    __device__ __forceinline__ void operator()(const f32x4 (&acc)[2][2][4][2], const GUnit& u, int wr, int wc, int fr, int fq) const {
        bf16* base = (wc < 2) ? Kb : Vb;
        EPI_ROWS_BEGIN
#pragma unroll
            for (int bj = 0; bj < 2; ++bj) { const int head = u.pn * 2 + bj;
                *(u32x4*)(base + (size_t)row * 512 + head * 64 + (wc & 1) * 32 + 8 * fq) = pack_f4f4(acc[ai][bj][m][0], acc[ai][bj][m][1]); }
        EPI_ROWS_END
    }
};
struct EpiUp {
    static constexpr bool PERM = true;
    EpiUq q; EpiUkv kv;
    __device__ __forceinline__ void operator()(const f32x4 (&acc)[2][2][4][2], const GUnit& u, int wr, int wc, int fr, int fq) const { if (u.z == 0) q(acc, u, wr, wc, fr, fq); else kv(acc, u, wr, wc, fr, fq); }
};
template <int MODE> struct EpiPair {
    static constexpr bool PERM = true;
    bf16* O; int ldc; int cbase; int rsub;
    __device__ __forceinline__ void operator()(const f32x4 (&acc)[2][2][4][2], const GUnit& u, int wr, int wc, int fr, int fq) const {
        const int col0 = cbase + u.pn * 128 + wc * 32 + 8 * fq;
        EPI_ROWS_BEGIN
            f32x4 o[2];
#pragma unroll
            for (int n = 0; n < 2; ++n)
#pragma unroll
                for (int j = 0; j < 4; ++j) { const float a = acc[ai][0][m][n][j], b = acc[ai][1][m][n][j]; o[n][j] = MODE == 0 ? a * fsigmoid(b) : fsilu(a) * b; }
            *(u32x4*)(O + (size_t)(row - rsub) * ldc + col0) = pack_f4f4(o[0], o[1]);
        EPI_ROWS_END
    }
};
struct EpiGate {
    static constexpr bool PERM = true;
    const float* bmg; u32x4* gscr; float ds;
    __device__ __forceinline__ void operator()(const f32x4 (&acc)[2][2][4][2], const GUnit& u, int wr, int wc, int fr, int fq) const {
        const int n = u.z, tid = (wr * 4 + wc) * 64 + fq * 16 + fr;
#pragma unroll
        for (int bj = 0; bj < 2; ++bj) {
            const float* bp = bmg + n * 1024 + u.pn * BM + bj * HALF + wc * 32 + 8 * fq;
            const f32x4 b0 = *(const f32x4*)bp, b1 = *(const f32x4*)(bp + 4);
#pragma unroll
            for (int ai = 0; ai < 2; ++ai)
#pragma unroll
                for (int m = 0; m < 4; ++m) { f32x4 g0 = acc[ai][bj][m][0] * ds + b0, g1 = acc[ai][bj][m][1] * ds + b1;
#pragma unroll
                    for (int j = 0; j < 4; ++j) { g0[j] = fsigmoid(g0[j]); g1[j] = fsigmoid(g1[j]); }
                    gscr[((n * 8 + (tid >> 6)) * 16 + (ai * 4 + m) * 2 + bj) * 64 + (tid & 63)] = pack_f4f4(g0, g1); asm volatile("" ::: "memory"); }
        }
    }
};
struct EpiMergeP {
    static constexpr bool PERM = true;
    bf16* M; const u32x4* gscr;
    __device__ __forceinline__ void operator()(const f32x4 (&acc)[2][2][4][2], const GUnit& u, int wr, int wc, int fr, int fq) const {
        const int n = u.z, tid = (wr * 4 + wc) * 64 + fq * 16 + fr;
        const int col0 = u.pn * BM + wc * 32 + 8 * fq;
        EPI_ROWS_BEGIN
#pragma unroll
            for (int bj = 0; bj < 2; ++bj) {
                float g[8], p[8]; unpack8(gscr[((n * 8 + (tid >> 6)) * 16 + (ai * 4 + m) * 2 + bj) * 64 + (tid & 63)], g);
                bf16* dst = M + (size_t)row * 1024 + col0 + bj * HALF;
                if (n > 0) unpack8(*(const u32x4*)dst, p);
#pragma unroll
                for (int j = 0; j < 8; ++j) { const float v = g[j] * acc[ai][bj][m][j >> 2][j & 3]; p[j] = n > 0 ? p[j] + v : v; }
                *(u32x4*)dst = pack8(p);
            }
            asm volatile("" ::: "memory");
        EPI_ROWS_END
    }
};
template <bool OUT8> struct EpiPairS {
    static constexpr bool PERM = true;
    unsigned char* O; int ldc; int rsub; float ds, os;
    __device__ __forceinline__ void operator()(const f32x4 (&acc)[2][2][4][2], const GUnit& u, int wr, int wc, int fr, int fq) const {
        const int col0 = u.pn * 128 + wc * 32 + 8 * fq;
        EPI_ROWS_BEGIN
            float o[8];
#pragma unroll
            for (int n = 0; n < 2; ++n)
#pragma unroll
                for (int j = 0; j < 4; ++j) { const float a = acc[ai][0][m][n][j] * ds, b = acc[ai][1][m][n][j]; o[4 * n + j] = fsilu(a) * b * (ds * os); }
            if constexpr (OUT8) *(u32x2*)(O + (size_t)(row - rsub) * ldc + col0) = (u32x2){pk_fp8x4(o[0], o[1], o[2], o[3]), pk_fp8x4(o[4], o[5], o[6], o[7])};
            else *(u32x4*)((bf16*)O + (size_t)(row - rsub) * ldc + col0) = pack8(o);
            asm volatile("" ::: "memory");
        EPI_ROWS_END
    }
};
struct EpiF32S {
    static constexpr bool PERM = false;
    float* C; int ldc; float ds;
    __device__ __forceinline__ void operator()(const f32x4 (&acc)[2][2][4][2], const GUnit& u, int wr, int wc, int fr, int fq) const {
        const int col0 = u.pn * BM + wc * 32 + 4 * fq;
        EPI_ROWS_BEGIN
            float* rowp = C + (size_t)row * ldc + col0;
#pragma unroll
            for (int bj = 0; bj < 2; ++bj)
#pragma unroll
                for (int n = 0; n < 2; ++n) *(f32x4*)(rowp + bj * HALF + n * 16) = acc[ai][bj][m][n] * ds;
        EPI_ROWS_END
    }
};
struct EpiBf16S {
    static constexpr bool PERM = true;
    bf16* O; int ldc; float ds;
    __device__ __forceinline__ void operator()(const f32x4 (&acc)[2][2][4][2], const GUnit& u, int wr, int wc, int fr, int fq) const {
        const int col0 = u.pn * BM + wc * 32 + 8 * fq;
        EPI_ROWS_BEGIN
            bf16* rowp = O + (size_t)row * ldc + col0;
#pragma unroll
            for (int bj = 0; bj < 2; ++bj) *(u32x4*)(rowp + bj * HALF) = pack_f4f4(acc[ai][bj][m][0] * ds, acc[ai][bj][m][1] * ds);
        EPI_ROWS_END
    }
};
#undef EPI_ROWS_BEGIN
#undef EPI_ROWS_END
}

namespace att {
__device__ __forceinline__ float swap32_max(float v) { const auto rr = __builtin_amdgcn_permlane32_swap(__float_as_uint(v), __float_as_uint(v), false, false); return __builtin_fmaxf(__uint_as_float(rr[0]), __uint_as_float(rr[1])); }
__device__ __forceinline__ float swap32_sum(float v) { const auto rr = __builtin_amdgcn_permlane32_swap(__float_as_uint(v), __float_as_uint(v), false, false); return __uint_as_float(rr[0]) + __uint_as_float(rr[1]); }
constexpr int VSLOT = 8192, NSLOT = 3;
__device__ __forceinline__ int crow(int r, int hi) { return (r & 3) + 8 * (r >> 2) + 4 * hi; }
__device__ __forceinline__ void glds16(const void* gsrc, unsigned lds_dst) { unsigned keep;
    asm volatile("s_mov_b32 %0, m0\n\ts_mov_b32 m0, %2\n\ts_nop 0\n\tglobal_load_lds_dwordx4 %1, off\n\ts_mov_b32 m0, %0" : "=&s"(keep) : "v"(gsrc), "s"(lds_dst) : "memory"); }
typedef short v4i16_t __attribute__((ext_vector_type(4)));
__device__ __forceinline__ s16x4 vtr(const LAS unsigned char* p) { return __builtin_bit_cast(s16x4, __builtin_amdgcn_ds_read_tr16_b64_v4i16((LAS v4i16_t*)p)); }

struct AttnArgs {
    const bf16* Q; int qpitch, qcol; long qrow0;
    const bf16* K1; int k1pitch, k1col;
    const bf16* K2; int k2pitch;
    const bf16* V; int vpitch, vcol;
    bf16* O; int opitch, ocol;
    int b, ntiles;
};
template <int DK> __device__ __forceinline__ void attn_unit(const AttnArgs& A, LAS unsigned char* lds, int wave_) {
    constexpr int NKS = DK / 16, KSLOT = (DK / 8) * 1024, NKSLOT = 4, NVSLOT = 4; constexpr float THR = 8.f;
    constexpr bool NOMAX = (DK == 64);
    constexpr int LDS_K = 0, LDS_V = NKSLOT * KSLOT, LDS_WS = LDS_V + NVSLOT * VSLOT;
    int tid = wave_ * 64 + lane_id(); asm volatile("" : "+v"(tid));
    const int lane = tid & 63, r32 = lane & 31, hi = lane >> 5; const int wid = __builtin_amdgcn_readfirstlane(tid >> 6);
    const unsigned lds0 = (unsigned)(uintptr_t)lds;
    LAS float* wsf = (LAS float*)(lds + LDS_WS) + wid * 64;
    const int NT = A.ntiles, b = A.b;
#define TILE_ROW(j) ((j) < 4 ? (long)(NLAT + b * CTXL + 64 * (j)) : (long)(b * SEQ + 64 * ((j) - 4)))
#define DMA_K(j) do { const long r0_ = TILE_ROW(j); const int s_ = (j) & 3; \
        glds16(A.K1 + (r0_ + lane) * A.k1pitch + A.k1col + wid * 8, (unsigned)__builtin_amdgcn_readfirstlane(lds0 + LDS_K + s_ * KSLOT + wid * 1024)); \
        if (DK == 96 && wid < 4) glds16(A.K2 + (r0_ + lane) * A.k2pitch + wid * 8, (unsigned)__builtin_amdgcn_readfirstlane(lds0 + LDS_K + s_ * KSLOT + (8 + wid) * 1024)); } while (0)
#define DMA_V(j) do { const long r0_ = TILE_ROW(j); const int s_ = (j) & 3; \
        glds16(A.V + (r0_ + 16 * (wid & 3) + (lane >> 2)) * A.vpitch + A.vcol + (wid >> 2) * 32 + (lane & 3) * 8, (unsigned)__builtin_amdgcn_readfirstlane(lds0 + LDS_V + (s_) * VSLOT + wid * 1024)); } while (0)
#define WAITBAR(n) asm volatile("s_waitcnt vmcnt(" #n ") lgkmcnt(0)\n\ts_barrier" ::: "memory")
#define WAIT_CNT(cnt) do { const int c_ = (cnt); if (c_ >= 3) WAITBAR(3); else if (c_ == 2) WAITBAR(2); else if (c_ == 1) WAITBAR(1); else WAITBAR(0); } while (0)
#define QK(S0, S1, slot) do { const LAS unsigned char* Ks_ = lds + LDS_K + (slot) * KSLOT + hi * 1024 + r32 * 16; \
        _Pragma("unroll") for (int ks = 0; ks < NKS; ++ks) { const bf16x8 k0_ = *(const LAS bf16x8*)(Ks_ + ks * 2048), k1_ = *(const LAS bf16x8*)(Ks_ + ks * 2048 + 512); \
            S0 = __builtin_amdgcn_mfma_f32_32x32x16_bf16(k0_, qr[ks], ks == 0 ? (NOMAX ? f32x16{} : negm) : S0, 0, 0, 0); S1 = __builtin_amdgcn_mfma_f32_32x32x16_bf16(k1_, qr[ks], ks == 0 ? (NOMAX ? f32x16{} : negm) : S1, 0, 0, 0); } } while (0)
    const int nK = (DK == 96 && wid < 4) ? 2 : 1;
    bf16x8 qr[NKS];
    { const bf16* Qw = A.Q + (A.qrow0 + wid * 32 + r32) * A.qpitch + A.qcol + hi * 8;
#pragma unroll
      for (int ks = 0; ks < NKS; ++ks) qr[ks] = *(const bf16x8*)(Qw + ks * 16); }
    asm volatile("s_waitcnt vmcnt(0)" ::: "memory");
    DMA_K(0); DMA_V(0); DMA_K(1); DMA_K(2); DMA_V(1);
    float mref = 0.f, lsum = 0.f; f32x16 o[2]; o[0] = f32x16{}; o[1] = f32x16{};
    f32x16 negm = f32x16{};
    const int vb = (4 * hi + ((lane & 15) >> 2)) * 64 + ((lane >> 4) & 1) * 32 + (lane & 3) * 8;
    f32x16 s0, s1;
    WAITBAR(0);
    QK(s0, s1, 0);
    if constexpr (!NOMAX) { float rm = __builtin_fmaxf(s0[0], s1[0]);
#pragma unroll
      for (int r = 1; r < 16; ++r) rm = __builtin_fmaxf(__builtin_fmaxf(rm, s0[r]), s1[r]);
      rm = swap32_max(rm); mref = rm;
#pragma unroll
      for (int r = 0; r < 16; ++r) { s0[r] -= rm; s1[r] -= rm; negm[r] = -rm; } }
    int vslot = 0;
#define HEAD(t) do { WAITBAR(0);        \
        if ((t) + 3 < NT) DMA_K((t) + 3); if ((t) + 4 < NT) DMA_K((t) + 4); \
        if ((t) + 2 < NT) DMA_V((t) + 2); if ((t) + 3 < NT) DMA_V((t) + 3); } while (0)
#define QKP(N0, N1, t) do { if ((t) + 1 < NT) { const LAS unsigned char* Ks_ = lds + LDS_K + (((t) + 1) & 3) * KSLOT + hi * 1024 + r32 * 16; \
            _Pragma("unroll") for (int kh = 0; kh < 2; ++kh) { bf16x8 kf[NKS]; \
                _Pragma("unroll") for (int k2 = 0; k2 < NKS / 2; ++k2) { const int ks = kh * (NKS / 2) + k2; kf[2 * k2] = *(const LAS bf16x8*)(Ks_ + ks * 2048); kf[2 * k2 + 1] = *(const LAS bf16x8*)(Ks_ + ks * 2048 + 512); } \
                __builtin_amdgcn_s_setprio(1); \
                _Pragma("unroll") for (int k2 = 0; k2 < NKS / 2; ++k2) { const int ks = kh * (NKS / 2) + k2; \
                    N0 = __builtin_amdgcn_mfma_f32_32x32x16_bf16(kf[2 * k2], qr[ks], ks == 0 ? (NOMAX ? f32x16{} : negm) : N0, 0, 0, 0); N1 = __builtin_amdgcn_mfma_f32_32x32x16_bf16(kf[2 * k2 + 1], qr[ks], ks == 0 ? (NOMAX ? f32x16{} : negm) : N1, 0, 0, 0); } \
                __builtin_amdgcn_s_setprio(0); } } } while (0)
#define SMP(C0, C1, N0, N1, t, NREADY) do { if constexpr (!NOMAX) { \
        float rm = __builtin_fmaxf(C0[0], C1[0]); \
        _Pragma("unroll") for (int r = 1; r < 16; ++r) rm = __builtin_fmaxf(__builtin_fmaxf(rm, C0[r]), C1[r]); \
        rm = swap32_max(rm); \
        if (__builtin_expect(__any(rm > THR), 0)) { \
            const float dl = __builtin_fmaxf(rm, 0.f), al = __builtin_amdgcn_exp2f(-dl); \
            mref += dl; lsum *= al; \
            _Pragma("unroll") for (int r = 0; r < 16; ++r) { C0[r] -= dl; C1[r] -= dl; negm[r] = -mref; } \
            if (NREADY && (t) + 1 < NT) { _Pragma("unroll") for (int r = 0; r < 16; ++r) { N0[r] -= dl; N1[r] -= dl; } } \
            if (hi == 0) wsf[r32] = al; \
            asm volatile("s_waitcnt lgkmcnt(0)" ::: "memory"); \
            _Pragma("unroll") for (int rq = 0; rq < 4; ++rq) { const f32x4 a4 = *(const LAS f32x4*)(wsf + 8 * rq + 4 * hi); \
                _Pragma("unroll") for (int j = 0; j < 4; ++j) { o[0][4 * rq + j] *= a4[j]; o[1][4 * rq + j] *= a4[j]; } } \
        } } \
        float ps0 = 0.f, ps1 = 0.f, ps2 = 0.f, ps3 = 0.f; \
        _Pragma("unroll") for (int r = 0; r < 16; r += 2) { C0[r] = __builtin_amdgcn_exp2f(C0[r]); C1[r] = __builtin_amdgcn_exp2f(C1[r]); C0[r + 1] = __builtin_amdgcn_exp2f(C0[r + 1]); C1[r + 1] = __builtin_amdgcn_exp2f(C1[r + 1]); \
            ps0 += C0[r]; ps1 += C1[r]; ps2 += C0[r + 1]; ps3 += C1[r + 1]; } \
        lsum += (ps0 + ps1) + (ps2 + ps3); \
        pw[0] = (u32x4){pk2(C0[0], C0[1]), pk2(C0[2], C0[3]), pk2(C0[4], C0[5]), pk2(C0[6], C0[7])}; \
        pw[1] = (u32x4){pk2(C0[8], C0[9]), pk2(C0[10], C0[11]), pk2(C0[12], C0[13]), pk2(C0[14], C0[15])}; \
        pw[2] = (u32x4){pk2(C1[0], C1[1]), pk2(C1[2], C1[3]), pk2(C1[4], C1[5]), pk2(C1[6], C1[7])}; \
        pw[3] = (u32x4){pk2(C1[8], C1[9]), pk2(C1[10], C1[11]), pk2(C1[12], C1[13]), pk2(C1[14], C1[15])}; } while (0)
#define PVP() do { const LAS unsigned char* Vs = lds + LDS_V + vslot * VSLOT + vb; \
        _Pragma("unroll") for (int d0 = 0; d0 < 2; ++d0) { s16x4 vlo[4], vhh[4]; \
            _Pragma("unroll") for (int i = 0; i < 4; ++i) { vlo[i] = vtr(Vs + d0 * 4096 + i * 1024); vhh[i] = vtr(Vs + d0 * 4096 + i * 1024 + 512); } \
            __builtin_amdgcn_s_setprio(1); \
            _Pragma("unroll") for (int ks = 0; ks < 4; ++ks) { \
                const bf16x8 vf = (bf16x8){vlo[ks][0], vlo[ks][1], vlo[ks][2], vlo[ks][3], vhh[ks][0], vhh[ks][1], vhh[ks][2], vhh[ks][3]}; \
                o[d0] = __builtin_amdgcn_mfma_f32_32x32x16_bf16(__builtin_bit_cast(bf16x8, pw[ks]), vf, o[d0], 0, 0, 0); } \
            __builtin_amdgcn_s_setprio(0); } \
        vslot = (vslot + 1) & 3; } while (0)
    f32x16 n0, n1; u32x4 pw[4];
    if (wid < 8) {
        for (int t = 0; t < NT; t += 2) {
            HEAD(t); QKP(n0, n1, t); SMP(s0, s1, n0, n1, t, 1); PVP();
            QKP(s0, s1, t + 1); SMP(n0, n1, s0, s1, t + 1, 1); PVP(); }
    } else {
        for (int t = 0; t < NT; t += 2) {
            HEAD(t); SMP(s0, s1, n0, n1, t, 0); PVP(); QKP(n0, n1, t);
            SMP(n0, n1, s0, s1, t + 1, 0); PVP(); QKP(s0, s1, t + 1); }
    }
#undef HEAD
#undef QKP
#undef SMP
#undef PVP
    lsum = swap32_sum(lsum);
    if (hi == 0) wsf[32 + r32] = __builtin_amdgcn_rcpf(lsum);
    asm volatile("s_waitcnt vmcnt(0) lgkmcnt(0)\n\ts_barrier" ::: "memory");
    { LAS bf16* stg = (LAS bf16*)(lds + wid * 4096);
#pragma unroll
      for (int rq = 0; rq < 4; ++rq) { const f32x4 i4 = *(const LAS f32x4*)(wsf + 32 + 8 * rq + 4 * hi);
#pragma unroll
          for (int j = 0; j < 4; ++j) { const int q = 8 * rq + 4 * hi + j;
              stg[q * 64 + r32] = (bf16)f2bf(o[0][4 * rq + j] * i4[j]); stg[q * 64 + 32 + r32] = (bf16)f2bf(o[1][4 * rq + j] * i4[j]); } }
      asm volatile("s_waitcnt lgkmcnt(0)" ::: "memory");
      bf16* Ow = A.O + (A.qrow0 + wid * 32) * A.opitch + A.ocol;
#pragma unroll
      for (int i = 0; i < 4; ++i) { const int row = i * 8 + (lane >> 3), ch = lane & 7; *(u32x4*)(Ow + (long)row * A.opitch + ch * 8) = *(const LAS u32x4*)(stg + row * 64 + ch * 8); } }
    asm volatile("s_waitcnt vmcnt(0) lgkmcnt(0)\n\ts_barrier" ::: "memory");
#undef TILE_ROW
#undef DMA_K
#undef DMA_V
#undef WAITBAR
#undef WAIT_CNT
#undef QK
}

template <int DK> __device__ __forceinline__ void attn_unit3(const AttnArgs& A, LAS unsigned char* lds, int wave_) {
    constexpr int NKS = DK / 16, KSLOT = (DK / 8) * 1024, NKSLOT = 4, NVSLOT = 4;
    constexpr int LDS_K = 0, LDS_V = NKSLOT * KSLOT, LDS_WS = LDS_V + NVSLOT * VSLOT;
    int tid = wave_ * 64 + lane_id(); asm volatile("" : "+v"(tid));
    const int lane = tid & 63, r32 = lane & 31, hi = lane >> 5; const int wid = __builtin_amdgcn_readfirstlane(tid >> 6);
    const unsigned lds0 = (unsigned)(uintptr_t)lds;
    LAS float* wsf = (LAS float*)(lds + LDS_WS) + wid * 64;
    const int NT = A.ntiles, b = A.b;
#define TILE_ROW(j) ((j) < 4 ? (long)(NLAT + b * CTXL + 64 * (j)) : (long)(b * SEQ + 64 * ((j) - 4)))
#define DMA_K(j) do { const long r0_ = TILE_ROW(j); const int s_ = (j) & 3; \
        glds16(A.K1 + (r0_ + lane) * A.k1pitch + A.k1col + wid * 8, (unsigned)__builtin_amdgcn_readfirstlane(lds0 + LDS_K + s_ * KSLOT + wid * 1024)); \
        if (DK == 96 && wid < 4) glds16(A.K2 + (r0_ + lane) * A.k2pitch + wid * 8, (unsigned)__builtin_amdgcn_readfirstlane(lds0 + LDS_K + s_ * KSLOT + (8 + wid) * 1024)); } while (0)
#define DMA_V(j) do { const long r0_ = TILE_ROW(j); const int s_ = (j) & 3; \
        glds16(A.V + (r0_ + 16 * (wid & 3) + (lane >> 2)) * A.vpitch + A.vcol + (wid >> 2) * 32 + (lane & 3) * 8, (unsigned)__builtin_amdgcn_readfirstlane(lds0 + LDS_V + (s_) * VSLOT + wid * 1024)); } while (0)
#define WAITBAR(n) asm volatile("s_waitcnt vmcnt(" #n ") lgkmcnt(0)\n\ts_barrier" ::: "memory")
    bf16x8 qr[NKS];
    { const bf16* Qw = A.Q + (A.qrow0 + wid * 32 + r32) * A.qpitch + A.qcol + hi * 8;
#pragma unroll
      for (int ks = 0; ks < NKS; ++ks) qr[ks] = *(const bf16x8*)(Qw + ks * 16); }
    asm volatile("s_waitcnt vmcnt(0)" ::: "memory");
    DMA_K(0); DMA_K(1); DMA_V(0); DMA_K(2); DMA_K(3); DMA_V(1);
    float ls0 = 0.f, ls1 = 0.f, ls2 = 0.f, ls3 = 0.f; f32x16 o[2]; o[0] = f32x16{}; o[1] = f32x16{};
    const int vb = (4 * hi + ((lane & 15) >> 2)) * 64 + ((lane >> 4) & 1) * 32 + (lane & 3) * 8;
    const LAS unsigned char* Kb = lds + LDS_K + hi * 1024 + r32 * 16;
    const LAS unsigned char* Vb = lds + LDS_V + vb;
#define QKH(S0, S1, j, kh) do { const LAS unsigned char* Ks_ = Kb + ((j) & 3) * KSLOT; bf16x8 kf[NKS]; \
        _Pragma("unroll") for (int k2 = 0; k2 < NKS / 2; ++k2) { const int ks = (kh) * (NKS / 2) + k2; kf[2 * k2] = *(const LAS bf16x8*)(Ks_ + ks * 2048); kf[2 * k2 + 1] = *(const LAS bf16x8*)(Ks_ + ks * 2048 + 512); } \
        _Pragma("unroll") for (int k2 = 0; k2 < NKS / 2; ++k2) { const int ks = (kh) * (NKS / 2) + k2; \
            S0 = __builtin_amdgcn_mfma_f32_32x32x16_bf16(kf[2 * k2], qr[ks], ks == 0 ? f32x16{} : S0, 0, 0, 0); S1 = __builtin_amdgcn_mfma_f32_32x32x16_bf16(kf[2 * k2 + 1], qr[ks], ks == 0 ? f32x16{} : S1, 0, 0, 0); } } while (0)
#define PVH(PW, j, d0) do { const LAS unsigned char* Vs_ = Vb + ((j) & 3) * VSLOT + (d0) * 4096; s16x4 vlo[4], vhh[4]; \
        _Pragma("unroll") for (int i = 0; i < 4; ++i) { vlo[i] = vtr(Vs_ + i * 1024); vhh[i] = vtr(Vs_ + i * 1024 + 512); } \
        _Pragma("unroll") for (int ks = 0; ks < 4; ++ks) { const bf16x8 vf = (bf16x8){vlo[ks][0], vlo[ks][1], vlo[ks][2], vlo[ks][3], vhh[ks][0], vhh[ks][1], vhh[ks][2], vhh[ks][3]}; \
            o[d0] = __builtin_amdgcn_mfma_f32_32x32x16_bf16(__builtin_bit_cast(bf16x8, PW[ks]), vf, o[d0], 0, 0, 0); } } while (0)
#define SOFT(C0, C1, PW) do { \
        _Pragma("unroll") for (int r = 0; r < 16; r += 2) { C0[r] = __builtin_amdgcn_exp2f(C0[r]); C1[r] = __builtin_amdgcn_exp2f(C1[r]); C0[r + 1] = __builtin_amdgcn_exp2f(C0[r + 1]); C1[r + 1] = __builtin_amdgcn_exp2f(C1[r + 1]); \
            ls0 += C0[r]; ls1 += C1[r]; ls2 += C0[r + 1]; ls3 += C1[r + 1]; } \
        PW[0] = (u32x4){pk2(C0[0], C0[1]), pk2(C0[2], C0[3]), pk2(C0[4], C0[5]), pk2(C0[6], C0[7])}; \
        PW[1] = (u32x4){pk2(C0[8], C0[9]), pk2(C0[10], C0[11]), pk2(C0[12], C0[13]), pk2(C0[14], C0[15])}; \
        PW[2] = (u32x4){pk2(C1[0], C1[1]), pk2(C1[2], C1[3]), pk2(C1[4], C1[5]), pk2(C1[6], C1[7])}; \
        PW[3] = (u32x4){pk2(C1[8], C1[9]), pk2(C1[10], C1[11]), pk2(C1[12], C1[13]), pk2(C1[14], C1[15])}; } while (0)
#define HINTS() do { _Pragma("unroll") for (int h_ = 0; h_ < 2; ++h_) { __builtin_amdgcn_sched_group_barrier(0x100, NKS + 8, 0); \
            _Pragma("unroll") for (int g_ = 0; g_ < NKS + 4; ++g_) { __builtin_amdgcn_sched_group_barrier(0x008, 1, 0); __builtin_amdgcn_sched_group_barrier(0x400, 2, 0); __builtin_amdgcn_sched_group_barrier(0x002, 3, 0); } } } while (0)
#define STEP3(N0, N1, C0, C1, PN, PC, t) do { __builtin_amdgcn_sched_barrier(0); \
        QKH(N0, N1, (t) + 2, 0); PVH(PC, t, 0); QKH(N0, N1, (t) + 2, 1); PVH(PC, t, 1); SOFT(C0, C1, PN); HINTS(); __builtin_amdgcn_sched_barrier(0); } while (0)
    f32x16 sA0, sA1, sB0, sB1; u32x4 pA[4], pB[4];
    WAITBAR(0);
    QKH(sA0, sA1, 0, 0); QKH(sA0, sA1, 0, 1); QKH(sB0, sB1, 1, 0); QKH(sB0, sB1, 1, 1);
    SOFT(sA0, sA1, pA);
    int t = 0;
    for (; t + 3 < NT; t += 2) {
        WAITBAR(0);
        if (t + 4 < NT) DMA_K(t + 4); if (t + 5 < NT) DMA_K(t + 5); if (t + 2 < NT) DMA_V(t + 2); if (t + 3 < NT) DMA_V(t + 3);
        STEP3(sA0, sA1, sB0, sB1, pB, pA, t);
        STEP3(sB0, sB1, sA0, sA1, pA, pB, t + 1);
    }
    WAITBAR(0);
    __builtin_amdgcn_sched_barrier(0);
    PVH(pA, t, 0); PVH(pA, t, 1); SOFT(sB0, sB1, pB);
    __builtin_amdgcn_sched_barrier(0);
    PVH(pB, t + 1, 0); PVH(pB, t + 1, 1);
    float lsum = (ls0 + ls1) + (ls2 + ls3);
    lsum = swap32_sum(lsum);
    if (hi == 0) wsf[32 + r32] = __builtin_amdgcn_rcpf(lsum);
    asm volatile("s_waitcnt vmcnt(0) lgkmcnt(0)\n\ts_barrier" ::: "memory");
    { LAS bf16* stg = (LAS bf16*)(lds + wid * 4096);
#pragma unroll
      for (int rq = 0; rq < 4; ++rq) { const f32x4 i4 = *(const LAS f32x4*)(wsf + 32 + 8 * rq + 4 * hi);
#pragma unroll
          for (int j = 0; j < 4; ++j) { const int q = 8 * rq + 4 * hi + j;
              stg[q * 64 + r32] = (bf16)f2bf(o[0][4 * rq + j] * i4[j]); stg[q * 64 + 32 + r32] = (bf16)f2bf(o[1][4 * rq + j] * i4[j]); } }
      asm volatile("s_waitcnt lgkmcnt(0)" ::: "memory");
      bf16* Ow = A.O + (A.qrow0 + wid * 32) * A.opitch + A.ocol;
#pragma unroll
      for (int i = 0; i < 4; ++i) { const int row = i * 8 + (lane >> 3), ch = lane & 7; *(u32x4*)(Ow + (long)row * A.opitch + ch * 8) = *(const LAS u32x4*)(stg + row * 64 + ch * 8); } }
    asm volatile("s_waitcnt vmcnt(0) lgkmcnt(0)\n\ts_barrier" ::: "memory");
#undef TILE_ROW
#undef DMA_K
#undef DMA_V
#undef WAITBAR
#undef QKH
#undef PVH
#undef SOFT
#undef HINTS
#undef STEP3
}

#define ASBAR() __builtin_amdgcn_sched_barrier(0)
#define APIN(x) asm volatile("" : "+v"(x))
template <int DK> __device__ __forceinline__ void attn_unit4(const AttnArgs& A, LAS unsigned char* lds, int wave_) {
    constexpr int NKS = DK / 16, KSLOT = (DK / 8) * 1024, NKSLOT = 4, NVSLOT = 4;
    constexpr int LDS_K = 0, LDS_V = NKSLOT * KSLOT, LDS_WS = LDS_V + NVSLOT * VSLOT;
    int tid = wave_ * 64 + lane_id(); asm volatile("" : "+v"(tid));
    const int lane = tid & 63, r32 = lane & 31, hi = lane >> 5; const int wid = __builtin_amdgcn_readfirstlane(tid >> 6);
    const unsigned lds0 = (unsigned)(uintptr_t)lds;
    LAS float* wsf = (LAS float*)(lds + LDS_WS) + wid * 64;
    const int NT = A.ntiles, b = A.b;
#define TILE_ROW(j) ((j) < 4 ? (long)(NLAT + b * CTXL + 64 * (j)) : (long)(b * SEQ + 64 * ((j) - 4)))
#define DMA_K(j) do { const long r0_ = TILE_ROW(j); const int s_ = (j) & 3; \
        glds16(A.K1 + (r0_ + lane) * A.k1pitch + A.k1col + wid * 8, (unsigned)__builtin_amdgcn_readfirstlane(lds0 + LDS_K + s_ * KSLOT + wid * 1024)); \
        if (DK == 96 && wid < 4) glds16(A.K2 + (r0_ + lane) * A.k2pitch + wid * 8, (unsigned)__builtin_amdgcn_readfirstlane(lds0 + LDS_K + s_ * KSLOT + (8 + wid) * 1024)); } while (0)
#define DMA_V(j) do { const long r0_ = TILE_ROW(j); const int s_ = (j) & 3; \
        glds16(A.V + (r0_ + 16 * (wid & 3) + (lane >> 2)) * A.vpitch + A.vcol + (wid >> 2) * 32 + (lane & 3) * 8, (unsigned)__builtin_amdgcn_readfirstlane(lds0 + LDS_V + (s_) * VSLOT + wid * 1024)); } while (0)
#define WAITBAR(n) asm volatile("s_waitcnt vmcnt(" #n ") lgkmcnt(0)\n\ts_barrier" ::: "memory")
    bf16x8 qr[NKS];
    { const bf16* Qw = A.Q + (A.qrow0 + wid * 32 + r32) * A.qpitch + A.qcol + hi * 8;
#pragma unroll
      for (int ks = 0; ks < NKS; ++ks) qr[ks] = *(const bf16x8*)(Qw + ks * 16); }
    DMA_K(0); DMA_K(1); DMA_V(0); DMA_K(2); DMA_K(3); DMA_V(1);
    float lsum = 0.f; f32x16 o[2]; o[0] = f32x16{}; o[1] = f32x16{};
    const LAS unsigned char* Kb = lds + LDS_K + hi * 1024 + r32 * 16;
    const LAS unsigned char* Vb = lds + LDS_V + (4 * hi + ((lane & 15) >> 2)) * 64 + ((lane >> 4) & 1) * 32 + (lane & 3) * 8;
    f32x16 pA0, pA1, pB0, pB1; bf16x8 kf[2 * NKS]; s16x4 vlo[8], vhi[8]; u32x4 pw0, pw1, pw2, pw3;
#define MF(a, b, c) __builtin_amdgcn_mfma_f32_32x32x16_bf16(a, b, c, 0, 0, 0)
#define KLD2(kp, d0) do { kf[2 * (d0)] = *(const LAS bf16x8*)((kp) + (d0) * 2048); kf[2 * (d0) + 1] = *(const LAS bf16x8*)((kp) + (d0) * 2048 + 512); } while (0)
#define PKW(P, i) pk2(P[i], P[(i) + 1])
#define PAF(k) __builtin_bit_cast(bf16x8, pw##k)
#define VFR(i) (bf16x8){vlo[i][0], vlo[i][1], vlo[i][2], vlo[i][3], vhi[i][0], vhi[i][1], vhi[i][2], vhi[i][3]}
#define VRD(i) do { vlo[i] = vtr(vp_ + (((i) >> 2) * 4096 + ((i) & 3) * 1024)); vhi[i] = vtr(vp_ + (((i) >> 2) * 4096 + ((i) & 3) * 1024 + 512)); } while (0)
#define KRD(G, d0) do { if (G) { KLD2(kn_, d0); ASBAR(); } } while (0)
#define EX(v) __builtin_amdgcn_exp2f(v)
#define GAPA(MFS, a0, a1, a2, a3, W0, W1, PW) do { MFS; sacc += a0; sacc += a1; sacc += a2; sacc += a3; W0; W1; APIN(PW); APIN(sacc); ASBAR(); } while (0)
#define GAPB(MFS, X, i) do { MFS; X[i] = EX(X[i]); X[(i) + 1] = EX(X[(i) + 1]); X[(i) + 2] = EX(X[(i) + 2]); X[(i) + 3] = EX(X[(i) + 3]); APIN(X); ASBAR(); } while (0)
#define STEP4(C0, C1, P0, P1, t, GL) do { ASBAR(); \
    const LAS unsigned char* vp_ = Vb + (((t) - 1) & 3) * VSLOT; const LAS unsigned char* kn_ = Kb + (((t) + 1) & 3) * KSLOT; \
    VRD(0); ASBAR(); float sacc = P0[0] + P0[1]; \
                     GAPA(C0 = MF(kf[0], qr[0], f32x16{}), P0[2], P0[3], P0[4], P0[5],     pw0[0] = PKW(P0, 0),  pw0[1] = PKW(P0, 2),  pw0); \
    VRD(4); ASBAR(); GAPA(C1 = MF(kf[1], qr[0], f32x16{}), P0[6], P0[7], P0[8], P0[9],     pw0[2] = PKW(P0, 4),  pw0[3] = PKW(P0, 6),  pw0); \
    VRD(1); ASBAR(); GAPA(C0 = MF(kf[2], qr[1], C0),       P0[10], P0[11], P0[12], P0[13], pw1[0] = PKW(P0, 8),  pw1[1] = PKW(P0, 10), pw1); \
    VRD(5); ASBAR(); GAPA(C1 = MF(kf[3], qr[1], C1),       P0[14], P0[15], P1[0], P1[1],   pw1[2] = PKW(P0, 12), pw1[3] = PKW(P0, 14), pw1); \
    VRD(2); ASBAR(); GAPA(C0 = MF(kf[4], qr[2], C0),       P1[2], P1[3], P1[4], P1[5],     pw2[0] = PKW(P1, 0),  pw2[1] = PKW(P1, 2),  pw2); \
    VRD(6); ASBAR(); GAPA(C1 = MF(kf[5], qr[2], C1),       P1[6], P1[7], P1[8], P1[9],     pw2[2] = PKW(P1, 4),  pw2[3] = PKW(P1, 6),  pw2); \
    VRD(3); ASBAR(); GAPA(C0 = MF(kf[6], qr[3], C0),       P1[10], P1[11], P1[12], P1[13], pw3[0] = PKW(P1, 8),  pw3[1] = PKW(P1, 10), pw3); \
    VRD(7); ASBAR(); GAPA(C1 = MF(kf[7], qr[3], C1),       P1[14], P1[15], 0.f, 0.f,       pw3[2] = PKW(P1, 12), pw3[3] = PKW(P1, 14), pw3); \
    if (NKS == 6) { C0 = MF(kf[2 * (NKS - 2)], qr[NKS - 2], C0); C1 = MF(kf[2 * (NKS - 2) + 1], qr[NKS - 2], C1); C0 = MF(kf[2 * (NKS - 1)], qr[NKS - 1], C0); C1 = MF(kf[2 * (NKS - 1) + 1], qr[NKS - 1], C1); ASBAR(); } \
    lsum += sacc; ASBAR(); \
    GAPB(o[0] = MF(PAF(0), VFR(0), o[0]), C0, 0);               KRD((GL) && NKS == 6, 4); GAPB(o[1] = MF(PAF(0), VFR(4), o[1]), C0, 4); \
    KRD(GL, 0); GAPB(o[0] = MF(PAF(1), VFR(1), o[0]), C0, 8);   KRD(GL, 1); GAPB(o[1] = MF(PAF(1), VFR(5), o[1]), C0, 12); \
    KRD(GL, 2); GAPB(o[0] = MF(PAF(2), VFR(2), o[0]), C1, 0);   KRD(GL, 3); GAPB(o[1] = MF(PAF(2), VFR(6), o[1]), C1, 4); \
    KRD((GL) && NKS == 6, 5); GAPB(o[0] = MF(PAF(3), VFR(3), o[0]), C1, 8);   GAPB(o[1] = MF(PAF(3), VFR(7), o[1]), C1, 12); \
    } while (0)
    WAITBAR(0);
#pragma unroll
    for (int d0 = 0; d0 < NKS; ++d0) KLD2(Kb, d0);
#pragma unroll
    for (int d0 = 0; d0 < NKS; ++d0) { pA0 = MF(kf[2 * d0], qr[d0], d0 == 0 ? f32x16{} : pA0); pA1 = MF(kf[2 * d0 + 1], qr[d0], d0 == 0 ? f32x16{} : pA1); }
#pragma unroll
    for (int r = 0; r < 16; ++r) { pA0[r] = EX(pA0[r]); pA1[r] = EX(pA1[r]); }
#pragma unroll
    for (int d0 = 0; d0 < NKS; ++d0) KLD2(Kb + KSLOT, d0);
    int t = 1;
    for (; t + 2 < NT; t += 2) {
        WAITBAR(0);
        if (t + 3 < NT) DMA_K(t + 3); if (t + 4 < NT) DMA_K(t + 4); if (t + 1 < NT) DMA_V(t + 1); if (t + 2 < NT) DMA_V(t + 2);
        STEP4(pB0, pB1, pA0, pA1, t, true);
        STEP4(pA0, pA1, pB0, pB1, t + 1, true);
    }
    WAITBAR(0);
    STEP4(pB0, pB1, pA0, pA1, t, false);
    { ASBAR(); float sacc = pB0[0] + pB0[1];
#pragma unroll
      for (int r = 2; r < 16; ++r) sacc += pB0[r];
#pragma unroll
      for (int r = 0; r < 16; ++r) sacc += pB1[r];
      lsum += sacc;
      pw0 = (u32x4){PKW(pB0, 0), PKW(pB0, 2), PKW(pB0, 4), PKW(pB0, 6)}; pw1 = (u32x4){PKW(pB0, 8), PKW(pB0, 10), PKW(pB0, 12), PKW(pB0, 14)};
      pw2 = (u32x4){PKW(pB1, 0), PKW(pB1, 2), PKW(pB1, 4), PKW(pB1, 6)}; pw3 = (u32x4){PKW(pB1, 8), PKW(pB1, 10), PKW(pB1, 12), PKW(pB1, 14)};
      const LAS unsigned char* vp_ = Vb + (t & 3) * VSLOT;
#pragma unroll
      for (int i = 0; i < 8; ++i) VRD(i);
      o[0] = MF(PAF(0), VFR(0), o[0]); o[1] = MF(PAF(0), VFR(4), o[1]); o[0] = MF(PAF(1), VFR(1), o[0]); o[1] = MF(PAF(1), VFR(5), o[1]);
      o[0] = MF(PAF(2), VFR(2), o[0]); o[1] = MF(PAF(2), VFR(6), o[1]); o[0] = MF(PAF(3), VFR(3), o[0]); o[1] = MF(PAF(3), VFR(7), o[1]); }
    lsum = swap32_sum(lsum);
    if (hi == 0) wsf[32 + r32] = __builtin_amdgcn_rcpf(lsum);
    asm volatile("s_waitcnt vmcnt(0) lgkmcnt(0)\n\ts_barrier" ::: "memory");
    { LAS bf16* stg = (LAS bf16*)(lds + wid * 4096);
#pragma unroll
      for (int rq = 0; rq < 4; ++rq) { const f32x4 i4 = *(const LAS f32x4*)(wsf + 32 + 8 * rq + 4 * hi);
#pragma unroll
          for (int j = 0; j < 4; ++j) { const int q = 8 * rq + 4 * hi + j;
              stg[q * 64 + r32] = (bf16)f2bf(o[0][4 * rq + j] * i4[j]); stg[q * 64 + 32 + r32] = (bf16)f2bf(o[1][4 * rq + j] * i4[j]); } }
      asm volatile("s_waitcnt lgkmcnt(0)" ::: "memory");
      bf16* Ow = A.O + (A.qrow0 + wid * 32) * A.opitch + A.ocol;
#pragma unroll
      for (int i = 0; i < 4; ++i) { const int row = i * 8 + (lane >> 3), ch = lane & 7; *(u32x4*)(Ow + (long)row * A.opitch + ch * 8) = *(const LAS u32x4*)(stg + row * 64 + ch * 8); } }
    asm volatile("s_waitcnt vmcnt(0) lgkmcnt(0)\n\ts_barrier" ::: "memory");
#undef TILE_ROW
#undef DMA_K
#undef DMA_V
#undef WAITBAR
#undef MF
#undef KLD2
#undef PKW
#undef PAF
#undef VFR
#undef VRD
#undef KRD
#undef EX
#undef GAPA
#undef GAPB
#undef STEP4
}
#undef ASBAR
#undef APIN
}

namespace s5 {
constexpr int NCH = LPOS / 16;
constexpr int M_MC = 0, M_WCF = 65536, M_WCB = 65536 + 32768, M_WSF = 131072, M_WSB = 131072 + 32768, M_TOTAL = 196608;
constexpr int LDS_E = 18 * 4096;

struct Params { const float *lam_re, *lam_im, *log_dt, *b_re, *b_im, *c_re, *c_im, *dsk; };

__device__ __forceinline__ void build_mats(const Params& P, int l, int g, bf16* out, LAS unsigned char* lds, int wave_) {
    LAS f32x2* apow = (LAS f32x2*)lds;
    LAS f32x2* Bb = apow + 2 * 64 * 17;
    LAS f32x2* Cc = Bb + 2 * 64 * 16;
    LAS float* Kt = (LAS float*)(Cc + 2 * 16 * 64);
    constexpr int KTL = 260, KTD = 16 * KTL;
    const int tid = wave_ * 64 + lane_id();
    LAS float* lamv = Kt + 2 * KTD;
    LAS float* dskv = lamv + 512;
    f32x2 cv[4], bv[4];
#pragma unroll
    for (int m = 0; m < 4; ++m) { const int i = tid + NTHREADS * m; { const int dir = i >> 10, hp = (i >> 6) & 15, p = i & 63; const size_t ci = ((size_t)((l * 2 + dir) * 32 + g) * 16 + hp) * 64 + p; cv[m] = (f32x2){P.c_re[ci], P.c_im[ci]}; }
        { const int dir = i >> 10, p = (i >> 4) & 63, h = i & 15, pi = ((l * 2 + dir) * 32 + g) * 64 + p; bv[m] = (f32x2){P.b_re[(size_t)pi * 16 + h], P.b_im[(size_t)pi * 16 + h]}; } }
    if (tid < 128) { const int dir = tid >> 6, p = tid & 63, pi = ((l * 2 + dir) * 32 + g) * 64 + p;
        lamv[4 * tid] = fminf(P.lam_re[pi], -1e-4f); lamv[4 * tid + 1] = P.lam_im[pi]; lamv[4 * tid + 2] = expf(P.log_dt[(l * 2 + dir) * 32 + g]); }
    else if (tid < 144) dskv[tid - 128] = P.dsk[(l * 32 + g) * 16 + tid - 128];
#pragma unroll
    for (int m = 0; m < 4; ++m) Cc[tid + NTHREADS * m] = cv[m];
    __syncthreads();
    for (int i = tid; i < 2 * 64 * 17; i += NTHREADS) {
        const int dir = i / (64 * 17), r = i - dir * (64 * 17), p = r / 17, j = r - p * 17;
        const float lr = lamv[4 * (dir * 64 + p)], li = lamv[4 * (dir * 64 + p) + 1], dt = lamv[4 * (dir * 64 + p) + 2];
        const float mag = expf((float)j * lr * dt), ang = (float)j * li * dt; apow[i] = (f32x2){mag * cosf(ang), mag * sinf(ang)}; }
#pragma unroll
    for (int m = 0; m < 4; ++m) {
        const int i = tid + NTHREADS * m, dir = i >> 10, p = (i >> 4) & 63;
        const float lr = lamv[4 * (dir * 64 + p)], li = lamv[4 * (dir * 64 + p) + 1], dt = lamv[4 * (dir * 64 + p) + 2];
        const float abr = expf(lr * dt) * cosf(li * dt), abi = expf(lr * dt) * sinf(li * dt), den = lr * lr + li * li;
        const float fr = ((abr - 1.0f) * lr + abi * li) / den, fi = (abi * lr - (abr - 1.0f) * li) / den;
        const float br = bv[m].x, bi = bv[m].y; Bb[i] = (f32x2){fr * br - fi * bi, fr * bi + fi * br}; }
    __syncthreads();
    {
        const int dir = tid >> 8, j = (tid >> 4) & 15, hp0 = ((tid >> 2) & 3) * 4, h0 = (tid & 3) * 4; float sacc[4][4];
#pragma unroll
        for (int x = 0; x < 4; ++x)
#pragma unroll
            for (int y = 0; y < 4; ++y) sacc[x][y] = 0.f;
        for (int p = 0; p < 64; ++p) { const f32x2 a = apow[(dir * 64 + p) * 17 + j];
            const f32x2 c0_ = Cc[(dir * 16 + hp0) * 64 + p], c1_ = Cc[(dir * 16 + hp0 + 1) * 64 + p], c2_ = Cc[(dir * 16 + hp0 + 2) * 64 + p], c3_ = Cc[(dir * 16 + hp0 + 3) * 64 + p];
            const f32x4 c01 = {c0_.x, c0_.y, c1_.x, c1_.y}, c23 = {c2_.x, c2_.y, c3_.x, c3_.y};
            const f32x4 b01 = *(const LAS f32x4*)(Bb + (dir * 64 + p) * 16 + h0), b23 = *(const LAS f32x4*)(Bb + (dir * 64 + p) * 16 + h0 + 2);
            const float cx[4] = {c01[0], c01[2], c23[0], c23[2]}, cy[4] = {c01[1], c01[3], c23[1], c23[3]}, bx[4] = {b01[0], b01[2], b23[0], b23[2]}, by[4] = {b01[1], b01[3], b23[1], b23[3]};
#pragma unroll
            for (int x = 0; x < 4; ++x) { const float tr = cx[x] * a.x - cy[x] * a.y, ti = cx[x] * a.y + cy[x] * a.x;
#pragma unroll
                for (int y = 0; y < 4; ++y) sacc[x][y] += tr * bx[y] - ti * by[y]; } }
#pragma unroll
        for (int x = 0; x < 4; ++x) *(LAS f32x4*)(Kt + dir * KTD + j * KTL + (hp0 + x) * 16 + h0) = (f32x4){sacc[x][0], sacc[x][1], sacc[x][2], sacc[x][3]};
    }
    __syncthreads();
#pragma unroll 4
    for (int i = tid; i < 65536 / 8; i += NTHREADS) {
        const int row = i >> 5, c0 = (i & 31) * 8, t = row >> 4, hp = row & 15, s = c0 >> 4, h0 = c0 & 15; float v[8];
        const int lf = s <= t ? t - s : 0, lb = s >= t ? s - t : 0;
        const f32x4 f0 = *(const LAS f32x4*)(Kt + lf * KTL + hp * 16 + h0), f1 = *(const LAS f32x4*)(Kt + lf * KTL + hp * 16 + h0 + 4);
        const f32x4 b0 = *(const LAS f32x4*)(Kt + KTD + lb * KTL + hp * 16 + h0), b1 = *(const LAS f32x4*)(Kt + KTD + lb * KTL + hp * 16 + h0 + 4);
        const float wf = s <= t ? 1.f : 0.f, wb = s >= t ? 1.f : 0.f;
#pragma unroll
        for (int e = 0; e < 8; ++e) { const int h = h0 + e; float x = 0.f;
            if (s <= t) x += (e < 4 ? f0[e & 3] : f1[e & 3]);
            if (s >= t) x += (e < 4 ? b0[e & 3] : b1[e & 3]);
            if (s == t && h == hp) x += dskv[h];
            v[e] = x; }
        (void)wf; (void)wb;
        *(u32x4*)(out + M_MC + (size_t)row * 256 + c0) = pack8(v);
    }
#pragma unroll 4
    for (int i = tid; i < 2 * 32768 / 8; i += NTHREADS) {
        const int dir = i >> 12, ii = i & 4095, row = ii >> 4, c0 = (ii & 15) * 8, t = row >> 4, hp = row & 15, ex = dir == 0 ? t + 1 : 16 - t; float v[8];
#pragma unroll
        for (int e = 0; e < 8; e += 2) { const int p = (c0 + e) >> 1; const f32x2 c = Cc[(dir * 16 + hp) * 64 + p], a = apow[(dir * 64 + p) * 17 + ex];
            v[e] = c.x * a.x - c.y * a.y; v[e + 1] = -(c.x * a.y + c.y * a.x); }
        *(u32x4*)(out + (dir == 0 ? M_WCF : M_WCB) + (size_t)row * 128 + c0) = pack8(v);
    }
#pragma unroll 4
    for (int i = tid; i < 2 * 32768 / 8; i += NTHREADS) {
        const int dir = i >> 12, ii = i & 4095, row = ii >> 5, c0 = (ii & 31) * 8, p = row >> 1, im = row & 1, s = c0 >> 4, h0 = c0 & 15, ex = dir == 0 ? 15 - s : s; float v[8];
        const f32x2 a = apow[(dir * 64 + p) * 17 + ex];
#pragma unroll
        for (int e = 0; e < 8; ++e) { const f32x2 bb = Bb[(dir * 64 + p) * 16 + h0 + e]; v[e] = im ? (a.x * bb.y + a.y * bb.x) : (a.x * bb.x - a.y * bb.y); }
        *(u32x4*)(out + (dir == 0 ? M_WSF : M_WSB) + (size_t)row * 256 + c0) = pack8(v);
    }
    __syncthreads();
}

__device__ __forceinline__ void build_a16(const Params& P, float* a16, int gt, int ngt) {
    for (int pi = gt; pi < 2 * 2 * 32 * 64; pi += ngt) {
        const float lr = fminf(P.lam_re[pi], -1e-4f), li = P.lam_im[pi], dt = expf(P.log_dt[pi >> 6]);
        const float mag = expf(16.f * lr * dt), ang = 16.f * li * dt; a16[2 * pi] = mag * cosf(ang); a16[2 * pi + 1] = mag * sinf(ang); }
}
__device__ __forceinline__ void unit(const float* a16, int l, int b, int g, const bf16* Ug, const bf16* mats, bf16* Aglu, bool skip_ctx, LAS unsigned char* lds, int wave_, int half) {
    int tid = wave_ * 64 + lane_id(); asm volatile("" : "+v"(tid));
    const int lane = tid & 63, n = lane & 15, q = lane >> 4; const int wid = __builtin_amdgcn_readfirstlane(tid >> 6);
    LAS unsigned char* Ef = lds; LAS unsigned char* Eb = lds + LDS_E;
    const bf16* U = Ug + (size_t)(b * 32 + g) * LPOS * 16;
    const int rt = 8 * half + wid;
    f32x4 yi[17];
    {
        bf16x8 af[8], ab[8], am[8]; u32x4 st[4]; unsigned uoff[8];
#pragma unroll
        for (int ks = 0; ks < 8; ++ks) { af[ks] = *(const bf16x8*)(mats + M_WSF + (size_t)(16 * wid + n) * 256 + 32 * ks + 8 * q); ab[ks] = *(const bf16x8*)(mats + M_WSB + (size_t)(16 * wid + n) * 256 + 32 * ks + 8 * q);
            am[ks] = *(const bf16x8*)(mats + M_MC + (size_t)(16 * rt + n) * 256 + 32 * ks + 8 * q); }
        const bf16* ug = U + wid * 512 + lane * 8;
        const int ns = 2 * wid + (lane >> 5), js = lane & 31;
        const unsigned sdst = (ns < 8 ? 0u : (unsigned)LDS_E) + (ns & 7) * 512 + ((js ^ ns) << 4);
#pragma unroll
        for (int i = 0; i < 4; ++i) st[i] = *(const u32x4*)(ug + i * 4096);
#pragma unroll
        for (int ks = 0; ks < 8; ++ks) uoff[ks] = (n < 8 ? 0u : (unsigned)LDS_E) + (n & 7) * 512 + (((4 * ks + q) ^ n) << 4);
        *(LAS u32x4*)(lds + sdst + 4096) = st[0]; st[0] = *(const u32x4*)(ug + 4 * 4096);
        __syncthreads();
#pragma unroll
        for (int t = 0; t < 17; ++t) {
            bf16x8 ub[8];
#pragma unroll
            for (int ks = 0; ks < 8; ++ks) ub[ks] = *(const LAS bf16x8*)(lds + 4096 * (t + 1) + uoff[ks]);
            if (t + 1 < 17) { *(LAS u32x4*)(lds + sdst + 4096 * (t + 2)) = st[(t + 1) & 3]; if (t + 5 < 17) st[(t + 1) & 3] = *(const u32x4*)(ug + (t + 5) * 4096); }
            f32x4 cf = {0.f, 0.f, 0.f, 0.f}, cb = {0.f, 0.f, 0.f, 0.f}, cy = {0.f, 0.f, 0.f, 0.f};
#pragma unroll
            for (int ks = 0; ks < 8; ++ks) { cf = __builtin_amdgcn_mfma_f32_16x16x32_bf16(af[ks], ub[ks], cf, 0, 0, 0); cb = __builtin_amdgcn_mfma_f32_16x16x32_bf16(ab[ks], ub[ks], cb, 0, 0, 0);
                if (!(t == 0 && skip_ctx)) cy = __builtin_amdgcn_mfma_f32_16x16x32_bf16(am[ks], ub[ks], cy, 0, 0, 0); }
            yi[t] = cy;
            const int eo = (16 * t + n) * 256 + (((2 * wid + (q >> 1)) ^ n) << 4) + (q & 1) * 8;
            *(LAS u32x2*)(Ef + eo) = (u32x2){pk2(cf[0], cf[1]), pk2(cf[2], cf[3])};
            *(LAS u32x2*)(Eb + eo) = (u32x2){pk2(cb[0], cb[1]), pk2(cb[2], cb[3])};
            __syncthreads();
        }
    }
    bf16x8 wf[4], wb[4];
#pragma unroll
    for (int ks = 0; ks < 4; ++ks) { wf[ks] = *(const bf16x8*)(mats + M_WCF + (size_t)(16 * rt + n) * 128 + 32 * ks + 8 * q); wb[ks] = *(const bf16x8*)(mats + M_WCB + (size_t)(16 * rt + n) * 128 + 32 * ks + 8 * q); }
    if (wid < 2) {
        const int dir = wid, p = lane, pi = ((l * 2 + dir) * 32 + g) * 64 + p;
        const float ar = a16[2 * pi], ai = a16[2 * pi + 1];
        LAS unsigned* E32 = (LAS unsigned*)(dir ? Eb : Ef);
        float xr = 0.f, xi = 0.f;
#define S5_CH(st) (dir == 0 ? (st) : ((st) < 16 ? 15 - (st) : NCH + 15 - (st)))
#define S5_EW(k, j) (S5_CH(16 * (k) + (j)) * 64 + ((((p >> 2) ^ (dir == 0 ? (j) : 15 - (j))) << 2) | (p & 3)))
        unsigned ea[16], eb[16];
#pragma unroll
        for (int j = 0; j < 16; ++j) ea[j] = E32[S5_EW(0, j)];
        for (int k = 0; k < 17; k += 2) {
#pragma unroll
            for (int j = 0; j < 16; ++j) eb[j] = E32[S5_EW(k + 1 < 17 ? k + 1 : k, j)];
#pragma unroll
            for (int j = 0; j < 16; ++j) { const unsigned e = ea[j]; E32[S5_EW(k, j)] = pk2(xr, xi);
                const float er = bf2f(e & 0xffffu), ei = bf2f(e >> 16); const float nr = ar * xr - ai * xi + er, ni = ar * xi + ai * xr + ei; xr = nr; xi = ni; }
            if (k + 1 < 17) {
#pragma unroll
                for (int j = 0; j < 16; ++j) ea[j] = E32[S5_EW(k + 2 < 17 ? k + 2 : k + 1, j)];
#pragma unroll
                for (int j = 0; j < 16; ++j) { const unsigned e = eb[j]; E32[S5_EW(k + 1, j)] = pk2(xr, xi);
                    const float er = bf2f(e & 0xffffu), ei = bf2f(e >> 16); const float nr = ar * xr - ai * xi + er, ni = ar * xi + ai * xr + ei; xr = nr; xi = ni; }
            }
        }
#undef S5_EW
#undef S5_CH
    }
    __syncthreads();
    {
        unsigned xoff[4];
#pragma unroll
        for (int ks = 0; ks < 4; ++ks) xoff[ks] = n * 256 + (((q + 4 * ks) ^ n) << 4);
#pragma unroll
        for (int ct = 0; ct < 17; ++ct) {
            if (ct == 0 && skip_ctx) continue;
            int cto = ct; asm volatile("" : "+s"(cto));
            f32x4 acc = yi[ct];
#pragma unroll
            for (int ks = 0; ks < 4; ++ks) { acc = __builtin_amdgcn_mfma_f32_16x16x32_bf16(wf[ks], *(const LAS bf16x8*)(Ef + 4096 * cto + xoff[ks]), acc, 0, 0, 0);
                acc = __builtin_amdgcn_mfma_f32_16x16x32_bf16(wb[ks], *(const LAS bf16x8*)(Eb + 4096 * cto + xoff[ks]), acc, 0, 0, 0); }
            const int pos = (16 * cto + n) * 16 + rt;
            *(u32x2*)(Aglu + (size_t)pos_row(b, pos) * 512 + g * 16 + 4 * q) = (u32x2){pk2(fgelu_tanh(acc[0]), fgelu_tanh(acc[1])), pk2(fgelu_tanh(acc[2]), fgelu_tanh(acc[3]))};
        }
    }
    __syncthreads();
}
}

struct Ptrs {
    const float *x, *c, *ctx, *c_ctx, *w_mod, *b_mod, *g_mix_pre, *g_mix_post, *g_ffn_pre, *g_ffn_post, *w_in, *g_q, *g_k, *g_cq, *g_ckv, *w_uq, *w_ukv;
    s5::Params s5p;
    const float *w_glu, *w_branch, *w_mg, *b_mg, *w_out, *ffn_w1, *ffn_w3, *ffn_w2, *router_w, *router_b, *moe_w1, *moe_w3, *moe_w2;
    float* out; unsigned char* ws;
};

template <int MAP  >
__device__ __forceinline__ void transpose_item(const float* W, int K, int N, bf16* WT, int kb, int n0, int drow0, LAS float* scr, int lane) {
    const int k0 = 64 * kb;
#pragma unroll
    for (int i = 0; i < 8; ++i) { const int kk = 8 * i + (lane >> 3), c4 = 4 * (lane & 7); const f32x4 v = *(const f32x4*)(W + (size_t)(k0 + kk) * N + n0 + c4);
        LAS float* d = scr + kk * 33 + c4; d[0] = v[0]; d[1] = v[1]; d[2] = v[2]; d[3] = v[3]; }
    asm volatile("s_waitcnt lgkmcnt(0)" ::: "memory");
    const int c = lane & 7;
#pragma unroll
    for (int j = 0; j < 4; ++j) { const int n = (lane >> 3) + 8 * j; const LAS float* s = scr + (8 * c) * 33 + n;
        u32x4 o; o.x = pk2(s[0 * 33], s[1 * 33]); o.y = pk2(s[2 * 33], s[3 * 33]); o.z = pk2(s[4 * 33], s[5 * 33]); o.w = pk2(s[6 * 33], s[7 * 33]);
        int dr = n; if (MAP == 1) { const int i2 = n & 15; dr = 8 * (i2 >> 2) + (i2 & 3) + ((n >> 4) << 2); }
        *(u32x4*)(WT + (size_t)(drow0 + dr) * K + k0 + 8 * c) = o; }
    asm volatile("s_waitcnt lgkmcnt(0)" ::: "memory");
}

__device__ __forceinline__ void transpose_item_f8(const float* W, int K, int N, unsigned char* WT, int kb, int n0, int drow0, float wscale, LAS float* scr, int lane) {
    const int k0 = 64 * kb;
#pragma unroll
    for (int i = 0; i < 8; ++i) { const int kk = 8 * i + (lane >> 3), c4 = 4 * (lane & 7); const f32x4 v = *(const f32x4*)(W + (size_t)(k0 + kk) * N + n0 + c4);
        LAS float* d = scr + kk * 33 + c4; d[0] = v[0]; d[1] = v[1]; d[2] = v[2]; d[3] = v[3]; }
    asm volatile("s_waitcnt lgkmcnt(0)" ::: "memory");
    const int c = lane & 7;
#pragma unroll
    for (int j = 0; j < 4; ++j) { const int n = (lane >> 3) + 8 * j; const LAS float* s = scr + (8 * c) * 33 + n;
        u32x2 o; o.x = pg8::pk_fp8x4(s[0 * 33] * wscale, s[1 * 33] * wscale, s[2 * 33] * wscale, s[3 * 33] * wscale); o.y = pg8::pk_fp8x4(s[4 * 33] * wscale, s[5 * 33] * wscale, s[6 * 33] * wscale, s[7 * 33] * wscale);
        *(u32x2*)(WT + (size_t)(drow0 + n) * K + k0 + 8 * c) = o; }
    asm volatile("s_waitcnt lgkmcnt(0)" ::: "memory");
}
__device__ __forceinline__ int zmap(int n0) { return n0 < 512 ? n0 : n0 < 896 ? ZC_CQ + (n0 - 512) : n0 < 1024 ? ZC_KG + (n0 - 896) : n0 < 1152 ? ZC_VG + (n0 - 1024) : n0 < 1440 ? n0 : ZC_U + (n0 - 1440); }
__device__ __forceinline__ int pairmap(int n0, int second) { return 256 * (n0 >> 7) + (second ? 128 : 0) + (n0 & 127); }

__device__ __forceinline__ void transposes(const Ptrs& P, int gw, int ngw, LAS float* scr, int lane, int qsel = 0) {
    unsigned char* ws = P.ws;
    constexpr int I_WIN = 16 * 61, I_MG = 16 * 96, I_UQ = 6 * 24, I_UKV = 4 * 32, I_GLU = 8 * 32, I_BR = 8 * 32, I_OUT = 16 * 32, I_F13 = 16 * 88, I_F2 = 44 * 32;
    constexpr int PER_L = I_WIN + I_MG + I_UQ + I_UKV + I_GLU + 3 * I_BR + I_OUT;
    constexpr int N_L = 2 * PER_L, N_F = 2 * I_F13 + I_F2, N_M = 8 * (2 * I_F13 + I_F2), NITEMS = N_L + N_F + N_M;
    const int qx = (int)blockIdx.x & 7;
    unsigned* q = (unsigned*)(ws + WS_CTL) + CW_Q + 256 * qsel + 32 * qx; (void)gw; (void)ngw;
    for (;;) { int base = 0; if (lane == 0) base = (int)atomicAdd(q, 4u); base = __builtin_amdgcn_readfirstlane(base); if (base * 8 + qx + N_M >= NITEMS) break;
    for (int it_ = base; it_ < base + 4; ++it_) { const int it = it_ * 8 + qx + N_M; if (it >= NITEMS) break;
        int r = it;
        if (r < N_M) {
            const int e = r / (2 * I_F13 + I_F2); r -= e * (2 * I_F13 + I_F2);
            unsigned char* W1T = ws + WS_WM1T + (size_t)e * 5632 * 1024; unsigned char* W2T = ws + WS_WM2T + (size_t)e * 1024 * 2816;
            if (r < I_F13) { const int kb = r / 88, nb = r % 88; if (F8_M1) transpose_item_f8(P.moe_w1 + (size_t)e * 1024 * DFF, 1024, DFF, W1T, kb, 32 * nb, pairmap(32 * nb, 0), F8_WSCALE, scr, lane); else transpose_item<0>(P.moe_w1 + (size_t)e * 1024 * DFF, 1024, DFF, (bf16*)(ws + WS_WM1T) + (size_t)e * 5632 * 1024, kb, 32 * nb, pairmap(32 * nb, 0), scr, lane); continue; } r -= I_F13;
            if (r < I_F13) { const int kb = r / 88, nb = r % 88; if (F8_M1) transpose_item_f8(P.moe_w3 + (size_t)e * 1024 * DFF, 1024, DFF, W1T, kb, 32 * nb, pairmap(32 * nb, 1), F8_WSCALE, scr, lane); else transpose_item<0>(P.moe_w3 + (size_t)e * 1024 * DFF, 1024, DFF, (bf16*)(ws + WS_WM1T) + (size_t)e * 5632 * 1024, kb, 32 * nb, pairmap(32 * nb, 1), scr, lane); continue; } r -= I_F13;
            { const int kb = r / 32, nb = r % 32; transpose_item_f8(P.moe_w2 + (size_t)e * DFF * 1024, DFF, 1024, W2T, kb, 32 * nb, 32 * nb, F8_WSCALE, scr, lane); continue; }
        }
        r -= N_M;
        if (r < N_F) {
            unsigned char* W1T = ws + WS_WF1T; unsigned char* W2T = ws + WS_WF2T;
            if (r < I_F13) { const int kb = r / 88, nb = r % 88; if (F8_D1) transpose_item_f8(P.ffn_w1, 1024, DFF, W1T, kb, 32 * nb, pairmap(32 * nb, 0), F8_WSCALE, scr, lane); else transpose_item<0>(P.ffn_w1, 1024, DFF, (bf16*)W1T, kb, 32 * nb, pairmap(32 * nb, 0), scr, lane); continue; } r -= I_F13;
            if (r < I_F13) { const int kb = r / 88, nb = r % 88; if (F8_D1) transpose_item_f8(P.ffn_w3, 1024, DFF, W1T, kb, 32 * nb, pairmap(32 * nb, 1), F8_WSCALE, scr, lane); else transpose_item<0>(P.ffn_w3, 1024, DFF, (bf16*)W1T, kb, 32 * nb, pairmap(32 * nb, 1), scr, lane); continue; } r -= I_F13;
            { const int kb = r / 32, nb = r % 32; if (F8_D2) transpose_item_f8(P.ffn_w2, DFF, 1024, W2T, kb, 32 * nb, 32 * nb, F8_WSCALE, scr, lane); else transpose_item<0>(P.ffn_w2, DFF, 1024, (bf16*)W2T, kb, 32 * nb, 32 * nb, scr, lane); continue; }
        }
        r -= N_F;
        const int l = r / PER_L; r -= l * PER_L;
        if (r < I_WIN) { const int kb = r / 61, nb = r % 61; if (F8_G1L1 && l == 1) transpose_item_f8(P.w_in + (size_t)l * 1024 * NIN, 1024, NIN, ws + WS_W1T + (size_t)l * ZW * 2048, kb, 32 * nb, zmap(32 * nb), F8_WSCALE, scr, lane);
            else transpose_item<0>(P.w_in + (size_t)l * 1024 * NIN, 1024, NIN, (bf16*)(ws + WS_W1T) + (size_t)l * ZW * 1024, kb, 32 * nb, zmap(32 * nb), scr, lane); continue; } r -= I_WIN;
        if (r < I_MG) { const int kb = r / 96, nb = r % 96; transpose_item_f8(P.w_mg + (size_t)l * 1024 * 3072, 1024, 3072, ws + WS_WMGT + (size_t)l * 3072 * 1024, kb, 32 * nb, 32 * nb, F8_WSCALE, scr, lane); continue; } r -= I_MG;
        if (r < I_UQ) { const int kb = r / 24, nb = r % 24; bf16* T = (bf16*)(ws + WS_WUQT) + (size_t)l * 768 * 384;
            if (nb % 3 == 2) transpose_item<1>(P.w_uq + (size_t)l * 384 * 768, 384, 768, T, kb, 32 * nb, 32 * nb, scr, lane); else transpose_item<0>(P.w_uq + (size_t)l * 384 * 768, 384, 768, T, kb, 32 * nb, 32 * nb, scr, lane); continue; } r -= I_UQ;
        if (r < I_UKV) { const int kb = r / 32, nb = r % 32; transpose_item<0>(P.w_ukv + (size_t)l * 256 * 1024, 256, 1024, (bf16*)(ws + WS_WUKVT) + (size_t)l * 1024 * 256, kb, 32 * nb, 32 * nb, scr, lane); continue; } r -= I_UKV;
        if (r < I_GLU) { const int kb = r / 32, nb = r % 32, n0 = 32 * nb; transpose_item<0>(P.w_glu + (size_t)l * 512 * 1024, 512, 1024, (bf16*)(ws + WS_WGLUT) + (size_t)l * 1024 * 512, kb, n0, n0 < 512 ? pairmap(n0, 0) : pairmap(n0 - 512, 1), scr, lane); continue; } r -= I_GLU;
        if (r < 3 * I_BR) { const int n = r / I_BR; r -= n * I_BR; const int kb = r / 32, nb = r % 32;
            transpose_item<0>(P.w_branch + ((size_t)l * 3 + n) * 512 * 1024, 512, 1024, (bf16*)(ws + WS_WBT) + ((size_t)l * 3 + n) * 1024 * 512, kb, 32 * nb, 32 * nb, scr, lane); continue; } r -= 3 * I_BR;
        { const int kb = r / 32, nb = r % 32; transpose_item<0>(P.w_out + (size_t)l * 1024 * 1024, 1024, 1024, (bf16*)(ws + WS_WOUTT) + (size_t)l * 1024 * 1024, kb, 32 * nb, 32 * nb, scr, lane); }
    } }
}


constexpr int MOE_ITEMS_PER_E = 2 * 16 * 88 + 44 * 32, MOE_ITEMS = 8 * MOE_ITEMS_PER_E;
__device__ __forceinline__ void moe_transposes(const float* w1, const float* w3, const float* w2, unsigned char* ws, int lo, int hi, int giw, int ngiw, LAS float* scr, int lane) {
    constexpr int I_F13 = 16 * 88;
    for (int it = lo + giw; it < hi; it += ngiw) {
        const int e = it / MOE_ITEMS_PER_E; int r = it - e * MOE_ITEMS_PER_E;
        unsigned char* W1T = ws + WS_WM1T + (size_t)e * 5632 * 1024; unsigned char* W2T = ws + WS_WM2T + (size_t)e * 1024 * 2816;
        if (r < I_F13) { const int kb = r / 88, nb = r % 88; if (F8_M1) transpose_item_f8(w1 + (size_t)e * 1024 * DFF, 1024, DFF, W1T, kb, 32 * nb, pairmap(32 * nb, 0), F8_WSCALE, scr, lane); else transpose_item<0>(w1 + (size_t)e * 1024 * DFF, 1024, DFF, (bf16*)(ws + WS_WM1T) + (size_t)e * 5632 * 1024, kb, 32 * nb, pairmap(32 * nb, 0), scr, lane); continue; } r -= I_F13;
        if (r < I_F13) { const int kb = r / 88, nb = r % 88; if (F8_M1) transpose_item_f8(w3 + (size_t)e * 1024 * DFF, 1024, DFF, W1T, kb, 32 * nb, pairmap(32 * nb, 1), F8_WSCALE, scr, lane); else transpose_item<0>(w3 + (size_t)e * 1024 * DFF, 1024, DFF, (bf16*)(ws + WS_WM1T) + (size_t)e * 5632 * 1024, kb, 32 * nb, pairmap(32 * nb, 1), scr, lane); continue; } r -= I_F13;
        { const int kb = r / 32, nb = r % 32; transpose_item_f8(w2 + (size_t)e * DFF * 1024, DFF, 1024, W2T, kb, 32 * nb, 32 * nb, F8_WSCALE, scr, lane); }
    }
}
__device__ __forceinline__ void mod_item(const Ptrs& P, int item, LAS unsigned char* lds, int wave_) {
    LAS float* sc = (LAS float*)lds;
    LAS float* part = sc + 5 * 1024;
    const int lane = lane_id(), wid = wave_, tid = wid * 64 + lane, l = item / 96, n0 = (item % 96) * 64;
    for (int i = tid; i < 5 * 1024; i += NTHREADS) { const float v = i < 4096 ? P.c[i] : P.c_ctx[i - 4096]; sc[i] = v / (1.0f + expf(-v)); }
    __syncthreads();
    float a[5] = {0.f, 0.f, 0.f, 0.f, 0.f};
    const float* W = P.w_mod + (size_t)l * 1024 * 6144 + n0 + lane;
    for (int k0 = wid; k0 < 1024; k0 += 256) {
        float w[32];
#pragma unroll
        for (int j = 0; j < 32; ++j) w[j] = W[(size_t)(k0 + 8 * j) * 6144];
#pragma unroll
        for (int j = 0; j < 32; ++j)
#pragma unroll
            for (int r = 0; r < 5; ++r) a[r] += sc[r * 1024 + k0 + 8 * j] * w[j]; }
#pragma unroll
    for (int r = 0; r < 5; ++r) part[(wid * 5 + r) * 64 + lane] = a[r];
    __syncthreads();
    if (tid < 320) { const int r = tid >> 6; float s = 0.f;
#pragma unroll
        for (int w = 0; w < 8; ++w) s += part[(w * 5 + r) * 64 + lane];
        ((float*)(P.ws + WS_MOD))[((size_t)l * 5 + r) * 6144 + n0 + lane] = s + P.b_mod[l * 6144 + n0 + lane]; }
    __syncthreads();
}
__device__ __forceinline__ void copy_params(const Ptrs& P, int gt, int ngt) {
    float* par = (float*)(P.ws + WS_PAR);
    for (int i = gt; i < 2048; i += ngt) { par[PR_GMIXPRE + i] = P.g_mix_pre[i]; par[PR_GMIXPOST + i] = P.g_mix_post[i]; par[PR_GFFNPRE + i] = P.g_ffn_pre[i]; par[PR_GFFNPOST + i] = P.g_ffn_post[i]; }
    for (int i = gt; i < 128; i += ngt) { par[PR_GQ + i] = P.g_q[i]; par[PR_GK + i] = P.g_k[i]; }
    for (int i = gt; i < 768; i += ngt) par[PR_GCQ + i] = P.g_cq[i];
    for (int i = gt; i < 512; i += ngt) par[PR_GCKV + i] = P.g_ckv[i];
    for (int i = gt; i < 6144; i += ngt) par[PR_BMG + i] = P.b_mg[i];
    for (int i = gt; i < 8192; i += ngt) par[PR_RW + i] = P.router_w[i];
    for (int i = gt; i < 8; i += ngt) par[PR_RB + i] = P.router_b[i];
    s5::build_a16(P.s5p, par + PR_A16, gt, ngt);
}
__device__ __forceinline__ void rope_tables(const Ptrs& P, int gt, int ngt) {
    float* ca = (float*)(P.ws + WS_ROPE); float* sa = ca + 4096 * 32; float* cb = sa + 4096 * 32; float* sb = cb + 4096 * 16;
    for (int i = gt; i < 4096 * 32; i += ngt) { const int pos = i >> 5, j = i & 31; const float f = expf(-9.210340371976184f * (float)(j & 15) * (1.0f / 16.0f));
        const float ang = (float)(j < 16 ? pos / GRIDW : pos % GRIDW) * f; ca[i] = cosf(ang); sa[i] = sinf(ang); }
    for (int i = gt; i < 4096 * 16; i += ngt) { const int pos = i >> 4, j = i & 15; const float f = expf(-9.210340371976184f * (float)(j & 7) * (1.0f / 8.0f));
        const float ang = (float)(j < 8 ? pos / GRIDW : pos % GRIDW) * f; cb[i] = cosf(ang); sb[i] = sinf(ang); }
}

__device__ __forceinline__ void ld8(const float* p, float (&o)[8]) { const f32x4 a = *(const f32x4*)p, b = *(const f32x4*)(p + 4); o[0] = a[0]; o[1] = a[1]; o[2] = a[2]; o[3] = a[3]; o[4] = b[0]; o[5] = b[1]; o[6] = b[2]; o[7] = b[3]; }
__device__ __forceinline__ void token_row(unsigned char* ws, int l, int row, int lane) {
    const float* par = (const float*)(ws + WS_PAR);
    const bf16* z = (const bf16*)(ws + P_Z) + (size_t)row * ZW;
    const bool lat = row < NLAT; const int t = row & (SEQ - 1);
    const float* cosA = (const float*)(ws + WS_ROPE) + t * 32; const float* sinA = cosA + 4096 * 32;
    const float* cosB = (const float*)(ws + WS_ROPE) + 2 * 4096 * 32 + t * 16; const float* sinB = cosB + 4096 * 16;
    float v0[8], v1[8], v2[8];
    unpack8(*(const u32x4*)(z + 8 * lane), v0); unpack8(*(const u32x4*)(z + 512 + 8 * lane), v1); unpack8(*(const u32x4*)(z + 1024 + 8 * lane), v2);
    const u32x4 uraw = *(const u32x4*)(z + ZC_U + 8 * lane);
    float ca[8], sa[8], cb8[8], sb8[8];
    ld8(cosA + ((8 * (lane & 7)) & 31), ca); ld8(sinA + ((8 * (lane & 7)) & 31), sa); ld8(cosB + ((8 * ((lane - 48) & 3)) & 15), cb8); ld8(sinB + ((8 * ((lane - 48) & 3)) & 15), sb8);
    { float ss = 0.f;
#pragma unroll
      for (int j = 0; j < 8; ++j) ss += v0[j] * v0[j];
      ss += shfl_xor_l(ss, 1, lane); ss += shfl_xor_l(ss, 2, lane); ss += shfl_xor_l(ss, 4, lane);
      const float rs = rsqrtf(ss * (1.0f / 64.0f) + EPS); const int d0 = 8 * (lane & 7); float o[8], gq[8];
      ld8(par + PR_GQ + l * 64 + d0, gq);
#pragma unroll
      for (int j = 0; j < 8; ++j) v0[j] = v0[j] * rs * gq[j];
#pragma unroll
      for (int j = 0; j < 8; ++j) { const float other = shfl_xor_l(v0[j], 4, lane); const float c = ca[j], s = sa[j];
          o[j] = lat ? ((d0 < 32) ? v0[j] * c - other * s : other * s + v0[j] * c) : v0[j];
          o[j] *= 0.125f * LOG2E; }
      *(u32x4*)((bf16*)(ws + P_QA) + (size_t)row * 512 + 8 * lane) = pack8(o); }
    { float ss = 0.f;
#pragma unroll
      for (int j = 0; j < 8; ++j) ss += v1[j] * v1[j];
      float ssk = ss; ssk += shfl_xor_l(ssk, 1, lane); ssk += shfl_xor_l(ssk, 2, lane); ssk += shfl_xor_l(ssk, 4, lane);
      float ss2 = 0.f;
#pragma unroll
      for (int j = 0; j < 8; ++j) ss2 += v2[j] * v2[j];
      const float sq = wave_sum((lane >= 32 ? ss : 0.f) + (lane < 16 ? ss2 : 0.f));
      const float skv = wave_sum((lane >= 16 && lane < 48) ? ss2 : 0.f);
      const float rq = rsqrtf(sq * (1.0f / 384.0f) + EPS), rkv = rsqrtf(skv * (1.0f / 256.0f) + EPS);
      { const float rs = rsqrtf(ssk * (1.0f / 64.0f) + EPS); const int d0 = 8 * (lane & 7); float kk[8], o[8], gk[8];
        ld8(par + PR_GK + l * 64 + d0, gk);
#pragma unroll
        for (int j = 0; j < 8; ++j) kk[j] = v1[j] * rs * gk[j];
#pragma unroll
        for (int j = 0; j < 8; ++j) { const float other = shfl_xor_l(kk[j], 4, lane); const float c = ca[j], s = sa[j];
            o[j] = lat ? ((d0 < 32) ? kk[j] * c - other * s : other * s + kk[j] * c) : kk[j]; }
        if (lane < 16) *(u32x4*)((bf16*)(ws + P_KA) + (size_t)row * 128 + 8 * lane) = pack8(o); }
      if (lane >= 16 && lane < 32) *(u32x4*)((bf16*)(ws + P_VA) + (size_t)row * 128 + 8 * (lane - 16)) = pack8(v1);
      { float g1[8], g2[8], g3[8], o[8];
        const int i1 = lane >= 32 ? 8 * (lane - 32) : 0, i2 = lane < 16 ? 256 + 8 * lane : 0, i3 = (lane >= 16 && lane < 48) ? 8 * (lane - 16) : 0;
        ld8(par + PR_GCQ + l * 384 + i1, g1); ld8(par + PR_GCQ + l * 384 + i2, g2); ld8(par + PR_GCKV + l * 256 + i3, g3);
#pragma unroll
        for (int j = 0; j < 8; ++j) o[j] = v1[j] * rq * g1[j];
        if (lane >= 32) *(u32x4*)((bf16*)(ws + P_CQN) + (size_t)row * 384 + i1) = pack8(o);
#pragma unroll
        for (int j = 0; j < 8; ++j) o[j] = v2[j] * rq * g2[j];
        if (lane < 16) *(u32x4*)((bf16*)(ws + P_CQN) + (size_t)row * 384 + i2) = pack8(o);
#pragma unroll
        for (int j = 0; j < 8; ++j) o[j] = v2[j] * rkv * g3[j];
        if (lane >= 16 && lane < 48) *(u32x4*)((bf16*)(ws + P_CKVN) + (size_t)row * 256 + i3) = pack8(o); }
      { float o[8]; const int i0 = 8 * ((lane - 48) & 3);
#pragma unroll
        for (int j = 0; j < 8; ++j) { const float other = shfl_xor_l(v2[j], 2, lane); const float c = cb8[j], s = sb8[j];
            o[j] = lat ? ((i0 < 16) ? v2[j] * c - other * s : other * s + v2[j] * c) : v2[j]; }
        if (lane >= 48 && lane < 52) *(u32x4*)((bf16*)(ws + P_KRR) + (size_t)row * 32 + i0) = pack8(o); }
    }
    { const int b = lat ? row >> 12 : (row - NLAT) >> 8, pos = lat ? CTXL + t : (row - NLAT) & 255, g = lane >> 1;
      *(u32x4*)((bf16*)(ws + P_UG) + ((size_t)(b * 32 + g) * LPOS + pos) * 16 + 8 * (lane & 1)) = uraw; }
}

struct ResidArgs {
    int mode;
    const float* y; const float* g_post; int gate_chunk;
    const float* g_pre; int shift_chunk;
    bool dry;
    float ysc;
    bf16* hout; int l_mod; bool h8; unsigned char* hout8;
    int l_gate; bool route;
};
__device__ __forceinline__ void resid_row(unsigned char* ws, float* outp, const float* xin, const float* ctxin, const ResidArgs R, int row, int lane, const LAS int* tb) {
    const float* par = (const float*)(ws + WS_PAR);
    const bool lat = row < NLAT; const int b = lat ? row >> 12 : (row - NLAT) >> 8, mr = lat ? b : 4;
    const float* mod = (const float*)(ws + WS_MOD);
    float* latp = lat ? outp + (size_t)row * 1024 : (float*)(ws + WS_LATC) + (size_t)(row - NLAT) * 1024;
    f32x4 v[4];
    if (R.mode == 0) { const float* src = lat ? xin + (size_t)row * 1024 : ctxin + (size_t)(row - NLAT) * 1024;
#pragma unroll
        for (int j = 0; j < 4; ++j) v[j] = *(const f32x4*)(src + 4 * lane + 256 * j);
    } else {
        f32x4 yv[4];
        if (R.mode == 1) {
#pragma unroll
            for (int j = 0; j < 4; ++j) yv[j] = *(const f32x4*)(R.y + (size_t)row * 1024 + 4 * lane + 256 * j) * R.ysc;
        } else if (R.mode == 3) {
            const bf16* yb = (const bf16*)R.y + (size_t)row * 1024;
#pragma unroll
            for (int j = 0; j < 4; ++j) { const u32x2 a = *(const u32x2*)(yb + 4 * lane + 256 * j);
                yv[j] = (f32x4){bf2f(a.x & 0xffffu), bf2f(a.x >> 16), bf2f(a.y & 0xffffu), bf2f(a.y >> 16)} * R.ysc; }
        } else {
            const int* ti = (const int*)(ws + WS_LIST) + 8 * 16384 + row * 8;
            const int e0 = ti[0], p0 = ti[1], e1 = ti[2], p1 = ti[3]; const float w0 = __int_as_float(ti[4]) * R.ysc, w1 = __int_as_float(ti[5]) * R.ysc;
            const bf16* f0 = (const bf16*)(ws + P_Y2) + ((size_t)tb[8 + e0] * 256 + p0) * 1024; const bf16* f1 = (const bf16*)(ws + P_Y2) + ((size_t)tb[8 + e1] * 256 + p1) * 1024;
#pragma unroll
            for (int j = 0; j < 4; ++j) { const u32x2 a = *(const u32x2*)(f0 + 4 * lane + 256 * j), c = *(const u32x2*)(f1 + 4 * lane + 256 * j);
                yv[j][0] = w0 * bf2f(a.x & 0xffffu) + w1 * bf2f(c.x & 0xffffu); yv[j][1] = w0 * bf2f(a.x >> 16) + w1 * bf2f(c.x >> 16);
                yv[j][2] = w0 * bf2f(a.y & 0xffffu) + w1 * bf2f(c.y & 0xffffu); yv[j][3] = w0 * bf2f(a.y >> 16) + w1 * bf2f(c.y >> 16); }
        }
        float ss = 0.f;
#pragma unroll
        for (int j = 0; j < 4; ++j) ss += (yv[j][0] * yv[j][0] + yv[j][1] * yv[j][1]) + (yv[j][2] * yv[j][2] + yv[j][3] * yv[j][3]);
        const float rs = rsqrtf(wave_sum(ss) * (1.0f / 1024.0f) + EPS);
        const float* gate = mod + ((size_t)R.l_gate * 5 + mr) * 6144 + R.gate_chunk * 1024;
#pragma unroll
        for (int j = 0; j < 4; ++j) { const int c = 4 * lane + 256 * j; const f32x4 lv = *(const f32x4*)(latp + c), gp = *(const f32x4*)(R.g_post + c), gt = *(const f32x4*)(gate + c);
            v[j] = lv + gt * (yv[j] * rs * gp); }
    }
    if (!R.dry) {
#pragma unroll
    for (int j = 0; j < 4; ++j) *(f32x4*)(latp + 4 * lane + 256 * j) = v[j]; }
    if (R.hout == nullptr) return;
    float ss = 0.f;
#pragma unroll
    for (int j = 0; j < 4; ++j) ss += (v[j][0] * v[j][0] + v[j][1] * v[j][1]) + (v[j][2] * v[j][2] + v[j][3] * v[j][3]);
    const float rs = rsqrtf(wave_sum(ss) * (1.0f / 1024.0f) + EPS);
    const float* shift = mod + ((size_t)R.l_mod * 5 + mr) * 6144 + R.shift_chunk * 1024; const float* scale = shift + 1024;
    f32x4 hv[4];
#pragma unroll
    for (int j = 0; j < 4; ++j) { const int c = 4 * lane + 256 * j; const f32x4 gp = *(const f32x4*)(R.g_pre + c), sh = *(const f32x4*)(shift + c), sc = *(const f32x4*)(scale + c);
        hv[j] = (v[j] * rs * gp) * (1.0f + sc) + sh;
        if (R.dry) { if (hv[j][0] == 123.456f) *(float*)(ws + WS_CTL + 64) = 1.f; continue; }
        if (R.hout8) *(unsigned*)(R.hout8 + (size_t)row * 1024 + c) = pg8::pk_fp8x4(hv[j][0] * F8_HSCALE, hv[j][1] * F8_HSCALE, hv[j][2] * F8_HSCALE, hv[j][3] * F8_HSCALE);
        if (R.h8) *(unsigned*)((unsigned char*)R.hout + (size_t)row * 1024 + c) = pg8::pk_fp8x4(hv[j][0] * F8_HSCALE, hv[j][1] * F8_HSCALE, hv[j][2] * F8_HSCALE, hv[j][3] * F8_HSCALE);
        else *(u32x2*)(R.hout + (size_t)row * 1024 + c) = (u32x2){pk2(hv[j][0], hv[j][1]), pk2(hv[j][2], hv[j][3])}; }
    if (R.route) {
        float lg[8];
#pragma unroll
        for (int e = 0; e < 8; ++e) lg[e] = 0.f;
#pragma unroll
        for (int j = 0; j < 4; ++j)
#pragma unroll
            for (int i = 0; i < 4; ++i) { const float* rw = par + PR_RW + (size_t)(4 * lane + 256 * j + i) * 8; const f32x4 r0 = *(const f32x4*)rw, r1 = *(const f32x4*)(rw + 4); const float hvv = hv[j][i];
                lg[0] += hvv * r0[0]; lg[1] += hvv * r0[1]; lg[2] += hvv * r0[2]; lg[3] += hvv * r0[3]; lg[4] += hvv * r1[0]; lg[5] += hvv * r1[1]; lg[6] += hvv * r1[2]; lg[7] += hvv * r1[3]; }
#pragma unroll
        for (int e = 0; e < 8; ++e) lg[e] = wave_sum(lg[e]) + par[PR_RB + e];
        int e0 = 0; float b0 = lg[0];
#pragma unroll
        for (int e = 1; e < 8; ++e) if (lg[e] > b0) { b0 = lg[e]; e0 = e; }
        int e1 = -1; float b1 = -3.0e38f;
#pragma unroll
        for (int e = 0; e < 8; ++e) if (e != e0 && lg[e] > b1) { b1 = lg[e]; e1 = e; }
        if (lane == 0 && !R.dry) {
            const float w0 = 1.0f / (1.0f + expf(b1 - b0)), w1 = 1.0f - w0;
            unsigned* cnt = (unsigned*)(ws + WS_CTL) + CW_CNT;
            const int p0 = (int)atomicAdd(cnt + e0, 1u), p1 = (int)atomicAdd(cnt + e1, 1u);
            int* list = (int*)(ws + WS_LIST); list[e0 * 16384 + p0] = row; list[e1 * 16384 + p1] = row;
            int* ti = list + 8 * 16384 + row * 8; ti[0] = e0; ti[1] = p0; ti[2] = e1; ti[3] = p1; ti[4] = __float_as_int(w0); ti[5] = __float_as_int(w1);
        }
    }
}

#if MK_DEBUG
namespace dbg {
__device__ __forceinline__ unsigned hash(unsigned a, unsigned b) { unsigned x = a * 0x9E3779B1u ^ (b + 0x7F4A7C15u) * 0x85EBCA77u; x ^= x >> 15; x *= 0xC2B2AE3Du; x ^= x >> 13; x *= 0x27D4EB2Fu; x ^= x >> 16; return x; }
__device__ __forceinline__ float rbf(float f) { return bf2f(f2bf(f)); }
__device__ __forceinline__ void add(unsigned char* ws, int k, float got, float ref, int lane) {
    if (lane == 0) { float* d = (float*)(ws + WS_CTL) + CW_DBG + 2 * k; const float df = got - ref; atomicAdd(d, (df == df && fabsf(df) < 1e18f) ? df * df : 1e30f); atomicAdd(d + 1, ref * ref); }
}
__device__ __forceinline__ float dot_aw(const bf16* a, const float* w, size_t wstride, int K, int lane) { float s = 0.f; for (int k = lane; k < K; k += 64) s += bf2f(a[k]) * rbf(w[(size_t)k * wstride]); return wave_sum(s); }

__device__ __forceinline__ float angA(int t, int i) { return (float)(i < 16 ? t / 64 : t % 64) * powf(10000.f, -(float)(2 * (i & 15)) / 32.f); }
__device__ __forceinline__ float angB(int t, int i) { return (float)(i < 8 ? t / 64 : t % 64) * powf(10000.f, -(float)(2 * (i & 7)) / 16.f); }
__device__ __forceinline__ void chk_mod(unsigned char* ws, const float* const* in, int gw, int ngw, int lane) {
    for (int s = gw; s < 1024; s += ngw) { const unsigned hh = hash(s, 1); const int l = hh & 1, r = (hh >> 1) % 5, n = (hh >> 8) % 6144; float a = 0.f;
        for (int k = lane; k < 1024; k += 64) { const float c = r < 4 ? in[1][r * 1024 + k] : in[3][k]; a += c / (1.f + expf(-c)) * in[4][((size_t)l * 1024 + k) * 6144 + n]; }
        a = wave_sum(a) + in[5][l * 6144 + n]; add(ws, 0, ((const float*)(ws + WS_MOD))[((size_t)l * 5 + r) * 6144 + n], a, lane); }
}
__device__ __forceinline__ void chk_weights(unsigned char* ws, const float* const* in, int gw, int ngw, int lane) {
    for (int s = gw * 64 + lane; s < 65536; s += ngw * 64) { const unsigned hh = hash(s, 2), h2 = hash(s, 3); const int l = hh & 1; float got = 0.f, ref = 0.f; const int which = (hh >> 1) % 12;
        if (which == 0) { const int j = (hh >> 8) % 1952, k = h2 % 1024; int dr = j < 512 ? j : j < 896 ? 768 + (j - 512) : j < 1024 ? 512 + (j - 896) : j < 1152 ? 640 + (j - 1024) : j < 1440 ? j : 1536 + (j - 1440);
            got = bf2f(((const bf16*)(ws + WS_W1T))[((size_t)l * 2048 + dr) * 1024 + k]); ref = rbf(in[10][((size_t)l * 1024 + k) * 1952 + j]); }
        else if (which == 1) { const int j = (hh >> 8) % 3072, k = h2 % 1024; got = bf2f(((const bf16*)(ws + WS_WMGT))[((size_t)l * 3072 + j) * 1024 + k]); ref = rbf(in[27][((size_t)l * 1024 + k) * 3072 + j]); }
        else if (which == 2) { const int j = (hh >> 8) % 768, k = h2 % 384, hd = j / 96, e = j % 96; int de = e; if (e >= 64) { const int i = e - 64; de = 64 + (i < 16 ? 8 * (i >> 2) + (i & 3) : 8 * ((i - 16) >> 2) + 4 + ((i - 16) & 3)); }
            got = bf2f(((const bf16*)(ws + WS_WUQT))[((size_t)l * 768 + hd * 96 + de) * 384 + k]); ref = rbf(in[15][((size_t)l * 384 + k) * 768 + j]); }
        else if (which == 3) { const int j = (hh >> 8) % 1024, k = h2 % 256; got = bf2f(((const bf16*)(ws + WS_WUKVT))[((size_t)l * 1024 + j) * 256 + k]); ref = rbf(in[16][((size_t)l * 256 + k) * 1024 + j]); }
        else if (which == 4) { const int j = (hh >> 8) % 1024, k = h2 % 512; const int jj = j < 512 ? j : j - 512; const int dr = 256 * (jj / 128) + (j < 512 ? 0 : 128) + jj % 128;
            got = bf2f(((const bf16*)(ws + WS_WGLUT))[((size_t)l * 1024 + dr) * 512 + k]); ref = rbf(in[25][((size_t)l * 512 + k) * 1024 + j]); }
        else if (which == 5) { const int n = (hh >> 4) % 3, j = (hh >> 8) % 1024, k = h2 % 512; got = bf2f(((const bf16*)(ws + WS_WBT))[(((size_t)l * 3 + n) * 1024 + j) * 512 + k]); ref = rbf(in[26][(((size_t)l * 3 + n) * 512 + k) * 1024 + j]); }
        else if (which == 6) { const int j = (hh >> 8) % 1024, k = h2 % 1024; got = bf2f(((const bf16*)(ws + WS_WOUTT))[((size_t)l * 1024 + j) * 1024 + k]); ref = rbf(in[29][((size_t)l * 1024 + k) * 1024 + j]); }
        else if (which == 7) { const int j = (hh >> 8) % 2816, k = h2 % 1024, sec = (hh >> 5) & 1; const int dr = 256 * (j / 128) + sec * 128 + j % 128;
            got = bf2f(((const bf16*)(ws + WS_WF1T))[(size_t)dr * 1024 + k]); ref = rbf(in[sec ? 31 : 30][(size_t)k * 2816 + j]); }
        else if (which == 8) { const int j = (hh >> 8) % 1024, k = h2 % 2816; got = bf2f(((const bf16*)(ws + WS_WF2T))[(size_t)j * 2816 + k]); ref = rbf(in[32][(size_t)k * 1024 + j]); }
        else if (which <= 10) { const int e = (hh >> 5) & 7, j = (hh >> 8) % 2816, k = h2 % 1024, sec = which - 9; const int dr = 256 * (j / 128) + sec * 128 + j % 128;
            got = bf2f(((const bf16*)(ws + WS_WM1T))[((size_t)e * 5632 + dr) * 1024 + k]); ref = rbf(in[sec ? 36 : 35][((size_t)e * 1024 + k) * 2816 + j]); }
        else { const int e = (hh >> 5) & 7, j = (hh >> 8) % 1024, k = h2 % 2816; got = bf2f(((const bf16*)(ws + WS_WM2T))[((size_t)e * 1024 + j) * 2816 + k]); ref = rbf(in[37][((size_t)e * 2816 + k) * 1024 + j]); }
        float* d = (float*)(ws + WS_CTL) + CW_DBG + 2 * 1; const float df = got - ref; atomicAdd(d, (df == df) ? df * df : 1e30f); atomicAdd(d + 1, ref * ref); }
}
__device__ __forceinline__ void chk_h(unsigned char* ws, const float* const* in, const float* outp, int k, int l_mod, int shift_chunk, const float* g_pre, int nrows, int gw, int ngw, int lane) {
    for (int s = gw; s < 512; s += ngw) { const int row = hash(s, 10 + k) % nrows; const bool lat = row < NLAT; const int mr = lat ? row >> 12 : 4;
        const float* latp = lat ? outp + (size_t)row * 1024 : (const float*)(ws + WS_LATC) + (size_t)(row - NLAT) * 1024; float ss = 0.f;
        for (int c = lane; c < 1024; c += 64) ss += latp[c] * latp[c];
        const float rs = rsqrtf(wave_sum(ss) / 1024.f + EPS); const float* mod = (const float*)(ws + WS_MOD) + ((size_t)l_mod * 5 + mr) * 6144 + shift_chunk * 1024;
        const int c = hash(s, 77) % 1024; const float ref = latp[c] * rs * g_pre[c] * (1.f + mod[1024 + c]) + mod[c];
        add(ws, k, bf2f(((const bf16*)(ws + P_H))[(size_t)row * 1024 + c]), ref, lane); }
}
template <class F> __device__ __forceinline__ void chk_gemm(unsigned char* ws, int k, const bf16* A, int lda, const float* W, int N, int K, int nrows, int ncols, F fin, int gw, int ngw, int lane) {
    for (int s = gw; s < 1024; s += ngw) { const unsigned hh = hash(s, 20 + k); const int row = hh % nrows, col = (hh >> 16) % ncols;
        const float ref = dot_aw(A + (size_t)row * lda, W + col, N, K, lane); float got, rr; fin(row, col, ref, got, rr); add(ws, k, got, rr, lane); }
}
__device__ __forceinline__ void chk_tok(unsigned char* ws, int k, int l, int gw, int ngw, int lane) {
    const float* par = (const float*)(ws + WS_PAR);
    for (int s = gw; s < 1024; s += ngw) { const unsigned hh = hash(s, 40 + k); const int row = hh % MALL; const bool lat = row < NLAT; const int t = row & 4095; const bf16* z = (const bf16*)(ws + P_Z) + (size_t)row * ZW;
        const int which = (hh >> 20) % 6; float got = 0.f, ref = 0.f;
        if (which == 0 || which == 1) { const int nh = which == 0 ? 8 : 2, hd = (hh >> 24) % nh, d = (hh >> 14) & 63; const bf16* x = z + (which == 0 ? 0 : ZC_KG) + hd * 64; const float* g = par + (which == 0 ? PR_GQ : PR_GK) + l * 64;
            float ss = 0.f; for (int i = 0; i < 64; ++i) ss += bf2f(x[i]) * bf2f(x[i]); const float rs = rsqrtf(ss / 64.f + EPS);
            const int i = d & 31; const float x1 = bf2f(x[i]) * rs * g[i], x2 = bf2f(x[i + 32]) * rs * g[i + 32]; float o = d < 32 ? x1 : x2;
            if (lat) { const float an = angA(t, i), c = cosf(an), sn = sinf(an); o = d < 32 ? x1 * c - x2 * sn : x1 * sn + x2 * c; }
            if (which == 0) { o *= 0.125f * LOG2E; got = bf2f(((const bf16*)(ws + P_QA))[(size_t)row * 512 + hd * 64 + d]); } else got = bf2f(((const bf16*)(ws + P_KA))[(size_t)row * 128 + hd * 64 + d]);
            ref = o; }
        else if (which == 2) { const int i = (hh >> 8) % 384; float ss = 0.f; for (int j = 0; j < 384; ++j) ss += bf2f(z[ZC_CQ + j]) * bf2f(z[ZC_CQ + j]);
            ref = bf2f(z[ZC_CQ + i]) * rsqrtf(ss / 384.f + EPS) * par[PR_GCQ + l * 384 + i]; got = bf2f(((const bf16*)(ws + P_CQN))[(size_t)row * 384 + i]); }
        else if (which == 3) { const int i = (hh >> 8) % 256; float ss = 0.f; for (int j = 0; j < 256; ++j) ss += bf2f(z[ZC_CKV + j]) * bf2f(z[ZC_CKV + j]);
            ref = bf2f(z[ZC_CKV + i]) * rsqrtf(ss / 256.f + EPS) * par[PR_GCKV + l * 256 + i]; got = bf2f(((const bf16*)(ws + P_CKVN))[(size_t)row * 256 + i]); }
        else if (which == 4) { const int d = (hh >> 8) & 31, i = d & 15; const float x1 = bf2f(z[ZC_KR + i]), x2 = bf2f(z[ZC_KR + 16 + i]); float o = d < 16 ? x1 : x2;
            if (lat) { const float an = angB(t, i), c = cosf(an), sn = sinf(an); o = d < 16 ? x1 * c - x2 * sn : x1 * sn + x2 * c; } ref = o; got = bf2f(((const bf16*)(ws + P_KRR))[(size_t)row * 32 + d]); }
        else { const int c = (hh >> 8) & 511, b = lat ? row >> 12 : (row - NLAT) >> 8, pos = lat ? 256 + t : (row - NLAT) & 255; const int wv = (hh >> 19) & 1;
            if (wv) { ref = bf2f(z[ZC_U + c]); got = bf2f(((const bf16*)(ws + P_UG))[((size_t)(b * 32 + (c >> 4)) * LPOS + pos) * 16 + (c & 15)]); }
            else { ref = bf2f(z[ZC_VG + (c & 127)]); got = bf2f(((const bf16*)(ws + P_VA))[(size_t)row * 128 + (c & 127)]); } }
        add(ws, k, got, ref, lane); }
}
__device__ __forceinline__ void chk_attn(unsigned char* ws, int k, bool lastl, int gw, int ngw, int lane) {
    for (int s = gw; s < 256; s += ngw) { const unsigned hh = hash(s, 60 + k); const int typ = hh & 1, b = (hh >> 1) & 3, h = (hh >> 3) & 7, d = (hh >> 6) & 63; const bool cq = !lastl && ((hh >> 12) & 7) == 0;
        const int qrow = cq ? NLAT + b * 256 + ((hh >> 16) & 255) : b * 4096 + ((hh >> 16) & 4095); const int nk = cq ? 256 : LPOS, DKK = typ ? 96 : 64;
        const bf16* q = typ ? (const bf16*)(ws + P_QB) + (size_t)qrow * 768 + h * 96 : (const bf16*)(ws + P_QA) + (size_t)qrow * 512 + h * 64;
        float m = -1e30f, l = 0.f, o = 0.f;
        for (int p = lane; p < nk; p += 64) { const int kr = pos_row(b, p); float sc = 0.f;
            if (typ) { const bf16* kk = (const bf16*)(ws + P_KB) + (size_t)kr * 512 + h * 64; const bf16* k2 = (const bf16*)(ws + P_KRR) + (size_t)kr * 32;
                for (int i = 0; i < 64; ++i) sc += bf2f(q[i]) * bf2f(kk[i]); for (int i = 0; i < 32; ++i) sc += bf2f(q[64 + i]) * bf2f(k2[i]); }
            else { const bf16* kk = (const bf16*)(ws + P_KA) + (size_t)kr * 128 + (h >> 2) * 64; for (int i = 0; i < 64; ++i) sc += bf2f(q[i]) * bf2f(kk[i]); }
            const float v = typ ? bf2f(((const bf16*)(ws + P_VB))[(size_t)kr * 512 + h * 64 + d]) : bf2f(((const bf16*)(ws + P_VA))[(size_t)kr * 128 + (h >> 2) * 64 + d]);
            const float mn = fmaxf(m, sc), al = exp2f(m - mn), pp = exp2f(sc - mn); l = l * al + pp; o = o * al + pp * v; m = mn; (void)DKK; }
        float mg = m; for (int x = 1; x < 64; x <<= 1) mg = fmaxf(mg, __shfl_xor(mg, x));
        const float f = exp2f(m - mg); l = wave_sum(l * f); o = wave_sum(o * f);
        add(ws, k, bf2f(((const bf16*)(ws + P_YBR))[(size_t)qrow * 1536 + typ * 512 + h * 64 + d]), o / l, lane); }
}
__device__ __forceinline__ void chk_s5(unsigned char* ws, const float* const* in, int k, int l, bool lastl, int gw, int ngw, int lane) {
    for (int s = gw; s < 512; s += ngw) { const unsigned hh = hash(s, 80 + k); const int b = hh & 3, g = (hh >> 2) & 31, hp = (hh >> 7) & 15; int psel = (hh >> 12) % LPOS; if (lastl && psel < 256) psel += 256;
        const bf16* U = (const bf16*)(ws + P_UG) + (size_t)(b * 32 + g) * LPOS * 16; float yf[2], yl[2];
        for (int dir = 0; dir < 2; ++dir) { const int pi = ((l * 2 + dir) * 32 + g) * 64 + lane;
            const float lr = fminf(in[17][pi], -1e-4f), li = in[18][pi], dt = expf(in[19][(l * 2 + dir) * 32 + g]); const float mag = expf(lr * dt), abr = mag * cosf(li * dt), abi = mag * sinf(li * dt), den = lr * lr + li * li;
            const float fr = ((abr - 1.f) * lr + abi * li) / den, fi = (abi * lr - (abr - 1.f) * li) / den; float bbr[16], bbi[16];
            _Pragma("unroll") for (int h = 0; h < 16; ++h) { const float br = in[20][(size_t)pi * 16 + h], bi = in[21][(size_t)pi * 16 + h]; bbr[h] = fr * br - fi * bi; bbi[h] = fr * bi + fi * br; }
            float xr = 0.f, xi = 0.f, zr = 0.f, zi = 0.f;
            for (int st = 0; st < LPOS; ++st) { const int p = dir == 0 ? st : (st < 256 ? 255 - st : LPOS + 255 - st); float vr = 0.f, vi = 0.f;
                _Pragma("unroll") for (int h = 0; h < 16; ++h) { const float u = bf2f(U[(size_t)p * 16 + h]); vr += bbr[h] * u; vi += bbi[h] * u; }
                if ((dir == 0 && (p & 15) == 0) || (dir == 1 && (p & 15) == 15)) { zr = 0.f; zi = 0.f; }
                const float nr = abr * xr - abi * xi + vr, ni = abr * xi + abi * xr + vi; xr = nr; xi = ni;
                const float mr = abr * zr - abi * zi + vr, mi = abr * zi + abi * zr + vi; zr = mr; zi = mi;
                if (p == psel) break; }
            const size_t ci = ((size_t)((l * 2 + dir) * 32 + g) * 16 + hp) * 64 + lane; yf[dir] = wave_sum(in[22][ci] * xr - in[23][ci] * xi); yl[dir] = wave_sum(in[22][ci] * zr - in[23][ci] * zi); }
        const float du = in[24][(l * 32 + g) * 16 + hp] * bf2f(U[(size_t)psel * 16 + hp]); const float got = bf2f(((const bf16*)(ws + P_AGLU))[(size_t)pos_row(b, psel) * 512 + g * 16 + hp]);
        auto ge = [](float y) { const float u2 = 0.7978845608028654f * (y + 0.044715f * y * y * y); return 0.5f * y * (1.f + tanhf(u2)); };
        add(ws, k, got, ge(du + yf[0] + yf[1]), lane);
        if (l == 0) { add(ws, 30, got, ge(du + yf[0] + yl[1]), lane); add(ws, 31, got, ge(du + yl[0] + yf[1]), lane); add(ws, 32, got, ge(du + yl[0] + yl[1]), lane); add(ws, 33, got, ge(du), lane); } }
}
__device__ __forceinline__ void chk_s5m(unsigned char* ws, const float* const* in, int k, int gw, int ngw, int lane) {
    for (int s = gw; s < 2048; s += ngw) { const unsigned hh = hash(s, 700), h2 = hash(s, 701); const int l = hh & 1, g = (hh >> 1) & 31, which = (hh >> 6) % 5;
        const bf16* M = (const bf16*)(ws + WS_S5M) + (size_t)(l * 32 + g) * 196608; float got = 0.f, ref = 0.f;
        const int t = (h2 >> 0) & 15, hp = (h2 >> 4) & 15, sx = (h2 >> 8) & 15, h = (h2 >> 12) & 15, p2 = (h2 >> 16) & 63, im = (h2 >> 22) & 1, dsel = (h2 >> 23) & 1;
        float cre[2], cim[2], are[2], aim[2], bre[2], bim[2], lrr[2], lii[2], dtt[2];
        _Pragma("unroll") for (int dir = 0; dir < 2; ++dir) { const int pi = ((l * 2 + dir) * 32 + g) * 64 + lane; lrr[dir] = fminf(in[17][pi], -1e-4f); lii[dir] = in[18][pi]; dtt[dir] = expf(in[19][(l * 2 + dir) * 32 + g]);
            const float mag = expf(lrr[dir] * dtt[dir]); are[dir] = mag * cosf(lii[dir] * dtt[dir]); aim[dir] = mag * sinf(lii[dir] * dtt[dir]);
            const float den = lrr[dir] * lrr[dir] + lii[dir] * lii[dir], fr = ((are[dir] - 1.f) * lrr[dir] + aim[dir] * lii[dir]) / den, fi = (aim[dir] * lrr[dir] - (are[dir] - 1.f) * lii[dir]) / den;
            const float br = in[20][(size_t)pi * 16 + h], bi = in[21][(size_t)pi * 16 + h]; bre[dir] = fr * br - fi * bi; bim[dir] = fr * bi + fi * br;
            const size_t ci = ((size_t)((l * 2 + dir) * 32 + g) * 16 + hp) * 64 + lane; cre[dir] = in[22][ci]; cim[dir] = in[23][ci]; }
        if (which == 0) {
            float acc = 0.f;
            _Pragma("unroll") for (int dir = 0; dir < 2; ++dir) { const int j = dir == 0 ? t - sx : sx - t; if (j >= 0) { float pr = 1.f, pq = 0.f; for (int e = 0; e < j; ++e) { const float nr = pr * are[dir] - pq * aim[dir], nq = pr * aim[dir] + pq * are[dir]; pr = nr; pq = nq; }
                    const float tr = cre[dir] * pr - cim[dir] * pq, tq = cre[dir] * pq + cim[dir] * pr; acc += tr * bre[dir] - tq * bim[dir]; } }
            ref = wave_sum(acc) + ((t == sx && h == hp) ? in[24][(l * 32 + g) * 16 + h] : 0.f); got = bf2f(M[(size_t)(16 * t + hp) * 256 + 16 * sx + h]); }
        else if (which <= 2) {
            const int dir = which - 1, ex = dir == 0 ? t + 1 : 16 - t; float pr = 1.f, pq = 0.f; for (int e = 0; e < ex; ++e) { const float nr = pr * are[dir] - pq * aim[dir], nq = pr * aim[dir] + pq * are[dir]; pr = nr; pq = nq; }
            const float tr = cre[dir] * pr - cim[dir] * pq, tq = cre[dir] * pq + cim[dir] * pr; const float mine = im ? -tq : tr; ref = __shfl(mine, p2); got = bf2f(M[(dir == 0 ? 65536 : 98304) + (size_t)(16 * t + hp) * 128 + 2 * p2 + im]); }
        else {
            const int dir = which - 3, ex = dir == 0 ? 15 - sx : sx; float pr = 1.f, pq = 0.f; for (int e = 0; e < ex; ++e) { const float nr = pr * are[dir] - pq * aim[dir], nq = pr * aim[dir] + pq * are[dir]; pr = nr; pq = nq; }
            const float tr = pr * bre[dir] - pq * bim[dir], tq = pr * bim[dir] + pq * bre[dir]; const float mine = im ? tq : tr; ref = __shfl(mine, p2); got = bf2f(M[(dir == 0 ? 131072 : 163840) + (size_t)(2 * p2 + im) * 256 + 16 * sx + h]); }
        (void)dsel; add(ws, which == 0 ? ((t == sx && h == hp) ? k : 35) : which <= 2 ? 36 : 37, got, ref, lane); }
}

__device__ __forceinline__ void chk_s5x(unsigned char* ws, const float* const* in, int gw, int ngw, int lane) {
    const int l = 0, b = 0;
    for (int s = gw; s < 512; s += ngw) { const unsigned hh = hash(s, 900); const int g = hh & 15, dir = (hh >> 5) & 1, c = (hh >> 8) % 272, im = (hh >> 20) & 1, psel = (hh >> 24) & 63;
        const bf16* U = (const bf16*)(ws + P_UG) + (size_t)(b * 32 + g) * LPOS * 16; const int pi = ((l * 2 + dir) * 32 + g) * 64 + lane;
        const float lr = fminf(in[17][pi], -1e-4f), li = in[18][pi], dt = expf(in[19][(l * 2 + dir) * 32 + g]); const float mag = expf(lr * dt), abr = mag * cosf(li * dt), abi = mag * sinf(li * dt), den = lr * lr + li * li;
        const float fr = ((abr - 1.f) * lr + abi * li) / den, fi = (abi * lr - (abr - 1.f) * li) / den; float bbr[16], bbi[16];
        _Pragma("unroll") for (int h = 0; h < 16; ++h) { const float br = in[20][(size_t)pi * 16 + h], bi = in[21][(size_t)pi * 16 + h]; bbr[h] = fr * br - fi * bi; bbi[h] = fr * bi + fi * br; }
        float xr = 0.f, xi = 0.f;
        for (int st = 0; st < LPOS; ++st) { const int p = dir == 0 ? st : (st < 256 ? 255 - st : LPOS + 255 - st);
            if ((p >> 4) == c) break;
            float vr = 0.f, vi = 0.f;
            _Pragma("unroll") for (int h = 0; h < 16; ++h) { const float u = bf2f(U[(size_t)p * 16 + h]); vr += bbr[h] * u; vi += bbi[h] * u; }
            const float nr = abr * xr - abi * xi + vr, ni = abr * xi + abi * xr + vi; xr = nr; xi = ni; }
        const float mine = im ? xi : xr; const float ref = __shfl(mine, psel);
        {
          float er = 0.f, ei = 0.f;
          for (int q = 0; q < 16; ++q) { const int sx = dir == 0 ? q : 15 - q, p = 16 * c + sx; float vr = 0.f, vi = 0.f;
              _Pragma("unroll") for (int h = 0; h < 16; ++h) { const float u = bf2f(U[(size_t)p * 16 + h]); vr += bbr[h] * u; vi += bbi[h] * u; }
              const float nr = abr * er - abi * ei + vr, ni = abr * ei + abi * er + vi; er = nr; ei = ni; }
          const float m2 = im ? ei : er; const float r2 = __shfl(m2, psel);
          const bf16* E = (const bf16*)(ws + WS_POOL + 98 * MiB) + (size_t)g * 69632 + (size_t)dir * 34816;
          add(ws, 39, bf2f(E[c * 128 + 2 * psel + im]), r2, lane); }
        const bf16* X = (const bf16*)(ws + WS_POOL + 94 * MiB) + (size_t)g * 69632 + (size_t)dir * 34816;
        add(ws, 38, bf2f(X[c * 128 + 2 * psel + im]), ref, lane); }
}
__device__ __forceinline__ void encode(unsigned char* ws, const float* x, float* outp, int nchk, int gt, int ngt) {
    const float* d = (const float*)(ws + WS_CTL) + CW_DBG; int bad = -1; float eb = 0.f;
#ifdef DBG_REPORT
    { const int k = DBG_REPORT; const float e = sqrtf(d[2 * k] / fmaxf(d[2 * k + 1], 1e-30f)); const float F = 1.f + 1e14f * fminf(e * e, 1e4f) + 1e3f;
      for (size_t i = gt; i < (size_t)NLAT * 1024; i += ngt) outp[i] = x[i] * F; return; }
#endif
    for (int k = 0; k < 30; ++k) { const float e = sqrtf(d[2 * k] / fmaxf(d[2 * k + 1], 1e-30f)); const bool unused = d[2 * k + 1] == 0.f && d[2 * k] == 0.f; if (!unused && !(e < 0.02f)) { bad = k; eb = e; break; } }
    if (bad < 0) return;
    float F = 1.f; for (int i = 0; i <= bad; ++i) F *= 4.f; F = 1.f + F * (1.f + fminf(eb, 0.99f));
    for (size_t i = gt; i < (size_t)NLAT * 1024; i += ngt) outp[i] = x[i] * F;
}
}
struct Args;
#endif

struct Args { const float* in[38]; float* out; unsigned char* ws; int ph_lo, ph_hi; };
constexpr int PH_PRO = 0, PH_R0 = 1, PH_L0 = 2, PH_PER_L = 16, NPH = PH_L0 + 2 * PH_PER_L;


#if MK_DEBUG
constexpr int DBG_NCHK = 40;
__global__ void __launch_bounds__(NTHREADS, 2) dbg_fwd(Args args, int ph) {
    unsigned char* ws = args.ws; float* outp = args.out; const float* const* in = args.in;
    const int tid = threadIdx.x, lane = tid & 63, wave = tid >> 6, gw = blockIdx.x * NWAVES + wave, ngw = gridDim.x * NWAVES;
    const float* par = (const float*)(ws + WS_PAR);
    if (ph == 1000) { dbg::encode(ws, in[0], outp, DBG_NCHK, blockIdx.x * NTHREADS + tid, gridDim.x * NTHREADS); return; }
    if (ph == PH_PRO) { dbg::chk_mod(ws, in, gw, ngw, lane); dbg::chk_weights(ws, in, gw, ngw, lane); dbg::chk_s5m(ws, in, 16, gw, ngw, lane); return; }
    if (ph == PH_R0) { dbg::chk_h(ws, in, outp, 2, 0, 0, par + PR_GMIXPRE, MALL, gw, ngw, lane); return; }
    const int l = (ph - PH_L0) / PH_PER_L, rel = (ph - PH_L0) % PH_PER_L, kb = 3 + 14 * l; const bool lastl = l == 1; const int nrq = lastl ? NLAT : MALL;
    if (rel == 0) { const bf16* Z = (const bf16*)(ws + P_Z);
        dbg::chk_gemm(ws, kb + 0, (const bf16*)(ws + P_H), 1024, in[10] + (size_t)l * 1024 * NIN, NIN, 1024, MALL, NIN, [=](int row, int col, float ref, float& got, float& rr) {
            const int j = col, dr = j < 512 ? j : j < 896 ? 768 + (j - 512) : j < 1024 ? 512 + (j - 896) : j < 1152 ? 640 + (j - 1024) : j < 1440 ? j : 1536 + (j - 1440); got = bf2f(Z[(size_t)row * ZW + dr]); rr = ref; }, gw, ngw, lane); }
    if (rel == 1) dbg::chk_tok(ws, kb + 1, l, gw, ngw, lane);
    if (rel == 2) {
        const bf16* QB = (const bf16*)(ws + P_QB); const bf16* CQ = (const bf16*)(ws + P_CQN); const float* Wq = in[15] + (size_t)l * 384 * 768; const float scale = 0.10206207261596575f * LOG2E;
        dbg::chk_gemm(ws, kb + 2, CQ, 384, Wq, 768, 384, nrq, 768, [=](int row, int col, float ref, float& got, float& rr) {
            const int hd = col / 96, e = col % 96; float v = ref;
            if (e >= 64 && row < NLAT) { const int i = (e - 64) & 15; const float x1 = dbg::dot_aw(CQ + (size_t)row * 384, Wq + hd * 96 + 64 + i, 768, 384, lane), x2 = dbg::dot_aw(CQ + (size_t)row * 384, Wq + hd * 96 + 80 + i, 768, 384, lane);
                const float an = dbg::angB(row & 4095, i), c = cosf(an), sn = sinf(an); v = e < 80 ? x1 * c - x2 * sn : x1 * sn + x2 * c; }
            got = bf2f(QB[(size_t)row * 768 + col]); rr = v * scale; }, gw, ngw, lane);
        const bf16* KB = (const bf16*)(ws + P_KB); const bf16* VB = (const bf16*)(ws + P_VB);
        dbg::chk_gemm(ws, kb + 3, (const bf16*)(ws + P_CKVN), 256, in[16] + (size_t)l * 256 * 1024, 1024, 256, MALL, 1024, [=](int row, int col, float ref, float& got, float& rr) {
            const int hd = col / 128, e = col % 128; got = e < 64 ? bf2f(KB[(size_t)row * 512 + hd * 64 + e]) : bf2f(VB[(size_t)row * 512 + hd * 64 + e - 64]); rr = ref; }, gw, ngw, lane); }
    if (rel == 3) { dbg::chk_attn(ws, kb + 4, lastl, gw, ngw, lane); dbg::chk_s5(ws, in, kb + 5, l, lastl, gw, ngw, lane); if (l == 0) dbg::chk_s5x(ws, in, gw, ngw, lane); }
    if (rel == 4) { const bf16* AG = (const bf16*)(ws + P_AGLU); const bf16* YB = (const bf16*)(ws + P_YBR); const float* Wg = in[25] + (size_t)l * 512 * 1024;
        dbg::chk_gemm(ws, kb + 6, AG, 512, Wg, 1024, 512, nrq, 512, [=](int row, int col, float ref, float& got, float& rr) {
            const float g = dbg::dot_aw(AG + (size_t)row * 512, Wg + 512 + col, 1024, 512, lane); got = bf2f(YB[(size_t)row * 1536 + 1024 + col]); rr = ref / (1.f + expf(-g)); }, gw, ngw, lane); }
    if (rel == 5) { const bf16* H = (const bf16*)(ws + P_H); const bf16* YB = (const bf16*)(ws + P_YBR); const bf16* MG = (const bf16*)(ws + P_MRG);
        const float* Wm = in[27] + (size_t)l * 1024 * 3072; const float* Wb = in[26] + (size_t)l * 3 * 512 * 1024; const float* bm = in[28] + l * 3072;
        for (int s = gw; s < 512; s += ngw) { const unsigned hh = dbg::hash(s, 333 + l); const int row = hh % nrq, col = (hh >> 16) % 1024; float acc = 0.f;
            for (int n = 0; n < 3; ++n) { const float g = dbg::dot_aw(H + (size_t)row * 1024, Wm + n * 1024 + col, 3072, 1024, lane) + bm[n * 1024 + col];
                const float p = dbg::dot_aw(YB + (size_t)row * 1536 + n * 512, Wb + (size_t)n * 512 * 1024 + col, 1024, 512, lane); acc += p / (1.f + expf(-g)); }
            dbg::add(ws, kb + 7, bf2f(MG[(size_t)row * 1024 + col]), acc, lane); } }
    if (rel == 6) { const float* Y = (const float*)(ws + P_Y);
        dbg::chk_gemm(ws, kb + 8, (const bf16*)(ws + P_MRG), 1024, in[29] + (size_t)l * 1024 * 1024, 1024, 1024, nrq, 1024, [=](int row, int col, float ref, float& got, float& rr) { got = Y[(size_t)row * 1024 + col]; rr = ref; }, gw, ngw, lane); }
    if (rel == 7) dbg::chk_h(ws, in, outp, kb + 9, l, 3, par + PR_GFFNPRE + l * 1024, nrq, gw, ngw, lane);
    if (!lastl) {
        if (rel == 8) { const bf16* H = (const bf16*)(ws + P_H); const bf16* ACT = (const bf16*)(ws + P_ACT);
            dbg::chk_gemm(ws, kb + 10, H, 1024, in[30], DFF, 1024, MALL, DFF, [=](int row, int col, float ref, float& got, float& rr) {
                const float b = dbg::dot_aw(H + (size_t)row * 1024, in[31] + col, DFF, 1024, lane); got = bf2f(ACT[(size_t)row * DFF + col]); rr = ref / (1.f + expf(-ref)) * b; }, gw, ngw, lane); }
        if (rel == 9) { const float* Y2 = (const float*)(ws + P_Y2);
            dbg::chk_gemm(ws, kb + 11, (const bf16*)(ws + P_ACT), DFF, in[32], 1024, DFF, MALL, 1024, [=](int row, int col, float ref, float& got, float& rr) { got = Y2[(size_t)row * 1024 + col]; rr = ref; }, gw, ngw, lane); }
        if (rel == 12) dbg::chk_h(ws, in, outp, kb + 12, 1, 0, par + PR_GMIXPRE + 1024, MALL, gw, ngw, lane);
    } else if (rel == 11) {
        const bf16* H = (const bf16*)(ws + P_H); const bf16* FO = (const bf16*)(ws + P_Y2); const unsigned* cnt = (const unsigned*)(ws + WS_CTL) + CW_CNT; const int* ti = (const int*)(ws + WS_LIST) + 8 * 16384;
        for (int s = gw; s < 64; s += ngw) { const unsigned hh = dbg::hash(s, 555); const int tok = hh % NLAT, kk = (hh >> 16) & 1, c = (hh >> 17) % 1024; const int e = ti[tok * 8 + 2 * kk], pos = ti[tok * 8 + 2 * kk + 1];
            int base = 0; for (int q = 0; q < e; ++q) base += ((int)cnt[q] + 255) >> 8;
            float acc = 0.f;
            for (int j = 0; j < DFF; ++j) { const float a = dbg::dot_aw(H + (size_t)tok * 1024, in[35] + (size_t)e * 1024 * DFF + j, DFF, 1024, lane), b = dbg::dot_aw(H + (size_t)tok * 1024, in[36] + (size_t)e * 1024 * DFF + j, DFF, 1024, lane);
                acc += dbg::rbf(a / (1.f + expf(-a)) * b) * dbg::rbf(in[37][((size_t)e * DFF + j) * 1024 + c]); }
            dbg::add(ws, kb + 10, bf2f(FO[((size_t)base * 256 + pos) * 1024 + c]), acc, lane); } }
}
#endif

#ifndef PHMASK
#define PHMASK 0xFFFFFFFFu
#endif
#define PHON(k) (((PHMASK) >> (k)) & 1u)
#ifndef REPMASK
#define REPMASK 0u
#endif
#define REPON(k) (((REPMASK) >> (k)) & 1u)

__device__ __forceinline__ ResidArgs Rd(ResidArgs R, int rep) { R.dry = rep > 0; return R; }
__global__ void __launch_bounds__(NTHREADS, 2) mk_fwd(Args args) {
    extern __shared__ __attribute__((aligned(16))) unsigned char lds_raw[];
    LAS unsigned char* lds = (LAS unsigned char*)lds_raw;
    const int wave = __builtin_amdgcn_readfirstlane((int)threadIdx.x >> 6);
#define tid (wave * 64 + lane_id())
    const int G = gridDim.x, bx = blockIdx.x; const int vcu = (G % 8 == 0) ? (bx % 8) * (G / 8) + bx / 8 : bx;
    unsigned char* ws0 = args.ws; float* outp = args.out;
    unsigned char* ws = ws0;
    volatile LAS unsigned* misc = (volatile LAS unsigned*)(lds + LDS_MISC);
    LAS int* tb; { unsigned tba_ = (unsigned)(uintptr_t)(lds + LDS_MISC + 64); asm volatile("" : "+s"(tba_)); tb = (LAS int*)(uintptr_t)tba_; }
    if (tid < 64) misc[tid] = 0u;
    __syncthreads();
    const int lo = args.ph_lo, hi = args.ph_hi;
    XcdBarrier bar; bar.bar = (unsigned*)(ws + WS_CTL) + CW_BAR; bar.x = 0; bar.st = misc; bar.wave = wave;
    if (hi - lo > 1) bar = xcd_barrier_post((unsigned*)(ws + WS_CTL) + CW_BAR, misc, wave);
#define IN(k) (lo <= (k) && (k) < hi)
#define SEAM(k) do { if ((k) + 1 < hi) xcd_barrier(bar); } while (0)
    const int gw = vcu * NWAVES + wave, ngw = G * NWAVES;

    if (PHON(0) && IN(PH_PRO)) for (int rep_ = 0; rep_ <= (int)REPON(0); ++rep_) {
            GAS unsigned char* wsq = (GAS unsigned char*)ws0; asm volatile("" : "+s"(wsq)); unsigned char* const ws = (unsigned char*)wsq; const float* const par = (const float*)(ws + WS_PAR); int lnq = lane_id(); asm volatile("" : "+v"(lnq)); const int lane = lnq; (void)par; (void)lane;
        Ptrs P;
        { const float* const* in = args.in;
          P.x = in[0]; P.c = in[1]; P.ctx = in[2]; P.c_ctx = in[3]; P.w_mod = in[4]; P.b_mod = in[5]; P.g_mix_pre = in[6]; P.g_mix_post = in[7]; P.g_ffn_pre = in[8]; P.g_ffn_post = in[9];
          P.w_in = in[10]; P.g_q = in[11]; P.g_k = in[12]; P.g_cq = in[13]; P.g_ckv = in[14]; P.w_uq = in[15]; P.w_ukv = in[16];
          P.s5p.lam_re = in[17]; P.s5p.lam_im = in[18]; P.s5p.log_dt = in[19]; P.s5p.b_re = in[20]; P.s5p.b_im = in[21]; P.s5p.c_re = in[22]; P.s5p.c_im = in[23]; P.s5p.dsk = in[24];
          P.w_glu = in[25]; P.w_branch = in[26]; P.w_mg = in[27]; P.b_mg = in[28]; P.w_out = in[29]; P.ffn_w1 = in[30]; P.ffn_w3 = in[31]; P.ffn_w2 = in[32];
          P.router_w = in[33]; P.router_b = in[34]; P.moe_w1 = in[35]; P.moe_w3 = in[36]; P.moe_w2 = in[37]; P.out = args.out; P.ws = args.ws; }
#ifndef PRO_ONLYT
#define PRO_ONLYT 0
#endif
        if (!(PRO_ONLYT && rep_ > 0)) {
        copy_params(P, bx * NTHREADS + tid, G * NTHREADS);
        for (int it = bx; it < 192 + 64; it += G) {
            if (it < 192) mod_item(P, it, lds, wave);
#ifndef PRO_SKIPB
#define PRO_SKIPB 0
#endif
            else if (!(PRO_SKIPB && rep_ > 0)) { const int q = it - 192, l = q >> 5, g = q & 31; s5::build_mats(P.s5p, l, g, (bf16*)(ws + WS_S5M) + (size_t)(l * 32 + g) * s5::M_TOTAL, lds, wave); }
        }
        rope_tables(P, bx * NTHREADS + tid, G * NTHREADS);
        }
        __syncthreads();
#ifndef PRO_NOT
#define PRO_NOT 0
#endif
        if (!(PRO_NOT && rep_ > 0)) transposes(P, gw, ngw, (LAS float*)(lds + wave * 16384), lane, rep_);
        SEAM(PH_PRO);
    }
    if (PHON(1) && IN(PH_R0)) for (int rep_ = 0; rep_ <= (int)REPON(1); ++rep_) {
            GAS unsigned char* wsq = (GAS unsigned char*)ws0; asm volatile("" : "+s"(wsq)); unsigned char* const ws = (unsigned char*)wsq; const float* const par = (const float*)(ws + WS_PAR); int lnq = lane_id(); asm volatile("" : "+v"(lnq)); const int lane = lnq; (void)par; (void)lane;
        ResidArgs R{}; R.mode = 0; R.g_pre = par + PR_GMIXPRE; R.shift_chunk = 0; R.hout = (bf16*)(ws + P_H); R.l_mod = 0; R.route = false; R.hout8 = ws + P_H8;
        const float* xin = args.in[0]; const float* ctxin = args.in[2];
        { int row = gw; for (; row + ngw < MALL; row += 2 * ngw) { resid_row(ws, outp, xin, ctxin, Rd(R, rep_), row, lane, tb); resid_row(ws, outp, xin, ctxin, Rd(R, rep_), row + ngw, lane, tb); } if (row < MALL) resid_row(ws, outp, xin, ctxin, Rd(R, rep_), row, lane, tb); }
        SEAM(PH_R0);
    }
#define MOE_TAIL(lo_pm, hi_pm) do { if (l == 0 && bx >= 16) { const int lane_ = lane_id(); \
            moe_transposes(args.in[35], args.in[36], args.in[37], ws, (int)((long)MOE_ITEMS * (lo_pm) / 1000), (int)((long)MOE_ITEMS * (hi_pm) / 1000), (bx - 16) * NWAVES + wave, (G - 16) * NWAVES, (LAS float*)(lds + wave * 16384), lane_); } } while (0)
    for (int l = 0; l < 2; ++l) {
        const int pb = PH_L0 + l * PH_PER_L; const bool lastl = (l == 1);
        const int nMall = 68, nMq = lastl ? 64 : 68;
        if (PHON(2) && IN(pb + 0)) for (int rep_ = 0; rep_ <= (int)REPON(2); ++rep_) {
            GAS unsigned char* wsq = (GAS unsigned char*)ws0; asm volatile("" : "+s"(wsq)); unsigned char* const ws = (unsigned char*)wsq; const float* const par = (const float*)(ws + WS_PAR); int lnq = lane_id(); asm volatile("" : "+v"(lnq)); const int lane = lnq; (void)par; (void)lane;
            if (F8_G1L1 && lastl) {
                pg8::SchedPlain S{(const char*)(ws + P_H8), (const char*)(ws + WS_W1T) + (size_t)l * ZW * 2048, 1024u, 1024u, 8, nMall, 8, G, bx};
                pg8::EpiBf16S E{(bf16*)(ws + P_Z), ZW, 1.0f / (F8_HSCALE * F8_WSCALE)};
                pg8::gemm_phase<pg8::EpiBf16S, pg8::SchedPlain, false, true>(lds, S, E, wave);
            } else {
            pg8::SchedPlain S{(const char*)(ws + P_H), (const char*)(ws + WS_W1T) + (size_t)l * ZW * 2048, 2048u, 2048u, 16, nMall, 8, G, bx};
            pg8::EpiBf16 E{(bf16*)(ws + P_Z), ZW, 0};
            pg8::gemm_phase<pg8::EpiBf16, pg8::SchedPlain, false>(lds, S, E, wave); }
            SEAM(pb + 0);
        }
        if (PHON(3) && IN(pb + 1)) for (int rep_ = 0; rep_ <= (int)REPON(3); ++rep_) {
            GAS unsigned char* wsq = (GAS unsigned char*)ws0; asm volatile("" : "+s"(wsq)); unsigned char* const ws = (unsigned char*)wsq; const float* const par = (const float*)(ws + WS_PAR); int lnq = lane_id(); asm volatile("" : "+v"(lnq)); const int lane = lnq; (void)par; (void)lane;
            { int row = gw; for (; row + ngw < MALL; row += 2 * ngw) { token_row(ws, l, row, lane); token_row(ws, l, row + ngw, lane); } if (row < MALL) token_row(ws, l, row, lane); }
            SEAM(pb + 1);
        }
        if (PHON(4) && IN(pb + 2)) for (int rep_ = 0; rep_ <= (int)REPON(4); ++rep_) {
            GAS unsigned char* wsq = (GAS unsigned char*)ws0; asm volatile("" : "+s"(wsq)); unsigned char* const ws = (unsigned char*)wsq; const float* const par = (const float*)(ws + WS_PAR); int lnq = lane_id(); asm volatile("" : "+v"(lnq)); const int lane = lnq; (void)par; (void)lane;
            { pg8::SchedUp S{(const char*)(ws + P_CQN), (const char*)(ws + WS_WUQT) + (size_t)l * 768 * 768, (const char*)(ws + P_CKVN), (const char*)(ws + WS_WUKVT) + (size_t)l * 1024 * 512, nMq, nMall, G, bx};
              pg8::EpiUp E{pg8::EpiUq{(bf16*)(ws + P_QB), (const float*)(ws + WS_ROPE) + 2 * 4096 * 32, (const float*)(ws + WS_ROPE) + 2 * 4096 * 32 + 4096 * 16, 0.10206207261596575f * LOG2E}, pg8::EpiUkv{(bf16*)(ws + P_KB), (bf16*)(ws + P_VB)}};
              pg8::gemm_phase<pg8::EpiUp, pg8::SchedUp, false>(lds, S, E, wave); }
            SEAM(pb + 2);
        }
        if (PHON(5) && IN(pb + 3)) for (int rep_ = 0; rep_ <= (int)REPON(5); ++rep_) {
            GAS unsigned char* wsq = (GAS unsigned char*)ws0; asm volatile("" : "+s"(wsq)); unsigned char* const ws = (unsigned char*)wsq; const float* const par = (const float*)(ws + WS_PAR); int lnq = lane_id(); asm volatile("" : "+v"(lnq)); const int lane = lnq; (void)par; (void)lane;
            const int nlatu = 1024, nctxu = lastl ? 0 : 64;
            for (int it = vcu; it < nlatu + nctxu; it += G) {
                att::AttnArgs A; int typ, b, h;
                if (it < nlatu) { const int u = it >> 1; typ = (it ^ (it >> 8)) & 1;
                    b = u >> 7; h = (u >> 4) & 7; const int qb = u & 15; A.qrow0 = (long)b * SEQ + qb * 256; A.ntiles = 68; }
                else { const int u = it - nlatu; typ = u & 1; b = (u >> 1) >> 3; h = (u >> 1) & 7; A.qrow0 = NLAT + (long)b * CTXL; A.ntiles = 4; }
                A.b = b; A.O = (bf16*)(ws + P_YBR); A.opitch = 1536;
                if (typ == 0) { A.Q = (const bf16*)(ws + P_QA); A.qpitch = 512; A.qcol = h * 64; A.K1 = (const bf16*)(ws + P_KA); A.k1pitch = 128; A.k1col = (h >> 2) * 64; A.K2 = nullptr; A.k2pitch = 0;
                    A.V = (const bf16*)(ws + P_VA); A.vpitch = 128; A.vcol = (h >> 2) * 64; A.ocol = h * 64; att::attn_unit4<64>(A, lds, wave); }
                else { A.Q = (const bf16*)(ws + P_QB); A.qpitch = 768; A.qcol = h * 96; A.K1 = (const bf16*)(ws + P_KB); A.k1pitch = 512; A.k1col = h * 64; A.K2 = (const bf16*)(ws + P_KRR); A.k2pitch = 32;
                    A.V = (const bf16*)(ws + P_VB); A.vpitch = 512; A.vcol = h * 64; A.ocol = 512 + h * 64; att::attn_unit4<96>(A, lds, wave); }
            }
            __syncthreads();
#ifndef S5REP
#define S5REP 1
#endif
            for (int s5r_ = 0; s5r_ < S5REP; ++s5r_)
            for (int it = G - 1 - vcu; it < 256; it += G) { const int b = it >> 6, g = (it >> 1) & 31, half = it & 1;
                s5::unit(par + PR_A16, l, b, g, (const bf16*)(ws + P_UG), (const bf16*)(ws + WS_S5M) + (size_t)(l * 32 + g) * s5::M_TOTAL, (bf16*)(ws + P_AGLU), lastl, lds, wave, half); }
            SEAM(pb + 3);
        }
        if (PHON(6) && IN(pb + 4)) for (int rep_ = 0; rep_ <= (int)REPON(6); ++rep_) {
            GAS unsigned char* wsq = (GAS unsigned char*)ws0; asm volatile("" : "+s"(wsq)); unsigned char* const ws = (unsigned char*)wsq; const float* const par = (const float*)(ws + WS_PAR); int lnq = lane_id(); asm volatile("" : "+v"(lnq)); const int lane = lnq; (void)par; (void)lane;
            pg8::SchedPlain S{(const char*)(ws + P_AGLU), (const char*)(ws + WS_WGLUT) + (size_t)l * 1024 * 1024, 1024u, 1024u, 8, nMq, 4, G, bx};
            pg8::EpiPair<0> E{(bf16*)(ws + P_YBR), 1536, 1024, 0};
            pg8::gemm_phase<pg8::EpiPair<0>, pg8::SchedPlain, false>(lds, S, E, wave);
            SEAM(pb + 4);
        }
        if (PHON(7) && IN(pb + 5)) for (int rep_ = 0; rep_ <= (int)REPON(7); ++rep_) {
            GAS unsigned char* wsq = (GAS unsigned char*)ws0; asm volatile("" : "+s"(wsq)); unsigned char* const ws = (unsigned char*)wsq; const float* const par = (const float*)(ws + WS_PAR); int lnq = lane_id(); asm volatile("" : "+v"(lnq)); const int lane = lnq; (void)par; (void)lane;
#define MRG_ROUND(r) do { \
                { pg8::SchedMergeG S{(const char*)(ws + P_H8), (const char*)(ws + WS_WMGT) + (size_t)l * 3072 * 1024, 1024u, 1024u, 8, nMq, (r) * G + bx}; \
                  pg8::EpiGate E{par + PR_BMG + l * 3072, (u32x4*)(ws + P_GSCR + (size_t)bx * 3 * 131072), 1.0f / (F8_HSCALE * F8_WSCALE)}; \
                  pg8::gemm_phase<pg8::EpiGate, pg8::SchedMergeG, false, true>(lds, S, E, wave); } \
                { pg8::SchedMergeP S{(const char*)(ws + P_YBR), (const char*)(ws + WS_WBT) + (size_t)l * 3 * 1024 * 1024, 3072u, 1024u, 8, nMq, (r) * G + bx}; \
                  pg8::EpiMergeP E{(bf16*)(ws + P_MRG), (const u32x4*)(ws + P_GSCR + (size_t)bx * 3 * 131072)}; \
                  pg8::gemm_phase<pg8::EpiMergeP, pg8::SchedMergeP, false, false>(lds, S, E, wave); } } while (0)
            MRG_ROUND(0);
            if (G < nMq * 4) MRG_ROUND(1);
#undef MRG_ROUND
            MOE_TAIL(0, 480);
            SEAM(pb + 5);
        }
        if (PHON(8) && IN(pb + 6)) for (int rep_ = 0; rep_ <= (int)REPON(8); ++rep_) {
            GAS unsigned char* wsq = (GAS unsigned char*)ws0; asm volatile("" : "+s"(wsq)); unsigned char* const ws = (unsigned char*)wsq; const float* const par = (const float*)(ws + WS_PAR); int lnq = lane_id(); asm volatile("" : "+v"(lnq)); const int lane = lnq; (void)par; (void)lane;
            pg8::SchedPlain S{(const char*)(ws + P_MRG), (const char*)(ws + WS_WOUTT) + (size_t)l * 1024 * 2048, 2048u, 2048u, 16, nMq, 4, G, bx};
            pg8::EpiBf16 E{(bf16*)(ws + P_Y), 1024, 0};
            pg8::gemm_phase<pg8::EpiBf16, pg8::SchedPlain, false>(lds, S, E, wave);
            MOE_TAIL(480, 620);
            SEAM(pb + 6);
        }
        if (PHON(9) && IN(pb + 7)) for (int rep_ = 0; rep_ <= (int)REPON(9); ++rep_) {
            GAS unsigned char* wsq = (GAS unsigned char*)ws0; asm volatile("" : "+s"(wsq)); unsigned char* const ws = (unsigned char*)wsq; const float* const par = (const float*)(ws + WS_PAR); int lnq = lane_id(); asm volatile("" : "+v"(lnq)); const int lane = lnq; (void)par; (void)lane;
            ResidArgs R{}; R.mode = 3; R.y = (const float*)(ws + P_Y); R.g_post = par + PR_GMIXPOST + l * 1024; R.gate_chunk = 2; R.g_pre = par + PR_GFFNPRE + l * 1024; R.shift_chunk = 3;
            R.hout = (bf16*)(ws + P_H); R.l_mod = l; R.l_gate = l; R.route = lastl; R.h8 = lastl ? (F8_M1 != 0) : (F8_D1 != 0); R.ysc = 1.0f;
            { int row = gw; for (; row + ngw < nMq * 256; row += 2 * ngw) { resid_row(ws, outp, nullptr, nullptr, Rd(R, rep_), row, lane, tb); resid_row(ws, outp, nullptr, nullptr, Rd(R, rep_), row + ngw, lane, tb); } if (row < nMq * 256) resid_row(ws, outp, nullptr, nullptr, Rd(R, rep_), row, lane, tb); }
            SEAM(pb + 7);
        }
        if (!lastl) {
            if (PHON(10) && IN(pb + 8)) for (int rep_ = 0; rep_ <= (int)REPON(10); ++rep_) {
            GAS unsigned char* wsq = (GAS unsigned char*)ws0; asm volatile("" : "+s"(wsq)); unsigned char* const ws = (unsigned char*)wsq; const float* const par = (const float*)(ws + WS_PAR); int lnq = lane_id(); asm volatile("" : "+v"(lnq)); const int lane = lnq; (void)par; (void)lane;
                constexpr unsigned kb1 = F8_D1 ? 1024u : 2048u;
                pg8::SchedPlain S{(const char*)(ws + P_H), (const char*)(ws + WS_WF1T), kb1, kb1, F8_D1 ? 8 : 16, nMall, 22, G, bx};
                pg8::EpiPairS<F8_D2 != 0> E{ws + P_ACT, DFF, 0, F8_D1 ? 1.0f / (F8_HSCALE * F8_WSCALE) : 1.0f, F8_D2 ? F8_ASCALE : 1.0f};
                pg8::gemm_phase<pg8::EpiPairS<F8_D2 != 0>, pg8::SchedPlain, false, F8_D1 != 0>(lds, S, E, wave);
                SEAM(pb + 8);
            }
            if (PHON(11) && IN(pb + 9)) for (int rep_ = 0; rep_ <= (int)REPON(11); ++rep_) {
            GAS unsigned char* wsq = (GAS unsigned char*)ws0; asm volatile("" : "+s"(wsq)); unsigned char* const ws = (unsigned char*)wsq; const float* const par = (const float*)(ws + WS_PAR); int lnq = lane_id(); asm volatile("" : "+v"(lnq)); const int lane = lnq; (void)par; (void)lane;
                constexpr unsigned kb2 = F8_D2 ? 2816u : 5632u;
                pg8::SchedPlain S{(const char*)(ws + P_ACT), (const char*)(ws + WS_WF2T), kb2, kb2, F8_D2 ? 22 : 44, nMall, 4, G, bx};
                pg8::EpiBf16 E{(bf16*)(ws + P_Y2), 1024, 0};
                pg8::gemm_phase<pg8::EpiBf16, pg8::SchedPlain, false, F8_D2 != 0>(lds, S, E, wave);
                MOE_TAIL(620, 1000);
                SEAM(pb + 9);
            }
            if (PHON(14) && IN(pb + 12)) for (int rep_ = 0; rep_ <= (int)REPON(14); ++rep_) {
            GAS unsigned char* wsq = (GAS unsigned char*)ws0; asm volatile("" : "+s"(wsq)); unsigned char* const ws = (unsigned char*)wsq; const float* const par = (const float*)(ws + WS_PAR); int lnq = lane_id(); asm volatile("" : "+v"(lnq)); const int lane = lnq; (void)par; (void)lane;
                ResidArgs R{}; R.mode = 3; R.y = (const float*)(ws + P_Y2); R.g_post = par + PR_GFFNPOST; R.gate_chunk = 5; R.g_pre = par + PR_GMIXPRE + 1024; R.shift_chunk = 0;
                R.hout = (bf16*)(ws + P_H); R.l_mod = 1; R.l_gate = 0; R.route = false; R.hout8 = ws + P_H8; R.ysc = F8_D2 ? 1.0f / (F8_ASCALE * F8_WSCALE) : 1.0f;
                { int row = gw; for (; row + ngw < MALL; row += 2 * ngw) { resid_row(ws, outp, nullptr, nullptr, Rd(R, rep_), row, lane, tb); resid_row(ws, outp, nullptr, nullptr, Rd(R, rep_), row + ngw, lane, tb); } if (row < MALL) resid_row(ws, outp, nullptr, nullptr, Rd(R, rep_), row, lane, tb); }
                SEAM(pb + 12);
            }
        } else {
            for (int ch = 0; ch < 1; ++ch) {
                if (IN(pb + 8 + 2 * ch) || IN(pb + 9 + 2 * ch)) {
                    __syncthreads();
                    if (tid == 0) { const unsigned* cnt = (const unsigned*)(ws + WS_CTL) + CW_CNT; int acc = 0;
                        for (int e = 0; e < 8; ++e) { const int c = (int)__hip_atomic_load(cnt + e, __ATOMIC_RELAXED, __HIP_MEMORY_SCOPE_AGENT); tb[e] = c; tb[8 + e] = acc; acc += (c + 255) >> 8; }
                        tb[16] = acc; }
                    __syncthreads();
                }
                const int ntot = __builtin_amdgcn_readfirstlane(tb[16]), t0 = 0, t1 = ntot;
                if (PHON(12) && IN(pb + 8 + 2 * ch)) for (int rep_ = 0; rep_ <= (int)REPON(12); ++rep_) {
            GAS unsigned char* wsq = (GAS unsigned char*)ws0; asm volatile("" : "+s"(wsq)); unsigned char* const ws = (unsigned char*)wsq; const float* const par = (const float*)(ws + WS_PAR); int lnq = lane_id(); asm volatile("" : "+v"(lnq)); const int lane = lnq; (void)par; (void)lane;
                    constexpr unsigned kbm = F8_M1 ? 1024u : 2048u;
                    pg8::SchedMoe1 S{(const char*)(ws + P_H), (const char*)(ws + WS_WM1T), kbm, kbm, F8_M1 ? 8 : 16, (const int*)(ws + WS_LIST), tb, t1, G, bx, nullptr};
                    if (S.units() <= 16) { LAS unsigned* rtab = (LAS unsigned*)(lds + 131072); S.fill(rtab, wave * 64 + lane); S.rt = rtab; }
                    __syncthreads();
                    pg8::EpiPairS<true> E{ws + P_ACT, DFF, 0, F8_M1 ? 1.0f / (F8_HSCALE * F8_WSCALE) : 1.0f, F8_ASCALE};
                    pg8::gemm_phase<pg8::EpiPairS<true>, pg8::SchedMoe1, true, F8_M1 != 0>(lds, S, E, wave);
                    SEAM(pb + 8 + 2 * ch);
                }
                if (PHON(13) && IN(pb + 9 + 2 * ch)) for (int rep_ = 0; rep_ <= (int)REPON(13); ++rep_) {
            GAS unsigned char* wsq = (GAS unsigned char*)ws0; asm volatile("" : "+s"(wsq)); unsigned char* const ws = (unsigned char*)wsq; const float* const par = (const float*)(ws + WS_PAR); int lnq = lane_id(); asm volatile("" : "+v"(lnq)); const int lane = lnq; (void)par; (void)lane;
                    pg8::SchedMoe2 S{(const char*)(ws + P_ACT), (const char*)(ws + WS_WM2T), 2816u, 2816u, 22, tb, t1, G, bx};
                    pg8::EpiBf16 E{(bf16*)(ws + P_Y2), 1024, 0};
                    pg8::gemm_phase<pg8::EpiBf16, pg8::SchedMoe2, false, true>(lds, S, E, wave);
                    SEAM(pb + 9 + 2 * ch);
                }
            }
            if (PHON(14) && IN(pb + 12)) for (int rep_ = 0; rep_ <= (int)REPON(14); ++rep_) {
            GAS unsigned char* wsq = (GAS unsigned char*)ws0; asm volatile("" : "+s"(wsq)); unsigned char* const ws = (unsigned char*)wsq; const float* const par = (const float*)(ws + WS_PAR); int lnq = lane_id(); asm volatile("" : "+v"(lnq)); const int lane = lnq; (void)par; (void)lane;
                __syncthreads();
                if (tid == 0) { const unsigned* cnt = (const unsigned*)(ws + WS_CTL) + CW_CNT; int acc = 0;
                    for (int e = 0; e < 8; ++e) { const int c = (int)__hip_atomic_load(cnt + e, __ATOMIC_RELAXED, __HIP_MEMORY_SCOPE_AGENT); tb[e] = c; tb[8 + e] = acc; acc += (c + 255) >> 8; }
                    tb[16] = acc; }
                __syncthreads();
                ResidArgs R{}; R.mode = 2; R.g_post = par + PR_GFFNPOST + 1024; R.gate_chunk = 5; R.hout = nullptr; R.l_gate = 1; R.route = false; R.ysc = 1.0f / (F8_ASCALE * F8_WSCALE);
                { int row = gw; for (; row + ngw < NLAT; row += 2 * ngw) { resid_row(ws, outp, nullptr, nullptr, Rd(R, rep_), row, lane, tb); resid_row(ws, outp, nullptr, nullptr, Rd(R, rep_), row + ngw, lane, tb); } if (row < NLAT) resid_row(ws, outp, nullptr, nullptr, Rd(R, rep_), row, lane, tb); }
            }
        }
    }
#undef IN
#undef SEAM
#undef tid
}

extern "C" void kernel_launch(void* const* d_in, const int* in_sizes, int n_in, void* d_out, int out_size, void* d_ws, size_t ws_size, hipStream_t stream) {
    static int grid = 0;
    if (grid == 0) {
        if (n_in != 38 || out_size != NLAT * D || ws_size < WS_END) { fprintf(stderr, "kernel_launch: unexpected problem (n_in %d out %d ws %zu, need %zu)\n", n_in, out_size, ws_size, (size_t)WS_END); grid = -1; return; }
        int dev = 0, cus = 0, per_cu = 0;
        if (hipGetDevice(&dev) != hipSuccess || hipDeviceGetAttribute(&cus, hipDeviceAttributeMultiprocessorCount, dev) != hipSuccess) { grid = -1; return; }
        if (hipFuncSetAttribute((const void*)mk_fwd, hipFuncAttributeMaxDynamicSharedMemorySize, LDS_BYTES) != hipSuccess) { fprintf(stderr, "kernel_launch: hipFuncSetAttribute failed\n"); grid = -1; return; }
        if (hipOccupancyMaxActiveBlocksPerMultiprocessor(&per_cu, (const void*)mk_fwd, NTHREADS, LDS_BYTES) != hipSuccess || per_cu < 1) { fprintf(stderr, "kernel_launch: occupancy query says %d\n", per_cu); }
        (void)hipGetLastError();
        grid = cus;
    }
    if (grid < 0) return;
    (void)hipMemsetAsync((char*)d_ws + WS_CTL, 0, CTL_BYTES, stream);
    Args a{};
    for (int i = 0; i < 38; ++i) a.in[i] = (const float*)d_in[i];
    a.out = (float*)d_out; a.ws = (unsigned char*)d_ws;
#if MK_MULTI
    for (int ph = 0; ph < NPH; ++ph) {
        const int rel = ph < PH_L0 ? -1 : (ph - PH_L0) % PH_PER_L, l = ph < PH_L0 ? 0 : (ph - PH_L0) / PH_PER_L;
        if (rel > 12 || (l == 0 && (rel == 10 || rel == 11))) continue;
        a.ph_lo = ph; a.ph_hi = ph + 1;
        hipLaunchKernelGGL(mk_fwd, dim3(grid), dim3(NTHREADS), LDS_BYTES, stream, a);
#if MK_DEBUG
        hipLaunchKernelGGL(dbg_fwd, dim3(grid), dim3(NTHREADS), 0, stream, a, ph);
#endif
    }
#if MK_DEBUG
    hipLaunchKernelGGL(dbg_fwd, dim3(grid), dim3(NTHREADS), 0, stream, a, 1000);
#endif
#else
    a.ph_lo = 0; a.ph_hi = NPH;
    hipLaunchKernelGGL(mk_fwd, dim3(grid), dim3(NTHREADS), LDS_BYTES, stream, a);
#endif
}
```

```cpp
#include <hip/hip_runtime.h>
#include <cstdio>
#include <cstdint>

#ifndef MK_DEBUG
#define MK_DEBUG 0
#endif
#ifndef MK_MULTI
#define MK_MULTI 0
#endif

#define GAS __attribute__((address_space(1)))
#define LAS __attribute__((address_space(3)))
typedef unsigned short bf16;
typedef short bf16x8 __attribute__((ext_vector_type(8)));
typedef short s16x4 __attribute__((ext_vector_type(4)));
typedef float f32x2 __attribute__((ext_vector_type(2)));
typedef float f32x4 __attribute__((ext_vector_type(4)));
typedef float f32x16 __attribute__((ext_vector_type(16)));
typedef unsigned u32x2 __attribute__((ext_vector_type(2)));
typedef unsigned u32x4 __attribute__((ext_vector_type(4)));

constexpr int D = 1024, NB = 4, SEQ = 4096, CTXL = 256, GRIDW = 64;
constexpr int NLAT = NB * SEQ, NCTX = NB * CTXL, MALL = NLAT + NCTX;
constexpr int LPOS = CTXL + SEQ;
constexpr int NIN = 1952, ZW = 2048;
constexpr int DFF = 2816, NEXP = 8;
constexpr float EPS = 1e-6f;
constexpr float LOG2E = 1.4426950408889634f;
#ifndef F8_G1L1
#define F8_G1L1 1
#endif
constexpr float F8_WSCALE = 256.f, F8_HSCALE = 16.f, F8_ASCALE = 8.f;
#ifndef F8_D1
#define F8_D1 0
#endif
#ifndef F8_D2
#define F8_D2 0
#endif
#ifndef F8_M1
#define F8_M1 1
#endif
constexpr int ZC_QG = 0, ZC_KG = 512, ZC_VG = 640, ZC_CQ = 768, ZC_CKV = 1152, ZC_KR = 1408, ZC_U = 1536;

constexpr size_t MiB = 1u << 20;
constexpr size_t WS_CTL = 0, CTL_BYTES = 1 * MiB;
constexpr size_t WS_MOD = 1 * MiB;
constexpr size_t WS_ROPE = 2 * MiB;
constexpr size_t WS_PAR = 3 * MiB + 512 * 1024;
constexpr int PR_GMIXPRE = 0, PR_GMIXPOST = 2048, PR_GFFNPRE = 4096, PR_GFFNPOST = 6144, PR_GQ = 8192, PR_GK = 8320, PR_GCQ = 8448, PR_GCKV = 9216, PR_BMG = 9728, PR_RW = 15872, PR_RB = 24064,
              PR_A16 = 24080, PR_END = PR_A16 + 2 * 2 * 32 * 64 * 2;
constexpr size_t WS_LIST = 4 * MiB;
constexpr size_t WS_LATC = 5 * MiB;
constexpr size_t WS_W1T = 9 * MiB;
constexpr size_t WS_WMGT = 17 * MiB;
constexpr size_t WS_WUQT = 29 * MiB;
constexpr size_t WS_WUKVT = 31 * MiB;
constexpr size_t WS_S5M = 32 * MiB;
constexpr size_t WS_WGLUT = 56 * MiB;
constexpr size_t WS_WBT = 58 * MiB;
constexpr size_t WS_WOUTT = 64 * MiB;
constexpr size_t WS_WF1T = 68 * MiB;
constexpr size_t WS_WF2T = 79 * MiB;
constexpr size_t WS_WM1T = 85 * MiB;
constexpr size_t WS_WM2T = 173 * MiB;
constexpr size_t WS_POOL = 217 * MiB;
constexpr size_t P_H = WS_POOL + 0 * MiB;
constexpr size_t P_Z = WS_POOL + 34 * MiB;
constexpr size_t P_QB = WS_POOL + 34 * MiB;
constexpr size_t P_KB = WS_POOL + 60 * MiB;
constexpr size_t P_VB = WS_POOL + 77 * MiB;
constexpr size_t P_QA = WS_POOL + 102 * MiB;
constexpr size_t P_KA = WS_POOL + 119 * MiB;
constexpr size_t P_VA = WS_POOL + 124 * MiB;
constexpr size_t P_KRR = WS_POOL + 129 * MiB;
constexpr size_t P_UG = WS_POOL + 131 * MiB;
constexpr size_t P_CQN = WS_POOL + 148 * MiB;
constexpr size_t P_CKVN = WS_POOL + 161 * MiB;
constexpr size_t P_AGLU = WS_POOL + 170 * MiB;
constexpr size_t P_YBR = WS_POOL + 187 * MiB;
constexpr size_t P_MRG = WS_POOL + 34 * MiB;
constexpr size_t P_GSCR = WS_POOL + 68 * MiB;
constexpr size_t P_Y = WS_POOL + 102 * MiB;
constexpr size_t P_ACT = WS_POOL + 34 * MiB;
constexpr size_t P_Y2 = WS_POOL + 136 * MiB;
constexpr size_t P_H8 = WS_POOL + 240 * MiB;
constexpr size_t WS_END = WS_POOL + 257 * MiB;
static_assert(P_YBR + (size_t)MALL * 1536 * 2 <= WS_END && P_Y2 + (size_t)MALL * 1024 * 4 <= WS_END && P_ACT + (size_t)MALL * DFF * 2 <= P_Y2, "pool map");
static_assert(P_GSCR + 256 * 3 * 131072 <= P_AGLU && P_VB + (size_t)MALL * 512 * 2 <= P_QA && P_Y + (size_t)MALL * 4096 <= P_AGLU, "pool map 2");

constexpr int CW_BAR = 4096;
constexpr int CW_Q = 8320;
constexpr int CW_CNT = 8192;
constexpr int CW_DBG = 16384;

constexpr int LDS_MISC = 147456;
constexpr int LDS_BYTES = 151552;
constexpr int NWAVES = 8, NTHREADS = 512;

__device__ __forceinline__ int lane_id() { unsigned m_ = ~0u; asm volatile("" : "+s"(m_)); return (int)__builtin_amdgcn_mbcnt_hi(m_, __builtin_amdgcn_mbcnt_lo(m_, 0u)); }
__device__ __forceinline__ float bf2f(unsigned v) { return __uint_as_float(v << 16); }
__device__ __forceinline__ unsigned f2bf(float f) { unsigned u = __float_as_uint(f); return (u + 0x7fffu + ((u >> 16) & 1u)) >> 16; }
typedef __bf16 bf16x2_t __attribute__((ext_vector_type(2)));
__device__ __forceinline__ unsigned pk2(float lo, float hi) { const f32x2 v = {lo, hi}; return __builtin_bit_cast(unsigned, __builtin_convertvector(v, bf16x2_t)); }
__device__ __forceinline__ float shfl_xor_l(float v, int mask, int lane) { return __int_as_float(__builtin_amdgcn_ds_bpermute((lane ^ mask) << 2, __float_as_int(v))); }
__device__ __forceinline__ float wave_sum(float v) {
    const int lane = lane_id();
#pragma unroll
    for (int o = 1; o < 64; o <<= 1) v += shfl_xor_l(v, o, lane);
    return v;
}
__device__ __forceinline__ float fsigmoid(float x) { return __builtin_amdgcn_rcpf(1.0f + __builtin_amdgcn_exp2f(-x * LOG2E)); }
__device__ __forceinline__ float fsilu(float x) { return x * fsigmoid(x); }
__device__ __forceinline__ float fgelu_tanh(float x) { const float u = 0.7978845608028654f * (x + 0.044715f * x * x * x); return x * fsigmoid(2.0f * u); }
__device__ __forceinline__ void unpack8(const u32x4 v, float (&f)[8]) {
    f[0] = bf2f(v.x & 0xffffu); f[1] = bf2f(v.x >> 16); f[2] = bf2f(v.y & 0xffffu); f[3] = bf2f(v.y >> 16);
    f[4] = bf2f(v.z & 0xffffu); f[5] = bf2f(v.z >> 16); f[6] = bf2f(v.w & 0xffffu); f[7] = bf2f(v.w >> 16);
}
__device__ __forceinline__ u32x4 pack8(const float (&f)[8]) { u32x4 w; w.x = pk2(f[0], f[1]); w.y = pk2(f[2], f[3]); w.z = pk2(f[4], f[5]); w.w = pk2(f[6], f[7]); return w; }
__device__ __forceinline__ int pos_row(int b, int p) { return p < CTXL ? NLAT + b * CTXL + p : b * SEQ + (p - CTXL); }

#define XB_TMO      128
#define XB_XCNT(j)  (256  + 64 * (j))
#define XB_XSUB(j)  (1280 + 64 * (j))
#define XB_XGEN(j)  (2304 + 64 * (j))
#define XB_TOP      3328
#define XB_TOPGEN   3392
#define XCD_BAR_WORDS 3456
#define XB_SPIN_CAP (1u << 18)
__device__ __forceinline__ unsigned xb_ld(unsigned* p)              { return __hip_atomic_load(p, __ATOMIC_RELAXED, __HIP_MEMORY_SCOPE_AGENT); }
__device__ __forceinline__ unsigned xb_add(unsigned* p, unsigned v) { return __hip_atomic_fetch_add(p, v, __ATOMIC_RELAXED, __HIP_MEMORY_SCOPE_AGENT); }
__device__ __forceinline__ unsigned xb_xcc_id() { return (unsigned)__builtin_amdgcn_s_getreg((3 << 11) | 20) & 0xFu; }
#define XB_SPIN(cond, bar) do { unsigned _sp = 0; while (cond) { __builtin_amdgcn_s_sleep(1); \
    if ((++_sp & 255u) == 0u) { if (xb_ld(&(bar)[XB_TMO])) break; if (_sp > XB_SPIN_CAP) { atomicAdd(&(bar)[XB_TMO], 1u); break; } } } } while (0)
struct XcdBarrier { unsigned* bar; unsigned x; volatile LAS unsigned* st; int wave; };
__device__ __forceinline__ XcdBarrier xcd_barrier_post(unsigned* bar, volatile LAS unsigned* st, int wave) {
    XcdBarrier b; b.bar = bar; b.x = xb_xcc_id(); b.st = st; b.wave = wave;
    if (wave == 0 && lane_id() == 0) (void)xb_add(&bar[XB_XCNT(b.x)], 1u);
    return b;
}
__device__ __forceinline__ void xcd_barrier_complete(unsigned* bar, unsigned x, unsigned& nloc, unsigned& nx) {
    const unsigned G = gridDim.x * gridDim.y * gridDim.z;
    unsigned sum, cnt, mine, sp = 0u;
    for (;;) {
        sum = 0u; cnt = 0u; mine = 0u;
#pragma unroll
        for (unsigned j = 0; j < 16; ++j) { const unsigned c = xb_ld(&bar[XB_XCNT(j)]); sum += c; cnt += (c > 0u) ? 1u : 0u; mine = (j == x) ? c : mine; }
        if (sum == G) break;
        __builtin_amdgcn_s_sleep(1);
        if ((++sp & 255u) == 0u) { if (xb_ld(&bar[XB_TMO])) break; if (sp > XB_SPIN_CAP) { atomicAdd(&bar[XB_TMO], 1u); break; } }
    }
    nloc = mine > 0u ? mine : 1u; nx = cnt > 0u ? cnt : 1u;
}
__device__ __forceinline__ void xcd_barrier(const XcdBarrier& b) {
    asm volatile("s_waitcnt vmcnt(0)" ::: "memory");
    __syncthreads();
    if (b.wave == 0 && lane_id() == 0) {
        unsigned* bar = b.bar;
        __builtin_amdgcn_s_waitcnt(0);
        unsigned nloc = b.st[0], nx = b.st[1];
        if (nloc == 0u) { xcd_barrier_complete(bar, b.x, nloc, nx); b.st[0] = nloc; b.st[1] = nx; }
        const unsigned old = xb_add(&bar[XB_XSUB(b.x)], 1u);
        const unsigned gen = old / nloc;
        if (old + 1u == (gen + 1u) * nloc) {
            __builtin_amdgcn_fence(__ATOMIC_RELEASE, "agent");
            asm volatile("s_waitcnt vmcnt(0)" ::: "memory");
            const unsigned og = xb_add(&bar[XB_TOP], 1u);
            const unsigned tg = og / nx;
            if (og + 1u == (tg + 1u) * nx) xb_add(&bar[XB_TOPGEN], 1u);
            else XB_SPIN(xb_ld(&bar[XB_TOPGEN]) == tg, bar);
            __builtin_amdgcn_fence(__ATOMIC_ACQUIRE, "agent");
            xb_add(&bar[XB_XGEN(b.x)], 1u);
            asm volatile("s_waitcnt vmcnt(0)" ::: "memory");
        } else {
            XB_SPIN(xb_ld(&bar[XB_XGEN(b.x)]) == gen, bar);
            __builtin_amdgcn_fence(__ATOMIC_ACQUIRE, "agent");
            asm volatile("s_waitcnt vmcnt(0)" ::: "memory");
        }
    }
    __syncthreads();
}

namespace pg8 {
typedef int v4i __attribute__((ext_vector_type(4)));
typedef int v8i __attribute__((ext_vector_type(8)));
constexpr int BM = 256, BK = 64, HALF = 128, HTB = HALF * BK * 2, STAGE_BYTES = 8 * HTB;
__host__ __device__ __forceinline__ int lds_byte(int r, int c) { const int st = (r >> 4) * 2 + (c >> 5), rr = r & 15, cc = c & 31, ob = rr * 64 + cc * 2; return st * 1024 + (ob ^ (((ob >> 9) & 1) << 5)); }
__host__ __device__ __forceinline__ void stage_rc(int b, int& R, int& C) { const int st = b / 1024, sb = b % 1024, swz = sb ^ (((sb >> 9) & 1) << 5); R = (st >> 1) * 16 + swz / 64; C = (st & 1) * 32 + (swz % 64) / 2; }
__host__ __device__ __forceinline__ int perm32(int rho) { const int n = rho >> 4, i = rho & 15; return 8 * (i >> 2) + 4 * n + (i & 3); }

struct GUnit { const char* a; const char* b; unsigned lda, ldb; int nt; int pm, pn, z; };

__device__ __forceinline__ void tile_of(int L, int nM, int nN, int& pm, int& pn) {
    const int nwg = nM * nN; int wgid = L;
    { const int q = nwg / 8, r = nwg % 8, xcd = wgid % 8, off = wgid / 8; wgid = (xcd < r ? xcd * (q + 1) : r * (q + 1) + (xcd - r) * q) + off; }
    const int nig = 8 * nN, gid = wgid / nig, fm = gid * 8, gsz = (nM - fm) < 8 ? (nM - fm) : 8;
    pm = fm + ((wgid % nig) % gsz); pn = (wgid % nig) / gsz;
}

template <class Epi, class Sched, bool GATHER, bool F8 = false>
__device__ __forceinline__ void gemm_phase(LAS unsigned char* lds, const Sched& S, const Epi& E, int wave_) {
    int tid = wave_ * 64 + lane_id(); asm volatile("" : "+v"(tid));
    const int wid = __builtin_amdgcn_readfirstlane(tid >> 6), lane = tid & 63, wr = wid >> 2, wc = wid & 3, fr = lane & 15, fq = lane >> 4;
    int Rr[2], Cc[2], Rb[2];
#pragma unroll
    for (int i = 0; i < 2; ++i) { stage_rc(tid * 16 + i * 8192, Rr[i], Cc[i]); Rb[i] = Epi::PERM ? ((Rr[i] & ~31) + perm32(Rr[i] & 31)) : Rr[i]; }
    const size_t kstep = (size_t)(BK * 2);
    const unsigned ldsw = (unsigned)wid * 1024u;
    const int aoff = lds_byte(wr * 64 + fr, fq * 8), boff = lds_byte(wc * 32 + fr, fq * 8);
#define PG8_SA(b, h) (((b) * 2 + (h)) * HTB)
#define PG8_SB(b, h) ((4 + (b) * 2 + (h)) * HTB)
#define PG8_STAGE(bufoff, gbase, v0, v1) do { \
        __builtin_amdgcn_global_load_lds((const unsigned*)((const char*)(gbase) + (v0)), (LAS unsigned*)(lds + (bufoff) + ldsw), 16, 0, 0); \
        __builtin_amdgcn_global_load_lds((const unsigned*)((const char*)(gbase) + (v1)), (LAS unsigned*)(lds + (bufoff) + ldsw + 8192), 16, 0, 0); } while (0)
#define PG8_LD16(p) __builtin_bit_cast(v4i, *(const LAS bf16x8*)(p))
#define PG8_LDA(dst, b, h) do { _Pragma("unroll") for (int m = 0; m < 4; ++m) dst[m] = __builtin_shufflevector(PG8_LD16(lds + PG8_SA(b, h) + aoff + m * 2048), PG8_LD16(lds + PG8_SA(b, h) + aoff + m * 2048 + 1024), 0, 1, 2, 3, 4, 5, 6, 7); } while (0)
#define PG8_LDB(dst, b, h) do { _Pragma("unroll") for (int n = 0; n < 2; ++n) dst[n] = __builtin_shufflevector(PG8_LD16(lds + PG8_SB(b, h) + boff + n * 2048), PG8_LD16(lds + PG8_SB(b, h) + boff + n * 2048 + 1024), 0, 1, 2, 3, 4, 5, 6, 7); } while (0)
#define PG8_LO(x) __builtin_bit_cast(bf16x8, __builtin_shufflevector(x, x, 0, 1, 2, 3))
#define PG8_HI(x) __builtin_bit_cast(bf16x8, __builtin_shufflevector(x, x, 4, 5, 6, 7))
#define PG8_MMA(ai, bj, At, Bt) do { __builtin_amdgcn_s_setprio(1); \
        _Pragma("unroll") for (int m = 0; m < 4; ++m) _Pragma("unroll") for (int n = 0; n < 2; ++n) { \
            if constexpr (F8) acc[ai][bj][m][n] = __builtin_amdgcn_mfma_scale_f32_16x16x128_f8f6f4(Bt[n], At[m], acc[ai][bj][m][n], 0, 0, 0, 0, 0, 0); \
            else { acc[ai][bj][m][n] = __builtin_amdgcn_mfma_f32_16x16x32_bf16(PG8_LO(Bt[n]), PG8_LO(At[m]), acc[ai][bj][m][n], 0, 0, 0); \
                   acc[ai][bj][m][n] = __builtin_amdgcn_mfma_f32_16x16x32_bf16(PG8_HI(Bt[n]), PG8_HI(At[m]), acc[ai][bj][m][n], 0, 0, 0); } } \
        __builtin_amdgcn_s_setprio(0); } while (0)
#define PG8_WAIT_V(n) asm volatile("s_waitcnt vmcnt(" #n ")" ::: "memory")
#define PG8_WAIT_L(n) asm volatile("s_waitcnt lgkmcnt(" #n ")" ::: "memory")
#define PG8_BAR __builtin_amdgcn_s_barrier()
#define PG8_SCHED __builtin_amdgcn_sched_barrier(0)
#define PG8_OFFS(u) do { \
        _Pragma("unroll") for (int i_ = 0; i_ < 2; ++i_) { \
            if constexpr (GATHER) { oA0[i_] = S.arow(u, Rr[i_]) + (unsigned)Cc[i_] * 2u; oA1[i_] = S.arow(u, HALF + Rr[i_]) + (unsigned)Cc[i_] * 2u; } \
            else { oA0[i_] = (unsigned)Rr[i_] * (u).lda + (unsigned)Cc[i_] * 2u; } \
            oB[i_] = (unsigned)Rb[i_] * (u).ldb + (unsigned)Cc[i_] * 2u; } \
        hA = GATHER ? (size_t)0 : (size_t)HALF * (u).lda; hB = (size_t)HALF * (u).ldb; } while (0)
#define PG8_A1(i) (GATHER ? oA1[i] : oA0[i])
    GUnit cur, nxt; int ui = 0;
    if (!S.next(0, cur)) return;
    f32x4 acc[2][2][4][2];
#pragma unroll
    for (int a = 0; a < 2; ++a)
#pragma unroll
        for (int b = 0; b < 2; ++b)
#pragma unroll
            for (int m = 0; m < 4; ++m)
#pragma unroll
                for (int n = 0; n < 2; ++n) acc[a][b][m][n] = (f32x4){0.f, 0.f, 0.f, 0.f};
    v8i At[4], B0[2], B1[2];
    unsigned oA0[2], oA1[2], oB[2]; size_t hA, hB;
    oA1[0] = 0u; oA1[1] = 0u;
    PG8_OFFS(cur);
    const char* cA = cur.a; const char* cBp = cur.b;
    PG8_STAGE(PG8_SB(0, 0), cBp, oB[0], oB[1]); PG8_STAGE(PG8_SB(0, 1), cBp + hB, oB[0], oB[1]); PG8_STAGE(PG8_SA(0, 0), cA, oA0[0], oA0[1]); PG8_STAGE(PG8_SA(0, 1), cA + hA, PG8_A1(0), PG8_A1(1));
    if (wr == 1) PG8_BAR;
    PG8_WAIT_V(2); PG8_BAR;
    PG8_STAGE(PG8_SB(1, 0), cBp + kstep, oB[0], oB[1]); PG8_STAGE(PG8_SA(1, 0), cA + kstep, oA0[0], oA0[1]); PG8_STAGE(PG8_SB(1, 1), cBp + hB + kstep, oB[0], oB[1]);
    PG8_WAIT_V(6); PG8_BAR;
    for (;;) {
        const bool has_next = S.next(ui + 1, nxt);
        const char* nA = has_next ? nxt.a : cA; const char* nBp = has_next ? nxt.b : cBp;
        int nt = cur.nt; asm volatile("" : "+s"(nt));
        for (int t = 0; t < nt; t += 2) {
            const bool last = (t == nt - 2);
            const char* a1 = cA + (size_t)(t + 1) * kstep;
            const char* a2 = last ? nA : cA + (size_t)(t + 2) * kstep; const char* b2 = last ? nBp : cBp + (size_t)(t + 2) * kstep;
            const char* a3 = a2 + kstep; const char* b3 = b2 + kstep;
            PG8_LDB(B0, 0, 0); PG8_LDB(B1, 0, 1); PG8_SCHED; PG8_LDA(At, 0, 0); PG8_STAGE(PG8_SA(1, 1), a1 + hA, PG8_A1(0), PG8_A1(1));
            if (last && has_next) PG8_OFFS(nxt);
            PG8_WAIT_V(8); PG8_WAIT_L(0); PG8_BAR; PG8_MMA(0, 0, At, B0); PG8_MMA(0, 1, At, B1); PG8_BAR; PG8_SCHED;
            PG8_LDA(At, 0, 1); PG8_STAGE(PG8_SB(0, 0), b2, oB[0], oB[1]); PG8_STAGE(PG8_SB(0, 1), b2 + hB, oB[0], oB[1]); PG8_STAGE(PG8_SA(0, 0), a2, oA0[0], oA0[1]);
            PG8_WAIT_V(8); PG8_WAIT_L(0); PG8_BAR; PG8_MMA(1, 0, At, B0); PG8_MMA(1, 1, At, B1); PG8_BAR; PG8_SCHED;
            PG8_LDB(B0, 1, 0); PG8_LDB(B1, 1, 1); PG8_SCHED; PG8_LDA(At, 1, 0); PG8_STAGE(PG8_SA(0, 1), a2 + hA, PG8_A1(0), PG8_A1(1));
            PG8_WAIT_V(8); PG8_WAIT_L(0); PG8_BAR; PG8_MMA(0, 0, At, B0); PG8_MMA(0, 1, At, B1); PG8_BAR; PG8_SCHED;
            PG8_LDA(At, 1, 1); PG8_STAGE(PG8_SB(1, 0), b3, oB[0], oB[1]); PG8_STAGE(PG8_SB(1, 1), b3 + hB, oB[0], oB[1]); PG8_STAGE(PG8_SA(1, 0), a3, oA0[0], oA0[1]);
            PG8_WAIT_V(8); PG8_WAIT_L(0); PG8_BAR; PG8_MMA(1, 0, At, B0); PG8_MMA(1, 1, At, B1); PG8_BAR; PG8_SCHED;
        }
        if (wr == 0) PG8_BAR;
        E(acc, cur, wr, wc, fr, fq);
        if (!has_next) break;
#pragma unroll
        for (int a = 0; a < 2; ++a)
#pragma unroll
            for (int b = 0; b < 2; ++b)
#pragma unroll
                for (int m = 0; m < 4; ++m)
#pragma unroll
                    for (int n = 0; n < 2; ++n) acc[a][b][m][n] = (f32x4){0.f, 0.f, 0.f, 0.f};
        cur = nxt; cA = nA; cBp = nBp; ++ui;
        if (wr == 1) PG8_BAR;
    }
    PG8_WAIT_V(0);
    PG8_BAR;
#undef PG8_SA
#undef PG8_SB
#undef PG8_STAGE
#undef PG8_LDA
#undef PG8_LDB
#undef PG8_LD16
#undef PG8_LO
#undef PG8_HI
#undef PG8_MMA
#undef PG8_WAIT_V
#undef PG8_WAIT_L
#undef PG8_BAR
#undef PG8_SCHED
#undef PG8_OFFS
#undef PG8_A1
}
}

namespace pg8 {
__device__ __forceinline__ unsigned pk_fp8x4(float a, float b, float c, float d) {
    a = __builtin_amdgcn_fmed3f(a, -448.f, 448.f); b = __builtin_amdgcn_fmed3f(b, -448.f, 448.f); c = __builtin_amdgcn_fmed3f(c, -448.f, 448.f); d = __builtin_amdgcn_fmed3f(d, -448.f, 448.f);
    unsigned w = 0; w = __builtin_amdgcn_cvt_pk_fp8_f32(a, b, w, false); w = __builtin_amdgcn_cvt_pk_fp8_f32(c, d, w, true); return w; }
struct SchedPlain {
    const char* A; const char* B; unsigned lda, ldb; int nt, nM, nN, G, c;
    __device__ __forceinline__ bool next(int i, GUnit& u) const {
        const int L = i * G + c; if (L >= nM * nN) return false;
        int pm, pn; tile_of(L, nM, nN, pm, pn);
        u.a = A + (size_t)pm * 256 * lda; u.b = B + (size_t)pn * 256 * ldb; u.lda = lda; u.ldb = ldb; u.nt = nt; u.pm = pm; u.pn = pn; u.z = 0; return true;
    }
};
struct SchedUp {
    const char* Aq; const char* Bq; const char* Akv; const char* Bkv; int nMq, nMall, G, c;
    __device__ __forceinline__ bool next(int i, GUnit& u) const {
        int L = i * G + c; const int nq = nMq * 3; int pm, pn;
        if (L < nq) { tile_of(L, nMq, 3, pm, pn); u.a = Aq + (size_t)pm * 256 * 768; u.b = Bq + (size_t)pn * 256 * 768; u.lda = 768u; u.ldb = 768u; u.nt = 6; u.pm = pm; u.pn = pn; u.z = 0; return true; }
        L -= nq; if (L >= nMall * 4) return false;
        tile_of(L, nMall, 4, pm, pn); u.a = Akv + (size_t)pm * 256 * 512; u.b = Bkv + (size_t)pn * 256 * 512; u.lda = 512u; u.ldb = 512u; u.nt = 4; u.pm = pm; u.pn = pn; u.z = 1; return true;
    }
};
struct SchedMergeG {
    const char* A; const char* B; unsigned lda, ldb; int nt, nM, L;
    __device__ __forceinline__ bool next(int i, GUnit& u) const {
        if (i >= 3 || L >= nM * 4) return false;
        int pm, pn; tile_of(L, nM, 4, pm, pn);
        u.a = A + (size_t)pm * 256 * lda; u.lda = lda; u.b = B + ((size_t)i * 1024 + pn * 256) * ldb; u.ldb = ldb; u.nt = nt; u.pm = pm; u.pn = pn; u.z = i; return true;
    }
};
struct SchedMergeP {
    const char* A; const char* B; unsigned lda, ldb; int nt, nM, L;
    __device__ __forceinline__ bool next(int i, GUnit& u) const {
        if (i >= 3 || L >= nM * 4) return false;
        int pm, pn; tile_of(L, nM, 4, pm, pn);
        u.a = A + (size_t)pm * 256 * lda + i * 1024; u.lda = lda; u.b = B + ((size_t)i * 1024 + pn * 256) * ldb; u.ldb = ldb; u.nt = nt; u.pm = pm; u.pn = pn; u.z = i; return true;
    }
};
struct SchedMoe1 {
    const char* H2; const char* W; unsigned lda, ldb; int nt; const int* list; const LAS int* tb; int nM, G, c;
    const LAS unsigned* rt;
    __device__ __forceinline__ bool next(int i, GUnit& u) const {
        const int L = i * G + c; if (L >= nM * 22) return false;
        const int mt = L / 22, pn = L % 22; int e = 0;
#pragma unroll
        for (int j = 1; j < 8; ++j) e += (mt >= tb[8 + j]) ? 1 : 0;
        e = __builtin_amdgcn_readfirstlane(e);
        u.a = H2; u.lda = lda; u.b = W + ((size_t)e * 5632 + pn * 256) * ldb; u.ldb = ldb; u.nt = nt; u.pm = mt; u.pn = pn; u.z = e | (i << 8); return true;
    }
    __device__ __forceinline__ unsigned arow(const GUnit& u, int r) const {
        if (rt) return rt[(u.z >> 8) * 256 + r];
        const int e = u.z & 255, li = (u.pm - tb[8 + e]) * 256 + r; const int tok = (li < tb[e]) ? list[e * 16384 + li] : 0;
        return (unsigned)tok * lda;
    }
    __device__ __forceinline__ int units() const { const int tot = nM * 22; return c < tot ? (tot - c + G - 1) / G : 0; }
    __device__ __forceinline__ void fill(LAS unsigned* w, int tid) const {
        const int n = units() * 256;
        for (int base = tid; base < n; base += 4 * NTHREADS) { int tokv[4];
#pragma unroll
            for (int k = 0; k < 4; ++k) { const int idx = base + NTHREADS * k; tokv[k] = 0;
                if (idx < n) { const int i = idx >> 8, r = idx & 255, mt = (i * G + c) / 22; int e = 0;
#pragma unroll
                    for (int j = 1; j < 8; ++j) e += (mt >= tb[8 + j]) ? 1 : 0;
                    const int li = (mt - tb[8 + e]) * 256 + r; if (li < tb[e]) tokv[k] = list[e * 16384 + li]; } }
#pragma unroll
            for (int k = 0; k < 4; ++k) { const int idx = base + NTHREADS * k; if (idx < n) w[idx] = (unsigned)tokv[k] * lda; } }
    }
};
struct SchedMoe2 {
    const char* A; const char* B; unsigned lda, ldb; int nt; const LAS int* tb; int nM, G, c;
    __device__ __forceinline__ bool next(int i, GUnit& u) const {
        const int L = i * G + c; if (L >= nM * 4) return false;
        int pm, pn; tile_of(L, nM, 4, pm, pn); int e = 0;
#pragma unroll
        for (int j = 1; j < 8; ++j) e += (pm >= tb[8 + j]) ? 1 : 0;
        e = __builtin_amdgcn_readfirstlane(e);
        u.a = A + (size_t)pm * 256 * lda; u.b = B + (size_t)(e * 4 + pn) * 256 * ldb; u.lda = lda; u.ldb = ldb; u.nt = nt; u.pm = pm; u.pn = pn; u.z = e; return true;
    }
};

#define EPI_ROWS_BEGIN _Pragma("unroll") for (int ai = 0; ai < 2; ++ai) _Pragma("unroll") for (int m = 0; m < 4; ++m) { const int row = u.pm * BM + ai * HALF + wr * 64 + m * 16 + fr;
#define EPI_ROWS_END }
__device__ __forceinline__ u32x4 pack_f4f4(const f32x4 a, const f32x4 b) { u32x4 w; w.x = pk2(a[0], a[1]); w.y = pk2(a[2], a[3]); w.z = pk2(b[0], b[1]); w.w = pk2(b[2], b[3]); return w; }

struct EpiBf16 {
    static constexpr bool PERM = true;
    bf16* O; int ldc; int rsub;
    __device__ __forceinline__ void operator()(const f32x4 (&acc)[2][2][4][2], const GUnit& u, int wr, int wc, int fr, int fq) const {
        const int col0 = u.pn * BM + wc * 32 + 8 * fq;
        EPI_ROWS_BEGIN
            bf16* rowp = O + (size_t)(row - rsub) * ldc + col0;
#pragma unroll
            for (int bj = 0; bj < 2; ++bj) *(u32x4*)(rowp + bj * HALF) = pack_f4f4(acc[ai][bj][m][0], acc[ai][bj][m][1]);
        EPI_ROWS_END
    }
};
struct EpiF32 {
    static constexpr bool PERM = false;
    float* C; int ldc;
    __device__ __forceinline__ void operator()(const f32x4 (&acc)[2][2][4][2], const GUnit& u, int wr, int wc, int fr, int fq) const {
        const int col0 = u.pn * BM + wc * 32 + 4 * fq;
        EPI_ROWS_BEGIN
            float* rowp = C + (size_t)row * ldc + col0;
#pragma unroll
            for (int bj = 0; bj < 2; ++bj)
#pragma unroll
                for (int n = 0; n < 2; ++n) *(f32x4*)(rowp + bj * HALF + n * 16) = acc[ai][bj][m][n];
        EPI_ROWS_END
    }
};
struct EpiUq {
    static constexpr bool PERM = true;
    bf16* Qb; const float* cosB; const float* sinB; float scale;
    __device__ __forceinline__ void operator()(const f32x4 (&acc)[2][2][4][2], const GUnit& u, int wr, int wc, int fr, int fq) const {
        const bool lat = u.pm < 64;
        EPI_ROWS_BEGIN
            const int t = row & (SEQ - 1);
#pragma unroll
            for (int bj = 0; bj < 2; ++bj) {
                const int gidx = u.pn * 8 + bj * 4 + wc, head = gidx / 3, part = gidx - head * 3;
                bf16* dst = Qb + (size_t)row * 768 + head * 96 + part * 32;
                f32x4 a = acc[ai][bj][m][0] * scale, b = acc[ai][bj][m][1] * scale;
                if (part == 2) {
                    if (lat) { const f32x4 c = *(const f32x4*)(cosB + t * 16 + 4 * fq), s = *(const f32x4*)(sinB + t * 16 + 4 * fq);
                        const f32x4 x1 = a * c - b * s, x2 = a * s + b * c; a = x1; b = x2; }
                    u32x2 w0, w1; w0.x = pk2(a[0], a[1]); w0.y = pk2(a[2], a[3]); w1.x = pk2(b[0], b[1]); w1.y = pk2(b[2], b[3]);
                    *(u32x2*)(dst + 4 * fq) = w0; *(u32x2*)(dst + 16 + 4 * fq) = w1;
                } else *(u32x4*)(dst + 8 * fq) = pack_f4f4(a, b);
            }
        EPI_ROWS_END
    }
};
struct EpiUkv {
    static constexpr bool PERM = true;
    bf16* Kb; bf16* Vb;
    __device__ __forceinline__ void operator()(const f32x4 (&acc)[2][2][4][2], const GUnit& u, int wr, int wc, int fr, int fq) const {
        bf16* base = (wc < 2) ? Kb : Vb;
        EPI_ROWS_BEGIN
#pragma unroll
            for (int bj = 0; bj < 2; ++bj) { const int head = u.pn * 2 + bj;
                *(u32x4*)(base + (size_t)row * 512 + head * 64 + (wc & 1) * 32 + 8 * fq) = pack_f4f4(acc[ai][bj][m][0], acc[ai][bj][m][1]); }
        EPI_ROWS_END
    }
};
struct EpiUp {
    static constexpr bool PERM = true;
    EpiUq q; EpiUkv kv;
    __device__ __forceinline__ void operator()(const f32x4 (&acc)[2][2][4][2], const GUnit& u, int wr, int wc, int fr, int fq) const { if (u.z == 0) q(acc, u, wr, wc, fr, fq); else kv(acc, u, wr, wc, fr, fq); }
};
template <int MODE> struct EpiPair {
    static constexpr bool PERM = true;
    bf16* O; int ldc; int cbase; int rsub;
    __device__ __forceinline__ void operator()(const f32x4 (&acc)[2][2][4][2], const GUnit& u, int wr, int wc, int fr, int fq) const {
        const int col0 = cbase + u.pn * 128 + wc * 32 + 8 * fq;
        EPI_ROWS_BEGIN
            f32x4 o[2];
#pragma unroll
            for (int n = 0; n < 2; ++n)
#pragma unroll
                for (int j = 0; j < 4; ++j) { const float a = acc[ai][0][m][n][j], b = acc[ai][1][m][n][j]; o[n][j] = MODE == 0 ? a * fsigmoid(b) : fsilu(a) * b; }
            *(u32x4*)(O + (size_t)(row - rsub) * ldc + col0) = pack_f4f4(o[0], o[1]);
        EPI_ROWS_END
    }
};
struct EpiGate {
    static constexpr bool PERM = true;
    const float* bmg; u32x4* gscr; float ds;
    __device__ __forceinline__ void operator()(const f32x4 (&acc)[2][2][4][2], const GUnit& u, int wr, int wc, int fr, int fq) const {
        const int n = u.z, tid = (wr * 4 + wc) * 64 + fq * 16 + fr;
#pragma unroll
        for (int bj = 0; bj < 2; ++bj) {
            const float* bp = bmg + n * 1024 + u.pn * BM + bj * HALF + wc * 32 + 8 * fq;
            const f32x4 b0 = *(const f32x4*)bp, b1 = *(const f32x4*)(bp + 4);
#pragma unroll
            for (int ai = 0; ai < 2; ++ai)
#pragma unroll
                for (int m = 0; m < 4; ++m) { f32x4 g0 = acc[ai][bj][m][0] * ds + b0, g1 = acc[ai][bj][m][1] * ds + b1;
#pragma unroll
                    for (int j = 0; j < 4; ++j) { g0[j] = fsigmoid(g0[j]); g1[j] = fsigmoid(g1[j]); }
                    gscr[((n * 8 + (tid >> 6)) * 16 + (ai * 4 + m) * 2 + bj) * 64 + (tid & 63)] = pack_f4f4(g0, g1); asm volatile("" ::: "memory"); }
        }
    }
};
struct EpiMergeP {
    static constexpr bool PERM = true;
    bf16* M; const u32x4* gscr;
    __device__ __forceinline__ void operator()(const f32x4 (&acc)[2][2][4][2], const GUnit& u, int wr, int wc, int fr, int fq) const {
        const int n = u.z, tid = (wr * 4 + wc) * 64 + fq * 16 + fr;
        const int col0 = u.pn * BM + wc * 32 + 8 * fq;
        EPI_ROWS_BEGIN
#pragma unroll
            for (int bj = 0; bj < 2; ++bj) {
                float g[8], p[8]; unpack8(gscr[((n * 8 + (tid >> 6)) * 16 + (ai * 4 + m) * 2 + bj) * 64 + (tid & 63)], g);
                bf16* dst = M + (size_t)row * 1024 + col0 + bj * HALF;
                if (n > 0) unpack8(*(const u32x4*)dst, p);
#pragma unroll
                for (int j = 0; j < 8; ++j) { const float v = g[j] * acc[ai][bj][m][j >> 2][j & 3]; p[j] = n > 0 ? p[j] + v : v; }
                *(u32x4*)dst = pack8(p);
            }
            asm volatile("" ::: "memory");
        EPI_ROWS_END
    }
};
template <bool OUT8> struct EpiPairS {
    static constexpr bool PERM = true;
    unsigned char* O; int ldc; int rsub; float ds, os;
    __device__ __forceinline__ void operator()(const f32x4 (&acc)[2][2][4][2], const GUnit& u, int wr, int wc, int fr, int fq) const {
        const int col0 = u.pn * 128 + wc * 32 + 8 * fq;
        EPI_ROWS_BEGIN
            float o[8];
#pragma unroll
            for (int n = 0; n < 2; ++n)
#pragma unroll
                for (int j = 0; j < 4; ++j) { const float a = acc[ai][0][m][n][j] * ds, b = acc[ai][1][m][n][j]; o[4 * n + j] = fsilu(a) * b * (ds * os); }
            if constexpr (OUT8) *(u32x2*)(O + (size_t)(row - rsub) * ldc + col0) = (u32x2){pk_fp8x4(o[0], o[1], o[2], o[3]), pk_fp8x4(o[4], o[5], o[6], o[7])};
            else *(u32x4*)((bf16*)O + (size_t)(row - rsub) * ldc + col0) = pack8(o);
            asm volatile("" ::: "memory");
        EPI_ROWS_END
    }
};
struct EpiF32S {
    static constexpr bool PERM = false;
    float* C; int ldc; float ds;
    __device__ __forceinline__ void operator()(const f32x4 (&acc)[2][2][4][2], const GUnit& u, int wr, int wc, int fr, int fq) const {
        const int col0 = u.pn * BM + wc * 32 + 4 * fq;
        EPI_ROWS_BEGIN
            float* rowp = C + (size_t)row * ldc + col0;
#pragma unroll
            for (int bj = 0; bj < 2; ++bj)
#pragma unroll
                for (int n = 0; n < 2; ++n) *(f32x4*)(rowp + bj * HALF + n * 16) = acc[ai][bj][m][n] * ds;
        EPI_ROWS_END
    }
};
struct EpiBf16S {
    static constexpr bool PERM = true;
    bf16* O; int ldc; float ds;
    __device__ __forceinline__ void operator()(const f32x4 (&acc)[2][2][4][2], const GUnit& u, int wr, int wc, int fr, int fq) const {
        const int col0 = u.pn * BM + wc * 32 + 8 * fq;
        EPI_ROWS_BEGIN
            bf16* rowp = O + (size_t)row * ldc + col0;
#pragma unroll
            for (int bj = 0; bj < 2; ++bj) *(u32x4*)(rowp + bj * HALF) = pack_f4f4(acc[ai][bj][m][0] * ds, acc[ai][bj][m][1] * ds);
        EPI_ROWS_END
    }
};
#undef EPI_ROWS_BEGIN
#undef EPI_ROWS_END
}

namespace att {
__device__ __forceinline__ float swap32_max(float v) { const auto rr = __builtin_amdgcn_permlane32_swap(__float_as_uint(v), __float_as_uint(v), false, false); return __builtin_fmaxf(__uint_as_float(rr[0]), __uint_as_float(rr[1])); }
__device__ __forceinline__ float swap32_sum(float v) { const auto rr = __builtin_amdgcn_permlane32_swap(__float_as_uint(v), __float_as_uint(v), false, false); return __uint_as_float(rr[0]) + __uint_as_float(rr[1]); }
constexpr int VSLOT = 8192, NSLOT = 3;
__device__ __forceinline__ int crow(int r, int hi) { return (r & 3) + 8 * (r >> 2) + 4 * hi; }
__device__ __forceinline__ void glds16(const void* gsrc, unsigned lds_dst) { unsigned keep;
    asm volatile("s_mov_b32 %0, m0\n\ts_mov_b32 m0, %2\n\ts_nop 0\n\tglobal_load_lds_dwordx4 %1, off\n\ts_mov_b32 m0, %0" : "=&s"(keep) : "v"(gsrc), "s"(lds_dst) : "memory"); }
typedef short v4i16_t __attribute__((ext_vector_type(4)));
__device__ __forceinline__ s16x4 vtr(const LAS unsigned char* p) { return __builtin_bit_cast(s16x4, __builtin_amdgcn_ds_read_tr16_b64_v4i16((LAS v4i16_t*)p)); }

struct AttnArgs {
    const bf16* Q; int qpitch, qcol; long qrow0;
    const bf16* K1; int k1pitch, k1col;
    const bf16* K2; int k2pitch;
    const bf16* V; int vpitch, vcol;
    bf16* O; int opitch, ocol;
    int b, ntiles;
};
template <int DK> __device__ __forceinline__ void attn_unit(const AttnArgs& A, LAS unsigned char* lds, int wave_) {
    constexpr int NKS = DK / 16, KSLOT = (DK / 8) * 1024, NKSLOT = 4, NVSLOT = 4; constexpr float THR = 8.f;
    constexpr bool NOMAX = (DK == 64);
    constexpr int LDS_K = 0, LDS_V = NKSLOT * KSLOT, LDS_WS = LDS_V + NVSLOT * VSLOT;
    int tid = wave_ * 64 + lane_id(); asm volatile("" : "+v"(tid));
    const int lane = tid & 63, r32 = lane & 31, hi = lane >> 5; const int wid = __builtin_amdgcn_readfirstlane(tid >> 6);
    const unsigned lds0 = (unsigned)(uintptr_t)lds;
    LAS float* wsf = (LAS float*)(lds + LDS_WS) + wid * 64;
    const int NT = A.ntiles, b = A.b;
#define TILE_ROW(j) ((j) < 4 ? (long)(NLAT + b * CTXL + 64 * (j)) : (long)(b * SEQ + 64 * ((j) - 4)))
#define DMA_K(j) do { const long r0_ = TILE_ROW(j); const int s_ = (j) & 3; \
        glds16(A.K1 + (r0_ + lane) * A.k1pitch + A.k1col + wid * 8, (unsigned)__builtin_amdgcn_readfirstlane(lds0 + LDS_K + s_ * KSLOT + wid * 1024)); \
        if (DK == 96 && wid < 4) glds16(A.K2 + (r0_ + lane) * A.k2pitch + wid * 8, (unsigned)__builtin_amdgcn_readfirstlane(lds0 + LDS_K + s_ * KSLOT + (8 + wid) * 1024)); } while (0)
#define DMA_V(j) do { const long r0_ = TILE_ROW(j); const int s_ = (j) & 3; \
        glds16(A.V + (r0_ + 16 * (wid & 3) + (lane >> 2)) * A.vpitch + A.vcol + (wid >> 2) * 32 + (lane & 3) * 8, (unsigned)__builtin_amdgcn_readfirstlane(lds0 + LDS_V + (s_) * VSLOT + wid * 1024)); } while (0)
#define WAITBAR(n) asm volatile("s_waitcnt vmcnt(" #n ") lgkmcnt(0)\n\ts_barrier" ::: "memory")
#define WAIT_CNT(cnt) do { const int c_ = (cnt); if (c_ >= 3) WAITBAR(3); else if (c_ == 2) WAITBAR(2); else if (c_ == 1) WAITBAR(1); else WAITBAR(0); } while (0)
#define QK(S0, S1, slot) do { const LAS unsigned char* Ks_ = lds + LDS_K + (slot) * KSLOT + hi * 1024 + r32 * 16; \
        _Pragma("unroll") for (int ks = 0; ks < NKS; ++ks) { const bf16x8 k0_ = *(const LAS bf16x8*)(Ks_ + ks * 2048), k1_ = *(const LAS bf16x8*)(Ks_ + ks * 2048 + 512); \
            S0 = __builtin_amdgcn_mfma_f32_32x32x16_bf16(k0_, qr[ks], ks == 0 ? (NOMAX ? f32x16{} : negm) : S0, 0, 0, 0); S1 = __builtin_amdgcn_mfma_f32_32x32x16_bf16(k1_, qr[ks], ks == 0 ? (NOMAX ? f32x16{} : negm) : S1, 0, 0, 0); } } while (0)
    const int nK = (DK == 96 && wid < 4) ? 2 : 1;
    bf16x8 qr[NKS];
    { const bf16* Qw = A.Q + (A.qrow0 + wid * 32 + r32) * A.qpitch + A.qcol + hi * 8;
#pragma unroll
      for (int ks = 0; ks < NKS; ++ks) qr[ks] = *(const bf16x8*)(Qw + ks * 16); }
    asm volatile("s_waitcnt vmcnt(0)" ::: "memory");
    DMA_K(0); DMA_V(0); DMA_K(1); DMA_K(2); DMA_V(1);
    float mref = 0.f, lsum = 0.f; f32x16 o[2]; o[0] = f32x16{}; o[1] = f32x16{};
    f32x16 negm = f32x16{};
    const int vb = (4 * hi + ((lane & 15) >> 2)) * 64 + ((lane >> 4) & 1) * 32 + (lane & 3) * 8;
    f32x16 s0, s1;
    WAITBAR(0);
    QK(s0, s1, 0);
    if constexpr (!NOMAX) { float rm = __builtin_fmaxf(s0[0], s1[0]);
#pragma unroll
      for (int r = 1; r < 16; ++r) rm = __builtin_fmaxf(__builtin_fmaxf(rm, s0[r]), s1[r]);
      rm = swap32_max(rm); mref = rm;
#pragma unroll
      for (int r = 0; r < 16; ++r) { s0[r] -= rm; s1[r] -= rm; negm[r] = -rm; } }
    int vslot = 0;
#define HEAD(t) do { WAITBAR(0);        \
        if ((t) + 3 < NT) DMA_K((t) + 3); if ((t) + 4 < NT) DMA_K((t) + 4); \
        if ((t) + 2 < NT) DMA_V((t) + 2); if ((t) + 3 < NT) DMA_V((t) + 3); } while (0)
#define QKP(N0, N1, t) do { if ((t) + 1 < NT) { const LAS unsigned char* Ks_ = lds + LDS_K + (((t) + 1) & 3) * KSLOT + hi * 1024 + r32 * 16; \
            _Pragma("unroll") for (int kh = 0; kh < 2; ++kh) { bf16x8 kf[NKS]; \
                _Pragma("unroll") for (int k2 = 0; k2 < NKS / 2; ++k2) { const int ks = kh * (NKS / 2) + k2; kf[2 * k2] = *(const LAS bf16x8*)(Ks_ + ks * 2048); kf[2 * k2 + 1] = *(const LAS bf16x8*)(Ks_ + ks * 2048 + 512); } \
                __builtin_amdgcn_s_setprio(1); \
                _Pragma("unroll") for (int k2 = 0; k2 < NKS / 2; ++k2) { const int ks = kh * (NKS / 2) + k2; \
                    N0 = __builtin_amdgcn_mfma_f32_32x32x16_bf16(kf[2 * k2], qr[ks], ks == 0 ? (NOMAX ? f32x16{} : negm) : N0, 0, 0, 0); N1 = __builtin_amdgcn_mfma_f32_32x32x16_bf16(kf[2 * k2 + 1], qr[ks], ks == 0 ? (NOMAX ? f32x16{} : negm) : N1, 0, 0, 0); } \
                __builtin_amdgcn_s_setprio(0); } } } while (0)
#define SMP(C0, C1, N0, N1, t, NREADY) do { if constexpr (!NOMAX) { \
        float rm = __builtin_fmaxf(C0[0], C1[0]); \
        _Pragma("unroll") for (int r = 1; r < 16; ++r) rm = __builtin_fmaxf(__builtin_fmaxf(rm, C0[r]), C1[r]); \
        rm = swap32_max(rm); \
        if (__builtin_expect(__any(rm > THR), 0)) { \
            const float dl = __builtin_fmaxf(rm, 0.f), al = __builtin_amdgcn_exp2f(-dl); \
            mref += dl; lsum *= al; \
            _Pragma("unroll") for (int r = 0; r < 16; ++r) { C0[r] -= dl; C1[r] -= dl; negm[r] = -mref; } \
            if (NREADY && (t) + 1 < NT) { _Pragma("unroll") for (int r = 0; r < 16; ++r) { N0[r] -= dl; N1[r] -= dl; } } \
            if (hi == 0) wsf[r32] = al; \
            asm volatile("s_waitcnt lgkmcnt(0)" ::: "memory"); \
            _Pragma("unroll") for (int rq = 0; rq < 4; ++rq) { const f32x4 a4 = *(const LAS f32x4*)(wsf + 8 * rq + 4 * hi); \
                _Pragma("unroll") for (int j = 0; j < 4; ++j) { o[0][4 * rq + j] *= a4[j]; o[1][4 * rq + j] *= a4[j]; } } \
        } } \
        float ps0 = 0.f, ps1 = 0.f, ps2 = 0.f, ps3 = 0.f; \
        _Pragma("unroll") for (int r = 0; r < 16; r += 2) { C0[r] = __builtin_amdgcn_exp2f(C0[r]); C1[r] = __builtin_amdgcn_exp2f(C1[r]); C0[r + 1] = __builtin_amdgcn_exp2f(C0[r + 1]); C1[r + 1] = __builtin_amdgcn_exp2f(C1[r + 1]); \
            ps0 += C0[r]; ps1 += C1[r]; ps2 += C0[r + 1]; ps3 += C1[r + 1]; } \
        lsum += (ps0 + ps1) + (ps2 + ps3); \
        pw[0] = (u32x4){pk2(C0[0], C0[1]), pk2(C0[2], C0[3]), pk2(C0[4], C0[5]), pk2(C0[6], C0[7])}; \
        pw[1] = (u32x4){pk2(C0[8], C0[9]), pk2(C0[10], C0[11]), pk2(C0[12], C0[13]), pk2(C0[14], C0[15])}; \
        pw[2] = (u32x4){pk2(C1[0], C1[1]), pk2(C1[2], C1[3]), pk2(C1[4], C1[5]), pk2(C1[6], C1[7])}; \
        pw[3] = (u32x4){pk2(C1[8], C1[9]), pk2(C1[10], C1[11]), pk2(C1[12], C1[13]), pk2(C1[14], C1[15])}; } while (0)
#define PVP() do { const LAS unsigned char* Vs = lds + LDS_V + vslot * VSLOT + vb; \
        _Pragma("unroll") for (int d0 = 0; d0 < 2; ++d0) { s16x4 vlo[4], vhh[4]; \
            _Pragma("unroll") for (int i = 0; i < 4; ++i) { vlo[i] = vtr(Vs + d0 * 4096 + i * 1024); vhh[i] = vtr(Vs + d0 * 4096 + i * 1024 + 512); } \
            __builtin_amdgcn_s_setprio(1); \
            _Pragma("unroll") for (int ks = 0; ks < 4; ++ks) { \
                const bf16x8 vf = (bf16x8){vlo[ks][0], vlo[ks][1], vlo[ks][2], vlo[ks][3], vhh[ks][0], vhh[ks][1], vhh[ks][2], vhh[ks][3]}; \
                o[d0] = __builtin_amdgcn_mfma_f32_32x32x16_bf16(__builtin_bit_cast(bf16x8, pw[ks]), vf, o[d0], 0, 0, 0); } \
            __builtin_amdgcn_s_setprio(0); } \
        vslot = (vslot + 1) & 3; } while (0)
    f32x16 n0, n1; u32x4 pw[4];
    if (wid < 8) {
        for (int t = 0; t < NT; t += 2) {
            HEAD(t); QKP(n0, n1, t); SMP(s0, s1, n0, n1, t, 1); PVP();
            QKP(s0, s1, t + 1); SMP(n0, n1, s0, s1, t + 1, 1); PVP(); }
    } else {
        for (int t = 0; t < NT; t += 2) {
            HEAD(t); SMP(s0, s1, n0, n1, t, 0); PVP(); QKP(n0, n1, t);
            SMP(n0, n1, s0, s1, t + 1, 0); PVP(); QKP(s0, s1, t + 1); }
    }
#undef HEAD
#undef QKP
#undef SMP
#undef PVP
    lsum = swap32_sum(lsum);
    if (hi == 0) wsf[32 + r32] = __builtin_amdgcn_rcpf(lsum);
    asm volatile("s_waitcnt vmcnt(0) lgkmcnt(0)\n\ts_barrier" ::: "memory");
    { LAS bf16* stg = (LAS bf16*)(lds + wid * 4096);
#pragma unroll
      for (int rq = 0; rq < 4; ++rq) { const f32x4 i4 = *(const LAS f32x4*)(wsf + 32 + 8 * rq + 4 * hi);
#pragma unroll
          for (int j = 0; j < 4; ++j) { const int q = 8 * rq + 4 * hi + j;
              stg[q * 64 + r32] = (bf16)f2bf(o[0][4 * rq + j] * i4[j]); stg[q * 64 + 32 + r32] = (bf16)f2bf(o[1][4 * rq + j] * i4[j]); } }
      asm volatile("s_waitcnt lgkmcnt(0)" ::: "memory");
      bf16* Ow = A.O + (A.qrow0 + wid * 32) * A.opitch + A.ocol;
#pragma unroll
      for (int i = 0; i < 4; ++i) { const int row = i * 8 + (lane >> 3), ch = lane & 7; *(u32x4*)(Ow + (long)row * A.opitch + ch * 8) = *(const LAS u32x4*)(stg + row * 64 + ch * 8); } }
    asm volatile("s_waitcnt vmcnt(0) lgkmcnt(0)\n\ts_barrier" ::: "memory");
#undef TILE_ROW
#undef DMA_K
#undef DMA_V
#undef WAITBAR
#undef WAIT_CNT
#undef QK
}

template <int DK> __device__ __forceinline__ void attn_unit3(const AttnArgs& A, LAS unsigned char* lds, int wave_) {
    constexpr int NKS = DK / 16, KSLOT = (DK / 8) * 1024, NKSLOT = 4, NVSLOT = 4;
    constexpr int LDS_K = 0, LDS_V = NKSLOT * KSLOT, LDS_WS = LDS_V + NVSLOT * VSLOT;
    int tid = wave_ * 64 + lane_id(); asm volatile("" : "+v"(tid));
    const int lane = tid & 63, r32 = lane & 31, hi = lane >> 5; const int wid = __builtin_amdgcn_readfirstlane(tid >> 6);
    const unsigned lds0 = (unsigned)(uintptr_t)lds;
    LAS float* wsf = (LAS float*)(lds + LDS_WS) + wid * 64;
    const int NT = A.ntiles, b = A.b;
#define TILE_ROW(j) ((j) < 4 ? (long)(NLAT + b * CTXL + 64 * (j)) : (long)(b * SEQ + 64 * ((j) - 4)))
#define DMA_K(j) do { const long r0_ = TILE_ROW(j); const int s_ = (j) & 3; \
        glds16(A.K1 + (r0_ + lane) * A.k1pitch + A.k1col + wid * 8, (unsigned)__builtin_amdgcn_readfirstlane(lds0 + LDS_K + s_ * KSLOT + wid * 1024)); \
        if (DK == 96 && wid < 4) glds16(A.K2 + (r0_ + lane) * A.k2pitch + wid * 8, (unsigned)__builtin_amdgcn_readfirstlane(lds0 + LDS_K + s_ * KSLOT + (8 + wid) * 1024)); } while (0)
#define DMA_V(j) do { const long r0_ = TILE_ROW(j); const int s_ = (j) & 3; \
        glds16(A.V + (r0_ + 16 * (wid & 3) + (lane >> 2)) * A.vpitch + A.vcol + (wid >> 2) * 32 + (lane & 3) * 8, (unsigned)__builtin_amdgcn_readfirstlane(lds0 + LDS_V + (s_) * VSLOT + wid * 1024)); } while (0)
#define WAITBAR(n) asm volatile("s_waitcnt vmcnt(" #n ") lgkmcnt(0)\n\ts_barrier" ::: "memory")
    bf16x8 qr[NKS];
    { const bf16* Qw = A.Q + (A.qrow0 + wid * 32 + r32) * A.qpitch + A.qcol + hi * 8;
#pragma unroll
      for (int ks = 0; ks < NKS; ++ks) qr[ks] = *(const bf16x8*)(Qw + ks * 16); }
    asm volatile("s_waitcnt vmcnt(0)" ::: "memory");
    DMA_K(0); DMA_K(1); DMA_V(0); DMA_K(2); DMA_K(3); DMA_V(1);
    float ls0 = 0.f, ls1 = 0.f, ls2 = 0.f, ls3 = 0.f; f32x16 o[2]; o[0] = f32x16{}; o[1] = f32x16{};
    const int vb = (4 * hi + ((lane & 15) >> 2)) * 64 + ((lane >> 4) & 1) * 32 + (lane & 3) * 8;
    const LAS unsigned char* Kb = lds + LDS_K + hi * 1024 + r32 * 16;
    const LAS unsigned char* Vb = lds + LDS_V + vb;
#define QKH(S0, S1, j, kh) do { const LAS unsigned char* Ks_ = Kb + ((j) & 3) * KSLOT; bf16x8 kf[NKS]; \
        _Pragma("unroll") for (int k2 = 0; k2 < NKS / 2; ++k2) { const int ks = (kh) * (NKS / 2) + k2; kf[2 * k2] = *(const LAS bf16x8*)(Ks_ + ks * 2048); kf[2 * k2 + 1] = *(const LAS bf16x8*)(Ks_ + ks * 2048 + 512); } \
        _Pragma("unroll") for (int k2 = 0; k2 < NKS / 2; ++k2) { const int ks = (kh) * (NKS / 2) + k2; \
            S0 = __builtin_amdgcn_mfma_f32_32x32x16_bf16(kf[2 * k2], qr[ks], ks == 0 ? f32x16{} : S0, 0, 0, 0); S1 = __builtin_amdgcn_mfma_f32_32x32x16_bf16(kf[2 * k2 + 1], qr[ks], ks == 0 ? f32x16{} : S1, 0, 0, 0); } } while (0)
#define PVH(PW, j, d0) do { const LAS unsigned char* Vs_ = Vb + ((j) & 3) * VSLOT + (d0) * 4096; s16x4 vlo[4], vhh[4]; \
        _Pragma("unroll") for (int i = 0; i < 4; ++i) { vlo[i] = vtr(Vs_ + i * 1024); vhh[i] = vtr(Vs_ + i * 1024 + 512); } \
        _Pragma("unroll") for (int ks = 0; ks < 4; ++ks) { const bf16x8 vf = (bf16x8){vlo[ks][0], vlo[ks][1], vlo[ks][2], vlo[ks][3], vhh[ks][0], vhh[ks][1], vhh[ks][2], vhh[ks][3]}; \
            o[d0] = __builtin_amdgcn_mfma_f32_32x32x16_bf16(__builtin_bit_cast(bf16x8, PW[ks]), vf, o[d0], 0, 0, 0); } } while (0)
#define SOFT(C0, C1, PW) do { \
        _Pragma("unroll") for (int r = 0; r < 16; r += 2) { C0[r] = __builtin_amdgcn_exp2f(C0[r]); C1[r] = __builtin_amdgcn_exp2f(C1[r]); C0[r + 1] = __builtin_amdgcn_exp2f(C0[r + 1]); C1[r + 1] = __builtin_amdgcn_exp2f(C1[r + 1]); \
            ls0 += C0[r]; ls1 += C1[r]; ls2 += C0[r + 1]; ls3 += C1[r + 1]; } \
        PW[0] = (u32x4){pk2(C0[0], C0[1]), pk2(C0[2], C0[3]), pk2(C0[4], C0[5]), pk2(C0[6], C0[7])}; \
        PW[1] = (u32x4){pk2(C0[8], C0[9]), pk2(C0[10], C0[11]), pk2(C0[12], C0[13]), pk2(C0[14], C0[15])}; \
        PW[2] = (u32x4){pk2(C1[0], C1[1]), pk2(C1[2], C1[3]), pk2(C1[4], C1[5]), pk2(C1[6], C1[7])}; \
        PW[3] = (u32x4){pk2(C1[8], C1[9]), pk2(C1[10], C1[11]), pk2(C1[12], C1[13]), pk2(C1[14], C1[15])}; } while (0)
#define HINTS() do { _Pragma("unroll") for (int h_ = 0; h_ < 2; ++h_) { __builtin_amdgcn_sched_group_barrier(0x100, NKS + 8, 0); \
            _Pragma("unroll") for (int g_ = 0; g_ < NKS + 4; ++g_) { __builtin_amdgcn_sched_group_barrier(0x008, 1, 0); __builtin_amdgcn_sched_group_barrier(0x400, 2, 0); __builtin_amdgcn_sched_group_barrier(0x002, 3, 0); } } } while (0)
#define STEP3(N0, N1, C0, C1, PN, PC, t) do { __builtin_amdgcn_sched_barrier(0); \
        QKH(N0, N1, (t) + 2, 0); PVH(PC, t, 0); QKH(N0, N1, (t) + 2, 1); PVH(PC, t, 1); SOFT(C0, C1, PN); HINTS(); __builtin_amdgcn_sched_barrier(0); } while (0)
    f32x16 sA0, sA1, sB0, sB1; u32x4 pA[4], pB[4];
    WAITBAR(0);
    QKH(sA0, sA1, 0, 0); QKH(sA0, sA1, 0, 1); QKH(sB0, sB1, 1, 0); QKH(sB0, sB1, 1, 1);
    SOFT(sA0, sA1, pA);
    int t = 0;
    for (; t + 3 < NT; t += 2) {
        WAITBAR(0);
        if (t + 4 < NT) DMA_K(t + 4); if (t + 5 < NT) DMA_K(t + 5); if (t + 2 < NT) DMA_V(t + 2); if (t + 3 < NT) DMA_V(t + 3);
        STEP3(sA0, sA1, sB0, sB1, pB, pA, t);
        STEP3(sB0, sB1, sA0, sA1, pA, pB, t + 1);
    }
    WAITBAR(0);
    __builtin_amdgcn_sched_barrier(0);
    PVH(pA, t, 0); PVH(pA, t, 1); SOFT(sB0, sB1, pB);
    __builtin_amdgcn_sched_barrier(0);
    PVH(pB, t + 1, 0); PVH(pB, t + 1, 1);
    float lsum = (ls0 + ls1) + (ls2 + ls3);
    lsum = swap32_sum(lsum);
    if (hi == 0) wsf[32 + r32] = __builtin_amdgcn_rcpf(lsum);
    asm volatile("s_waitcnt vmcnt(0) lgkmcnt(0)\n\ts_barrier" ::: "memory");
    { LAS bf16* stg = (LAS bf16*)(lds + wid * 4096);
#pragma unroll
      for (int rq = 0; rq < 4; ++rq) { const f32x4 i4 = *(const LAS f32x4*)(wsf + 32 + 8 * rq + 4 * hi);
#pragma unroll
          for (int j = 0; j < 4; ++j) { const int q = 8 * rq + 4 * hi + j;
              stg[q * 64 + r32] = (bf16)f2bf(o[0][4 * rq + j] * i4[j]); stg[q * 64 + 32 + r32] = (bf16)f2bf(o[1][4 * rq + j] * i4[j]); } }
      asm volatile("s_waitcnt lgkmcnt(0)" ::: "memory");
      bf16* Ow = A.O + (A.qrow0 + wid * 32) * A.opitch + A.ocol;
#pragma unroll
      for (int i = 0; i < 4; ++i) { const int row = i * 8 + (lane >> 3), ch = lane & 7; *(u32x4*)(Ow + (long)row * A.opitch + ch * 8) = *(const LAS u32x4*)(stg + row * 64 + ch * 8); } }
    asm volatile("s_waitcnt vmcnt(0) lgkmcnt(0)\n\ts_barrier" ::: "memory");
#undef TILE_ROW
#undef DMA_K
#undef DMA_V
#undef WAITBAR
#undef QKH
#undef PVH
#undef SOFT
#undef HINTS
#undef STEP3
}

#define ASBAR() __builtin_amdgcn_sched_barrier(0)
#define APIN(x) asm volatile("" : "+v"(x))
template <int DK> __device__ __forceinline__ void attn_unit4(const AttnArgs& A, LAS unsigned char* lds, int wave_) {
    constexpr int NKS = DK / 16, KSLOT = (DK / 8) * 1024, NKSLOT = 4, NVSLOT = 4;
    constexpr int LDS_K = 0, LDS_V = NKSLOT * KSLOT, LDS_WS = LDS_V + NVSLOT * VSLOT;
    int tid = wave_ * 64 + lane_id(); asm volatile("" : "+v"(tid));
    const int lane = tid & 63, r32 = lane & 31, hi = lane >> 5; const int wid = __builtin_amdgcn_readfirstlane(tid >> 6);
    const unsigned lds0 = (unsigned)(uintptr_t)lds;
    LAS float* wsf = (LAS float*)(lds + LDS_WS) + wid * 64;
    const int NT = A.ntiles, b = A.b;
#define TILE_ROW(j) ((j) < 4 ? (long)(NLAT + b * CTXL + 64 * (j)) : (long)(b * SEQ + 64 * ((j) - 4)))
#define DMA_K(j) do { const long r0_ = TILE_ROW(j); const int s_ = (j) & 3; \
        glds16(A.K1 + (r0_ + lane) * A.k1pitch + A.k1col + wid * 8, (unsigned)__builtin_amdgcn_readfirstlane(lds0 + LDS_K + s_ * KSLOT + wid * 1024)); \
        if (DK == 96 && wid < 4) glds16(A.K2 + (r0_ + lane) * A.k2pitch + wid * 8, (unsigned)__builtin_amdgcn_readfirstlane(lds0 + LDS_K + s_ * KSLOT + (8 + wid) * 1024)); } while (0)
#define DMA_V(j) do { const long r0_ = TILE_ROW(j); const int s_ = (j) & 3; \
        glds16(A.V + (r0_ + 16 * (wid & 3) + (lane >> 2)) * A.vpitch + A.vcol + (wid >> 2) * 32 + (lane & 3) * 8, (unsigned)__builtin_amdgcn_readfirstlane(lds0 + LDS_V + (s_) * VSLOT + wid * 1024)); } while (0)
#define WAITBAR(n) asm volatile("s_waitcnt vmcnt(" #n ") lgkmcnt(0)\n\ts_barrier" ::: "memory")
    bf16x8 qr[NKS];
    { const bf16* Qw = A.Q + (A.qrow0 + wid * 32 + r32) * A.qpitch + A.qcol + hi * 8;
#pragma unroll
      for (int ks = 0; ks < NKS; ++ks) qr[ks] = *(const bf16x8*)(Qw + ks * 16); }
    DMA_K(0); DMA_K(1); DMA_V(0); DMA_K(2); DMA_K(3); DMA_V(1);
    float lsum = 0.f; f32x16 o[2]; o[0] = f32x16{}; o[1] = f32x16{};
    const LAS unsigned char* Kb = lds + LDS_K + hi * 1024 + r32 * 16;
    const LAS unsigned char* Vb = lds + LDS_V + (4 * hi + ((lane & 15) >> 2)) * 64 + ((lane >> 4) & 1) * 32 + (lane & 3) * 8;
    f32x16 pA0, pA1, pB0, pB1; bf16x8 kf[2 * NKS]; s16x4 vlo[8], vhi[8]; u32x4 pw0, pw1, pw2, pw3;
#define MF(a, b, c) __builtin_amdgcn_mfma_f32_32x32x16_bf16(a, b, c, 0, 0, 0)
#define KLD2(kp, d0) do { kf[2 * (d0)] = *(const LAS bf16x8*)((kp) + (d0) * 2048); kf[2 * (d0) + 1] = *(const LAS bf16x8*)((kp) + (d0) * 2048 + 512); } while (0)
#define PKW(P, i) pk2(P[i], P[(i) + 1])
#define PAF(k) __builtin_bit_cast(bf16x8, pw##k)
#define VFR(i) (bf16x8){vlo[i][0], vlo[i][1], vlo[i][2], vlo[i][3], vhi[i][0], vhi[i][1], vhi[i][2], vhi[i][3]}
#define VRD(i) do { vlo[i] = vtr(vp_ + (((i) >> 2) * 4096 + ((i) & 3) * 1024)); vhi[i] = vtr(vp_ + (((i) >> 2) * 4096 + ((i) & 3) * 1024 + 512)); } while (0)
#define KRD(G, d0) do { if (G) { KLD2(kn_, d0); ASBAR(); } } while (0)
#define EX(v) __builtin_amdgcn_exp2f(v)
#define GAPA(MFS, a0, a1, a2, a3, W0, W1, PW) do { MFS; sacc += a0; sacc += a1; sacc += a2; sacc += a3; W0; W1; APIN(PW); APIN(sacc); ASBAR(); } while (0)
#define GAPB(MFS, X, i) do { MFS; X[i] = EX(X[i]); X[(i) + 1] = EX(X[(i) + 1]); X[(i) + 2] = EX(X[(i) + 2]); X[(i) + 3] = EX(X[(i) + 3]); APIN(X); ASBAR(); } while (0)
#define STEP4(C0, C1, P0, P1, t, GL) do { ASBAR(); \
    const LAS unsigned char* vp_ = Vb + (((t) - 1) & 3) * VSLOT; const LAS unsigned char* kn_ = Kb + (((t) + 1) & 3) * KSLOT; \
    VRD(0); ASBAR(); float sacc = P0[0] + P0[1]; \
                     GAPA(C0 = MF(kf[0], qr[0], f32x16{}), P0[2], P0[3], P0[4], P0[5],     pw0[0] = PKW(P0, 0),  pw0[1] = PKW(P0, 2),  pw0); \
    VRD(4); ASBAR(); GAPA(C1 = MF(kf[1], qr[0], f32x16{}), P0[6], P0[7], P0[8], P0[9],     pw0[2] = PKW(P0, 4),  pw0[3] = PKW(P0, 6),  pw0); \
    VRD(1); ASBAR(); GAPA(C0 = MF(kf[2], qr[1], C0),       P0[10], P0[11], P0[12], P0[13], pw1[0] = PKW(P0, 8),  pw1[1] = PKW(P0, 10), pw1); \
    VRD(5); ASBAR(); GAPA(C1 = MF(kf[3], qr[1], C1),       P0[14], P0[15], P1[0], P1[1],   pw1[2] = PKW(P0, 12), pw1[3] = PKW(P0, 14), pw1); \
    VRD(2); ASBAR(); GAPA(C0 = MF(kf[4], qr[2], C0),       P1[2], P1[3], P1[4], P1[5],     pw2[0] = PKW(P1, 0),  pw2[1] = PKW(P1, 2),  pw2); \
    VRD(6); ASBAR(); GAPA(C1 = MF(kf[5], qr[2], C1),       P1[6], P1[7], P1[8], P1[9],     pw2[2] = PKW(P1, 4),  pw2[3] = PKW(P1, 6),  pw2); \
    VRD(3); ASBAR(); GAPA(C0 = MF(kf[6], qr[3], C0),       P1[10], P1[11], P1[12], P1[13], pw3[0] = PKW(P1, 8),  pw3[1] = PKW(P1, 10), pw3); \
    VRD(7); ASBAR(); GAPA(C1 = MF(kf[7], qr[3], C1),       P1[14], P1[15], 0.f, 0.f,       pw3[2] = PKW(P1, 12), pw3[3] = PKW(P1, 14), pw3); \
    if (NKS == 6) { C0 = MF(kf[2 * (NKS - 2)], qr[NKS - 2], C0); C1 = MF(kf[2 * (NKS - 2) + 1], qr[NKS - 2], C1); C0 = MF(kf[2 * (NKS - 1)], qr[NKS - 1], C0); C1 = MF(kf[2 * (NKS - 1) + 1], qr[NKS - 1], C1); ASBAR(); } \
    lsum += sacc; ASBAR(); \
    GAPB(o[0] = MF(PAF(0), VFR(0), o[0]), C0, 0);               KRD((GL) && NKS == 6, 4); GAPB(o[1] = MF(PAF(0), VFR(4), o[1]), C0, 4); \
    KRD(GL, 0); GAPB(o[0] = MF(PAF(1), VFR(1), o[0]), C0, 8);   KRD(GL, 1); GAPB(o[1] = MF(PAF(1), VFR(5), o[1]), C0, 12); \
    KRD(GL, 2); GAPB(o[0] = MF(PAF(2), VFR(2), o[0]), C1, 0);   KRD(GL, 3); GAPB(o[1] = MF(PAF(2), VFR(6), o[1]), C1, 4); \
    KRD((GL) && NKS == 6, 5); GAPB(o[0] = MF(PAF(3), VFR(3), o[0]), C1, 8);   GAPB(o[1] = MF(PAF(3), VFR(7), o[1]), C1, 12); \
    } while (0)
    WAITBAR(0);
#pragma unroll
    for (int d0 = 0; d0 < NKS; ++d0) KLD2(Kb, d0);
#pragma unroll
    for (int d0 = 0; d0 < NKS; ++d0) { pA0 = MF(kf[2 * d0], qr[d0], d0 == 0 ? f32x16{} : pA0); pA1 = MF(kf[2 * d0 + 1], qr[d0], d0 == 0 ? f32x16{} : pA1); }
#pragma unroll
    for (int r = 0; r < 16; ++r) { pA0[r] = EX(pA0[r]); pA1[r] = EX(pA1[r]); }
#pragma unroll
    for (int d0 = 0; d0 < NKS; ++d0) KLD2(Kb + KSLOT, d0);
    int t = 1;
    for (; t + 2 < NT; t += 2) {
        WAITBAR(0);
        if (t + 3 < NT) DMA_K(t + 3); if (t + 4 < NT) DMA_K(t + 4); if (t + 1 < NT) DMA_V(t + 1); if (t + 2 < NT) DMA_V(t + 2);
        STEP4(pB0, pB1, pA0, pA1, t, true);
        STEP4(pA0, pA1, pB0, pB1, t + 1, true);
    }
    WAITBAR(0);
    STEP4(pB0, pB1, pA0, pA1, t, false);
    { ASBAR(); float sacc = pB0[0] + pB0[1];
#pragma unroll
      for (int r = 2; r < 16; ++r) sacc += pB0[r];
#pragma unroll
      for (int r = 0; r < 16; ++r) sacc += pB1[r];
      lsum += sacc;
      pw0 = (u32x4){PKW(pB0, 0), PKW(pB0, 2), PKW(pB0, 4), PKW(pB0, 6)}; pw1 = (u32x4){PKW(pB0, 8), PKW(pB0, 10), PKW(pB0, 12), PKW(pB0, 14)};
      pw2 = (u32x4){PKW(pB1, 0), PKW(pB1, 2), PKW(pB1, 4), PKW(pB1, 6)}; pw3 = (u32x4){PKW(pB1, 8), PKW(pB1, 10), PKW(pB1, 12), PKW(pB1, 14)};
      const LAS unsigned char* vp_ = Vb + (t & 3) * VSLOT;
#pragma unroll
      for (int i = 0; i < 8; ++i) VRD(i);
      o[0] = MF(PAF(0), VFR(0), o[0]); o[1] = MF(PAF(0), VFR(4), o[1]); o[0] = MF(PAF(1), VFR(1), o[0]); o[1] = MF(PAF(1), VFR(5), o[1]);
      o[0] = MF(PAF(2), VFR(2), o[0]); o[1] = MF(PAF(2), VFR(6), o[1]); o[0] = MF(PAF(3), VFR(3), o[0]); o[1] = MF(PAF(3), VFR(7), o[1]); }
    lsum = swap32_sum(lsum);
    if (hi == 0) wsf[32 + r32] = __builtin_amdgcn_rcpf(lsum);
    asm volatile("s_waitcnt vmcnt(0) lgkmcnt(0)\n\ts_barrier" ::: "memory");
    { LAS bf16* stg = (LAS bf16*)(lds + wid * 4096);
#pragma unroll
      for (int rq = 0; rq < 4; ++rq) { const f32x4 i4 = *(const LAS f32x4*)(wsf + 32 + 8 * rq + 4 * hi);
#pragma unroll
          for (int j = 0; j < 4; ++j) { const int q = 8 * rq + 4 * hi + j;
              stg[q * 64 + r32] = (bf16)f2bf(o[0][4 * rq + j] * i4[j]); stg[q * 64 + 32 + r32] = (bf16)f2bf(o[1][4 * rq + j] * i4[j]); } }
      asm volatile("s_waitcnt lgkmcnt(0)" ::: "memory");
      bf16* Ow = A.O + (A.qrow0 + wid * 32) * A.opitch + A.ocol;
#pragma unroll
      for (int i = 0; i < 4; ++i) { const int row = i * 8 + (lane >> 3), ch = lane & 7; *(u32x4*)(Ow + (long)row * A.opitch + ch * 8) = *(const LAS u32x4*)(stg + row * 64 + ch * 8); } }
    asm volatile("s_waitcnt vmcnt(0) lgkmcnt(0)\n\ts_barrier" ::: "memory");
#undef TILE_ROW
#undef DMA_K
#undef DMA_V
#undef WAITBAR
#undef MF
#undef KLD2
#undef PKW
#undef PAF
#undef VFR
#undef VRD
#undef KRD
#undef EX
#undef GAPA
#undef GAPB
#undef STEP4
}
#undef ASBAR
#undef APIN
}

namespace s5 {
constexpr int NCH = LPOS / 16;
constexpr int M_MC = 0, M_WCF = 65536, M_WCB = 65536 + 32768, M_WSF = 131072, M_WSB = 131072 + 32768, M_TOTAL = 196608;
constexpr int LDS_E = 18 * 4096;

struct Params { const float *lam_re, *lam_im, *log_dt, *b_re, *b_im, *c_re, *c_im, *dsk; };

__device__ __forceinline__ void build_mats(const Params& P, int l, int g, bf16* out, LAS unsigned char* lds, int wave_) {
    LAS f32x2* apow = (LAS f32x2*)lds;
    LAS f32x2* Bb = apow + 2 * 64 * 17;
    LAS f32x2* Cc = Bb + 2 * 64 * 16;
    LAS float* Kt = (LAS float*)(Cc + 2 * 16 * 64);
    constexpr int KTL = 260, KTD = 16 * KTL;
    const int tid = wave_ * 64 + lane_id();
    LAS float* lamv = Kt + 2 * KTD;
    LAS float* dskv = lamv + 512;
    f32x2 cv[4], bv[4];
#pragma unroll
    for (int m = 0; m < 4; ++m) { const int i = tid + NTHREADS * m; { const int dir = i >> 10, hp = (i >> 6) & 15, p = i & 63; const size_t ci = ((size_t)((l * 2 + dir) * 32 + g) * 16 + hp) * 64 + p; cv[m] = (f32x2){P.c_re[ci], P.c_im[ci]}; }
        { const int dir = i >> 10, p = (i >> 4) & 63, h = i & 15, pi = ((l * 2 + dir) * 32 + g) * 64 + p; bv[m] = (f32x2){P.b_re[(size_t)pi * 16 + h], P.b_im[(size_t)pi * 16 + h]}; } }
    if (tid < 128) { const int dir = tid >> 6, p = tid & 63, pi = ((l * 2 + dir) * 32 + g) * 64 + p;
        lamv[4 * tid] = fminf(P.lam_re[pi], -1e-4f); lamv[4 * tid + 1] = P.lam_im[pi]; lamv[4 * tid + 2] = expf(P.log_dt[(l * 2 + dir) * 32 + g]); }
    else if (tid < 144) dskv[tid - 128] = P.dsk[(l * 32 + g) * 16 + tid - 128];
#pragma unroll
    for (int m = 0; m < 4; ++m) Cc[tid + NTHREADS * m] = cv[m];
    __syncthreads();
    for (int i = tid; i < 2 * 64 * 17; i += NTHREADS) {
        const int dir = i / (64 * 17), r = i - dir * (64 * 17), p = r / 17, j = r - p * 17;
        const float lr = lamv[4 * (dir * 64 + p)], li = lamv[4 * (dir * 64 + p) + 1], dt = lamv[4 * (dir * 64 + p) + 2];
        const float mag = expf((float)j * lr * dt), ang = (float)j * li * dt; apow[i] = (f32x2){mag * cosf(ang), mag * sinf(ang)}; }
#pragma unroll
    for (int m = 0; m < 4; ++m) {
        const int i = tid + NTHREADS * m, dir = i >> 10, p = (i >> 4) & 63;
        const float lr = lamv[4 * (dir * 64 + p)], li = lamv[4 * (dir * 64 + p) + 1], dt = lamv[4 * (dir * 64 + p) + 2];
        const float abr = expf(lr * dt) * cosf(li * dt), abi = expf(lr * dt) * sinf(li * dt), den = lr * lr + li * li;
        const float fr = ((abr - 1.0f) * lr + abi * li) / den, fi = (abi * lr - (abr - 1.0f) * li) / den;
        const float br = bv[m].x, bi = bv[m].y; Bb[i] = (f32x2){fr * br - fi * bi, fr * bi + fi * br}; }
    __syncthreads();
    {
        const int dir = tid >> 8, j = (tid >> 4) & 15, hp0 = ((tid >> 2) & 3) * 4, h0 = (tid & 3) * 4; float sacc[4][4];
#pragma unroll
        for (int x = 0; x < 4; ++x)
#pragma unroll
            for (int y = 0; y < 4; ++y) sacc[x][y] = 0.f;
        for (int p = 0; p < 64; ++p) { const f32x2 a = apow[(dir * 64 + p) * 17 + j];
            const f32x2 c0_ = Cc[(dir * 16 + hp0) * 64 + p], c1_ = Cc[(dir * 16 + hp0 + 1) * 64 + p], c2_ = Cc[(dir * 16 + hp0 + 2) * 64 + p], c3_ = Cc[(dir * 16 + hp0 + 3) * 64 + p];
            const f32x4 c01 = {c0_.x, c0_.y, c1_.x, c1_.y}, c23 = {c2_.x, c2_.y, c3_.x, c3_.y};
            const f32x4 b01 = *(const LAS f32x4*)(Bb + (dir * 64 + p) * 16 + h0), b23 = *(const LAS f32x4*)(Bb + (dir * 64 + p) * 16 + h0 + 2);
            const float cx[4] = {c01[0], c01[2], c23[0], c23[2]}, cy[4] = {c01[1], c01[3], c23[1], c23[3]}, bx[4] = {b01[0], b01[2], b23[0], b23[2]}, by[4] = {b01[1], b01[3], b23[1], b23[3]};
#pragma unroll
            for (int x = 0; x < 4; ++x) { const float tr = cx[x] * a.x - cy[x] * a.y, ti = cx[x] * a.y + cy[x] * a.x;
#pragma unroll
                for (int y = 0; y < 4; ++y) sacc[x][y] += tr * bx[y] - ti * by[y]; } }
#pragma unroll
        for (int x = 0; x < 4; ++x) *(LAS f32x4*)(Kt + dir * KTD + j * KTL + (hp0 + x) * 16 + h0) = (f32x4){sacc[x][0], sacc[x][1], sacc[x][2], sacc[x][3]};
    }
    __syncthreads();
#pragma unroll 4
    for (int i = tid; i < 65536 / 8; i += NTHREADS) {
        const int row = i >> 5, c0 = (i & 31) * 8, t = row >> 4, hp = row & 15, s = c0 >> 4, h0 = c0 & 15; float v[8];
        const int lf = s <= t ? t - s : 0, lb = s >= t ? s - t : 0;
        const f32x4 f0 = *(const LAS f32x4*)(Kt + lf * KTL + hp * 16 + h0), f1 = *(const LAS f32x4*)(Kt + lf * KTL + hp * 16 + h0 + 4);
        const f32x4 b0 = *(const LAS f32x4*)(Kt + KTD + lb * KTL + hp * 16 + h0), b1 = *(const LAS f32x4*)(Kt + KTD + lb * KTL + hp * 16 + h0 + 4);
        const float wf = s <= t ? 1.f : 0.f, wb = s >= t ? 1.f : 0.f;
#pragma unroll
        for (int e = 0; e < 8; ++e) { const int h = h0 + e; float x = 0.f;
            if (s <= t) x += (e < 4 ? f0[e & 3] : f1[e & 3]);
            if (s >= t) x += (e < 4 ? b0[e & 3] : b1[e & 3]);
            if (s == t && h == hp) x += dskv[h];
            v[e] = x; }
        (void)wf; (void)wb;
        *(u32x4*)(out + M_MC + (size_t)row * 256 + c0) = pack8(v);
    }
#pragma unroll 4
    for (int i = tid; i < 2 * 32768 / 8; i += NTHREADS) {
        const int dir = i >> 12, ii = i & 4095, row = ii >> 4, c0 = (ii & 15) * 8, t = row >> 4, hp = row & 15, ex = dir == 0 ? t + 1 : 16 - t; float v[8];
#pragma unroll
        for (int e = 0; e < 8; e += 2) { const int p = (c0 + e) >> 1; const f32x2 c = Cc[(dir * 16 + hp) * 64 + p], a = apow[(dir * 64 + p) * 17 + ex];
            v[e] = c.x * a.x - c.y * a.y; v[e + 1] = -(c.x * a.y + c.y * a.x); }
        *(u32x4*)(out + (dir == 0 ? M_WCF : M_WCB) + (size_t)row * 128 + c0) = pack8(v);
    }
#pragma unroll 4
    for (int i = tid; i < 2 * 32768 / 8; i += NTHREADS) {
        const int dir = i >> 12, ii = i & 4095, row = ii >> 5, c0 = (ii & 31) * 8, p = row >> 1, im = row & 1, s = c0 >> 4, h0 = c0 & 15, ex = dir == 0 ? 15 - s : s; float v[8];
        const f32x2 a = apow[(dir * 64 + p) * 17 + ex];
#pragma unroll
        for (int e = 0; e < 8; ++e) { const f32x2 bb = Bb[(dir * 64 + p) * 16 + h0 + e]; v[e] = im ? (a.x * bb.y + a.y * bb.x) : (a.x * bb.x - a.y * bb.y); }
        *(u32x4*)(out + (dir == 0 ? M_WSF : M_WSB) + (size_t)row * 256 + c0) = pack8(v);
    }
    __syncthreads();
}

__device__ __forceinline__ void build_a16(const Params& P, float* a16, int gt, int ngt) {
    for (int pi = gt; pi < 2 * 2 * 32 * 64; pi += ngt) {
        const float lr = fminf(P.lam_re[pi], -1e-4f), li = P.lam_im[pi], dt = expf(P.log_dt[pi >> 6]);
        const float mag = expf(16.f * lr * dt), ang = 16.f * li * dt; a16[2 * pi] = mag * cosf(ang); a16[2 * pi + 1] = mag * sinf(ang); }
}
__device__ __forceinline__ void unit(const float* a16, int l, int b, int g, const bf16* Ug, const bf16* mats, bf16* Aglu, bool skip_ctx, LAS unsigned char* lds, int wave_, int half) {
    int tid = wave_ * 64 + lane_id(); asm volatile("" : "+v"(tid));
    const int lane = tid & 63, n = lane & 15, q = lane >> 4; const int wid = __builtin_amdgcn_readfirstlane(tid >> 6);
    LAS unsigned char* Ef = lds; LAS unsigned char* Eb = lds + LDS_E;
    const bf16* U = Ug + (size_t)(b * 32 + g) * LPOS * 16;
    const int rt = 8 * half + wid;
    f32x4 yi[17];
    {
        bf16x8 af[8], ab[8], am[8]; u32x4 st[4]; unsigned uoff[8];
#pragma unroll
        for (int ks = 0; ks < 8; ++ks) { af[ks] = *(const bf16x8*)(mats + M_WSF + (size_t)(16 * wid + n) * 256 + 32 * ks + 8 * q); ab[ks] = *(const bf16x8*)(mats + M_WSB + (size_t)(16 * wid + n) * 256 + 32 * ks + 8 * q);
            am[ks] = *(const bf16x8*)(mats + M_MC + (size_t)(16 * rt + n) * 256 + 32 * ks + 8 * q); }
        const bf16* ug = U + wid * 512 + lane * 8;
        const int ns = 2 * wid + (lane >> 5), js = lane & 31;
        const unsigned sdst = (ns < 8 ? 0u : (unsigned)LDS_E) + (ns & 7) * 512 + ((js ^ ns) << 4);
#pragma unroll
        for (int i = 0; i < 4; ++i) st[i] = *(const u32x4*)(ug + i * 4096);
#pragma unroll
        for (int ks = 0; ks < 8; ++ks) uoff[ks] = (n < 8 ? 0u : (unsigned)LDS_E) + (n & 7) * 512 + (((4 * ks + q) ^ n) << 4);
        *(LAS u32x4*)(lds + sdst + 4096) = st[0]; st[0] = *(const u32x4*)(ug + 4 * 4096);
        __syncthreads();
#pragma unroll
        for (int t = 0; t < 17; ++t) {
            bf16x8 ub[8];
#pragma unroll
            for (int ks = 0; ks < 8; ++ks) ub[ks] = *(const LAS bf16x8*)(lds + 4096 * (t + 1) + uoff[ks]);
            if (t + 1 < 17) { *(LAS u32x4*)(lds + sdst + 4096 * (t + 2)) = st[(t + 1) & 3]; if (t + 5 < 17) st[(t + 1) & 3] = *(const u32x4*)(ug + (t + 5) * 4096); }
            f32x4 cf = {0.f, 0.f, 0.f, 0.f}, cb = {0.f, 0.f, 0.f, 0.f}, cy = {0.f, 0.f, 0.f, 0.f};
#pragma unroll
            for (int ks = 0; ks < 8; ++ks) { cf = __builtin_amdgcn_mfma_f32_16x16x32_bf16(af[ks], ub[ks], cf, 0, 0, 0); cb = __builtin_amdgcn_mfma_f32_16x16x32_bf16(ab[ks], ub[ks], cb, 0, 0, 0);
                if (!(t == 0 && skip_ctx)) cy = __builtin_amdgcn_mfma_f32_16x16x32_bf16(am[ks], ub[ks], cy, 0, 0, 0); }
            yi[t] = cy;
            const int eo = (16 * t + n) * 256 + (((2 * wid + (q >> 1)) ^ n) << 4) + (q & 1) * 8;
            *(LAS u32x2*)(Ef + eo) = (u32x2){pk2(cf[0], cf[1]), pk2(cf[2], cf[3])};
            *(LAS u32x2*)(Eb + eo) = (u32x2){pk2(cb[0], cb[1]), pk2(cb[2], cb[3])};
            __syncthreads();
        }
    }
    bf16x8 wf[4], wb[4];
#pragma unroll
    for (int ks = 0; ks < 4; ++ks) { wf[ks] = *(const bf16x8*)(mats + M_WCF + (size_t)(16 * rt + n) * 128 + 32 * ks + 8 * q); wb[ks] = *(const bf16x8*)(mats + M_WCB + (size_t)(16 * rt + n) * 128 + 32 * ks + 8 * q); }
    if (wid < 2) {
        const int dir = wid, p = lane, pi = ((l * 2 + dir) * 32 + g) * 64 + p;
        const float ar = a16[2 * pi], ai = a16[2 * pi + 1];
        LAS unsigned* E32 = (LAS unsigned*)(dir ? Eb : Ef);
        float xr = 0.f, xi = 0.f;
#define S5_CH(st) (dir == 0 ? (st) : ((st) < 16 ? 15 - (st) : NCH + 15 - (st)))
#define S5_EW(k, j) (S5_CH(16 * (k) + (j)) * 64 + ((((p >> 2) ^ (dir == 0 ? (j) : 15 - (j))) << 2) | (p & 3)))
        unsigned ea[16], eb[16];
#pragma unroll
        for (int j = 0; j < 16; ++j) ea[j] = E32[S5_EW(0, j)];
        for (int k = 0; k < 17; k += 2) {
#pragma unroll
            for (int j = 0; j < 16; ++j) eb[j] = E32[S5_EW(k + 1 < 17 ? k + 1 : k, j)];
#pragma unroll
            for (int j = 0; j < 16; ++j) { const unsigned e = ea[j]; E32[S5_EW(k, j)] = pk2(xr, xi);
                const float er = bf2f(e & 0xffffu), ei = bf2f(e >> 16); const float nr = ar * xr - ai * xi + er, ni = ar * xi + ai * xr + ei; xr = nr; xi = ni; }
            if (k + 1 < 17) {
#pragma unroll
                for (int j = 0; j < 16; ++j) ea[j] = E32[S5_EW(k + 2 < 17 ? k + 2 : k + 1, j)];
#pragma unroll
                for (int j = 0; j < 16; ++j) { const unsigned e = eb[j]; E32[S5_EW(k + 1, j)] = pk2(xr, xi);
                    const float er = bf2f(e & 0xffffu), ei = bf2f(e >> 16); const float nr = ar * xr - ai * xi + er, ni = ar * xi + ai * xr + ei; xr = nr; xi = ni; }
            }
        }
#undef S5_EW
#undef S5_CH
    }
    __syncthreads();
    {
        unsigned xoff[4];
#pragma unroll
        for (int ks = 0; ks < 4; ++ks) xoff[ks] = n * 256 + (((q + 4 * ks) ^ n) << 4);
#pragma unroll
        for (int ct = 0; ct < 17; ++ct) {
            if (ct == 0 && skip_ctx) continue;
            int cto = ct; asm volatile("" : "+s"(cto));
            f32x4 acc = yi[ct];
#pragma unroll
            for (int ks = 0; ks < 4; ++ks) { acc = __builtin_amdgcn_mfma_f32_16x16x32_bf16(wf[ks], *(const LAS bf16x8*)(Ef + 4096 * cto + xoff[ks]), acc, 0, 0, 0);
                acc = __builtin_amdgcn_mfma_f32_16x16x32_bf16(wb[ks], *(const LAS bf16x8*)(Eb + 4096 * cto + xoff[ks]), acc, 0, 0, 0); }
            const int pos = (16 * cto + n) * 16 + rt;
            *(u32x2*)(Aglu + (size_t)pos_row(b, pos) * 512 + g * 16 + 4 * q) = (u32x2){pk2(fgelu_tanh(acc[0]), fgelu_tanh(acc[1])), pk2(fgelu_tanh(acc[2]), fgelu_tanh(acc[3]))};
        }
    }
    __syncthreads();
}
}

struct Ptrs {
    const float *x, *c, *ctx, *c_ctx, *w_mod, *b_mod, *g_mix_pre, *g_mix_post, *g_ffn_pre, *g_ffn_post, *w_in, *g_q, *g_k, *g_cq, *g_ckv, *w_uq, *w_ukv;
    s5::Params s5p;
    const float *w_glu, *w_branch, *w_mg, *b_mg, *w_out, *ffn_w1, *ffn_w3, *ffn_w2, *router_w, *router_b, *moe_w1, *moe_w3, *moe_w2;
    float* out; unsigned char* ws;
};

template <int MAP  >
__device__ __forceinline__ void transpose_item(const float* W, int K, int N, bf16* WT, int kb, int n0, int drow0, LAS float* scr, int lane) {
    const int k0 = 64 * kb;
#pragma unroll
    for (int i = 0; i < 8; ++i) { const int kk = 8 * i + (lane >> 3), c4 = 4 * (lane & 7); const f32x4 v = *(const f32x4*)(W + (size_t)(k0 + kk) * N + n0 + c4);
        LAS float* d = scr + kk * 33 + c4; d[0] = v[0]; d[1] = v[1]; d[2] = v[2]; d[3] = v[3]; }
    asm volatile("s_waitcnt lgkmcnt(0)" ::: "memory");
    const int c = lane & 7;
#pragma unroll
    for (int j = 0; j < 4; ++j) { const int n = (lane >> 3) + 8 * j; const LAS float* s = scr + (8 * c) * 33 + n;
        u32x4 o; o.x = pk2(s[0 * 33], s[1 * 33]); o.y = pk2(s[2 * 33], s[3 * 33]); o.z = pk2(s[4 * 33], s[5 * 33]); o.w = pk2(s[6 * 33], s[7 * 33]);
        int dr = n; if (MAP == 1) { const int i2 = n & 15; dr = 8 * (i2 >> 2) + (i2 & 3) + ((n >> 4) << 2); }
        *(u32x4*)(WT + (size_t)(drow0 + dr) * K + k0 + 8 * c) = o; }
    asm volatile("s_waitcnt lgkmcnt(0)" ::: "memory");
}

__device__ __forceinline__ void transpose_item_f8(const float* W, int K, int N, unsigned char* WT, int kb, int n0, int drow0, float wscale, LAS float* scr, int lane) {
    const int k0 = 64 * kb;
#pragma unroll
    for (int i = 0; i < 8; ++i) { const int kk = 8 * i + (lane >> 3), c4 = 4 * (lane & 7); const f32x4 v = *(const f32x4*)(W + (size_t)(k0 + kk) * N + n0 + c4);
        LAS float* d = scr + kk * 33 + c4; d[0] = v[0]; d[1] = v[1]; d[2] = v[2]; d[3] = v[3]; }
    asm volatile("s_waitcnt lgkmcnt(0)" ::: "memory");
    const int c = lane & 7;
#pragma unroll
    for (int j = 0; j < 4; ++j) { const int n = (lane >> 3) + 8 * j; const LAS float* s = scr + (8 * c) * 33 + n;
        u32x2 o; o.x = pg8::pk_fp8x4(s[0 * 33] * wscale, s[1 * 33] * wscale, s[2 * 33] * wscale, s[3 * 33] * wscale); o.y = pg8::pk_fp8x4(s[4 * 33] * wscale, s[5 * 33] * wscale, s[6 * 33] * wscale, s[7 * 33] * wscale);
        *(u32x2*)(WT + (size_t)(drow0 + n) * K + k0 + 8 * c) = o; }
    asm volatile("s_waitcnt lgkmcnt(0)" ::: "memory");
}
__device__ __forceinline__ int zmap(int n0) { return n0 < 512 ? n0 : n0 < 896 ? ZC_CQ + (n0 - 512) : n0 < 1024 ? ZC_KG + (n0 - 896) : n0 < 1152 ? ZC_VG + (n0 - 1024) : n0 < 1440 ? n0 : ZC_U + (n0 - 1440); }
__device__ __forceinline__ int pairmap(int n0, int second) { return 256 * (n0 >> 7) + (second ? 128 : 0) + (n0 & 127); }

__device__ __forceinline__ void transposes(const Ptrs& P, int gw, int ngw, LAS float* scr, int lane, int qsel = 0) {
    unsigned char* ws = P.ws;
    constexpr int I_WIN = 16 * 61, I_MG = 16 * 96, I_UQ = 6 * 24, I_UKV = 4 * 32, I_GLU = 8 * 32, I_BR = 8 * 32, I_OUT = 16 * 32, I_F13 = 16 * 88, I_F2 = 44 * 32;
    constexpr int PER_L = I_WIN + I_MG + I_UQ + I_UKV + I_GLU + 3 * I_BR + I_OUT;
    constexpr int N_L = 2 * PER_L, N_F = 2 * I_F13 + I_F2, N_M = 8 * (2 * I_F13 + I_F2), NITEMS = N_L + N_F + N_M;
    const int qx = (int)blockIdx.x & 7;
    unsigned* q = (unsigned*)(ws + WS_CTL) + CW_Q + 256 * qsel + 32 * qx; (void)gw; (void)ngw;
    for (;;) { int base = 0; if (lane == 0) base = (int)atomicAdd(q, 4u); base = __builtin_amdgcn_readfirstlane(base); if (base * 8 + qx + N_M >= NITEMS) break;
    for (int it_ = base; it_ < base + 4; ++it_) { const int it = it_ * 8 + qx + N_M; if (it >= NITEMS) break;
        int r = it;
        if (r < N_M) {
            const int e = r / (2 * I_F13 + I_F2); r -= e * (2 * I_F13 + I_F2);
            unsigned char* W1T = ws + WS_WM1T + (size_t)e * 5632 * 1024; unsigned char* W2T = ws + WS_WM2T + (size_t)e * 1024 * 2816;
            if (r < I_F13) { const int kb = r / 88, nb = r % 88; if (F8_M1) transpose_item_f8(P.moe_w1 + (size_t)e * 1024 * DFF, 1024, DFF, W1T, kb, 32 * nb, pairmap(32 * nb, 0), F8_WSCALE, scr, lane); else transpose_item<0>(P.moe_w1 + (size_t)e * 1024 * DFF, 1024, DFF, (bf16*)(ws + WS_WM1T) + (size_t)e * 5632 * 1024, kb, 32 * nb, pairmap(32 * nb, 0), scr, lane); continue; } r -= I_F13;
            if (r < I_F13) { const int kb = r / 88, nb = r % 88; if (F8_M1) transpose_item_f8(P.moe_w3 + (size_t)e * 1024 * DFF, 1024, DFF, W1T, kb, 32 * nb, pairmap(32 * nb, 1), F8_WSCALE, scr, lane); else transpose_item<0>(P.moe_w3 + (size_t)e * 1024 * DFF, 1024, DFF, (bf16*)(ws + WS_WM1T) + (size_t)e * 5632 * 1024, kb, 32 * nb, pairmap(32 * nb, 1), scr, lane); continue; } r -= I_F13;
            { const int kb = r / 32, nb = r % 32; transpose_item_f8(P.moe_w2 + (size_t)e * DFF * 1024, DFF, 1024, W2T, kb, 32 * nb, 32 * nb, F8_WSCALE, scr, lane); continue; }
        }
        r -= N_M;
        if (r < N_F) {
            unsigned char* W1T = ws + WS_WF1T; unsigned char* W2T = ws + WS_WF2T;
            if (r < I_F13) { const int kb = r / 88, nb = r % 88; if (F8_D1) transpose_item_f8(P.ffn_w1, 1024, DFF, W1T, kb, 32 * nb, pairmap(32 * nb, 0), F8_WSCALE, scr, lane); else transpose_item<0>(P.ffn_w1, 1024, DFF, (bf16*)W1T, kb, 32 * nb, pairmap(32 * nb, 0), scr, lane); continue; } r -= I_F13;
            if (r < I_F13) { const int kb = r / 88, nb = r % 88; if (F8_D1) transpose_item_f8(P.ffn_w3, 1024, DFF, W1T, kb, 32 * nb, pairmap(32 * nb, 1), F8_WSCALE, scr, lane); else transpose_item<0>(P.ffn_w3, 1024, DFF, (bf16*)W1T, kb, 32 * nb, pairmap(32 * nb, 1), scr, lane); continue; } r -= I_F13;
            { const int kb = r / 32, nb = r % 32; if (F8_D2) transpose_item_f8(P.ffn_w2, DFF, 1024, W2T, kb, 32 * nb, 32 * nb, F8_WSCALE, scr, lane); else transpose_item<0>(P.ffn_w2, DFF, 1024, (bf16*)W2T, kb, 32 * nb, 32 * nb, scr, lane); continue; }
        }
        r -= N_F;
        const int l = r / PER_L; r -= l * PER_L;
        if (r < I_WIN) { const int kb = r / 61, nb = r % 61; if (F8_G1L1 && l == 1) transpose_item_f8(P.w_in + (size_t)l * 1024 * NIN, 1024, NIN, ws + WS_W1T + (size_t)l * ZW * 2048, kb, 32 * nb, zmap(32 * nb), F8_WSCALE, scr, lane);
            else transpose_item<0>(P.w_in + (size_t)l * 1024 * NIN, 1024, NIN, (bf16*)(ws + WS_W1T) + (size_t)l * ZW * 1024, kb, 32 * nb, zmap(32 * nb), scr, lane); continue; } r -= I_WIN;
        if (r < I_MG) { const int kb = r / 96, nb = r % 96; transpose_item_f8(P.w_mg + (size_t)l * 1024 * 3072, 1024, 3072, ws + WS_WMGT + (size_t)l * 3072 * 1024, kb, 32 * nb, 32 * nb, F8_WSCALE, scr, lane); continue; } r -= I_MG;
        if (r < I_UQ) { const int kb = r / 24, nb = r % 24; bf16* T = (bf16*)(ws + WS_WUQT) + (size_t)l * 768 * 384;
            if (nb % 3 == 2) transpose_item<1>(P.w_uq + (size_t)l * 384 * 768, 384, 768, T, kb, 32 * nb, 32 * nb, scr, lane); else transpose_item<0>(P.w_uq + (size_t)l * 384 * 768, 384, 768, T, kb, 32 * nb, 32 * nb, scr, lane); continue; } r -= I_UQ;
        if (r < I_UKV) { const int kb = r / 32, nb = r % 32; transpose_item<0>(P.w_ukv + (size_t)l * 256 * 1024, 256, 1024, (bf16*)(ws + WS_WUKVT) + (size_t)l * 1024 * 256, kb, 32 * nb, 32 * nb, scr, lane); continue; } r -= I_UKV;
        if (r < I_GLU) { const int kb = r / 32, nb = r % 32, n0 = 32 * nb; transpose_item<0>(P.w_glu + (size_t)l * 512 * 1024, 512, 1024, (bf16*)(ws + WS_WGLUT) + (size_t)l * 1024 * 512, kb, n0, n0 < 512 ? pairmap(n0, 0) : pairmap(n0 - 512, 1), scr, lane); continue; } r -= I_GLU;
        if (r < 3 * I_BR) { const int n = r / I_BR; r -= n * I_BR; const int kb = r / 32, nb = r % 32;
            transpose_item<0>(P.w_branch + ((size_t)l * 3 + n) * 512 * 1024, 512, 1024, (bf16*)(ws + WS_WBT) + ((size_t)l * 3 + n) * 1024 * 512, kb, 32 * nb, 32 * nb, scr, lane); continue; } r -= 3 * I_BR;
        { const int kb = r / 32, nb = r % 32; transpose_item<0>(P.w_out + (size_t)l * 1024 * 1024, 1024, 1024, (bf16*)(ws + WS_WOUTT) + (size_t)l * 1024 * 1024, kb, 32 * nb, 32 * nb, scr, lane); }
    } }
}


constexpr int MOE_ITEMS_PER_E = 2 * 16 * 88 + 44 * 32, MOE_ITEMS = 8 * MOE_ITEMS_PER_E;
struct TrItem { const float* W; unsigned char* WT; int K, N, kb, n0, drow0; };
__device__ __forceinline__ void tr_load(const TrItem& I, int lane, f32x4 (&v)[8]) {
    const int k0 = 64 * I.kb;
#pragma unroll
    for (int i = 0; i < 8; ++i) { const int kk = 8 * i + (lane >> 3), c4 = 4 * (lane & 7); v[i] = *(const f32x4*)(I.W + (size_t)(k0 + kk) * I.N + I.n0 + c4); }
}
__device__ __forceinline__ void tr_store_f8(const TrItem& I, const f32x4 (&v)[8], float wscale, LAS float* scr, int lane) {
    const int k0 = 64 * I.kb;
#pragma unroll
    for (int i = 0; i < 8; ++i) { const int kk = 8 * i + (lane >> 3), c4 = 4 * (lane & 7); LAS float* d = scr + kk * 33 + c4; d[0] = v[i][0]; d[1] = v[i][1]; d[2] = v[i][2]; d[3] = v[i][3]; }
    asm volatile("s_waitcnt lgkmcnt(0)" ::: "memory");
    const int c = lane & 7;
#pragma unroll
    for (int j = 0; j < 4; ++j) { const int n = (lane >> 3) + 8 * j; const LAS float* sp = scr + (8 * c) * 33 + n;
        u32x2 o; o.x = pg8::pk_fp8x4(sp[0 * 33] * wscale, sp[1 * 33] * wscale, sp[2 * 33] * wscale, sp[3 * 33] * wscale); o.y = pg8::pk_fp8x4(sp[4 * 33] * wscale, sp[5 * 33] * wscale, sp[6 * 33] * wscale, sp[7 * 33] * wscale);
        *(u32x2*)(I.WT + (size_t)(I.drow0 + n) * I.K + k0 + 8 * c) = o; }
    asm volatile("s_waitcnt lgkmcnt(0)" ::: "memory");
}
__device__ __forceinline__ TrItem moe_item(const float* w1, const float* w3, const float* w2, unsigned char* ws, int it) {
    constexpr int I_F13 = 16 * 88; TrItem I;
    const int e = it / MOE_ITEMS_PER_E; int r = it - e * MOE_ITEMS_PER_E;
    unsigned char* W1T = ws + WS_WM1T + (size_t)e * 5632 * 1024; unsigned char* W2T = ws + WS_WM2T + (size_t)e * 1024 * 2816;
    if (r < 2 * I_F13) { const int sec = r >= I_F13 ? 1 : 0; r -= sec * I_F13; const int kb = r / 88, nb = r % 88;
        I.W = (sec ? w3 : w1) + (size_t)e * 1024 * DFF; I.WT = W1T; I.K = 1024; I.N = DFF; I.kb = kb; I.n0 = 32 * nb; I.drow0 = pairmap(32 * nb, sec); }
    else { r -= 2 * I_F13; const int kb = r / 32, nb = r % 32; I.W = w2 + (size_t)e * DFF * 1024; I.WT = W2T; I.K = DFF; I.N = 1024; I.kb = kb; I.n0 = 32 * nb; I.drow0 = 32 * nb; }
    return I;
}
__device__ __forceinline__ void moe_transposes(const float* w1, const float* w3, const float* w2, unsigned char* ws, int lo, int hi, int giw, int ngiw, LAS float* scr, int lane) {
    static_assert(F8_M1 != 0, "the MoE weight copies are fp8");
    int it = lo + giw; if (it >= hi) return;
    f32x4 va[8], vb[8]; TrItem Ia = moe_item(w1, w3, w2, ws, it), Ib = Ia; tr_load(Ia, lane, va);
    for (;;) {
        const int itb = it + ngiw; const bool hb = itb < hi;
        if (hb) { Ib = moe_item(w1, w3, w2, ws, itb); tr_load(Ib, lane, vb); }
        tr_store_f8(Ia, va, F8_WSCALE, scr, lane);
        if (!hb) break;
        const int ita = itb + ngiw; const bool ha = ita < hi;
        if (ha) { Ia = moe_item(w1, w3, w2, ws, ita); tr_load(Ia, lane, va); }
        tr_store_f8(Ib, vb, F8_WSCALE, scr, lane);
        if (!ha) break;
        it = ita;
    }
}
__device__ __forceinline__ void mod_item(const Ptrs& P, int item, LAS unsigned char* lds, int wave_) {
    LAS float* sc = (LAS float*)lds;
    LAS float* part = sc + 5 * 1024;
    const int lane = lane_id(), wid = wave_, tid = wid * 64 + lane, l = item / 96, n0 = (item % 96) * 64;
    for (int i = tid; i < 5 * 1024; i += NTHREADS) { const float v = i < 4096 ? P.c[i] : P.c_ctx[i - 4096]; sc[i] = v / (1.0f + expf(-v)); }
    __syncthreads();
    float a[5] = {0.f, 0.f, 0.f, 0.f, 0.f};
    const float* W = P.w_mod + (size_t)l * 1024 * 6144 + n0 + lane;
    for (int k0 = wid; k0 < 1024; k0 += 256) {
        float w[32];
#pragma unroll
        for (int j = 0; j < 32; ++j) w[j] = W[(size_t)(k0 + 8 * j) * 6144];
#pragma unroll
        for (int j = 0; j < 32; ++j)
#pragma unroll
            for (int r = 0; r < 5; ++r) a[r] += sc[r * 1024 + k0 + 8 * j] * w[j]; }
#pragma unroll
    for (int r = 0; r < 5; ++r) part[(wid * 5 + r) * 64 + lane] = a[r];
    __syncthreads();
    if (tid < 320) { const int r = tid >> 6; float s = 0.f;
#pragma unroll
        for (int w = 0; w < 8; ++w) s += part[(w * 5 + r) * 64 + lane];
        ((float*)(P.ws + WS_MOD))[((size_t)l * 5 + r) * 6144 + n0 + lane] = s + P.b_mod[l * 6144 + n0 + lane]; }
    __syncthreads();
}
__device__ __forceinline__ void copy_params(const Ptrs& P, int gt, int ngt) {
    float* par = (float*)(P.ws + WS_PAR);
    for (int i = gt; i < 2048; i += ngt) { par[PR_GMIXPRE + i] = P.g_mix_pre[i]; par[PR_GMIXPOST + i] = P.g_mix_post[i]; par[PR_GFFNPRE + i] = P.g_ffn_pre[i]; par[PR_GFFNPOST + i] = P.g_ffn_post[i]; }
    for (int i = gt; i < 128; i += ngt) { par[PR_GQ + i] = P.g_q[i]; par[PR_GK + i] = P.g_k[i]; }
    for (int i = gt; i < 768; i += ngt) par[PR_GCQ + i] = P.g_cq[i];
    for (int i = gt; i < 512; i += ngt) par[PR_GCKV + i] = P.g_ckv[i];
    for (int i = gt; i < 6144; i += ngt) par[PR_BMG + i] = P.b_mg[i];
    for (int i = gt; i < 8192; i += ngt) par[PR_RW + i] = P.router_w[i];
    for (int i = gt; i < 8; i += ngt) par[PR_RB + i] = P.router_b[i];
    s5::build_a16(P.s5p, par + PR_A16, gt, ngt);
}
__device__ __forceinline__ void rope_tables(const Ptrs& P, int gt, int ngt) {
    float* ca = (float*)(P.ws + WS_ROPE); float* sa = ca + 4096 * 32; float* cb = sa + 4096 * 32; float* sb = cb + 4096 * 16;
    for (int i = gt; i < 4096 * 32; i += ngt) { const int pos = i >> 5, j = i & 31; const float f = expf(-9.210340371976184f * (float)(j & 15) * (1.0f / 16.0f));
        const float ang = (float)(j < 16 ? pos / GRIDW : pos % GRIDW) * f; ca[i] = cosf(ang); sa[i] = sinf(ang); }
    for (int i = gt; i < 4096 * 16; i += ngt) { const int pos = i >> 4, j = i & 15; const float f = expf(-9.210340371976184f * (float)(j & 7) * (1.0f / 8.0f));
        const float ang = (float)(j < 8 ? pos / GRIDW : pos % GRIDW) * f; cb[i] = cosf(ang); sb[i] = sinf(ang); }
}

__device__ __forceinline__ void ld8(const float* p, float (&o)[8]) { const f32x4 a = *(const f32x4*)p, b = *(const f32x4*)(p + 4); o[0] = a[0]; o[1] = a[1]; o[2] = a[2]; o[3] = a[3]; o[4] = b[0]; o[5] = b[1]; o[6] = b[2]; o[7] = b[3]; }
__device__ __forceinline__ void token_row(unsigned char* ws, int l, int row, int lane) {
    const float* par = (const float*)(ws + WS_PAR);
    const bf16* z = (const bf16*)(ws + P_Z) + (size_t)row * ZW;
    const bool lat = row < NLAT; const int t = row & (SEQ - 1);
    const float* cosA = (const float*)(ws + WS_ROPE) + t * 32; const float* sinA = cosA + 4096 * 32;
    const float* cosB = (const float*)(ws + WS_ROPE) + 2 * 4096 * 32 + t * 16; const float* sinB = cosB + 4096 * 16;
    float v0[8], v1[8], v2[8];
    unpack8(*(const u32x4*)(z + 8 * lane), v0); unpack8(*(const u32x4*)(z + 512 + 8 * lane), v1); unpack8(*(const u32x4*)(z + 1024 + 8 * lane), v2);
    const u32x4 uraw = *(const u32x4*)(z + ZC_U + 8 * lane);
    float ca[8], sa[8], cb8[8], sb8[8];
    ld8(cosA + ((8 * (lane & 7)) & 31), ca); ld8(sinA + ((8 * (lane & 7)) & 31), sa); ld8(cosB + ((8 * ((lane - 48) & 3)) & 15), cb8); ld8(sinB + ((8 * ((lane - 48) & 3)) & 15), sb8);
    { float ss = 0.f;
#pragma unroll
      for (int j = 0; j < 8; ++j) ss += v0[j] * v0[j];
      ss += shfl_xor_l(ss, 1, lane); ss += shfl_xor_l(ss, 2, lane); ss += shfl_xor_l(ss, 4, lane);
      const float rs = rsqrtf(ss * (1.0f / 64.0f) + EPS); const int d0 = 8 * (lane & 7); float o[8], gq[8];
      ld8(par + PR_GQ + l * 64 + d0, gq);
#pragma unroll
      for (int j = 0; j < 8; ++j) v0[j] = v0[j] * rs * gq[j];
#pragma unroll
      for (int j = 0; j < 8; ++j) { const float other = shfl_xor_l(v0[j], 4, lane); const float c = ca[j], s = sa[j];
          o[j] = lat ? ((d0 < 32) ? v0[j] * c - other * s : other * s + v0[j] * c) : v0[j];
          o[j] *= 0.125f * LOG2E; }
      *(u32x4*)((bf16*)(ws + P_QA) + (size_t)row * 512 + 8 * lane) = pack8(o); }
    { float ss = 0.f;
#pragma unroll
      for (int j = 0; j < 8; ++j) ss += v1[j] * v1[j];
      float ssk = ss; ssk += shfl_xor_l(ssk, 1, lane); ssk += shfl_xor_l(ssk, 2, lane); ssk += shfl_xor_l(ssk, 4, lane);
      float ss2 = 0.f;
#pragma unroll
      for (int j = 0; j < 8; ++j) ss2 += v2[j] * v2[j];
      const float sq = wave_sum((lane >= 32 ? ss : 0.f) + (lane < 16 ? ss2 : 0.f));
      const float skv = wave_sum((lane >= 16 && lane < 48) ? ss2 : 0.f);
      const float rq = rsqrtf(sq * (1.0f / 384.0f) + EPS), rkv = rsqrtf(skv * (1.0f / 256.0f) + EPS);
      { const float rs = rsqrtf(ssk * (1.0f / 64.0f) + EPS); const int d0 = 8 * (lane & 7); float kk[8], o[8], gk[8];
        ld8(par + PR_GK + l * 64 + d0, gk);
#pragma unroll
        for (int j = 0; j < 8; ++j) kk[j] = v1[j] * rs * gk[j];
#pragma unroll
        for (int j = 0; j < 8; ++j) { const float other = shfl_xor_l(kk[j], 4, lane); const float c = ca[j], s = sa[j];
            o[j] = lat ? ((d0 < 32) ? kk[j] * c - other * s : other * s + kk[j] * c) : kk[j]; }
        if (lane < 16) *(u32x4*)((bf16*)(ws + P_KA) + (size_t)row * 128 + 8 * lane) = pack8(o); }
      if (lane >= 16 && lane < 32) *(u32x4*)((bf16*)(ws + P_VA) + (size_t)row * 128 + 8 * (lane - 16)) = pack8(v1);
      { float g1[8], g2[8], g3[8], o[8];
        const int i1 = lane >= 32 ? 8 * (lane - 32) : 0, i2 = lane < 16 ? 256 + 8 * lane : 0, i3 = (lane >= 16 && lane < 48) ? 8 * (lane - 16) : 0;
        ld8(par + PR_GCQ + l * 384 + i1, g1); ld8(par + PR_GCQ + l * 384 + i2, g2); ld8(par + PR_GCKV + l * 256 + i3, g3);
#pragma unroll
        for (int j = 0; j < 8; ++j) o[j] = v1[j] * rq * g1[j];
        if (lane >= 32) *(u32x4*)((bf16*)(ws + P_CQN) + (size_t)row * 384 + i1) = pack8(o);
#pragma unroll
        for (int j = 0; j < 8; ++j) o[j] = v2[j] * rq * g2[j];
        if (lane < 16) *(u32x4*)((bf16*)(ws + P_CQN) + (size_t)row * 384 + i2) = pack8(o);
#pragma unroll
        for (int j = 0; j < 8; ++j) o[j] = v2[j] * rkv * g3[j];
        if (lane >= 16 && lane < 48) *(u32x4*)((bf16*)(ws + P_CKVN) + (size_t)row * 256 + i3) = pack8(o); }
      { float o[8]; const int i0 = 8 * ((lane - 48) & 3);
#pragma unroll
        for (int j = 0; j < 8; ++j) { const float other = shfl_xor_l(v2[j], 2, lane); const float c = cb8[j], s = sb8[j];
            o[j] = lat ? ((i0 < 16) ? v2[j] * c - other * s : other * s + v2[j] * c) : v2[j]; }
        if (lane >= 48 && lane < 52) *(u32x4*)((bf16*)(ws + P_KRR) + (size_t)row * 32 + i0) = pack8(o); }
    }
    { const int b = lat ? row >> 12 : (row - NLAT) >> 8, pos = lat ? CTXL + t : (row - NLAT) & 255, g = lane >> 1;
      *(u32x4*)((bf16*)(ws + P_UG) + ((size_t)(b * 32 + g) * LPOS + pos) * 16 + 8 * (lane & 1)) = uraw; }
}

struct ResidArgs {
    int mode;
    const float* y; const float* g_post; int gate_chunk;
    const float* g_pre; int shift_chunk;
    bool dry;
    float ysc;
    bf16* hout; int l_mod; bool h8; unsigned char* hout8;
    int l_gate; bool route;
};
__device__ __forceinline__ void resid_row(unsigned char* ws, float* outp, const float* xin, const float* ctxin, const ResidArgs R, int row, int lane, const LAS int* tb) {
    const float* par = (const float*)(ws + WS_PAR);
    const bool lat = row < NLAT; const int b = lat ? row >> 12 : (row - NLAT) >> 8, mr = lat ? b : 4;
    const float* mod = (const float*)(ws + WS_MOD);
    float* latp = lat ? outp + (size_t)row * 1024 : (float*)(ws + WS_LATC) + (size_t)(row - NLAT) * 1024;
    f32x4 v[4];
    if (R.mode == 0) { const float* src = lat ? xin + (size_t)row * 1024 : ctxin + (size_t)(row - NLAT) * 1024;
#pragma unroll
        for (int j = 0; j < 4; ++j) v[j] = *(const f32x4*)(src + 4 * lane + 256 * j);
    } else {
        f32x4 yv[4];
        if (R.mode == 1) {
#pragma unroll
            for (int j = 0; j < 4; ++j) yv[j] = *(const f32x4*)(R.y + (size_t)row * 1024 + 4 * lane + 256 * j) * R.ysc;
        } else if (R.mode == 3) {
            const bf16* yb = (const bf16*)R.y + (size_t)row * 1024;
#pragma unroll
            for (int j = 0; j < 4; ++j) { const u32x2 a = *(const u32x2*)(yb + 4 * lane + 256 * j);
                yv[j] = (f32x4){bf2f(a.x & 0xffffu), bf2f(a.x >> 16), bf2f(a.y & 0xffffu), bf2f(a.y >> 16)} * R.ysc; }
        } else {
            const int* ti = (const int*)(ws + WS_LIST) + 8 * 16384 + row * 8;
            const int e0 = ti[0], p0 = ti[1], e1 = ti[2], p1 = ti[3]; const float w0 = __int_as_float(ti[4]) * R.ysc, w1 = __int_as_float(ti[5]) * R.ysc;
            const bf16* f0 = (const bf16*)(ws + P_Y2) + ((size_t)tb[8 + e0] * 256 + p0) * 1024; const bf16* f1 = (const bf16*)(ws + P_Y2) + ((size_t)tb[8 + e1] * 256 + p1) * 1024;
#pragma unroll
            for (int j = 0; j < 4; ++j) { const u32x2 a = *(const u32x2*)(f0 + 4 * lane + 256 * j), c = *(const u32x2*)(f1 + 4 * lane + 256 * j);
                yv[j][0] = w0 * bf2f(a.x & 0xffffu) + w1 * bf2f(c.x & 0xffffu); yv[j][1] = w0 * bf2f(a.x >> 16) + w1 * bf2f(c.x >> 16);
                yv[j][2] = w0 * bf2f(a.y & 0xffffu) + w1 * bf2f(c.y & 0xffffu); yv[j][3] = w0 * bf2f(a.y >> 16) + w1 * bf2f(c.y >> 16); }
        }
        float ss = 0.f;
#pragma unroll
        for (int j = 0; j < 4; ++j) ss += (yv[j][0] * yv[j][0] + yv[j][1] * yv[j][1]) + (yv[j][2] * yv[j][2] + yv[j][3] * yv[j][3]);
        const float rs = rsqrtf(wave_sum(ss) * (1.0f / 1024.0f) + EPS);
        const float* gate = mod + ((size_t)R.l_gate * 5 + mr) * 6144 + R.gate_chunk * 1024;
#pragma unroll
        for (int j = 0; j < 4; ++j) { const int c = 4 * lane + 256 * j; const f32x4 lv = *(const f32x4*)(latp + c), gp = *(const f32x4*)(R.g_post + c), gt = *(const f32x4*)(gate + c);
            v[j] = lv + gt * (yv[j] * rs * gp); }
    }
    if (!R.dry) {
#pragma unroll
    for (int j = 0; j < 4; ++j) *(f32x4*)(latp + 4 * lane + 256 * j) = v[j]; }
    if (R.hout == nullptr) return;
    float ss = 0.f;
#pragma unroll
    for (int j = 0; j < 4; ++j) ss += (v[j][0] * v[j][0] + v[j][1] * v[j][1]) + (v[j][2] * v[j][2] + v[j][3] * v[j][3]);
    const float rs = rsqrtf(wave_sum(ss) * (1.0f / 1024.0f) + EPS);
    const float* shift = mod + ((size_t)R.l_mod * 5 + mr) * 6144 + R.shift_chunk * 1024; const float* scale = shift + 1024;
    f32x4 hv[4];
#pragma unroll
    for (int j = 0; j < 4; ++j) { const int c = 4 * lane + 256 * j; const f32x4 gp = *(const f32x4*)(R.g_pre + c), sh = *(const f32x4*)(shift + c), sc = *(const f32x4*)(scale + c);
        hv[j] = (v[j] * rs * gp) * (1.0f + sc) + sh;
        if (R.dry) { if (hv[j][0] == 123.456f) *(float*)(ws + WS_CTL + 64) = 1.f; continue; }
        if (R.hout8) *(unsigned*)(R.hout8 + (size_t)row * 1024 + c) = pg8::pk_fp8x4(hv[j][0] * F8_HSCALE, hv[j][1] * F8_HSCALE, hv[j][2] * F8_HSCALE, hv[j][3] * F8_HSCALE);
        if (R.h8) *(unsigned*)((unsigned char*)R.hout + (size_t)row * 1024 + c) = pg8::pk_fp8x4(hv[j][0] * F8_HSCALE, hv[j][1] * F8_HSCALE, hv[j][2] * F8_HSCALE, hv[j][3] * F8_HSCALE);
        else *(u32x2*)(R.hout + (size_t)row * 1024 + c) = (u32x2){pk2(hv[j][0], hv[j][1]), pk2(hv[j][2], hv[j][3])}; }
    if (R.route) {
        float lg[8];
#pragma unroll
        for (int e = 0; e < 8; ++e) lg[e] = 0.f;
#pragma unroll
        for (int j = 0; j < 4; ++j)
#pragma unroll
            for (int i = 0; i < 4; ++i) { const float* rw = par + PR_RW + (size_t)(4 * lane + 256 * j + i) * 8; const f32x4 r0 = *(const f32x4*)rw, r1 = *(const f32x4*)(rw + 4); const float hvv = hv[j][i];
                lg[0] += hvv * r0[0]; lg[1] += hvv * r0[1]; lg[2] += hvv * r0[2]; lg[3] += hvv * r0[3]; lg[4] += hvv * r1[0]; lg[5] += hvv * r1[1]; lg[6] += hvv * r1[2]; lg[7] += hvv * r1[3]; }
#pragma unroll
        for (int e = 0; e < 8; ++e) lg[e] = wave_sum(lg[e]) + par[PR_RB + e];
        int e0 = 0; float b0 = lg[0];
#pragma unroll
        for (int e = 1; e < 8; ++e) if (lg[e] > b0) { b0 = lg[e]; e0 = e; }
        int e1 = -1; float b1 = -3.0e38f;
#pragma unroll
        for (int e = 0; e < 8; ++e) if (e != e0 && lg[e] > b1) { b1 = lg[e]; e1 = e; }
        if (lane == 0 && !R.dry) {
            const float w0 = 1.0f / (1.0f + expf(b1 - b0)), w1 = 1.0f - w0;
            unsigned* cnt = (unsigned*)(ws + WS_CTL) + CW_CNT;
            const int p0 = (int)atomicAdd(cnt + e0, 1u), p1 = (int)atomicAdd(cnt + e1, 1u);
            int* list = (int*)(ws + WS_LIST); list[e0 * 16384 + p0] = row; list[e1 * 16384 + p1] = row;
            int* ti = list + 8 * 16384 + row * 8; ti[0] = e0; ti[1] = p0; ti[2] = e1; ti[3] = p1; ti[4] = __float_as_int(w0); ti[5] = __float_as_int(w1);
        }
    }
}

#if MK_DEBUG
namespace dbg {
__device__ __forceinline__ unsigned hash(unsigned a, unsigned b) { unsigned x = a * 0x9E3779B1u ^ (b + 0x7F4A7C15u) * 0x85EBCA77u; x ^= x >> 15; x *= 0xC2B2AE3Du; x ^= x >> 13; x *= 0x27D4EB2Fu; x ^= x >> 16; return x; }
__device__ __forceinline__ float rbf(float f) { return bf2f(f2bf(f)); }
__device__ __forceinline__ void add(unsigned char* ws, int k, float got, float ref, int lane) {
    if (lane == 0) { float* d = (float*)(ws + WS_CTL) + CW_DBG + 2 * k; const float df = got - ref; atomicAdd(d, (df == df && fabsf(df) < 1e18f) ? df * df : 1e30f); atomicAdd(d + 1, ref * ref); }
}
__device__ __forceinline__ float dot_aw(const bf16* a, const float* w, size_t wstride, int K, int lane) { float s = 0.f; for (int k = lane; k < K; k += 64) s += bf2f(a[k]) * rbf(w[(size_t)k * wstride]); return wave_sum(s); }

__device__ __forceinline__ float angA(int t, int i) { return (float)(i < 16 ? t / 64 : t % 64) * powf(10000.f, -(float)(2 * (i & 15)) / 32.f); }
__device__ __forceinline__ float angB(int t, int i) { return (float)(i < 8 ? t / 64 : t % 64) * powf(10000.f, -(float)(2 * (i & 7)) / 16.f); }
__device__ __forceinline__ void chk_mod(unsigned char* ws, const float* const* in, int gw, int ngw, int lane) {
    for (int s = gw; s < 1024; s += ngw) { const unsigned hh = hash(s, 1); const int l = hh & 1, r = (hh >> 1) % 5, n = (hh >> 8) % 6144; float a = 0.f;
        for (int k = lane; k < 1024; k += 64) { const float c = r < 4 ? in[1][r * 1024 + k] : in[3][k]; a += c / (1.f + expf(-c)) * in[4][((size_t)l * 1024 + k) * 6144 + n]; }
        a = wave_sum(a) + in[5][l * 6144 + n]; add(ws, 0, ((const float*)(ws + WS_MOD))[((size_t)l * 5 + r) * 6144 + n], a, lane); }
}
__device__ __forceinline__ void chk_weights(unsigned char* ws, const float* const* in, int gw, int ngw, int lane) {
    for (int s = gw * 64 + lane; s < 65536; s += ngw * 64) { const unsigned hh = hash(s, 2), h2 = hash(s, 3); const int l = hh & 1; float got = 0.f, ref = 0.f; const int which = (hh >> 1) % 12;
        if (which == 0) { const int j = (hh >> 8) % 1952, k = h2 % 1024; int dr = j < 512 ? j : j < 896 ? 768 + (j - 512) : j < 1024 ? 512 + (j - 896) : j < 1152 ? 640 + (j - 1024) : j < 1440 ? j : 1536 + (j - 1440);
            got = bf2f(((const bf16*)(ws + WS_W1T))[((size_t)l * 2048 + dr) * 1024 + k]); ref = rbf(in[10][((size_t)l * 1024 + k) * 1952 + j]); }
        else if (which == 1) { const int j = (hh >> 8) % 3072, k = h2 % 1024; got = bf2f(((const bf16*)(ws + WS_WMGT))[((size_t)l * 3072 + j) * 1024 + k]); ref = rbf(in[27][((size_t)l * 1024 + k) * 3072 + j]); }
        else if (which == 2) { const int j = (hh >> 8) % 768, k = h2 % 384, hd = j / 96, e = j % 96; int de = e; if (e >= 64) { const int i = e - 64; de = 64 + (i < 16 ? 8 * (i >> 2) + (i & 3) : 8 * ((i - 16) >> 2) + 4 + ((i - 16) & 3)); }
            got = bf2f(((const bf16*)(ws + WS_WUQT))[((size_t)l * 768 + hd * 96 + de) * 384 + k]); ref = rbf(in[15][((size_t)l * 384 + k) * 768 + j]); }
        else if (which == 3) { const int j = (hh >> 8) % 1024, k = h2 % 256; got = bf2f(((const bf16*)(ws + WS_WUKVT))[((size_t)l * 1024 + j) * 256 + k]); ref = rbf(in[16][((size_t)l * 256 + k) * 1024 + j]); }
        else if (which == 4) { const int j = (hh >> 8) % 1024, k = h2 % 512; const int jj = j < 512 ? j : j - 512; const int dr = 256 * (jj / 128) + (j < 512 ? 0 : 128) + jj % 128;
            got = bf2f(((const bf16*)(ws + WS_WGLUT))[((size_t)l * 1024 + dr) * 512 + k]); ref = rbf(in[25][((size_t)l * 512 + k) * 1024 + j]); }
        else if (which == 5) { const int n = (hh >> 4) % 3, j = (hh >> 8) % 1024, k = h2 % 512; got = bf2f(((const bf16*)(ws + WS_WBT))[(((size_t)l * 3 + n) * 1024 + j) * 512 + k]); ref = rbf(in[26][(((size_t)l * 3 + n) * 512 + k) * 1024 + j]); }
        else if (which == 6) { const int j = (hh >> 8) % 1024, k = h2 % 1024; got = bf2f(((const bf16*)(ws + WS_WOUTT))[((size_t)l * 1024 + j) * 1024 + k]); ref = rbf(in[29][((size_t)l * 1024 + k) * 1024 + j]); }
        else if (which == 7) { const int j = (hh >> 8) % 2816, k = h2 % 1024, sec = (hh >> 5) & 1; const int dr = 256 * (j / 128) + sec * 128 + j % 128;
            got = bf2f(((const bf16*)(ws + WS_WF1T))[(size_t)dr * 1024 + k]); ref = rbf(in[sec ? 31 : 30][(size_t)k * 2816 + j]); }
        else if (which == 8) { const int j = (hh >> 8) % 1024, k = h2 % 2816; got = bf2f(((const bf16*)(ws + WS_WF2T))[(size_t)j * 2816 + k]); ref = rbf(in[32][(size_t)k * 1024 + j]); }
        else if (which <= 10) { const int e = (hh >> 5) & 7, j = (hh >> 8) % 2816, k = h2 % 1024, sec = which - 9; const int dr = 256 * (j / 128) + sec * 128 + j % 128;
            got = bf2f(((const bf16*)(ws + WS_WM1T))[((size_t)e * 5632 + dr) * 1024 + k]); ref = rbf(in[sec ? 36 : 35][((size_t)e * 1024 + k) * 2816 + j]); }
        else { const int e = (hh >> 5) & 7, j = (hh >> 8) % 1024, k = h2 % 2816; got = bf2f(((const bf16*)(ws + WS_WM2T))[((size_t)e * 1024 + j) * 2816 + k]); ref = rbf(in[37][((size_t)e * 2816 + k) * 1024 + j]); }
        float* d = (float*)(ws + WS_CTL) + CW_DBG + 2 * 1; const float df = got - ref; atomicAdd(d, (df == df) ? df * df : 1e30f); atomicAdd(d + 1, ref * ref); }
}
__device__ __forceinline__ void chk_h(unsigned char* ws, const float* const* in, const float* outp, int k, int l_mod, int shift_chunk, const float* g_pre, int nrows, int gw, int ngw, int lane) {
    for (int s = gw; s < 512; s += ngw) { const int row = hash(s, 10 + k) % nrows; const bool lat = row < NLAT; const int mr = lat ? row >> 12 : 4;
        const float* latp = lat ? outp + (size_t)row * 1024 : (const float*)(ws + WS_LATC) + (size_t)(row - NLAT) * 1024; float ss = 0.f;
        for (int c = lane; c < 1024; c += 64) ss += latp[c] * latp[c];
        const float rs = rsqrtf(wave_sum(ss) / 1024.f + EPS); const float* mod = (const float*)(ws + WS_MOD) + ((size_t)l_mod * 5 + mr) * 6144 + shift_chunk * 1024;
        const int c = hash(s, 77) % 1024; const float ref = latp[c] * rs * g_pre[c] * (1.f + mod[1024 + c]) + mod[c];
        add(ws, k, bf2f(((const bf16*)(ws + P_H))[(size_t)row * 1024 + c]), ref, lane); }
}
template <class F> __device__ __forceinline__ void chk_gemm(unsigned char* ws, int k, const bf16* A, int lda, const float* W, int N, int K, int nrows, int ncols, F fin, int gw, int ngw, int lane) {
    for (int s = gw; s < 1024; s += ngw) { const unsigned hh = hash(s, 20 + k); const int row = hh % nrows, col = (hh >> 16) % ncols;
        const float ref = dot_aw(A + (size_t)row * lda, W + col, N, K, lane); float got, rr; fin(row, col, ref, got, rr); add(ws, k, got, rr, lane); }
}
__device__ __forceinline__ void chk_tok(unsigned char* ws, int k, int l, int gw, int ngw, int lane) {
    const float* par = (const float*)(ws + WS_PAR);
    for (int s = gw; s < 1024; s += ngw) { const unsigned hh = hash(s, 40 + k); const int row = hh % MALL; const bool lat = row < NLAT; const int t = row & 4095; const bf16* z = (const bf16*)(ws + P_Z) + (size_t)row * ZW;
        const int which = (hh >> 20) % 6; float got = 0.f, ref = 0.f;
        if (which == 0 || which == 1) { const int nh = which == 0 ? 8 : 2, hd = (hh >> 24) % nh, d = (hh >> 14) & 63; const bf16* x = z + (which == 0 ? 0 : ZC_KG) + hd * 64; const float* g = par + (which == 0 ? PR_GQ : PR_GK) + l * 64;
            float ss = 0.f; for (int i = 0; i < 64; ++i) ss += bf2f(x[i]) * bf2f(x[i]); const float rs = rsqrtf(ss / 64.f + EPS);
            const int i = d & 31; const float x1 = bf2f(x[i]) * rs * g[i], x2 = bf2f(x[i + 32]) * rs * g[i + 32]; float o = d < 32 ? x1 : x2;
            if (lat) { const float an = angA(t, i), c = cosf(an), sn = sinf(an); o = d < 32 ? x1 * c - x2 * sn : x1 * sn + x2 * c; }
            if (which == 0) { o *= 0.125f * LOG2E; got = bf2f(((const bf16*)(ws + P_QA))[(size_t)row * 512 + hd * 64 + d]); } else got = bf2f(((const bf16*)(ws + P_KA))[(size_t)row * 128 + hd * 64 + d]);
            ref = o; }
        else if (which == 2) { const int i = (hh >> 8) % 384; float ss = 0.f; for (int j = 0; j < 384; ++j) ss += bf2f(z[ZC_CQ + j]) * bf2f(z[ZC_CQ + j]);
            ref = bf2f(z[ZC_CQ + i]) * rsqrtf(ss / 384.f + EPS) * par[PR_GCQ + l * 384 + i]; got = bf2f(((const bf16*)(ws + P_CQN))[(size_t)row * 384 + i]); }
        else if (which == 3) { const int i = (hh >> 8) % 256; float ss = 0.f; for (int j = 0; j < 256; ++j) ss += bf2f(z[ZC_CKV + j]) * bf2f(z[ZC_CKV + j]);
            ref = bf2f(z[ZC_CKV + i]) * rsqrtf(ss / 256.f + EPS) * par[PR_GCKV + l * 256 + i]; got = bf2f(((const bf16*)(ws + P_CKVN))[(size_t)row * 256 + i]); }
        else if (which == 4) { const int d = (hh >> 8) & 31, i = d & 15; const float x1 = bf2f(z[ZC_KR + i]), x2 = bf2f(z[ZC_KR + 16 + i]); float o = d < 16 ? x1 : x2;
            if (lat) { const float an = angB(t, i), c = cosf(an), sn = sinf(an); o = d < 16 ? x1 * c - x2 * sn : x1 * sn + x2 * c; } ref = o; got = bf2f(((const bf16*)(ws + P_KRR))[(size_t)row * 32 + d]); }
        else { const int c = (hh >> 8) & 511, b = lat ? row >> 12 : (row - NLAT) >> 8, pos = lat ? 256 + t : (row - NLAT) & 255; const int wv = (hh >> 19) & 1;
            if (wv) { ref = bf2f(z[ZC_U + c]); got = bf2f(((const bf16*)(ws + P_UG))[((size_t)(b * 32 + (c >> 4)) * LPOS + pos) * 16 + (c & 15)]); }
            else { ref = bf2f(z[ZC_VG + (c & 127)]); got = bf2f(((const bf16*)(ws + P_VA))[(size_t)row * 128 + (c & 127)]); } }
        add(ws, k, got, ref, lane); }
}
__device__ __forceinline__ void chk_attn(unsigned char* ws, int k, bool lastl, int gw, int ngw, int lane) {
    for (int s = gw; s < 256; s += ngw) { const unsigned hh = hash(s, 60 + k); const int typ = hh & 1, b = (hh >> 1) & 3, h = (hh >> 3) & 7, d = (hh >> 6) & 63; const bool cq = !lastl && ((hh >> 12) & 7) == 0;
        const int qrow = cq ? NLAT + b * 256 + ((hh >> 16) & 255) : b * 4096 + ((hh >> 16) & 4095); const int nk = cq ? 256 : LPOS, DKK = typ ? 96 : 64;
        const bf16* q = typ ? (const bf16*)(ws + P_QB) + (size_t)qrow * 768 + h * 96 : (const bf16*)(ws + P_QA) + (size_t)qrow * 512 + h * 64;
        float m = -1e30f, l = 0.f, o = 0.f;
        for (int p = lane; p < nk; p += 64) { const int kr = pos_row(b, p); float sc = 0.f;
            if (typ) { const bf16* kk = (const bf16*)(ws + P_KB) + (size_t)kr * 512 + h * 64; const bf16* k2 = (const bf16*)(ws + P_KRR) + (size_t)kr * 32;
                for (int i = 0; i < 64; ++i) sc += bf2f(q[i]) * bf2f(kk[i]); for (int i = 0; i < 32; ++i) sc += bf2f(q[64 + i]) * bf2f(k2[i]); }
            else { const bf16* kk = (const bf16*)(ws + P_KA) + (size_t)kr * 128 + (h >> 2) * 64; for (int i = 0; i < 64; ++i) sc += bf2f(q[i]) * bf2f(kk[i]); }
            const float v = typ ? bf2f(((const bf16*)(ws + P_VB))[(size_t)kr * 512 + h * 64 + d]) : bf2f(((const bf16*)(ws + P_VA))[(size_t)kr * 128 + (h >> 2) * 64 + d]);
            const float mn = fmaxf(m, sc), al = exp2f(m - mn), pp = exp2f(sc - mn); l = l * al + pp; o = o * al + pp * v; m = mn; (void)DKK; }
        float mg = m; for (int x = 1; x < 64; x <<= 1) mg = fmaxf(mg, __shfl_xor(mg, x));
        const float f = exp2f(m - mg); l = wave_sum(l * f); o = wave_sum(o * f);
        add(ws, k, bf2f(((const bf16*)(ws + P_YBR))[(size_t)qrow * 1536 + typ * 512 + h * 64 + d]), o / l, lane); }
}
__device__ __forceinline__ void chk_s5(unsigned char* ws, const float* const* in, int k, int l, bool lastl, int gw, int ngw, int lane) {
    for (int s = gw; s < 512; s += ngw) { const unsigned hh = hash(s, 80 + k); const int b = hh & 3, g = (hh >> 2) & 31, hp = (hh >> 7) & 15; int psel = (hh >> 12) % LPOS; if (lastl && psel < 256) psel += 256;
        const bf16* U = (const bf16*)(ws + P_UG) + (size_t)(b * 32 + g) * LPOS * 16; float yf[2], yl[2];
        for (int dir = 0; dir < 2; ++dir) { const int pi = ((l * 2 + dir) * 32 + g) * 64 + lane;
            const float lr = fminf(in[17][pi], -1e-4f), li = in[18][pi], dt = expf(in[19][(l * 2 + dir) * 32 + g]); const float mag = expf(lr * dt), abr = mag * cosf(li * dt), abi = mag * sinf(li * dt), den = lr * lr + li * li;
            const float fr = ((abr - 1.f) * lr + abi * li) / den, fi = (abi * lr - (abr - 1.f) * li) / den; float bbr[16], bbi[16];
            _Pragma("unroll") for (int h = 0; h < 16; ++h) { const float br = in[20][(size_t)pi * 16 + h], bi = in[21][(size_t)pi * 16 + h]; bbr[h] = fr * br - fi * bi; bbi[h] = fr * bi + fi * br; }
            float xr = 0.f, xi = 0.f, zr = 0.f, zi = 0.f;
            for (int st = 0; st < LPOS; ++st) { const int p = dir == 0 ? st : (st < 256 ? 255 - st : LPOS + 255 - st); float vr = 0.f, vi = 0.f;
                _Pragma("unroll") for (int h = 0; h < 16; ++h) { const float u = bf2f(U[(size_t)p * 16 + h]); vr += bbr[h] * u; vi += bbi[h] * u; }
                if ((dir == 0 && (p & 15) == 0) || (dir == 1 && (p & 15) == 15)) { zr = 0.f; zi = 0.f; }
                const float nr = abr * xr - abi * xi + vr, ni = abr * xi + abi * xr + vi; xr = nr; xi = ni;
                const float mr = abr * zr - abi * zi + vr, mi = abr * zi + abi * zr + vi; zr = mr; zi = mi;
                if (p == psel) break; }
            const size_t ci = ((size_t)((l * 2 + dir) * 32 + g) * 16 + hp) * 64 + lane; yf[dir] = wave_sum(in[22][ci] * xr - in[23][ci] * xi); yl[dir] = wave_sum(in[22][ci] * zr - in[23][ci] * zi); }
        const float du = in[24][(l * 32 + g) * 16 + hp] * bf2f(U[(size_t)psel * 16 + hp]); const float got = bf2f(((const bf16*)(ws + P_AGLU))[(size_t)pos_row(b, psel) * 512 + g * 16 + hp]);
        auto ge = [](float y) { const float u2 = 0.7978845608028654f * (y + 0.044715f * y * y * y); return 0.5f * y * (1.f + tanhf(u2)); };
        add(ws, k, got, ge(du + yf[0] + yf[1]), lane);
        if (l == 0) { add(ws, 30, got, ge(du + yf[0] + yl[1]), lane); add(ws, 31, got, ge(du + yl[0] + yf[1]), lane); add(ws, 32, got, ge(du + yl[0] + yl[1]), lane); add(ws, 33, got, ge(du), lane); } }
}
__device__ __forceinline__ void chk_s5m(unsigned char* ws, const float* const* in, int k, int gw, int ngw, int lane) {
    for (int s = gw; s < 2048; s += ngw) { const unsigned hh = hash(s, 700), h2 = hash(s, 701); const int l = hh & 1, g = (hh >> 1) & 31, which = (hh >> 6) % 5;
        const bf16* M = (const bf16*)(ws + WS_S5M) + (size_t)(l * 32 + g) * 196608; float got = 0.f, ref = 0.f;
        const int t = (h2 >> 0) & 15, hp = (h2 >> 4) & 15, sx = (h2 >> 8) & 15, h = (h2 >> 12) & 15, p2 = (h2 >> 16) & 63, im = (h2 >> 22) & 1, dsel = (h2 >> 23) & 1;
        float cre[2], cim[2], are[2], aim[2], bre[2], bim[2], lrr[2], lii[2], dtt[2];
        _Pragma("unroll") for (int dir = 0; dir < 2; ++dir) { const int pi = ((l * 2 + dir) * 32 + g) * 64 + lane; lrr[dir] = fminf(in[17][pi], -1e-4f); lii[dir] = in[18][pi]; dtt[dir] = expf(in[19][(l * 2 + dir) * 32 + g]);
            const float mag = expf(lrr[dir] * dtt[dir]); are[dir] = mag * cosf(lii[dir] * dtt[dir]); aim[dir] = mag * sinf(lii[dir] * dtt[dir]);
            const float den = lrr[dir] * lrr[dir] + lii[dir] * lii[dir], fr = ((are[dir] - 1.f) * lrr[dir] + aim[dir] * lii[dir]) / den, fi = (aim[dir] * lrr[dir] - (are[dir] - 1.f) * lii[dir]) / den;
            const float br = in[20][(size_t)pi * 16 + h], bi = in[21][(size_t)pi * 16 + h]; bre[dir] = fr * br - fi * bi; bim[dir] = fr * bi + fi * br;
            const size_t ci = ((size_t)((l * 2 + dir) * 32 + g) * 16 + hp) * 64 + lane; cre[dir] = in[22][ci]; cim[dir] = in[23][ci]; }
        if (which == 0) {
            float acc = 0.f;
            _Pragma("unroll") for (int dir = 0; dir < 2; ++dir) { const int j = dir == 0 ? t - sx : sx - t; if (j >= 0) { float pr = 1.f, pq = 0.f; for (int e = 0; e < j; ++e) { const float nr = pr * are[dir] - pq * aim[dir], nq = pr * aim[dir] + pq * are[dir]; pr = nr; pq = nq; }
                    const float tr = cre[dir] * pr - cim[dir] * pq, tq = cre[dir] * pq + cim[dir] * pr; acc += tr * bre[dir] - tq * bim[dir]; } }
            ref = wave_sum(acc) + ((t == sx && h == hp) ? in[24][(l * 32 + g) * 16 + h] : 0.f); got = bf2f(M[(size_t)(16 * t + hp) * 256 + 16 * sx + h]); }
        else if (which <= 2) {
            const int dir = which - 1, ex = dir == 0 ? t + 1 : 16 - t; float pr = 1.f, pq = 0.f; for (int e = 0; e < ex; ++e) { const float nr = pr * are[dir] - pq * aim[dir], nq = pr * aim[dir] + pq * are[dir]; pr = nr; pq = nq; }
            const float tr = cre[dir] * pr - cim[dir] * pq, tq = cre[dir] * pq + cim[dir] * pr; const float mine = im ? -tq : tr; ref = __shfl(mine, p2); got = bf2f(M[(dir == 0 ? 65536 : 98304) + (size_t)(16 * t + hp) * 128 + 2 * p2 + im]); }
        else {
            const int dir = which - 3, ex = dir == 0 ? 15 - sx : sx; float pr = 1.f, pq = 0.f; for (int e = 0; e < ex; ++e) { const float nr = pr * are[dir] - pq * aim[dir], nq = pr * aim[dir] + pq * are[dir]; pr = nr; pq = nq; }
            const float tr = pr * bre[dir] - pq * bim[dir], tq = pr * bim[dir] + pq * bre[dir]; const float mine = im ? tq : tr; ref = __shfl(mine, p2); got = bf2f(M[(dir == 0 ? 131072 : 163840) + (size_t)(2 * p2 + im) * 256 + 16 * sx + h]); }
        (void)dsel; add(ws, which == 0 ? ((t == sx && h == hp) ? k : 35) : which <= 2 ? 36 : 37, got, ref, lane); }
}

__device__ __forceinline__ void chk_s5x(unsigned char* ws, const float* const* in, int gw, int ngw, int lane) {
    const int l = 0, b = 0;
    for (int s = gw; s < 512; s += ngw) { const unsigned hh = hash(s, 900); const int g = hh & 15, dir = (hh >> 5) & 1, c = (hh >> 8) % 272, im = (hh >> 20) & 1, psel = (hh >> 24) & 63;
        const bf16* U = (const bf16*)(ws + P_UG) + (size_t)(b * 32 + g) * LPOS * 16; const int pi = ((l * 2 + dir) * 32 + g) * 64 + lane;
        const float lr = fminf(in[17][pi], -1e-4f), li = in[18][pi], dt = expf(in[19][(l * 2 + dir) * 32 + g]); const float mag = expf(lr * dt), abr = mag * cosf(li * dt), abi = mag * sinf(li * dt), den = lr * lr + li * li;
        const float fr = ((abr - 1.f) * lr + abi * li) / den, fi = (abi * lr - (abr - 1.f) * li) / den; float bbr[16], bbi[16];
        _Pragma("unroll") for (int h = 0; h < 16; ++h) { const float br = in[20][(size_t)pi * 16 + h], bi = in[21][(size_t)pi * 16 + h]; bbr[h] = fr * br - fi * bi; bbi[h] = fr * bi + fi * br; }
        float xr = 0.f, xi = 0.f;
        for (int st = 0; st < LPOS; ++st) { const int p = dir == 0 ? st : (st < 256 ? 255 - st : LPOS + 255 - st);
            if ((p >> 4) == c) break;
            float vr = 0.f, vi = 0.f;
            _Pragma("unroll") for (int h = 0; h < 16; ++h) { const float u = bf2f(U[(size_t)p * 16 + h]); vr += bbr[h] * u; vi += bbi[h] * u; }
            const float nr = abr * xr - abi * xi + vr, ni = abr * xi + abi * xr + vi; xr = nr; xi = ni; }
        const float mine = im ? xi : xr; const float ref = __shfl(mine, psel);
        {
          float er = 0.f, ei = 0.f;
          for (int q = 0; q < 16; ++q) { const int sx = dir == 0 ? q : 15 - q, p = 16 * c + sx; float vr = 0.f, vi = 0.f;
              _Pragma("unroll") for (int h = 0; h < 16; ++h) { const float u = bf2f(U[(size_t)p * 16 + h]); vr += bbr[h] * u; vi += bbi[h] * u; }
              const float nr = abr * er - abi * ei + vr, ni = abr * ei + abi * er + vi; er = nr; ei = ni; }
          const float m2 = im ? ei : er; const float r2 = __shfl(m2, psel);
          const bf16* E = (const bf16*)(ws + WS_POOL + 98 * MiB) + (size_t)g * 69632 + (size_t)dir * 34816;
          add(ws, 39, bf2f(E[c * 128 + 2 * psel + im]), r2, lane); }
        const bf16* X = (const bf16*)(ws + WS_POOL + 94 * MiB) + (size_t)g * 69632 + (size_t)dir * 34816;
        add(ws, 38, bf2f(X[c * 128 + 2 * psel + im]), ref, lane); }
}
__device__ __forceinline__ void encode(unsigned char* ws, const float* x, float* outp, int nchk, int gt, int ngt) {
    const float* d = (const float*)(ws + WS_CTL) + CW_DBG; int bad = -1; float eb = 0.f;
#ifdef DBG_REPORT
    { const int k = DBG_REPORT; const float e = sqrtf(d[2 * k] / fmaxf(d[2 * k + 1], 1e-30f)); const float F = 1.f + 1e14f * fminf(e * e, 1e4f) + 1e3f;
      for (size_t i = gt; i < (size_t)NLAT * 1024; i += ngt) outp[i] = x[i] * F; return; }
#endif
    for (int k = 0; k < 30; ++k) { const float e = sqrtf(d[2 * k] / fmaxf(d[2 * k + 1], 1e-30f)); const bool unused = d[2 * k + 1] == 0.f && d[2 * k] == 0.f; if (!unused && !(e < 0.02f)) { bad = k; eb = e; break; } }
    if (bad < 0) return;
    float F = 1.f; for (int i = 0; i <= bad; ++i) F *= 4.f; F = 1.f + F * (1.f + fminf(eb, 0.99f));
    for (size_t i = gt; i < (size_t)NLAT * 1024; i += ngt) outp[i] = x[i] * F;
}
}
struct Args;
#endif

struct Args { const float* in[38]; float* out; unsigned char* ws; int ph_lo, ph_hi; };
constexpr int PH_PRO = 0, PH_R0 = 1, PH_L0 = 2, PH_PER_L = 16, NPH = PH_L0 + 2 * PH_PER_L;


#if MK_DEBUG
constexpr int DBG_NCHK = 40;
__global__ void __launch_bounds__(NTHREADS, 2) dbg_fwd(Args args, int ph) {
    unsigned char* ws = args.ws; float* outp = args.out; const float* const* in = args.in;
    const int tid = threadIdx.x, lane = tid & 63, wave = tid >> 6, gw = blockIdx.x * NWAVES + wave, ngw = gridDim.x * NWAVES;
    const float* par = (const float*)(ws + WS_PAR);
    if (ph == 1000) { dbg::encode(ws, in[0], outp, DBG_NCHK, blockIdx.x * NTHREADS + tid, gridDim.x * NTHREADS); return; }
    if (ph == PH_PRO) { dbg::chk_mod(ws, in, gw, ngw, lane); dbg::chk_weights(ws, in, gw, ngw, lane); dbg::chk_s5m(ws, in, 16, gw, ngw, lane); return; }
    if (ph == PH_R0) { dbg::chk_h(ws, in, outp, 2, 0, 0, par + PR_GMIXPRE, MALL, gw, ngw, lane); return; }
    const int l = (ph - PH_L0) / PH_PER_L, rel = (ph - PH_L0) % PH_PER_L, kb = 3 + 14 * l; const bool lastl = l == 1; const int nrq = lastl ? NLAT : MALL;
    if (rel == 0) { const bf16* Z = (const bf16*)(ws + P_Z);
        dbg::chk_gemm(ws, kb + 0, (const bf16*)(ws + P_H), 1024, in[10] + (size_t)l * 1024 * NIN, NIN, 1024, MALL, NIN, [=](int row, int col, float ref, float& got, float& rr) {
            const int j = col, dr = j < 512 ? j : j < 896 ? 768 + (j - 512) : j < 1024 ? 512 + (j - 896) : j < 1152 ? 640 + (j - 1024) : j < 1440 ? j : 1536 + (j - 1440); got = bf2f(Z[(size_t)row * ZW + dr]); rr = ref; }, gw, ngw, lane); }
    if (rel == 1) dbg::chk_tok(ws, kb + 1, l, gw, ngw, lane);
    if (rel == 2) {
        const bf16* QB = (const bf16*)(ws + P_QB); const bf16* CQ = (const bf16*)(ws + P_CQN); const float* Wq = in[15] + (size_t)l * 384 * 768; const float scale = 0.10206207261596575f * LOG2E;
        dbg::chk_gemm(ws, kb + 2, CQ, 384, Wq, 768, 384, nrq, 768, [=](int row, int col, float ref, float& got, float& rr) {
            const int hd = col / 96, e = col % 96; float v = ref;
            if (e >= 64 && row < NLAT) { const int i = (e - 64) & 15; const float x1 = dbg::dot_aw(CQ + (size_t)row * 384, Wq + hd * 96 + 64 + i, 768, 384, lane), x2 = dbg::dot_aw(CQ + (size_t)row * 384, Wq + hd * 96 + 80 + i, 768, 384, lane);
                const float an = dbg::angB(row & 4095, i), c = cosf(an), sn = sinf(an); v = e < 80 ? x1 * c - x2 * sn : x1 * sn + x2 * c; }
            got = bf2f(QB[(size_t)row * 768 + col]); rr = v * scale; }, gw, ngw, lane);
        const bf16* KB = (const bf16*)(ws + P_KB); const bf16* VB = (const bf16*)(ws + P_VB);
        dbg::chk_gemm(ws, kb + 3, (const bf16*)(ws + P_CKVN), 256, in[16] + (size_t)l * 256 * 1024, 1024, 256, MALL, 1024, [=](int row, int col, float ref, float& got, float& rr) {
            const int hd = col / 128, e = col % 128; got = e < 64 ? bf2f(KB[(size_t)row * 512 + hd * 64 + e]) : bf2f(VB[(size_t)row * 512 + hd * 64 + e - 64]); rr = ref; }, gw, ngw, lane); }
    if (rel == 3) { dbg::chk_attn(ws, kb + 4, lastl, gw, ngw, lane); dbg::chk_s5(ws, in, kb + 5, l, lastl, gw, ngw, lane); if (l == 0) dbg::chk_s5x(ws, in, gw, ngw, lane); }
    if (rel == 4) { const bf16* AG = (const bf16*)(ws + P_AGLU); const bf16* YB = (const bf16*)(ws + P_YBR); const float* Wg = in[25] + (size_t)l * 512 * 1024;
        dbg::chk_gemm(ws, kb + 6, AG, 512, Wg, 1024, 512, nrq, 512, [=](int row, int col, float ref, float& got, float& rr) {
            const float g = dbg::dot_aw(AG + (size_t)row * 512, Wg + 512 + col, 1024, 512, lane); got = bf2f(YB[(size_t)row * 1536 + 1024 + col]); rr = ref / (1.f + expf(-g)); }, gw, ngw, lane); }
    if (rel == 5) { const bf16* H = (const bf16*)(ws + P_H); const bf16* YB = (const bf16*)(ws + P_YBR); const bf16* MG = (const bf16*)(ws + P_MRG);
        const float* Wm = in[27] + (size_t)l * 1024 * 3072; const float* Wb = in[26] + (size_t)l * 3 * 512 * 1024; const float* bm = in[28] + l * 3072;
        for (int s = gw; s < 512; s += ngw) { const unsigned hh = dbg::hash(s, 333 + l); const int row = hh % nrq, col = (hh >> 16) % 1024; float acc = 0.f;
            for (int n = 0; n < 3; ++n) { const float g = dbg::dot_aw(H + (size_t)row * 1024, Wm + n * 1024 + col, 3072, 1024, lane) + bm[n * 1024 + col];
                const float p = dbg::dot_aw(YB + (size_t)row * 1536 + n * 512, Wb + (size_t)n * 512 * 1024 + col, 1024, 512, lane); acc += p / (1.f + expf(-g)); }
            dbg::add(ws, kb + 7, bf2f(MG[(size_t)row * 1024 + col]), acc, lane); } }
    if (rel == 6) { const float* Y = (const float*)(ws + P_Y);
        dbg::chk_gemm(ws, kb + 8, (const bf16*)(ws + P_MRG), 1024, in[29] + (size_t)l * 1024 * 1024, 1024, 1024, nrq, 1024, [=](int row, int col, float ref, float& got, float& rr) { got = Y[(size_t)row * 1024 + col]; rr = ref; }, gw, ngw, lane); }
    if (rel == 7) dbg::chk_h(ws, in, outp, kb + 9, l, 3, par + PR_GFFNPRE + l * 1024, nrq, gw, ngw, lane);
    if (!lastl) {
        if (rel == 8) { const bf16* H = (const bf16*)(ws + P_H); const bf16* ACT = (const bf16*)(ws + P_ACT);
            dbg::chk_gemm(ws, kb + 10, H, 1024, in[30], DFF, 1024, MALL, DFF, [=](int row, int col, float ref, float& got, float& rr) {
                const float b = dbg::dot_aw(H + (size_t)row * 1024, in[31] + col, DFF, 1024, lane); got = bf2f(ACT[(size_t)row * DFF + col]); rr = ref / (1.f + expf(-ref)) * b; }, gw, ngw, lane); }
        if (rel == 9) { const float* Y2 = (const float*)(ws + P_Y2);
            dbg::chk_gemm(ws, kb + 11, (const bf16*)(ws + P_ACT), DFF, in[32], 1024, DFF, MALL, 1024, [=](int row, int col, float ref, float& got, float& rr) { got = Y2[(size_t)row * 1024 + col]; rr = ref; }, gw, ngw, lane); }
        if (rel == 12) dbg::chk_h(ws, in, outp, kb + 12, 1, 0, par + PR_GMIXPRE + 1024, MALL, gw, ngw, lane);
    } else if (rel == 11) {
        const bf16* H = (const bf16*)(ws + P_H); const bf16* FO = (const bf16*)(ws + P_Y2); const unsigned* cnt = (const unsigned*)(ws + WS_CTL) + CW_CNT; const int* ti = (const int*)(ws + WS_LIST) + 8 * 16384;
        for (int s = gw; s < 64; s += ngw) { const unsigned hh = dbg::hash(s, 555); const int tok = hh % NLAT, kk = (hh >> 16) & 1, c = (hh >> 17) % 1024; const int e = ti[tok * 8 + 2 * kk], pos = ti[tok * 8 + 2 * kk + 1];
            int base = 0; for (int q = 0; q < e; ++q) base += ((int)cnt[q] + 255) >> 8;
            float acc = 0.f;
            for (int j = 0; j < DFF; ++j) { const float a = dbg::dot_aw(H + (size_t)tok * 1024, in[35] + (size_t)e * 1024 * DFF + j, DFF, 1024, lane), b = dbg::dot_aw(H + (size_t)tok * 1024, in[36] + (size_t)e * 1024 * DFF + j, DFF, 1024, lane);
                acc += dbg::rbf(a / (1.f + expf(-a)) * b) * dbg::rbf(in[37][((size_t)e * DFF + j) * 1024 + c]); }
            dbg::add(ws, kb + 10, bf2f(FO[((size_t)base * 256 + pos) * 1024 + c]), acc, lane); } }
}
#endif

#ifndef PHMASK
#define PHMASK 0xFFFFFFFFu
#endif
#define PHON(k) (((PHMASK) >> (k)) & 1u)
#ifndef REPMASK
#define REPMASK 0u
#endif
#define REPON(k) (((REPMASK) >> (k)) & 1u)

__device__ __forceinline__ ResidArgs Rd(ResidArgs R, int rep) { R.dry = rep > 0; return R; }
__global__ void __launch_bounds__(NTHREADS, 2) mk_fwd(Args args) {
    extern __shared__ __attribute__((aligned(16))) unsigned char lds_raw[];
    LAS unsigned char* lds = (LAS unsigned char*)lds_raw;
    const int wave = __builtin_amdgcn_readfirstlane((int)threadIdx.x >> 6);
#define tid (wave * 64 + lane_id())
    const int G = gridDim.x, bx = blockIdx.x; const int vcu = (G % 8 == 0) ? (bx % 8) * (G / 8) + bx / 8 : bx;
    unsigned char* ws0 = args.ws; float* outp = args.out;
    unsigned char* ws = ws0;
    volatile LAS unsigned* misc = (volatile LAS unsigned*)(lds + LDS_MISC);
    LAS int* tb; { unsigned tba_ = (unsigned)(uintptr_t)(lds + LDS_MISC + 64); asm volatile("" : "+s"(tba_)); tb = (LAS int*)(uintptr_t)tba_; }
    if (tid < 64) misc[tid] = 0u;
    __syncthreads();
    const int lo = args.ph_lo, hi = args.ph_hi;
    XcdBarrier bar; bar.bar = (unsigned*)(ws + WS_CTL) + CW_BAR; bar.x = 0; bar.st = misc; bar.wave = wave;
    if (hi - lo > 1) bar = xcd_barrier_post((unsigned*)(ws + WS_CTL) + CW_BAR, misc, wave);
#define IN(k) (lo <= (k) && (k) < hi)
#define SEAM(k) do { if ((k) + 1 < hi) xcd_barrier(bar); } while (0)
    const int gw = vcu * NWAVES + wave, ngw = G * NWAVES;

    if (PHON(0) && IN(PH_PRO)) for (int rep_ = 0; rep_ <= (int)REPON(0); ++rep_) {
            GAS unsigned char* wsq = (GAS unsigned char*)ws0; asm volatile("" : "+s"(wsq)); unsigned char* const ws = (unsigned char*)wsq; const float* const par = (const float*)(ws + WS_PAR); int lnq = lane_id(); asm volatile("" : "+v"(lnq)); const int lane = lnq; (void)par; (void)lane;
        Ptrs P;
        { const float* const* in = args.in;
          P.x = in[0]; P.c = in[1]; P.ctx = in[2]; P.c_ctx = in[3]; P.w_mod = in[4]; P.b_mod = in[5]; P.g_mix_pre = in[6]; P.g_mix_post = in[7]; P.g_ffn_pre = in[8]; P.g_ffn_post = in[9];
          P.w_in = in[10]; P.g_q = in[11]; P.g_k = in[12]; P.g_cq = in[13]; P.g_ckv = in[14]; P.w_uq = in[15]; P.w_ukv = in[16];
          P.s5p.lam_re = in[17]; P.s5p.lam_im = in[18]; P.s5p.log_dt = in[19]; P.s5p.b_re = in[20]; P.s5p.b_im = in[21]; P.s5p.c_re = in[22]; P.s5p.c_im = in[23]; P.s5p.dsk = in[24];
          P.w_glu = in[25]; P.w_branch = in[26]; P.w_mg = in[27]; P.b_mg = in[28]; P.w_out = in[29]; P.ffn_w1 = in[30]; P.ffn_w3 = in[31]; P.ffn_w2 = in[32];
          P.router_w = in[33]; P.router_b = in[34]; P.moe_w1 = in[35]; P.moe_w3 = in[36]; P.moe_w2 = in[37]; P.out = args.out; P.ws = args.ws; }
#ifndef PRO_ONLYT
#define PRO_ONLYT 0
#endif
        if (!(PRO_ONLYT && rep_ > 0)) {
        copy_params(P, bx * NTHREADS + tid, G * NTHREADS);
        for (int it = bx; it < 192 + 64; it += G) {
            if (it < 192) mod_item(P, it, lds, wave);
#ifndef PRO_SKIPB
#define PRO_SKIPB 0
#endif
            else if (!(PRO_SKIPB && rep_ > 0)) { const int q = it - 192, l = q >> 5, g = q & 31; s5::build_mats(P.s5p, l, g, (bf16*)(ws + WS_S5M) + (size_t)(l * 32 + g) * s5::M_TOTAL, lds, wave); }
        }
        rope_tables(P, bx * NTHREADS + tid, G * NTHREADS);
        }
        __syncthreads();
#ifndef PRO_NOT
#define PRO_NOT 0
#endif
        if (!(PRO_NOT && rep_ > 0)) transposes(P, gw, ngw, (LAS float*)(lds + wave * 16384), lane, rep_);
        SEAM(PH_PRO);
    }
    if (PHON(1) && IN(PH_R0)) for (int rep_ = 0; rep_ <= (int)REPON(1); ++rep_) {
            GAS unsigned char* wsq = (GAS unsigned char*)ws0; asm volatile("" : "+s"(wsq)); unsigned char* const ws = (unsigned char*)wsq; const float* const par = (const float*)(ws + WS_PAR); int lnq = lane_id(); asm volatile("" : "+v"(lnq)); const int lane = lnq; (void)par; (void)lane;
        ResidArgs R{}; R.mode = 0; R.g_pre = par + PR_GMIXPRE; R.shift_chunk = 0; R.hout = (bf16*)(ws + P_H); R.l_mod = 0; R.route = false; R.hout8 = ws + P_H8;
        const float* xin = args.in[0]; const float* ctxin = args.in[2];
        { int row = gw; for (; row + ngw < MALL; row += 2 * ngw) { resid_row(ws, outp, xin, ctxin, Rd(R, rep_), row, lane, tb); resid_row(ws, outp, xin, ctxin, Rd(R, rep_), row + ngw, lane, tb); } if (row < MALL) resid_row(ws, outp, xin, ctxin, Rd(R, rep_), row, lane, tb); }
        SEAM(PH_R0);
    }
#ifndef MOEREP
#define MOEREP 1
#endif
#define MOE_TAIL(lo_pm, hi_pm) do { if (l == 0 && bx >= 16) { const int lane_ = lane_id(); for (int mr_ = 0; mr_ < MOEREP; ++mr_) \
            moe_transposes(args.in[35], args.in[36], args.in[37], ws, (int)((long)MOE_ITEMS * (lo_pm) / 1000), (int)((long)MOE_ITEMS * (hi_pm) / 1000), (bx - 16) * NWAVES + wave, (G - 16) * NWAVES, (LAS float*)(lds + wave * 16384), lane_); } } while (0)
    for (int l = 0; l < 2; ++l) {
        const int pb = PH_L0 + l * PH_PER_L; const bool lastl = (l == 1);
        const int nMall = 68, nMq = lastl ? 64 : 68;
        if (PHON(2) && IN(pb + 0)) for (int rep_ = 0; rep_ <= (int)REPON(2); ++rep_) {
            GAS unsigned char* wsq = (GAS unsigned char*)ws0; asm volatile("" : "+s"(wsq)); unsigned char* const ws = (unsigned char*)wsq; const float* const par = (const float*)(ws + WS_PAR); int lnq = lane_id(); asm volatile("" : "+v"(lnq)); const int lane = lnq; (void)par; (void)lane;
            if (F8_G1L1 && lastl) {
                pg8::SchedPlain S{(const char*)(ws + P_H8), (const char*)(ws + WS_W1T) + (size_t)l * ZW * 2048, 1024u, 1024u, 8, nMall, 8, G, bx};
                pg8::EpiBf16S E{(bf16*)(ws + P_Z), ZW, 1.0f / (F8_HSCALE * F8_WSCALE)};
                pg8::gemm_phase<pg8::EpiBf16S, pg8::SchedPlain, false, true>(lds, S, E, wave);
            } else {
            pg8::SchedPlain S{(const char*)(ws + P_H), (const char*)(ws + WS_W1T) + (size_t)l * ZW * 2048, 2048u, 2048u, 16, nMall, 8, G, bx};
            pg8::EpiBf16 E{(bf16*)(ws + P_Z), ZW, 0};
            pg8::gemm_phase<pg8::EpiBf16, pg8::SchedPlain, false>(lds, S, E, wave); }
            SEAM(pb + 0);
        }
        if (PHON(3) && IN(pb + 1)) for (int rep_ = 0; rep_ <= (int)REPON(3); ++rep_) {
            GAS unsigned char* wsq = (GAS unsigned char*)ws0; asm volatile("" : "+s"(wsq)); unsigned char* const ws = (unsigned char*)wsq; const float* const par = (const float*)(ws + WS_PAR); int lnq = lane_id(); asm volatile("" : "+v"(lnq)); const int lane = lnq; (void)par; (void)lane;
            { int row = gw; for (; row + ngw < MALL; row += 2 * ngw) { token_row(ws, l, row, lane); token_row(ws, l, row + ngw, lane); } if (row < MALL) token_row(ws, l, row, lane); }
            SEAM(pb + 1);
        }
        if (PHON(4) && IN(pb + 2)) for (int rep_ = 0; rep_ <= (int)REPON(4); ++rep_) {
            GAS unsigned char* wsq = (GAS unsigned char*)ws0; asm volatile("" : "+s"(wsq)); unsigned char* const ws = (unsigned char*)wsq; const float* const par = (const float*)(ws + WS_PAR); int lnq = lane_id(); asm volatile("" : "+v"(lnq)); const int lane = lnq; (void)par; (void)lane;
            { pg8::SchedUp S{(const char*)(ws + P_CQN), (const char*)(ws + WS_WUQT) + (size_t)l * 768 * 768, (const char*)(ws + P_CKVN), (const char*)(ws + WS_WUKVT) + (size_t)l * 1024 * 512, nMq, nMall, G, bx};
              pg8::EpiUp E{pg8::EpiUq{(bf16*)(ws + P_QB), (const float*)(ws + WS_ROPE) + 2 * 4096 * 32, (const float*)(ws + WS_ROPE) + 2 * 4096 * 32 + 4096 * 16, 0.10206207261596575f * LOG2E}, pg8::EpiUkv{(bf16*)(ws + P_KB), (bf16*)(ws + P_VB)}};
              pg8::gemm_phase<pg8::EpiUp, pg8::SchedUp, false>(lds, S, E, wave); }
            SEAM(pb + 2);
        }
        if (PHON(5) && IN(pb + 3)) for (int rep_ = 0; rep_ <= (int)REPON(5); ++rep_) {
            GAS unsigned char* wsq = (GAS unsigned char*)ws0; asm volatile("" : "+s"(wsq)); unsigned char* const ws = (unsigned char*)wsq; const float* const par = (const float*)(ws + WS_PAR); int lnq = lane_id(); asm volatile("" : "+v"(lnq)); const int lane = lnq; (void)par; (void)lane;
            const int nlatu = 1024, nctxu = lastl ? 0 : 64;
            for (int it = vcu; it < nlatu + nctxu; it += G) {
                att::AttnArgs A; int typ, b, h;
                if (it < nlatu) { const int u = it >> 1; typ = (it ^ (it >> 8)) & 1;
                    b = u >> 7; h = (u >> 4) & 7; const int qb = u & 15; A.qrow0 = (long)b * SEQ + qb * 256; A.ntiles = 68; }
                else { const int u = it - nlatu; typ = u & 1; b = (u >> 1) >> 3; h = (u >> 1) & 7; A.qrow0 = NLAT + (long)b * CTXL; A.ntiles = 4; }
                A.b = b; A.O = (bf16*)(ws + P_YBR); A.opitch = 1536;
                if (typ == 0) { A.Q = (const bf16*)(ws + P_QA); A.qpitch = 512; A.qcol = h * 64; A.K1 = (const bf16*)(ws + P_KA); A.k1pitch = 128; A.k1col = (h >> 2) * 64; A.K2 = nullptr; A.k2pitch = 0;
                    A.V = (const bf16*)(ws + P_VA); A.vpitch = 128; A.vcol = (h >> 2) * 64; A.ocol = h * 64; att::attn_unit4<64>(A, lds, wave); }
                else { A.Q = (const bf16*)(ws + P_QB); A.qpitch = 768; A.qcol = h * 96; A.K1 = (const bf16*)(ws + P_KB); A.k1pitch = 512; A.k1col = h * 64; A.K2 = (const bf16*)(ws + P_KRR); A.k2pitch = 32;
                    A.V = (const bf16*)(ws + P_VB); A.vpitch = 512; A.vcol = h * 64; A.ocol = 512 + h * 64; att::attn_unit4<96>(A, lds, wave); }
            }
            __syncthreads();
#ifndef S5REP
#define S5REP 1
#endif
            for (int s5r_ = 0; s5r_ < S5REP; ++s5r_)
            for (int it = G - 1 - vcu; it < 256; it += G) { const int b = it >> 6, g = (it >> 1) & 31, half = it & 1;
                s5::unit(par + PR_A16, l, b, g, (const bf16*)(ws + P_UG), (const bf16*)(ws + WS_S5M) + (size_t)(l * 32 + g) * s5::M_TOTAL, (bf16*)(ws + P_AGLU), lastl, lds, wave, half); }
            SEAM(pb + 3);
        }
        if (PHON(6) && IN(pb + 4)) for (int rep_ = 0; rep_ <= (int)REPON(6); ++rep_) {
            GAS unsigned char* wsq = (GAS unsigned char*)ws0; asm volatile("" : "+s"(wsq)); unsigned char* const ws = (unsigned char*)wsq; const float* const par = (const float*)(ws + WS_PAR); int lnq = lane_id(); asm volatile("" : "+v"(lnq)); const int lane = lnq; (void)par; (void)lane;
            pg8::SchedPlain S{(const char*)(ws + P_AGLU), (const char*)(ws + WS_WGLUT) + (size_t)l * 1024 * 1024, 1024u, 1024u, 8, nMq, 4, G, bx};
            pg8::EpiPair<0> E{(bf16*)(ws + P_YBR), 1536, 1024, 0};
            pg8::gemm_phase<pg8::EpiPair<0>, pg8::SchedPlain, false>(lds, S, E, wave);
            SEAM(pb + 4);
        }
        if (PHON(7) && IN(pb + 5)) for (int rep_ = 0; rep_ <= (int)REPON(7); ++rep_) {
            GAS unsigned char* wsq = (GAS unsigned char*)ws0; asm volatile("" : "+s"(wsq)); unsigned char* const ws = (unsigned char*)wsq; const float* const par = (const float*)(ws + WS_PAR); int lnq = lane_id(); asm volatile("" : "+v"(lnq)); const int lane = lnq; (void)par; (void)lane;
#define MRG_ROUND(r) do { \
                { pg8::SchedMergeG S{(const char*)(ws + P_H8), (const char*)(ws + WS_WMGT) + (size_t)l * 3072 * 1024, 1024u, 1024u, 8, nMq, (r) * G + bx}; \
                  pg8::EpiGate E{par + PR_BMG + l * 3072, (u32x4*)(ws + P_GSCR + (size_t)bx * 3 * 131072), 1.0f / (F8_HSCALE * F8_WSCALE)}; \
                  pg8::gemm_phase<pg8::EpiGate, pg8::SchedMergeG, false, true>(lds, S, E, wave); } \
                { pg8::SchedMergeP S{(const char*)(ws + P_YBR), (const char*)(ws + WS_WBT) + (size_t)l * 3 * 1024 * 1024, 3072u, 1024u, 8, nMq, (r) * G + bx}; \
                  pg8::EpiMergeP E{(bf16*)(ws + P_MRG), (const u32x4*)(ws + P_GSCR + (size_t)bx * 3 * 131072)}; \
                  pg8::gemm_phase<pg8::EpiMergeP, pg8::SchedMergeP, false, false>(lds, S, E, wave); } } while (0)
            MRG_ROUND(0);
            if (G < nMq * 4) MRG_ROUND(1);
#undef MRG_ROUND
            MOE_TAIL(0, 480);
            SEAM(pb + 5);
        }
        if (PHON(8) && IN(pb + 6)) for (int rep_ = 0; rep_ <= (int)REPON(8); ++rep_) {
            GAS unsigned char* wsq = (GAS unsigned char*)ws0; asm volatile("" : "+s"(wsq)); unsigned char* const ws = (unsigned char*)wsq; const float* const par = (const float*)(ws + WS_PAR); int lnq = lane_id(); asm volatile("" : "+v"(lnq)); const int lane = lnq; (void)par; (void)lane;
            pg8::SchedPlain S{(const char*)(ws + P_MRG), (const char*)(ws + WS_WOUTT) + (size_t)l * 1024 * 2048, 2048u, 2048u, 16, nMq, 4, G, bx};
            pg8::EpiBf16 E{(bf16*)(ws + P_Y), 1024, 0};
            pg8::gemm_phase<pg8::EpiBf16, pg8::SchedPlain, false>(lds, S, E, wave);
            MOE_TAIL(480, 620);
            SEAM(pb + 6);
        }
        if (PHON(9) && IN(pb + 7)) for (int rep_ = 0; rep_ <= (int)REPON(9); ++rep_) {
            GAS unsigned char* wsq = (GAS unsigned char*)ws0; asm volatile("" : "+s"(wsq)); unsigned char* const ws = (unsigned char*)wsq; const float* const par = (const float*)(ws + WS_PAR); int lnq = lane_id(); asm volatile("" : "+v"(lnq)); const int lane = lnq; (void)par; (void)lane;
            ResidArgs R{}; R.mode = 3; R.y = (const float*)(ws + P_Y); R.g_post = par + PR_GMIXPOST + l * 1024; R.gate_chunk = 2; R.g_pre = par + PR_GFFNPRE + l * 1024; R.shift_chunk = 3;
            R.hout = (bf16*)(ws + P_H); R.l_mod = l; R.l_gate = l; R.route = lastl; R.h8 = lastl ? (F8_M1 != 0) : (F8_D1 != 0); R.ysc = 1.0f;
            { int row = gw; for (; row + ngw < nMq * 256; row += 2 * ngw) { resid_row(ws, outp, nullptr, nullptr, Rd(R, rep_), row, lane, tb); resid_row(ws, outp, nullptr, nullptr, Rd(R, rep_), row + ngw, lane, tb); } if (row < nMq * 256) resid_row(ws, outp, nullptr, nullptr, Rd(R, rep_), row, lane, tb); }
            SEAM(pb + 7);
        }
        if (!lastl) {
            if (PHON(10) && IN(pb + 8)) for (int rep_ = 0; rep_ <= (int)REPON(10); ++rep_) {
            GAS unsigned char* wsq = (GAS unsigned char*)ws0; asm volatile("" : "+s"(wsq)); unsigned char* const ws = (unsigned char*)wsq; const float* const par = (const float*)(ws + WS_PAR); int lnq = lane_id(); asm volatile("" : "+v"(lnq)); const int lane = lnq; (void)par; (void)lane;
                constexpr unsigned kb1 = F8_D1 ? 1024u : 2048u;
                pg8::SchedPlain S{(const char*)(ws + P_H), (const char*)(ws + WS_WF1T), kb1, kb1, F8_D1 ? 8 : 16, nMall, 22, G, bx};
                pg8::EpiPairS<F8_D2 != 0> E{ws + P_ACT, DFF, 0, F8_D1 ? 1.0f / (F8_HSCALE * F8_WSCALE) : 1.0f, F8_D2 ? F8_ASCALE : 1.0f};
                pg8::gemm_phase<pg8::EpiPairS<F8_D2 != 0>, pg8::SchedPlain, false, F8_D1 != 0>(lds, S, E, wave);
                SEAM(pb + 8);
            }
            if (PHON(11) && IN(pb + 9)) for (int rep_ = 0; rep_ <= (int)REPON(11); ++rep_) {
            GAS unsigned char* wsq = (GAS unsigned char*)ws0; asm volatile("" : "+s"(wsq)); unsigned char* const ws = (unsigned char*)wsq; const float* const par = (const float*)(ws + WS_PAR); int lnq = lane_id(); asm volatile("" : "+v"(lnq)); const int lane = lnq; (void)par; (void)lane;
                constexpr unsigned kb2 = F8_D2 ? 2816u : 5632u;
                pg8::SchedPlain S{(const char*)(ws + P_ACT), (const char*)(ws + WS_WF2T), kb2, kb2, F8_D2 ? 22 : 44, nMall, 4, G, bx};
                pg8::EpiBf16 E{(bf16*)(ws + P_Y2), 1024, 0};
                pg8::gemm_phase<pg8::EpiBf16, pg8::SchedPlain, false, F8_D2 != 0>(lds, S, E, wave);
                MOE_TAIL(620, 1000);
                SEAM(pb + 9);
            }
            if (PHON(14) && IN(pb + 12)) for (int rep_ = 0; rep_ <= (int)REPON(14); ++rep_) {
            GAS unsigned char* wsq = (GAS unsigned char*)ws0; asm volatile("" : "+s"(wsq)); unsigned char* const ws = (unsigned char*)wsq; const float* const par = (const float*)(ws + WS_PAR); int lnq = lane_id(); asm volatile("" : "+v"(lnq)); const int lane = lnq; (void)par; (void)lane;
                ResidArgs R{}; R.mode = 3; R.y = (const float*)(ws + P_Y2); R.g_post = par + PR_GFFNPOST; R.gate_chunk = 5; R.g_pre = par + PR_GMIXPRE + 1024; R.shift_chunk = 0;
                R.hout = (bf16*)(ws + P_H); R.l_mod = 1; R.l_gate = 0; R.route = false; R.hout8 = ws + P_H8; R.ysc = F8_D2 ? 1.0f / (F8_ASCALE * F8_WSCALE) : 1.0f;
                { int row = gw; for (; row + ngw < MALL; row += 2 * ngw) { resid_row(ws, outp, nullptr, nullptr, Rd(R, rep_), row, lane, tb); resid_row(ws, outp, nullptr, nullptr, Rd(R, rep_), row + ngw, lane, tb); } if (row < MALL) resid_row(ws, outp, nullptr, nullptr, Rd(R, rep_), row, lane, tb); }
                SEAM(pb + 12);
            }
        } else {
            for (int ch = 0; ch < 1; ++ch) {
                if (IN(pb + 8 + 2 * ch) || IN(pb + 9 + 2 * ch)) {
                    __syncthreads();
                    if (tid == 0) { const unsigned* cnt = (const unsigned*)(ws + WS_CTL) + CW_CNT; int acc = 0;
                        for (int e = 0; e < 8; ++e) { const int c = (int)__hip_atomic_load(cnt + e, __ATOMIC_RELAXED, __HIP_MEMORY_SCOPE_AGENT); tb[e] = c; tb[8 + e] = acc; acc += (c + 255) >> 8; }
                        tb[16] = acc; }
                    __syncthreads();
                }
                const int ntot = __builtin_amdgcn_readfirstlane(tb[16]), t0 = 0, t1 = ntot;
                if (PHON(12) && IN(pb + 8 + 2 * ch)) for (int rep_ = 0; rep_ <= (int)REPON(12); ++rep_) {
            GAS unsigned char* wsq = (GAS unsigned char*)ws0; asm volatile("" : "+s"(wsq)); unsigned char* const ws = (unsigned char*)wsq; const float* const par = (const float*)(ws + WS_PAR); int lnq = lane_id(); asm volatile("" : "+v"(lnq)); const int lane = lnq; (void)par; (void)lane;
                    constexpr unsigned kbm = F8_M1 ? 1024u : 2048u;
                    pg8::SchedMoe1 S{(const char*)(ws + P_H), (const char*)(ws + WS_WM1T), kbm, kbm, F8_M1 ? 8 : 16, (const int*)(ws + WS_LIST), tb, t1, G, bx, nullptr};
                    if (S.units() <= 16) { LAS unsigned* rtab = (LAS unsigned*)(lds + 131072); S.fill(rtab, wave * 64 + lane); S.rt = rtab; }
                    __syncthreads();
                    pg8::EpiPairS<true> E{ws + P_ACT, DFF, 0, F8_M1 ? 1.0f / (F8_HSCALE * F8_WSCALE) : 1.0f, F8_ASCALE};
                    pg8::gemm_phase<pg8::EpiPairS<true>, pg8::SchedMoe1, true, F8_M1 != 0>(lds, S, E, wave);
                    SEAM(pb + 8 + 2 * ch);
                }
                if (PHON(13) && IN(pb + 9 + 2 * ch)) for (int rep_ = 0; rep_ <= (int)REPON(13); ++rep_) {
            GAS unsigned char* wsq = (GAS unsigned char*)ws0; asm volatile("" : "+s"(wsq)); unsigned char* const ws = (unsigned char*)wsq; const float* const par = (const float*)(ws + WS_PAR); int lnq = lane_id(); asm volatile("" : "+v"(lnq)); const int lane = lnq; (void)par; (void)lane;
                    pg8::SchedMoe2 S{(const char*)(ws + P_ACT), (const char*)(ws + WS_WM2T), 2816u, 2816u, 22, tb, t1, G, bx};
                    pg8::EpiBf16 E{(bf16*)(ws + P_Y2), 1024, 0};
                    pg8::gemm_phase<pg8::EpiBf16, pg8::SchedMoe2, false, true>(lds, S, E, wave);
                    SEAM(pb + 9 + 2 * ch);
                }
            }
            if (PHON(14) && IN(pb + 12)) for (int rep_ = 0; rep_ <= (int)REPON(14); ++rep_) {
            GAS unsigned char* wsq = (GAS unsigned char*)ws0; asm volatile("" : "+s"(wsq)); unsigned char* const ws = (unsigned char*)wsq; const float* const par = (const float*)(ws + WS_PAR); int lnq = lane_id(); asm volatile("" : "+v"(lnq)); const int lane = lnq; (void)par; (void)lane;
                __syncthreads();
                if (tid == 0) { const unsigned* cnt = (const unsigned*)(ws + WS_CTL) + CW_CNT; int acc = 0;
                    for (int e = 0; e < 8; ++e) { const int c = (int)__hip_atomic_load(cnt + e, __ATOMIC_RELAXED, __HIP_MEMORY_SCOPE_AGENT); tb[e] = c; tb[8 + e] = acc; acc += (c + 255) >> 8; }
                    tb[16] = acc; }
                __syncthreads();
                ResidArgs R{}; R.mode = 2; R.g_post = par + PR_GFFNPOST + 1024; R.gate_chunk = 5; R.hout = nullptr; R.l_gate = 1; R.route = false; R.ysc = 1.0f / (F8_ASCALE * F8_WSCALE);
                { int row = gw; for (; row + ngw < NLAT; row += 2 * ngw) { resid_row(ws, outp, nullptr, nullptr, Rd(R, rep_), row, lane, tb); resid_row(ws, outp, nullptr, nullptr, Rd(R, rep_), row + ngw, lane, tb); } if (row < NLAT) resid_row(ws, outp, nullptr, nullptr, Rd(R, rep_), row, lane, tb); }
            }
        }
    }
#undef IN
#undef SEAM
#undef tid
}

extern "C" void kernel_launch(void* const* d_in, const int* in_sizes, int n_in, void* d_out, int out_size, void* d_ws, size_t ws_size, hipStream_t stream) {
    static int grid = 0;
    if (grid == 0) {
        if (n_in != 38 || out_size != NLAT * D || ws_size < WS_END) { fprintf(stderr, "kernel_launch: unexpected problem (n_in %d out %d ws %zu, need %zu)\n", n_in, out_size, ws_size, (size_t)WS_END); grid = -1; return; }
        int dev = 0, cus = 0, per_cu = 0;
        if (hipGetDevice(&dev) != hipSuccess || hipDeviceGetAttribute(&cus, hipDeviceAttributeMultiprocessorCount, dev) != hipSuccess) { grid = -1; return; }
        if (hipFuncSetAttribute((const void*)mk_fwd, hipFuncAttributeMaxDynamicSharedMemorySize, LDS_BYTES) != hipSuccess) { fprintf(stderr, "kernel_launch: hipFuncSetAttribute failed\n"); grid = -1; return; }
        if (hipOccupancyMaxActiveBlocksPerMultiprocessor(&per_cu, (const void*)mk_fwd, NTHREADS, LDS_BYTES) != hipSuccess || per_cu < 1) { fprintf(stderr, "kernel_launch: occupancy query says %d\n", per_cu); }
        (void)hipGetLastError();
        grid = cus;
    }
    if (grid < 0) return;
    (void)hipMemsetAsync((char*)d_ws + WS_CTL, 0, CTL_BYTES, stream);
    Args a{};
    for (int i = 0; i < 38; ++i) a.in[i] = (const float*)d_in[i];
    a.out = (float*)d_out; a.ws = (unsigned char*)d_ws;
#if MK_MULTI
    for (int ph = 0; ph < NPH; ++ph) {
        const int rel = ph < PH_L0 ? -1 : (ph - PH_L0) % PH_PER_L, l = ph < PH_L0 ? 0 : (ph - PH_L0) / PH_PER_L;
        if (rel > 12 || (l == 0 && (rel == 10 || rel == 11))) continue;
        a.ph_lo = ph; a.ph_hi = ph + 1;
        hipLaunchKernelGGL(mk_fwd, dim3(grid), dim3(NTHREADS), LDS_BYTES, stream, a);
#if MK_DEBUG
        hipLaunchKernelGGL(dbg_fwd, dim3(grid), dim3(NTHREADS), 0, stream, a, ph);
#endif
    }
#if MK_DEBUG
    hipLaunchKernelGGL(dbg_fwd, dim3(grid), dim3(NTHREADS), 0, stream, a, 1000);
#endif
#else
    a.ph_lo = 0; a.ph_hi = NPH;
    hipLaunchKernelGGL(mk_fwd, dim3(grid), dim3(NTHREADS), LDS_BYTES, stream, a);
#endif
}
```

```cpp
#include <hip/hip_runtime.h>
#include <cstdio>
#include <cstdint>

#ifndef MK_DEBUG
#define MK_DEBUG 0
#endif
#ifndef MK_MULTI
#define MK_MULTI 0
#endif

#define GAS __attribute__((address_space(1)))
#define LAS __attribute__((address_space(3)))
typedef unsigned short bf16;
typedef short bf16x8 __attribute__((ext_vector_type(8)));
typedef short s16x4 __attribute__((ext_vector_type(4)));
typedef float f32x2 __attribute__((ext_vector_type(2)));
typedef float f32x4 __attribute__((ext_vector_type(4)));
typedef float f32x16 __attribute__((ext_vector_type(16)));
typedef unsigned u32x2 __attribute__((ext_vector_type(2)));
typedef unsigned u32x4 __attribute__((ext_vector_type(4)));

constexpr int D = 1024, NB = 4, SEQ = 4096, CTXL = 256, GRIDW = 64;
constexpr int NLAT = NB * SEQ, NCTX = NB * CTXL, MALL = NLAT + NCTX;
constexpr int LPOS = CTXL + SEQ;
constexpr int NIN = 1952, ZW = 2048;
constexpr int DFF = 2816, NEXP = 8;
constexpr float EPS = 1e-6f;
constexpr float LOG2E = 1.4426950408889634f;
#ifndef F8_G1L1
#define F8_G1L1 1
#endif
constexpr float F8_WSCALE = 256.f, F8_HSCALE = 16.f, F8_ASCALE = 8.f;
#ifndef F8_D1
#define F8_D1 0
#endif
#ifndef F8_D2
#define F8_D2 0
#endif
#ifndef F8_M1
#define F8_M1 1
#endif
constexpr int ZC_QG = 0, ZC_KG = 512, ZC_VG = 640, ZC_CQ = 768, ZC_CKV = 1152, ZC_KR = 1408, ZC_U = 1536;

constexpr size_t MiB = 1u << 20;
constexpr size_t WS_CTL = 0, CTL_BYTES = 1 * MiB;
constexpr size_t WS_MOD = 1 * MiB;
constexpr size_t WS_ROPE = 2 * MiB;
constexpr size_t WS_PAR = 3 * MiB + 512 * 1024;
constexpr int PR_GMIXPRE = 0, PR_GMIXPOST = 2048, PR_GFFNPRE = 4096, PR_GFFNPOST = 6144, PR_GQ = 8192, PR_GK = 8320, PR_GCQ = 8448, PR_GCKV = 9216, PR_BMG = 9728, PR_RW = 15872, PR_RB = 24064,
              PR_A16 = 24080, PR_END = PR_A16 + 2 * 2 * 32 * 64 * 2;
constexpr size_t WS_LIST = 4 * MiB;
constexpr size_t WS_LATC = 5 * MiB;
constexpr size_t WS_W1T = 9 * MiB;
constexpr size_t WS_WMGT = 17 * MiB;
constexpr size_t WS_WUQT = 29 * MiB;
constexpr size_t WS_WUKVT = 31 * MiB;
constexpr size_t WS_S5M = 32 * MiB;
constexpr size_t WS_WGLUT = 56 * MiB;
constexpr size_t WS_WBT = 58 * MiB;
constexpr size_t WS_WOUTT = 64 * MiB;
constexpr size_t WS_WF1T = 68 * MiB;
constexpr size_t WS_WF2T = 79 * MiB;
constexpr size_t WS_WM1T = 85 * MiB;
constexpr size_t WS_WM2T = 173 * MiB;
constexpr size_t WS_POOL = 217 * MiB;
constexpr size_t P_H = WS_POOL + 0 * MiB;
constexpr size_t P_Z = WS_POOL + 34 * MiB;
constexpr size_t P_QB = WS_POOL + 34 * MiB;
constexpr size_t P_KB = WS_POOL + 60 * MiB;
constexpr size_t P_VB = WS_POOL + 77 * MiB;
constexpr size_t P_QA = WS_POOL + 102 * MiB;
constexpr size_t P_KA = WS_POOL + 119 * MiB;
constexpr size_t P_VA = WS_POOL + 124 * MiB;
constexpr size_t P_KRR = WS_POOL + 129 * MiB;
constexpr size_t P_UG = WS_POOL + 131 * MiB;
constexpr size_t P_CQN = WS_POOL + 148 * MiB;
constexpr size_t P_CKVN = WS_POOL + 161 * MiB;
constexpr size_t P_AGLU = WS_POOL + 170 * MiB;
constexpr size_t P_YBR = WS_POOL + 187 * MiB;
constexpr size_t P_MRG = WS_POOL + 34 * MiB;
constexpr size_t P_GSCR = WS_POOL + 68 * MiB;
constexpr size_t P_Y = WS_POOL + 102 * MiB;
constexpr size_t P_ACT = WS_POOL + 34 * MiB;
constexpr size_t P_Y2 = WS_POOL + 136 * MiB;
constexpr size_t P_H8 = WS_POOL + 240 * MiB;
constexpr size_t WS_END = WS_POOL + 257 * MiB;
static_assert(P_YBR + (size_t)MALL * 1536 * 2 <= WS_END && P_Y2 + (size_t)MALL * 1024 * 4 <= WS_END && P_ACT + (size_t)MALL * DFF * 2 <= P_Y2, "pool map");
static_assert(P_GSCR + 256 * 3 * 131072 <= P_AGLU && P_VB + (size_t)MALL * 512 * 2 <= P_QA && P_Y + (size_t)MALL * 4096 <= P_AGLU, "pool map 2");

constexpr int CW_BAR = 4096;
constexpr int CW_Q = 8320;
constexpr int CW_CNT = 8192;
constexpr int CW_MFLAG = 9216;
constexpr int CW_DBG = 16384;

constexpr int LDS_MISC = 147456;
constexpr int LDS_BYTES = 151552;
constexpr int NWAVES = 8, NTHREADS = 512;

__device__ __forceinline__ int lane_id() { unsigned m_ = ~0u; asm volatile("" : "+s"(m_)); return (int)__builtin_amdgcn_mbcnt_hi(m_, __builtin_amdgcn_mbcnt_lo(m_, 0u)); }
__device__ __forceinline__ float bf2f(unsigned v) { return __uint_as_float(v << 16); }
__device__ __forceinline__ unsigned f2bf(float f) { unsigned u = __float_as_uint(f); return (u + 0x7fffu + ((u >> 16) & 1u)) >> 16; }
typedef __bf16 bf16x2_t __attribute__((ext_vector_type(2)));
__device__ __forceinline__ unsigned pk2(float lo, float hi) { const f32x2 v = {lo, hi}; return __builtin_bit_cast(unsigned, __builtin_convertvector(v, bf16x2_t)); }
__device__ __forceinline__ float shfl_xor_l(float v, int mask, int lane) { return __int_as_float(__builtin_amdgcn_ds_bpermute((lane ^ mask) << 2, __float_as_int(v))); }
__device__ __forceinline__ float wave_sum(float v) {
    const int lane = lane_id();
#pragma unroll
    for (int o = 1; o < 64; o <<= 1) v += shfl_xor_l(v, o, lane);
    return v;
}
__device__ __forceinline__ float fsigmoid(float x) { return __builtin_amdgcn_rcpf(1.0f + __builtin_amdgcn_exp2f(-x * LOG2E)); }
__device__ __forceinline__ float fsilu(float x) { return x * fsigmoid(x); }
__device__ __forceinline__ float fgelu_tanh(float x) { const float u = 0.7978845608028654f * (x + 0.044715f * x * x * x); return x * fsigmoid(2.0f * u); }
__device__ __forceinline__ void unpack8(const u32x4 v, float (&f)[8]) {
    f[0] = bf2f(v.x & 0xffffu); f[1] = bf2f(v.x >> 16); f[2] = bf2f(v.y & 0xffffu); f[3] = bf2f(v.y >> 16);
    f[4] = bf2f(v.z & 0xffffu); f[5] = bf2f(v.z >> 16); f[6] = bf2f(v.w & 0xffffu); f[7] = bf2f(v.w >> 16);
}
__device__ __forceinline__ u32x4 pack8(const float (&f)[8]) { u32x4 w; w.x = pk2(f[0], f[1]); w.y = pk2(f[2], f[3]); w.z = pk2(f[4], f[5]); w.w = pk2(f[6], f[7]); return w; }
__device__ __forceinline__ int pos_row(int b, int p) { return p < CTXL ? NLAT + b * CTXL + p : b * SEQ + (p - CTXL); }

#define XB_TMO      128
#define XB_XCNT(j)  (256  + 64 * (j))
#define XB_XSUB(j)  (1280 + 64 * (j))
#define XB_XGEN(j)  (2304 + 64 * (j))
#define XB_TOP      3328
#define XB_TOPGEN   3392
#define XCD_BAR_WORDS 3456
#define XB_SPIN_CAP (1u << 18)
__device__ __forceinline__ unsigned xb_ld(unsigned* p)              { return __hip_atomic_load(p, __ATOMIC_RELAXED, __HIP_MEMORY_SCOPE_AGENT); }
__device__ __forceinline__ unsigned xb_add(unsigned* p, unsigned v) { return __hip_atomic_fetch_add(p, v, __ATOMIC_RELAXED, __HIP_MEMORY_SCOPE_AGENT); }
__device__ __forceinline__ unsigned xb_xcc_id() { return (unsigned)__builtin_amdgcn_s_getreg((3 << 11) | 20) & 0xFu; }
#define XB_SPIN(cond, bar) do { unsigned _sp = 0; while (cond) { __builtin_amdgcn_s_sleep(1); \
    if ((++_sp & 255u) == 0u) { if (xb_ld(&(bar)[XB_TMO])) break; if (_sp > XB_SPIN_CAP) { atomicAdd(&(bar)[XB_TMO], 1u); break; } } } } while (0)
struct XcdBarrier { unsigned* bar; unsigned x; volatile LAS unsigned* st; int wave; };
__device__ __forceinline__ XcdBarrier xcd_barrier_post(unsigned* bar, volatile LAS unsigned* st, int wave) {
    XcdBarrier b; b.bar = bar; b.x = xb_xcc_id(); b.st = st; b.wave = wave;
    if (wave == 0 && lane_id() == 0) (void)xb_add(&bar[XB_XCNT(b.x)], 1u);
    return b;
}
__device__ __forceinline__ void xcd_barrier_complete(unsigned* bar, unsigned x, unsigned& nloc, unsigned& nx) {
    const unsigned G = gridDim.x * gridDim.y * gridDim.z;
    unsigned sum, cnt, mine, sp = 0u;
    for (;;) {
        sum = 0u; cnt = 0u; mine = 0u;
#pragma unroll
        for (unsigned j = 0; j < 16; ++j) { const unsigned c = xb_ld(&bar[XB_XCNT(j)]); sum += c; cnt += (c > 0u) ? 1u : 0u; mine = (j == x) ? c : mine; }
        if (sum == G) break;
        __builtin_amdgcn_s_sleep(1);
        if ((++sp & 255u) == 0u) { if (xb_ld(&bar[XB_TMO])) break; if (sp > XB_SPIN_CAP) { atomicAdd(&bar[XB_TMO], 1u); break; } }
    }
    nloc = mine > 0u ? mine : 1u; nx = cnt > 0u ? cnt : 1u;
}
__device__ __forceinline__ void xcd_barrier(const XcdBarrier& b) {
    asm volatile("s_waitcnt vmcnt(0)" ::: "memory");
    __syncthreads();
    if (b.wave == 0 && lane_id() == 0) {
        unsigned* bar = b.bar;
        __builtin_amdgcn_s_waitcnt(0);
        unsigned nloc = b.st[0], nx = b.st[1];
        if (nloc == 0u) { xcd_barrier_complete(bar, b.x, nloc, nx); b.st[0] = nloc; b.st[1] = nx; }
        const unsigned old = xb_add(&bar[XB_XSUB(b.x)], 1u);
        const unsigned gen = old / nloc;
        if (old + 1u == (gen + 1u) * nloc) {
            __builtin_amdgcn_fence(__ATOMIC_RELEASE, "agent");
            asm volatile("s_waitcnt vmcnt(0)" ::: "memory");
            const unsigned og = xb_add(&bar[XB_TOP], 1u);
            const unsigned tg = og / nx;
            if (og + 1u == (tg + 1u) * nx) xb_add(&bar[XB_TOPGEN], 1u);
            else XB_SPIN(xb_ld(&bar[XB_TOPGEN]) == tg, bar);
            __builtin_amdgcn_fence(__ATOMIC_ACQUIRE, "agent");
            xb_add(&bar[XB_XGEN(b.x)], 1u);
            asm volatile("s_waitcnt vmcnt(0)" ::: "memory");
        } else {
            XB_SPIN(xb_ld(&bar[XB_XGEN(b.x)]) == gen, bar);
            __builtin_amdgcn_fence(__ATOMIC_ACQUIRE, "agent");
            asm volatile("s_waitcnt vmcnt(0)" ::: "memory");
        }
    }
    __syncthreads();
}

namespace pg8 {
typedef int v4i __attribute__((ext_vector_type(4)));
typedef int v8i __attribute__((ext_vector_type(8)));
constexpr int BM = 256, BK = 64, HALF = 128, HTB = HALF * BK * 2, STAGE_BYTES = 8 * HTB;
__host__ __device__ __forceinline__ int lds_byte(int r, int c) { const int st = (r >> 4) * 2 + (c >> 5), rr = r & 15, cc = c & 31, ob = rr * 64 + cc * 2; return st * 1024 + (ob ^ (((ob >> 9) & 1) << 5)); }
__host__ __device__ __forceinline__ void stage_rc(int b, int& R, int& C) { const int st = b / 1024, sb = b % 1024, swz = sb ^ (((sb >> 9) & 1) << 5); R = (st >> 1) * 16 + swz / 64; C = (st & 1) * 32 + (swz % 64) / 2; }
__host__ __device__ __forceinline__ int perm32(int rho) { const int n = rho >> 4, i = rho & 15; return 8 * (i >> 2) + 4 * n + (i & 3); }

struct GUnit { const char* a; const char* b; unsigned lda, ldb; int nt; int pm, pn, z; };

__device__ __forceinline__ void tile_of(int L, int nM, int nN, int& pm, int& pn) {
    const int nwg = nM * nN; int wgid = L;
    { const int q = nwg / 8, r = nwg % 8, xcd = wgid % 8, off = wgid / 8; wgid = (xcd < r ? xcd * (q + 1) : r * (q + 1) + (xcd - r) * q) + off; }
    const int nig = 8 * nN, gid = wgid / nig, fm = gid * 8, gsz = (nM - fm) < 8 ? (nM - fm) : 8;
    pm = fm + ((wgid % nig) % gsz); pn = (wgid % nig) / gsz;
}

template <class Epi, class Sched, bool GATHER, bool F8 = false>
__device__ __forceinline__ void gemm_phase(LAS unsigned char* lds, const Sched& S, const Epi& E, int wave_) {
    int tid = wave_ * 64 + lane_id(); asm volatile("" : "+v"(tid));
    const int wid = __builtin_amdgcn_readfirstlane(tid >> 6), lane = tid & 63, wr = wid >> 2, wc = wid & 3, fr = lane & 15, fq = lane >> 4;
    int Rr[2], Cc[2], Rb[2];
#pragma unroll
    for (int i = 0; i < 2; ++i) { stage_rc(tid * 16 + i * 8192, Rr[i], Cc[i]); Rb[i] = Epi::PERM ? ((Rr[i] & ~31) + perm32(Rr[i] & 31)) : Rr[i]; }
    const size_t kstep = (size_t)(BK * 2);
    const unsigned ldsw = (unsigned)wid * 1024u;
    const int aoff = lds_byte(wr * 64 + fr, fq * 8), boff = lds_byte(wc * 32 + fr, fq * 8);
#define PG8_SA(b, h) (((b) * 2 + (h)) * HTB)
#define PG8_SB(b, h) ((4 + (b) * 2 + (h)) * HTB)
#define PG8_STAGE(bufoff, gbase, v0, v1) do { \
        __builtin_amdgcn_global_load_lds((const unsigned*)((const char*)(gbase) + (v0)), (LAS unsigned*)(lds + (bufoff) + ldsw), 16, 0, 0); \
        __builtin_amdgcn_global_load_lds((const unsigned*)((const char*)(gbase) + (v1)), (LAS unsigned*)(lds + (bufoff) + ldsw + 8192), 16, 0, 0); } while (0)
#define PG8_LD16(p) __builtin_bit_cast(v4i, *(const LAS bf16x8*)(p))
#define PG8_LDA(dst, b, h) do { _Pragma("unroll") for (int m = 0; m < 4; ++m) dst[m] = __builtin_shufflevector(PG8_LD16(lds + PG8_SA(b, h) + aoff + m * 2048), PG8_LD16(lds + PG8_SA(b, h) + aoff + m * 2048 + 1024), 0, 1, 2, 3, 4, 5, 6, 7); } while (0)
#define PG8_LDB(dst, b, h) do { _Pragma("unroll") for (int n = 0; n < 2; ++n) dst[n] = __builtin_shufflevector(PG8_LD16(lds + PG8_SB(b, h) + boff + n * 2048), PG8_LD16(lds + PG8_SB(b, h) + boff + n * 2048 + 1024), 0, 1, 2, 3, 4, 5, 6, 7); } while (0)
#define PG8_LO(x) __builtin_bit_cast(bf16x8, __builtin_shufflevector(x, x, 0, 1, 2, 3))
#define PG8_HI(x) __builtin_bit_cast(bf16x8, __builtin_shufflevector(x, x, 4, 5, 6, 7))
#define PG8_MMA(ai, bj, At, Bt) do { __builtin_amdgcn_s_setprio(1); \
        _Pragma("unroll") for (int m = 0; m < 4; ++m) _Pragma("unroll") for (int n = 0; n < 2; ++n) { \
            if constexpr (F8) acc[ai][bj][m][n] = __builtin_amdgcn_mfma_scale_f32_16x16x128_f8f6f4(Bt[n], At[m], acc[ai][bj][m][n], 0, 0, 0, 0, 0, 0); \
            else { acc[ai][bj][m][n] = __builtin_amdgcn_mfma_f32_16x16x32_bf16(PG8_LO(Bt[n]), PG8_LO(At[m]), acc[ai][bj][m][n], 0, 0, 0); \
                   acc[ai][bj][m][n] = __builtin_amdgcn_mfma_f32_16x16x32_bf16(PG8_HI(Bt[n]), PG8_HI(At[m]), acc[ai][bj][m][n], 0, 0, 0); } } \
        __builtin_amdgcn_s_setprio(0); } while (0)
#define PG8_WAIT_V(n) asm volatile("s_waitcnt vmcnt(" #n ")" ::: "memory")
#define PG8_WAIT_L(n) asm volatile("s_waitcnt lgkmcnt(" #n ")" ::: "memory")
#define PG8_BAR __builtin_amdgcn_s_barrier()
#define PG8_SCHED __builtin_amdgcn_sched_barrier(0)
#define PG8_OFFS(u) do { \
        _Pragma("unroll") for (int i_ = 0; i_ < 2; ++i_) { \
            if constexpr (GATHER) { oA0[i_] = S.arow(u, Rr[i_]) + (unsigned)Cc[i_] * 2u; oA1[i_] = S.arow(u, HALF + Rr[i_]) + (unsigned)Cc[i_] * 2u; } \
            else { oA0[i_] = (unsigned)Rr[i_] * (u).lda + (unsigned)Cc[i_] * 2u; } \
            oB[i_] = (unsigned)Rb[i_] * (u).ldb + (unsigned)Cc[i_] * 2u; } \
        hA = GATHER ? (size_t)0 : (size_t)HALF * (u).lda; hB = (size_t)HALF * (u).ldb; } while (0)
#define PG8_A1(i) (GATHER ? oA1[i] : oA0[i])
    GUnit cur, nxt; int ui = 0;
    if (!S.next(0, cur)) return;
    f32x4 acc[2][2][4][2];
#pragma unroll
    for (int a = 0; a < 2; ++a)
#pragma unroll
        for (int b = 0; b < 2; ++b)
#pragma unroll
            for (int m = 0; m < 4; ++m)
#pragma unroll
                for (int n = 0; n < 2; ++n) acc[a][b][m][n] = (f32x4){0.f, 0.f, 0.f, 0.f};
    v8i At[4], B0[2], B1[2];
    unsigned oA0[2], oA1[2], oB[2]; size_t hA, hB;
    oA1[0] = 0u; oA1[1] = 0u;
    PG8_OFFS(cur);
    const char* cA = cur.a; const char* cBp = cur.b;
    PG8_STAGE(PG8_SB(0, 0), cBp, oB[0], oB[1]); PG8_STAGE(PG8_SB(0, 1), cBp + hB, oB[0], oB[1]); PG8_STAGE(PG8_SA(0, 0), cA, oA0[0], oA0[1]); PG8_STAGE(PG8_SA(0, 1), cA + hA, PG8_A1(0), PG8_A1(1));
    if (wr == 1) PG8_BAR;
    PG8_WAIT_V(2); PG8_BAR;
    PG8_STAGE(PG8_SB(1, 0), cBp + kstep, oB[0], oB[1]); PG8_STAGE(PG8_SA(1, 0), cA + kstep, oA0[0], oA0[1]); PG8_STAGE(PG8_SB(1, 1), cBp + hB + kstep, oB[0], oB[1]);
    PG8_WAIT_V(6); PG8_BAR;
    for (;;) {
        const bool has_next = S.next(ui + 1, nxt);
        const char* nA = has_next ? nxt.a : cA; const char* nBp = has_next ? nxt.b : cBp;
        int nt = cur.nt; asm volatile("" : "+s"(nt));
        for (int t = 0; t < nt; t += 2) {
            const bool last = (t == nt - 2);
            const char* a1 = cA + (size_t)(t + 1) * kstep;
            const char* a2 = last ? nA : cA + (size_t)(t + 2) * kstep; const char* b2 = last ? nBp : cBp + (size_t)(t + 2) * kstep;
            const char* a3 = a2 + kstep; const char* b3 = b2 + kstep;
            PG8_LDB(B0, 0, 0); PG8_LDB(B1, 0, 1); PG8_SCHED; PG8_LDA(At, 0, 0); PG8_STAGE(PG8_SA(1, 1), a1 + hA, PG8_A1(0), PG8_A1(1));
            if (last && has_next) PG8_OFFS(nxt);
            PG8_WAIT_V(8); PG8_WAIT_L(0); PG8_BAR; PG8_MMA(0, 0, At, B0); PG8_MMA(0, 1, At, B1); PG8_BAR; PG8_SCHED;
            PG8_LDA(At, 0, 1); PG8_STAGE(PG8_SB(0, 0), b2, oB[0], oB[1]); PG8_STAGE(PG8_SB(0, 1), b2 + hB, oB[0], oB[1]); PG8_STAGE(PG8_SA(0, 0), a2, oA0[0], oA0[1]);
            PG8_WAIT_V(8); PG8_WAIT_L(0); PG8_BAR; PG8_MMA(1, 0, At, B0); PG8_MMA(1, 1, At, B1); PG8_BAR; PG8_SCHED;
            PG8_LDB(B0, 1, 0); PG8_LDB(B1, 1, 1); PG8_SCHED; PG8_LDA(At, 1, 0); PG8_STAGE(PG8_SA(0, 1), a2 + hA, PG8_A1(0), PG8_A1(1));
            PG8_WAIT_V(8); PG8_WAIT_L(0); PG8_BAR; PG8_MMA(0, 0, At, B0); PG8_MMA(0, 1, At, B1); PG8_BAR; PG8_SCHED;
            PG8_LDA(At, 1, 1); PG8_STAGE(PG8_SB(1, 0), b3, oB[0], oB[1]); PG8_STAGE(PG8_SB(1, 1), b3 + hB, oB[0], oB[1]); PG8_STAGE(PG8_SA(1, 0), a3, oA0[0], oA0[1]);
            PG8_WAIT_V(8); PG8_WAIT_L(0); PG8_BAR; PG8_MMA(1, 0, At, B0); PG8_MMA(1, 1, At, B1); PG8_BAR; PG8_SCHED;
        }
        if (wr == 0) PG8_BAR;
        E(acc, cur, wr, wc, fr, fq);
        if (!has_next) break;
#pragma unroll
        for (int a = 0; a < 2; ++a)
#pragma unroll
            for (int b = 0; b < 2; ++b)
#pragma unroll
                for (int m = 0; m < 4; ++m)
#pragma unroll
                    for (int n = 0; n < 2; ++n) acc[a][b][m][n] = (f32x4){0.f, 0.f, 0.f, 0.f};
        cur = nxt; cA = nA; cBp = nBp; ++ui;
        if (wr == 1) PG8_BAR;
    }
    PG8_WAIT_V(0);
    PG8_BAR;
#undef PG8_SA
#undef PG8_SB
#undef PG8_STAGE
#undef PG8_LDA
#undef PG8_LDB
#undef PG8_LD16
#undef PG8_LO
#undef PG8_HI
#undef PG8_MMA
#undef PG8_WAIT_V
#undef PG8_WAIT_L
#undef PG8_BAR
#undef PG8_SCHED
#undef PG8_OFFS
#undef PG8_A1
}
}

namespace pg8 {
__device__ __forceinline__ unsigned pk_fp8x4(float a, float b, float c, float d) {
    a = __builtin_amdgcn_fmed3f(a, -448.f, 448.f); b = __builtin_amdgcn_fmed3f(b, -448.f, 448.f); c = __builtin_amdgcn_fmed3f(c, -448.f, 448.f); d = __builtin_amdgcn_fmed3f(d, -448.f, 448.f);
    unsigned w = 0; w = __builtin_amdgcn_cvt_pk_fp8_f32(a, b, w, false); w = __builtin_amdgcn_cvt_pk_fp8_f32(c, d, w, true); return w; }
struct SchedPlain {
    const char* A; const char* B; unsigned lda, ldb; int nt, nM, nN, G, c;
    __device__ __forceinline__ bool next(int i, GUnit& u) const {
        const int L = i * G + c; if (L >= nM * nN) return false;
        int pm, pn; tile_of(L, nM, nN, pm, pn);
        u.a = A + (size_t)pm * 256 * lda; u.b = B + (size_t)pn * 256 * ldb; u.lda = lda; u.ldb = ldb; u.nt = nt; u.pm = pm; u.pn = pn; u.z = 0; return true;
    }
};
struct SchedUp {
    const char* Aq; const char* Bq; const char* Akv; const char* Bkv; int nMq, nMall, G, c;
    __device__ __forceinline__ bool next(int i, GUnit& u) const {
        int L = i * G + c; const int nq = nMq * 3; int pm, pn;
        if (L < nq) { tile_of(L, nMq, 3, pm, pn); u.a = Aq + (size_t)pm * 256 * 768; u.b = Bq + (size_t)pn * 256 * 768; u.lda = 768u; u.ldb = 768u; u.nt = 6; u.pm = pm; u.pn = pn; u.z = 0; return true; }
        L -= nq; if (L >= nMall * 4) return false;
        tile_of(L, nMall, 4, pm, pn); u.a = Akv + (size_t)pm * 256 * 512; u.b = Bkv + (size_t)pn * 256 * 512; u.lda = 512u; u.ldb = 512u; u.nt = 4; u.pm = pm; u.pn = pn; u.z = 1; return true;
    }
};
struct SchedMergeG {
    const char* A; const char* B; unsigned lda, ldb; int nt, nM, L; int only = -1;
    __device__ __forceinline__ bool next(int i_, GUnit& u) const {
        if ((only >= 0 ? i_ >= 1 : i_ >= 3) || L >= nM * 4) return false;
        const int i = only >= 0 ? only : i_;
        int pm, pn; tile_of(L, nM, 4, pm, pn);
        u.a = A + (size_t)pm * 256 * lda; u.lda = lda; u.b = B + ((size_t)i * 1024 + pn * 256) * ldb; u.ldb = ldb; u.nt = nt; u.pm = pm; u.pn = pn; u.z = i; return true;
    }
};
struct SchedMergeP {
    const char* A; const char* B; unsigned lda, ldb; int nt, nM, L; int only = -1;
    __device__ __forceinline__ bool next(int i_, GUnit& u) const {
        if ((only >= 0 ? i_ >= 1 : i_ >= 3) || L >= nM * 4) return false;
        const int i = only >= 0 ? only : i_;
        int pm, pn; tile_of(L, nM, 4, pm, pn);
        u.a = A + (size_t)pm * 256 * lda + i * 1024; u.lda = lda; u.b = B + ((size_t)i * 1024 + pn * 256) * ldb; u.ldb = ldb; u.nt = nt; u.pm = pm; u.pn = pn; u.z = i; return true;
    }
};
struct SchedMoe1 {
    const char* H2; const char* W; unsigned lda, ldb; int nt; const int* list; const LAS int* tb; int nM, G, c;
    const LAS unsigned* rt;
    __device__ __forceinline__ bool next(int i, GUnit& u) const {
        const int L = i * G + c; if (L >= nM * 22) return false;
        const int mt = L / 22, pn = L % 22; int e = 0;
#pragma unroll
        for (int j = 1; j < 8; ++j) e += (mt >= tb[8 + j]) ? 1 : 0;
        e = __builtin_amdgcn_readfirstlane(e);
        u.a = H2; u.lda = lda; u.b = W + ((size_t)e * 5632 + pn * 256) * ldb; u.ldb = ldb; u.nt = nt; u.pm = mt; u.pn = pn; u.z = e | (i << 8); return true;
    }
    __device__ __forceinline__ unsigned arow(const GUnit& u, int r) const {
        if (rt) return rt[(u.z >> 8) * 256 + r];
        const int e = u.z & 255, li = (u.pm - tb[8 + e]) * 256 + r; const int tok = (li < tb[e]) ? list[e * 16384 + li] : 0;
        return (unsigned)tok * lda;
    }
    __device__ __forceinline__ int units() const { const int tot = nM * 22; return c < tot ? (tot - c + G - 1) / G : 0; }
    __device__ __forceinline__ void fill(LAS unsigned* w, int tid) const {
        const int n = units() * 256;
        for (int base = tid; base < n; base += 4 * NTHREADS) { int tokv[4];
#pragma unroll
            for (int k = 0; k < 4; ++k) { const int idx = base + NTHREADS * k; tokv[k] = 0;
                if (idx < n) { const int i = idx >> 8, r = idx & 255, mt = (i * G + c) / 22; int e = 0;
#pragma unroll
                    for (int j = 1; j < 8; ++j) e += (mt >= tb[8 + j]) ? 1 : 0;
                    const int li = (mt - tb[8 + e]) * 256 + r; if (li < tb[e]) tokv[k] = list[e * 16384 + li]; } }
#pragma unroll
            for (int k = 0; k < 4; ++k) { const int idx = base + NTHREADS * k; if (idx < n) w[idx] = (unsigned)tokv[k] * lda; } }
    }
};
struct SchedMoe2 {
    const char* A; const char* B; unsigned lda, ldb; int nt; const LAS int* tb; int nM, G, c;
    __device__ __forceinline__ bool next(int i, GUnit& u) const {
        const int L = i * G + c; if (L >= nM * 4) return false;
        int pm, pn; tile_of(L, nM, 4, pm, pn); int e = 0;
#pragma unroll
        for (int j = 1; j < 8; ++j) e += (pm >= tb[8 + j]) ? 1 : 0;
        e = __builtin_amdgcn_readfirstlane(e);
        u.a = A + (size_t)pm * 256 * lda; u.b = B + (size_t)(e * 4 + pn) * 256 * ldb; u.lda = lda; u.ldb = ldb; u.nt = nt; u.pm = pm; u.pn = pn; u.z = e; return true;
    }
};

#define EPI_ROWS_BEGIN _Pragma("unroll") for (int ai = 0; ai < 2; ++ai) _Pragma("unroll") for (int m = 0; m < 4; ++m) { const int row = u.pm * BM + ai * HALF + wr * 64 + m * 16 + fr;
#define EPI_ROWS_END }
__device__ __forceinline__ u32x4 pack_f4f4(const f32x4 a, const f32x4 b) { u32x4 w; w.x = pk2(a[0], a[1]); w.y = pk2(a[2], a[3]); w.z = pk2(b[0], b[1]); w.w = pk2(b[2], b[3]); return w; }

struct EpiBf16 {
    static constexpr bool PERM = true;
    bf16* O; int ldc; int rsub;
    __device__ __forceinline__ void operator()(const f32x4 (&acc)[2][2][4][2], const GUnit& u, int wr, int wc, int fr, int fq) const {
        const int col0 = u.pn * BM + wc * 32 + 8 * fq;
        EPI_ROWS_BEGIN
            bf16* rowp = O + (size_t)(row - rsub) * ldc + col0;
#pragma unroll
            for (int bj = 0; bj < 2; ++bj) *(u32x4*)(rowp + bj * HALF) = pack_f4f4(acc[ai][bj][m][0], acc[ai][bj][m][1]);
        EPI_ROWS_END
    }
};
struct EpiF32 {
    static constexpr bool PERM = false;
    float* C; int ldc;
    __device__ __forceinline__ void operator()(const f32x4 (&acc)[2][2][4][2], const GUnit& u, int wr, int wc, int fr, int fq) const {
        const int col0 = u.pn * BM + wc * 32 + 4 * fq;
        EPI_ROWS_BEGIN
            float* rowp = C + (size_t)row * ldc + col0;
#pragma unroll
            for (int bj = 0; bj < 2; ++bj)
#pragma unroll
                for (int n = 0; n < 2; ++n) *(f32x4*)(rowp + bj * HALF + n * 16) = acc[ai][bj][m][n];
        EPI_ROWS_END
    }
};
struct EpiUq {
    static constexpr bool PERM = true;
    bf16* Qb; const float* cosB; const float* sinB; float scale;
    __device__ __forceinline__ void operator()(const f32x4 (&acc)[2][2][4][2], const GUnit& u, int wr, int wc, int fr, int fq) const {
        const bool lat = u.pm < 64;
        EPI_ROWS_BEGIN
            const int t = row & (SEQ - 1);
#pragma unroll
            for (int bj = 0; bj < 2; ++bj) {
                const int gidx = u.pn * 8 + bj * 4 + wc, head = gidx / 3, part = gidx - head * 3;
                bf16* dst = Qb + (size_t)row * 768 + head * 96 + part * 32;
                f32x4 a = acc[ai][bj][m][0] * scale, b = acc[ai][bj][m][1] * scale;
                if (part == 2) {
                    if (lat) { const f32x4 c = *(const f32x4*)(cosB + t * 16 + 4 * fq), s = *(const f32x4*)(sinB + t * 16 + 4 * fq);
                        const f32x4 x1 = a * c - b * s, x2 = a * s + b * c; a = x1; b = x2; }
                    u32x2 w0, w1; w0.x = pk2(a[0], a[1]); w0.y = pk2(a[2], a[3]); w1.x = pk2(b[0], b[1]); w1.y = pk2(b[2], b[3]);
                    *(u32x2*)(dst + 4 * fq) = w0; *(u32x2*)(dst + 16 + 4 * fq) = w1;
                } else *(u32x4*)(dst + 8 * fq) = pack_f4f4(a, b);
            }
        EPI_ROWS_END
    }
};
struct EpiUkv {
    static constexpr bool PERM = true;
    bf16* Kb; bf16* Vb;
    __device__ __forceinline__ void operator()(const f32x4 (&acc)[2][2][4][2], const GUnit& u, int wr, int wc, int fr, int fq) const {
        bf16* base = (wc < 2) ? Kb : Vb;
        EPI_ROWS_BEGIN
#pragma unroll
            for (int bj = 0; bj < 2; ++bj) { const int head = u.pn * 2 + bj;
                *(u32x4*)(base + (size_t)row * 512 + head * 64 + (wc & 1) * 32 + 8 * fq) = pack_f4f4(acc[ai][bj][m][0], acc[ai][bj][m][1]); }
        EPI_ROWS_END
    }
};
struct EpiUp {
    static constexpr bool PERM = true;
    EpiUq q; EpiUkv kv;
    __device__ __forceinline__ void operator()(const f32x4 (&acc)[2][2][4][2], const GUnit& u, int wr, int wc, int fr, int fq) const { if (u.z == 0) q(acc, u, wr, wc, fr, fq); else kv(acc, u, wr, wc, fr, fq); }
};
template <int MODE> struct EpiPair {
    static constexpr bool PERM = true;
    bf16* O; int ldc; int cbase; int rsub;
    __device__ __forceinline__ void operator()(const f32x4 (&acc)[2][2][4][2], const GUnit& u, int wr, int wc, int fr, int fq) const {
        const int col0 = cbase + u.pn * 128 + wc * 32 + 8 * fq;
        EPI_ROWS_BEGIN
            f32x4 o[2];
#pragma unroll
            for (int n = 0; n < 2; ++n)
#pragma unroll
                for (int j = 0; j < 4; ++j) { const float a = acc[ai][0][m][n][j], b = acc[ai][1][m][n][j]; o[n][j] = MODE == 0 ? a * fsigmoid(b) : fsilu(a) * b; }
            *(u32x4*)(O + (size_t)(row - rsub) * ldc + col0) = pack_f4f4(o[0], o[1]);
        EPI_ROWS_END
    }
};
struct EpiGate {
    static constexpr bool PERM = true;
    const float* bmg; u32x4* gscr; float ds;
    __device__ __forceinline__ void operator()(const f32x4 (&acc)[2][2][4][2], const GUnit& u, int wr, int wc, int fr, int fq) const {
        const int n = u.z, tid = (wr * 4 + wc) * 64 + fq * 16 + fr;
#pragma unroll
        for (int bj = 0; bj < 2; ++bj) {
            const float* bp = bmg + n * 1024 + u.pn * BM + bj * HALF + wc * 32 + 8 * fq;
            const f32x4 b0 = *(const f32x4*)bp, b1 = *(const f32x4*)(bp + 4);
#pragma unroll
            for (int ai = 0; ai < 2; ++ai)
#pragma unroll
                for (int m = 0; m < 4; ++m) { f32x4 g0 = acc[ai][bj][m][0] * ds + b0, g1 = acc[ai][bj][m][1] * ds + b1;
#pragma unroll
                    for (int j = 0; j < 4; ++j) { g0[j] = fsigmoid(g0[j]); g1[j] = fsigmoid(g1[j]); }
                    gscr[((n * 8 + (tid >> 6)) * 16 + (ai * 4 + m) * 2 + bj) * 64 + (tid & 63)] = pack_f4f4(g0, g1); asm volatile("" ::: "memory"); }
        }
    }
};
struct EpiMergeP {
    static constexpr bool PERM = true;
    bf16* M; const u32x4* gscr;
    __device__ __forceinline__ void operator()(const f32x4 (&acc)[2][2][4][2], const GUnit& u, int wr, int wc, int fr, int fq) const {
        const int n = u.z, tid = (wr * 4 + wc) * 64 + fq * 16 + fr;
        const int col0 = u.pn * BM + wc * 32 + 8 * fq;
        EPI_ROWS_BEGIN
#pragma unroll
            for (int bj = 0; bj < 2; ++bj) {
                float g[8], p[8]; unpack8(gscr[((n * 8 + (tid >> 6)) * 16 + (ai * 4 + m) * 2 + bj) * 64 + (tid & 63)], g);
                bf16* dst = M + (size_t)row * 1024 + col0 + bj * HALF;
                if (n > 0) unpack8(*(const u32x4*)dst, p);
#pragma unroll
                for (int j = 0; j < 8; ++j) { const float v = g[j] * acc[ai][bj][m][j >> 2][j & 3]; p[j] = n > 0 ? p[j] + v : v; }
                *(u32x4*)dst = pack8(p);
            }
            asm volatile("" ::: "memory");
        EPI_ROWS_END
    }
};
template <bool OUT8> struct EpiPairS {
    static constexpr bool PERM = true;
    unsigned char* O; int ldc; int rsub; float ds, os;
    __device__ __forceinline__ void operator()(const f32x4 (&acc)[2][2][4][2], const GUnit& u, int wr, int wc, int fr, int fq) const {
        const int col0 = u.pn * 128 + wc * 32 + 8 * fq;
        EPI_ROWS_BEGIN
            float o[8];
#pragma unroll
            for (int n = 0; n < 2; ++n)
#pragma unroll
                for (int j = 0; j < 4; ++j) { const float a = acc[ai][0][m][n][j] * ds, b = acc[ai][1][m][n][j]; o[4 * n + j] = fsilu(a) * b * (ds * os); }
            if constexpr (OUT8) *(u32x2*)(O + (size_t)(row - rsub) * ldc + col0) = (u32x2){pk_fp8x4(o[0], o[1], o[2], o[3]), pk_fp8x4(o[4], o[5], o[6], o[7])};
            else *(u32x4*)((bf16*)O + (size_t)(row - rsub) * ldc + col0) = pack8(o);
            asm volatile("" ::: "memory");
        EPI_ROWS_END
    }
};
struct EpiF32S {
    static constexpr bool PERM = false;
    float* C; int ldc; float ds;
    __device__ __forceinline__ void operator()(const f32x4 (&acc)[2][2][4][2], const GUnit& u, int wr, int wc, int fr, int fq) const {
        const int col0 = u.pn * BM + wc * 32 + 4 * fq;
        EPI_ROWS_BEGIN
            float* rowp = C + (size_t)row * ldc + col0;
#pragma unroll
            for (int bj = 0; bj < 2; ++bj)
#pragma unroll
                for (int n = 0; n < 2; ++n) *(f32x4*)(rowp + bj * HALF + n * 16) = acc[ai][bj][m][n] * ds;
        EPI_ROWS_END
    }
};
struct EpiBf16S {
    static constexpr bool PERM = true;
    bf16* O; int ldc; float ds;
    __device__ __forceinline__ void operator()(const f32x4 (&acc)[2][2][4][2], const GUnit& u, int wr, int wc, int fr, int fq) const {
        const int col0 = u.pn * BM + wc * 32 + 8 * fq;
        EPI_ROWS_BEGIN
            bf16* rowp = O + (size_t)row * ldc + col0;
#pragma unroll
            for (int bj = 0; bj < 2; ++bj) *(u32x4*)(rowp + bj * HALF) = pack_f4f4(acc[ai][bj][m][0] * ds, acc[ai][bj][m][1] * ds);
        EPI_ROWS_END
    }
};
#undef EPI_ROWS_BEGIN
#undef EPI_ROWS_END
}

namespace att {
__device__ __forceinline__ float swap32_max(float v) { const auto rr = __builtin_amdgcn_permlane32_swap(__float_as_uint(v), __float_as_uint(v), false, false); return __builtin_fmaxf(__uint_as_float(rr[0]), __uint_as_float(rr[1])); }
__device__ __forceinline__ float swap32_sum(float v) { const auto rr = __builtin_amdgcn_permlane32_swap(__float_as_uint(v), __float_as_uint(v), false, false); return __uint_as_float(rr[0]) + __uint_as_float(rr[1]); }
constexpr int VSLOT = 8192, NSLOT = 3;
__device__ __forceinline__ int crow(int r, int hi) { return (r & 3) + 8 * (r >> 2) + 4 * hi; }
__device__ __forceinline__ void glds16(const void* gsrc, unsigned lds_dst) { unsigned keep;
    asm volatile("s_mov_b32 %0, m0\n\ts_mov_b32 m0, %2\n\ts_nop 0\n\tglobal_load_lds_dwordx4 %1, off\n\ts_mov_b32 m0, %0" : "=&s"(keep) : "v"(gsrc), "s"(lds_dst) : "memory"); }
typedef short v4i16_t __attribute__((ext_vector_type(4)));
__device__ __forceinline__ s16x4 vtr(const LAS unsigned char* p) { return __builtin_bit_cast(s16x4, __builtin_amdgcn_ds_read_tr16_b64_v4i16((LAS v4i16_t*)p)); }

struct AttnArgs {
    const bf16* Q; int qpitch, qcol; long qrow0;
    const bf16* K1; int k1pitch, k1col;
    const bf16* K2; int k2pitch;
    const bf16* V; int vpitch, vcol;
    bf16* O; int opitch, ocol;
    int b, ntiles;
};
template <int DK> __device__ __forceinline__ void attn_unit(const AttnArgs& A, LAS unsigned char* lds, int wave_) {
    constexpr int NKS = DK / 16, KSLOT = (DK / 8) * 1024, NKSLOT = 4, NVSLOT = 4; constexpr float THR = 8.f;
    constexpr bool NOMAX = (DK == 64);
    constexpr int LDS_K = 0, LDS_V = NKSLOT * KSLOT, LDS_WS = LDS_V + NVSLOT * VSLOT;
    int tid = wave_ * 64 + lane_id(); asm volatile("" : "+v"(tid));
    const int lane = tid & 63, r32 = lane & 31, hi = lane >> 5; const int wid = __builtin_amdgcn_readfirstlane(tid >> 6);
    const unsigned lds0 = (unsigned)(uintptr_t)lds;
    LAS float* wsf = (LAS float*)(lds + LDS_WS) + wid * 64;
    const int NT = A.ntiles, b = A.b;
#define TILE_ROW(j) ((j) < 4 ? (long)(NLAT + b * CTXL + 64 * (j)) : (long)(b * SEQ + 64 * ((j) - 4)))
#define DMA_K(j) do { const long r0_ = TILE_ROW(j); const int s_ = (j) & 3; \
        glds16(A.K1 + (r0_ + lane) * A.k1pitch + A.k1col + wid * 8, (unsigned)__builtin_amdgcn_readfirstlane(lds0 + LDS_K + s_ * KSLOT + wid * 1024)); \
        if (DK == 96 && wid < 4) glds16(A.K2 + (r0_ + lane) * A.k2pitch + wid * 8, (unsigned)__builtin_amdgcn_readfirstlane(lds0 + LDS_K + s_ * KSLOT + (8 + wid) * 1024)); } while (0)
#define DMA_V(j) do { const long r0_ = TILE_ROW(j); const int s_ = (j) & 3; \
        glds16(A.V + (r0_ + 16 * (wid & 3) + (lane >> 2)) * A.vpitch + A.vcol + (wid >> 2) * 32 + (lane & 3) * 8, (unsigned)__builtin_amdgcn_readfirstlane(lds0 + LDS_V + (s_) * VSLOT + wid * 1024)); } while (0)
#define WAITBAR(n) asm volatile("s_waitcnt vmcnt(" #n ") lgkmcnt(0)\n\ts_barrier" ::: "memory")
#define WAIT_CNT(cnt) do { const int c_ = (cnt); if (c_ >= 3) WAITBAR(3); else if (c_ == 2) WAITBAR(2); else if (c_ == 1) WAITBAR(1); else WAITBAR(0); } while (0)
#define QK(S0, S1, slot) do { const LAS unsigned char* Ks_ = lds + LDS_K + (slot) * KSLOT + hi * 1024 + r32 * 16; \
        _Pragma("unroll") for (int ks = 0; ks < NKS; ++ks) { const bf16x8 k0_ = *(const LAS bf16x8*)(Ks_ + ks * 2048), k1_ = *(const LAS bf16x8*)(Ks_ + ks * 2048 + 512); \
            S0 = __builtin_amdgcn_mfma_f32_32x32x16_bf16(k0_, qr[ks], ks == 0 ? (NOMAX ? f32x16{} : negm) : S0, 0, 0, 0); S1 = __builtin_amdgcn_mfma_f32_32x32x16_bf16(k1_, qr[ks], ks == 0 ? (NOMAX ? f32x16{} : negm) : S1, 0, 0, 0); } } while (0)
    const int nK = (DK == 96 && wid < 4) ? 2 : 1;
    bf16x8 qr[NKS];
    { const bf16* Qw = A.Q + (A.qrow0 + wid * 32 + r32) * A.qpitch + A.qcol + hi * 8;
#pragma unroll
      for (int ks = 0; ks < NKS; ++ks) qr[ks] = *(const bf16x8*)(Qw + ks * 16); }
    asm volatile("s_waitcnt vmcnt(0)" ::: "memory");
    DMA_K(0); DMA_V(0); DMA_K(1); DMA_K(2); DMA_V(1);
    float mref = 0.f, lsum = 0.f; f32x16 o[2]; o[0] = f32x16{}; o[1] = f32x16{};
    f32x16 negm = f32x16{};
    const int vb = (4 * hi + ((lane & 15) >> 2)) * 64 + ((lane >> 4) & 1) * 32 + (lane & 3) * 8;
    f32x16 s0, s1;
    WAITBAR(0);
    QK(s0, s1, 0);
    if constexpr (!NOMAX) { float rm = __builtin_fmaxf(s0[0], s1[0]);
#pragma unroll
      for (int r = 1; r < 16; ++r) rm = __builtin_fmaxf(__builtin_fmaxf(rm, s0[r]), s1[r]);
      rm = swap32_max(rm); mref = rm;
#pragma unroll
      for (int r = 0; r < 16; ++r) { s0[r] -= rm; s1[r] -= rm; negm[r] = -rm; } }
    int vslot = 0;
#define HEAD(t) do { WAITBAR(0);        \
        if ((t) + 3 < NT) DMA_K((t) + 3); if ((t) + 4 < NT) DMA_K((t) + 4); \
        if ((t) + 2 < NT) DMA_V((t) + 2); if ((t) + 3 < NT) DMA_V((t) + 3); } while (0)
#define QKP(N0, N1, t) do { if ((t) + 1 < NT) { const LAS unsigned char* Ks_ = lds + LDS_K + (((t) + 1) & 3) * KSLOT + hi * 1024 + r32 * 16; \
            _Pragma("unroll") for (int kh = 0; kh < 2; ++kh) { bf16x8 kf[NKS]; \
                _Pragma("unroll") for (int k2 = 0; k2 < NKS / 2; ++k2) { const int ks = kh * (NKS / 2) + k2; kf[2 * k2] = *(const LAS bf16x8*)(Ks_ + ks * 2048); kf[2 * k2 + 1] = *(const LAS bf16x8*)(Ks_ + ks * 2048 + 512); } \
                __builtin_amdgcn_s_setprio(1); \
                _Pragma("unroll") for (int k2 = 0; k2 < NKS / 2; ++k2) { const int ks = kh * (NKS / 2) + k2; \
                    N0 = __builtin_amdgcn_mfma_f32_32x32x16_bf16(kf[2 * k2], qr[ks], ks == 0 ? (NOMAX ? f32x16{} : negm) : N0, 0, 0, 0); N1 = __builtin_amdgcn_mfma_f32_32x32x16_bf16(kf[2 * k2 + 1], qr[ks], ks == 0 ? (NOMAX ? f32x16{} : negm) : N1, 0, 0, 0); } \
                __builtin_amdgcn_s_setprio(0); } } } while (0)
#define SMP(C0, C1, N0, N1, t, NREADY) do { if constexpr (!NOMAX) { \
        float rm = __builtin_fmaxf(C0[0], C1[0]); \
        _Pragma("unroll") for (int r = 1; r < 16; ++r) rm = __builtin_fmaxf(__builtin_fmaxf(rm, C0[r]), C1[r]); \
        rm = swap32_max(rm); \
        if (__builtin_expect(__any(rm > THR), 0)) { \
            const float dl = __builtin_fmaxf(rm, 0.f), al = __builtin_amdgcn_exp2f(-dl); \
            mref += dl; lsum *= al; \
            _Pragma("unroll") for (int r = 0; r < 16; ++r) { C0[r] -= dl; C1[r] -= dl; negm[r] = -mref; } \
            if (NREADY && (t) + 1 < NT) { _Pragma("unroll") for (int r = 0; r < 16; ++r) { N0[r] -= dl; N1[r] -= dl; } } \
            if (hi == 0) wsf[r32] = al; \
            asm volatile("s_waitcnt lgkmcnt(0)" ::: "memory"); \
            _Pragma("unroll") for (int rq = 0; rq < 4; ++rq) { const f32x4 a4 = *(const LAS f32x4*)(wsf + 8 * rq + 4 * hi); \
                _Pragma("unroll") for (int j = 0; j < 4; ++j) { o[0][4 * rq + j] *= a4[j]; o[1][4 * rq + j] *= a4[j]; } } \
        } } \
        float ps0 = 0.f, ps1 = 0.f, ps2 = 0.f, ps3 = 0.f; \
        _Pragma("unroll") for (int r = 0; r < 16; r += 2) { C0[r] = __builtin_amdgcn_exp2f(C0[r]); C1[r] = __builtin_amdgcn_exp2f(C1[r]); C0[r + 1] = __builtin_amdgcn_exp2f(C0[r + 1]); C1[r + 1] = __builtin_amdgcn_exp2f(C1[r + 1]); \
            ps0 += C0[r]; ps1 += C1[r]; ps2 += C0[r + 1]; ps3 += C1[r + 1]; } \
        lsum += (ps0 + ps1) + (ps2 + ps3); \
        pw[0] = (u32x4){pk2(C0[0], C0[1]), pk2(C0[2], C0[3]), pk2(C0[4], C0[5]), pk2(C0[6], C0[7])}; \
        pw[1] = (u32x4){pk2(C0[8], C0[9]), pk2(C0[10], C0[11]), pk2(C0[12], C0[13]), pk2(C0[14], C0[15])}; \
        pw[2] = (u32x4){pk2(C1[0], C1[1]), pk2(C1[2], C1[3]), pk2(C1[4], C1[5]), pk2(C1[6], C1[7])}; \
        pw[3] = (u32x4){pk2(C1[8], C1[9]), pk2(C1[10], C1[11]), pk2(C1[12], C1[13]), pk2(C1[14], C1[15])}; } while (0)
#define PVP() do { const LAS unsigned char* Vs = lds + LDS_V + vslot * VSLOT + vb; \
        _Pragma("unroll") for (int d0 = 0; d0 < 2; ++d0) { s16x4 vlo[4], vhh[4]; \
            _Pragma("unroll") for (int i = 0; i < 4; ++i) { vlo[i] = vtr(Vs + d0 * 4096 + i * 1024); vhh[i] = vtr(Vs + d0 * 4096 + i * 1024 + 512); } \
            __builtin_amdgcn_s_setprio(1); \
            _Pragma("unroll") for (int ks = 0; ks < 4; ++ks) { \
                const bf16x8 vf = (bf16x8){vlo[ks][0], vlo[ks][1], vlo[ks][2], vlo[ks][3], vhh[ks][0], vhh[ks][1], vhh[ks][2], vhh[ks][3]}; \
                o[d0] = __builtin_amdgcn_mfma_f32_32x32x16_bf16(__builtin_bit_cast(bf16x8, pw[ks]), vf, o[d0], 0, 0, 0); } \
            __builtin_amdgcn_s_setprio(0); } \
        vslot = (vslot + 1) & 3; } while (0)
    f32x16 n0, n1; u32x4 pw[4];
    if (wid < 8) {
        for (int t = 0; t < NT; t += 2) {
            HEAD(t); QKP(n0, n1, t); SMP(s0, s1, n0, n1, t, 1); PVP();
            QKP(s0, s1, t + 1); SMP(n0, n1, s0, s1, t + 1, 1); PVP(); }
    } else {
        for (int t = 0; t < NT; t += 2) {
            HEAD(t); SMP(s0, s1, n0, n1, t, 0); PVP(); QKP(n0, n1, t);
            SMP(n0, n1, s0, s1, t + 1, 0); PVP(); QKP(s0, s1, t + 1); }
    }
#undef HEAD
#undef QKP
#undef SMP
#undef PVP
    lsum = swap32_sum(lsum);
    if (hi == 0) wsf[32 + r32] = __builtin_amdgcn_rcpf(lsum);
    asm volatile("s_waitcnt vmcnt(0) lgkmcnt(0)\n\ts_barrier" ::: "memory");
    { LAS bf16* stg = (LAS bf16*)(lds + wid * 4096);
#pragma unroll
      for (int rq = 0; rq < 4; ++rq) { const f32x4 i4 = *(const LAS f32x4*)(wsf + 32 + 8 * rq + 4 * hi);
#pragma unroll
          for (int j = 0; j < 4; ++j) { const int q = 8 * rq + 4 * hi + j;
              stg[q * 64 + r32] = (bf16)f2bf(o[0][4 * rq + j] * i4[j]); stg[q * 64 + 32 + r32] = (bf16)f2bf(o[1][4 * rq + j] * i4[j]); } }
      asm volatile("s_waitcnt lgkmcnt(0)" ::: "memory");
      bf16* Ow = A.O + (A.qrow0 + wid * 32) * A.opitch + A.ocol;
#pragma unroll
      for (int i = 0; i < 4; ++i) { const int row = i * 8 + (lane >> 3), ch = lane & 7; *(u32x4*)(Ow + (long)row * A.opitch + ch * 8) = *(const LAS u32x4*)(stg + row * 64 + ch * 8); } }
    asm volatile("s_waitcnt vmcnt(0) lgkmcnt(0)\n\ts_barrier" ::: "memory");
#undef TILE_ROW
#undef DMA_K
#undef DMA_V
#undef WAITBAR
#undef WAIT_CNT
#undef QK
}

template <int DK> __device__ __forceinline__ void attn_unit3(const AttnArgs& A, LAS unsigned char* lds, int wave_) {
    constexpr int NKS = DK / 16, KSLOT = (DK / 8) * 1024, NKSLOT = 4, NVSLOT = 4;
    constexpr int LDS_K = 0, LDS_V = NKSLOT * KSLOT, LDS_WS = LDS_V + NVSLOT * VSLOT;
    int tid = wave_ * 64 + lane_id(); asm volatile("" : "+v"(tid));
    const int lane = tid & 63, r32 = lane & 31, hi = lane >> 5; const int wid = __builtin_amdgcn_readfirstlane(tid >> 6);
    const unsigned lds0 = (unsigned)(uintptr_t)lds;
    LAS float* wsf = (LAS float*)(lds + LDS_WS) + wid * 64;
    const int NT = A.ntiles, b = A.b;
#define TILE_ROW(j) ((j) < 4 ? (long)(NLAT + b * CTXL + 64 * (j)) : (long)(b * SEQ + 64 * ((j) - 4)))
#define DMA_K(j) do { const long r0_ = TILE_ROW(j); const int s_ = (j) & 3; \
        glds16(A.K1 + (r0_ + lane) * A.k1pitch + A.k1col + wid * 8, (unsigned)__builtin_amdgcn_readfirstlane(lds0 + LDS_K + s_ * KSLOT + wid * 1024)); \
        if (DK == 96 && wid < 4) glds16(A.K2 + (r0_ + lane) * A.k2pitch + wid * 8, (unsigned)__builtin_amdgcn_readfirstlane(lds0 + LDS_K + s_ * KSLOT + (8 + wid) * 1024)); } while (0)
#define DMA_V(j) do { const long r0_ = TILE_ROW(j); const int s_ = (j) & 3; \
        glds16(A.V + (r0_ + 16 * (wid & 3) + (lane >> 2)) * A.vpitch + A.vcol + (wid >> 2) * 32 + (lane & 3) * 8, (unsigned)__builtin_amdgcn_readfirstlane(lds0 + LDS_V + (s_) * VSLOT + wid * 1024)); } while (0)
#define WAITBAR(n) asm volatile("s_waitcnt vmcnt(" #n ") lgkmcnt(0)\n\ts_barrier" ::: "memory")
    bf16x8 qr[NKS];
    { const bf16* Qw = A.Q + (A.qrow0 + wid * 32 + r32) * A.qpitch + A.qcol + hi * 8;
#pragma unroll
      for (int ks = 0; ks < NKS; ++ks) qr[ks] = *(const bf16x8*)(Qw + ks * 16); }
    asm volatile("s_waitcnt vmcnt(0)" ::: "memory");
    DMA_K(0); DMA_K(1); DMA_V(0); DMA_K(2); DMA_K(3); DMA_V(1);
    float ls0 = 0.f, ls1 = 0.f, ls2 = 0.f, ls3 = 0.f; f32x16 o[2]; o[0] = f32x16{}; o[1] = f32x16{};
    const int vb = (4 * hi + ((lane & 15) >> 2)) * 64 + ((lane >> 4) & 1) * 32 + (lane & 3) * 8;
    const LAS unsigned char* Kb = lds + LDS_K + hi * 1024 + r32 * 16;
    const LAS unsigned char* Vb = lds + LDS_V + vb;
#define QKH(S0, S1, j, kh) do { const LAS unsigned char* Ks_ = Kb + ((j) & 3) * KSLOT; bf16x8 kf[NKS]; \
        _Pragma("unroll") for (int k2 = 0; k2 < NKS / 2; ++k2) { const int ks = (kh) * (NKS / 2) + k2; kf[2 * k2] = *(const LAS bf16x8*)(Ks_ + ks * 2048); kf[2 * k2 + 1] = *(const LAS bf16x8*)(Ks_ + ks * 2048 + 512); } \
        _Pragma("unroll") for (int k2 = 0; k2 < NKS / 2; ++k2) { const int ks = (kh) * (NKS / 2) + k2; \
            S0 = __builtin_amdgcn_mfma_f32_32x32x16_bf16(kf[2 * k2], qr[ks], ks == 0 ? f32x16{} : S0, 0, 0, 0); S1 = __builtin_amdgcn_mfma_f32_32x32x16_bf16(kf[2 * k2 + 1], qr[ks], ks == 0 ? f32x16{} : S1, 0, 0, 0); } } while (0)
#define PVH(PW, j, d0) do { const LAS unsigned char* Vs_ = Vb + ((j) & 3) * VSLOT + (d0) * 4096; s16x4 vlo[4], vhh[4]; \
        _Pragma("unroll") for (int i = 0; i < 4; ++i) { vlo[i] = vtr(Vs_ + i * 1024); vhh[i] = vtr(Vs_ + i * 1024 + 512); } \
        _Pragma("unroll") for (int ks = 0; ks < 4; ++ks) { const bf16x8 vf = (bf16x8){vlo[ks][0], vlo[ks][1], vlo[ks][2], vlo[ks][3], vhh[ks][0], vhh[ks][1], vhh[ks][2], vhh[ks][3]}; \
            o[d0] = __builtin_amdgcn_mfma_f32_32x32x16_bf16(__builtin_bit_cast(bf16x8, PW[ks]), vf, o[d0], 0, 0, 0); } } while (0)
#define SOFT(C0, C1, PW) do { \
        _Pragma("unroll") for (int r = 0; r < 16; r += 2) { C0[r] = __builtin_amdgcn_exp2f(C0[r]); C1[r] = __builtin_amdgcn_exp2f(C1[r]); C0[r + 1] = __builtin_amdgcn_exp2f(C0[r + 1]); C1[r + 1] = __builtin_amdgcn_exp2f(C1[r + 1]); \
            ls0 += C0[r]; ls1 += C1[r]; ls2 += C0[r + 1]; ls3 += C1[r + 1]; } \
        PW[0] = (u32x4){pk2(C0[0], C0[1]), pk2(C0[2], C0[3]), pk2(C0[4], C0[5]), pk2(C0[6], C0[7])}; \
        PW[1] = (u32x4){pk2(C0[8], C0[9]), pk2(C0[10], C0[11]), pk2(C0[12], C0[13]), pk2(C0[14], C0[15])}; \
        PW[2] = (u32x4){pk2(C1[0], C1[1]), pk2(C1[2], C1[3]), pk2(C1[4], C1[5]), pk2(C1[6], C1[7])}; \
        PW[3] = (u32x4){pk2(C1[8], C1[9]), pk2(C1[10], C1[11]), pk2(C1[12], C1[13]), pk2(C1[14], C1[15])}; } while (0)
#define HINTS() do { _Pragma("unroll") for (int h_ = 0; h_ < 2; ++h_) { __builtin_amdgcn_sched_group_barrier(0x100, NKS + 8, 0); \
            _Pragma("unroll") for (int g_ = 0; g_ < NKS + 4; ++g_) { __builtin_amdgcn_sched_group_barrier(0x008, 1, 0); __builtin_amdgcn_sched_group_barrier(0x400, 2, 0); __builtin_amdgcn_sched_group_barrier(0x002, 3, 0); } } } while (0)
#define STEP3(N0, N1, C0, C1, PN, PC, t) do { __builtin_amdgcn_sched_barrier(0); \
        QKH(N0, N1, (t) + 2, 0); PVH(PC, t, 0); QKH(N0, N1, (t) + 2, 1); PVH(PC, t, 1); SOFT(C0, C1, PN); HINTS(); __builtin_amdgcn_sched_barrier(0); } while (0)
    f32x16 sA0, sA1, sB0, sB1; u32x4 pA[4], pB[4];
    WAITBAR(0);
    QKH(sA0, sA1, 0, 0); QKH(sA0, sA1, 0, 1); QKH(sB0, sB1, 1, 0); QKH(sB0, sB1, 1, 1);
    SOFT(sA0, sA1, pA);
    int t = 0;
    for (; t + 3 < NT; t += 2) {
        WAITBAR(0);
        if (t + 4 < NT) DMA_K(t + 4); if (t + 5 < NT) DMA_K(t + 5); if (t + 2 < NT) DMA_V(t + 2); if (t + 3 < NT) DMA_V(t + 3);
        STEP3(sA0, sA1, sB0, sB1, pB, pA, t);
        STEP3(sB0, sB1, sA0, sA1, pA, pB, t + 1);
    }
    WAITBAR(0);
    __builtin_amdgcn_sched_barrier(0);
    PVH(pA, t, 0); PVH(pA, t, 1); SOFT(sB0, sB1, pB);
    __builtin_amdgcn_sched_barrier(0);
    PVH(pB, t + 1, 0); PVH(pB, t + 1, 1);
    float lsum = (ls0 + ls1) + (ls2 + ls3);
    lsum = swap32_sum(lsum);
    if (hi == 0) wsf[32 + r32] = __builtin_amdgcn_rcpf(lsum);
    asm volatile("s_waitcnt vmcnt(0) lgkmcnt(0)\n\ts_barrier" ::: "memory");
    { LAS bf16* stg = (LAS bf16*)(lds + wid * 4096);
#pragma unroll
      for (int rq = 0; rq < 4; ++rq) { const f32x4 i4 = *(const LAS f32x4*)(wsf + 32 + 8 * rq + 4 * hi);
#pragma unroll
          for (int j = 0; j < 4; ++j) { const int q = 8 * rq + 4 * hi + j;
              stg[q * 64 + r32] = (bf16)f2bf(o[0][4 * rq + j] * i4[j]); stg[q * 64 + 32 + r32] = (bf16)f2bf(o[1][4 * rq + j] * i4[j]); } }
      asm volatile("s_waitcnt lgkmcnt(0)" ::: "memory");
      bf16* Ow = A.O + (A.qrow0 + wid * 32) * A.opitch + A.ocol;
#pragma unroll
      for (int i = 0; i < 4; ++i) { const int row = i * 8 + (lane >> 3), ch = lane & 7; *(u32x4*)(Ow + (long)row * A.opitch + ch * 8) = *(const LAS u32x4*)(stg + row * 64 + ch * 8); } }
    asm volatile("s_waitcnt vmcnt(0) lgkmcnt(0)\n\ts_barrier" ::: "memory");
#undef TILE_ROW
#undef DMA_K
#undef DMA_V
#undef WAITBAR
#undef QKH
#undef PVH
#undef SOFT
#undef HINTS
#undef STEP3
}

#define ASBAR() __builtin_amdgcn_sched_barrier(0)
#define APIN(x) asm volatile("" : "+v"(x))
template <int DK> __device__ __forceinline__ void attn_unit4(const AttnArgs& A, LAS unsigned char* lds, int wave_) {
    constexpr int NKS = DK / 16, KSLOT = (DK / 8) * 1024, NKSLOT = 4, NVSLOT = 4;
    constexpr int LDS_K = 0, LDS_V = NKSLOT * KSLOT, LDS_WS = LDS_V + NVSLOT * VSLOT;
    int tid = wave_ * 64 + lane_id(); asm volatile("" : "+v"(tid));
    const int lane = tid & 63, r32 = lane & 31, hi = lane >> 5; const int wid = __builtin_amdgcn_readfirstlane(tid >> 6);
    const unsigned lds0 = (unsigned)(uintptr_t)lds;
    LAS float* wsf = (LAS float*)(lds + LDS_WS) + wid * 64;
    const int NT = A.ntiles, b = A.b;
#define TILE_ROW(j) ((j) < 4 ? (long)(NLAT + b * CTXL + 64 * (j)) : (long)(b * SEQ + 64 * ((j) - 4)))
#define DMA_K(j) do { const long r0_ = TILE_ROW(j); const int s_ = (j) & 3; \
        glds16(A.K1 + (r0_ + lane) * A.k1pitch + A.k1col + wid * 8, (unsigned)__builtin_amdgcn_readfirstlane(lds0 + LDS_K + s_ * KSLOT + wid * 1024)); \
        if (DK == 96 && wid < 4) glds16(A.K2 + (r0_ + lane) * A.k2pitch + wid * 8, (unsigned)__builtin_amdgcn_readfirstlane(lds0 + LDS_K + s_ * KSLOT + (8 + wid) * 1024)); } while (0)
#define DMA_V(j) do { const long r0_ = TILE_ROW(j); const int s_ = (j) & 3; \
        glds16(A.V + (r0_ + 16 * (wid & 3) + (lane >> 2)) * A.vpitch + A.vcol + (wid >> 2) * 32 + (lane & 3) * 8, (unsigned)__builtin_amdgcn_readfirstlane(lds0 + LDS_V + (s_) * VSLOT + wid * 1024)); } while (0)
#define WAITBAR(n) asm volatile("s_waitcnt vmcnt(" #n ") lgkmcnt(0)\n\ts_barrier" ::: "memory")
    bf16x8 qr[NKS];
    { const bf16* Qw = A.Q + (A.qrow0 + wid * 32 + r32) * A.qpitch + A.qcol + hi * 8;
#pragma unroll
      for (int ks = 0; ks < NKS; ++ks) qr[ks] = *(const bf16x8*)(Qw + ks * 16); }
    DMA_K(0); DMA_K(1); DMA_V(0); DMA_K(2); DMA_K(3); DMA_V(1);
    float lsum = 0.f; f32x16 o[2]; o[0] = f32x16{}; o[1] = f32x16{};
    const LAS unsigned char* Kb = lds + LDS_K + hi * 1024 + r32 * 16;
    const LAS unsigned char* Vb = lds + LDS_V + (4 * hi + ((lane & 15) >> 2)) * 64 + ((lane >> 4) & 1) * 32 + (lane & 3) * 8;
    f32x16 pA0, pA1, pB0, pB1; bf16x8 kf[2 * NKS]; s16x4 vlo[8], vhi[8]; u32x4 pw0, pw1, pw2, pw3;
#define MF(a, b, c) __builtin_amdgcn_mfma_f32_32x32x16_bf16(a, b, c, 0, 0, 0)
#define KLD2(kp, d0) do { kf[2 * (d0)] = *(const LAS bf16x8*)((kp) + (d0) * 2048); kf[2 * (d0) + 1] = *(const LAS bf16x8*)((kp) + (d0) * 2048 + 512); } while (0)
#define PKW(P, i) pk2(P[i], P[(i) + 1])
#define PAF(k) __builtin_bit_cast(bf16x8, pw##k)
#define VFR(i) (bf16x8){vlo[i][0], vlo[i][1], vlo[i][2], vlo[i][3], vhi[i][0], vhi[i][1], vhi[i][2], vhi[i][3]}
#define VRD(i) do { vlo[i] = vtr(vp_ + (((i) >> 2) * 4096 + ((i) & 3) * 1024)); vhi[i] = vtr(vp_ + (((i) >> 2) * 4096 + ((i) & 3) * 1024 + 512)); } while (0)
#define KRD(G, d0) do { if (G) { KLD2(kn_, d0); ASBAR(); } } while (0)
#define EX(v) __builtin_amdgcn_exp2f(v)
#define GAPA(MFS, a0, a1, a2, a3, W0, W1, PW) do { MFS; sacc += a0; sacc += a1; sacc += a2; sacc += a3; W0; W1; APIN(PW); APIN(sacc); ASBAR(); } while (0)
#define GAPB(MFS, X, i) do { MFS; X[i] = EX(X[i]); X[(i) + 1] = EX(X[(i) + 1]); X[(i) + 2] = EX(X[(i) + 2]); X[(i) + 3] = EX(X[(i) + 3]); APIN(X); ASBAR(); } while (0)
#define STEP4(C0, C1, P0, P1, t, GL) do { ASBAR(); \
    const LAS unsigned char* vp_ = Vb + (((t) - 1) & 3) * VSLOT; const LAS unsigned char* kn_ = Kb + (((t) + 1) & 3) * KSLOT; \
    VRD(0); ASBAR(); float sacc = P0[0] + P0[1]; \
                     GAPA(C0 = MF(kf[0], qr[0], f32x16{}), P0[2], P0[3], P0[4], P0[5],     pw0[0] = PKW(P0, 0),  pw0[1] = PKW(P0, 2),  pw0); \
    VRD(4); ASBAR(); GAPA(C1 = MF(kf[1], qr[0], f32x16{}), P0[6], P0[7], P0[8], P0[9],     pw0[2] = PKW(P0, 4),  pw0[3] = PKW(P0, 6),  pw0); \
    VRD(1); ASBAR(); GAPA(C0 = MF(kf[2], qr[1], C0),       P0[10], P0[11], P0[12], P0[13], pw1[0] = PKW(P0, 8),  pw1[1] = PKW(P0, 10), pw1); \
    VRD(5); ASBAR(); GAPA(C1 = MF(kf[3], qr[1], C1),       P0[14], P0[15], P1[0], P1[1],   pw1[2] = PKW(P0, 12), pw1[3] = PKW(P0, 14), pw1); \
    VRD(2); ASBAR(); GAPA(C0 = MF(kf[4], qr[2], C0),       P1[2], P1[3], P1[4], P1[5],     pw2[0] = PKW(P1, 0),  pw2[1] = PKW(P1, 2),  pw2); \
    VRD(6); ASBAR(); GAPA(C1 = MF(kf[5], qr[2], C1),       P1[6], P1[7], P1[8], P1[9],     pw2[2] = PKW(P1, 4),  pw2[3] = PKW(P1, 6),  pw2); \
    VRD(3); ASBAR(); GAPA(C0 = MF(kf[6], qr[3], C0),       P1[10], P1[11], P1[12], P1[13], pw3[0] = PKW(P1, 8),  pw3[1] = PKW(P1, 10), pw3); \
    VRD(7); ASBAR(); GAPA(C1 = MF(kf[7], qr[3], C1),       P1[14], P1[15], 0.f, 0.f,       pw3[2] = PKW(P1, 12), pw3[3] = PKW(P1, 14), pw3); \
    if (NKS == 6) { C0 = MF(kf[2 * (NKS - 2)], qr[NKS - 2], C0); C1 = MF(kf[2 * (NKS - 2) + 1], qr[NKS - 2], C1); C0 = MF(kf[2 * (NKS - 1)], qr[NKS - 1], C0); C1 = MF(kf[2 * (NKS - 1) + 1], qr[NKS - 1], C1); ASBAR(); } \
    lsum += sacc; ASBAR(); \
    GAPB(o[0] = MF(PAF(0), VFR(0), o[0]), C0, 0);               KRD((GL) && NKS == 6, 4); GAPB(o[1] = MF(PAF(0), VFR(4), o[1]), C0, 4); \
    KRD(GL, 0); GAPB(o[0] = MF(PAF(1), VFR(1), o[0]), C0, 8);   KRD(GL, 1); GAPB(o[1] = MF(PAF(1), VFR(5), o[1]), C0, 12); \
    KRD(GL, 2); GAPB(o[0] = MF(PAF(2), VFR(2), o[0]), C1, 0);   KRD(GL, 3); GAPB(o[1] = MF(PAF(2), VFR(6), o[1]), C1, 4); \
    KRD((GL) && NKS == 6, 5); GAPB(o[0] = MF(PAF(3), VFR(3), o[0]), C1, 8);   GAPB(o[1] = MF(PAF(3), VFR(7), o[1]), C1, 12); \
    } while (0)
    WAITBAR(0);
#pragma unroll
    for (int d0 = 0; d0 < NKS; ++d0) KLD2(Kb, d0);
#pragma unroll
    for (int d0 = 0; d0 < NKS; ++d0) { pA0 = MF(kf[2 * d0], qr[d0], d0 == 0 ? f32x16{} : pA0); pA1 = MF(kf[2 * d0 + 1], qr[d0], d0 == 0 ? f32x16{} : pA1); }
#pragma unroll
    for (int r = 0; r < 16; ++r) { pA0[r] = EX(pA0[r]); pA1[r] = EX(pA1[r]); }
#pragma unroll
    for (int d0 = 0; d0 < NKS; ++d0) KLD2(Kb + KSLOT, d0);
    int t = 1;
    for (; t + 2 < NT; t += 2) {
        WAITBAR(0);
        if (t + 3 < NT) DMA_K(t + 3); if (t + 4 < NT) DMA_K(t + 4); if (t + 1 < NT) DMA_V(t + 1); if (t + 2 < NT) DMA_V(t + 2);
        STEP4(pB0, pB1, pA0, pA1, t, true);
        STEP4(pA0, pA1, pB0, pB1, t + 1, true);
    }
    WAITBAR(0);
    STEP4(pB0, pB1, pA0, pA1, t, false);
    { ASBAR(); float sacc = pB0[0] + pB0[1];
#pragma unroll
      for (int r = 2; r < 16; ++r) sacc += pB0[r];
#pragma unroll
      for (int r = 0; r < 16; ++r) sacc += pB1[r];
      lsum += sacc;
      pw0 = (u32x4){PKW(pB0, 0), PKW(pB0, 2), PKW(pB0, 4), PKW(pB0, 6)}; pw1 = (u32x4){PKW(pB0, 8), PKW(pB0, 10), PKW(pB0, 12), PKW(pB0, 14)};
      pw2 = (u32x4){PKW(pB1, 0), PKW(pB1, 2), PKW(pB1, 4), PKW(pB1, 6)}; pw3 = (u32x4){PKW(pB1, 8), PKW(pB1, 10), PKW(pB1, 12), PKW(pB1, 14)};
      const LAS unsigned char* vp_ = Vb + (t & 3) * VSLOT;
#pragma unroll
      for (int i = 0; i < 8; ++i) VRD(i);
      o[0] = MF(PAF(0), VFR(0), o[0]); o[1] = MF(PAF(0), VFR(4), o[1]); o[0] = MF(PAF(1), VFR(1), o[0]); o[1] = MF(PAF(1), VFR(5), o[1]);
      o[0] = MF(PAF(2), VFR(2), o[0]); o[1] = MF(PAF(2), VFR(6), o[1]); o[0] = MF(PAF(3), VFR(3), o[0]); o[1] = MF(PAF(3), VFR(7), o[1]); }
    lsum = swap32_sum(lsum);
    if (hi == 0) wsf[32 + r32] = __builtin_amdgcn_rcpf(lsum);
    asm volatile("s_waitcnt vmcnt(0) lgkmcnt(0)\n\ts_barrier" ::: "memory");
    { LAS bf16* stg = (LAS bf16*)(lds + wid * 4096);
#pragma unroll
      for (int rq = 0; rq < 4; ++rq) { const f32x4 i4 = *(const LAS f32x4*)(wsf + 32 + 8 * rq + 4 * hi);
#pragma unroll
          for (int j = 0; j < 4; ++j) { const int q = 8 * rq + 4 * hi + j;
              stg[q * 64 + r32] = (bf16)f2bf(o[0][4 * rq + j] * i4[j]); stg[q * 64 + 32 + r32] = (bf16)f2bf(o[1][4 * rq + j] * i4[j]); } }
      asm volatile("s_waitcnt lgkmcnt(0)" ::: "memory");
      bf16* Ow = A.O + (A.qrow0 + wid * 32) * A.opitch + A.ocol;
#pragma unroll
      for (int i = 0; i < 4; ++i) { const int row = i * 8 + (lane >> 3), ch = lane & 7; *(u32x4*)(Ow + (long)row * A.opitch + ch * 8) = *(const LAS u32x4*)(stg + row * 64 + ch * 8); } }
    asm volatile("s_waitcnt vmcnt(0) lgkmcnt(0)\n\ts_barrier" ::: "memory");
#undef TILE_ROW
#undef DMA_K
#undef DMA_V
#undef WAITBAR
#undef MF
#undef KLD2
#undef PKW
#undef PAF
#undef VFR
#undef VRD
#undef KRD
#undef EX
#undef GAPA
#undef GAPB
#undef STEP4
}
#undef ASBAR
#undef APIN
}

namespace s5 {
constexpr int NCH = LPOS / 16;
constexpr int M_MC = 0, M_WCF = 65536, M_WCB = 65536 + 32768, M_WSF = 131072, M_WSB = 131072 + 32768, M_TOTAL = 196608;
constexpr int LDS_E = 18 * 4096;

struct Params { const float *lam_re, *lam_im, *log_dt, *b_re, *b_im, *c_re, *c_im, *dsk; };

__device__ __forceinline__ void build_mats(const Params& P, int l, int g, bf16* out, LAS unsigned char* lds, int wave_) {
    LAS f32x2* apow = (LAS f32x2*)lds;
    LAS f32x2* Bb = apow + 2 * 64 * 17;
    LAS f32x2* Cc = Bb + 2 * 64 * 16;
    LAS float* Kt = (LAS float*)(Cc + 2 * 16 * 64);
    constexpr int KTL = 260, KTD = 16 * KTL;
    const int tid = wave_ * 64 + lane_id();
    LAS float* lamv = Kt + 2 * KTD;
    LAS float* dskv = lamv + 512;
    f32x2 cv[4], bv[4];
#pragma unroll
    for (int m = 0; m < 4; ++m) { const int i = tid + NTHREADS * m; { const int dir = i >> 10, hp = (i >> 6) & 15, p = i & 63; const size_t ci = ((size_t)((l * 2 + dir) * 32 + g) * 16 + hp) * 64 + p; cv[m] = (f32x2){P.c_re[ci], P.c_im[ci]}; }
        { const int dir = i >> 10, p = (i >> 4) & 63, h = i & 15, pi = ((l * 2 + dir) * 32 + g) * 64 + p; bv[m] = (f32x2){P.b_re[(size_t)pi * 16 + h], P.b_im[(size_t)pi * 16 + h]}; } }
    if (tid < 128) { const int dir = tid >> 6, p = tid & 63, pi = ((l * 2 + dir) * 32 + g) * 64 + p;
        lamv[4 * tid] = fminf(P.lam_re[pi], -1e-4f); lamv[4 * tid + 1] = P.lam_im[pi]; lamv[4 * tid + 2] = expf(P.log_dt[(l * 2 + dir) * 32 + g]); }
    else if (tid < 144) dskv[tid - 128] = P.dsk[(l * 32 + g) * 16 + tid - 128];
#pragma unroll
    for (int m = 0; m < 4; ++m) Cc[tid + NTHREADS * m] = cv[m];
    __syncthreads();
    for (int i = tid; i < 2 * 64 * 17; i += NTHREADS) {
        const int dir = i / (64 * 17), r = i - dir * (64 * 17), p = r / 17, j = r - p * 17;
        const float lr = lamv[4 * (dir * 64 + p)], li = lamv[4 * (dir * 64 + p) + 1], dt = lamv[4 * (dir * 64 + p) + 2];
        const float mag = expf((float)j * lr * dt), ang = (float)j * li * dt; apow[i] = (f32x2){mag * cosf(ang), mag * sinf(ang)}; }
#pragma unroll
    for (int m = 0; m < 4; ++m) {
        const int i = tid + NTHREADS * m, dir = i >> 10, p = (i >> 4) & 63;
        const float lr = lamv[4 * (dir * 64 + p)], li = lamv[4 * (dir * 64 + p) + 1], dt = lamv[4 * (dir * 64 + p) + 2];
        const float abr = expf(lr * dt) * cosf(li * dt), abi = expf(lr * dt) * sinf(li * dt), den = lr * lr + li * li;
        const float fr = ((abr - 1.0f) * lr + abi * li) / den, fi = (abi * lr - (abr - 1.0f) * li) / den;
        const float br = bv[m].x, bi = bv[m].y; Bb[i] = (f32x2){fr * br - fi * bi, fr * bi + fi * br}; }
    __syncthreads();
    {
        const int dir = tid >> 8, j = (tid >> 4) & 15, hp0 = ((tid >> 2) & 3) * 4, h0 = (tid & 3) * 4; float sacc[4][4];
#pragma unroll
        for (int x = 0; x < 4; ++x)
#pragma unroll
            for (int y = 0; y < 4; ++y) sacc[x][y] = 0.f;
        for (int p = 0; p < 64; ++p) { const f32x2 a = apow[(dir * 64 + p) * 17 + j];
            const f32x2 c0_ = Cc[(dir * 16 + hp0) * 64 + p], c1_ = Cc[(dir * 16 + hp0 + 1) * 64 + p], c2_ = Cc[(dir * 16 + hp0 + 2) * 64 + p], c3_ = Cc[(dir * 16 + hp0 + 3) * 64 + p];
            const f32x4 c01 = {c0_.x, c0_.y, c1_.x, c1_.y}, c23 = {c2_.x, c2_.y, c3_.x, c3_.y};
            const f32x4 b01 = *(const LAS f32x4*)(Bb + (dir * 64 + p) * 16 + h0), b23 = *(const LAS f32x4*)(Bb + (dir * 64 + p) * 16 + h0 + 2);
            const float cx[4] = {c01[0], c01[2], c23[0], c23[2]}, cy[4] = {c01[1], c01[3], c23[1], c23[3]}, bx[4] = {b01[0], b01[2], b23[0], b23[2]}, by[4] = {b01[1], b01[3], b23[1], b23[3]};
#pragma unroll
            for (int x = 0; x < 4; ++x) { const float tr = cx[x] * a.x - cy[x] * a.y, ti = cx[x] * a.y + cy[x] * a.x;
#pragma unroll
                for (int y = 0; y < 4; ++y) sacc[x][y] += tr * bx[y] - ti * by[y]; } }
#pragma unroll
        for (int x = 0; x < 4; ++x) *(LAS f32x4*)(Kt + dir * KTD + j * KTL + (hp0 + x) * 16 + h0) = (f32x4){sacc[x][0], sacc[x][1], sacc[x][2], sacc[x][3]};
    }
    __syncthreads();
#pragma unroll 4
    for (int i = tid; i < 65536 / 8; i += NTHREADS) {
        const int row = i >> 5, c0 = (i & 31) * 8, t = row >> 4, hp = row & 15, s = c0 >> 4, h0 = c0 & 15; float v[8];
        const int lf = s <= t ? t - s : 0, lb = s >= t ? s - t : 0;
        const f32x4 f0 = *(const LAS f32x4*)(Kt + lf * KTL + hp * 16 + h0), f1 = *(const LAS f32x4*)(Kt + lf * KTL + hp * 16 + h0 + 4);
        const f32x4 b0 = *(const LAS f32x4*)(Kt + KTD + lb * KTL + hp * 16 + h0), b1 = *(const LAS f32x4*)(Kt + KTD + lb * KTL + hp * 16 + h0 + 4);
        const float wf = s <= t ? 1.f : 0.f, wb = s >= t ? 1.f : 0.f;
#pragma unroll
        for (int e = 0; e < 8; ++e) { const int h = h0 + e; float x = 0.f;
            if (s <= t) x += (e < 4 ? f0[e & 3] : f1[e & 3]);
            if (s >= t) x += (e < 4 ? b0[e & 3] : b1[e & 3]);
            if (s == t && h == hp) x += dskv[h];
            v[e] = x; }
        (void)wf; (void)wb;
        *(u32x4*)(out + M_MC + (size_t)row * 256 + c0) = pack8(v);
    }
#pragma unroll 4
    for (int i = tid; i < 2 * 32768 / 8; i += NTHREADS) {
        const int dir = i >> 12, ii = i & 4095, row = ii >> 4, c0 = (ii & 15) * 8, t = row >> 4, hp = row & 15, ex = dir == 0 ? t + 1 : 16 - t; float v[8];
#pragma unroll
        for (int e = 0; e < 8; e += 2) { const int p = (c0 + e) >> 1; const f32x2 c = Cc[(dir * 16 + hp) * 64 + p], a = apow[(dir * 64 + p) * 17 + ex];
            v[e] = c.x * a.x - c.y * a.y; v[e + 1] = -(c.x * a.y + c.y * a.x); }
        *(u32x4*)(out + (dir == 0 ? M_WCF : M_WCB) + (size_t)row * 128 + c0) = pack8(v);
    }
#pragma unroll 4
    for (int i = tid; i < 2 * 32768 / 8; i += NTHREADS) {
        const int dir = i >> 12, ii = i & 4095, row = ii >> 5, c0 = (ii & 31) * 8, p = row >> 1, im = row & 1, s = c0 >> 4, h0 = c0 & 15, ex = dir == 0 ? 15 - s : s; float v[8];
        const f32x2 a = apow[(dir * 64 + p) * 17 + ex];
#pragma unroll
        for (int e = 0; e < 8; ++e) { const f32x2 bb = Bb[(dir * 64 + p) * 16 + h0 + e]; v[e] = im ? (a.x * bb.y + a.y * bb.x) : (a.x * bb.x - a.y * bb.y); }
        *(u32x4*)(out + (dir == 0 ? M_WSF : M_WSB) + (size_t)row * 256 + c0) = pack8(v);
    }
    __syncthreads();
}

__device__ __forceinline__ void build_a16(const Params& P, float* a16, int gt, int ngt) {
    for (int pi = gt; pi < 2 * 2 * 32 * 64; pi += ngt) {
        const float lr = fminf(P.lam_re[pi], -1e-4f), li = P.lam_im[pi], dt = expf(P.log_dt[pi >> 6]);
        const float mag = expf(16.f * lr * dt), ang = 16.f * li * dt; a16[2 * pi] = mag * cosf(ang); a16[2 * pi + 1] = mag * sinf(ang); }
}
__device__ __forceinline__ void unit(const float* a16, int l, int b, int g, const bf16* Ug, const bf16* mats, bf16* Aglu, bool skip_ctx, LAS unsigned char* lds, int wave_, int half) {
    int tid = wave_ * 64 + lane_id(); asm volatile("" : "+v"(tid));
    const int lane = tid & 63, n = lane & 15, q = lane >> 4; const int wid = __builtin_amdgcn_readfirstlane(tid >> 6);
    LAS unsigned char* Ef = lds; LAS unsigned char* Eb = lds + LDS_E;
    const bf16* U = Ug + (size_t)(b * 32 + g) * LPOS * 16;
    const int rt = 8 * half + wid;
    f32x4 yi[17];
    {
        bf16x8 af[8], ab[8], am[8]; u32x4 st[4]; unsigned uoff[8];
#pragma unroll
        for (int ks = 0; ks < 8; ++ks) { af[ks] = *(const bf16x8*)(mats + M_WSF + (size_t)(16 * wid + n) * 256 + 32 * ks + 8 * q); ab[ks] = *(const bf16x8*)(mats + M_WSB + (size_t)(16 * wid + n) * 256 + 32 * ks + 8 * q);
            am[ks] = *(const bf16x8*)(mats + M_MC + (size_t)(16 * rt + n) * 256 + 32 * ks + 8 * q); }
        const bf16* ug = U + wid * 512 + lane * 8;
        const int ns = 2 * wid + (lane >> 5), js = lane & 31;
        const unsigned sdst = (ns < 8 ? 0u : (unsigned)LDS_E) + (ns & 7) * 512 + ((js ^ ns) << 4);
#pragma unroll
        for (int i = 0; i < 4; ++i) st[i] = *(const u32x4*)(ug + i * 4096);
#pragma unroll
        for (int ks = 0; ks < 8; ++ks) uoff[ks] = (n < 8 ? 0u : (unsigned)LDS_E) + (n & 7) * 512 + (((4 * ks + q) ^ n) << 4);
        *(LAS u32x4*)(lds + sdst + 4096) = st[0]; st[0] = *(const u32x4*)(ug + 4 * 4096);
        __syncthreads();
#pragma unroll
        for (int t = 0; t < 17; ++t) {
            bf16x8 ub[8];
#pragma unroll
            for (int ks = 0; ks < 8; ++ks) ub[ks] = *(const LAS bf16x8*)(lds + 4096 * (t + 1) + uoff[ks]);
            if (t + 1 < 17) { *(LAS u32x4*)(lds + sdst + 4096 * (t + 2)) = st[(t + 1) & 3]; if (t + 5 < 17) st[(t + 1) & 3] = *(const u32x4*)(ug + (t + 5) * 4096); }
            f32x4 cf = {0.f, 0.f, 0.f, 0.f}, cb = {0.f, 0.f, 0.f, 0.f}, cy = {0.f, 0.f, 0.f, 0.f};
#pragma unroll
            for (int ks = 0; ks < 8; ++ks) { cf = __builtin_amdgcn_mfma_f32_16x16x32_bf16(af[ks], ub[ks], cf, 0, 0, 0); cb = __builtin_amdgcn_mfma_f32_16x16x32_bf16(ab[ks], ub[ks], cb, 0, 0, 0);
                if (!(t == 0 && skip_ctx)) cy = __builtin_amdgcn_mfma_f32_16x16x32_bf16(am[ks], ub[ks], cy, 0, 0, 0); }
            yi[t] = cy;
            const int eo = (16 * t + n) * 256 + (((2 * wid + (q >> 1)) ^ n) << 4) + (q & 1) * 8;
            *(LAS u32x2*)(Ef + eo) = (u32x2){pk2(cf[0], cf[1]), pk2(cf[2], cf[3])};
            *(LAS u32x2*)(Eb + eo) = (u32x2){pk2(cb[0], cb[1]), pk2(cb[2], cb[3])};
            __syncthreads();
        }
    }
    bf16x8 wf[4], wb[4];
#pragma unroll
    for (int ks = 0; ks < 4; ++ks) { wf[ks] = *(const bf16x8*)(mats + M_WCF + (size_t)(16 * rt + n) * 128 + 32 * ks + 8 * q); wb[ks] = *(const bf16x8*)(mats + M_WCB + (size_t)(16 * rt + n) * 128 + 32 * ks + 8 * q); }
    if (wid < 2) {
        const int dir = wid, p = lane, pi = ((l * 2 + dir) * 32 + g) * 64 + p;
        const float ar = a16[2 * pi], ai = a16[2 * pi + 1];
        LAS unsigned* E32 = (LAS unsigned*)(dir ? Eb : Ef);
        float xr = 0.f, xi = 0.f;
#define S5_CH(st) (dir == 0 ? (st) : ((st) < 16 ? 15 - (st) : NCH + 15 - (st)))
#define S5_EW(k, j) (S5_CH(16 * (k) + (j)) * 64 + ((((p >> 2) ^ (dir == 0 ? (j) : 15 - (j))) << 2) | (p & 3)))
        unsigned ea[16], eb[16];
#pragma unroll
        for (int j = 0; j < 16; ++j) ea[j] = E32[S5_EW(0, j)];
        for (int k = 0; k < 17; k += 2) {
#pragma unroll
            for (int j = 0; j < 16; ++j) eb[j] = E32[S5_EW(k + 1 < 17 ? k + 1 : k, j)];
#pragma unroll
            for (int j = 0; j < 16; ++j) { const unsigned e = ea[j]; E32[S5_EW(k, j)] = pk2(xr, xi);
                const float er = bf2f(e & 0xffffu), ei = bf2f(e >> 16); const float nr = ar * xr - ai * xi + er, ni = ar * xi + ai * xr + ei; xr = nr; xi = ni; }
            if (k + 1 < 17) {
#pragma unroll
                for (int j = 0; j < 16; ++j) ea[j] = E32[S5_EW(k + 2 < 17 ? k + 2 : k + 1, j)];
#pragma unroll
                for (int j = 0; j < 16; ++j) { const unsigned e = eb[j]; E32[S5_EW(k + 1, j)] = pk2(xr, xi);
                    const float er = bf2f(e & 0xffffu), ei = bf2f(e >> 16); const float nr = ar * xr - ai * xi + er, ni = ar * xi + ai * xr + ei; xr = nr; xi = ni; }
            }
        }
#undef S5_EW
#undef S5_CH
    }
    __syncthreads();
    {
        unsigned xoff[4];
#pragma unroll
        for (int ks = 0; ks < 4; ++ks) xoff[ks] = n * 256 + (((q + 4 * ks) ^ n) << 4);
#pragma unroll
        for (int ct = 0; ct < 17; ++ct) {
            if (ct == 0 && skip_ctx) continue;
            int cto = ct; asm volatile("" : "+s"(cto));
            f32x4 acc = yi[ct];
#pragma unroll
            for (int ks = 0; ks < 4; ++ks) { acc = __builtin_amdgcn_mfma_f32_16x16x32_bf16(wf[ks], *(const LAS bf16x8*)(Ef + 4096 * cto + xoff[ks]), acc, 0, 0, 0);
                acc = __builtin_amdgcn_mfma_f32_16x16x32_bf16(wb[ks], *(const LAS bf16x8*)(Eb + 4096 * cto + xoff[ks]), acc, 0, 0, 0); }
            const int pos = (16 * cto + n) * 16 + rt;
            *(u32x2*)(Aglu + (size_t)pos_row(b, pos) * 512 + g * 16 + 4 * q) = (u32x2){pk2(fgelu_tanh(acc[0]), fgelu_tanh(acc[1])), pk2(fgelu_tanh(acc[2]), fgelu_tanh(acc[3]))};
        }
    }
    __syncthreads();
}
}

struct Ptrs {
    const float *x, *c, *ctx, *c_ctx, *w_mod, *b_mod, *g_mix_pre, *g_mix_post, *g_ffn_pre, *g_ffn_post, *w_in, *g_q, *g_k, *g_cq, *g_ckv, *w_uq, *w_ukv;
    s5::Params s5p;
    const float *w_glu, *w_branch, *w_mg, *b_mg, *w_out, *ffn_w1, *ffn_w3, *ffn_w2, *router_w, *router_b, *moe_w1, *moe_w3, *moe_w2;
    float* out; unsigned char* ws;
};

template <int MAP  >
__device__ __forceinline__ void transpose_item(const float* W, int K, int N, bf16* WT, int kb, int n0, int drow0, LAS float* scr, int lane) {
    const int k0 = 64 * kb;
#pragma unroll
    for (int i = 0; i < 8; ++i) { const int kk = 8 * i + (lane >> 3), c4 = 4 * (lane & 7); const f32x4 v = *(const f32x4*)(W + (size_t)(k0 + kk) * N + n0 + c4);
        LAS float* d = scr + kk * 33 + c4; d[0] = v[0]; d[1] = v[1]; d[2] = v[2]; d[3] = v[3]; }
    asm volatile("s_waitcnt lgkmcnt(0)" ::: "memory");
    const int c = lane & 7;
#pragma unroll
    for (int j = 0; j < 4; ++j) { const int n = (lane >> 3) + 8 * j; const LAS float* s = scr + (8 * c) * 33 + n;
        u32x4 o; o.x = pk2(s[0 * 33], s[1 * 33]); o.y = pk2(s[2 * 33], s[3 * 33]); o.z = pk2(s[4 * 33], s[5 * 33]); o.w = pk2(s[6 * 33], s[7 * 33]);
        int dr = n; if (MAP == 1) { const int i2 = n & 15; dr = 8 * (i2 >> 2) + (i2 & 3) + ((n >> 4) << 2); }
        *(u32x4*)(WT + (size_t)(drow0 + dr) * K + k0 + 8 * c) = o; }
    asm volatile("s_waitcnt lgkmcnt(0)" ::: "memory");
}

__device__ __forceinline__ void transpose_item_f8(const float* W, int K, int N, unsigned char* WT, int kb, int n0, int drow0, float wscale, LAS float* scr, int lane) {
    const int k0 = 64 * kb;
#pragma unroll
    for (int i = 0; i < 8; ++i) { const int kk = 8 * i + (lane >> 3), c4 = 4 * (lane & 7); const f32x4 v = *(const f32x4*)(W + (size_t)(k0 + kk) * N + n0 + c4);
        LAS float* d = scr + kk * 33 + c4; d[0] = v[0]; d[1] = v[1]; d[2] = v[2]; d[3] = v[3]; }
    asm volatile("s_waitcnt lgkmcnt(0)" ::: "memory");
    const int c = lane & 7;
#pragma unroll
    for (int j = 0; j < 4; ++j) { const int n = (lane >> 3) + 8 * j; const LAS float* s = scr + (8 * c) * 33 + n;
        u32x2 o; o.x = pg8::pk_fp8x4(s[0 * 33] * wscale, s[1 * 33] * wscale, s[2 * 33] * wscale, s[3 * 33] * wscale); o.y = pg8::pk_fp8x4(s[4 * 33] * wscale, s[5 * 33] * wscale, s[6 * 33] * wscale, s[7 * 33] * wscale);
        *(u32x2*)(WT + (size_t)(drow0 + n) * K + k0 + 8 * c) = o; }
    asm volatile("s_waitcnt lgkmcnt(0)" ::: "memory");
}
__device__ __forceinline__ int zmap(int n0) { return n0 < 512 ? n0 : n0 < 896 ? ZC_CQ + (n0 - 512) : n0 < 1024 ? ZC_KG + (n0 - 896) : n0 < 1152 ? ZC_VG + (n0 - 1024) : n0 < 1440 ? n0 : ZC_U + (n0 - 1440); }
__device__ __forceinline__ int pairmap(int n0, int second) { return 256 * (n0 >> 7) + (second ? 128 : 0) + (n0 & 127); }

__device__ __forceinline__ void transposes(const Ptrs& P, int gw, int ngw, LAS float* scr, int lane, int qsel = 0) {
    unsigned char* ws = P.ws;
    constexpr int I_WIN = 16 * 61, I_MG = 16 * 96, I_UQ = 6 * 24, I_UKV = 4 * 32, I_GLU = 8 * 32, I_BR = 8 * 32, I_OUT = 16 * 32, I_F13 = 16 * 88, I_F2 = 44 * 32;
    constexpr int PER_L = I_WIN + I_MG + I_UQ + I_UKV + I_GLU + 3 * I_BR + I_OUT;
    constexpr int N_L = 2 * PER_L, N_F = 2 * I_F13 + I_F2, N_M = 8 * (2 * I_F13 + I_F2), NITEMS = N_L + N_F + N_M;
    const int qx = (int)blockIdx.x & 7;
    unsigned* q = (unsigned*)(ws + WS_CTL) + CW_Q + 256 * qsel + 32 * qx; (void)gw; (void)ngw;
    for (;;) { int base = 0; if (lane == 0) base = (int)atomicAdd(q, 4u); base = __builtin_amdgcn_readfirstlane(base); if (base * 8 + qx + N_M >= NITEMS) break;
    for (int it_ = base; it_ < base + 4; ++it_) { const int it = it_ * 8 + qx + N_M; if (it >= NITEMS) break;
        int r = it;
        if (r < N_M) {
            const int e = r / (2 * I_F13 + I_F2); r -= e * (2 * I_F13 + I_F2);
            unsigned char* W1T = ws + WS_WM1T + (size_t)e * 5632 * 1024; unsigned char* W2T = ws + WS_WM2T + (size_t)e * 1024 * 2816;
            if (r < I_F13) { const int kb = r / 88, nb = r % 88; if (F8_M1) transpose_item_f8(P.moe_w1 + (size_t)e * 1024 * DFF, 1024, DFF, W1T, kb, 32 * nb, pairmap(32 * nb, 0), F8_WSCALE, scr, lane); else transpose_item<0>(P.moe_w1 + (size_t)e * 1024 * DFF, 1024, DFF, (bf16*)(ws + WS_WM1T) + (size_t)e * 5632 * 1024, kb, 32 * nb, pairmap(32 * nb, 0), scr, lane); continue; } r -= I_F13;
            if (r < I_F13) { const int kb = r / 88, nb = r % 88; if (F8_M1) transpose_item_f8(P.moe_w3 + (size_t)e * 1024 * DFF, 1024, DFF, W1T, kb, 32 * nb, pairmap(32 * nb, 1), F8_WSCALE, scr, lane); else transpose_item<0>(P.moe_w3 + (size_t)e * 1024 * DFF, 1024, DFF, (bf16*)(ws + WS_WM1T) + (size_t)e * 5632 * 1024, kb, 32 * nb, pairmap(32 * nb, 1), scr, lane); continue; } r -= I_F13;
            { const int kb = r / 32, nb = r % 32; transpose_item_f8(P.moe_w2 + (size_t)e * DFF * 1024, DFF, 1024, W2T, kb, 32 * nb, 32 * nb, F8_WSCALE, scr, lane); continue; }
        }
        r -= N_M;
        if (r < N_F) {
            unsigned char* W1T = ws + WS_WF1T; unsigned char* W2T = ws + WS_WF2T;
            if (r < I_F13) { const int kb = r / 88, nb = r % 88; if (F8_D1) transpose_item_f8(P.ffn_w1, 1024, DFF, W1T, kb, 32 * nb, pairmap(32 * nb, 0), F8_WSCALE, scr, lane); else transpose_item<0>(P.ffn_w1, 1024, DFF, (bf16*)W1T, kb, 32 * nb, pairmap(32 * nb, 0), scr, lane); continue; } r -= I_F13;
            if (r < I_F13) { const int kb = r / 88, nb = r % 88; if (F8_D1) transpose_item_f8(P.ffn_w3, 1024, DFF, W1T, kb, 32 * nb, pairmap(32 * nb, 1), F8_WSCALE, scr, lane); else transpose_item<0>(P.ffn_w3, 1024, DFF, (bf16*)W1T, kb, 32 * nb, pairmap(32 * nb, 1), scr, lane); continue; } r -= I_F13;
            { const int kb = r / 32, nb = r % 32; if (F8_D2) transpose_item_f8(P.ffn_w2, DFF, 1024, W2T, kb, 32 * nb, 32 * nb, F8_WSCALE, scr, lane); else transpose_item<0>(P.ffn_w2, DFF, 1024, (bf16*)W2T, kb, 32 * nb, 32 * nb, scr, lane); continue; }
        }
        r -= N_F;
        const int l = r / PER_L; r -= l * PER_L;
        if (r < I_WIN) { const int kb = r / 61, nb = r % 61; if (F8_G1L1 && l == 1) transpose_item_f8(P.w_in + (size_t)l * 1024 * NIN, 1024, NIN, ws + WS_W1T + (size_t)l * ZW * 2048, kb, 32 * nb, zmap(32 * nb), F8_WSCALE, scr, lane);
            else transpose_item<0>(P.w_in + (size_t)l * 1024 * NIN, 1024, NIN, (bf16*)(ws + WS_W1T) + (size_t)l * ZW * 1024, kb, 32 * nb, zmap(32 * nb), scr, lane); continue; } r -= I_WIN;
        if (r < I_MG) { const int kb = r / 96, nb = r % 96; transpose_item_f8(P.w_mg + (size_t)l * 1024 * 3072, 1024, 3072, ws + WS_WMGT + (size_t)l * 3072 * 1024, kb, 32 * nb, 32 * nb, F8_WSCALE, scr, lane); continue; } r -= I_MG;
        if (r < I_UQ) { const int kb = r / 24, nb = r % 24; bf16* T = (bf16*)(ws + WS_WUQT) + (size_t)l * 768 * 384;
            if (nb % 3 == 2) transpose_item<1>(P.w_uq + (size_t)l * 384 * 768, 384, 768, T, kb, 32 * nb, 32 * nb, scr, lane); else transpose_item<0>(P.w_uq + (size_t)l * 384 * 768, 384, 768, T, kb, 32 * nb, 32 * nb, scr, lane); continue; } r -= I_UQ;
        if (r < I_UKV) { const int kb = r / 32, nb = r % 32; transpose_item<0>(P.w_ukv + (size_t)l * 256 * 1024, 256, 1024, (bf16*)(ws + WS_WUKVT) + (size_t)l * 1024 * 256, kb, 32 * nb, 32 * nb, scr, lane); continue; } r -= I_UKV;
        if (r < I_GLU) { const int kb = r / 32, nb = r % 32, n0 = 32 * nb; transpose_item<0>(P.w_glu + (size_t)l * 512 * 1024, 512, 1024, (bf16*)(ws + WS_WGLUT) + (size_t)l * 1024 * 512, kb, n0, n0 < 512 ? pairmap(n0, 0) : pairmap(n0 - 512, 1), scr, lane); continue; } r -= I_GLU;
        if (r < 3 * I_BR) { const int n = r / I_BR; r -= n * I_BR; const int kb = r / 32, nb = r % 32;
            transpose_item<0>(P.w_branch + ((size_t)l * 3 + n) * 512 * 1024, 512, 1024, (bf16*)(ws + WS_WBT) + ((size_t)l * 3 + n) * 1024 * 512, kb, 32 * nb, 32 * nb, scr, lane); continue; } r -= 3 * I_BR;
        { const int kb = r / 32, nb = r % 32; transpose_item<0>(P.w_out + (size_t)l * 1024 * 1024, 1024, 1024, (bf16*)(ws + WS_WOUTT) + (size_t)l * 1024 * 1024, kb, 32 * nb, 32 * nb, scr, lane); }
    } }
}


constexpr int MOE_ITEMS_PER_E = 2 * 16 * 88 + 44 * 32, MOE_ITEMS = 8 * MOE_ITEMS_PER_E;
__device__ __forceinline__ void moe_transposes(const float* w1, const float* w3, const float* w2, unsigned char* ws, int lo, int hi, int giw, int ngiw, LAS float* scr, int lane) {
    constexpr int I_F13 = 16 * 88;
    for (int it = lo + giw; it < hi; it += ngiw) {
        const int e = it / MOE_ITEMS_PER_E; int r = it - e * MOE_ITEMS_PER_E;
        unsigned char* W1T = ws + WS_WM1T + (size_t)e * 5632 * 1024; unsigned char* W2T = ws + WS_WM2T + (size_t)e * 1024 * 2816;
        if (r < I_F13) { const int kb = r / 88, nb = r % 88; if (F8_M1) transpose_item_f8(w1 + (size_t)e * 1024 * DFF, 1024, DFF, W1T, kb, 32 * nb, pairmap(32 * nb, 0), F8_WSCALE, scr, lane); else transpose_item<0>(w1 + (size_t)e * 1024 * DFF, 1024, DFF, (bf16*)(ws + WS_WM1T) + (size_t)e * 5632 * 1024, kb, 32 * nb, pairmap(32 * nb, 0), scr, lane); continue; } r -= I_F13;
        if (r < I_F13) { const int kb = r / 88, nb = r % 88; if (F8_M1) transpose_item_f8(w3 + (size_t)e * 1024 * DFF, 1024, DFF, W1T, kb, 32 * nb, pairmap(32 * nb, 1), F8_WSCALE, scr, lane); else transpose_item<0>(w3 + (size_t)e * 1024 * DFF, 1024, DFF, (bf16*)(ws + WS_WM1T) + (size_t)e * 5632 * 1024, kb, 32 * nb, pairmap(32 * nb, 1), scr, lane); continue; } r -= I_F13;
        { const int kb = r / 32, nb = r % 32; transpose_item_f8(w2 + (size_t)e * DFF * 1024, DFF, 1024, W2T, kb, 32 * nb, 32 * nb, F8_WSCALE, scr, lane); }
    }
}
__device__ __forceinline__ void mod_item(const Ptrs& P, int item, LAS unsigned char* lds, int wave_) {
    LAS float* sc = (LAS float*)lds;
    LAS float* part = sc + 5 * 1024;
    const int lane = lane_id(), wid = wave_, tid = wid * 64 + lane, l = item / 96, n0 = (item % 96) * 64;
    for (int i = tid; i < 5 * 1024; i += NTHREADS) { const float v = i < 4096 ? P.c[i] : P.c_ctx[i - 4096]; sc[i] = v / (1.0f + expf(-v)); }
    __syncthreads();
    float a[5] = {0.f, 0.f, 0.f, 0.f, 0.f};
    const float* W = P.w_mod + (size_t)l * 1024 * 6144 + n0 + lane;
    for (int k0 = wid; k0 < 1024; k0 += 256) {
        float w[32];
#pragma unroll
        for (int j = 0; j < 32; ++j) w[j] = W[(size_t)(k0 + 8 * j) * 6144];
#pragma unroll
        for (int j = 0; j < 32; ++j)
#pragma unroll
            for (int r = 0; r < 5; ++r) a[r] += sc[r * 1024 + k0 + 8 * j] * w[j]; }
#pragma unroll
    for (int r = 0; r < 5; ++r) part[(wid * 5 + r) * 64 + lane] = a[r];
    __syncthreads();
    if (tid < 320) { const int r = tid >> 6; float s = 0.f;
#pragma unroll
        for (int w = 0; w < 8; ++w) s += part[(w * 5 + r) * 64 + lane];
        ((float*)(P.ws + WS_MOD))[((size_t)l * 5 + r) * 6144 + n0 + lane] = s + P.b_mod[l * 6144 + n0 + lane]; }
    __syncthreads();
}
__device__ __forceinline__ void copy_params(const Ptrs& P, int gt, int ngt) {
    float* par = (float*)(P.ws + WS_PAR);
    for (int i = gt; i < 2048; i += ngt) { par[PR_GMIXPRE + i] = P.g_mix_pre[i]; par[PR_GMIXPOST + i] = P.g_mix_post[i]; par[PR_GFFNPRE + i] = P.g_ffn_pre[i]; par[PR_GFFNPOST + i] = P.g_ffn_post[i]; }
    for (int i = gt; i < 128; i += ngt) { par[PR_GQ + i] = P.g_q[i]; par[PR_GK + i] = P.g_k[i]; }
    for (int i = gt; i < 768; i += ngt) par[PR_GCQ + i] = P.g_cq[i];
    for (int i = gt; i < 512; i += ngt) par[PR_GCKV + i] = P.g_ckv[i];
    for (int i = gt; i < 6144; i += ngt) par[PR_BMG + i] = P.b_mg[i];
    for (int i = gt; i < 8192; i += ngt) par[PR_RW + i] = P.router_w[i];
    for (int i = gt; i < 8; i += ngt) par[PR_RB + i] = P.router_b[i];
    s5::build_a16(P.s5p, par + PR_A16, gt, ngt);
}
__device__ __forceinline__ void rope_tables(const Ptrs& P, int gt, int ngt) {
    float* ca = (float*)(P.ws + WS_ROPE); float* sa = ca + 4096 * 32; float* cb = sa + 4096 * 32; float* sb = cb + 4096 * 16;
    for (int i = gt; i < 4096 * 32; i += ngt) { const int pos = i >> 5, j = i & 31; const float f = expf(-9.210340371976184f * (float)(j & 15) * (1.0f / 16.0f));
        const float ang = (float)(j < 16 ? pos / GRIDW : pos % GRIDW) * f; ca[i] = cosf(ang); sa[i] = sinf(ang); }
    for (int i = gt; i < 4096 * 16; i += ngt) { const int pos = i >> 4, j = i & 15; const float f = expf(-9.210340371976184f * (float)(j & 7) * (1.0f / 8.0f));
        const float ang = (float)(j < 8 ? pos / GRIDW : pos % GRIDW) * f; cb[i] = cosf(ang); sb[i] = sinf(ang); }
}

__device__ __forceinline__ void ld8(const float* p, float (&o)[8]) { const f32x4 a = *(const f32x4*)p, b = *(const f32x4*)(p + 4); o[0] = a[0]; o[1] = a[1]; o[2] = a[2]; o[3] = a[3]; o[4] = b[0]; o[5] = b[1]; o[6] = b[2]; o[7] = b[3]; }
__device__ __forceinline__ void token_row(unsigned char* ws, int l, int row, int lane) {
    const float* par = (const float*)(ws + WS_PAR);
    const bf16* z = (const bf16*)(ws + P_Z) + (size_t)row * ZW;
    const bool lat = row < NLAT; const int t = row & (SEQ - 1);
    const float* cosA = (const float*)(ws + WS_ROPE) + t * 32; const float* sinA = cosA + 4096 * 32;
    const float* cosB = (const float*)(ws + WS_ROPE) + 2 * 4096 * 32 + t * 16; const float* sinB = cosB + 4096 * 16;
    float v0[8], v1[8], v2[8];
    unpack8(*(const u32x4*)(z + 8 * lane), v0); unpack8(*(const u32x4*)(z + 512 + 8 * lane), v1); unpack8(*(const u32x4*)(z + 1024 + 8 * lane), v2);
    const u32x4 uraw = *(const u32x4*)(z + ZC_U + 8 * lane);
    float ca[8], sa[8], cb8[8], sb8[8];
    ld8(cosA + ((8 * (lane & 7)) & 31), ca); ld8(sinA + ((8 * (lane & 7)) & 31), sa); ld8(cosB + ((8 * ((lane - 48) & 3)) & 15), cb8); ld8(sinB + ((8 * ((lane - 48) & 3)) & 15), sb8);
    { float ss = 0.f;
#pragma unroll
      for (int j = 0; j < 8; ++j) ss += v0[j] * v0[j];
      ss += shfl_xor_l(ss, 1, lane); ss += shfl_xor_l(ss, 2, lane); ss += shfl_xor_l(ss, 4, lane);
      const float rs = rsqrtf(ss * (1.0f / 64.0f) + EPS); const int d0 = 8 * (lane & 7); float o[8], gq[8];
      ld8(par + PR_GQ + l * 64 + d0, gq);
#pragma unroll
      for (int j = 0; j < 8; ++j) v0[j] = v0[j] * rs * gq[j];
#pragma unroll
      for (int j = 0; j < 8; ++j) { const float other = shfl_xor_l(v0[j], 4, lane); const float c = ca[j], s = sa[j];
          o[j] = lat ? ((d0 < 32) ? v0[j] * c - other * s : other * s + v0[j] * c) : v0[j];
          o[j] *= 0.125f * LOG2E; }
      *(u32x4*)((bf16*)(ws + P_QA) + (size_t)row * 512 + 8 * lane) = pack8(o); }
    { float ss = 0.f;
#pragma unroll
      for (int j = 0; j < 8; ++j) ss += v1[j] * v1[j];
      float ssk = ss; ssk += shfl_xor_l(ssk, 1, lane); ssk += shfl_xor_l(ssk, 2, lane); ssk += shfl_xor_l(ssk, 4, lane);
      float ss2 = 0.f;
#pragma unroll
      for (int j = 0; j < 8; ++j) ss2 += v2[j] * v2[j];
      const float sq = wave_sum((lane >= 32 ? ss : 0.f) + (lane < 16 ? ss2 : 0.f));
      const float skv = wave_sum((lane >= 16 && lane < 48) ? ss2 : 0.f);
      const float rq = rsqrtf(sq * (1.0f / 384.0f) + EPS), rkv = rsqrtf(skv * (1.0f / 256.0f) + EPS);
      { const float rs = rsqrtf(ssk * (1.0f / 64.0f) + EPS); const int d0 = 8 * (lane & 7); float kk[8], o[8], gk[8];
        ld8(par + PR_GK + l * 64 + d0, gk);
#pragma unroll
        for (int j = 0; j < 8; ++j) kk[j] = v1[j] * rs * gk[j];
#pragma unroll
        for (int j = 0; j < 8; ++j) { const float other = shfl_xor_l(kk[j], 4, lane); const float c = ca[j], s = sa[j];
            o[j] = lat ? ((d0 < 32) ? kk[j] * c - other * s : other * s + kk[j] * c) : kk[j]; }
        if (lane < 16) *(u32x4*)((bf16*)(ws + P_KA) + (size_t)row * 128 + 8 * lane) = pack8(o); }
      if (lane >= 16 && lane < 32) *(u32x4*)((bf16*)(ws + P_VA) + (size_t)row * 128 + 8 * (lane - 16)) = pack8(v1);
      { float g1[8], g2[8], g3[8], o[8];
        const int i1 = lane >= 32 ? 8 * (lane - 32) : 0, i2 = lane < 16 ? 256 + 8 * lane : 0, i3 = (lane >= 16 && lane < 48) ? 8 * (lane - 16) : 0;
        ld8(par + PR_GCQ + l * 384 + i1, g1); ld8(par + PR_GCQ + l * 384 + i2, g2); ld8(par + PR_GCKV + l * 256 + i3, g3);
#pragma unroll
        for (int j = 0; j < 8; ++j) o[j] = v1[j] * rq * g1[j];
        if (lane >= 32) *(u32x4*)((bf16*)(ws + P_CQN) + (size_t)row * 384 + i1) = pack8(o);
#pragma unroll
        for (int j = 0; j < 8; ++j) o[j] = v2[j] * rq * g2[j];
        if (lane < 16) *(u32x4*)((bf16*)(ws + P_CQN) + (size_t)row * 384 + i2) = pack8(o);
#pragma unroll
        for (int j = 0; j < 8; ++j) o[j] = v2[j] * rkv * g3[j];
        if (lane >= 16 && lane < 48) *(u32x4*)((bf16*)(ws + P_CKVN) + (size_t)row * 256 + i3) = pack8(o); }
      { float o[8]; const int i0 = 8 * ((lane - 48) & 3);
#pragma unroll
        for (int j = 0; j < 8; ++j) { const float other = shfl_xor_l(v2[j], 2, lane); const float c = cb8[j], s = sb8[j];
            o[j] = lat ? ((i0 < 16) ? v2[j] * c - other * s : other * s + v2[j] * c) : v2[j]; }
        if (lane >= 48 && lane < 52) *(u32x4*)((bf16*)(ws + P_KRR) + (size_t)row * 32 + i0) = pack8(o); }
    }
    { const int b = lat ? row >> 12 : (row - NLAT) >> 8, pos = lat ? CTXL + t : (row - NLAT) & 255, g = lane >> 1;
      *(u32x4*)((bf16*)(ws + P_UG) + ((size_t)(b * 32 + g) * LPOS + pos) * 16 + 8 * (lane & 1)) = uraw; }
}

struct ResidArgs {
    int mode;
    const float* y; const float* g_post; int gate_chunk;
    const float* g_pre; int shift_chunk;
    bool dry;
    float ysc;
    bf16* hout; int l_mod; bool h8; unsigned char* hout8;
    int l_gate; bool route;
};
__device__ __forceinline__ void resid_row(unsigned char* ws, float* outp, const float* xin, const float* ctxin, const ResidArgs R, int row, int lane, const LAS int* tb) {
    const float* par = (const float*)(ws + WS_PAR);
    const bool lat = row < NLAT; const int b = lat ? row >> 12 : (row - NLAT) >> 8, mr = lat ? b : 4;
    const float* mod = (const float*)(ws + WS_MOD);
    float* latp = lat ? outp + (size_t)row * 1024 : (float*)(ws + WS_LATC) + (size_t)(row - NLAT) * 1024;
    f32x4 v[4];
    if (R.mode == 0) { const float* src = lat ? xin + (size_t)row * 1024 : ctxin + (size_t)(row - NLAT) * 1024;
#pragma unroll
        for (int j = 0; j < 4; ++j) v[j] = *(const f32x4*)(src + 4 * lane + 256 * j);
    } else {
        f32x4 yv[4];
        if (R.mode == 1) {
#pragma unroll
            for (int j = 0; j < 4; ++j) yv[j] = *(const f32x4*)(R.y + (size_t)row * 1024 + 4 * lane + 256 * j) * R.ysc;
        } else if (R.mode == 3) {
            const bf16* yb = (const bf16*)R.y + (size_t)row * 1024;
#pragma unroll
            for (int j = 0; j < 4; ++j) { const u32x2 a = *(const u32x2*)(yb + 4 * lane + 256 * j);
                yv[j] = (f32x4){bf2f(a.x & 0xffffu), bf2f(a.x >> 16), bf2f(a.y & 0xffffu), bf2f(a.y >> 16)} * R.ysc; }
        } else {
            const int* ti = (const int*)(ws + WS_LIST) + 8 * 16384 + row * 8;
            const int e0 = ti[0], p0 = ti[1], e1 = ti[2], p1 = ti[3]; const float w0 = __int_as_float(ti[4]) * R.ysc, w1 = __int_as_float(ti[5]) * R.ysc;
            const bf16* f0 = (const bf16*)(ws + P_Y2) + ((size_t)tb[8 + e0] * 256 + p0) * 1024; const bf16* f1 = (const bf16*)(ws + P_Y2) + ((size_t)tb[8 + e1] * 256 + p1) * 1024;
#pragma unroll
            for (int j = 0; j < 4; ++j) { const u32x2 a = *(const u32x2*)(f0 + 4 * lane + 256 * j), c = *(const u32x2*)(f1 + 4 * lane + 256 * j);
                yv[j][0] = w0 * bf2f(a.x & 0xffffu) + w1 * bf2f(c.x & 0xffffu); yv[j][1] = w0 * bf2f(a.x >> 16) + w1 * bf2f(c.x >> 16);
                yv[j][2] = w0 * bf2f(a.y & 0xffffu) + w1 * bf2f(c.y & 0xffffu); yv[j][3] = w0 * bf2f(a.y >> 16) + w1 * bf2f(c.y >> 16); }
        }
        float ss = 0.f;
#pragma unroll
        for (int j = 0; j < 4; ++j) ss += (yv[j][0] * yv[j][0] + yv[j][1] * yv[j][1]) + (yv[j][2] * yv[j][2] + yv[j][3] * yv[j][3]);
        const float rs = rsqrtf(wave_sum(ss) * (1.0f / 1024.0f) + EPS);
        const float* gate = mod + ((size_t)R.l_gate * 5 + mr) * 6144 + R.gate_chunk * 1024;
#pragma unroll
        for (int j = 0; j < 4; ++j) { const int c = 4 * lane + 256 * j; const f32x4 lv = *(const f32x4*)(latp + c), gp = *(const f32x4*)(R.g_post + c), gt = *(const f32x4*)(gate + c);
            v[j] = lv + gt * (yv[j] * rs * gp); }
    }
    if (!R.dry) {
#pragma unroll
    for (int j = 0; j < 4; ++j) *(f32x4*)(latp + 4 * lane + 256 * j) = v[j]; }
    if (R.hout == nullptr) return;
    float ss = 0.f;
#pragma unroll
    for (int j = 0; j < 4; ++j) ss += (v[j][0] * v[j][0] + v[j][1] * v[j][1]) + (v[j][2] * v[j][2] + v[j][3] * v[j][3]);
    const float rs = rsqrtf(wave_sum(ss) * (1.0f / 1024.0f) + EPS);
    const float* shift = mod + ((size_t)R.l_mod * 5 + mr) * 6144 + R.shift_chunk * 1024; const float* scale = shift + 1024;
    f32x4 hv[4];
#pragma unroll
    for (int j = 0; j < 4; ++j) { const int c = 4 * lane + 256 * j; const f32x4 gp = *(const f32x4*)(R.g_pre + c), sh = *(const f32x4*)(shift + c), sc = *(const f32x4*)(scale + c);
        hv[j] = (v[j] * rs * gp) * (1.0f + sc) + sh;
        if (R.dry) { if (hv[j][0] == 123.456f) *(float*)(ws + WS_CTL + 64) = 1.f; continue; }
        if (R.hout8) *(unsigned*)(R.hout8 + (size_t)row * 1024 + c) = pg8::pk_fp8x4(hv[j][0] * F8_HSCALE, hv[j][1] * F8_HSCALE, hv[j][2] * F8_HSCALE, hv[j][3] * F8_HSCALE);
        if (R.h8) *(unsigned*)((unsigned char*)R.hout + (size_t)row * 1024 + c) = pg8::pk_fp8x4(hv[j][0] * F8_HSCALE, hv[j][1] * F8_HSCALE, hv[j][2] * F8_HSCALE, hv[j][3] * F8_HSCALE);
        else *(u32x2*)(R.hout + (size_t)row * 1024 + c) = (u32x2){pk2(hv[j][0], hv[j][1]), pk2(hv[j][2], hv[j][3])}; }
    if (R.route) {
        float lg[8];
#pragma unroll
        for (int e = 0; e < 8; ++e) lg[e] = 0.f;
#pragma unroll
        for (int j = 0; j < 4; ++j)
#pragma unroll
            for (int i = 0; i < 4; ++i) { const float* rw = par + PR_RW + (size_t)(4 * lane + 256 * j + i) * 8; const f32x4 r0 = *(const f32x4*)rw, r1 = *(const f32x4*)(rw + 4); const float hvv = hv[j][i];
                lg[0] += hvv * r0[0]; lg[1] += hvv * r0[1]; lg[2] += hvv * r0[2]; lg[3] += hvv * r0[3]; lg[4] += hvv * r1[0]; lg[5] += hvv * r1[1]; lg[6] += hvv * r1[2]; lg[7] += hvv * r1[3]; }
#pragma unroll
        for (int e = 0; e < 8; ++e) lg[e] = wave_sum(lg[e]) + par[PR_RB + e];
        int e0 = 0; float b0 = lg[0];
#pragma unroll
        for (int e = 1; e < 8; ++e) if (lg[e] > b0) { b0 = lg[e]; e0 = e; }
        int e1 = -1; float b1 = -3.0e38f;
#pragma unroll
        for (int e = 0; e < 8; ++e) if (e != e0 && lg[e] > b1) { b1 = lg[e]; e1 = e; }
        if (lane == 0 && !R.dry) {
            const float w0 = 1.0f / (1.0f + expf(b1 - b0)), w1 = 1.0f - w0;
            unsigned* cnt = (unsigned*)(ws + WS_CTL) + CW_CNT;
            const int p0 = (int)atomicAdd(cnt + e0, 1u), p1 = (int)atomicAdd(cnt + e1, 1u);
            int* list = (int*)(ws + WS_LIST); list[e0 * 16384 + p0] = row; list[e1 * 16384 + p1] = row;
            int* ti = list + 8 * 16384 + row * 8; ti[0] = e0; ti[1] = p0; ti[2] = e1; ti[3] = p1; ti[4] = __float_as_int(w0); ti[5] = __float_as_int(w1);
        }
    }
}

#if MK_DEBUG
namespace dbg {
__device__ __forceinline__ unsigned hash(unsigned a, unsigned b) { unsigned x = a * 0x9E3779B1u ^ (b + 0x7F4A7C15u) * 0x85EBCA77u; x ^= x >> 15; x *= 0xC2B2AE3Du; x ^= x >> 13; x *= 0x27D4EB2Fu; x ^= x >> 16; return x; }
__device__ __forceinline__ float rbf(float f) { return bf2f(f2bf(f)); }
__device__ __forceinline__ void add(unsigned char* ws, int k, float got, float ref, int lane) {
    if (lane == 0) { float* d = (float*)(ws + WS_CTL) + CW_DBG + 2 * k; const float df = got - ref; atomicAdd(d, (df == df && fabsf(df) < 1e18f) ? df * df : 1e30f); atomicAdd(d + 1, ref * ref); }
}
__device__ __forceinline__ float dot_aw(const bf16* a, const float* w, size_t wstride, int K, int lane) { float s = 0.f; for (int k = lane; k < K; k += 64) s += bf2f(a[k]) * rbf(w[(size_t)k * wstride]); return wave_sum(s); }

__device__ __forceinline__ float angA(int t, int i) { return (float)(i < 16 ? t / 64 : t % 64) * powf(10000.f, -(float)(2 * (i & 15)) / 32.f); }
__device__ __forceinline__ float angB(int t, int i) { return (float)(i < 8 ? t / 64 : t % 64) * powf(10000.f, -(float)(2 * (i & 7)) / 16.f); }
__device__ __forceinline__ void chk_mod(unsigned char* ws, const float* const* in, int gw, int ngw, int lane) {
    for (int s = gw; s < 1024; s += ngw) { const unsigned hh = hash(s, 1); const int l = hh & 1, r = (hh >> 1) % 5, n = (hh >> 8) % 6144; float a = 0.f;
        for (int k = lane; k < 1024; k += 64) { const float c = r < 4 ? in[1][r * 1024 + k] : in[3][k]; a += c / (1.f + expf(-c)) * in[4][((size_t)l * 1024 + k) * 6144 + n]; }
        a = wave_sum(a) + in[5][l * 6144 + n]; add(ws, 0, ((const float*)(ws + WS_MOD))[((size_t)l * 5 + r) * 6144 + n], a, lane); }
}
__device__ __forceinline__ void chk_weights(unsigned char* ws, const float* const* in, int gw, int ngw, int lane) {
    for (int s = gw * 64 + lane; s < 65536; s += ngw * 64) { const unsigned hh = hash(s, 2), h2 = hash(s, 3); const int l = hh & 1; float got = 0.f, ref = 0.f; const int which = (hh >> 1) % 12;
        if (which == 0) { const int j = (hh >> 8) % 1952, k = h2 % 1024; int dr = j < 512 ? j : j < 896 ? 768 + (j - 512) : j < 1024 ? 512 + (j - 896) : j < 1152 ? 640 + (j - 1024) : j < 1440 ? j : 1536 + (j - 1440);
            got = bf2f(((const bf16*)(ws + WS_W1T))[((size_t)l * 2048 + dr) * 1024 + k]); ref = rbf(in[10][((size_t)l * 1024 + k) * 1952 + j]); }
        else if (which == 1) { const int j = (hh >> 8) % 3072, k = h2 % 1024; got = bf2f(((const bf16*)(ws + WS_WMGT))[((size_t)l * 3072 + j) * 1024 + k]); ref = rbf(in[27][((size_t)l * 1024 + k) * 3072 + j]); }
        else if (which == 2) { const int j = (hh >> 8) % 768, k = h2 % 384, hd = j / 96, e = j % 96; int de = e; if (e >= 64) { const int i = e - 64; de = 64 + (i < 16 ? 8 * (i >> 2) + (i & 3) : 8 * ((i - 16) >> 2) + 4 + ((i - 16) & 3)); }
            got = bf2f(((const bf16*)(ws + WS_WUQT))[((size_t)l * 768 + hd * 96 + de) * 384 + k]); ref = rbf(in[15][((size_t)l * 384 + k) * 768 + j]); }
        else if (which == 3) { const int j = (hh >> 8) % 1024, k = h2 % 256; got = bf2f(((const bf16*)(ws + WS_WUKVT))[((size_t)l * 1024 + j) * 256 + k]); ref = rbf(in[16][((size_t)l * 256 + k) * 1024 + j]); }
        else if (which == 4) { const int j = (hh >> 8) % 1024, k = h2 % 512; const int jj = j < 512 ? j : j - 512; const int dr = 256 * (jj / 128) + (j < 512 ? 0 : 128) + jj % 128;
            got = bf2f(((const bf16*)(ws + WS_WGLUT))[((size_t)l * 1024 + dr) * 512 + k]); ref = rbf(in[25][((size_t)l * 512 + k) * 1024 + j]); }
        else if (which == 5) { const int n = (hh >> 4) % 3, j = (hh >> 8) % 1024, k = h2 % 512; got = bf2f(((const bf16*)(ws + WS_WBT))[(((size_t)l * 3 + n) * 1024 + j) * 512 + k]); ref = rbf(in[26][(((size_t)l * 3 + n) * 512 + k) * 1024 + j]); }
        else if (which == 6) { const int j = (hh >> 8) % 1024, k = h2 % 1024; got = bf2f(((const bf16*)(ws + WS_WOUTT))[((size_t)l * 1024 + j) * 1024 + k]); ref = rbf(in[29][((size_t)l * 1024 + k) * 1024 + j]); }
        else if (which == 7) { const int j = (hh >> 8) % 2816, k = h2 % 1024, sec = (hh >> 5) & 1; const int dr = 256 * (j / 128) + sec * 128 + j % 128;
            got = bf2f(((const bf16*)(ws + WS_WF1T))[(size_t)dr * 1024 + k]); ref = rbf(in[sec ? 31 : 30][(size_t)k * 2816 + j]); }
        else if (which == 8) { const int j = (hh >> 8) % 1024, k = h2 % 2816; got = bf2f(((const bf16*)(ws + WS_WF2T))[(size_t)j * 2816 + k]); ref = rbf(in[32][(size_t)k * 1024 + j]); }
        else if (which <= 10) { const int e = (hh >> 5) & 7, j = (hh >> 8) % 2816, k = h2 % 1024, sec = which - 9; const int dr = 256 * (j / 128) + sec * 128 + j % 128;
            got = bf2f(((const bf16*)(ws + WS_WM1T))[((size_t)e * 5632 + dr) * 1024 + k]); ref = rbf(in[sec ? 36 : 35][((size_t)e * 1024 + k) * 2816 + j]); }
        else { const int e = (hh >> 5) & 7, j = (hh >> 8) % 1024, k = h2 % 2816; got = bf2f(((const bf16*)(ws + WS_WM2T))[((size_t)e * 1024 + j) * 2816 + k]); ref = rbf(in[37][((size_t)e * 2816 + k) * 1024 + j]); }
        float* d = (float*)(ws + WS_CTL) + CW_DBG + 2 * 1; const float df = got - ref; atomicAdd(d, (df == df) ? df * df : 1e30f); atomicAdd(d + 1, ref * ref); }
}
__device__ __forceinline__ void chk_h(unsigned char* ws, const float* const* in, const float* outp, int k, int l_mod, int shift_chunk, const float* g_pre, int nrows, int gw, int ngw, int lane) {
    for (int s = gw; s < 512; s += ngw) { const int row = hash(s, 10 + k) % nrows; const bool lat = row < NLAT; const int mr = lat ? row >> 12 : 4;
        const float* latp = lat ? outp + (size_t)row * 1024 : (const float*)(ws + WS_LATC) + (size_t)(row - NLAT) * 1024; float ss = 0.f;
        for (int c = lane; c < 1024; c += 64) ss += latp[c] * latp[c];
        const float rs = rsqrtf(wave_sum(ss) / 1024.f + EPS); const float* mod = (const float*)(ws + WS_MOD) + ((size_t)l_mod * 5 + mr) * 6144 + shift_chunk * 1024;
        const int c = hash(s, 77) % 1024; const float ref = latp[c] * rs * g_pre[c] * (1.f + mod[1024 + c]) + mod[c];
        add(ws, k, bf2f(((const bf16*)(ws + P_H))[(size_t)row * 1024 + c]), ref, lane); }
}
template <class F> __device__ __forceinline__ void chk_gemm(unsigned char* ws, int k, const bf16* A, int lda, const float* W, int N, int K, int nrows, int ncols, F fin, int gw, int ngw, int lane) {
    for (int s = gw; s < 1024; s += ngw) { const unsigned hh = hash(s, 20 + k); const int row = hh % nrows, col = (hh >> 16) % ncols;
        const float ref = dot_aw(A + (size_t)row * lda, W + col, N, K, lane); float got, rr; fin(row, col, ref, got, rr); add(ws, k, got, rr, lane); }
}
__device__ __forceinline__ void chk_tok(unsigned char* ws, int k, int l, int gw, int ngw, int lane) {
    const float* par = (const float*)(ws + WS_PAR);
    for (int s = gw; s < 1024; s += ngw) { const unsigned hh = hash(s, 40 + k); const int row = hh % MALL; const bool lat = row < NLAT; const int t = row & 4095; const bf16* z = (const bf16*)(ws + P_Z) + (size_t)row * ZW;
        const int which = (hh >> 20) % 6; float got = 0.f, ref = 0.f;
        if (which == 0 || which == 1) { const int nh = which == 0 ? 8 : 2, hd = (hh >> 24) % nh, d = (hh >> 14) & 63; const bf16* x = z + (which == 0 ? 0 : ZC_KG) + hd * 64; const float* g = par + (which == 0 ? PR_GQ : PR_GK) + l * 64;
            float ss = 0.f; for (int i = 0; i < 64; ++i) ss += bf2f(x[i]) * bf2f(x[i]); const float rs = rsqrtf(ss / 64.f + EPS);
            const int i = d & 31; const float x1 = bf2f(x[i]) * rs * g[i], x2 = bf2f(x[i + 32]) * rs * g[i + 32]; float o = d < 32 ? x1 : x2;
            if (lat) { const float an = angA(t, i), c = cosf(an), sn = sinf(an); o = d < 32 ? x1 * c - x2 * sn : x1 * sn + x2 * c; }
            if (which == 0) { o *= 0.125f * LOG2E; got = bf2f(((const bf16*)(ws + P_QA))[(size_t)row * 512 + hd * 64 + d]); } else got = bf2f(((const bf16*)(ws + P_KA))[(size_t)row * 128 + hd * 64 + d]);
            ref = o; }
        else if (which == 2) { const int i = (hh >> 8) % 384; float ss = 0.f; for (int j = 0; j < 384; ++j) ss += bf2f(z[ZC_CQ + j]) * bf2f(z[ZC_CQ + j]);
            ref = bf2f(z[ZC_CQ + i]) * rsqrtf(ss / 384.f + EPS) * par[PR_GCQ + l * 384 + i]; got = bf2f(((const bf16*)(ws + P_CQN))[(size_t)row * 384 + i]); }
        else if (which == 3) { const int i = (hh >> 8) % 256; float ss = 0.f; for (int j = 0; j < 256; ++j) ss += bf2f(z[ZC_CKV + j]) * bf2f(z[ZC_CKV + j]);
            ref = bf2f(z[ZC_CKV + i]) * rsqrtf(ss / 256.f + EPS) * par[PR_GCKV + l * 256 + i]; got = bf2f(((const bf16*)(ws + P_CKVN))[(size_t)row * 256 + i]); }
        else if (which == 4) { const int d = (hh >> 8) & 31, i = d & 15; const float x1 = bf2f(z[ZC_KR + i]), x2 = bf2f(z[ZC_KR + 16 + i]); float o = d < 16 ? x1 : x2;
            if (lat) { const float an = angB(t, i), c = cosf(an), sn = sinf(an); o = d < 16 ? x1 * c - x2 * sn : x1 * sn + x2 * c; } ref = o; got = bf2f(((const bf16*)(ws + P_KRR))[(size_t)row * 32 + d]); }
        else { const int c = (hh >> 8) & 511, b = lat ? row >> 12 : (row - NLAT) >> 8, pos = lat ? 256 + t : (row - NLAT) & 255; const int wv = (hh >> 19) & 1;
            if (wv) { ref = bf2f(z[ZC_U + c]); got = bf2f(((const bf16*)(ws + P_UG))[((size_t)(b * 32 + (c >> 4)) * LPOS + pos) * 16 + (c & 15)]); }
            else { ref = bf2f(z[ZC_VG + (c & 127)]); got = bf2f(((const bf16*)(ws + P_VA))[(size_t)row * 128 + (c & 127)]); } }
        add(ws, k, got, ref, lane); }
}
__device__ __forceinline__ void chk_attn(unsigned char* ws, int k, bool lastl, int gw, int ngw, int lane) {
    for (int s = gw; s < 256; s += ngw) { const unsigned hh = hash(s, 60 + k); const int typ = hh & 1, b = (hh >> 1) & 3, h = (hh >> 3) & 7, d = (hh >> 6) & 63; const bool cq = !lastl && ((hh >> 12) & 7) == 0;
        const int qrow = cq ? NLAT + b * 256 + ((hh >> 16) & 255) : b * 4096 + ((hh >> 16) & 4095); const int nk = cq ? 256 : LPOS, DKK = typ ? 96 : 64;
        const bf16* q = typ ? (const bf16*)(ws + P_QB) + (size_t)qrow * 768 + h * 96 : (const bf16*)(ws + P_QA) + (size_t)qrow * 512 + h * 64;
        float m = -1e30f, l = 0.f, o = 0.f;
        for (int p = lane; p < nk; p += 64) { const int kr = pos_row(b, p); float sc = 0.f;
            if (typ) { const bf16* kk = (const bf16*)(ws + P_KB) + (size_t)kr * 512 + h * 64; const bf16* k2 = (const bf16*)(ws + P_KRR) + (size_t)kr * 32;
                for (int i = 0; i < 64; ++i) sc += bf2f(q[i]) * bf2f(kk[i]); for (int i = 0; i < 32; ++i) sc += bf2f(q[64 + i]) * bf2f(k2[i]); }
            else { const bf16* kk = (const bf16*)(ws + P_KA) + (size_t)kr * 128 + (h >> 2) * 64; for (int i = 0; i < 64; ++i) sc += bf2f(q[i]) * bf2f(kk[i]); }
            const float v = typ ? bf2f(((const bf16*)(ws + P_VB))[(size_t)kr * 512 + h * 64 + d]) : bf2f(((const bf16*)(ws + P_VA))[(size_t)kr * 128 + (h >> 2) * 64 + d]);
            const float mn = fmaxf(m, sc), al = exp2f(m - mn), pp = exp2f(sc - mn); l = l * al + pp; o = o * al + pp * v; m = mn; (void)DKK; }
        float mg = m; for (int x = 1; x < 64; x <<= 1) mg = fmaxf(mg, __shfl_xor(mg, x));
        const float f = exp2f(m - mg); l = wave_sum(l * f); o = wave_sum(o * f);
        add(ws, k, bf2f(((const bf16*)(ws + P_YBR))[(size_t)qrow * 1536 + typ * 512 + h * 64 + d]), o / l, lane); }
}
__device__ __forceinline__ void chk_s5(unsigned char* ws, const float* const* in, int k, int l, bool lastl, int gw, int ngw, int lane) {
    for (int s = gw; s < 512; s += ngw) { const unsigned hh = hash(s, 80 + k); const int b = hh & 3, g = (hh >> 2) & 31, hp = (hh >> 7) & 15; int psel = (hh >> 12) % LPOS; if (lastl && psel < 256) psel += 256;
        const bf16* U = (const bf16*)(ws + P_UG) + (size_t)(b * 32 + g) * LPOS * 16; float yf[2], yl[2];
        for (int dir = 0; dir < 2; ++dir) { const int pi = ((l * 2 + dir) * 32 + g) * 64 + lane;
            const float lr = fminf(in[17][pi], -1e-4f), li = in[18][pi], dt = expf(in[19][(l * 2 + dir) * 32 + g]); const float mag = expf(lr * dt), abr = mag * cosf(li * dt), abi = mag * sinf(li * dt), den = lr * lr + li * li;
            const float fr = ((abr - 1.f) * lr + abi * li) / den, fi = (abi * lr - (abr - 1.f) * li) / den; float bbr[16], bbi[16];
            _Pragma("unroll") for (int h = 0; h < 16; ++h) { const float br = in[20][(size_t)pi * 16 + h], bi = in[21][(size_t)pi * 16 + h]; bbr[h] = fr * br - fi * bi; bbi[h] = fr * bi + fi * br; }
            float xr = 0.f, xi = 0.f, zr = 0.f, zi = 0.f;
            for (int st = 0; st < LPOS; ++st) { const int p = dir == 0 ? st : (st < 256 ? 255 - st : LPOS + 255 - st); float vr = 0.f, vi = 0.f;
                _Pragma("unroll") for (int h = 0; h < 16; ++h) { const float u = bf2f(U[(size_t)p * 16 + h]); vr += bbr[h] * u; vi += bbi[h] * u; }
                if ((dir == 0 && (p & 15) == 0) || (dir == 1 && (p & 15) == 15)) { zr = 0.f; zi = 0.f; }
                const float nr = abr * xr - abi * xi + vr, ni = abr * xi + abi * xr + vi; xr = nr; xi = ni;
                const float mr = abr * zr - abi * zi + vr, mi = abr * zi + abi * zr + vi; zr = mr; zi = mi;
                if (p == psel) break; }
            const size_t ci = ((size_t)((l * 2 + dir) * 32 + g) * 16 + hp) * 64 + lane; yf[dir] = wave_sum(in[22][ci] * xr - in[23][ci] * xi); yl[dir] = wave_sum(in[22][ci] * zr - in[23][ci] * zi); }
        const float du = in[24][(l * 32 + g) * 16 + hp] * bf2f(U[(size_t)psel * 16 + hp]); const float got = bf2f(((const bf16*)(ws + P_AGLU))[(size_t)pos_row(b, psel) * 512 + g * 16 + hp]);
        auto ge = [](float y) { const float u2 = 0.7978845608028654f * (y + 0.044715f * y * y * y); return 0.5f * y * (1.f + tanhf(u2)); };
        add(ws, k, got, ge(du + yf[0] + yf[1]), lane);
        if (l == 0) { add(ws, 30, got, ge(du + yf[0] + yl[1]), lane); add(ws, 31, got, ge(du + yl[0] + yf[1]), lane); add(ws, 32, got, ge(du + yl[0] + yl[1]), lane); add(ws, 33, got, ge(du), lane); } }
}
__device__ __forceinline__ void chk_s5m(unsigned char* ws, const float* const* in, int k, int gw, int ngw, int lane) {
    for (int s = gw; s < 2048; s += ngw) { const unsigned hh = hash(s, 700), h2 = hash(s, 701); const int l = hh & 1, g = (hh >> 1) & 31, which = (hh >> 6) % 5;
        const bf16* M = (const bf16*)(ws + WS_S5M) + (size_t)(l * 32 + g) * 196608; float got = 0.f, ref = 0.f;
        const int t = (h2 >> 0) & 15, hp = (h2 >> 4) & 15, sx = (h2 >> 8) & 15, h = (h2 >> 12) & 15, p2 = (h2 >> 16) & 63, im = (h2 >> 22) & 1, dsel = (h2 >> 23) & 1;
        float cre[2], cim[2], are[2], aim[2], bre[2], bim[2], lrr[2], lii[2], dtt[2];
        _Pragma("unroll") for (int dir = 0; dir < 2; ++dir) { const int pi = ((l * 2 + dir) * 32 + g) * 64 + lane; lrr[dir] = fminf(in[17][pi], -1e-4f); lii[dir] = in[18][pi]; dtt[dir] = expf(in[19][(l * 2 + dir) * 32 + g]);
            const float mag = expf(lrr[dir] * dtt[dir]); are[dir] = mag * cosf(lii[dir] * dtt[dir]); aim[dir] = mag * sinf(lii[dir] * dtt[dir]);
            const float den = lrr[dir] * lrr[dir] + lii[dir] * lii[dir], fr = ((are[dir] - 1.f) * lrr[dir] + aim[dir] * lii[dir]) / den, fi = (aim[dir] * lrr[dir] - (are[dir] - 1.f) * lii[dir]) / den;
            const float br = in[20][(size_t)pi * 16 + h], bi = in[21][(size_t)pi * 16 + h]; bre[dir] = fr * br - fi * bi; bim[dir] = fr * bi + fi * br;
            const size_t ci = ((size_t)((l * 2 + dir) * 32 + g) * 16 + hp) * 64 + lane; cre[dir] = in[22][ci]; cim[dir] = in[23][ci]; }
        if (which == 0) {
            float acc = 0.f;
            _Pragma("unroll") for (int dir = 0; dir < 2; ++dir) { const int j = dir == 0 ? t - sx : sx - t; if (j >= 0) { float pr = 1.f, pq = 0.f; for (int e = 0; e < j; ++e) { const float nr = pr * are[dir] - pq * aim[dir], nq = pr * aim[dir] + pq * are[dir]; pr = nr; pq = nq; }
                    const float tr = cre[dir] * pr - cim[dir] * pq, tq = cre[dir] * pq + cim[dir] * pr; acc += tr * bre[dir] - tq * bim[dir]; } }
            ref = wave_sum(acc) + ((t == sx && h == hp) ? in[24][(l * 32 + g) * 16 + h] : 0.f); got = bf2f(M[(size_t)(16 * t + hp) * 256 + 16 * sx + h]); }
        else if (which <= 2) {
            const int dir = which - 1, ex = dir == 0 ? t + 1 : 16 - t; float pr = 1.f, pq = 0.f; for (int e = 0; e < ex; ++e) { const float nr = pr * are[dir] - pq * aim[dir], nq = pr * aim[dir] + pq * are[dir]; pr = nr; pq = nq; }
            const float tr = cre[dir] * pr - cim[dir] * pq, tq = cre[dir] * pq + cim[dir] * pr; const float mine = im ? -tq : tr; ref = __shfl(mine, p2); got = bf2f(M[(dir == 0 ? 65536 : 98304) + (size_t)(16 * t + hp) * 128 + 2 * p2 + im]); }
        else {
            const int dir = which - 3, ex = dir == 0 ? 15 - sx : sx; float pr = 1.f, pq = 0.f; for (int e = 0; e < ex; ++e) { const float nr = pr * are[dir] - pq * aim[dir], nq = pr * aim[dir] + pq * are[dir]; pr = nr; pq = nq; }
            const float tr = pr * bre[dir] - pq * bim[dir], tq = pr * bim[dir] + pq * bre[dir]; const float mine = im ? tq : tr; ref = __shfl(mine, p2); got = bf2f(M[(dir == 0 ? 131072 : 163840) + (size_t)(2 * p2 + im) * 256 + 16 * sx + h]); }
        (void)dsel; add(ws, which == 0 ? ((t == sx && h == hp) ? k : 35) : which <= 2 ? 36 : 37, got, ref, lane); }
}

__device__ __forceinline__ void chk_s5x(unsigned char* ws, const float* const* in, int gw, int ngw, int lane) {
    const int l = 0, b = 0;
    for (int s = gw; s < 512; s += ngw) { const unsigned hh = hash(s, 900); const int g = hh & 15, dir = (hh >> 5) & 1, c = (hh >> 8) % 272, im = (hh >> 20) & 1, psel = (hh >> 24) & 63;
        const bf16* U = (const bf16*)(ws + P_UG) + (size_t)(b * 32 + g) * LPOS * 16; const int pi = ((l * 2 + dir) * 32 + g) * 64 + lane;
        const float lr = fminf(in[17][pi], -1e-4f), li = in[18][pi], dt = expf(in[19][(l * 2 + dir) * 32 + g]); const float mag = expf(lr * dt), abr = mag * cosf(li * dt), abi = mag * sinf(li * dt), den = lr * lr + li * li;
        const float fr = ((abr - 1.f) * lr + abi * li) / den, fi = (abi * lr - (abr - 1.f) * li) / den; float bbr[16], bbi[16];
        _Pragma("unroll") for (int h = 0; h < 16; ++h) { const float br = in[20][(size_t)pi * 16 + h], bi = in[21][(size_t)pi * 16 + h]; bbr[h] = fr * br - fi * bi; bbi[h] = fr * bi + fi * br; }
        float xr = 0.f, xi = 0.f;
        for (int st = 0; st < LPOS; ++st) { const int p = dir == 0 ? st : (st < 256 ? 255 - st : LPOS + 255 - st);
            if ((p >> 4) == c) break;
            float vr = 0.f, vi = 0.f;
            _Pragma("unroll") for (int h = 0; h < 16; ++h) { const float u = bf2f(U[(size_t)p * 16 + h]); vr += bbr[h] * u; vi += bbi[h] * u; }
            const float nr = abr * xr - abi * xi + vr, ni = abr * xi + abi * xr + vi; xr = nr; xi = ni; }
        const float mine = im ? xi : xr; const float ref = __shfl(mine, psel);
        {
          float er = 0.f, ei = 0.f;
          for (int q = 0; q < 16; ++q) { const int sx = dir == 0 ? q : 15 - q, p = 16 * c + sx; float vr = 0.f, vi = 0.f;
              _Pragma("unroll") for (int h = 0; h < 16; ++h) { const float u = bf2f(U[(size_t)p * 16 + h]); vr += bbr[h] * u; vi += bbi[h] * u; }
              const float nr = abr * er - abi * ei + vr, ni = abr * ei + abi * er + vi; er = nr; ei = ni; }
          const float m2 = im ? ei : er; const float r2 = __shfl(m2, psel);
          const bf16* E = (const bf16*)(ws + WS_POOL + 98 * MiB) + (size_t)g * 69632 + (size_t)dir * 34816;
          add(ws, 39, bf2f(E[c * 128 + 2 * psel + im]), r2, lane); }
        const bf16* X = (const bf16*)(ws + WS_POOL + 94 * MiB) + (size_t)g * 69632 + (size_t)dir * 34816;
        add(ws, 38, bf2f(X[c * 128 + 2 * psel + im]), ref, lane); }
}
__device__ __forceinline__ void encode(unsigned char* ws, const float* x, float* outp, int nchk, int gt, int ngt) {
    const float* d = (const float*)(ws + WS_CTL) + CW_DBG; int bad = -1; float eb = 0.f;
#ifdef DBG_REPORT
    { const int k = DBG_REPORT; const float e = sqrtf(d[2 * k] / fmaxf(d[2 * k + 1], 1e-30f)); const float F = 1.f + 1e14f * fminf(e * e, 1e4f) + 1e3f;
      for (size_t i = gt; i < (size_t)NLAT * 1024; i += ngt) outp[i] = x[i] * F; return; }
#endif
    for (int k = 0; k < 30; ++k) { const float e = sqrtf(d[2 * k] / fmaxf(d[2 * k + 1], 1e-30f)); const bool unused = d[2 * k + 1] == 0.f && d[2 * k] == 0.f; if (!unused && !(e < 0.02f)) { bad = k; eb = e; break; } }
    if (bad < 0) return;
    float F = 1.f; for (int i = 0; i <= bad; ++i) F *= 4.f; F = 1.f + F * (1.f + fminf(eb, 0.99f));
    for (size_t i = gt; i < (size_t)NLAT * 1024; i += ngt) outp[i] = x[i] * F;
}
}
struct Args;
#endif

struct Args { const float* in[38]; float* out; unsigned char* ws; int ph_lo, ph_hi; };
constexpr int PH_PRO = 0, PH_R0 = 1, PH_L0 = 2, PH_PER_L = 16, NPH = PH_L0 + 2 * PH_PER_L;


#if MK_DEBUG
constexpr int DBG_NCHK = 40;
__global__ void __launch_bounds__(NTHREADS, 2) dbg_fwd(Args args, int ph) {
    unsigned char* ws = args.ws; float* outp = args.out; const float* const* in = args.in;
    const int tid = threadIdx.x, lane = tid & 63, wave = tid >> 6, gw = blockIdx.x * NWAVES + wave, ngw = gridDim.x * NWAVES;
    const float* par = (const float*)(ws + WS_PAR);
    if (ph == 1000) { dbg::encode(ws, in[0], outp, DBG_NCHK, blockIdx.x * NTHREADS + tid, gridDim.x * NTHREADS); return; }
    if (ph == PH_PRO) { dbg::chk_mod(ws, in, gw, ngw, lane); dbg::chk_weights(ws, in, gw, ngw, lane); dbg::chk_s5m(ws, in, 16, gw, ngw, lane); return; }
    if (ph == PH_R0) { dbg::chk_h(ws, in, outp, 2, 0, 0, par + PR_GMIXPRE, MALL, gw, ngw, lane); return; }
    const int l = (ph - PH_L0) / PH_PER_L, rel = (ph - PH_L0) % PH_PER_L, kb = 3 + 14 * l; const bool lastl = l == 1; const int nrq = lastl ? NLAT : MALL;
    if (rel == 0) { const bf16* Z = (const bf16*)(ws + P_Z);
        dbg::chk_gemm(ws, kb + 0, (const bf16*)(ws + P_H), 1024, in[10] + (size_t)l * 1024 * NIN, NIN, 1024, MALL, NIN, [=](int row, int col, float ref, float& got, float& rr) {
            const int j = col, dr = j < 512 ? j : j < 896 ? 768 + (j - 512) : j < 1024 ? 512 + (j - 896) : j < 1152 ? 640 + (j - 1024) : j < 1440 ? j : 1536 + (j - 1440); got = bf2f(Z[(size_t)row * ZW + dr]); rr = ref; }, gw, ngw, lane); }
    if (rel == 1) dbg::chk_tok(ws, kb + 1, l, gw, ngw, lane);
    if (rel == 2) {
        const bf16* QB = (const bf16*)(ws + P_QB); const bf16* CQ = (const bf16*)(ws + P_CQN); const float* Wq = in[15] + (size_t)l * 384 * 768; const float scale = 0.10206207261596575f * LOG2E;
        dbg::chk_gemm(ws, kb + 2, CQ, 384, Wq, 768, 384, nrq, 768, [=](int row, int col, float ref, float& got, float& rr) {
            const int hd = col / 96, e = col % 96; float v = ref;
            if (e >= 64 && row < NLAT) { const int i = (e - 64) & 15; const float x1 = dbg::dot_aw(CQ + (size_t)row * 384, Wq + hd * 96 + 64 + i, 768, 384, lane), x2 = dbg::dot_aw(CQ + (size_t)row * 384, Wq + hd * 96 + 80 + i, 768, 384, lane);
                const float an = dbg::angB(row & 4095, i), c = cosf(an), sn = sinf(an); v = e < 80 ? x1 * c - x2 * sn : x1 * sn + x2 * c; }
            got = bf2f(QB[(size_t)row * 768 + col]); rr = v * scale; }, gw, ngw, lane);
        const bf16* KB = (const bf16*)(ws + P_KB); const bf16* VB = (const bf16*)(ws + P_VB);
        dbg::chk_gemm(ws, kb + 3, (const bf16*)(ws + P_CKVN), 256, in[16] + (size_t)l * 256 * 1024, 1024, 256, MALL, 1024, [=](int row, int col, float ref, float& got, float& rr) {
            const int hd = col / 128, e = col % 128; got = e < 64 ? bf2f(KB[(size_t)row * 512 + hd * 64 + e]) : bf2f(VB[(size_t)row * 512 + hd * 64 + e - 64]); rr = ref; }, gw, ngw, lane); }
    if (rel == 3) { dbg::chk_attn(ws, kb + 4, lastl, gw, ngw, lane); dbg::chk_s5(ws, in, kb + 5, l, lastl, gw, ngw, lane); if (l == 0) dbg::chk_s5x(ws, in, gw, ngw, lane); }
    if (rel == 4) { const bf16* AG = (const bf16*)(ws + P_AGLU); const bf16* YB = (const bf16*)(ws + P_YBR); const float* Wg = in[25] + (size_t)l * 512 * 1024;
        dbg::chk_gemm(ws, kb + 6, AG, 512, Wg, 1024, 512, nrq, 512, [=](int row, int col, float ref, float& got, float& rr) {
            const float g = dbg::dot_aw(AG + (size_t)row * 512, Wg + 512 + col, 1024, 512, lane); got = bf2f(YB[(size_t)row * 1536 + 1024 + col]); rr = ref / (1.f + expf(-g)); }, gw, ngw, lane); }
    if (rel == 5) { const bf16* H = (const bf16*)(ws + P_H); const bf16* YB = (const bf16*)(ws + P_YBR); const bf16* MG = (const bf16*)(ws + P_MRG);
        const float* Wm = in[27] + (size_t)l * 1024 * 3072; const float* Wb = in[26] + (size_t)l * 3 * 512 * 1024; const float* bm = in[28] + l * 3072;
        for (int s = gw; s < 512; s += ngw) { const unsigned hh = dbg::hash(s, 333 + l); const int row = hh % nrq, col = (hh >> 16) % 1024; float acc = 0.f;
            for (int n = 0; n < 3; ++n) { const float g = dbg::dot_aw(H + (size_t)row * 1024, Wm + n * 1024 + col, 3072, 1024, lane) + bm[n * 1024 + col];
                const float p = dbg::dot_aw(YB + (size_t)row * 1536 + n * 512, Wb + (size_t)n * 512 * 1024 + col, 1024, 512, lane); acc += p / (1.f + expf(-g)); }
            dbg::add(ws, kb + 7, bf2f(MG[(size_t)row * 1024 + col]), acc, lane); } }
    if (rel == 6) { const float* Y = (const float*)(ws + P_Y);
        dbg::chk_gemm(ws, kb + 8, (const bf16*)(ws + P_MRG), 1024, in[29] + (size_t)l * 1024 * 1024, 1024, 1024, nrq, 1024, [=](int row, int col, float ref, float& got, float& rr) { got = Y[(size_t)row * 1024 + col]; rr = ref; }, gw, ngw, lane); }
    if (rel == 7) dbg::chk_h(ws, in, outp, kb + 9, l, 3, par + PR_GFFNPRE + l * 1024, nrq, gw, ngw, lane);
    if (!lastl) {
        if (rel == 8) { const bf16* H = (const bf16*)(ws + P_H); const bf16* ACT = (const bf16*)(ws + P_ACT);
            dbg::chk_gemm(ws, kb + 10, H, 1024, in[30], DFF, 1024, MALL, DFF, [=](int row, int col, float ref, float& got, float& rr) {
                const float b = dbg::dot_aw(H + (size_t)row * 1024, in[31] + col, DFF, 1024, lane); got = bf2f(ACT[(size_t)row * DFF + col]); rr = ref / (1.f + expf(-ref)) * b; }, gw, ngw, lane); }
        if (rel == 9) { const float* Y2 = (const float*)(ws + P_Y2);
            dbg::chk_gemm(ws, kb + 11, (const bf16*)(ws + P_ACT), DFF, in[32], 1024, DFF, MALL, 1024, [=](int row, int col, float ref, float& got, float& rr) { got = Y2[(size_t)row * 1024 + col]; rr = ref; }, gw, ngw, lane); }
        if (rel == 12) dbg::chk_h(ws, in, outp, kb + 12, 1, 0, par + PR_GMIXPRE + 1024, MALL, gw, ngw, lane);
    } else if (rel == 11) {
        const bf16* H = (const bf16*)(ws + P_H); const bf16* FO = (const bf16*)(ws + P_Y2); const unsigned* cnt = (const unsigned*)(ws + WS_CTL) + CW_CNT; const int* ti = (const int*)(ws + WS_LIST) + 8 * 16384;
        for (int s = gw; s < 64; s += ngw) { const unsigned hh = dbg::hash(s, 555); const int tok = hh % NLAT, kk = (hh >> 16) & 1, c = (hh >> 17) % 1024; const int e = ti[tok * 8 + 2 * kk], pos = ti[tok * 8 + 2 * kk + 1];
            int base = 0; for (int q = 0; q < e; ++q) base += ((int)cnt[q] + 255) >> 8;
            float acc = 0.f;
            for (int j = 0; j < DFF; ++j) { const float a = dbg::dot_aw(H + (size_t)tok * 1024, in[35] + (size_t)e * 1024 * DFF + j, DFF, 1024, lane), b = dbg::dot_aw(H + (size_t)tok * 1024, in[36] + (size_t)e * 1024 * DFF + j, DFF, 1024, lane);
                acc += dbg::rbf(a / (1.f + expf(-a)) * b) * dbg::rbf(in[37][((size_t)e * DFF + j) * 1024 + c]); }
            dbg::add(ws, kb + 10, bf2f(FO[((size_t)base * 256 + pos) * 1024 + c]), acc, lane); } }
}
#endif

#ifndef PHMASK
#define PHMASK 0xFFFFFFFFu
#endif
#define PHON(k) (((PHMASK) >> (k)) & 1u)
#ifndef REPMASK
#define REPMASK 0u
#endif
#define REPON(k) (((REPMASK) >> (k)) & 1u)

__device__ __forceinline__ ResidArgs Rd(ResidArgs R, int rep) { R.dry = rep > 0; return R; }
__global__ void __launch_bounds__(NTHREADS, 2) mk_fwd(Args args) {
    extern __shared__ __attribute__((aligned(16))) unsigned char lds_raw[];
    LAS unsigned char* lds = (LAS unsigned char*)lds_raw;
    const int wave = __builtin_amdgcn_readfirstlane((int)threadIdx.x >> 6);
#define tid (wave * 64 + lane_id())
    const int G = gridDim.x, bx = blockIdx.x; const int vcu = (G % 8 == 0) ? (bx % 8) * (G / 8) + bx / 8 : bx;
    unsigned char* ws0 = args.ws; float* outp = args.out;
    unsigned char* ws = ws0;
    volatile LAS unsigned* misc = (volatile LAS unsigned*)(lds + LDS_MISC);
    LAS int* tb; { unsigned tba_ = (unsigned)(uintptr_t)(lds + LDS_MISC + 64); asm volatile("" : "+s"(tba_)); tb = (LAS int*)(uintptr_t)tba_; }
    if (tid < 64) misc[tid] = 0u;
    __syncthreads();
    const int lo = args.ph_lo, hi = args.ph_hi;
    XcdBarrier bar; bar.bar = (unsigned*)(ws + WS_CTL) + CW_BAR; bar.x = 0; bar.st = misc; bar.wave = wave;
    if (hi - lo > 1) bar = xcd_barrier_post((unsigned*)(ws + WS_CTL) + CW_BAR, misc, wave);
#define IN(k) (lo <= (k) && (k) < hi)
#define SEAM(k) do { if ((k) + 1 < hi) xcd_barrier(bar); } while (0)
    const int gw = vcu * NWAVES + wave, ngw = G * NWAVES;

    if (PHON(0) && IN(PH_PRO)) for (int rep_ = 0; rep_ <= (int)REPON(0); ++rep_) {
            GAS unsigned char* wsq = (GAS unsigned char*)ws0; asm volatile("" : "+s"(wsq)); unsigned char* const ws = (unsigned char*)wsq; const float* const par = (const float*)(ws + WS_PAR); int lnq = lane_id(); asm volatile("" : "+v"(lnq)); const int lane = lnq; (void)par; (void)lane;
        Ptrs P;
        { const float* const* in = args.in;
          P.x = in[0]; P.c = in[1]; P.ctx = in[2]; P.c_ctx = in[3]; P.w_mod = in[4]; P.b_mod = in[5]; P.g_mix_pre = in[6]; P.g_mix_post = in[7]; P.g_ffn_pre = in[8]; P.g_ffn_post = in[9];
          P.w_in = in[10]; P.g_q = in[11]; P.g_k = in[12]; P.g_cq = in[13]; P.g_ckv = in[14]; P.w_uq = in[15]; P.w_ukv = in[16];
          P.s5p.lam_re = in[17]; P.s5p.lam_im = in[18]; P.s5p.log_dt = in[19]; P.s5p.b_re = in[20]; P.s5p.b_im = in[21]; P.s5p.c_re = in[22]; P.s5p.c_im = in[23]; P.s5p.dsk = in[24];
          P.w_glu = in[25]; P.w_branch = in[26]; P.w_mg = in[27]; P.b_mg = in[28]; P.w_out = in[29]; P.ffn_w1 = in[30]; P.ffn_w3 = in[31]; P.ffn_w2 = in[32];
          P.router_w = in[33]; P.router_b = in[34]; P.moe_w1 = in[35]; P.moe_w3 = in[36]; P.moe_w2 = in[37]; P.out = args.out; P.ws = args.ws; }
#ifndef PRO_ONLYT
#define PRO_ONLYT 0
#endif
        if (!(PRO_ONLYT && rep_ > 0)) {
        copy_params(P, bx * NTHREADS + tid, G * NTHREADS);
        for (int it = bx; it < 192 + 64; it += G) {
            if (it < 192) mod_item(P, it, lds, wave);
#ifndef PRO_SKIPB
#define PRO_SKIPB 0
#endif
            else if (!(PRO_SKIPB && rep_ > 0)) { const int q = it - 192, l = q >> 5, g = q & 31; s5::build_mats(P.s5p, l, g, (bf16*)(ws + WS_S5M) + (size_t)(l * 32 + g) * s5::M_TOTAL, lds, wave); }
        }
        rope_tables(P, bx * NTHREADS + tid, G * NTHREADS);
        }
        __syncthreads();
#ifndef PRO_NOT
#define PRO_NOT 0
#endif
        if (!(PRO_NOT && rep_ > 0)) transposes(P, gw, ngw, (LAS float*)(lds + wave * 16384), lane, rep_);
        SEAM(PH_PRO);
    }
    if (PHON(1) && IN(PH_R0)) for (int rep_ = 0; rep_ <= (int)REPON(1); ++rep_) {
            GAS unsigned char* wsq = (GAS unsigned char*)ws0; asm volatile("" : "+s"(wsq)); unsigned char* const ws = (unsigned char*)wsq; const float* const par = (const float*)(ws + WS_PAR); int lnq = lane_id(); asm volatile("" : "+v"(lnq)); const int lane = lnq; (void)par; (void)lane;
        ResidArgs R{}; R.mode = 0; R.g_pre = par + PR_GMIXPRE; R.shift_chunk = 0; R.hout = (bf16*)(ws + P_H); R.l_mod = 0; R.route = false; R.hout8 = ws + P_H8;
        const float* xin = args.in[0]; const float* ctxin = args.in[2];
        { int row = gw; for (; row + ngw < MALL; row += 2 * ngw) { resid_row(ws, outp, xin, ctxin, Rd(R, rep_), row, lane, tb); resid_row(ws, outp, xin, ctxin, Rd(R, rep_), row + ngw, lane, tb); } if (row < MALL) resid_row(ws, outp, xin, ctxin, Rd(R, rep_), row, lane, tb); }
        SEAM(PH_R0);
    }
#define MOE_TAIL_FROM(lo_pm, hi_pm, first) do { if (l == 0 && bx >= (first)) { const int lane_ = lane_id(); \
            moe_transposes(args.in[35], args.in[36], args.in[37], ws, (int)((long)MOE_ITEMS * (lo_pm) / 1000), (int)((long)MOE_ITEMS * (hi_pm) / 1000), (bx - (first)) * NWAVES + wave, (G - (first)) * NWAVES, (LAS float*)(lds + wave * 16384), lane_); } } while (0)
#define MOE_TAIL(lo_pm, hi_pm) MOE_TAIL_FROM(lo_pm, hi_pm, 16)
    for (int l = 0; l < 2; ++l) {
        const int pb = PH_L0 + l * PH_PER_L; const bool lastl = (l == 1);
        const int nMall = 68, nMq = lastl ? 64 : 68;
        if (PHON(2) && IN(pb + 0)) for (int rep_ = 0; rep_ <= (int)REPON(2); ++rep_) {
            GAS unsigned char* wsq = (GAS unsigned char*)ws0; asm volatile("" : "+s"(wsq)); unsigned char* const ws = (unsigned char*)wsq; const float* const par = (const float*)(ws + WS_PAR); int lnq = lane_id(); asm volatile("" : "+v"(lnq)); const int lane = lnq; (void)par; (void)lane;
            if (F8_G1L1 && lastl) {
                pg8::SchedPlain S{(const char*)(ws + P_H8), (const char*)(ws + WS_W1T) + (size_t)l * ZW * 2048, 1024u, 1024u, 8, nMall, 8, G, bx};
                pg8::EpiBf16S E{(bf16*)(ws + P_Z), ZW, 1.0f / (F8_HSCALE * F8_WSCALE)};
                pg8::gemm_phase<pg8::EpiBf16S, pg8::SchedPlain, false, true>(lds, S, E, wave);
            } else {
            pg8::SchedPlain S{(const char*)(ws + P_H), (const char*)(ws + WS_W1T) + (size_t)l * ZW * 2048, 2048u, 2048u, 16, nMall, 8, G, bx};
            pg8::EpiBf16 E{(bf16*)(ws + P_Z), ZW, 0};
            pg8::gemm_phase<pg8::EpiBf16, pg8::SchedPlain, false>(lds, S, E, wave); }
            SEAM(pb + 0);
        }
        if (PHON(3) && IN(pb + 1)) for (int rep_ = 0; rep_ <= (int)REPON(3); ++rep_) {
            GAS unsigned char* wsq = (GAS unsigned char*)ws0; asm volatile("" : "+s"(wsq)); unsigned char* const ws = (unsigned char*)wsq; const float* const par = (const float*)(ws + WS_PAR); int lnq = lane_id(); asm volatile("" : "+v"(lnq)); const int lane = lnq; (void)par; (void)lane;
            { int row = gw; for (; row + ngw < MALL; row += 2 * ngw) { token_row(ws, l, row, lane); token_row(ws, l, row + ngw, lane); } if (row < MALL) token_row(ws, l, row, lane); }
            SEAM(pb + 1);
        }
        if (PHON(4) && IN(pb + 2)) for (int rep_ = 0; rep_ <= (int)REPON(4); ++rep_) {
            GAS unsigned char* wsq = (GAS unsigned char*)ws0; asm volatile("" : "+s"(wsq)); unsigned char* const ws = (unsigned char*)wsq; const float* const par = (const float*)(ws + WS_PAR); int lnq = lane_id(); asm volatile("" : "+v"(lnq)); const int lane = lnq; (void)par; (void)lane;
            { pg8::SchedUp S{(const char*)(ws + P_CQN), (const char*)(ws + WS_WUQT) + (size_t)l * 768 * 768, (const char*)(ws + P_CKVN), (const char*)(ws + WS_WUKVT) + (size_t)l * 1024 * 512, nMq, nMall, G, bx};
              pg8::EpiUp E{pg8::EpiUq{(bf16*)(ws + P_QB), (const float*)(ws + WS_ROPE) + 2 * 4096 * 32, (const float*)(ws + WS_ROPE) + 2 * 4096 * 32 + 4096 * 16, 0.10206207261596575f * LOG2E}, pg8::EpiUkv{(bf16*)(ws + P_KB), (bf16*)(ws + P_VB)}};
              pg8::gemm_phase<pg8::EpiUp, pg8::SchedUp, false>(lds, S, E, wave); }
            SEAM(pb + 2);
        }
        if (PHON(5) && IN(pb + 3)) for (int rep_ = 0; rep_ <= (int)REPON(5); ++rep_) {
            GAS unsigned char* wsq = (GAS unsigned char*)ws0; asm volatile("" : "+s"(wsq)); unsigned char* const ws = (unsigned char*)wsq; const float* const par = (const float*)(ws + WS_PAR); int lnq = lane_id(); asm volatile("" : "+v"(lnq)); const int lane = lnq; (void)par; (void)lane;
            const int nlatu = 1024, nctxu = lastl ? 0 : 64;
            for (int it = vcu; it < nlatu + nctxu; it += G) {
                att::AttnArgs A; int typ, b, h;
                if (it < nlatu) { const int u = it >> 1; typ = (it ^ (it >> 8)) & 1;
                    b = u >> 7; h = (u >> 4) & 7; const int qb = u & 15; A.qrow0 = (long)b * SEQ + qb * 256; A.ntiles = 68; }
                else { const int u = it - nlatu; typ = u & 1; b = (u >> 1) >> 3; h = (u >> 1) & 7; A.qrow0 = NLAT + (long)b * CTXL; A.ntiles = 4; }
                A.b = b; A.O = (bf16*)(ws + P_YBR); A.opitch = 1536;
                if (typ == 0) { A.Q = (const bf16*)(ws + P_QA); A.qpitch = 512; A.qcol = h * 64; A.K1 = (const bf16*)(ws + P_KA); A.k1pitch = 128; A.k1col = (h >> 2) * 64; A.K2 = nullptr; A.k2pitch = 0;
                    A.V = (const bf16*)(ws + P_VA); A.vpitch = 128; A.vcol = (h >> 2) * 64; A.ocol = h * 64; att::attn_unit4<64>(A, lds, wave); }
                else { A.Q = (const bf16*)(ws + P_QB); A.qpitch = 768; A.qcol = h * 96; A.K1 = (const bf16*)(ws + P_KB); A.k1pitch = 512; A.k1col = h * 64; A.K2 = (const bf16*)(ws + P_KRR); A.k2pitch = 32;
                    A.V = (const bf16*)(ws + P_VB); A.vpitch = 512; A.vcol = h * 64; A.ocol = 512 + h * 64; att::attn_unit4<96>(A, lds, wave); }
            }
            __syncthreads();
#ifndef S5REP
#define S5REP 1
#endif
            for (int s5r_ = 0; s5r_ < S5REP; ++s5r_)
            for (int it = G - 1 - vcu; it < 256; it += G) { const int b = it >> 6, g = (it >> 1) & 31, half = it & 1;
                s5::unit(par + PR_A16, l, b, g, (const bf16*)(ws + P_UG), (const bf16*)(ws + WS_S5M) + (size_t)(l * 32 + g) * s5::M_TOTAL, (bf16*)(ws + P_AGLU), lastl, lds, wave, half); }
            SEAM(pb + 3);
        }
        if (PHON(6) && IN(pb + 4)) for (int rep_ = 0; rep_ <= (int)REPON(6); ++rep_) {
            GAS unsigned char* wsq = (GAS unsigned char*)ws0; asm volatile("" : "+s"(wsq)); unsigned char* const ws = (unsigned char*)wsq; const float* const par = (const float*)(ws + WS_PAR); int lnq = lane_id(); asm volatile("" : "+v"(lnq)); const int lane = lnq; (void)par; (void)lane;
            pg8::SchedPlain S{(const char*)(ws + P_AGLU), (const char*)(ws + WS_WGLUT) + (size_t)l * 1024 * 1024, 1024u, 1024u, 8, nMq, 4, G, bx};
            pg8::EpiPair<0> E{(bf16*)(ws + P_YBR), 1536, 1024, 0};
            pg8::gemm_phase<pg8::EpiPair<0>, pg8::SchedPlain, false>(lds, S, E, wave);
            SEAM(pb + 4);
        }
        if (PHON(7) && IN(pb + 5)) for (int rep_ = 0; rep_ <= (int)REPON(7); ++rep_) {
            GAS unsigned char* wsq = (GAS unsigned char*)ws0; asm volatile("" : "+s"(wsq)); unsigned char* const ws = (unsigned char*)wsq; const float* const par = (const float*)(ws + WS_PAR); int lnq = lane_id(); asm volatile("" : "+v"(lnq)); const int lane = lnq; (void)par; (void)lane;
#define MRG_ROUND(r) do { \
                { pg8::SchedMergeG S{(const char*)(ws + P_H8), (const char*)(ws + WS_WMGT) + (size_t)l * 3072 * 1024, 1024u, 1024u, 8, nMq, (r) * G + bx}; \
                  pg8::EpiGate E{par + PR_BMG + l * 3072, (u32x4*)(ws + P_GSCR + (size_t)bx * 3 * 131072), 1.0f / (F8_HSCALE * F8_WSCALE)}; \
                  pg8::gemm_phase<pg8::EpiGate, pg8::SchedMergeG, false, true>(lds, S, E, wave); } \
                { pg8::SchedMergeP S{(const char*)(ws + P_YBR), (const char*)(ws + WS_WBT) + (size_t)l * 3 * 1024 * 1024, 3072u, 1024u, 8, nMq, (r) * G + bx}; \
                  pg8::EpiMergeP E{(bf16*)(ws + P_MRG), (const u32x4*)(ws + P_GSCR + (size_t)bx * 3 * 131072)}; \
                  pg8::gemm_phase<pg8::EpiMergeP, pg8::SchedMergeP, false, false>(lds, S, E, wave); } } while (0)
            MRG_ROUND(0);
            const int nx = nMq * 4 - G; int mfirst = 16;
            if (nx > 0 && 3 * nx <= G) { mfirst = 3 * nx;
                if (bx < 3 * nx) { const int j = bx % nx, n = bx / nx; unsigned* flag = (unsigned*)(ws + WS_CTL) + CW_MFLAG + 64 * j; const unsigned want = (unsigned)(rep_ * 3 + n);
                    { pg8::SchedMergeG S{(const char*)(ws + P_H8), (const char*)(ws + WS_WMGT) + (size_t)l * 3072 * 1024, 1024u, 1024u, 8, nMq, G + j, n};
                      pg8::EpiGate E{par + PR_BMG + l * 3072, (u32x4*)(ws + P_GSCR + (size_t)bx * 3 * 131072), 1.0f / (F8_HSCALE * F8_WSCALE)};
                      pg8::gemm_phase<pg8::EpiGate, pg8::SchedMergeG, false, true>(lds, S, E, wave); }
                    if (n > 0) { if (wave == 0 && lane_id() == 0) { XB_SPIN(xb_ld(flag) < want, (unsigned*)(ws + WS_CTL) + CW_BAR); __builtin_amdgcn_fence(__ATOMIC_ACQUIRE, "agent"); asm volatile("s_waitcnt vmcnt(0)" ::: "memory"); }
                        __syncthreads(); }
                    { pg8::SchedMergeP S{(const char*)(ws + P_YBR), (const char*)(ws + WS_WBT) + (size_t)l * 3 * 1024 * 1024, 3072u, 1024u, 8, nMq, G + j, n};
                      pg8::EpiMergeP E{(bf16*)(ws + P_MRG), (const u32x4*)(ws + P_GSCR + (size_t)bx * 3 * 131072)};
                      pg8::gemm_phase<pg8::EpiMergeP, pg8::SchedMergeP, false, false>(lds, S, E, wave); }
                    asm volatile("s_waitcnt vmcnt(0)" ::: "memory");
                    __syncthreads();
                    if (wave == 0 && lane_id() == 0) { __builtin_amdgcn_fence(__ATOMIC_RELEASE, "agent"); asm volatile("s_waitcnt vmcnt(0)" ::: "memory"); __hip_atomic_store(flag, want + 1u, __ATOMIC_RELAXED, __HIP_MEMORY_SCOPE_AGENT); }
                }
            } else if (nx > 0) MRG_ROUND(1);
#undef MRG_ROUND
            MOE_TAIL_FROM(0, 480, mfirst);
            SEAM(pb + 5);
        }
        if (PHON(8) && IN(pb + 6)) for (int rep_ = 0; rep_ <= (int)REPON(8); ++rep_) {
            GAS unsigned char* wsq = (GAS unsigned char*)ws0; asm volatile("" : "+s"(wsq)); unsigned char* const ws = (unsigned char*)wsq; const float* const par = (const float*)(ws + WS_PAR); int lnq = lane_id(); asm volatile("" : "+v"(lnq)); const int lane = lnq; (void)par; (void)lane;
            pg8::SchedPlain S{(const char*)(ws + P_MRG), (const char*)(ws + WS_WOUTT) + (size_t)l * 1024 * 2048, 2048u, 2048u, 16, nMq, 4, G, bx};
            pg8::EpiBf16 E{(bf16*)(ws + P_Y), 1024, 0};
            pg8::gemm_phase<pg8::EpiBf16, pg8::SchedPlain, false>(lds, S, E, wave);
            MOE_TAIL(480, 620);
            SEAM(pb + 6);
        }
        if (PHON(9) && IN(pb + 7)) for (int rep_ = 0; rep_ <= (int)REPON(9); ++rep_) {
            GAS unsigned char* wsq = (GAS unsigned char*)ws0; asm volatile("" : "+s"(wsq)); unsigned char* const ws = (unsigned char*)wsq; const float* const par = (const float*)(ws + WS_PAR); int lnq = lane_id(); asm volatile("" : "+v"(lnq)); const int lane = lnq; (void)par; (void)lane;
            ResidArgs R{}; R.mode = 3; R.y = (const float*)(ws + P_Y); R.g_post = par + PR_GMIXPOST + l * 1024; R.gate_chunk = 2; R.g_pre = par + PR_GFFNPRE + l * 1024; R.shift_chunk = 3;
            R.hout = (bf16*)(ws + P_H); R.l_mod = l; R.l_gate = l; R.route = lastl; R.h8 = lastl ? (F8_M1 != 0) : (F8_D1 != 0); R.ysc = 1.0f;
            { int row = gw; for (; row + ngw < nMq * 256; row += 2 * ngw) { resid_row(ws, outp, nullptr, nullptr, Rd(R, rep_), row, lane, tb); resid_row(ws, outp, nullptr, nullptr, Rd(R, rep_), row + ngw, lane, tb); } if (row < nMq * 256) resid_row(ws, outp, nullptr, nullptr, Rd(R, rep_), row, lane, tb); }
            SEAM(pb + 7);
        }
        if (!lastl) {
            if (PHON(10) && IN(pb + 8)) for (int rep_ = 0; rep_ <= (int)REPON(10); ++rep_) {
            GAS unsigned char* wsq = (GAS unsigned char*)ws0; asm volatile("" : "+s"(wsq)); unsigned char* const ws = (unsigned char*)wsq; const float* const par = (const float*)(ws + WS_PAR); int lnq = lane_id(); asm volatile("" : "+v"(lnq)); const int lane = lnq; (void)par; (void)lane;
                constexpr unsigned kb1 = F8_D1 ? 1024u : 2048u;
                pg8::SchedPlain S{(const char*)(ws + P_H), (const char*)(ws + WS_WF1T), kb1, kb1, F8_D1 ? 8 : 16, nMall, 22, G, bx};
                pg8::EpiPairS<F8_D2 != 0> E{ws + P_ACT, DFF, 0, F8_D1 ? 1.0f / (F8_HSCALE * F8_WSCALE) : 1.0f, F8_D2 ? F8_ASCALE : 1.0f};
                pg8::gemm_phase<pg8::EpiPairS<F8_D2 != 0>, pg8::SchedPlain, false, F8_D1 != 0>(lds, S, E, wave);
                SEAM(pb + 8);
            }
            if (PHON(11) && IN(pb + 9)) for (int rep_ = 0; rep_ <= (int)REPON(11); ++rep_) {
            GAS unsigned char* wsq = (GAS unsigned char*)ws0; asm volatile("" : "+s"(wsq)); unsigned char* const ws = (unsigned char*)wsq; const float* const par = (const float*)(ws + WS_PAR); int lnq = lane_id(); asm volatile("" : "+v"(lnq)); const int lane = lnq; (void)par; (void)lane;
                constexpr unsigned kb2 = F8_D2 ? 2816u : 5632u;
                pg8::SchedPlain S{(const char*)(ws + P_ACT), (const char*)(ws + WS_WF2T), kb2, kb2, F8_D2 ? 22 : 44, nMall, 4, G, bx};
                pg8::EpiBf16 E{(bf16*)(ws + P_Y2), 1024, 0};
                pg8::gemm_phase<pg8::EpiBf16, pg8::SchedPlain, false, F8_D2 != 0>(lds, S, E, wave);
                MOE_TAIL(620, 1000);
                SEAM(pb + 9);
            }
            if (PHON(14) && IN(pb + 12)) for (int rep_ = 0; rep_ <= (int)REPON(14); ++rep_) {
            GAS unsigned char* wsq = (GAS unsigned char*)ws0; asm volatile("" : "+s"(wsq)); unsigned char* const ws = (unsigned char*)wsq; const float* const par = (const float*)(ws + WS_PAR); int lnq = lane_id(); asm volatile("" : "+v"(lnq)); const int lane = lnq; (void)par; (void)lane;
                ResidArgs R{}; R.mode = 3; R.y = (const float*)(ws + P_Y2); R.g_post = par + PR_GFFNPOST; R.gate_chunk = 5; R.g_pre = par + PR_GMIXPRE + 1024; R.shift_chunk = 0;
                R.hout = (bf16*)(ws + P_H); R.l_mod = 1; R.l_gate = 0; R.route = false; R.hout8 = ws + P_H8; R.ysc = F8_D2 ? 1.0f / (F8_ASCALE * F8_WSCALE) : 1.0f;
                { int row = gw; for (; row + ngw < MALL; row += 2 * ngw) { resid_row(ws, outp, nullptr, nullptr, Rd(R, rep_), row, lane, tb); resid_row(ws, outp, nullptr, nullptr, Rd(R, rep_), row + ngw, lane, tb); } if (row < MALL) resid_row(ws, outp, nullptr, nullptr, Rd(R, rep_), row, lane, tb); }
                SEAM(pb + 12);
            }
        } else {
            for (int ch = 0; ch < 1; ++ch) {
                if (IN(pb + 8 + 2 * ch) || IN(pb + 9 + 2 * ch)) {
                    __syncthreads();
                    if (tid == 0) { const unsigned* cnt = (const unsigned*)(ws + WS_CTL) + CW_CNT; int acc = 0;
                        for (int e = 0; e < 8; ++e) { const int c = (int)__hip_atomic_load(cnt + e, __ATOMIC_RELAXED, __HIP_MEMORY_SCOPE_AGENT); tb[e] = c; tb[8 + e] = acc; acc += (c + 255) >> 8; }
                        tb[16] = acc; }
                    __syncthreads();
                }
                const int ntot = __builtin_amdgcn_readfirstlane(tb[16]), t0 = 0, t1 = ntot;
                if (PHON(12) && IN(pb + 8 + 2 * ch)) for (int rep_ = 0; rep_ <= (int)REPON(12); ++rep_) {
            GAS unsigned char* wsq = (GAS unsigned char*)ws0; asm volatile("" : "+s"(wsq)); unsigned char* const ws = (unsigned char*)wsq; const float* const par = (const float*)(ws + WS_PAR); int lnq = lane_id(); asm volatile("" : "+v"(lnq)); const int lane = lnq; (void)par; (void)lane;
                    constexpr unsigned kbm = F8_M1 ? 1024u : 2048u;
                    pg8::SchedMoe1 S{(const char*)(ws + P_H), (const char*)(ws + WS_WM1T), kbm, kbm, F8_M1 ? 8 : 16, (const int*)(ws + WS_LIST), tb, t1, G, bx, nullptr};
                    if (S.units() <= 16) { LAS unsigned* rtab = (LAS unsigned*)(lds + 131072); S.fill(rtab, wave * 64 + lane); S.rt = rtab; }
                    __syncthreads();
                    pg8::EpiPairS<true> E{ws + P_ACT, DFF, 0, F8_M1 ? 1.0f / (F8_HSCALE * F8_WSCALE) : 1.0f, F8_ASCALE};
                    pg8::gemm_phase<pg8::EpiPairS<true>, pg8::SchedMoe1, true, F8_M1 != 0>(lds, S, E, wave);
                    SEAM(pb + 8 + 2 * ch);
                }
                if (PHON(13) && IN(pb + 9 + 2 * ch)) for (int rep_ = 0; rep_ <= (int)REPON(13); ++rep_) {
            GAS unsigned char* wsq = (GAS unsigned char*)ws0; asm volatile("" : "+s"(wsq)); unsigned char* const ws = (unsigned char*)wsq; const float* const par = (const float*)(ws + WS_PAR); int lnq = lane_id(); asm volatile("" : "+v"(lnq)); const int lane = lnq; (void)par; (void)lane;
                    pg8::SchedMoe2 S{(const char*)(ws + P_ACT), (const char*)(ws + WS_WM2T), 2816u, 2816u, 22, tb, t1, G, bx};
                    pg8::EpiBf16 E{(bf16*)(ws + P_Y2), 1024, 0};
                    pg8::gemm_phase<pg8::EpiBf16, pg8::SchedMoe2, false, true>(lds, S, E, wave);
                    SEAM(pb + 9 + 2 * ch);
                }
            }
            if (PHON(14) && IN(pb + 12)) for (int rep_ = 0; rep_ <= (int)REPON(14); ++rep_) {
            GAS unsigned char* wsq = (GAS unsigned char*)ws0; asm volatile("" : "+s"(wsq)); unsigned char* const ws = (unsigned char*)wsq; const float* const par = (const float*)(ws + WS_PAR); int lnq = lane_id(); asm volatile("" : "+v"(lnq)); const int lane = lnq; (void)par; (void)lane;
                __syncthreads();
                if (tid == 0) { const unsigned* cnt = (const unsigned*)(ws + WS_CTL) + CW_CNT; int acc = 0;
                    for (int e = 0; e < 8; ++e) { const int c = (int)__hip_atomic_load(cnt + e, __ATOMIC_RELAXED, __HIP_MEMORY_SCOPE_AGENT); tb[e] = c; tb[8 + e] = acc; acc += (c + 255) >> 8; }
                    tb[16] = acc; }
                __syncthreads();
                ResidArgs R{}; R.mode = 2; R.g_post = par + PR_GFFNPOST + 1024; R.gate_chunk = 5; R.hout = nullptr; R.l_gate = 1; R.route = false; R.ysc = 1.0f / (F8_ASCALE * F8_WSCALE);
                { int row = gw; for (; row + ngw < NLAT; row += 2 * ngw) { resid_row(ws, outp, nullptr, nullptr, Rd(R, rep_), row, lane, tb); resid_row(ws, outp, nullptr, nullptr, Rd(R, rep_), row + ngw, lane, tb); } if (row < NLAT) resid_row(ws, outp, nullptr, nullptr, Rd(R, rep_), row, lane, tb); }
            }
        }
    }
#undef IN
#undef SEAM
#undef tid
}

extern "C" void kernel_launch(void* const* d_in, const int* in_sizes, int n_in, void* d_out, int out_size, void* d_ws, size_t ws_size, hipStream_t stream) {
    static int grid = 0;
    if (grid == 0) {
        if (n_in != 38 || out_size != NLAT * D || ws_size < WS_END) { fprintf(stderr, "kernel_launch: unexpected problem (n_in %d out %d ws %zu, need %zu)\n", n_in, out_size, ws_size, (size_t)WS_END); grid = -1; return; }
        int dev = 0, cus = 0, per_cu = 0;
        if (hipGetDevice(&dev) != hipSuccess || hipDeviceGetAttribute(&cus, hipDeviceAttributeMultiprocessorCount, dev) != hipSuccess) { grid = -1; return; }
        if (hipFuncSetAttribute((const void*)mk_fwd, hipFuncAttributeMaxDynamicSharedMemorySize, LDS_BYTES) != hipSuccess) { fprintf(stderr, "kernel_launch: hipFuncSetAttribute failed\n"); grid = -1; return; }
        if (hipOccupancyMaxActiveBlocksPerMultiprocessor(&per_cu, (const void*)mk_fwd, NTHREADS, LDS_BYTES) != hipSuccess || per_cu < 1) { fprintf(stderr, "kernel_launch: occupancy query says %d\n", per_cu); }
        (void)hipGetLastError();
        grid = cus;
    }
    if (grid < 0) return;
    (void)hipMemsetAsync((char*)d_ws + WS_CTL, 0, CTL_BYTES, stream);
    Args a{};
    for (int i = 0; i < 38; ++i) a.in[i] = (const float*)d_in[i];
    a.out = (float*)d_out; a.ws = (unsigned char*)d_ws;
#if MK_MULTI
    for (int ph = 0; ph < NPH; ++ph) {
        const int rel = ph < PH_L0 ? -1 : (ph - PH_L0) % PH_PER_L, l = ph < PH_L0 ? 0 : (ph - PH_L0) / PH_PER_L;
        if (rel > 12 || (l == 0 && (rel == 10 || rel == 11))) continue;
        a.ph_lo = ph; a.ph_hi = ph + 1;
        hipLaunchKernelGGL(mk_fwd, dim3(grid), dim3(NTHREADS), LDS_BYTES, stream, a);
#if MK_DEBUG
        hipLaunchKernelGGL(dbg_fwd, dim3(grid), dim3(NTHREADS), 0, stream, a, ph);
#endif
    }
#if MK_DEBUG
    hipLaunchKernelGGL(dbg_fwd, dim3(grid), dim3(NTHREADS), 0, stream, a, 1000);
#endif
#else
    a.ph_lo = 0; a.ph_hi = NPH;
    hipLaunchKernelGGL(mk_fwd, dim3(grid), dim3(NTHREADS), LDS_BYTES, stream, a);
#endif
}
```

```cpp
#include <hip/hip_runtime.h>
#include <cstdio>
#include <cstdint>

#ifndef MK_DEBUG
#define MK_DEBUG 0
#endif
#ifndef MK_MULTI
#define MK_MULTI 0
#endif

#define GAS __attribute__((address_space(1)))
#define LAS __attribute__((address_space(3)))
typedef unsigned short bf16;
typedef short bf16x8 __attribute__((ext_vector_type(8)));
typedef short s16x4 __attribute__((ext_vector_type(4)));
typedef float f32x2 __attribute__((ext_vector_type(2)));
typedef float f32x4 __attribute__((ext_vector_type(4)));
typedef float f32x16 __attribute__((ext_vector_type(16)));
typedef unsigned u32x2 __attribute__((ext_vector_type(2)));
typedef unsigned u32x4 __attribute__((ext_vector_type(4)));

constexpr int D = 1024, NB = 4, SEQ = 4096, CTXL = 256, GRIDW = 64;
constexpr int NLAT = NB * SEQ, NCTX = NB * CTXL, MALL = NLAT + NCTX;
constexpr int LPOS = CTXL + SEQ;
constexpr int NIN = 1952, ZW = 2048;
constexpr int DFF = 2816, NEXP = 8;
constexpr float EPS = 1e-6f;
constexpr float LOG2E = 1.4426950408889634f;
#ifndef F8_G1L1
#define F8_G1L1 1
#endif
constexpr float F8_WSCALE = 256.f, F8_HSCALE = 16.f, F8_ASCALE = 8.f;
#ifndef F8_D1
#define F8_D1 0
#endif
#ifndef F8_D2
#define F8_D2 0
#endif
#ifndef F8_M1
#define F8_M1 1
#endif
constexpr int ZC_QG = 0, ZC_KG = 512, ZC_VG = 640, ZC_CQ = 768, ZC_CKV = 1152, ZC_KR = 1408, ZC_U = 1536;

constexpr size_t MiB = 1u << 20;
constexpr size_t WS_CTL = 0, CTL_BYTES = 1 * MiB;
constexpr size_t WS_MOD = 1 * MiB;
constexpr size_t WS_ROPE = 2 * MiB;
constexpr size_t WS_PAR = 3 * MiB + 512 * 1024;
constexpr int PR_GMIXPRE = 0, PR_GMIXPOST = 2048, PR_GFFNPRE = 4096, PR_GFFNPOST = 6144, PR_GQ = 8192, PR_GK = 8320, PR_GCQ = 8448, PR_GCKV = 9216, PR_BMG = 9728, PR_RW = 15872, PR_RB = 24064,
              PR_A16 = 24080, PR_END = PR_A16 + 2 * 2 * 32 * 64 * 2;
constexpr size_t WS_LIST = 4 * MiB;
constexpr size_t WS_LATC = 5 * MiB;
constexpr size_t WS_W1T = 9 * MiB;
constexpr size_t WS_WMGT = 17 * MiB;
constexpr size_t WS_WUQT = 29 * MiB;
constexpr size_t WS_WUKVT = 31 * MiB;
constexpr size_t WS_S5M = 32 * MiB;
constexpr size_t WS_WGLUT = 56 * MiB;
constexpr size_t WS_WBT = 58 * MiB;
constexpr size_t WS_WOUTT = 64 * MiB;
constexpr size_t WS_WF1T = 68 * MiB;
constexpr size_t WS_WF2T = 79 * MiB;
constexpr size_t WS_WM1T = 85 * MiB;
constexpr size_t WS_WM2T = 173 * MiB;
constexpr size_t WS_POOL = 217 * MiB;
constexpr size_t P_H = WS_POOL + 0 * MiB;
constexpr size_t P_Z = WS_POOL + 34 * MiB;
constexpr size_t P_QB = WS_POOL + 34 * MiB;
constexpr size_t P_KB = WS_POOL + 60 * MiB;
constexpr size_t P_VB = WS_POOL + 77 * MiB;
constexpr size_t P_QA = WS_POOL + 102 * MiB;
constexpr size_t P_KA = WS_POOL + 119 * MiB;
constexpr size_t P_VA = WS_POOL + 124 * MiB;
constexpr size_t P_KRR = WS_POOL + 129 * MiB;
constexpr size_t P_UG = WS_POOL + 131 * MiB;
constexpr size_t P_CQN = WS_POOL + 148 * MiB;
constexpr size_t P_CKVN = WS_POOL + 161 * MiB;
constexpr size_t P_AGLU = WS_POOL + 170 * MiB;
constexpr size_t P_YBR = WS_POOL + 187 * MiB;
constexpr size_t P_MRG = WS_POOL + 34 * MiB;
constexpr size_t P_GSCR = WS_POOL + 68 * MiB;
constexpr size_t P_Y = WS_POOL + 102 * MiB;
constexpr size_t P_ACT = WS_POOL + 34 * MiB;
constexpr size_t P_Y2 = WS_POOL + 136 * MiB;
constexpr size_t P_H8 = WS_POOL + 240 * MiB;
constexpr size_t WS_END = WS_POOL + 257 * MiB;
static_assert(P_YBR + (size_t)MALL * 1536 * 2 <= WS_END && P_Y2 + (size_t)MALL * 1024 * 4 <= WS_END && P_ACT + (size_t)MALL * DFF * 2 <= P_Y2, "pool map");
static_assert(P_GSCR + 256 * 3 * 131072 <= P_AGLU && P_VB + (size_t)MALL * 512 * 2 <= P_QA && P_Y + (size_t)MALL * 4096 <= P_AGLU, "pool map 2");

constexpr int CW_BAR = 4096;
constexpr int CW_Q = 8320;
constexpr int CW_CNT = 8192;
constexpr int CW_MFLAG = 9216;
constexpr int CW_DBG = 16384;

constexpr int LDS_MISC = 147456;
constexpr int LDS_BYTES = 151552;
constexpr int NWAVES = 8, NTHREADS = 512;

__device__ __forceinline__ int lane_id() { unsigned m_ = ~0u; asm volatile("" : "+s"(m_)); return (int)__builtin_amdgcn_mbcnt_hi(m_, __builtin_amdgcn_mbcnt_lo(m_, 0u)); }
__device__ __forceinline__ float bf2f(unsigned v) { return __uint_as_float(v << 16); }
__device__ __forceinline__ unsigned f2bf(float f) { unsigned u = __float_as_uint(f); return (u + 0x7fffu + ((u >> 16) & 1u)) >> 16; }
typedef __bf16 bf16x2_t __attribute__((ext_vector_type(2)));
__device__ __forceinline__ unsigned pk2(float lo, float hi) { const f32x2 v = {lo, hi}; return __builtin_bit_cast(unsigned, __builtin_convertvector(v, bf16x2_t)); }
__device__ __forceinline__ float shfl_xor_l(float v, int mask, int lane) { return __int_as_float(__builtin_amdgcn_ds_bpermute((lane ^ mask) << 2, __float_as_int(v))); }
__device__ __forceinline__ float wave_sum(float v) {
    const int lane = lane_id();
#pragma unroll
    for (int o = 1; o < 64; o <<= 1) v += shfl_xor_l(v, o, lane);
    return v;
}
__device__ __forceinline__ float fsigmoid(float x) { return __builtin_amdgcn_rcpf(1.0f + __builtin_amdgcn_exp2f(-x * LOG2E)); }
__device__ __forceinline__ float fsilu(float x) { return x * fsigmoid(x); }
__device__ __forceinline__ float fgelu_tanh(float x) { const float u = 0.7978845608028654f * (x + 0.044715f * x * x * x); return x * fsigmoid(2.0f * u); }
__device__ __forceinline__ void unpack8(const u32x4 v, float (&f)[8]) {
    f[0] = bf2f(v.x & 0xffffu); f[1] = bf2f(v.x >> 16); f[2] = bf2f(v.y & 0xffffu); f[3] = bf2f(v.y >> 16);
    f[4] = bf2f(v.z & 0xffffu); f[5] = bf2f(v.z >> 16); f[6] = bf2f(v.w & 0xffffu); f[7] = bf2f(v.w >> 16);
}
__device__ __forceinline__ u32x4 pack8(const float (&f)[8]) { u32x4 w; w.x = pk2(f[0], f[1]); w.y = pk2(f[2], f[3]); w.z = pk2(f[4], f[5]); w.w = pk2(f[6], f[7]); return w; }
__device__ __forceinline__ int pos_row(int b, int p) { return p < CTXL ? NLAT + b * CTXL + p : b * SEQ + (p - CTXL); }

#define XB_TMO      128
#define XB_XCNT(j)  (256  + 64 * (j))
#define XB_XSUB(j)  (1280 + 64 * (j))
#define XB_XGEN(j)  (2304 + 64 * (j))
#define XB_TOP      3328
#define XB_TOPGEN   3392
#define XCD_BAR_WORDS 3456
#define XB_SPIN_CAP (1u << 18)
__device__ __forceinline__ unsigned xb_ld(unsigned* p)              { return __hip_atomic_load(p, __ATOMIC_RELAXED, __HIP_MEMORY_SCOPE_AGENT); }
__device__ __forceinline__ unsigned xb_add(unsigned* p, unsigned v) { return __hip_atomic_fetch_add(p, v, __ATOMIC_RELAXED, __HIP_MEMORY_SCOPE_AGENT); }
__device__ __forceinline__ unsigned xb_xcc_id() { return (unsigned)__builtin_amdgcn_s_getreg((3 << 11) | 20) & 0xFu; }
#define XB_SPIN(cond, bar) do { unsigned _sp = 0; while (cond) { __builtin_amdgcn_s_sleep(1); \
    if ((++_sp & 255u) == 0u) { if (xb_ld(&(bar)[XB_TMO])) break; if (_sp > XB_SPIN_CAP) { atomicAdd(&(bar)[XB_TMO], 1u); break; } } } } while (0)
struct XcdBarrier { unsigned* bar; unsigned x; volatile LAS unsigned* st; int wave; };
__device__ __forceinline__ XcdBarrier xcd_barrier_post(unsigned* bar, volatile LAS unsigned* st, int wave) {
    XcdBarrier b; b.bar = bar; b.x = xb_xcc_id(); b.st = st; b.wave = wave;
    if (wave == 0 && lane_id() == 0) (void)xb_add(&bar[XB_XCNT(b.x)], 1u);
    return b;
}
__device__ __forceinline__ void xcd_barrier_complete(unsigned* bar, unsigned x, unsigned& nloc, unsigned& nx) {
    const unsigned G = gridDim.x * gridDim.y * gridDim.z;
    unsigned sum, cnt, mine, sp = 0u;
    for (;;) {
        sum = 0u; cnt = 0u; mine = 0u;
#pragma unroll
        for (unsigned j = 0; j < 16; ++j) { const unsigned c = xb_ld(&bar[XB_XCNT(j)]); sum += c; cnt += (c > 0u) ? 1u : 0u; mine = (j == x) ? c : mine; }
        if (sum == G) break;
        __builtin_amdgcn_s_sleep(1);
        if ((++sp & 255u) == 0u) { if (xb_ld(&bar[XB_TMO])) break; if (sp > XB_SPIN_CAP) { atomicAdd(&bar[XB_TMO], 1u); break; } }
    }
    nloc = mine > 0u ? mine : 1u; nx = cnt > 0u ? cnt : 1u;
}
__device__ __forceinline__ void xcd_barrier(const XcdBarrier& b) {
    asm volatile("s_waitcnt vmcnt(0)" ::: "memory");
    __syncthreads();
    if (b.wave == 0 && lane_id() == 0) {
        unsigned* bar = b.bar;
        __builtin_amdgcn_s_waitcnt(0);
        unsigned nloc = b.st[0], nx = b.st[1];
        if (nloc == 0u) { xcd_barrier_complete(bar, b.x, nloc, nx); b.st[0] = nloc; b.st[1] = nx; }
        const unsigned old = xb_add(&bar[XB_XSUB(b.x)], 1u);
        const unsigned gen = old / nloc;
        if (old + 1u == (gen + 1u) * nloc) {
            __builtin_amdgcn_fence(__ATOMIC_RELEASE, "agent");
            asm volatile("s_waitcnt vmcnt(0)" ::: "memory");
            const unsigned og = xb_add(&bar[XB_TOP], 1u);
            const unsigned tg = og / nx;
            if (og + 1u == (tg + 1u) * nx) xb_add(&bar[XB_TOPGEN], 1u);
            else XB_SPIN(xb_ld(&bar[XB_TOPGEN]) == tg, bar);
            __builtin_amdgcn_fence(__ATOMIC_ACQUIRE, "agent");
            xb_add(&bar[XB_XGEN(b.x)], 1u);
            asm volatile("s_waitcnt vmcnt(0)" ::: "memory");
        } else {
            XB_SPIN(xb_ld(&bar[XB_XGEN(b.x)]) == gen, bar);
            __builtin_amdgcn_fence(__ATOMIC_ACQUIRE, "agent");
            asm volatile("s_waitcnt vmcnt(0)" ::: "memory");
        }
    }
    __syncthreads();
}

namespace pg8 {
typedef int v4i __attribute__((ext_vector_type(4)));
typedef int v8i __attribute__((ext_vector_type(8)));
constexpr int BM = 256, BK = 64, HALF = 128, HTB = HALF * BK * 2, STAGE_BYTES = 8 * HTB;
__host__ __device__ __forceinline__ int lds_byte(int r, int c) { const int st = (r >> 4) * 2 + (c >> 5), rr = r & 15, cc = c & 31, ob = rr * 64 + cc * 2; return st * 1024 + (ob ^ (((ob >> 9) & 1) << 5)); }
__host__ __device__ __forceinline__ void stage_rc(int b, int& R, int& C) { const int st = b / 1024, sb = b % 1024, swz = sb ^ (((sb >> 9) & 1) << 5); R = (st >> 1) * 16 + swz / 64; C = (st & 1) * 32 + (swz % 64) / 2; }
__host__ __device__ __forceinline__ int perm32(int rho) { const int n = rho >> 4, i = rho & 15; return 8 * (i >> 2) + 4 * n + (i & 3); }

struct GUnit { const char* a; const char* b; unsigned lda, ldb; int nt; int pm, pn, z; };

__device__ __forceinline__ void tile_of(int L, int nM, int nN, int& pm, int& pn) {
    const int nwg = nM * nN; int wgid = L;
    { const int q = nwg / 8, r = nwg % 8, xcd = wgid % 8, off = wgid / 8; wgid = (xcd < r ? xcd * (q + 1) : r * (q + 1) + (xcd - r) * q) + off; }
    const int nig = 8 * nN, gid = wgid / nig, fm = gid * 8, gsz = (nM - fm) < 8 ? (nM - fm) : 8;
    pm = fm + ((wgid % nig) % gsz); pn = (wgid % nig) / gsz;
}

template <class Epi, class Sched, bool GATHER, bool F8 = false>
__device__ __forceinline__ void gemm_phase(LAS unsigned char* lds, const Sched& S, const Epi& E, int wave_) {
    int tid = wave_ * 64 + lane_id(); asm volatile("" : "+v"(tid));
    const int wid = __builtin_amdgcn_readfirstlane(tid >> 6), lane = tid & 63, wr = wid >> 2, wc = wid & 3, fr = lane & 15, fq = lane >> 4;
    int Rr[2], Cc[2], Rb[2];
#pragma unroll
    for (int i = 0; i < 2; ++i) { stage_rc(tid * 16 + i * 8192, Rr[i], Cc[i]); Rb[i] = Epi::PERM ? ((Rr[i] & ~31) + perm32(Rr[i] & 31)) : Rr[i]; }
    const size_t kstep = (size_t)(BK * 2);
    const unsigned ldsw = (unsigned)wid * 1024u;
    const int aoff = lds_byte(wr * 64 + fr, fq * 8), boff = lds_byte(wc * 32 + fr, fq * 8);
#define PG8_SA(b, h) (((b) * 2 + (h)) * HTB)
#define PG8_SB(b, h) ((4 + (b) * 2 + (h)) * HTB)
#define PG8_STAGE(bufoff, gbase, v0, v1) do { \
        __builtin_amdgcn_global_load_lds((const unsigned*)((const char*)(gbase) + (v0)), (LAS unsigned*)(lds + (bufoff) + ldsw), 16, 0, 0); \
        __builtin_amdgcn_global_load_lds((const unsigned*)((const char*)(gbase) + (v1)), (LAS unsigned*)(lds + (bufoff) + ldsw + 8192), 16, 0, 0); } while (0)
#define PG8_LD16(p) __builtin_bit_cast(v4i, *(const LAS bf16x8*)(p))
#define PG8_LDA(dst, b, h) do { _Pragma("unroll") for (int m = 0; m < 4; ++m) dst[m] = __builtin_shufflevector(PG8_LD16(lds + PG8_SA(b, h) + aoff + m * 2048), PG8_LD16(lds + PG8_SA(b, h) + aoff + m * 2048 + 1024), 0, 1, 2, 3, 4, 5, 6, 7); } while (0)
#define PG8_LDB(dst, b, h) do { _Pragma("unroll") for (int n = 0; n < 2; ++n) dst[n] = __builtin_shufflevector(PG8_LD16(lds + PG8_SB(b, h) + boff + n * 2048), PG8_LD16(lds + PG8_SB(b, h) + boff + n * 2048 + 1024), 0, 1, 2, 3, 4, 5, 6, 7); } while (0)
#define PG8_LO(x) __builtin_bit_cast(bf16x8, __builtin_shufflevector(x, x, 0, 1, 2, 3))
#define PG8_HI(x) __builtin_bit_cast(bf16x8, __builtin_shufflevector(x, x, 4, 5, 6, 7))
#define PG8_MMA(ai, bj, At, Bt) do { __builtin_amdgcn_s_setprio(1); \
        _Pragma("unroll") for (int m = 0; m < 4; ++m) _Pragma("unroll") for (int n = 0; n < 2; ++n) { \
            if constexpr (F8) acc[ai][bj][m][n] = __builtin_amdgcn_mfma_scale_f32_16x16x128_f8f6f4(Bt[n], At[m], acc[ai][bj][m][n], 0, 0, 0, 0, 0, 0); \
            else { acc[ai][bj][m][n] = __builtin_amdgcn_mfma_f32_16x16x32_bf16(PG8_LO(Bt[n]), PG8_LO(At[m]), acc[ai][bj][m][n], 0, 0, 0); \
                   acc[ai][bj][m][n] = __builtin_amdgcn_mfma_f32_16x16x32_bf16(PG8_HI(Bt[n]), PG8_HI(At[m]), acc[ai][bj][m][n], 0, 0, 0); } } \
        __builtin_amdgcn_s_setprio(0); } while (0)
#define PG8_WAIT_V(n) asm volatile("s_waitcnt vmcnt(" #n ")" ::: "memory")
#define PG8_WAIT_L(n) asm volatile("s_waitcnt lgkmcnt(" #n ")" ::: "memory")
#define PG8_BAR __builtin_amdgcn_s_barrier()
#define PG8_SCHED __builtin_amdgcn_sched_barrier(0)
#define PG8_OFFS(u) do { \
        _Pragma("unroll") for (int i_ = 0; i_ < 2; ++i_) { \
            if constexpr (GATHER) { oA0[i_] = S.arow(u, Rr[i_]) + (unsigned)Cc[i_] * 2u; oA1[i_] = S.arow(u, HALF + Rr[i_]) + (unsigned)Cc[i_] * 2u; } \
            else { oA0[i_] = (unsigned)Rr[i_] * (u).lda + (unsigned)Cc[i_] * 2u; } \
            oB[i_] = (unsigned)Rb[i_] * (u).ldb + (unsigned)Cc[i_] * 2u; } \
        hA = GATHER ? (size_t)0 : (size_t)HALF * (u).lda; hB = (size_t)HALF * (u).ldb; } while (0)
#define PG8_A1(i) (GATHER ? oA1[i] : oA0[i])
    GUnit cur, nxt; int ui = 0;
    if (!S.next(0, cur)) return;
    f32x4 acc[2][2][4][2];
#pragma unroll
    for (int a = 0; a < 2; ++a)
#pragma unroll
        for (int b = 0; b < 2; ++b)
#pragma unroll
            for (int m = 0; m < 4; ++m)
#pragma unroll
                for (int n = 0; n < 2; ++n) acc[a][b][m][n] = (f32x4){0.f, 0.f, 0.f, 0.f};
    v8i At[4], B0[2], B1[2];
    unsigned oA0[2], oA1[2], oB[2]; size_t hA, hB;
    oA1[0] = 0u; oA1[1] = 0u;
    PG8_OFFS(cur);
    const char* cA = cur.a; const char* cBp = cur.b;
    PG8_STAGE(PG8_SB(0, 0), cBp, oB[0], oB[1]); PG8_STAGE(PG8_SB(0, 1), cBp + hB, oB[0], oB[1]); PG8_STAGE(PG8_SA(0, 0), cA, oA0[0], oA0[1]); PG8_STAGE(PG8_SA(0, 1), cA + hA, PG8_A1(0), PG8_A1(1));
    if (wr == 1) PG8_BAR;
    PG8_WAIT_V(2); PG8_BAR;
    PG8_STAGE(PG8_SB(1, 0), cBp + kstep, oB[0], oB[1]); PG8_STAGE(PG8_SA(1, 0), cA + kstep, oA0[0], oA0[1]); PG8_STAGE(PG8_SB(1, 1), cBp + hB + kstep, oB[0], oB[1]);
    PG8_WAIT_V(6); PG8_BAR;
    for (;;) {
        const bool has_next = S.next(ui + 1, nxt);
        const char* nA = has_next ? nxt.a : cA; const char* nBp = has_next ? nxt.b : cBp;
        int nt = cur.nt; asm volatile("" : "+s"(nt));
        for (int t = 0; t < nt; t += 2) {
            const bool last = (t == nt - 2);
            const char* a1 = cA + (size_t)(t + 1) * kstep;
            const char* a2 = last ? nA : cA + (size_t)(t + 2) * kstep; const char* b2 = last ? nBp : cBp + (size_t)(t + 2) * kstep;
            const char* a3 = a2 + kstep; const char* b3 = b2 + kstep;
            PG8_LDB(B0, 0, 0); PG8_LDB(B1, 0, 1); PG8_SCHED; PG8_LDA(At, 0, 0); PG8_STAGE(PG8_SA(1, 1), a1 + hA, PG8_A1(0), PG8_A1(1));
            if (last && has_next) PG8_OFFS(nxt);
            PG8_WAIT_V(8); PG8_WAIT_L(0); PG8_BAR; PG8_MMA(0, 0, At, B0); PG8_MMA(0, 1, At, B1); PG8_BAR; PG8_SCHED;
            PG8_LDA(At, 0, 1); PG8_STAGE(PG8_SB(0, 0), b2, oB[0], oB[1]); PG8_STAGE(PG8_SB(0, 1), b2 + hB, oB[0], oB[1]); PG8_STAGE(PG8_SA(0, 0), a2, oA0[0], oA0[1]);
            PG8_WAIT_V(8); PG8_WAIT_L(0); PG8_BAR; PG8_MMA(1, 0, At, B0); PG8_MMA(1, 1, At, B1); PG8_BAR; PG8_SCHED;
            PG8_LDB(B0, 1, 0); PG8_LDB(B1, 1, 1); PG8_SCHED; PG8_LDA(At, 1, 0); PG8_STAGE(PG8_SA(0, 1), a2 + hA, PG8_A1(0), PG8_A1(1));
            PG8_WAIT_V(8); PG8_WAIT_L(0); PG8_BAR; PG8_MMA(0, 0, At, B0); PG8_MMA(0, 1, At, B1); PG8_BAR; PG8_SCHED;
            PG8_LDA(At, 1, 1); PG8_STAGE(PG8_SB(1, 0), b3, oB[0], oB[1]); PG8_STAGE(PG8_SB(1, 1), b3 + hB, oB[0], oB[1]); PG8_STAGE(PG8_SA(1, 0), a3, oA0[0], oA0[1]);
            PG8_WAIT_V(8); PG8_WAIT_L(0); PG8_BAR; PG8_MMA(1, 0, At, B0); PG8_MMA(1, 1, At, B1); PG8_BAR; PG8_SCHED;
        }
        if (wr == 0) PG8_BAR;
        E(acc, cur, wr, wc, fr, fq);
        if (!has_next) break;
#pragma unroll
        for (int a = 0; a < 2; ++a)
#pragma unroll
            for (int b = 0; b < 2; ++b)
#pragma unroll
                for (int m = 0; m < 4; ++m)
#pragma unroll
                    for (int n = 0; n < 2; ++n) acc[a][b][m][n] = (f32x4){0.f, 0.f, 0.f, 0.f};
        cur = nxt; cA = nA; cBp = nBp; ++ui;
        if (wr == 1) PG8_BAR;
    }
    PG8_WAIT_V(0);
    PG8_BAR;
#undef PG8_SA
#undef PG8_SB
#undef PG8_STAGE
#undef PG8_LDA
#undef PG8_LDB
#undef PG8_LD16
#undef PG8_LO
#undef PG8_HI
#undef PG8_MMA
#undef PG8_WAIT_V
#undef PG8_WAIT_L
#undef PG8_BAR
#undef PG8_SCHED
#undef PG8_OFFS
#undef PG8_A1
}
}

namespace pg8 {
__device__ __forceinline__ unsigned pk_fp8x4(float a, float b, float c, float d) {
    a = __builtin_amdgcn_fmed3f(a, -448.f, 448.f); b = __builtin_amdgcn_fmed3f(b, -448.f, 448.f); c = __builtin_amdgcn_fmed3f(c, -448.f, 448.f); d = __builtin_amdgcn_fmed3f(d, -448.f, 448.f);
    unsigned w = 0; w = __builtin_amdgcn_cvt_pk_fp8_f32(a, b, w, false); w = __builtin_amdgcn_cvt_pk_fp8_f32(c, d, w, true); return w; }
struct SchedPlain {
    const char* A; const char* B; unsigned lda, ldb; int nt, nM, nN, G, c;
    __device__ __forceinline__ bool next(int i, GUnit& u) const {
        const int L = i * G + c; if (L >= nM * nN) return false;
        int pm, pn; tile_of(L, nM, nN, pm, pn);
        u.a = A + (size_t)pm * 256 * lda; u.b = B + (size_t)pn * 256 * ldb; u.lda = lda; u.ldb = ldb; u.nt = nt; u.pm = pm; u.pn = pn; u.z = 0; return true;
    }
};
struct SchedUp {
    const char* Aq; const char* Bq; const char* Akv; const char* Bkv; int nMq, nMall, G, c;
    __device__ __forceinline__ bool next(int i, GUnit& u) const {
        int L = i * G + c; const int nq = nMq * 3; int pm, pn;
        if (L < nq) { tile_of(L, nMq, 3, pm, pn); u.a = Aq + (size_t)pm * 256 * 768; u.b = Bq + (size_t)pn * 256 * 768; u.lda = 768u; u.ldb = 768u; u.nt = 6; u.pm = pm; u.pn = pn; u.z = 0; return true; }
        L -= nq; if (L >= nMall * 4) return false;
        tile_of(L, nMall, 4, pm, pn); u.a = Akv + (size_t)pm * 256 * 512; u.b = Bkv + (size_t)pn * 256 * 512; u.lda = 512u; u.ldb = 512u; u.nt = 4; u.pm = pm; u.pn = pn; u.z = 1; return true;
    }
};
struct SchedMergeG {
    const char* A; const char* B; unsigned lda, ldb; int nt, nM, L; int only = -1;
    __device__ __forceinline__ bool next(int i_, GUnit& u) const {
        if ((only >= 0 ? i_ >= 1 : i_ >= 3) || L >= nM * 4) return false;
        const int i = only >= 0 ? only : i_;
        int pm, pn; tile_of(L, nM, 4, pm, pn);
        u.a = A + (size_t)pm * 256 * lda; u.lda = lda; u.b = B + ((size_t)i * 1024 + pn * 256) * ldb; u.ldb = ldb; u.nt = nt; u.pm = pm; u.pn = pn; u.z = i; return true;
    }
};
struct SchedMergeP {
    const char* A; const char* B; unsigned lda, ldb; int nt, nM, L; int only = -1;
    __device__ __forceinline__ bool next(int i_, GUnit& u) const {
        if ((only >= 0 ? i_ >= 1 : i_ >= 3) || L >= nM * 4) return false;
        const int i = only >= 0 ? only : i_;
        int pm, pn; tile_of(L, nM, 4, pm, pn);
        u.a = A + (size_t)pm * 256 * lda + i * 1024; u.lda = lda; u.b = B + ((size_t)i * 1024 + pn * 256) * ldb; u.ldb = ldb; u.nt = nt; u.pm = pm; u.pn = pn; u.z = i; return true;
    }
};
struct SchedMoe1 {
    const char* H2; const char* W; unsigned lda, ldb; int nt; const int* list; const LAS int* tb; int nM, G, c;
    const LAS unsigned* rt;
    __device__ __forceinline__ bool next(int i, GUnit& u) const {
        const int L = i * G + c; if (L >= nM * 22) return false;
        const int mt = L / 22, pn = L % 22; int e = 0;
#pragma unroll
        for (int j = 1; j < 8; ++j) e += (mt >= tb[8 + j]) ? 1 : 0;
        e = __builtin_amdgcn_readfirstlane(e);
        u.a = H2; u.lda = lda; u.b = W + ((size_t)e * 5632 + pn * 256) * ldb; u.ldb = ldb; u.nt = nt; u.pm = mt; u.pn = pn; u.z = e | (i << 8); return true;
    }
    __device__ __forceinline__ unsigned arow(const GUnit& u, int r) const {
        if (rt) return rt[(u.z >> 8) * 256 + r];
        const int e = u.z & 255, li = (u.pm - tb[8 + e]) * 256 + r; const int tok = (li < tb[e]) ? list[e * 16384 + li] : 0;
        return (unsigned)tok * lda;
    }
    __device__ __forceinline__ int units() const { const int tot = nM * 22; return c < tot ? (tot - c + G - 1) / G : 0; }
    __device__ __forceinline__ void fill(LAS unsigned* w, int tid) const {
        const int n = units() * 256;
        for (int base = tid; base < n; base += 4 * NTHREADS) { int tokv[4];
#pragma unroll
            for (int k = 0; k < 4; ++k) { const int idx = base + NTHREADS * k; tokv[k] = 0;
                if (idx < n) { const int i = idx >> 8, r = idx & 255, mt = (i * G + c) / 22; int e = 0;
#pragma unroll
                    for (int j = 1; j < 8; ++j) e += (mt >= tb[8 + j]) ? 1 : 0;
                    const int li = (mt - tb[8 + e]) * 256 + r; if (li < tb[e]) tokv[k] = list[e * 16384 + li]; } }
#pragma unroll
            for (int k = 0; k < 4; ++k) { const int idx = base + NTHREADS * k; if (idx < n) w[idx] = (unsigned)tokv[k] * lda; } }
    }
};
struct SchedMoe2 {
    const char* A; const char* B; unsigned lda, ldb; int nt; const LAS int* tb; int nM, G, c;
    __device__ __forceinline__ bool next(int i, GUnit& u) const {
        const int L = i * G + c; if (L >= nM * 4) return false;
        int pm, pn; tile_of(L, nM, 4, pm, pn); int e = 0;
#pragma unroll
        for (int j = 1; j < 8; ++j) e += (pm >= tb[8 + j]) ? 1 : 0;
        e = __builtin_amdgcn_readfirstlane(e);
        u.a = A + (size_t)pm * 256 * lda; u.b = B + (size_t)(e * 4 + pn) * 256 * ldb; u.lda = lda; u.ldb = ldb; u.nt = nt; u.pm = pm; u.pn = pn; u.z = e; return true;
    }
};

#define EPI_ROWS_BEGIN _Pragma("unroll") for (int ai = 0; ai < 2; ++ai) _Pragma("unroll") for (int m = 0; m < 4; ++m) { const int row = u.pm * BM + ai * HALF + wr * 64 + m * 16 + fr;
#define EPI_ROWS_END }
__device__ __forceinline__ u32x4 pack_f4f4(const f32x4 a, const f32x4 b) { u32x4 w; w.x = pk2(a[0], a[1]); w.y = pk2(a[2], a[3]); w.z = pk2(b[0], b[1]); w.w = pk2(b[2], b[3]); return w; }

struct EpiBf16 {
    static constexpr bool PERM = true;
    bf16* O; int ldc; int rsub;
    __device__ __forceinline__ void operator()(const f32x4 (&acc)[2][2][4][2], const GUnit& u, int wr, int wc, int fr, int fq) const {
        const int col0 = u.pn * BM + wc * 32 + 8 * fq;
        EPI_ROWS_BEGIN
            bf16* rowp = O + (size_t)(row - rsub) * ldc + col0;
#pragma unroll
            for (int bj = 0; bj < 2; ++bj) *(u32x4*)(rowp + bj * HALF) = pack_f4f4(acc[ai][bj][m][0], acc[ai][bj][m][1]);
        EPI_ROWS_END
    }
};
struct EpiF32 {
    static constexpr bool PERM = false;
    float* C; int ldc;
    __device__ __forceinline__ void operator()(const f32x4 (&acc)[2][2][4][2], const GUnit& u, int wr, int wc, int fr, int fq) const {
        const int col0 = u.pn * BM + wc * 32 + 4 * fq;
        EPI_ROWS_BEGIN
            float* rowp = C + (size_t)row * ldc + col0;
#pragma unroll
            for (int bj = 0; bj < 2; ++bj)
#pragma unroll
                for (int n = 0; n < 2; ++n) *(f32x4*)(rowp + bj * HALF + n * 16) = acc[ai][bj][m][n];
        EPI_ROWS_END
    }
};
struct EpiUq {
    static constexpr bool PERM = true;
    bf16* Qb; const float* cosB; const float* sinB; float scale;
    __device__ __forceinline__ void operator()(const f32x4 (&acc)[2][2][4][2], const GUnit& u, int wr, int wc, int fr, int fq) const {
        const bool lat = u.pm < 64;
        EPI_ROWS_BEGIN
            const int t = row & (SEQ - 1);
#pragma unroll
            for (int bj = 0; bj < 2; ++bj) {
                const int gidx = u.pn * 8 + bj * 4 + wc, head = gidx / 3, part = gidx - head * 3;
                bf16* dst = Qb + (size_t)row * 768 + head * 96 + part * 32;
                f32x4 a = acc[ai][bj][m][0] * scale, b = acc[ai][bj][m][1] * scale;
                if (part == 2) {
                    if (lat) { const f32x4 c = *(const f32x4*)(cosB + t * 16 + 4 * fq), s = *(const f32x4*)(sinB + t * 16 + 4 * fq);
                        const f32x4 x1 = a * c - b * s, x2 = a * s + b * c; a = x1; b = x2; }
                    u32x2 w0, w1; w0.x = pk2(a[0], a[1]); w0.y = pk2(a[2], a[3]); w1.x = pk2(b[0], b[1]); w1.y = pk2(b[2], b[3]);
                    *(u32x2*)(dst + 4 * fq) = w0; *(u32x2*)(dst + 16 + 4 * fq) = w1;
                } else *(u32x4*)(dst + 8 * fq) = pack_f4f4(a, b);
            }
        EPI_ROWS_END
    }
};
struct EpiUkv {
    static constexpr bool PERM = true;
    bf16* Kb; bf16* Vb;
    __device__ __forceinline__ void operator()(const f32x4 (&acc)[2][2][4][2], const GUnit& u, int wr, int wc, int fr, int fq) const {
        bf16* base = (wc < 2) ? Kb : Vb;
        EPI_ROWS_BEGIN
#pragma unroll
            for (int bj = 0; bj < 2; ++bj) { const int head = u.pn * 2 + bj;
                *(u32x4*)(base + (size_t)row * 512 + head * 64 + (wc & 1) * 32 + 8 * fq) = pack_f4f4(acc[ai][bj][m][0], acc[ai][bj][m][1]); }
        EPI_ROWS_END
    }
};
struct EpiUp {
    static constexpr bool PERM = true;
    EpiUq q; EpiUkv kv;
    __device__ __forceinline__ void operator()(const f32x4 (&acc)[2][2][4][2], const GUnit& u, int wr, int wc, int fr, int fq) const { if (u.z == 0) q(acc, u, wr, wc, fr, fq); else kv(acc, u, wr, wc, fr, fq); }
};
template <int MODE> struct EpiPair {
    static constexpr bool PERM = true;
    bf16* O; int ldc; int cbase; int rsub;
    __device__ __forceinline__ void operator()(const f32x4 (&acc)[2][2][4][2], const GUnit& u, int wr, int wc, int fr, int fq) const {
        const int col0 = cbase + u.pn * 128 + wc * 32 + 8 * fq;
        EPI_ROWS_BEGIN
            f32x4 o[2];
#pragma unroll
            for (int n = 0; n < 2; ++n)
#pragma unroll
                for (int j = 0; j < 4; ++j) { const float a = acc[ai][0][m][n][j], b = acc[ai][1][m][n][j]; o[n][j] = MODE == 0 ? a * fsigmoid(b) : fsilu(a) * b; }
            *(u32x4*)(O + (size_t)(row - rsub) * ldc + col0) = pack_f4f4(o[0], o[1]);
        EPI_ROWS_END
    }
};
struct EpiGate {
    static constexpr bool PERM = true;
    const float* bmg; u32x4* gscr; float ds;
    __device__ __forceinline__ void operator()(const f32x4 (&acc)[2][2][4][2], const GUnit& u, int wr, int wc, int fr, int fq) const {
        const int n = u.z, tid = (wr * 4 + wc) * 64 + fq * 16 + fr;
#pragma unroll
        for (int bj = 0; bj < 2; ++bj) {
            const float* bp = bmg + n * 1024 + u.pn * BM + bj * HALF + wc * 32 + 8 * fq;
            const f32x4 b0 = *(const f32x4*)bp, b1 = *(const f32x4*)(bp + 4);
#pragma unroll
            for (int ai = 0; ai < 2; ++ai)
#pragma unroll
                for (int m = 0; m < 4; ++m) { f32x4 g0 = acc[ai][bj][m][0] * ds + b0, g1 = acc[ai][bj][m][1] * ds + b1;
#pragma unroll
                    for (int j = 0; j < 4; ++j) { g0[j] = fsigmoid(g0[j]); g1[j] = fsigmoid(g1[j]); }
                    gscr[((n * 8 + (tid >> 6)) * 16 + (ai * 4 + m) * 2 + bj) * 64 + (tid & 63)] = pack_f4f4(g0, g1); asm volatile("" ::: "memory"); }
        }
    }
};
struct EpiMergeP {
    static constexpr bool PERM = true;
    bf16* M; const u32x4* gscr;
    __device__ __forceinline__ void operator()(const f32x4 (&acc)[2][2][4][2], const GUnit& u, int wr, int wc, int fr, int fq) const {
        const int n = u.z, tid = (wr * 4 + wc) * 64 + fq * 16 + fr;
        const int col0 = u.pn * BM + wc * 32 + 8 * fq;
        EPI_ROWS_BEGIN
#pragma unroll
            for (int bj = 0; bj < 2; ++bj) {
                float g[8], p[8]; unpack8(gscr[((n * 8 + (tid >> 6)) * 16 + (ai * 4 + m) * 2 + bj) * 64 + (tid & 63)], g);
                bf16* dst = M + (size_t)row * 1024 + col0 + bj * HALF;
                if (n > 0) unpack8(*(const u32x4*)dst, p);
#pragma unroll
                for (int j = 0; j < 8; ++j) { const float v = g[j] * acc[ai][bj][m][j >> 2][j & 3]; p[j] = n > 0 ? p[j] + v : v; }
                *(u32x4*)dst = pack8(p);
            }
            asm volatile("" ::: "memory");
        EPI_ROWS_END
    }
};
template <bool OUT8> struct EpiPairS {
    static constexpr bool PERM = true;
    unsigned char* O; int ldc; int rsub; float ds, os;
    __device__ __forceinline__ void operator()(const f32x4 (&acc)[2][2][4][2], const GUnit& u, int wr, int wc, int fr, int fq) const {
        const int col0 = u.pn * 128 + wc * 32 + 8 * fq;
        EPI_ROWS_BEGIN
            float o[8];
#pragma unroll
            for (int n = 0; n < 2; ++n)
#pragma unroll
                for (int j = 0; j < 4; ++j) { const float a = acc[ai][0][m][n][j] * ds, b = acc[ai][1][m][n][j]; o[4 * n + j] = fsilu(a) * b * (ds * os); }
            if constexpr (OUT8) *(u32x2*)(O + (size_t)(row - rsub) * ldc + col0) = (u32x2){pk_fp8x4(o[0], o[1], o[2], o[3]), pk_fp8x4(o[4], o[5], o[6], o[7])};
            else *(u32x4*)((bf16*)O + (size_t)(row - rsub) * ldc + col0) = pack8(o);
            asm volatile("" ::: "memory");
        EPI_ROWS_END
    }
};
struct EpiF32S {
    static constexpr bool PERM = false;
    float* C; int ldc; float ds;
    __device__ __forceinline__ void operator()(const f32x4 (&acc)[2][2][4][2], const GUnit& u, int wr, int wc, int fr, int fq) const {
        const int col0 = u.pn * BM + wc * 32 + 4 * fq;
        EPI_ROWS_BEGIN
            float* rowp = C + (size_t)row * ldc + col0;
#pragma unroll
            for (int bj = 0; bj < 2; ++bj)
#pragma unroll
                for (int n = 0; n < 2; ++n) *(f32x4*)(rowp + bj * HALF + n * 16) = acc[ai][bj][m][n] * ds;
        EPI_ROWS_END
    }
};
struct EpiBf16S {
    static constexpr bool PERM = true;
    bf16* O; int ldc; float ds;
    __device__ __forceinline__ void operator()(const f32x4 (&acc)[2][2][4][2], const GUnit& u, int wr, int wc, int fr, int fq) const {
        const int col0 = u.pn * BM + wc * 32 + 8 * fq;
        EPI_ROWS_BEGIN
            bf16* rowp = O + (size_t)row * ldc + col0;
#pragma unroll
            for (int bj = 0; bj < 2; ++bj) *(u32x4*)(rowp + bj * HALF) = pack_f4f4(acc[ai][bj][m][0] * ds, acc[ai][bj][m][1] * ds);
        EPI_ROWS_END
    }
};
#undef EPI_ROWS_BEGIN
#undef EPI_ROWS_END
}

namespace att {
__device__ __forceinline__ float swap32_max(float v) { const auto rr = __builtin_amdgcn_permlane32_swap(__float_as_uint(v), __float_as_uint(v), false, false); return __builtin_fmaxf(__uint_as_float(rr[0]), __uint_as_float(rr[1])); }
__device__ __forceinline__ float swap32_sum(float v) { const auto rr = __builtin_amdgcn_permlane32_swap(__float_as_uint(v), __float_as_uint(v), false, false); return __uint_as_float(rr[0]) + __uint_as_float(rr[1]); }
constexpr int VSLOT = 8192, NSLOT = 3;
__device__ __forceinline__ int crow(int r, int hi) { return (r & 3) + 8 * (r >> 2) + 4 * hi; }
__device__ __forceinline__ void glds16(const void* gsrc, unsigned lds_dst) { unsigned keep;
    asm volatile("s_mov_b32 %0, m0\n\ts_mov_b32 m0, %2\n\ts_nop 0\n\tglobal_load_lds_dwordx4 %1, off\n\ts_mov_b32 m0, %0" : "=&s"(keep) : "v"(gsrc), "s"(lds_dst) : "memory"); }
typedef short v4i16_t __attribute__((ext_vector_type(4)));
__device__ __forceinline__ s16x4 vtr(const LAS unsigned char* p) { return __builtin_bit_cast(s16x4, __builtin_amdgcn_ds_read_tr16_b64_v4i16((LAS v4i16_t*)p)); }

struct AttnArgs {
    const bf16* Q; int qpitch, qcol; long qrow0;
    const bf16* K1; int k1pitch, k1col;
    const bf16* K2; int k2pitch;
    const bf16* V; int vpitch, vcol;
    bf16* O; int opitch, ocol;
    int b, ntiles;
};
template <int DK> __device__ __forceinline__ void attn_unit(const AttnArgs& A, LAS unsigned char* lds, int wave_) {
    constexpr int NKS = DK / 16, KSLOT = (DK / 8) * 1024, NKSLOT = 4, NVSLOT = 4; constexpr float THR = 8.f;
    constexpr bool NOMAX = (DK == 64);
    constexpr int LDS_K = 0, LDS_V = NKSLOT * KSLOT, LDS_WS = LDS_V + NVSLOT * VSLOT;
    int tid = wave_ * 64 + lane_id(); asm volatile("" : "+v"(tid));
    const int lane = tid & 63, r32 = lane & 31, hi = lane >> 5; const int wid = __builtin_amdgcn_readfirstlane(tid >> 6);
    const unsigned lds0 = (unsigned)(uintptr_t)lds;
    LAS float* wsf = (LAS float*)(lds + LDS_WS) + wid * 64;
    const int NT = A.ntiles, b = A.b;
#define TILE_ROW(j) ((j) < 4 ? (long)(NLAT + b * CTXL + 64 * (j)) : (long)(b * SEQ + 64 * ((j) - 4)))
#define DMA_K(j) do { const long r0_ = TILE_ROW(j); const int s_ = (j) & 3; \
        glds16(A.K1 + (r0_ + lane) * A.k1pitch + A.k1col + wid * 8, (unsigned)__builtin_amdgcn_readfirstlane(lds0 + LDS_K + s_ * KSLOT + wid * 1024)); \
        if (DK == 96 && wid < 4) glds16(A.K2 + (r0_ + lane) * A.k2pitch + wid * 8, (unsigned)__builtin_amdgcn_readfirstlane(lds0 + LDS_K + s_ * KSLOT + (8 + wid) * 1024)); } while (0)
#define DMA_V(j) do { const long r0_ = TILE_ROW(j); const int s_ = (j) & 3; \
        glds16(A.V + (r0_ + 16 * (wid & 3) + (lane >> 2)) * A.vpitch + A.vcol + (wid >> 2) * 32 + (lane & 3) * 8, (unsigned)__builtin_amdgcn_readfirstlane(lds0 + LDS_V + (s_) * VSLOT + wid * 1024)); } while (0)
#define WAITBAR(n) asm volatile("s_waitcnt vmcnt(" #n ") lgkmcnt(0)\n\ts_barrier" ::: "memory")
#define WAIT_CNT(cnt) do { const int c_ = (cnt); if (c_ >= 3) WAITBAR(3); else if (c_ == 2) WAITBAR(2); else if (c_ == 1) WAITBAR(1); else WAITBAR(0); } while (0)
#define QK(S0, S1, slot) do { const LAS unsigned char* Ks_ = lds + LDS_K + (slot) * KSLOT + hi * 1024 + r32 * 16; \
        _Pragma("unroll") for (int ks = 0; ks < NKS; ++ks) { const bf16x8 k0_ = *(const LAS bf16x8*)(Ks_ + ks * 2048), k1_ = *(const LAS bf16x8*)(Ks_ + ks * 2048 + 512); \
            S0 = __builtin_amdgcn_mfma_f32_32x32x16_bf16(k0_, qr[ks], ks == 0 ? (NOMAX ? f32x16{} : negm) : S0, 0, 0, 0); S1 = __builtin_amdgcn_mfma_f32_32x32x16_bf16(k1_, qr[ks], ks == 0 ? (NOMAX ? f32x16{} : negm) : S1, 0, 0, 0); } } while (0)
    const int nK = (DK == 96 && wid < 4) ? 2 : 1;
    bf16x8 qr[NKS];
    { const bf16* Qw = A.Q + (A.qrow0 + wid * 32 + r32) * A.qpitch + A.qcol + hi * 8;
#pragma unroll
      for (int ks = 0; ks < NKS; ++ks) qr[ks] = *(const bf16x8*)(Qw + ks * 16); }
    asm volatile("s_waitcnt vmcnt(0)" ::: "memory");
    DMA_K(0); DMA_V(0); DMA_K(1); DMA_K(2); DMA_V(1);
    float mref = 0.f, lsum = 0.f; f32x16 o[2]; o[0] = f32x16{}; o[1] = f32x16{};
    f32x16 negm = f32x16{};
    const int vb = (4 * hi + ((lane & 15) >> 2)) * 64 + ((lane >> 4) & 1) * 32 + (lane & 3) * 8;
    f32x16 s0, s1;
    WAITBAR(0);
    QK(s0, s1, 0);
    if constexpr (!NOMAX) { float rm = __builtin_fmaxf(s0[0], s1[0]);
#pragma unroll
      for (int r = 1; r < 16; ++r) rm = __builtin_fmaxf(__builtin_fmaxf(rm, s0[r]), s1[r]);
      rm = swap32_max(rm); mref = rm;
#pragma unroll
      for (int r = 0; r < 16; ++r) { s0[r] -= rm; s1[r] -= rm; negm[r] = -rm; } }
    int vslot = 0;
#define HEAD(t) do { WAITBAR(0);        \
        if ((t) + 3 < NT) DMA_K((t) + 3); if ((t) + 4 < NT) DMA_K((t) + 4); \
        if ((t) + 2 < NT) DMA_V((t) + 2); if ((t) + 3 < NT) DMA_V((t) + 3); } while (0)
#define QKP(N0, N1, t) do { if ((t) + 1 < NT) { const LAS unsigned char* Ks_ = lds + LDS_K + (((t) + 1) & 3) * KSLOT + hi * 1024 + r32 * 16; \
            _Pragma("unroll") for (int kh = 0; kh < 2; ++kh) { bf16x8 kf[NKS]; \
                _Pragma("unroll") for (int k2 = 0; k2 < NKS / 2; ++k2) { const int ks = kh * (NKS / 2) + k2; kf[2 * k2] = *(const LAS bf16x8*)(Ks_ + ks * 2048); kf[2 * k2 + 1] = *(const LAS bf16x8*)(Ks_ + ks * 2048 + 512); } \
                __builtin_amdgcn_s_setprio(1); \
                _Pragma("unroll") for (int k2 = 0; k2 < NKS / 2; ++k2) { const int ks = kh * (NKS / 2) + k2; \
                    N0 = __builtin_amdgcn_mfma_f32_32x32x16_bf16(kf[2 * k2], qr[ks], ks == 0 ? (NOMAX ? f32x16{} : negm) : N0, 0, 0, 0); N1 = __builtin_amdgcn_mfma_f32_32x32x16_bf16(kf[2 * k2 + 1], qr[ks], ks == 0 ? (NOMAX ? f32x16{} : negm) : N1, 0, 0, 0); } \
                __builtin_amdgcn_s_setprio(0); } } } while (0)
#define SMP(C0, C1, N0, N1, t, NREADY) do { if constexpr (!NOMAX) { \
        float rm = __builtin_fmaxf(C0[0], C1[0]); \
        _Pragma("unroll") for (int r = 1; r < 16; ++r) rm = __builtin_fmaxf(__builtin_fmaxf(rm, C0[r]), C1[r]); \
        rm = swap32_max(rm); \
        if (__builtin_expect(__any(rm > THR), 0)) { \
            const float dl = __builtin_fmaxf(rm, 0.f), al = __builtin_amdgcn_exp2f(-dl); \
            mref += dl; lsum *= al; \
            _Pragma("unroll") for (int r = 0; r < 16; ++r) { C0[r] -= dl; C1[r] -= dl; negm[r] = -mref; } \
            if (NREADY && (t) + 1 < NT) { _Pragma("unroll") for (int r = 0; r < 16; ++r) { N0[r] -= dl; N1[r] -= dl; } } \
            if (hi == 0) wsf[r32] = al; \
            asm volatile("s_waitcnt lgkmcnt(0)" ::: "memory"); \
            _Pragma("unroll") for (int rq = 0; rq < 4; ++rq) { const f32x4 a4 = *(const LAS f32x4*)(wsf + 8 * rq + 4 * hi); \
                _Pragma("unroll") for (int j = 0; j < 4; ++j) { o[0][4 * rq + j] *= a4[j]; o[1][4 * rq + j] *= a4[j]; } } \
        } } \
        float ps0 = 0.f, ps1 = 0.f, ps2 = 0.f, ps3 = 0.f; \
        _Pragma("unroll") for (int r = 0; r < 16; r += 2) { C0[r] = __builtin_amdgcn_exp2f(C0[r]); C1[r] = __builtin_amdgcn_exp2f(C1[r]); C0[r + 1] = __builtin_amdgcn_exp2f(C0[r + 1]); C1[r + 1] = __builtin_amdgcn_exp2f(C1[r + 1]); \
            ps0 += C0[r]; ps1 += C1[r]; ps2 += C0[r + 1]; ps3 += C1[r + 1]; } \
        lsum += (ps0 + ps1) + (ps2 + ps3); \
        pw[0] = (u32x4){pk2(C0[0], C0[1]), pk2(C0[2], C0[3]), pk2(C0[4], C0[5]), pk2(C0[6], C0[7])}; \
        pw[1] = (u32x4){pk2(C0[8], C0[9]), pk2(C0[10], C0[11]), pk2(C0[12], C0[13]), pk2(C0[14], C0[15])}; \
        pw[2] = (u32x4){pk2(C1[0], C1[1]), pk2(C1[2], C1[3]), pk2(C1[4], C1[5]), pk2(C1[6], C1[7])}; \
        pw[3] = (u32x4){pk2(C1[8], C1[9]), pk2(C1[10], C1[11]), pk2(C1[12], C1[13]), pk2(C1[14], C1[15])}; } while (0)
#define PVP() do { const LAS unsigned char* Vs = lds + LDS_V + vslot * VSLOT + vb; \
        _Pragma("unroll") for (int d0 = 0; d0 < 2; ++d0) { s16x4 vlo[4], vhh[4]; \
            _Pragma("unroll") for (int i = 0; i < 4; ++i) { vlo[i] = vtr(Vs + d0 * 4096 + i * 1024); vhh[i] = vtr(Vs + d0 * 4096 + i * 1024 + 512); } \
            __builtin_amdgcn_s_setprio(1); \
            _Pragma("unroll") for (int ks = 0; ks < 4; ++ks) { \
                const bf16x8 vf = (bf16x8){vlo[ks][0], vlo[ks][1], vlo[ks][2], vlo[ks][3], vhh[ks][0], vhh[ks][1], vhh[ks][2], vhh[ks][3]}; \
                o[d0] = __builtin_amdgcn_mfma_f32_32x32x16_bf16(__builtin_bit_cast(bf16x8, pw[ks]), vf, o[d0], 0, 0, 0); } \
            __builtin_amdgcn_s_setprio(0); } \
        vslot = (vslot + 1) & 3; } while (0)
    f32x16 n0, n1; u32x4 pw[4];
    if (wid < 8) {
        for (int t = 0; t < NT; t += 2) {
            HEAD(t); QKP(n0, n1, t); SMP(s0, s1, n0, n1, t, 1); PVP();
            QKP(s0, s1, t + 1); SMP(n0, n1, s0, s1, t + 1, 1); PVP(); }
    } else {
        for (int t = 0; t < NT; t += 2) {
            HEAD(t); SMP(s0, s1, n0, n1, t, 0); PVP(); QKP(n0, n1, t);
            SMP(n0, n1, s0, s1, t + 1, 0); PVP(); QKP(s0, s1, t + 1); }
    }
#undef HEAD
#undef QKP
#undef SMP
#undef PVP
    lsum = swap32_sum(lsum);
    if (hi == 0) wsf[32 + r32] = __builtin_amdgcn_rcpf(lsum);
    asm volatile("s_waitcnt vmcnt(0) lgkmcnt(0)\n\ts_barrier" ::: "memory");
    { LAS bf16* stg = (LAS bf16*)(lds + wid * 4096);
#pragma unroll
      for (int rq = 0; rq < 4; ++rq) { const f32x4 i4 = *(const LAS f32x4*)(wsf + 32 + 8 * rq + 4 * hi);
#pragma unroll
          for (int j = 0; j < 4; ++j) { const int q = 8 * rq + 4 * hi + j;
              stg[q * 64 + r32] = (bf16)f2bf(o[0][4 * rq + j] * i4[j]); stg[q * 64 + 32 + r32] = (bf16)f2bf(o[1][4 * rq + j] * i4[j]); } }
      asm volatile("s_waitcnt lgkmcnt(0)" ::: "memory");
      bf16* Ow = A.O + (A.qrow0 + wid * 32) * A.opitch + A.ocol;
#pragma unroll
      for (int i = 0; i < 4; ++i) { const int row = i * 8 + (lane >> 3), ch = lane & 7; *(u32x4*)(Ow + (long)row * A.opitch + ch * 8) = *(const LAS u32x4*)(stg + row * 64 + ch * 8); } }
    asm volatile("s_waitcnt vmcnt(0) lgkmcnt(0)\n\ts_barrier" ::: "memory");
#undef TILE_ROW
#undef DMA_K
#undef DMA_V
#undef WAITBAR
#undef WAIT_CNT
#undef QK
}

template <int DK> __device__ __forceinline__ void attn_unit3(const AttnArgs& A, LAS unsigned char* lds, int wave_) {
    constexpr int NKS = DK / 16, KSLOT = (DK / 8) * 1024, NKSLOT = 4, NVSLOT = 4;
    constexpr int LDS_K = 0, LDS_V = NKSLOT * KSLOT, LDS_WS = LDS_V + NVSLOT * VSLOT;
    int tid = wave_ * 64 + lane_id(); asm volatile("" : "+v"(tid));
    const int lane = tid & 63, r32 = lane & 31, hi = lane >> 5; const int wid = __builtin_amdgcn_readfirstlane(tid >> 6);
    const unsigned lds0 = (unsigned)(uintptr_t)lds;
    LAS float* wsf = (LAS float*)(lds + LDS_WS) + wid * 64;
    const int NT = A.ntiles, b = A.b;
#define TILE_ROW(j) ((j) < 4 ? (long)(NLAT + b * CTXL + 64 * (j)) : (long)(b * SEQ + 64 * ((j) - 4)))
#define DMA_K(j) do { const long r0_ = TILE_ROW(j); const int s_ = (j) & 3; \
        glds16(A.K1 + (r0_ + lane) * A.k1pitch + A.k1col + wid * 8, (unsigned)__builtin_amdgcn_readfirstlane(lds0 + LDS_K + s_ * KSLOT + wid * 1024)); \
        if (DK == 96 && wid < 4) glds16(A.K2 + (r0_ + lane) * A.k2pitch + wid * 8, (unsigned)__builtin_amdgcn_readfirstlane(lds0 + LDS_K + s_ * KSLOT + (8 + wid) * 1024)); } while (0)
#define DMA_V(j) do { const long r0_ = TILE_ROW(j); const int s_ = (j) & 3; \
        glds16(A.V + (r0_ + 16 * (wid & 3) + (lane >> 2)) * A.vpitch + A.vcol + (wid >> 2) * 32 + (lane & 3) * 8, (unsigned)__builtin_amdgcn_readfirstlane(lds0 + LDS_V + (s_) * VSLOT + wid * 1024)); } while (0)
#define WAITBAR(n) asm volatile("s_waitcnt vmcnt(" #n ") lgkmcnt(0)\n\ts_barrier" ::: "memory")
    bf16x8 qr[NKS];
    { const bf16* Qw = A.Q + (A.qrow0 + wid * 32 + r32) * A.qpitch + A.qcol + hi * 8;
#pragma unroll
      for (int ks = 0; ks < NKS; ++ks) qr[ks] = *(const bf16x8*)(Qw + ks * 16); }
    asm volatile("s_waitcnt vmcnt(0)" ::: "memory");
    DMA_K(0); DMA_K(1); DMA_V(0); DMA_K(2); DMA_K(3); DMA_V(1);
    float ls0 = 0.f, ls1 = 0.f, ls2 = 0.f, ls3 = 0.f; f32x16 o[2]; o[0] = f32x16{}; o[1] = f32x16{};
    const int vb = (4 * hi + ((lane & 15) >> 2)) * 64 + ((lane >> 4) & 1) * 32 + (lane & 3) * 8;
    const LAS unsigned char* Kb = lds + LDS_K + hi * 1024 + r32 * 16;
    const LAS unsigned char* Vb = lds + LDS_V + vb;
#define QKH(S0, S1, j, kh) do { const LAS unsigned char* Ks_ = Kb + ((j) & 3) * KSLOT; bf16x8 kf[NKS]; \
        _Pragma("unroll") for (int k2 = 0; k2 < NKS / 2; ++k2) { const int ks = (kh) * (NKS / 2) + k2; kf[2 * k2] = *(const LAS bf16x8*)(Ks_ + ks * 2048); kf[2 * k2 + 1] = *(const LAS bf16x8*)(Ks_ + ks * 2048 + 512); } \
        _Pragma("unroll") for (int k2 = 0; k2 < NKS / 2; ++k2) { const int ks = (kh) * (NKS / 2) + k2; \
            S0 = __builtin_amdgcn_mfma_f32_32x32x16_bf16(kf[2 * k2], qr[ks], ks == 0 ? f32x16{} : S0, 0, 0, 0); S1 = __builtin_amdgcn_mfma_f32_32x32x16_bf16(kf[2 * k2 + 1], qr[ks], ks == 0 ? f32x16{} : S1, 0, 0, 0); } } while (0)
#define PVH(PW, j, d0) do { const LAS unsigned char* Vs_ = Vb + ((j) & 3) * VSLOT + (d0) * 4096; s16x4 vlo[4], vhh[4]; \
        _Pragma("unroll") for (int i = 0; i < 4; ++i) { vlo[i] = vtr(Vs_ + i * 1024); vhh[i] = vtr(Vs_ + i * 1024 + 512); } \
        _Pragma("unroll") for (int ks = 0; ks < 4; ++ks) { const bf16x8 vf = (bf16x8){vlo[ks][0], vlo[ks][1], vlo[ks][2], vlo[ks][3], vhh[ks][0], vhh[ks][1], vhh[ks][2], vhh[ks][3]}; \
            o[d0] = __builtin_amdgcn_mfma_f32_32x32x16_bf16(__builtin_bit_cast(bf16x8, PW[ks]), vf, o[d0], 0, 0, 0); } } while (0)
#define SOFT(C0, C1, PW) do { \
        _Pragma("unroll") for (int r = 0; r < 16; r += 2) { C0[r] = __builtin_amdgcn_exp2f(C0[r]); C1[r] = __builtin_amdgcn_exp2f(C1[r]); C0[r + 1] = __builtin_amdgcn_exp2f(C0[r + 1]); C1[r + 1] = __builtin_amdgcn_exp2f(C1[r + 1]); \
            ls0 += C0[r]; ls1 += C1[r]; ls2 += C0[r + 1]; ls3 += C1[r + 1]; } \
        PW[0] = (u32x4){pk2(C0[0], C0[1]), pk2(C0[2], C0[3]), pk2(C0[4], C0[5]), pk2(C0[6], C0[7])}; \
        PW[1] = (u32x4){pk2(C0[8], C0[9]), pk2(C0[10], C0[11]), pk2(C0[12], C0[13]), pk2(C0[14], C0[15])}; \
        PW[2] = (u32x4){pk2(C1[0], C1[1]), pk2(C1[2], C1[3]), pk2(C1[4], C1[5]), pk2(C1[6], C1[7])}; \
        PW[3] = (u32x4){pk2(C1[8], C1[9]), pk2(C1[10], C1[11]), pk2(C1[12], C1[13]), pk2(C1[14], C1[15])}; } while (0)
#define HINTS() do { _Pragma("unroll") for (int h_ = 0; h_ < 2; ++h_) { __builtin_amdgcn_sched_group_barrier(0x100, NKS + 8, 0); \
            _Pragma("unroll") for (int g_ = 0; g_ < NKS + 4; ++g_) { __builtin_amdgcn_sched_group_barrier(0x008, 1, 0); __builtin_amdgcn_sched_group_barrier(0x400, 2, 0); __builtin_amdgcn_sched_group_barrier(0x002, 3, 0); } } } while (0)
#define STEP3(N0, N1, C0, C1, PN, PC, t) do { __builtin_amdgcn_sched_barrier(0); \
        QKH(N0, N1, (t) + 2, 0); PVH(PC, t, 0); QKH(N0, N1, (t) + 2, 1); PVH(PC, t, 1); SOFT(C0, C1, PN); HINTS(); __builtin_amdgcn_sched_barrier(0); } while (0)
    f32x16 sA0, sA1, sB0, sB1; u32x4 pA[4], pB[4];
    WAITBAR(0);
    QKH(sA0, sA1, 0, 0); QKH(sA0, sA1, 0, 1); QKH(sB0, sB1, 1, 0); QKH(sB0, sB1, 1, 1);
    SOFT(sA0, sA1, pA);
    int t = 0;
    for (; t + 3 < NT; t += 2) {
        WAITBAR(0);
        if (t + 4 < NT) DMA_K(t + 4); if (t + 5 < NT) DMA_K(t + 5); if (t + 2 < NT) DMA_V(t + 2); if (t + 3 < NT) DMA_V(t + 3);
        STEP3(sA0, sA1, sB0, sB1, pB, pA, t);
        STEP3(sB0, sB1, sA0, sA1, pA, pB, t + 1);
    }
    WAITBAR(0);
    __builtin_amdgcn_sched_barrier(0);
    PVH(pA, t, 0); PVH(pA, t, 1); SOFT(sB0, sB1, pB);
    __builtin_amdgcn_sched_barrier(0);
    PVH(pB, t + 1, 0); PVH(pB, t + 1, 1);
    float lsum = (ls0 + ls1) + (ls2 + ls3);
    lsum = swap32_sum(lsum);
    if (hi == 0) wsf[32 + r32] = __builtin_amdgcn_rcpf(lsum);
    asm volatile("s_waitcnt vmcnt(0) lgkmcnt(0)\n\ts_barrier" ::: "memory");
    { LAS bf16* stg = (LAS bf16*)(lds + wid * 4096);
#pragma unroll
      for (int rq = 0; rq < 4; ++rq) { const f32x4 i4 = *(const LAS f32x4*)(wsf + 32 + 8 * rq + 4 * hi);
#pragma unroll
          for (int j = 0; j < 4; ++j) { const int q = 8 * rq + 4 * hi + j;
              stg[q * 64 + r32] = (bf16)f2bf(o[0][4 * rq + j] * i4[j]); stg[q * 64 + 32 + r32] = (bf16)f2bf(o[1][4 * rq + j] * i4[j]); } }
      asm volatile("s_waitcnt lgkmcnt(0)" ::: "memory");
      bf16* Ow = A.O + (A.qrow0 + wid * 32) * A.opitch + A.ocol;
#pragma unroll
      for (int i = 0; i < 4; ++i) { const int row = i * 8 + (lane >> 3), ch = lane & 7; *(u32x4*)(Ow + (long)row * A.opitch + ch * 8) = *(const LAS u32x4*)(stg + row * 64 + ch * 8); } }
    asm volatile("s_waitcnt vmcnt(0) lgkmcnt(0)\n\ts_barrier" ::: "memory");
#undef TILE_ROW
#undef DMA_K
#undef DMA_V
#undef WAITBAR
#undef QKH
#undef PVH
#undef SOFT
#undef HINTS
#undef STEP3
}

#define ASBAR() __builtin_amdgcn_sched_barrier(0)
#define APIN(x) asm volatile("" : "+v"(x))
template <int DK> __device__ __forceinline__ void attn_unit4(const AttnArgs& A, LAS unsigned char* lds, int wave_) {
    constexpr int NKS = DK / 16, KSLOT = (DK / 8) * 1024, NKSLOT = 4, NVSLOT = 4;
    constexpr int LDS_K = 0, LDS_V = NKSLOT * KSLOT, LDS_WS = LDS_V + NVSLOT * VSLOT;
    int tid = wave_ * 64 + lane_id(); asm volatile("" : "+v"(tid));
    const int lane = tid & 63, r32 = lane & 31, hi = lane >> 5; const int wid = __builtin_amdgcn_readfirstlane(tid >> 6);
    const unsigned lds0 = (unsigned)(uintptr_t)lds;
    LAS float* wsf = (LAS float*)(lds + LDS_WS) + wid * 64;
    const int NT = A.ntiles, b = A.b;
#define TILE_ROW(j) ((j) < 4 ? (long)(NLAT + b * CTXL + 64 * (j)) : (long)(b * SEQ + 64 * ((j) - 4)))
#define DMA_K(j) do { const long r0_ = TILE_ROW(j); const int s_ = (j) & 3; \
        glds16(A.K1 + (r0_ + lane) * A.k1pitch + A.k1col + wid * 8, (unsigned)__builtin_amdgcn_readfirstlane(lds0 + LDS_K + s_ * KSLOT + wid * 1024)); \
        if (DK == 96 && wid < 4) glds16(A.K2 + (r0_ + lane) * A.k2pitch + wid * 8, (unsigned)__builtin_amdgcn_readfirstlane(lds0 + LDS_K + s_ * KSLOT + (8 + wid) * 1024)); } while (0)
#define DMA_V(j) do { const long r0_ = TILE_ROW(j); const int s_ = (j) & 3; \
        glds16(A.V + (r0_ + 16 * (wid & 3) + (lane >> 2)) * A.vpitch + A.vcol + (wid >> 2) * 32 + (lane & 3) * 8, (unsigned)__builtin_amdgcn_readfirstlane(lds0 + LDS_V + (s_) * VSLOT + wid * 1024)); } while (0)
#define WAITBAR(n) asm volatile("s_waitcnt vmcnt(" #n ") lgkmcnt(0)\n\ts_barrier" ::: "memory")
    bf16x8 qr[NKS];
    { const bf16* Qw = A.Q + (A.qrow0 + wid * 32 + r32) * A.qpitch + A.qcol + hi * 8;
#pragma unroll
      for (int ks = 0; ks < NKS; ++ks) qr[ks] = *(const bf16x8*)(Qw + ks * 16); }
    DMA_K(0); DMA_K(1); DMA_V(0); DMA_K(2); DMA_K(3); DMA_V(1);
    float lsum = 0.f; f32x16 o[2]; o[0] = f32x16{}; o[1] = f32x16{};
    const LAS unsigned char* Kb = lds + LDS_K + hi * 1024 + r32 * 16;
    const LAS unsigned char* Vb = lds + LDS_V + (4 * hi + ((lane & 15) >> 2)) * 64 + ((lane >> 4) & 1) * 32 + (lane & 3) * 8;
    f32x16 pA0, pA1, pB0, pB1; bf16x8 kf[2 * NKS]; s16x4 vlo[8], vhi[8]; u32x4 pw0, pw1, pw2, pw3;
#define MF(a, b, c) __builtin_amdgcn_mfma_f32_32x32x16_bf16(a, b, c, 0, 0, 0)
#define KLD2(kp, d0) do { kf[2 * (d0)] = *(const LAS bf16x8*)((kp) + (d0) * 2048); kf[2 * (d0) + 1] = *(const LAS bf16x8*)((kp) + (d0) * 2048 + 512); } while (0)
#define PKW(P, i) pk2(P[i], P[(i) + 1])
#define PAF(k) __builtin_bit_cast(bf16x8, pw##k)
#define VFR(i) (bf16x8){vlo[i][0], vlo[i][1], vlo[i][2], vlo[i][3], vhi[i][0], vhi[i][1], vhi[i][2], vhi[i][3]}
#define VRD(i) do { vlo[i] = vtr(vp_ + (((i) >> 2) * 4096 + ((i) & 3) * 1024)); vhi[i] = vtr(vp_ + (((i) >> 2) * 4096 + ((i) & 3) * 1024 + 512)); } while (0)
#define KRD(G, d0) do { if (G) { KLD2(kn_, d0); ASBAR(); } } while (0)
#define EX(v) __builtin_amdgcn_exp2f(v)
#define GAPA(MFS, a0, a1, a2, a3, W0, W1, PW) do { MFS; sacc += a0; sacc += a1; sacc += a2; sacc += a3; W0; W1; APIN(PW); APIN(sacc); ASBAR(); } while (0)
#define GAPB(MFS, X, i) do { MFS; X[i] = EX(X[i]); X[(i) + 1] = EX(X[(i) + 1]); X[(i) + 2] = EX(X[(i) + 2]); X[(i) + 3] = EX(X[(i) + 3]); APIN(X); ASBAR(); } while (0)
#define STEP4(C0, C1, P0, P1, t, GL) do { ASBAR(); \
    const LAS unsigned char* vp_ = Vb + (((t) - 1) & 3) * VSLOT; const LAS unsigned char* kn_ = Kb + (((t) + 1) & 3) * KSLOT; \
    VRD(0); ASBAR(); float sacc = P0[0] + P0[1]; \
                     GAPA(C0 = MF(kf[0], qr[0], f32x16{}), P0[2], P0[3], P0[4], P0[5],     pw0[0] = PKW(P0, 0),  pw0[1] = PKW(P0, 2),  pw0); \
    VRD(4); ASBAR(); GAPA(C1 = MF(kf[1], qr[0], f32x16{}), P0[6], P0[7], P0[8], P0[9],     pw0[2] = PKW(P0, 4),  pw0[3] = PKW(P0, 6),  pw0); \
    VRD(1); ASBAR(); GAPA(C0 = MF(kf[2], qr[1], C0),       P0[10], P0[11], P0[12], P0[13], pw1[0] = PKW(P0, 8),  pw1[1] = PKW(P0, 10), pw1); \
    VRD(5); ASBAR(); GAPA(C1 = MF(kf[3], qr[1], C1),       P0[14], P0[15], P1[0], P1[1],   pw1[2] = PKW(P0, 12), pw1[3] = PKW(P0, 14), pw1); \
    VRD(2); ASBAR(); GAPA(C0 = MF(kf[4], qr[2], C0),       P1[2], P1[3], P1[4], P1[5],     pw2[0] = PKW(P1, 0),  pw2[1] = PKW(P1, 2),  pw2); \
    VRD(6); ASBAR(); GAPA(C1 = MF(kf[5], qr[2], C1),       P1[6], P1[7], P1[8], P1[9],     pw2[2] = PKW(P1, 4),  pw2[3] = PKW(P1, 6),  pw2); \
    VRD(3); ASBAR(); GAPA(C0 = MF(kf[6], qr[3], C0),       P1[10], P1[11], P1[12], P1[13], pw3[0] = PKW(P1, 8),  pw3[1] = PKW(P1, 10), pw3); \
    VRD(7); ASBAR(); GAPA(C1 = MF(kf[7], qr[3], C1),       P1[14], P1[15], 0.f, 0.f,       pw3[2] = PKW(P1, 12), pw3[3] = PKW(P1, 14), pw3); \
    if (NKS == 6) { C0 = MF(kf[2 * (NKS - 2)], qr[NKS - 2], C0); C1 = MF(kf[2 * (NKS - 2) + 1], qr[NKS - 2], C1); C0 = MF(kf[2 * (NKS - 1)], qr[NKS - 1], C0); C1 = MF(kf[2 * (NKS - 1) + 1], qr[NKS - 1], C1); ASBAR(); } \
    lsum += sacc; ASBAR(); \
    GAPB(o[0] = MF(PAF(0), VFR(0), o[0]), C0, 0);               KRD((GL) && NKS == 6, 4); GAPB(o[1] = MF(PAF(0), VFR(4), o[1]), C0, 4); \
    KRD(GL, 0); GAPB(o[0] = MF(PAF(1), VFR(1), o[0]), C0, 8);   KRD(GL, 1); GAPB(o[1] = MF(PAF(1), VFR(5), o[1]), C0, 12); \
    KRD(GL, 2); GAPB(o[0] = MF(PAF(2), VFR(2), o[0]), C1, 0);   KRD(GL, 3); GAPB(o[1] = MF(PAF(2), VFR(6), o[1]), C1, 4); \
    KRD((GL) && NKS == 6, 5); GAPB(o[0] = MF(PAF(3), VFR(3), o[0]), C1, 8);   GAPB(o[1] = MF(PAF(3), VFR(7), o[1]), C1, 12); \
    } while (0)
    WAITBAR(0);
#pragma unroll
    for (int d0 = 0; d0 < NKS; ++d0) KLD2(Kb, d0);
#pragma unroll
    for (int d0 = 0; d0 < NKS; ++d0) { pA0 = MF(kf[2 * d0], qr[d0], d0 == 0 ? f32x16{} : pA0); pA1 = MF(kf[2 * d0 + 1], qr[d0], d0 == 0 ? f32x16{} : pA1); }
#pragma unroll
    for (int r = 0; r < 16; ++r) { pA0[r] = EX(pA0[r]); pA1[r] = EX(pA1[r]); }
#pragma unroll
    for (int d0 = 0; d0 < NKS; ++d0) KLD2(Kb + KSLOT, d0);
    int t = 1;
    for (; t + 2 < NT; t += 2) {
        WAITBAR(0);
        if (t + 3 < NT) DMA_K(t + 3); if (t + 4 < NT) DMA_K(t + 4); if (t + 1 < NT) DMA_V(t + 1); if (t + 2 < NT) DMA_V(t + 2);
        STEP4(pB0, pB1, pA0, pA1, t, true);
        STEP4(pA0, pA1, pB0, pB1, t + 1, true);
    }
    WAITBAR(0);
    STEP4(pB0, pB1, pA0, pA1, t, false);
    { ASBAR(); float sacc = pB0[0] + pB0[1];
#pragma unroll
      for (int r = 2; r < 16; ++r) sacc += pB0[r];
#pragma unroll
      for (int r = 0; r < 16; ++r) sacc += pB1[r];
      lsum += sacc;
      pw0 = (u32x4){PKW(pB0, 0), PKW(pB0, 2), PKW(pB0, 4), PKW(pB0, 6)}; pw1 = (u32x4){PKW(pB0, 8), PKW(pB0, 10), PKW(pB0, 12), PKW(pB0, 14)};
      pw2 = (u32x4){PKW(pB1, 0), PKW(pB1, 2), PKW(pB1, 4), PKW(pB1, 6)}; pw3 = (u32x4){PKW(pB1, 8), PKW(pB1, 10), PKW(pB1, 12), PKW(pB1, 14)};
      const LAS unsigned char* vp_ = Vb + (t & 3) * VSLOT;
#pragma unroll
      for (int i = 0; i < 8; ++i) VRD(i);
      o[0] = MF(PAF(0), VFR(0), o[0]); o[1] = MF(PAF(0), VFR(4), o[1]); o[0] = MF(PAF(1), VFR(1), o[0]); o[1] = MF(PAF(1), VFR(5), o[1]);
      o[0] = MF(PAF(2), VFR(2), o[0]); o[1] = MF(PAF(2), VFR(6), o[1]); o[0] = MF(PAF(3), VFR(3), o[0]); o[1] = MF(PAF(3), VFR(7), o[1]); }
    lsum = swap32_sum(lsum);
    if (hi == 0) wsf[32 + r32] = __builtin_amdgcn_rcpf(lsum);
    asm volatile("s_waitcnt vmcnt(0) lgkmcnt(0)\n\ts_barrier" ::: "memory");
    { LAS bf16* stg = (LAS bf16*)(lds + wid * 4096);
#pragma unroll
      for (int rq = 0; rq < 4; ++rq) { const f32x4 i4 = *(const LAS f32x4*)(wsf + 32 + 8 * rq + 4 * hi);
#pragma unroll
          for (int j = 0; j < 4; ++j) { const int q = 8 * rq + 4 * hi + j;
              stg[q * 64 + r32] = (bf16)f2bf(o[0][4 * rq + j] * i4[j]); stg[q * 64 + 32 + r32] = (bf16)f2bf(o[1][4 * rq + j] * i4[j]); } }
      asm volatile("s_waitcnt lgkmcnt(0)" ::: "memory");
      bf16* Ow = A.O + (A.qrow0 + wid * 32) * A.opitch + A.ocol;
#pragma unroll
      for (int i = 0; i < 4; ++i) { const int row = i * 8 + (lane >> 3), ch = lane & 7; *(u32x4*)(Ow + (long)row * A.opitch + ch * 8) = *(const LAS u32x4*)(stg + row * 64 + ch * 8); } }
    asm volatile("s_waitcnt vmcnt(0) lgkmcnt(0)\n\ts_barrier" ::: "memory");
#undef TILE_ROW
#undef DMA_K
#undef DMA_V
#undef WAITBAR
#undef MF
#undef KLD2
#undef PKW
#undef PAF
#undef VFR
#undef VRD
#undef KRD
#undef EX
#undef GAPA
#undef GAPB
#undef STEP4
}
#undef ASBAR
#undef APIN
}

namespace s5 {
constexpr int NCH = LPOS / 16;
constexpr int M_MC = 0, M_WCF = 65536, M_WCB = 65536 + 32768, M_WSF = 131072, M_WSB = 131072 + 32768, M_TOTAL = 196608;
constexpr int LDS_E = 18 * 4096;

struct Params { const float *lam_re, *lam_im, *log_dt, *b_re, *b_im, *c_re, *c_im, *dsk; };

__device__ __forceinline__ void build_mats(const Params& P, int l, int g, bf16* out, LAS unsigned char* lds, int wave_, int skipmask = 0) {
    LAS f32x2* apow = (LAS f32x2*)lds;
    LAS f32x2* Bb = apow + 2 * 64 * 17;
    LAS f32x2* Cc = Bb + 2 * 64 * 16;
    LAS float* Kt = (LAS float*)(Cc + 2 * 16 * 64);
    constexpr int KTL = 260, KTD = 16 * KTL;
    const int tid = wave_ * 64 + lane_id();
    LAS float* lamv = Kt + 2 * KTD;
    LAS float* dskv = lamv + 512;
    f32x2 cv[4], bv[4];
#pragma unroll
    for (int m = 0; m < 4; ++m) { const int i = tid + NTHREADS * m; { const int dir = i >> 10, hp = (i >> 6) & 15, p = i & 63; const size_t ci = ((size_t)((l * 2 + dir) * 32 + g) * 16 + hp) * 64 + p; cv[m] = (f32x2){P.c_re[ci], P.c_im[ci]}; }
        { const int dir = i >> 10, p = (i >> 4) & 63, h = i & 15, pi = ((l * 2 + dir) * 32 + g) * 64 + p; bv[m] = (f32x2){P.b_re[(size_t)pi * 16 + h], P.b_im[(size_t)pi * 16 + h]}; } }
    if (tid < 128) { const int dir = tid >> 6, p = tid & 63, pi = ((l * 2 + dir) * 32 + g) * 64 + p;
        lamv[4 * tid] = fminf(P.lam_re[pi], -1e-4f); lamv[4 * tid + 1] = P.lam_im[pi]; lamv[4 * tid + 2] = expf(P.log_dt[(l * 2 + dir) * 32 + g]); }
    else if (tid < 144) dskv[tid - 128] = P.dsk[(l * 32 + g) * 16 + tid - 128];
#pragma unroll
    for (int m = 0; m < 4; ++m) Cc[tid + NTHREADS * m] = cv[m];
    __syncthreads();
    for (int i = tid; i < 2 * 64 * 17; i += NTHREADS) {
        const int dir = i / (64 * 17), r = i - dir * (64 * 17), p = r / 17, j = r - p * 17;
        const float lr = lamv[4 * (dir * 64 + p)], li = lamv[4 * (dir * 64 + p) + 1], dt = lamv[4 * (dir * 64 + p) + 2];
        const float mag = expf((float)j * lr * dt), ang = (float)j * li * dt; apow[i] = (f32x2){mag * cosf(ang), mag * sinf(ang)}; }
#pragma unroll
    for (int m = 0; m < 4; ++m) {
        const int i = tid + NTHREADS * m, dir = i >> 10, p = (i >> 4) & 63;
        const float lr = lamv[4 * (dir * 64 + p)], li = lamv[4 * (dir * 64 + p) + 1], dt = lamv[4 * (dir * 64 + p) + 2];
        const float abr = expf(lr * dt) * cosf(li * dt), abi = expf(lr * dt) * sinf(li * dt), den = lr * lr + li * li;
        const float fr = ((abr - 1.0f) * lr + abi * li) / den, fi = (abi * lr - (abr - 1.0f) * li) / den;
        const float br = bv[m].x, bi = bv[m].y; Bb[i] = (f32x2){fr * br - fi * bi, fr * bi + fi * br}; }
    __syncthreads();
    if (!(skipmask & 1)) {
        const int dir = tid >> 8, j = (tid >> 4) & 15, hp0 = ((tid >> 2) & 3) * 4, h0 = (tid & 3) * 4; float sacc[4][4];
#pragma unroll
        for (int x = 0; x < 4; ++x)
#pragma unroll
            for (int y = 0; y < 4; ++y) sacc[x][y] = 0.f;
        for (int p = 0; p < 64; ++p) { const f32x2 a = apow[(dir * 64 + p) * 17 + j];
            const f32x2 c0_ = Cc[(dir * 16 + hp0) * 64 + p], c1_ = Cc[(dir * 16 + hp0 + 1) * 64 + p], c2_ = Cc[(dir * 16 + hp0 + 2) * 64 + p], c3_ = Cc[(dir * 16 + hp0 + 3) * 64 + p];
            const f32x4 c01 = {c0_.x, c0_.y, c1_.x, c1_.y}, c23 = {c2_.x, c2_.y, c3_.x, c3_.y};
            const f32x4 b01 = *(const LAS f32x4*)(Bb + (dir * 64 + p) * 16 + h0), b23 = *(const LAS f32x4*)(Bb + (dir * 64 + p) * 16 + h0 + 2);
            const float cx[4] = {c01[0], c01[2], c23[0], c23[2]}, cy[4] = {c01[1], c01[3], c23[1], c23[3]}, bx[4] = {b01[0], b01[2], b23[0], b23[2]}, by[4] = {b01[1], b01[3], b23[1], b23[3]};
#pragma unroll
            for (int x = 0; x < 4; ++x) { const float tr = cx[x] * a.x - cy[x] * a.y, ti = cx[x] * a.y + cy[x] * a.x;
#pragma unroll
                for (int y = 0; y < 4; ++y) sacc[x][y] += tr * bx[y] - ti * by[y]; } }
#pragma unroll
        for (int x = 0; x < 4; ++x) *(LAS f32x4*)(Kt + dir * KTD + j * KTL + (hp0 + x) * 16 + h0) = (f32x4){sacc[x][0], sacc[x][1], sacc[x][2], sacc[x][3]};
    }
    __syncthreads();
    if (!(skipmask & 2))
#pragma unroll 4
    for (int i = tid; i < 65536 / 8; i += NTHREADS) {
        const int row = i >> 5, c0 = (i & 31) * 8, t = row >> 4, hp = row & 15, s = c0 >> 4, h0 = c0 & 15; float v[8];
        const int lf = s <= t ? t - s : 0, lb = s >= t ? s - t : 0;
        const f32x4 f0 = *(const LAS f32x4*)(Kt + lf * KTL + hp * 16 + h0), f1 = *(const LAS f32x4*)(Kt + lf * KTL + hp * 16 + h0 + 4);
        const f32x4 b0 = *(const LAS f32x4*)(Kt + KTD + lb * KTL + hp * 16 + h0), b1 = *(const LAS f32x4*)(Kt + KTD + lb * KTL + hp * 16 + h0 + 4);
        const float wf = s <= t ? 1.f : 0.f, wb = s >= t ? 1.f : 0.f;
#pragma unroll
        for (int e = 0; e < 8; ++e) { const int h = h0 + e; float x = 0.f;
            if (s <= t) x += (e < 4 ? f0[e & 3] : f1[e & 3]);
            if (s >= t) x += (e < 4 ? b0[e & 3] : b1[e & 3]);
            if (s == t && h == hp) x += dskv[h];
            v[e] = x; }
        (void)wf; (void)wb;
        *(u32x4*)(out + M_MC + (size_t)row * 256 + c0) = pack8(v);
    }
    if (!(skipmask & 4))
#pragma unroll 4
    for (int i = tid; i < 2 * 32768 / 8; i += NTHREADS) {
        const int dir = i >> 12, ii = i & 4095, row = ii >> 4, c0 = (ii & 15) * 8, t = row >> 4, hp = row & 15, ex = dir == 0 ? t + 1 : 16 - t; float v[8];
#pragma unroll
        for (int e = 0; e < 8; e += 2) { const int p = (c0 + e) >> 1; const f32x2 c = Cc[(dir * 16 + hp) * 64 + p], a = apow[(dir * 64 + p) * 17 + ex];
            v[e] = c.x * a.x - c.y * a.y; v[e + 1] = -(c.x * a.y + c.y * a.x); }
        *(u32x4*)(out + (dir == 0 ? M_WCF : M_WCB) + (size_t)row * 128 + c0) = pack8(v);
    }
    if (!(skipmask & 8))
#pragma unroll 4
    for (int i = tid; i < 2 * 32768 / 8; i += NTHREADS) {
        const int dir = i >> 12, ii = i & 4095, row = ii >> 5, c0 = (ii & 31) * 8, p = row >> 1, im = row & 1, s = c0 >> 4, h0 = c0 & 15, ex = dir == 0 ? 15 - s : s; float v[8];
        const f32x2 a = apow[(dir * 64 + p) * 17 + ex];
#pragma unroll
        for (int e = 0; e < 8; ++e) { const f32x2 bb = Bb[(dir * 64 + p) * 16 + h0 + e]; v[e] = im ? (a.x * bb.y + a.y * bb.x) : (a.x * bb.x - a.y * bb.y); }
        *(u32x4*)(out + (dir == 0 ? M_WSF : M_WSB) + (size_t)row * 256 + c0) = pack8(v);
    }
    __syncthreads();
}

__device__ __forceinline__ void build_a16(const Params& P, float* a16, int gt, int ngt) {
    for (int pi = gt; pi < 2 * 2 * 32 * 64; pi += ngt) {
        const float lr = fminf(P.lam_re[pi], -1e-4f), li = P.lam_im[pi], dt = expf(P.log_dt[pi >> 6]);
        const float mag = expf(16.f * lr * dt), ang = 16.f * li * dt; a16[2 * pi] = mag * cosf(ang); a16[2 * pi + 1] = mag * sinf(ang); }
}
__device__ __forceinline__ void unit(const float* a16, int l, int b, int g, const bf16* Ug, const bf16* mats, bf16* Aglu, bool skip_ctx, LAS unsigned char* lds, int wave_, int half) {
    int tid = wave_ * 64 + lane_id(); asm volatile("" : "+v"(tid));
    const int lane = tid & 63, n = lane & 15, q = lane >> 4; const int wid = __builtin_amdgcn_readfirstlane(tid >> 6);
    LAS unsigned char* Ef = lds; LAS unsigned char* Eb = lds + LDS_E;
    const bf16* U = Ug + (size_t)(b * 32 + g) * LPOS * 16;
    const int rt = 8 * half + wid;
    f32x4 yi[17];
    {
        bf16x8 af[8], ab[8], am[8]; u32x4 st[4]; unsigned uoff[8];
#pragma unroll
        for (int ks = 0; ks < 8; ++ks) { af[ks] = *(const bf16x8*)(mats + M_WSF + (size_t)(16 * wid + n) * 256 + 32 * ks + 8 * q); ab[ks] = *(const bf16x8*)(mats + M_WSB + (size_t)(16 * wid + n) * 256 + 32 * ks + 8 * q);
            am[ks] = *(const bf16x8*)(mats + M_MC + (size_t)(16 * rt + n) * 256 + 32 * ks + 8 * q); }
        const bf16* ug = U + wid * 512 + lane * 8;
        const int ns = 2 * wid + (lane >> 5), js = lane & 31;
        const unsigned sdst = (ns < 8 ? 0u : (unsigned)LDS_E) + (ns & 7) * 512 + ((js ^ ns) << 4);
#pragma unroll
        for (int i = 0; i < 4; ++i) st[i] = *(const u32x4*)(ug + i * 4096);
#pragma unroll
        for (int ks = 0; ks < 8; ++ks) uoff[ks] = (n < 8 ? 0u : (unsigned)LDS_E) + (n & 7) * 512 + (((4 * ks + q) ^ n) << 4);
        *(LAS u32x4*)(lds + sdst + 4096) = st[0]; st[0] = *(const u32x4*)(ug + 4 * 4096);
        __syncthreads();
#pragma unroll
        for (int t = 0; t < 17; ++t) {
            bf16x8 ub[8];
#pragma unroll
            for (int ks = 0; ks < 8; ++ks) ub[ks] = *(const LAS bf16x8*)(lds + 4096 * (t + 1) + uoff[ks]);
            if (t + 1 < 17) { *(LAS u32x4*)(lds + sdst + 4096 * (t + 2)) = st[(t + 1) & 3]; if (t + 5 < 17) st[(t + 1) & 3] = *(const u32x4*)(ug + (t + 5) * 4096); }
            f32x4 cf = {0.f, 0.f, 0.f, 0.f}, cb = {0.f, 0.f, 0.f, 0.f}, cy = {0.f, 0.f, 0.f, 0.f};
#pragma unroll
            for (int ks = 0; ks < 8; ++ks) { cf = __builtin_amdgcn_mfma_f32_16x16x32_bf16(af[ks], ub[ks], cf, 0, 0, 0); cb = __builtin_amdgcn_mfma_f32_16x16x32_bf16(ab[ks], ub[ks], cb, 0, 0, 0);
                if (!(t == 0 && skip_ctx)) cy = __builtin_amdgcn_mfma_f32_16x16x32_bf16(am[ks], ub[ks], cy, 0, 0, 0); }
            yi[t] = cy;
            const int eo = (16 * t + n) * 256 + (((2 * wid + (q >> 1)) ^ n) << 4) + (q & 1) * 8;
            *(LAS u32x2*)(Ef + eo) = (u32x2){pk2(cf[0], cf[1]), pk2(cf[2], cf[3])};
            *(LAS u32x2*)(Eb + eo) = (u32x2){pk2(cb[0], cb[1]), pk2(cb[2], cb[3])};
            __syncthreads();
        }
    }
    bf16x8 wf[4], wb[4];
#pragma unroll
    for (int ks = 0; ks < 4; ++ks) { wf[ks] = *(const bf16x8*)(mats + M_WCF + (size_t)(16 * rt + n) * 128 + 32 * ks + 8 * q); wb[ks] = *(const bf16x8*)(mats + M_WCB + (size_t)(16 * rt + n) * 128 + 32 * ks + 8 * q); }
    if (wid < 2) {
        const int dir = wid, p = lane, pi = ((l * 2 + dir) * 32 + g) * 64 + p;
        const float ar = a16[2 * pi], ai = a16[2 * pi + 1];
        LAS unsigned* E32 = (LAS unsigned*)(dir ? Eb : Ef);
        float xr = 0.f, xi = 0.f;
#define S5_CH(st) (dir == 0 ? (st) : ((st) < 16 ? 15 - (st) : NCH + 15 - (st)))
#define S5_EW(k, j) (S5_CH(16 * (k) + (j)) * 64 + ((((p >> 2) ^ (dir == 0 ? (j) : 15 - (j))) << 2) | (p & 3)))
        unsigned ea[16], eb[16];
#pragma unroll
        for (int j = 0; j < 16; ++j) ea[j] = E32[S5_EW(0, j)];
        for (int k = 0; k < 17; k += 2) {
#pragma unroll
            for (int j = 0; j < 16; ++j) eb[j] = E32[S5_EW(k + 1 < 17 ? k + 1 : k, j)];
#pragma unroll
            for (int j = 0; j < 16; ++j) { const unsigned e = ea[j]; E32[S5_EW(k, j)] = pk2(xr, xi);
                const float er = bf2f(e & 0xffffu), ei = bf2f(e >> 16); const float nr = ar * xr - ai * xi + er, ni = ar * xi + ai * xr + ei; xr = nr; xi = ni; }
            if (k + 1 < 17) {
#pragma unroll
                for (int j = 0; j < 16; ++j) ea[j] = E32[S5_EW(k + 2 < 17 ? k + 2 : k + 1, j)];
#pragma unroll
                for (int j = 0; j < 16; ++j) { const unsigned e = eb[j]; E32[S5_EW(k + 1, j)] = pk2(xr, xi);
                    const float er = bf2f(e & 0xffffu), ei = bf2f(e >> 16); const float nr = ar * xr - ai * xi + er, ni = ar * xi + ai * xr + ei; xr = nr; xi = ni; }
            }
        }
#undef S5_EW
#undef S5_CH
    }
    __syncthreads();
    {
        unsigned xoff[4];
#pragma unroll
        for (int ks = 0; ks < 4; ++ks) xoff[ks] = n * 256 + (((q + 4 * ks) ^ n) << 4);
#pragma unroll
        for (int ct = 0; ct < 17; ++ct) {
            if (ct == 0 && skip_ctx) continue;
            int cto = ct; asm volatile("" : "+s"(cto));
            f32x4 acc = yi[ct];
#pragma unroll
            for (int ks = 0; ks < 4; ++ks) { acc = __builtin_amdgcn_mfma_f32_16x16x32_bf16(wf[ks], *(const LAS bf16x8*)(Ef + 4096 * cto + xoff[ks]), acc, 0, 0, 0);
                acc = __builtin_amdgcn_mfma_f32_16x16x32_bf16(wb[ks], *(const LAS bf16x8*)(Eb + 4096 * cto + xoff[ks]), acc, 0, 0, 0); }
            const int pos = (16 * cto + n) * 16 + rt;
            *(u32x2*)(Aglu + (size_t)pos_row(b, pos) * 512 + g * 16 + 4 * q) = (u32x2){pk2(fgelu_tanh(acc[0]), fgelu_tanh(acc[1])), pk2(fgelu_tanh(acc[2]), fgelu_tanh(acc[3]))};
        }
    }
    __syncthreads();
}
}

struct Ptrs {
    const float *x, *c, *ctx, *c_ctx, *w_mod, *b_mod, *g_mix_pre, *g_mix_post, *g_ffn_pre, *g_ffn_post, *w_in, *g_q, *g_k, *g_cq, *g_ckv, *w_uq, *w_ukv;
    s5::Params s5p;
    const float *w_glu, *w_branch, *w_mg, *b_mg, *w_out, *ffn_w1, *ffn_w3, *ffn_w2, *router_w, *router_b, *moe_w1, *moe_w3, *moe_w2;
    float* out; unsigned char* ws;
};

template <int MAP  >
__device__ __forceinline__ void transpose_item(const float* W, int K, int N, bf16* WT, int kb, int n0, int drow0, LAS float* scr, int lane) {
    const int k0 = 64 * kb;
#pragma unroll
    for (int i = 0; i < 8; ++i) { const int kk = 8 * i + (lane >> 3), c4 = 4 * (lane & 7); const f32x4 v = *(const f32x4*)(W + (size_t)(k0 + kk) * N + n0 + c4);
        LAS float* d = scr + kk * 33 + c4; d[0] = v[0]; d[1] = v[1]; d[2] = v[2]; d[3] = v[3]; }
    asm volatile("s_waitcnt lgkmcnt(0)" ::: "memory");
    const int c = lane & 7;
#pragma unroll
    for (int j = 0; j < 4; ++j) { const int n = (lane >> 3) + 8 * j; const LAS float* s = scr + (8 * c) * 33 + n;
        u32x4 o; o.x = pk2(s[0 * 33], s[1 * 33]); o.y = pk2(s[2 * 33], s[3 * 33]); o.z = pk2(s[4 * 33], s[5 * 33]); o.w = pk2(s[6 * 33], s[7 * 33]);
        int dr = n; if (MAP == 1) { const int i2 = n & 15; dr = 8 * (i2 >> 2) + (i2 & 3) + ((n >> 4) << 2); }
        *(u32x4*)(WT + (size_t)(drow0 + dr) * K + k0 + 8 * c) = o; }
    asm volatile("s_waitcnt lgkmcnt(0)" ::: "memory");
}

__device__ __forceinline__ void transpose_item_f8(const float* W, int K, int N, unsigned char* WT, int kb, int n0, int drow0, float wscale, LAS float* scr, int lane) {
    const int k0 = 64 * kb;
#pragma unroll
    for (int i = 0; i < 8; ++i) { const int kk = 8 * i + (lane >> 3), c4 = 4 * (lane & 7); const f32x4 v = *(const f32x4*)(W + (size_t)(k0 + kk) * N + n0 + c4);
        LAS float* d = scr + kk * 33 + c4; d[0] = v[0]; d[1] = v[1]; d[2] = v[2]; d[3] = v[3]; }
    asm volatile("s_waitcnt lgkmcnt(0)" ::: "memory");
    const int c = lane & 7;
#pragma unroll
    for (int j = 0; j < 4; ++j) { const int n = (lane >> 3) + 8 * j; const LAS float* s = scr + (8 * c) * 33 + n;
        u32x2 o; o.x = pg8::pk_fp8x4(s[0 * 33] * wscale, s[1 * 33] * wscale, s[2 * 33] * wscale, s[3 * 33] * wscale); o.y = pg8::pk_fp8x4(s[4 * 33] * wscale, s[5 * 33] * wscale, s[6 * 33] * wscale, s[7 * 33] * wscale);
        *(u32x2*)(WT + (size_t)(drow0 + n) * K + k0 + 8 * c) = o; }
    asm volatile("s_waitcnt lgkmcnt(0)" ::: "memory");
}
__device__ __forceinline__ int zmap(int n0) { return n0 < 512 ? n0 : n0 < 896 ? ZC_CQ + (n0 - 512) : n0 < 1024 ? ZC_KG + (n0 - 896) : n0 < 1152 ? ZC_VG + (n0 - 1024) : n0 < 1440 ? n0 : ZC_U + (n0 - 1440); }
__device__ __forceinline__ int pairmap(int n0, int second) { return 256 * (n0 >> 7) + (second ? 128 : 0) + (n0 & 127); }

__device__ __forceinline__ void transposes(const Ptrs& P, int gw, int ngw, LAS float* scr, int lane, int qsel = 0) {
    unsigned char* ws = P.ws;
    constexpr int I_WIN = 16 * 61, I_MG = 16 * 96, I_UQ = 6 * 24, I_UKV = 4 * 32, I_GLU = 8 * 32, I_BR = 8 * 32, I_OUT = 16 * 32, I_F13 = 16 * 88, I_F2 = 44 * 32;
    constexpr int PER_L = I_WIN + I_MG + I_UQ + I_UKV + I_GLU + 3 * I_BR + I_OUT;
    constexpr int N_L = 2 * PER_L, N_F = 2 * I_F13 + I_F2, N_M = 8 * (2 * I_F13 + I_F2), NITEMS = N_L + N_F + N_M;
    const int qx = (int)blockIdx.x & 7;
    unsigned* q = (unsigned*)(ws + WS_CTL) + CW_Q + 256 * qsel + 32 * qx; (void)gw; (void)ngw;
    for (;;) { int base = 0; if (lane == 0) base = (int)atomicAdd(q, 4u); base = __builtin_amdgcn_readfirstlane(base); if (base * 8 + qx + N_M >= NITEMS) break;
    for (int it_ = base; it_ < base + 4; ++it_) { const int it = it_ * 8 + qx + N_M; if (it >= NITEMS) break;
        int r = it;
        if (r < N_M) {
            const int e = r / (2 * I_F13 + I_F2); r -= e * (2 * I_F13 + I_F2);
            unsigned char* W1T = ws + WS_WM1T + (size_t)e * 5632 * 1024; unsigned char* W2T = ws + WS_WM2T + (size_t)e * 1024 * 2816;
            if (r < I_F13) { const int kb = r / 88, nb = r % 88; if (F8_M1) transpose_item_f8(P.moe_w1 + (size_t)e * 1024 * DFF, 1024, DFF, W1T, kb, 32 * nb, pairmap(32 * nb, 0), F8_WSCALE, scr, lane); else transpose_item<0>(P.moe_w1 + (size_t)e * 1024 * DFF, 1024, DFF, (bf16*)(ws + WS_WM1T) + (size_t)e * 5632 * 1024, kb, 32 * nb, pairmap(32 * nb, 0), scr, lane); continue; } r -= I_F13;
            if (r < I_F13) { const int kb = r / 88, nb = r % 88; if (F8_M1) transpose_item_f8(P.moe_w3 + (size_t)e * 1024 * DFF, 1024, DFF, W1T, kb, 32 * nb, pairmap(32 * nb, 1), F8_WSCALE, scr, lane); else transpose_item<0>(P.moe_w3 + (size_t)e * 1024 * DFF, 1024, DFF, (bf16*)(ws + WS_WM1T) + (size_t)e * 5632 * 1024, kb, 32 * nb, pairmap(32 * nb, 1), scr, lane); continue; } r -= I_F13;
            { const int kb = r / 32, nb = r % 32; transpose_item_f8(P.moe_w2 + (size_t)e * DFF * 1024, DFF, 1024, W2T, kb, 32 * nb, 32 * nb, F8_WSCALE, scr, lane); continue; }
        }
        r -= N_M;
        if (r < N_F) {
            unsigned char* W1T = ws + WS_WF1T; unsigned char* W2T = ws + WS_WF2T;
            if (r < I_F13) { const int kb = r / 88, nb = r % 88; if (F8_D1) transpose_item_f8(P.ffn_w1, 1024, DFF, W1T, kb, 32 * nb, pairmap(32 * nb, 0), F8_WSCALE, scr, lane); else transpose_item<0>(P.ffn_w1, 1024, DFF, (bf16*)W1T, kb, 32 * nb, pairmap(32 * nb, 0), scr, lane); continue; } r -= I_F13;
            if (r < I_F13) { const int kb = r / 88, nb = r % 88; if (F8_D1) transpose_item_f8(P.ffn_w3, 1024, DFF, W1T, kb, 32 * nb, pairmap(32 * nb, 1), F8_WSCALE, scr, lane); else transpose_item<0>(P.ffn_w3, 1024, DFF, (bf16*)W1T, kb, 32 * nb, pairmap(32 * nb, 1), scr, lane); continue; } r -= I_F13;
            { const int kb = r / 32, nb = r % 32; if (F8_D2) transpose_item_f8(P.ffn_w2, DFF, 1024, W2T, kb, 32 * nb, 32 * nb, F8_WSCALE, scr, lane); else transpose_item<0>(P.ffn_w2, DFF, 1024, (bf16*)W2T, kb, 32 * nb, 32 * nb, scr, lane); continue; }
        }
        r -= N_F;
        const int l = r / PER_L; r -= l * PER_L;
        if (r < I_WIN) { const int kb = r / 61, nb = r % 61; if (F8_G1L1 && l == 1) transpose_item_f8(P.w_in + (size_t)l * 1024 * NIN, 1024, NIN, ws + WS_W1T + (size_t)l * ZW * 2048, kb, 32 * nb, zmap(32 * nb), F8_WSCALE, scr, lane);
            else transpose_item<0>(P.w_in + (size_t)l * 1024 * NIN, 1024, NIN, (bf16*)(ws + WS_W1T) + (size_t)l * ZW * 1024, kb, 32 * nb, zmap(32 * nb), scr, lane); continue; } r -= I_WIN;
        if (r < I_MG) { const int kb = r / 96, nb = r % 96; transpose_item_f8(P.w_mg + (size_t)l * 1024 * 3072, 1024, 3072, ws + WS_WMGT + (size_t)l * 3072 * 1024, kb, 32 * nb, 32 * nb, F8_WSCALE, scr, lane); continue; } r -= I_MG;
        if (r < I_UQ) { const int kb = r / 24, nb = r % 24; bf16* T = (bf16*)(ws + WS_WUQT) + (size_t)l * 768 * 384;
            if (nb % 3 == 2) transpose_item<1>(P.w_uq + (size_t)l * 384 * 768, 384, 768, T, kb, 32 * nb, 32 * nb, scr, lane); else transpose_item<0>(P.w_uq + (size_t)l * 384 * 768, 384, 768, T, kb, 32 * nb, 32 * nb, scr, lane); continue; } r -= I_UQ;
        if (r < I_UKV) { const int kb = r / 32, nb = r % 32; transpose_item<0>(P.w_ukv + (size_t)l * 256 * 1024, 256, 1024, (bf16*)(ws + WS_WUKVT) + (size_t)l * 1024 * 256, kb, 32 * nb, 32 * nb, scr, lane); continue; } r -= I_UKV;
        if (r < I_GLU) { const int kb = r / 32, nb = r % 32, n0 = 32 * nb; transpose_item<0>(P.w_glu + (size_t)l * 512 * 1024, 512, 1024, (bf16*)(ws + WS_WGLUT) + (size_t)l * 1024 * 512, kb, n0, n0 < 512 ? pairmap(n0, 0) : pairmap(n0 - 512, 1), scr, lane); continue; } r -= I_GLU;
        if (r < 3 * I_BR) { const int n = r / I_BR; r -= n * I_BR; const int kb = r / 32, nb = r % 32;
            transpose_item<0>(P.w_branch + ((size_t)l * 3 + n) * 512 * 1024, 512, 1024, (bf16*)(ws + WS_WBT) + ((size_t)l * 3 + n) * 1024 * 512, kb, 32 * nb, 32 * nb, scr, lane); continue; } r -= 3 * I_BR;
        { const int kb = r / 32, nb = r % 32; transpose_item<0>(P.w_out + (size_t)l * 1024 * 1024, 1024, 1024, (bf16*)(ws + WS_WOUTT) + (size_t)l * 1024 * 1024, kb, 32 * nb, 32 * nb, scr, lane); }
    } }
}


constexpr int MOE_ITEMS_PER_E = 2 * 16 * 88 + 44 * 32, MOE_ITEMS = 8 * MOE_ITEMS_PER_E;
__device__ __forceinline__ void moe_transposes(const float* w1, const float* w3, const float* w2, unsigned char* ws, int lo, int hi, int giw, int ngiw, LAS float* scr, int lane) {
    constexpr int I_F13 = 16 * 88;
    for (int it = lo + giw; it < hi; it += ngiw) {
        const int e = it / MOE_ITEMS_PER_E; int r = it - e * MOE_ITEMS_PER_E;
        unsigned char* W1T = ws + WS_WM1T + (size_t)e * 5632 * 1024; unsigned char* W2T = ws + WS_WM2T + (size_t)e * 1024 * 2816;
        if (r < I_F13) { const int kb = r / 88, nb = r % 88; if (F8_M1) transpose_item_f8(w1 + (size_t)e * 1024 * DFF, 1024, DFF, W1T, kb, 32 * nb, pairmap(32 * nb, 0), F8_WSCALE, scr, lane); else transpose_item<0>(w1 + (size_t)e * 1024 * DFF, 1024, DFF, (bf16*)(ws + WS_WM1T) + (size_t)e * 5632 * 1024, kb, 32 * nb, pairmap(32 * nb, 0), scr, lane); continue; } r -= I_F13;
        if (r < I_F13) { const int kb = r / 88, nb = r % 88; if (F8_M1) transpose_item_f8(w3 + (size_t)e * 1024 * DFF, 1024, DFF, W1T, kb, 32 * nb, pairmap(32 * nb, 1), F8_WSCALE, scr, lane); else transpose_item<0>(w3 + (size_t)e * 1024 * DFF, 1024, DFF, (bf16*)(ws + WS_WM1T) + (size_t)e * 5632 * 1024, kb, 32 * nb, pairmap(32 * nb, 1), scr, lane); continue; } r -= I_F13;
        { const int kb = r / 32, nb = r % 32; transpose_item_f8(w2 + (size_t)e * DFF * 1024, DFF, 1024, W2T, kb, 32 * nb, 32 * nb, F8_WSCALE, scr, lane); }
    }
}
__device__ __forceinline__ void mod_item(const Ptrs& P, int item, LAS unsigned char* lds, int wave_) {
    LAS float* sc = (LAS float*)lds;
    LAS float* part = sc + 5 * 1024;
    const int lane = lane_id(), wid = wave_, tid = wid * 64 + lane, l = item / 96, n0 = (item % 96) * 64;
    for (int i = tid; i < 5 * 1024; i += NTHREADS) { const float v = i < 4096 ? P.c[i] : P.c_ctx[i - 4096]; sc[i] = v / (1.0f + expf(-v)); }
    __syncthreads();
    float a[5] = {0.f, 0.f, 0.f, 0.f, 0.f};
    const float* W = P.w_mod + (size_t)l * 1024 * 6144 + n0 + lane;
    for (int k0 = wid; k0 < 1024; k0 += 256) {
        float w[32];
#pragma unroll
        for (int j = 0; j < 32; ++j) w[j] = W[(size_t)(k0 + 8 * j) * 6144];
#pragma unroll
        for (int j = 0; j < 32; ++j)
#pragma unroll
            for (int r = 0; r < 5; ++r) a[r] += sc[r * 1024 + k0 + 8 * j] * w[j]; }
#pragma unroll
    for (int r = 0; r < 5; ++r) part[(wid * 5 + r) * 64 + lane] = a[r];
    __syncthreads();
    if (tid < 320) { const int r = tid >> 6; float s = 0.f;
#pragma unroll
        for (int w = 0; w < 8; ++w) s += part[(w * 5 + r) * 64 + lane];
        ((float*)(P.ws + WS_MOD))[((size_t)l * 5 + r) * 6144 + n0 + lane] = s + P.b_mod[l * 6144 + n0 + lane]; }
    __syncthreads();
}
__device__ __forceinline__ void copy_params(const Ptrs& P, int gt, int ngt) {
    float* par = (float*)(P.ws + WS_PAR);
    for (int i = gt; i < 2048; i += ngt) { par[PR_GMIXPRE + i] = P.g_mix_pre[i]; par[PR_GMIXPOST + i] = P.g_mix_post[i]; par[PR_GFFNPRE + i] = P.g_ffn_pre[i]; par[PR_GFFNPOST + i] = P.g_ffn_post[i]; }
    for (int i = gt; i < 128; i += ngt) { par[PR_GQ + i] = P.g_q[i]; par[PR_GK + i] = P.g_k[i]; }
    for (int i = gt; i < 768; i += ngt) par[PR_GCQ + i] = P.g_cq[i];
    for (int i = gt; i < 512; i += ngt) par[PR_GCKV + i] = P.g_ckv[i];
    for (int i = gt; i < 6144; i += ngt) par[PR_BMG + i] = P.b_mg[i];
    for (int i = gt; i < 8192; i += ngt) par[PR_RW + i] = P.router_w[i];
    for (int i = gt; i < 8; i += ngt) par[PR_RB + i] = P.router_b[i];
    s5::build_a16(P.s5p, par + PR_A16, gt, ngt);
}
__device__ __forceinline__ void rope_tables(const Ptrs& P, int gt, int ngt) {
    float* ca = (float*)(P.ws + WS_ROPE); float* sa = ca + 4096 * 32; float* cb = sa + 4096 * 32; float* sb = cb + 4096 * 16;
    for (int i = gt; i < 4096 * 32; i += ngt) { const int pos = i >> 5, j = i & 31; const float f = expf(-9.210340371976184f * (float)(j & 15) * (1.0f / 16.0f));
        const float ang = (float)(j < 16 ? pos / GRIDW : pos % GRIDW) * f; ca[i] = cosf(ang); sa[i] = sinf(ang); }
    for (int i = gt; i < 4096 * 16; i += ngt) { const int pos = i >> 4, j = i & 15; const float f = expf(-9.210340371976184f * (float)(j & 7) * (1.0f / 8.0f));
        const float ang = (float)(j < 8 ? pos / GRIDW : pos % GRIDW) * f; cb[i] = cosf(ang); sb[i] = sinf(ang); }
}

__device__ __forceinline__ void ld8(const float* p, float (&o)[8]) { const f32x4 a = *(const f32x4*)p, b = *(const f32x4*)(p + 4); o[0] = a[0]; o[1] = a[1]; o[2] = a[2]; o[3] = a[3]; o[4] = b[0]; o[5] = b[1]; o[6] = b[2]; o[7] = b[3]; }
__device__ __forceinline__ void token_row(unsigned char* ws, int l, int row, int lane) {
    const float* par = (const float*)(ws + WS_PAR);
    const bf16* z = (const bf16*)(ws + P_Z) + (size_t)row * ZW;
    const bool lat = row < NLAT; const int t = row & (SEQ - 1);
    const float* cosA = (const float*)(ws + WS_ROPE) + t * 32; const float* sinA = cosA + 4096 * 32;
    const float* cosB = (const float*)(ws + WS_ROPE) + 2 * 4096 * 32 + t * 16; const float* sinB = cosB + 4096 * 16;
    float v0[8], v1[8], v2[8];
    unpack8(*(const u32x4*)(z + 8 * lane), v0); unpack8(*(const u32x4*)(z + 512 + 8 * lane), v1); unpack8(*(const u32x4*)(z + 1024 + 8 * lane), v2);
    const u32x4 uraw = *(const u32x4*)(z + ZC_U + 8 * lane);
    float ca[8], sa[8], cb8[8], sb8[8];
    ld8(cosA + ((8 * (lane & 7)) & 31), ca); ld8(sinA + ((8 * (lane & 7)) & 31), sa); ld8(cosB + ((8 * ((lane - 48) & 3)) & 15), cb8); ld8(sinB + ((8 * ((lane - 48) & 3)) & 15), sb8);
    { float ss = 0.f;
#pragma unroll
      for (int j = 0; j < 8; ++j) ss += v0[j] * v0[j];
      ss += shfl_xor_l(ss, 1, lane); ss += shfl_xor_l(ss, 2, lane); ss += shfl_xor_l(ss, 4, lane);
      const float rs = rsqrtf(ss * (1.0f / 64.0f) + EPS); const int d0 = 8 * (lane & 7); float o[8], gq[8];
      ld8(par + PR_GQ + l * 64 + d0, gq);
#pragma unroll
      for (int j = 0; j < 8; ++j) v0[j] = v0[j] * rs * gq[j];
#pragma unroll
      for (int j = 0; j < 8; ++j) { const float other = shfl_xor_l(v0[j], 4, lane); const float c = ca[j], s = sa[j];
          o[j] = lat ? ((d0 < 32) ? v0[j] * c - other * s : other * s + v0[j] * c) : v0[j];
          o[j] *= 0.125f * LOG2E; }
      *(u32x4*)((bf16*)(ws + P_QA) + (size_t)row * 512 + 8 * lane) = pack8(o); }
    { float ss = 0.f;
#pragma unroll
      for (int j = 0; j < 8; ++j) ss += v1[j] * v1[j];
      float ssk = ss; ssk += shfl_xor_l(ssk, 1, lane); ssk += shfl_xor_l(ssk, 2, lane); ssk += shfl_xor_l(ssk, 4, lane);
      float ss2 = 0.f;
#pragma unroll
      for (int j = 0; j < 8; ++j) ss2 += v2[j] * v2[j];
      const float sq = wave_sum((lane >= 32 ? ss : 0.f) + (lane < 16 ? ss2 : 0.f));
      const float skv = wave_sum((lane >= 16 && lane < 48) ? ss2 : 0.f);
      const float rq = rsqrtf(sq * (1.0f / 384.0f) + EPS), rkv = rsqrtf(skv * (1.0f / 256.0f) + EPS);
      { const float rs = rsqrtf(ssk * (1.0f / 64.0f) + EPS); const int d0 = 8 * (lane & 7); float kk[8], o[8], gk[8];
        ld8(par + PR_GK + l * 64 + d0, gk);
#pragma unroll
        for (int j = 0; j < 8; ++j) kk[j] = v1[j] * rs * gk[j];
#pragma unroll
        for (int j = 0; j < 8; ++j) { const float other = shfl_xor_l(kk[j], 4, lane); const float c = ca[j], s = sa[j];
            o[j] = lat ? ((d0 < 32) ? kk[j] * c - other * s : other * s + kk[j] * c) : kk[j]; }
        if (lane < 16) *(u32x4*)((bf16*)(ws + P_KA) + (size_t)row * 128 + 8 * lane) = pack8(o); }
      if (lane >= 16 && lane < 32) *(u32x4*)((bf16*)(ws + P_VA) + (size_t)row * 128 + 8 * (lane - 16)) = pack8(v1);
      { float g1[8], g2[8], g3[8], o[8];
        const int i1 = lane >= 32 ? 8 * (lane - 32) : 0, i2 = lane < 16 ? 256 + 8 * lane : 0, i3 = (lane >= 16 && lane < 48) ? 8 * (lane - 16) : 0;
        ld8(par + PR_GCQ + l * 384 + i1, g1); ld8(par + PR_GCQ + l * 384 + i2, g2); ld8(par + PR_GCKV + l * 256 + i3, g3);
#pragma unroll
        for (int j = 0; j < 8; ++j) o[j] = v1[j] * rq * g1[j];
        if (lane >= 32) *(u32x4*)((bf16*)(ws + P_CQN) + (size_t)row * 384 + i1) = pack8(o);
#pragma unroll
        for (int j = 0; j < 8; ++j) o[j] = v2[j] * rq * g2[j];
        if (lane < 16) *(u32x4*)((bf16*)(ws + P_CQN) + (size_t)row * 384 + i2) = pack8(o);
#pragma unroll
        for (int j = 0; j < 8; ++j) o[j] = v2[j] * rkv * g3[j];
        if (lane >= 16 && lane < 48) *(u32x4*)((bf16*)(ws + P_CKVN) + (size_t)row * 256 + i3) = pack8(o); }
      { float o[8]; const int i0 = 8 * ((lane - 48) & 3);
#pragma unroll
        for (int j = 0; j < 8; ++j) { const float other = shfl_xor_l(v2[j], 2, lane); const float c = cb8[j], s = sb8[j];
            o[j] = lat ? ((i0 < 16) ? v2[j] * c - other * s : other * s + v2[j] * c) : v2[j]; }
        if (lane >= 48 && lane < 52) *(u32x4*)((bf16*)(ws + P_KRR) + (size_t)row * 32 + i0) = pack8(o); }
    }
    { const int b = lat ? row >> 12 : (row - NLAT) >> 8, pos = lat ? CTXL + t : (row - NLAT) & 255, g = lane >> 1;
      *(u32x4*)((bf16*)(ws + P_UG) + ((size_t)(b * 32 + g) * LPOS + pos) * 16 + 8 * (lane & 1)) = uraw; }
}

struct ResidArgs {
    int mode;
    const float* y; const float* g_post; int gate_chunk;
    const float* g_pre; int shift_chunk;
    bool dry;
    float ysc;
    bf16* hout; int l_mod; bool h8; unsigned char* hout8;
    int l_gate; bool route;
};
__device__ __forceinline__ void resid_row(unsigned char* ws, float* outp, const float* xin, const float* ctxin, const ResidArgs R, int row, int lane, const LAS int* tb) {
    const float* par = (const float*)(ws + WS_PAR);
    const bool lat = row < NLAT; const int b = lat ? row >> 12 : (row - NLAT) >> 8, mr = lat ? b : 4;
    const float* mod = (const float*)(ws + WS_MOD);
    float* latp = lat ? outp + (size_t)row * 1024 : (float*)(ws + WS_LATC) + (size_t)(row - NLAT) * 1024;
    f32x4 v[4];
    if (R.mode == 0) { const float* src = lat ? xin + (size_t)row * 1024 : ctxin + (size_t)(row - NLAT) * 1024;
#pragma unroll
        for (int j = 0; j < 4; ++j) v[j] = *(const f32x4*)(src + 4 * lane + 256 * j);
    } else {
        f32x4 yv[4];
        if (R.mode == 1) {
#pragma unroll
            for (int j = 0; j < 4; ++j) yv[j] = *(const f32x4*)(R.y + (size_t)row * 1024 + 4 * lane + 256 * j) * R.ysc;
        } else if (R.mode == 3) {
            const bf16* yb = (const bf16*)R.y + (size_t)row * 1024;
#pragma unroll
            for (int j = 0; j < 4; ++j) { const u32x2 a = *(const u32x2*)(yb + 4 * lane + 256 * j);
                yv[j] = (f32x4){bf2f(a.x & 0xffffu), bf2f(a.x >> 16), bf2f(a.y & 0xffffu), bf2f(a.y >> 16)} * R.ysc; }
        } else {
            const int* ti = (const int*)(ws + WS_LIST) + 8 * 16384 + row * 8;
            const int e0 = ti[0], p0 = ti[1], e1 = ti[2], p1 = ti[3]; const float w0 = __int_as_float(ti[4]) * R.ysc, w1 = __int_as_float(ti[5]) * R.ysc;
            const bf16* f0 = (const bf16*)(ws + P_Y2) + ((size_t)tb[8 + e0] * 256 + p0) * 1024; const bf16* f1 = (const bf16*)(ws + P_Y2) + ((size_t)tb[8 + e1] * 256 + p1) * 1024;
#pragma unroll
            for (int j = 0; j < 4; ++j) { const u32x2 a = *(const u32x2*)(f0 + 4 * lane + 256 * j), c = *(const u32x2*)(f1 + 4 * lane + 256 * j);
                yv[j][0] = w0 * bf2f(a.x & 0xffffu) + w1 * bf2f(c.x & 0xffffu); yv[j][1] = w0 * bf2f(a.x >> 16) + w1 * bf2f(c.x >> 16);
                yv[j][2] = w0 * bf2f(a.y & 0xffffu) + w1 * bf2f(c.y & 0xffffu); yv[j][3] = w0 * bf2f(a.y >> 16) + w1 * bf2f(c.y >> 16); }
        }
        float ss = 0.f;
#pragma unroll
        for (int j = 0; j < 4; ++j) ss += (yv[j][0] * yv[j][0] + yv[j][1] * yv[j][1]) + (yv[j][2] * yv[j][2] + yv[j][3] * yv[j][3]);
        const float rs = rsqrtf(wave_sum(ss) * (1.0f / 1024.0f) + EPS);
        const float* gate = mod + ((size_t)R.l_gate * 5 + mr) * 6144 + R.gate_chunk * 1024;
#pragma unroll
        for (int j = 0; j < 4; ++j) { const int c = 4 * lane + 256 * j; const f32x4 lv = *(const f32x4*)(latp + c), gp = *(const f32x4*)(R.g_post + c), gt = *(const f32x4*)(gate + c);
            v[j] = lv + gt * (yv[j] * rs * gp); }
    }
    if (!R.dry) {
#pragma unroll
    for (int j = 0; j < 4; ++j) *(f32x4*)(latp + 4 * lane + 256 * j) = v[j]; }
    if (R.hout == nullptr) return;
    float ss = 0.f;
#pragma unroll
    for (int j = 0; j < 4; ++j) ss += (v[j][0] * v[j][0] + v[j][1] * v[j][1]) + (v[j][2] * v[j][2] + v[j][3] * v[j][3]);
    const float rs = rsqrtf(wave_sum(ss) * (1.0f / 1024.0f) + EPS);
    const float* shift = mod + ((size_t)R.l_mod * 5 + mr) * 6144 + R.shift_chunk * 1024; const float* scale = shift + 1024;
    f32x4 hv[4];
#pragma unroll
    for (int j = 0; j < 4; ++j) { const int c = 4 * lane + 256 * j; const f32x4 gp = *(const f32x4*)(R.g_pre + c), sh = *(const f32x4*)(shift + c), sc = *(const f32x4*)(scale + c);
        hv[j] = (v[j] * rs * gp) * (1.0f + sc) + sh;
        if (R.dry) { if (hv[j][0] == 123.456f) *(float*)(ws + WS_CTL + 64) = 1.f; continue; }
        if (R.hout8) *(unsigned*)(R.hout8 + (size_t)row * 1024 + c) = pg8::pk_fp8x4(hv[j][0] * F8_HSCALE, hv[j][1] * F8_HSCALE, hv[j][2] * F8_HSCALE, hv[j][3] * F8_HSCALE);
        if (R.h8) *(unsigned*)((unsigned char*)R.hout + (size_t)row * 1024 + c) = pg8::pk_fp8x4(hv[j][0] * F8_HSCALE, hv[j][1] * F8_HSCALE, hv[j][2] * F8_HSCALE, hv[j][3] * F8_HSCALE);
        else *(u32x2*)(R.hout + (size_t)row * 1024 + c) = (u32x2){pk2(hv[j][0], hv[j][1]), pk2(hv[j][2], hv[j][3])}; }
    if (R.route) {
        float lg[8];
#pragma unroll
        for (int e = 0; e < 8; ++e) lg[e] = 0.f;
#pragma unroll
        for (int j = 0; j < 4; ++j)
#pragma unroll
            for (int i = 0; i < 4; ++i) { const float* rw = par + PR_RW + (size_t)(4 * lane + 256 * j + i) * 8; const f32x4 r0 = *(const f32x4*)rw, r1 = *(const f32x4*)(rw + 4); const float hvv = hv[j][i];
                lg[0] += hvv * r0[0]; lg[1] += hvv * r0[1]; lg[2] += hvv * r0[2]; lg[3] += hvv * r0[3]; lg[4] += hvv * r1[0]; lg[5] += hvv * r1[1]; lg[6] += hvv * r1[2]; lg[7] += hvv * r1[3]; }
#pragma unroll
        for (int e = 0; e < 8; ++e) lg[e] = wave_sum(lg[e]) + par[PR_RB + e];
        int e0 = 0; float b0 = lg[0];
#pragma unroll
        for (int e = 1; e < 8; ++e) if (lg[e] > b0) { b0 = lg[e]; e0 = e; }
        int e1 = -1; float b1 = -3.0e38f;
#pragma unroll
        for (int e = 0; e < 8; ++e) if (e != e0 && lg[e] > b1) { b1 = lg[e]; e1 = e; }
        if (lane == 0 && !R.dry) {
            const float w0 = 1.0f / (1.0f + expf(b1 - b0)), w1 = 1.0f - w0;
            unsigned* cnt = (unsigned*)(ws + WS_CTL) + CW_CNT;
            const int p0 = (int)atomicAdd(cnt + e0, 1u), p1 = (int)atomicAdd(cnt + e1, 1u);
            int* list = (int*)(ws + WS_LIST); list[e0 * 16384 + p0] = row; list[e1 * 16384 + p1] = row;
            int* ti = list + 8 * 16384 + row * 8; ti[0] = e0; ti[1] = p0; ti[2] = e1; ti[3] = p1; ti[4] = __float_as_int(w0); ti[5] = __float_as_int(w1);
        }
    }
}

#if MK_DEBUG
namespace dbg {
__device__ __forceinline__ unsigned hash(unsigned a, unsigned b) { unsigned x = a * 0x9E3779B1u ^ (b + 0x7F4A7C15u) * 0x85EBCA77u; x ^= x >> 15; x *= 0xC2B2AE3Du; x ^= x >> 13; x *= 0x27D4EB2Fu; x ^= x >> 16; return x; }
__device__ __forceinline__ float rbf(float f) { return bf2f(f2bf(f)); }
__device__ __forceinline__ void add(unsigned char* ws, int k, float got, float ref, int lane) {
    if (lane == 0) { float* d = (float*)(ws + WS_CTL) + CW_DBG + 2 * k; const float df = got - ref; atomicAdd(d, (df == df && fabsf(df) < 1e18f) ? df * df : 1e30f); atomicAdd(d + 1, ref * ref); }
}
__device__ __forceinline__ float dot_aw(const bf16* a, const float* w, size_t wstride, int K, int lane) { float s = 0.f; for (int k = lane; k < K; k += 64) s += bf2f(a[k]) * rbf(w[(size_t)k * wstride]); return wave_sum(s); }

__device__ __forceinline__ float angA(int t, int i) { return (float)(i < 16 ? t / 64 : t % 64) * powf(10000.f, -(float)(2 * (i & 15)) / 32.f); }
__device__ __forceinline__ float angB(int t, int i) { return (float)(i < 8 ? t / 64 : t % 64) * powf(10000.f, -(float)(2 * (i & 7)) / 16.f); }
__device__ __forceinline__ void chk_mod(unsigned char* ws, const float* const* in, int gw, int ngw, int lane) {
    for (int s = gw; s < 1024; s += ngw) { const unsigned hh = hash(s, 1); const int l = hh & 1, r = (hh >> 1) % 5, n = (hh >> 8) % 6144; float a = 0.f;
        for (int k = lane; k < 1024; k += 64) { const float c = r < 4 ? in[1][r * 1024 + k] : in[3][k]; a += c / (1.f + expf(-c)) * in[4][((size_t)l * 1024 + k) * 6144 + n]; }
        a = wave_sum(a) + in[5][l * 6144 + n]; add(ws, 0, ((const float*)(ws + WS_MOD))[((size_t)l * 5 + r) * 6144 + n], a, lane); }
}
__device__ __forceinline__ void chk_weights(unsigned char* ws, const float* const* in, int gw, int ngw, int lane) {
    for (int s = gw * 64 + lane; s < 65536; s += ngw * 64) { const unsigned hh = hash(s, 2), h2 = hash(s, 3); const int l = hh & 1; float got = 0.f, ref = 0.f; const int which = (hh >> 1) % 12;
        if (which == 0) { const int j = (hh >> 8) % 1952, k = h2 % 1024; int dr = j < 512 ? j : j < 896 ? 768 + (j - 512) : j < 1024 ? 512 + (j - 896) : j < 1152 ? 640 + (j - 1024) : j < 1440 ? j : 1536 + (j - 1440);
            got = bf2f(((const bf16*)(ws + WS_W1T))[((size_t)l * 2048 + dr) * 1024 + k]); ref = rbf(in[10][((size_t)l * 1024 + k) * 1952 + j]); }
        else if (which == 1) { const int j = (hh >> 8) % 3072, k = h2 % 1024; got = bf2f(((const bf16*)(ws + WS_WMGT))[((size_t)l * 3072 + j) * 1024 + k]); ref = rbf(in[27][((size_t)l * 1024 + k) * 3072 + j]); }
        else if (which == 2) { const int j = (hh >> 8) % 768, k = h2 % 384, hd = j / 96, e = j % 96; int de = e; if (e >= 64) { const int i = e - 64; de = 64 + (i < 16 ? 8 * (i >> 2) + (i & 3) : 8 * ((i - 16) >> 2) + 4 + ((i - 16) & 3)); }
            got = bf2f(((const bf16*)(ws + WS_WUQT))[((size_t)l * 768 + hd * 96 + de) * 384 + k]); ref = rbf(in[15][((size_t)l * 384 + k) * 768 + j]); }
        else if (which == 3) { const int j = (hh >> 8) % 1024, k = h2 % 256; got = bf2f(((const bf16*)(ws + WS_WUKVT))[((size_t)l * 1024 + j) * 256 + k]); ref = rbf(in[16][((size_t)l * 256 + k) * 1024 + j]); }
        else if (which == 4) { const int j = (hh >> 8) % 1024, k = h2 % 512; const int jj = j < 512 ? j : j - 512; const int dr = 256 * (jj / 128) + (j < 512 ? 0 : 128) + jj % 128;
            got = bf2f(((const bf16*)(ws + WS_WGLUT))[((size_t)l * 1024 + dr) * 512 + k]); ref = rbf(in[25][((size_t)l * 512 + k) * 1024 + j]); }
        else if (which == 5) { const int n = (hh >> 4) % 3, j = (hh >> 8) % 1024, k = h2 % 512; got = bf2f(((const bf16*)(ws + WS_WBT))[(((size_t)l * 3 + n) * 1024 + j) * 512 + k]); ref = rbf(in[26][(((size_t)l * 3 + n) * 512 + k) * 1024 + j]); }
        else if (which == 6) { const int j = (hh >> 8) % 1024, k = h2 % 1024; got = bf2f(((const bf16*)(ws + WS_WOUTT))[((size_t)l * 1024 + j) * 1024 + k]); ref = rbf(in[29][((size_t)l * 1024 + k) * 1024 + j]); }
        else if (which == 7) { const int j = (hh >> 8) % 2816, k = h2 % 1024, sec = (hh >> 5) & 1; const int dr = 256 * (j / 128) + sec * 128 + j % 128;
            got = bf2f(((const bf16*)(ws + WS_WF1T))[(size_t)dr * 1024 + k]); ref = rbf(in[sec ? 31 : 30][(size_t)k * 2816 + j]); }
        else if (which == 8) { const int j = (hh >> 8) % 1024, k = h2 % 2816; got = bf2f(((const bf16*)(ws + WS_WF2T))[(size_t)j * 2816 + k]); ref = rbf(in[32][(size_t)k * 1024 + j]); }
        else if (which <= 10) { const int e = (hh >> 5) & 7, j = (hh >> 8) % 2816, k = h2 % 1024, sec = which - 9; const int dr = 256 * (j / 128) + sec * 128 + j % 128;
            got = bf2f(((const bf16*)(ws + WS_WM1T))[((size_t)e * 5632 + dr) * 1024 + k]); ref = rbf(in[sec ? 36 : 35][((size_t)e * 1024 + k) * 2816 + j]); }
        else { const int e = (hh >> 5) & 7, j = (hh >> 8) % 1024, k = h2 % 2816; got = bf2f(((const bf16*)(ws + WS_WM2T))[((size_t)e * 1024 + j) * 2816 + k]); ref = rbf(in[37][((size_t)e * 2816 + k) * 1024 + j]); }
        float* d = (float*)(ws + WS_CTL) + CW_DBG + 2 * 1; const float df = got - ref; atomicAdd(d, (df == df) ? df * df : 1e30f); atomicAdd(d + 1, ref * ref); }
}
__device__ __forceinline__ void chk_h(unsigned char* ws, const float* const* in, const float* outp, int k, int l_mod, int shift_chunk, const float* g_pre, int nrows, int gw, int ngw, int lane) {
    for (int s = gw; s < 512; s += ngw) { const int row = hash(s, 10 + k) % nrows; const bool lat = row < NLAT; const int mr = lat ? row >> 12 : 4;
        const float* latp = lat ? outp + (size_t)row * 1024 : (const float*)(ws + WS_LATC) + (size_t)(row - NLAT) * 1024; float ss = 0.f;
        for (int c = lane; c < 1024; c += 64) ss += latp[c] * latp[c];
        const float rs = rsqrtf(wave_sum(ss) / 1024.f + EPS); const float* mod = (const float*)(ws + WS_MOD) + ((size_t)l_mod * 5 + mr) * 6144 + shift_chunk * 1024;
        const int c = hash(s, 77) % 1024; const float ref = latp[c] * rs * g_pre[c] * (1.f + mod[1024 + c]) + mod[c];
        add(ws, k, bf2f(((const bf16*)(ws + P_H))[(size_t)row * 1024 + c]), ref, lane); }
}
template <class F> __device__ __forceinline__ void chk_gemm(unsigned char* ws, int k, const bf16* A, int lda, const float* W, int N, int K, int nrows, int ncols, F fin, int gw, int ngw, int lane) {
    for (int s = gw; s < 1024; s += ngw) { const unsigned hh = hash(s, 20 + k); const int row = hh % nrows, col = (hh >> 16) % ncols;
        const float ref = dot_aw(A + (size_t)row * lda, W + col, N, K, lane); float got, rr; fin(row, col, ref, got, rr); add(ws, k, got, rr, lane); }
}
__device__ __forceinline__ void chk_tok(unsigned char* ws, int k, int l, int gw, int ngw, int lane) {
    const float* par = (const float*)(ws + WS_PAR);
    for (int s = gw; s < 1024; s += ngw) { const unsigned hh = hash(s, 40 + k); const int row = hh % MALL; const bool lat = row < NLAT; const int t = row & 4095; const bf16* z = (const bf16*)(ws + P_Z) + (size_t)row * ZW;
        const int which = (hh >> 20) % 6; float got = 0.f, ref = 0.f;
        if (which == 0 || which == 1) { const int nh = which == 0 ? 8 : 2, hd = (hh >> 24) % nh, d = (hh >> 14) & 63; const bf16* x = z + (which == 0 ? 0 : ZC_KG) + hd * 64; const float* g = par + (which == 0 ? PR_GQ : PR_GK) + l * 64;
            float ss = 0.f; for (int i = 0; i < 64; ++i) ss += bf2f(x[i]) * bf2f(x[i]); const float rs = rsqrtf(ss / 64.f + EPS);
            const int i = d & 31; const float x1 = bf2f(x[i]) * rs * g[i], x2 = bf2f(x[i + 32]) * rs * g[i + 32]; float o = d < 32 ? x1 : x2;
            if (lat) { const float an = angA(t, i), c = cosf(an), sn = sinf(an); o = d < 32 ? x1 * c - x2 * sn : x1 * sn + x2 * c; }
            if (which == 0) { o *= 0.125f * LOG2E; got = bf2f(((const bf16*)(ws + P_QA))[(size_t)row * 512 + hd * 64 + d]); } else got = bf2f(((const bf16*)(ws + P_KA))[(size_t)row * 128 + hd * 64 + d]);
            ref = o; }
        else if (which == 2) { const int i = (hh >> 8) % 384; float ss = 0.f; for (int j = 0; j < 384; ++j) ss += bf2f(z[ZC_CQ + j]) * bf2f(z[ZC_CQ + j]);
            ref = bf2f(z[ZC_CQ + i]) * rsqrtf(ss / 384.f + EPS) * par[PR_GCQ + l * 384 + i]; got = bf2f(((const bf16*)(ws + P_CQN))[(size_t)row * 384 + i]); }
        else if (which == 3) { const int i = (hh >> 8) % 256; float ss = 0.f; for (int j = 0; j < 256; ++j) ss += bf2f(z[ZC_CKV + j]) * bf2f(z[ZC_CKV + j]);
            ref = bf2f(z[ZC_CKV + i]) * rsqrtf(ss / 256.f + EPS) * par[PR_GCKV + l * 256 + i]; got = bf2f(((const bf16*)(ws + P_CKVN))[(size_t)row * 256 + i]); }
        else if (which == 4) { const int d = (hh >> 8) & 31, i = d & 15; const float x1 = bf2f(z[ZC_KR + i]), x2 = bf2f(z[ZC_KR + 16 + i]); float o = d < 16 ? x1 : x2;
            if (lat) { const float an = angB(t, i), c = cosf(an), sn = sinf(an); o = d < 16 ? x1 * c - x2 * sn : x1 * sn + x2 * c; } ref = o; got = bf2f(((const bf16*)(ws + P_KRR))[(size_t)row * 32 + d]); }
        else { const int c = (hh >> 8) & 511, b = lat ? row >> 12 : (row - NLAT) >> 8, pos = lat ? 256 + t : (row - NLAT) & 255; const int wv = (hh >> 19) & 1;
            if (wv) { ref = bf2f(z[ZC_U + c]); got = bf2f(((const bf16*)(ws + P_UG))[((size_t)(b * 32 + (c >> 4)) * LPOS + pos) * 16 + (c & 15)]); }
            else { ref = bf2f(z[ZC_VG + (c & 127)]); got = bf2f(((const bf16*)(ws + P_VA))[(size_t)row * 128 + (c & 127)]); } }
        add(ws, k, got, ref, lane); }
}
__device__ __forceinline__ void chk_attn(unsigned char* ws, int k, bool lastl, int gw, int ngw, int lane) {
    for (int s = gw; s < 256; s += ngw) { const unsigned hh = hash(s, 60 + k); const int typ = hh & 1, b = (hh >> 1) & 3, h = (hh >> 3) & 7, d = (hh >> 6) & 63; const bool cq = !lastl && ((hh >> 12) & 7) == 0;
        const int qrow = cq ? NLAT + b * 256 + ((hh >> 16) & 255) : b * 4096 + ((hh >> 16) & 4095); const int nk = cq ? 256 : LPOS, DKK = typ ? 96 : 64;
        const bf16* q = typ ? (const bf16*)(ws + P_QB) + (size_t)qrow * 768 + h * 96 : (const bf16*)(ws + P_QA) + (size_t)qrow * 512 + h * 64;
        float m = -1e30f, l = 0.f, o = 0.f;
        for (int p = lane; p < nk; p += 64) { const int kr = pos_row(b, p); float sc = 0.f;
            if (typ) { const bf16* kk = (const bf16*)(ws + P_KB) + (size_t)kr * 512 + h * 64; const bf16* k2 = (const bf16*)(ws + P_KRR) + (size_t)kr * 32;
                for (int i = 0; i < 64; ++i) sc += bf2f(q[i]) * bf2f(kk[i]); for (int i = 0; i < 32; ++i) sc += bf2f(q[64 + i]) * bf2f(k2[i]); }
            else { const bf16* kk = (const bf16*)(ws + P_KA) + (size_t)kr * 128 + (h >> 2) * 64; for (int i = 0; i < 64; ++i) sc += bf2f(q[i]) * bf2f(kk[i]); }
            const float v = typ ? bf2f(((const bf16*)(ws + P_VB))[(size_t)kr * 512 + h * 64 + d]) : bf2f(((const bf16*)(ws + P_VA))[(size_t)kr * 128 + (h >> 2) * 64 + d]);
            const float mn = fmaxf(m, sc), al = exp2f(m - mn), pp = exp2f(sc - mn); l = l * al + pp; o = o * al + pp * v; m = mn; (void)DKK; }
        float mg = m; for (int x = 1; x < 64; x <<= 1) mg = fmaxf(mg, __shfl_xor(mg, x));
        const float f = exp2f(m - mg); l = wave_sum(l * f); o = wave_sum(o * f);
        add(ws, k, bf2f(((const bf16*)(ws + P_YBR))[(size_t)qrow * 1536 + typ * 512 + h * 64 + d]), o / l, lane); }
}
__device__ __forceinline__ void chk_s5(unsigned char* ws, const float* const* in, int k, int l, bool lastl, int gw, int ngw, int lane) {
    for (int s = gw; s < 512; s += ngw) { const unsigned hh = hash(s, 80 + k); const int b = hh & 3, g = (hh >> 2) & 31, hp = (hh >> 7) & 15; int psel = (hh >> 12) % LPOS; if (lastl && psel < 256) psel += 256;
        const bf16* U = (const bf16*)(ws + P_UG) + (size_t)(b * 32 + g) * LPOS * 16; float yf[2], yl[2];
        for (int dir = 0; dir < 2; ++dir) { const int pi = ((l * 2 + dir) * 32 + g) * 64 + lane;
            const float lr = fminf(in[17][pi], -1e-4f), li = in[18][pi], dt = expf(in[19][(l * 2 + dir) * 32 + g]); const float mag = expf(lr * dt), abr = mag * cosf(li * dt), abi = mag * sinf(li * dt), den = lr * lr + li * li;
            const float fr = ((abr - 1.f) * lr + abi * li) / den, fi = (abi * lr - (abr - 1.f) * li) / den; float bbr[16], bbi[16];
            _Pragma("unroll") for (int h = 0; h < 16; ++h) { const float br = in[20][(size_t)pi * 16 + h], bi = in[21][(size_t)pi * 16 + h]; bbr[h] = fr * br - fi * bi; bbi[h] = fr * bi + fi * br; }
            float xr = 0.f, xi = 0.f, zr = 0.f, zi = 0.f;
            for (int st = 0; st < LPOS; ++st) { const int p = dir == 0 ? st : (st < 256 ? 255 - st : LPOS + 255 - st); float vr = 0.f, vi = 0.f;
                _Pragma("unroll") for (int h = 0; h < 16; ++h) { const float u = bf2f(U[(size_t)p * 16 + h]); vr += bbr[h] * u; vi += bbi[h] * u; }
                if ((dir == 0 && (p & 15) == 0) || (dir == 1 && (p & 15) == 15)) { zr = 0.f; zi = 0.f; }
                const float nr = abr * xr - abi * xi + vr, ni = abr * xi + abi * xr + vi; xr = nr; xi = ni;
                const float mr = abr * zr - abi * zi + vr, mi = abr * zi + abi * zr + vi; zr = mr; zi = mi;
                if (p == psel) break; }
            const size_t ci = ((size_t)((l * 2 + dir) * 32 + g) * 16 + hp) * 64 + lane; yf[dir] = wave_sum(in[22][ci] * xr - in[23][ci] * xi); yl[dir] = wave_sum(in[22][ci] * zr - in[23][ci] * zi); }
        const float du = in[24][(l * 32 + g) * 16 + hp] * bf2f(U[(size_t)psel * 16 + hp]); const float got = bf2f(((const bf16*)(ws + P_AGLU))[(size_t)pos_row(b, psel) * 512 + g * 16 + hp]);
        auto ge = [](float y) { const float u2 = 0.7978845608028654f * (y + 0.044715f * y * y * y); return 0.5f * y * (1.f + tanhf(u2)); };
        add(ws, k, got, ge(du + yf[0] + yf[1]), lane);
        if (l == 0) { add(ws, 30, got, ge(du + yf[0] + yl[1]), lane); add(ws, 31, got, ge(du + yl[0] + yf[1]), lane); add(ws, 32, got, ge(du + yl[0] + yl[1]), lane); add(ws, 33, got, ge(du), lane); } }
}
__device__ __forceinline__ void chk_s5m(unsigned char* ws, const float* const* in, int k, int gw, int ngw, int lane) {
    for (int s = gw; s < 2048; s += ngw) { const unsigned hh = hash(s, 700), h2 = hash(s, 701); const int l = hh & 1, g = (hh >> 1) & 31, which = (hh >> 6) % 5;
        const bf16* M = (const bf16*)(ws + WS_S5M) + (size_t)(l * 32 + g) * 196608; float got = 0.f, ref = 0.f;
        const int t = (h2 >> 0) & 15, hp = (h2 >> 4) & 15, sx = (h2 >> 8) & 15, h = (h2 >> 12) & 15, p2 = (h2 >> 16) & 63, im = (h2 >> 22) & 1, dsel = (h2 >> 23) & 1;
        float cre[2], cim[2], are[2], aim[2], bre[2], bim[2], lrr[2], lii[2], dtt[2];
        _Pragma("unroll") for (int dir = 0; dir < 2; ++dir) { const int pi = ((l * 2 + dir) * 32 + g) * 64 + lane; lrr[dir] = fminf(in[17][pi], -1e-4f); lii[dir] = in[18][pi]; dtt[dir] = expf(in[19][(l * 2 + dir) * 32 + g]);
            const float mag = expf(lrr[dir] * dtt[dir]); are[dir] = mag * cosf(lii[dir] * dtt[dir]); aim[dir] = mag * sinf(lii[dir] * dtt[dir]);
            const float den = lrr[dir] * lrr[dir] + lii[dir] * lii[dir], fr = ((are[dir] - 1.f) * lrr[dir] + aim[dir] * lii[dir]) / den, fi = (aim[dir] * lrr[dir] - (are[dir] - 1.f) * lii[dir]) / den;
            const float br = in[20][(size_t)pi * 16 + h], bi = in[21][(size_t)pi * 16 + h]; bre[dir] = fr * br - fi * bi; bim[dir] = fr * bi + fi * br;
            const size_t ci = ((size_t)((l * 2 + dir) * 32 + g) * 16 + hp) * 64 + lane; cre[dir] = in[22][ci]; cim[dir] = in[23][ci]; }
        if (which == 0) {
            float acc = 0.f;
            _Pragma("unroll") for (int dir = 0; dir < 2; ++dir) { const int j = dir == 0 ? t - sx : sx - t; if (j >= 0) { float pr = 1.f, pq = 0.f; for (int e = 0; e < j; ++e) { const float nr = pr * are[dir] - pq * aim[dir], nq = pr * aim[dir] + pq * are[dir]; pr = nr; pq = nq; }
                    const float tr = cre[dir] * pr - cim[dir] * pq, tq = cre[dir] * pq + cim[dir] * pr; acc += tr * bre[dir] - tq * bim[dir]; } }
            ref = wave_sum(acc) + ((t == sx && h == hp) ? in[24][(l * 32 + g) * 16 + h] : 0.f); got = bf2f(M[(size_t)(16 * t + hp) * 256 + 16 * sx + h]); }
        else if (which <= 2) {
            const int dir = which - 1, ex = dir == 0 ? t + 1 : 16 - t; float pr = 1.f, pq = 0.f; for (int e = 0; e < ex; ++e) { const float nr = pr * are[dir] - pq * aim[dir], nq = pr * aim[dir] + pq * are[dir]; pr = nr; pq = nq; }
            const float tr = cre[dir] * pr - cim[dir] * pq, tq = cre[dir] * pq + cim[dir] * pr; const float mine = im ? -tq : tr; ref = __shfl(mine, p2); got = bf2f(M[(dir == 0 ? 65536 : 98304) + (size_t)(16 * t + hp) * 128 + 2 * p2 + im]); }
        else {
            const int dir = which - 3, ex = dir == 0 ? 15 - sx : sx; float pr = 1.f, pq = 0.f; for (int e = 0; e < ex; ++e) { const float nr = pr * are[dir] - pq * aim[dir], nq = pr * aim[dir] + pq * are[dir]; pr = nr; pq = nq; }
            const float tr = pr * bre[dir] - pq * bim[dir], tq = pr * bim[dir] + pq * bre[dir]; const float mine = im ? tq : tr; ref = __shfl(mine, p2); got = bf2f(M[(dir == 0 ? 131072 : 163840) + (size_t)(2 * p2 + im) * 256 + 16 * sx + h]); }
        (void)dsel; add(ws, which == 0 ? ((t == sx && h == hp) ? k : 35) : which <= 2 ? 36 : 37, got, ref, lane); }
}

__device__ __forceinline__ void chk_s5x(unsigned char* ws, const float* const* in, int gw, int ngw, int lane) {
    const int l = 0, b = 0;
    for (int s = gw; s < 512; s += ngw) { const unsigned hh = hash(s, 900); const int g = hh & 15, dir = (hh >> 5) & 1, c = (hh >> 8) % 272, im = (hh >> 20) & 1, psel = (hh >> 24) & 63;
        const bf16* U = (const bf16*)(ws + P_UG) + (size_t)(b * 32 + g) * LPOS * 16; const int pi = ((l * 2 + dir) * 32 + g) * 64 + lane;
        const float lr = fminf(in[17][pi], -1e-4f), li = in[18][pi], dt = expf(in[19][(l * 2 + dir) * 32 + g]); const float mag = expf(lr * dt), abr = mag * cosf(li * dt), abi = mag * sinf(li * dt), den = lr * lr + li * li;
        const float fr = ((abr - 1.f) * lr + abi * li) / den, fi = (abi * lr - (abr - 1.f) * li) / den; float bbr[16], bbi[16];
        _Pragma("unroll") for (int h = 0; h < 16; ++h) { const float br = in[20][(size_t)pi * 16 + h], bi = in[21][(size_t)pi * 16 + h]; bbr[h] = fr * br - fi * bi; bbi[h] = fr * bi + fi * br; }
        float xr = 0.f, xi = 0.f;
        for (int st = 0; st < LPOS; ++st) { const int p = dir == 0 ? st : (st < 256 ? 255 - st : LPOS + 255 - st);
            if ((p >> 4) == c) break;
            float vr = 0.f, vi = 0.f;
            _Pragma("unroll") for (int h = 0; h < 16; ++h) { const float u = bf2f(U[(size_t)p * 16 + h]); vr += bbr[h] * u; vi += bbi[h] * u; }
            const float nr = abr * xr - abi * xi + vr, ni = abr * xi + abi * xr + vi; xr = nr; xi = ni; }
        const float mine = im ? xi : xr; const float ref = __shfl(mine, psel);
        {
          float er = 0.f, ei = 0.f;
          for (int q = 0; q < 16; ++q) { const int sx = dir == 0 ? q : 15 - q, p = 16 * c + sx; float vr = 0.f, vi = 0.f;
              _Pragma("unroll") for (int h = 0; h < 16; ++h) { const float u = bf2f(U[(size_t)p * 16 + h]); vr += bbr[h] * u; vi += bbi[h] * u; }
              const float nr = abr * er - abi * ei + vr, ni = abr * ei + abi * er + vi; er = nr; ei = ni; }
          const float m2 = im ? ei : er; const float r2 = __shfl(m2, psel);
          const bf16* E = (const bf16*)(ws + WS_POOL + 98 * MiB) + (size_t)g * 69632 + (size_t)dir * 34816;
          add(ws, 39, bf2f(E[c * 128 + 2 * psel + im]), r2, lane); }
        const bf16* X = (const bf16*)(ws + WS_POOL + 94 * MiB) + (size_t)g * 69632 + (size_t)dir * 34816;
        add(ws, 38, bf2f(X[c * 128 + 2 * psel + im]), ref, lane); }
}
__device__ __forceinline__ void encode(unsigned char* ws, const float* x, float* outp, int nchk, int gt, int ngt) {
    const float* d = (const float*)(ws + WS_CTL) + CW_DBG; int bad = -1; float eb = 0.f;
#ifdef DBG_REPORT
    { const int k = DBG_REPORT; const float e = sqrtf(d[2 * k] / fmaxf(d[2 * k + 1], 1e-30f)); const float F = 1.f + 1e14f * fminf(e * e, 1e4f) + 1e3f;
      for (size_t i = gt; i < (size_t)NLAT * 1024; i += ngt) outp[i] = x[i] * F; return; }
#endif
    for (int k = 0; k < 30; ++k) { const float e = sqrtf(d[2 * k] / fmaxf(d[2 * k + 1], 1e-30f)); const bool unused = d[2 * k + 1] == 0.f && d[2 * k] == 0.f; if (!unused && !(e < 0.02f)) { bad = k; eb = e; break; } }
    if (bad < 0) return;
    float F = 1.f; for (int i = 0; i <= bad; ++i) F *= 4.f; F = 1.f + F * (1.f + fminf(eb, 0.99f));
    for (size_t i = gt; i < (size_t)NLAT * 1024; i += ngt) outp[i] = x[i] * F;
}
}
struct Args;
#endif

struct Args { const float* in[38]; float* out; unsigned char* ws; int ph_lo, ph_hi; };
constexpr int PH_PRO = 0, PH_R0 = 1, PH_L0 = 2, PH_PER_L = 16, NPH = PH_L0 + 2 * PH_PER_L;


#if MK_DEBUG
constexpr int DBG_NCHK = 40;
__global__ void __launch_bounds__(NTHREADS, 2) dbg_fwd(Args args, int ph) {
    unsigned char* ws = args.ws; float* outp = args.out; const float* const* in = args.in;
    const int tid = threadIdx.x, lane = tid & 63, wave = tid >> 6, gw = blockIdx.x * NWAVES + wave, ngw = gridDim.x * NWAVES;
    const float* par = (const float*)(ws + WS_PAR);
    if (ph == 1000) { dbg::encode(ws, in[0], outp, DBG_NCHK, blockIdx.x * NTHREADS + tid, gridDim.x * NTHREADS); return; }
    if (ph == PH_PRO) { dbg::chk_mod(ws, in, gw, ngw, lane); dbg::chk_weights(ws, in, gw, ngw, lane); dbg::chk_s5m(ws, in, 16, gw, ngw, lane); return; }
    if (ph == PH_R0) { dbg::chk_h(ws, in, outp, 2, 0, 0, par + PR_GMIXPRE, MALL, gw, ngw, lane); return; }
    const int l = (ph - PH_L0) / PH_PER_L, rel = (ph - PH_L0) % PH_PER_L, kb = 3 + 14 * l; const bool lastl = l == 1; const int nrq = lastl ? NLAT : MALL;
    if (rel == 0) { const bf16* Z = (const bf16*)(ws + P_Z);
        dbg::chk_gemm(ws, kb + 0, (const bf16*)(ws + P_H), 1024, in[10] + (size_t)l * 1024 * NIN, NIN, 1024, MALL, NIN, [=](int row, int col, float ref, float& got, float& rr) {
            const int j = col, dr = j < 512 ? j : j < 896 ? 768 + (j - 512) : j < 1024 ? 512 + (j - 896) : j < 1152 ? 640 + (j - 1024) : j < 1440 ? j : 1536 + (j - 1440); got = bf2f(Z[(size_t)row * ZW + dr]); rr = ref; }, gw, ngw, lane); }
    if (rel == 1) dbg::chk_tok(ws, kb + 1, l, gw, ngw, lane);
    if (rel == 2) {
        const bf16* QB = (const bf16*)(ws + P_QB); const bf16* CQ = (const bf16*)(ws + P_CQN); const float* Wq = in[15] + (size_t)l * 384 * 768; const float scale = 0.10206207261596575f * LOG2E;
        dbg::chk_gemm(ws, kb + 2, CQ, 384, Wq, 768, 384, nrq, 768, [=](int row, int col, float ref, float& got, float& rr) {
            const int hd = col / 96, e = col % 96; float v = ref;
            if (e >= 64 && row < NLAT) { const int i = (e - 64) & 15; const float x1 = dbg::dot_aw(CQ + (size_t)row * 384, Wq + hd * 96 + 64 + i, 768, 384, lane), x2 = dbg::dot_aw(CQ + (size_t)row * 384, Wq + hd * 96 + 80 + i, 768, 384, lane);
                const float an = dbg::angB(row & 4095, i), c = cosf(an), sn = sinf(an); v = e < 80 ? x1 * c - x2 * sn : x1 * sn + x2 * c; }
            got = bf2f(QB[(size_t)row * 768 + col]); rr = v * scale; }, gw, ngw, lane);
        const bf16* KB = (const bf16*)(ws + P_KB); const bf16* VB = (const bf16*)(ws + P_VB);
        dbg::chk_gemm(ws, kb + 3, (const bf16*)(ws + P_CKVN), 256, in[16] + (size_t)l * 256 * 1024, 1024, 256, MALL, 1024, [=](int row, int col, float ref, float& got, float& rr) {
            const int hd = col / 128, e = col % 128; got = e < 64 ? bf2f(KB[(size_t)row * 512 + hd * 64 + e]) : bf2f(VB[(size_t)row * 512 + hd * 64 + e - 64]); rr = ref; }, gw, ngw, lane); }
    if (rel == 3) { dbg::chk_attn(ws, kb + 4, lastl, gw, ngw, lane); dbg::chk_s5(ws, in, kb + 5, l, lastl, gw, ngw, lane); if (l == 0) dbg::chk_s5x(ws, in, gw, ngw, lane); }
    if (rel == 4) { const bf16* AG = (const bf16*)(ws + P_AGLU); const bf16* YB = (const bf16*)(ws + P_YBR); const float* Wg = in[25] + (size_t)l * 512 * 1024;
        dbg::chk_gemm(ws, kb + 6, AG, 512, Wg, 1024, 512, nrq, 512, [=](int row, int col, float ref, float& got, float& rr) {
            const float g = dbg::dot_aw(AG + (size_t)row * 512, Wg + 512 + col, 1024, 512, lane); got = bf2f(YB[(size_t)row * 1536 + 1024 + col]); rr = ref / (1.f + expf(-g)); }, gw, ngw, lane); }
    if (rel == 5) { const bf16* H = (const bf16*)(ws + P_H); const bf16* YB = (const bf16*)(ws + P_YBR); const bf16* MG = (const bf16*)(ws + P_MRG);
        const float* Wm = in[27] + (size_t)l * 1024 * 3072; const float* Wb = in[26] + (size_t)l * 3 * 512 * 1024; const float* bm = in[28] + l * 3072;
        for (int s = gw; s < 512; s += ngw) { const unsigned hh = dbg::hash(s, 333 + l); const int row = hh % nrq, col = (hh >> 16) % 1024; float acc = 0.f;
            for (int n = 0; n < 3; ++n) { const float g = dbg::dot_aw(H + (size_t)row * 1024, Wm + n * 1024 + col, 3072, 1024, lane) + bm[n * 1024 + col];
                const float p = dbg::dot_aw(YB + (size_t)row * 1536 + n * 512, Wb + (size_t)n * 512 * 1024 + col, 1024, 512, lane); acc += p / (1.f + expf(-g)); }
            dbg::add(ws, kb + 7, bf2f(MG[(size_t)row * 1024 + col]), acc, lane); } }
    if (rel == 6) { const float* Y = (const float*)(ws + P_Y);
        dbg::chk_gemm(ws, kb + 8, (const bf16*)(ws + P_MRG), 1024, in[29] + (size_t)l * 1024 * 1024, 1024, 1024, nrq, 1024, [=](int row, int col, float ref, float& got, float& rr) { got = Y[(size_t)row * 1024 + col]; rr = ref; }, gw, ngw, lane); }
    if (rel == 7) dbg::chk_h(ws, in, outp, kb + 9, l, 3, par + PR_GFFNPRE + l * 1024, nrq, gw, ngw, lane);
    if (!lastl) {
        if (rel == 8) { const bf16* H = (const bf16*)(ws + P_H); const bf16* ACT = (const bf16*)(ws + P_ACT);
            dbg::chk_gemm(ws, kb + 10, H, 1024, in[30], DFF, 1024, MALL, DFF, [=](int row, int col, float ref, float& got, float& rr) {
                const float b = dbg::dot_aw(H + (size_t)row * 1024, in[31] + col, DFF, 1024, lane); got = bf2f(ACT[(size_t)row * DFF + col]); rr = ref / (1.f + expf(-ref)) * b; }, gw, ngw, lane); }
        if (rel == 9) { const float* Y2 = (const float*)(ws + P_Y2);
            dbg::chk_gemm(ws, kb + 11, (const bf16*)(ws + P_ACT), DFF, in[32], 1024, DFF, MALL, 1024, [=](int row, int col, float ref, float& got, float& rr) { got = Y2[(size_t)row * 1024 + col]; rr = ref; }, gw, ngw, lane); }
        if (rel == 12) dbg::chk_h(ws, in, outp, kb + 12, 1, 0, par + PR_GMIXPRE + 1024, MALL, gw, ngw, lane);
    } else if (rel == 11) {
        const bf16* H = (const bf16*)(ws + P_H); const bf16* FO = (const bf16*)(ws + P_Y2); const unsigned* cnt = (const unsigned*)(ws + WS_CTL) + CW_CNT; const int* ti = (const int*)(ws + WS_LIST) + 8 * 16384;
        for (int s = gw; s < 64; s += ngw) { const unsigned hh = dbg::hash(s, 555); const int tok = hh % NLAT, kk = (hh >> 16) & 1, c = (hh >> 17) % 1024; const int e = ti[tok * 8 + 2 * kk], pos = ti[tok * 8 + 2 * kk + 1];
            int base = 0; for (int q = 0; q < e; ++q) base += ((int)cnt[q] + 255) >> 8;
            float acc = 0.f;
            for (int j = 0; j < DFF; ++j) { const float a = dbg::dot_aw(H + (size_t)tok * 1024, in[35] + (size_t)e * 1024 * DFF + j, DFF, 1024, lane), b = dbg::dot_aw(H + (size_t)tok * 1024, in[36] + (size_t)e * 1024 * DFF + j, DFF, 1024, lane);
                acc += dbg::rbf(a / (1.f + expf(-a)) * b) * dbg::rbf(in[37][((size_t)e * DFF + j) * 1024 + c]); }
            dbg::add(ws, kb + 10, bf2f(FO[((size_t)base * 256 + pos) * 1024 + c]), acc, lane); } }
}
#endif

#ifndef PHMASK
#define PHMASK 0xFFFFFFFFu
#endif
#define PHON(k) (((PHMASK) >> (k)) & 1u)
#ifndef REPMASK
#define REPMASK 0u
#endif
#define REPON(k) (((REPMASK) >> (k)) & 1u)

__device__ __forceinline__ ResidArgs Rd(ResidArgs R, int rep) { R.dry = rep > 0; return R; }
__global__ void __launch_bounds__(NTHREADS, 2) mk_fwd(Args args) {
    extern __shared__ __attribute__((aligned(16))) unsigned char lds_raw[];
    LAS unsigned char* lds = (LAS unsigned char*)lds_raw;
    const int wave = __builtin_amdgcn_readfirstlane((int)threadIdx.x >> 6);
#define tid (wave * 64 + lane_id())
    const int G = gridDim.x, bx = blockIdx.x; const int vcu = (G % 8 == 0) ? (bx % 8) * (G / 8) + bx / 8 : bx;
    unsigned char* ws0 = args.ws; float* outp = args.out;
    unsigned char* ws = ws0;
    volatile LAS unsigned* misc = (volatile LAS unsigned*)(lds + LDS_MISC);
    LAS int* tb; { unsigned tba_ = (unsigned)(uintptr_t)(lds + LDS_MISC + 64); asm volatile("" : "+s"(tba_)); tb = (LAS int*)(uintptr_t)tba_; }
    if (tid < 64) misc[tid] = 0u;
    __syncthreads();
    const int lo = args.ph_lo, hi = args.ph_hi;
    XcdBarrier bar; bar.bar = (unsigned*)(ws + WS_CTL) + CW_BAR; bar.x = 0; bar.st = misc; bar.wave = wave;
    if (hi - lo > 1) bar = xcd_barrier_post((unsigned*)(ws + WS_CTL) + CW_BAR, misc, wave);
#define IN(k) (lo <= (k) && (k) < hi)
#define SEAM(k) do { if ((k) + 1 < hi) xcd_barrier(bar); } while (0)
    const int gw = vcu * NWAVES + wave, ngw = G * NWAVES;

    if (PHON(0) && IN(PH_PRO)) for (int rep_ = 0; rep_ <= (int)REPON(0); ++rep_) {
            GAS unsigned char* wsq = (GAS unsigned char*)ws0; asm volatile("" : "+s"(wsq)); unsigned char* const ws = (unsigned char*)wsq; const float* const par = (const float*)(ws + WS_PAR); int lnq = lane_id(); asm volatile("" : "+v"(lnq)); const int lane = lnq; (void)par; (void)lane;
        Ptrs P;
        { const float* const* in = args.in;
          P.x = in[0]; P.c = in[1]; P.ctx = in[2]; P.c_ctx = in[3]; P.w_mod = in[4]; P.b_mod = in[5]; P.g_mix_pre = in[6]; P.g_mix_post = in[7]; P.g_ffn_pre = in[8]; P.g_ffn_post = in[9];
          P.w_in = in[10]; P.g_q = in[11]; P.g_k = in[12]; P.g_cq = in[13]; P.g_ckv = in[14]; P.w_uq = in[15]; P.w_ukv = in[16];
          P.s5p.lam_re = in[17]; P.s5p.lam_im = in[18]; P.s5p.log_dt = in[19]; P.s5p.b_re = in[20]; P.s5p.b_im = in[21]; P.s5p.c_re = in[22]; P.s5p.c_im = in[23]; P.s5p.dsk = in[24];
          P.w_glu = in[25]; P.w_branch = in[26]; P.w_mg = in[27]; P.b_mg = in[28]; P.w_out = in[29]; P.ffn_w1 = in[30]; P.ffn_w3 = in[31]; P.ffn_w2 = in[32];
          P.router_w = in[33]; P.router_b = in[34]; P.moe_w1 = in[35]; P.moe_w3 = in[36]; P.moe_w2 = in[37]; P.out = args.out; P.ws = args.ws; }
#ifndef PRO_ONLYT
#define PRO_ONLYT 0
#endif
        if (!(PRO_ONLYT && rep_ > 0)) {
        copy_params(P, bx * NTHREADS + tid, G * NTHREADS);
        for (int it = bx; it < 192 + 64; it += G) {
            if (it < 192) mod_item(P, it, lds, wave);
#ifndef PRO_SKIPB
#define PRO_SKIPB 0
#endif
#ifndef BM_SKIP
#define BM_SKIP 0
#endif
            else if (!(PRO_SKIPB && rep_ > 0)) { const int q = it - 192, l = q >> 5, g = q & 31; s5::build_mats(P.s5p, l, g, (bf16*)(ws + WS_S5M) + (size_t)(l * 32 + g) * s5::M_TOTAL, lds, wave, rep_ > 0 ? BM_SKIP : 0); }
        }
        rope_tables(P, bx * NTHREADS + tid, G * NTHREADS);
        }
        __syncthreads();
#ifndef PRO_NOT
#define PRO_NOT 0
#endif
        if (!(PRO_NOT && rep_ > 0)) transposes(P, gw, ngw, (LAS float*)(lds + wave * 16384), lane, rep_);
        SEAM(PH_PRO);
    }
    if (PHON(1) && IN(PH_R0)) for (int rep_ = 0; rep_ <= (int)REPON(1); ++rep_) {
            GAS unsigned char* wsq = (GAS unsigned char*)ws0; asm volatile("" : "+s"(wsq)); unsigned char* const ws = (unsigned char*)wsq; const float* const par = (const float*)(ws + WS_PAR); int lnq = lane_id(); asm volatile("" : "+v"(lnq)); const int lane = lnq; (void)par; (void)lane;
        ResidArgs R{}; R.mode = 0; R.g_pre = par + PR_GMIXPRE; R.shift_chunk = 0; R.hout = (bf16*)(ws + P_H); R.l_mod = 0; R.route = false; R.hout8 = ws + P_H8;
        const float* xin = args.in[0]; const float* ctxin = args.in[2];
        { int row = gw; for (; row + ngw < MALL; row += 2 * ngw) { resid_row(ws, outp, xin, ctxin, Rd(R, rep_), row, lane, tb); resid_row(ws, outp, xin, ctxin, Rd(R, rep_), row + ngw, lane, tb); } if (row < MALL) resid_row(ws, outp, xin, ctxin, Rd(R, rep_), row, lane, tb); }
        SEAM(PH_R0);
    }
#define MOE_TAIL_FROM(lo_pm, hi_pm, first) do { if (l == 0 && bx >= (first)) { const int lane_ = lane_id(); \
            moe_transposes(args.in[35], args.in[36], args.in[37], ws, (int)((long)MOE_ITEMS * (lo_pm) / 1000), (int)((long)MOE_ITEMS * (hi_pm) / 1000), (bx - (first)) * NWAVES + wave, (G - (first)) * NWAVES, (LAS float*)(lds + wave * 16384), lane_); } } while (0)
#define MOE_TAIL(lo_pm, hi_pm) MOE_TAIL_FROM(lo_pm, hi_pm, 16)
    for (int l = 0; l < 2; ++l) {
        const int pb = PH_L0 + l * PH_PER_L; const bool lastl = (l == 1);
        const int nMall = 68, nMq = lastl ? 64 : 68;
        if (PHON(2) && IN(pb + 0)) for (int rep_ = 0; rep_ <= (int)REPON(2); ++rep_) {
            GAS unsigned char* wsq = (GAS unsigned char*)ws0; asm volatile("" : "+s"(wsq)); unsigned char* const ws = (unsigned char*)wsq; const float* const par = (const float*)(ws + WS_PAR); int lnq = lane_id(); asm volatile("" : "+v"(lnq)); const int lane = lnq; (void)par; (void)lane;
            if (F8_G1L1 && lastl) {
                pg8::SchedPlain S{(const char*)(ws + P_H8), (const char*)(ws + WS_W1T) + (size_t)l * ZW * 2048, 1024u, 1024u, 8, nMall, 8, G, bx};
                pg8::EpiBf16S E{(bf16*)(ws + P_Z), ZW, 1.0f / (F8_HSCALE * F8_WSCALE)};
                pg8::gemm_phase<pg8::EpiBf16S, pg8::SchedPlain, false, true>(lds, S, E, wave);
            } else {
            pg8::SchedPlain S{(const char*)(ws + P_H), (const char*)(ws + WS_W1T) + (size_t)l * ZW * 2048, 2048u, 2048u, 16, nMall, 8, G, bx};
            pg8::EpiBf16 E{(bf16*)(ws + P_Z), ZW, 0};
            pg8::gemm_phase<pg8::EpiBf16, pg8::SchedPlain, false>(lds, S, E, wave); }
            SEAM(pb + 0);
        }
        if (PHON(3) && IN(pb + 1)) for (int rep_ = 0; rep_ <= (int)REPON(3); ++rep_) {
            GAS unsigned char* wsq = (GAS unsigned char*)ws0; asm volatile("" : "+s"(wsq)); unsigned char* const ws = (unsigned char*)wsq; const float* const par = (const float*)(ws + WS_PAR); int lnq = lane_id(); asm volatile("" : "+v"(lnq)); const int lane = lnq; (void)par; (void)lane;
            { int row = gw; for (; row + ngw < MALL; row += 2 * ngw) { token_row(ws, l, row, lane); token_row(ws, l, row + ngw, lane); } if (row < MALL) token_row(ws, l, row, lane); }
            SEAM(pb + 1);
        }
        if (PHON(4) && IN(pb + 2)) for (int rep_ = 0; rep_ <= (int)REPON(4); ++rep_) {
            GAS unsigned char* wsq = (GAS unsigned char*)ws0; asm volatile("" : "+s"(wsq)); unsigned char* const ws = (unsigned char*)wsq; const float* const par = (const float*)(ws + WS_PAR); int lnq = lane_id(); asm volatile("" : "+v"(lnq)); const int lane = lnq; (void)par; (void)lane;
            { pg8::SchedUp S{(const char*)(ws + P_CQN), (const char*)(ws + WS_WUQT) + (size_t)l * 768 * 768, (const char*)(ws + P_CKVN), (const char*)(ws + WS_WUKVT) + (size_t)l * 1024 * 512, nMq, nMall, G, bx};
              pg8::EpiUp E{pg8::EpiUq{(bf16*)(ws + P_QB), (const float*)(ws + WS_ROPE) + 2 * 4096 * 32, (const float*)(ws + WS_ROPE) + 2 * 4096 * 32 + 4096 * 16, 0.10206207261596575f * LOG2E}, pg8::EpiUkv{(bf16*)(ws + P_KB), (bf16*)(ws + P_VB)}};
              pg8::gemm_phase<pg8::EpiUp, pg8::SchedUp, false>(lds, S, E, wave); }
            SEAM(pb + 2);
        }
        if (PHON(5) && IN(pb + 3)) for (int rep_ = 0; rep_ <= (int)REPON(5); ++rep_) {
            GAS unsigned char* wsq = (GAS unsigned char*)ws0; asm volatile("" : "+s"(wsq)); unsigned char* const ws = (unsigned char*)wsq; const float* const par = (const float*)(ws + WS_PAR); int lnq = lane_id(); asm volatile("" : "+v"(lnq)); const int lane = lnq; (void)par; (void)lane;
            const int nlatu = 1024, nctxu = lastl ? 0 : 64;
            for (int it = vcu; it < nlatu + nctxu; it += G) {
                att::AttnArgs A; int typ, b, h;
                if (it < nlatu) { const int u = it >> 1; typ = (it ^ (it >> 8)) & 1;
                    b = u >> 7; h = (u >> 4) & 7; const int qb = u & 15; A.qrow0 = (long)b * SEQ + qb * 256; A.ntiles = 68; }
                else { const int u = it - nlatu; typ = u & 1; b = (u >> 1) >> 3; h = (u >> 1) & 7; A.qrow0 = NLAT + (long)b * CTXL; A.ntiles = 4; }
                A.b = b; A.O = (bf16*)(ws + P_YBR); A.opitch = 1536;
                if (typ == 0) { A.Q = (const bf16*)(ws + P_QA); A.qpitch = 512; A.qcol = h * 64; A.K1 = (const bf16*)(ws + P_KA); A.k1pitch = 128; A.k1col = (h >> 2) * 64; A.K2 = nullptr; A.k2pitch = 0;
                    A.V = (const bf16*)(ws + P_VA); A.vpitch = 128; A.vcol = (h >> 2) * 64; A.ocol = h * 64; att::attn_unit4<64>(A, lds, wave); }
                else { A.Q = (const bf16*)(ws + P_QB); A.qpitch = 768; A.qcol = h * 96; A.K1 = (const bf16*)(ws + P_KB); A.k1pitch = 512; A.k1col = h * 64; A.K2 = (const bf16*)(ws + P_KRR); A.k2pitch = 32;
                    A.V = (const bf16*)(ws + P_VB); A.vpitch = 512; A.vcol = h * 64; A.ocol = 512 + h * 64; att::attn_unit4<96>(A, lds, wave); }
            }
            __syncthreads();
#ifndef S5REP
#define S5REP 1
#endif
            for (int s5r_ = 0; s5r_ < S5REP; ++s5r_)
            for (int it = G - 1 - vcu; it < 256; it += G) { const int b = it >> 6, g = (it >> 1) & 31, half = it & 1;
                s5::unit(par + PR_A16, l, b, g, (const bf16*)(ws + P_UG), (const bf16*)(ws + WS_S5M) + (size_t)(l * 32 + g) * s5::M_TOTAL, (bf16*)(ws + P_AGLU), lastl, lds, wave, half); }
            SEAM(pb + 3);
        }
        if (PHON(6) && IN(pb + 4)) for (int rep_ = 0; rep_ <= (int)REPON(6); ++rep_) {
            GAS unsigned char* wsq = (GAS unsigned char*)ws0; asm volatile("" : "+s"(wsq)); unsigned char* const ws = (unsigned char*)wsq; const float* const par = (const float*)(ws + WS_PAR); int lnq = lane_id(); asm volatile("" : "+v"(lnq)); const int lane = lnq; (void)par; (void)lane;
            pg8::SchedPlain S{(const char*)(ws + P_AGLU), (const char*)(ws + WS_WGLUT) + (size_t)l * 1024 * 1024, 1024u, 1024u, 8, nMq, 4, G, bx};
            pg8::EpiPair<0> E{(bf16*)(ws + P_YBR), 1536, 1024, 0};
            pg8::gemm_phase<pg8::EpiPair<0>, pg8::SchedPlain, false>(lds, S, E, wave);
            SEAM(pb + 4);
        }
        if (PHON(7) && IN(pb + 5)) for (int rep_ = 0; rep_ <= (int)REPON(7); ++rep_) {
            GAS unsigned char* wsq = (GAS unsigned char*)ws0; asm volatile("" : "+s"(wsq)); unsigned char* const ws = (unsigned char*)wsq; const float* const par = (const float*)(ws + WS_PAR); int lnq = lane_id(); asm volatile("" : "+v"(lnq)); const int lane = lnq; (void)par; (void)lane;
#define MRG_ROUND(r) do { \
                { pg8::SchedMergeG S{(const char*)(ws + P_H8), (const char*)(ws + WS_WMGT) + (size_t)l * 3072 * 1024, 1024u, 1024u, 8, nMq, (r) * G + bx}; \
                  pg8::EpiGate E{par + PR_BMG + l * 3072, (u32x4*)(ws + P_GSCR + (size_t)bx * 3 * 131072), 1.0f / (F8_HSCALE * F8_WSCALE)}; \
                  pg8::gemm_phase<pg8::EpiGate, pg8::SchedMergeG, false, true>(lds, S, E, wave); } \
                { pg8::SchedMergeP S{(const char*)(ws + P_YBR), (const char*)(ws + WS_WBT) + (size_t)l * 3 * 1024 * 1024, 3072u, 1024u, 8, nMq, (r) * G + bx}; \
                  pg8::EpiMergeP E{(bf16*)(ws + P_MRG), (const u32x4*)(ws + P_GSCR + (size_t)bx * 3 * 131072)}; \
                  pg8::gemm_phase<pg8::EpiMergeP, pg8::SchedMergeP, false, false>(lds, S, E, wave); } } while (0)
            MRG_ROUND(0);
            const int nx = nMq * 4 - G; int mfirst = 16;
            if (nx > 0 && 3 * nx <= G) { mfirst = 3 * nx;
                if (bx < 3 * nx) { const int j = bx % nx, n = bx / nx; unsigned* flag = (unsigned*)(ws + WS_CTL) + CW_MFLAG + 64 * j; const unsigned want = (unsigned)(rep_ * 3 + n);
                    { pg8::SchedMergeG S{(const char*)(ws + P_H8), (const char*)(ws + WS_WMGT) + (size_t)l * 3072 * 1024, 1024u, 1024u, 8, nMq, G + j, n};
                      pg8::EpiGate E{par + PR_BMG + l * 3072, (u32x4*)(ws + P_GSCR + (size_t)bx * 3 * 131072), 1.0f / (F8_HSCALE * F8_WSCALE)};
                      pg8::gemm_phase<pg8::EpiGate, pg8::SchedMergeG, false, true>(lds, S, E, wave); }
                    if (n > 0) { if (wave == 0 && lane_id() == 0) { XB_SPIN(xb_ld(flag) < want, (unsigned*)(ws + WS_CTL) + CW_BAR); __builtin_amdgcn_fence(__ATOMIC_ACQUIRE, "agent"); asm volatile("s_waitcnt vmcnt(0)" ::: "memory"); }
                        __syncthreads(); }
                    { pg8::SchedMergeP S{(const char*)(ws + P_YBR), (const char*)(ws + WS_WBT) + (size_t)l * 3 * 1024 * 1024, 3072u, 1024u, 8, nMq, G + j, n};
                      pg8::EpiMergeP E{(bf16*)(ws + P_MRG), (const u32x4*)(ws + P_GSCR + (size_t)bx * 3 * 131072)};
                      pg8::gemm_phase<pg8::EpiMergeP, pg8::SchedMergeP, false, false>(lds, S, E, wave); }
                    asm volatile("s_waitcnt vmcnt(0)" ::: "memory");
                    __syncthreads();
                    if (wave == 0 && lane_id() == 0) { __builtin_amdgcn_fence(__ATOMIC_RELEASE, "agent"); asm volatile("s_waitcnt vmcnt(0)" ::: "memory"); __hip_atomic_store(flag, want + 1u, __ATOMIC_RELAXED, __HIP_MEMORY_SCOPE_AGENT); }
                }
            } else if (nx > 0) MRG_ROUND(1);
#undef MRG_ROUND
            MOE_TAIL_FROM(0, 480, mfirst);
            SEAM(pb + 5);
        }
        if (PHON(8) && IN(pb + 6)) for (int rep_ = 0; rep_ <= (int)REPON(8); ++rep_) {
            GAS unsigned char* wsq = (GAS unsigned char*)ws0; asm volatile("" : "+s"(wsq)); unsigned char* const ws = (unsigned char*)wsq; const float* const par = (const float*)(ws + WS_PAR); int lnq = lane_id(); asm volatile("" : "+v"(lnq)); const int lane = lnq; (void)par; (void)lane;
            pg8::SchedPlain S{(const char*)(ws + P_MRG), (const char*)(ws + WS_WOUTT) + (size_t)l * 1024 * 2048, 2048u, 2048u, 16, nMq, 4, G, bx};
            pg8::EpiBf16 E{(bf16*)(ws + P_Y), 1024, 0};
            pg8::gemm_phase<pg8::EpiBf16, pg8::SchedPlain, false>(lds, S, E, wave);
            MOE_TAIL(480, 620);
            SEAM(pb + 6);
        }
        if (PHON(9) && IN(pb + 7)) for (int rep_ = 0; rep_ <= (int)REPON(9); ++rep_) {
            GAS unsigned char* wsq = (GAS unsigned char*)ws0; asm volatile("" : "+s"(wsq)); unsigned char* const ws = (unsigned char*)wsq; const float* const par = (const float*)(ws + WS_PAR); int lnq = lane_id(); asm volatile("" : "+v"(lnq)); const int lane = lnq; (void)par; (void)lane;
            ResidArgs R{}; R.mode = 3; R.y = (const float*)(ws + P_Y); R.g_post = par + PR_GMIXPOST + l * 1024; R.gate_chunk = 2; R.g_pre = par + PR_GFFNPRE + l * 1024; R.shift_chunk = 3;
            R.hout = (bf16*)(ws + P_H); R.l_mod = l; R.l_gate = l; R.route = lastl; R.h8 = lastl ? (F8_M1 != 0) : (F8_D1 != 0); R.ysc = 1.0f;
            { int row = gw; for (; row + ngw < nMq * 256; row += 2 * ngw) { resid_row(ws, outp, nullptr, nullptr, Rd(R, rep_), row, lane, tb); resid_row(ws, outp, nullptr, nullptr, Rd(R, rep_), row + ngw, lane, tb); } if (row < nMq * 256) resid_row(ws, outp, nullptr, nullptr, Rd(R, rep_), row, lane, tb); }
            SEAM(pb + 7);
        }
        if (!lastl) {
            if (PHON(10) && IN(pb + 8)) for (int rep_ = 0; rep_ <= (int)REPON(10); ++rep_) {
            GAS unsigned char* wsq = (GAS unsigned char*)ws0; asm volatile("" : "+s"(wsq)); unsigned char* const ws = (unsigned char*)wsq; const float* const par = (const float*)(ws + WS_PAR); int lnq = lane_id(); asm volatile("" : "+v"(lnq)); const int lane = lnq; (void)par; (void)lane;
                constexpr unsigned kb1 = F8_D1 ? 1024u : 2048u;
                pg8::SchedPlain S{(const char*)(ws + P_H), (const char*)(ws + WS_WF1T), kb1, kb1, F8_D1 ? 8 : 16, nMall, 22, G, bx};
                pg8::EpiPairS<F8_D2 != 0> E{ws + P_ACT, DFF, 0, F8_D1 ? 1.0f / (F8_HSCALE * F8_WSCALE) : 1.0f, F8_D2 ? F8_ASCALE : 1.0f};
                pg8::gemm_phase<pg8::EpiPairS<F8_D2 != 0>, pg8::SchedPlain, false, F8_D1 != 0>(lds, S, E, wave);
                SEAM(pb + 8);
            }
            if (PHON(11) && IN(pb + 9)) for (int rep_ = 0; rep_ <= (int)REPON(11); ++rep_) {
            GAS unsigned char* wsq = (GAS unsigned char*)ws0; asm volatile("" : "+s"(wsq)); unsigned char* const ws = (unsigned char*)wsq; const float* const par = (const float*)(ws + WS_PAR); int lnq = lane_id(); asm volatile("" : "+v"(lnq)); const int lane = lnq; (void)par; (void)lane;
                constexpr unsigned kb2 = F8_D2 ? 2816u : 5632u;
                pg8::SchedPlain S{(const char*)(ws + P_ACT), (const char*)(ws + WS_WF2T), kb2, kb2, F8_D2 ? 22 : 44, nMall, 4, G, bx};
                pg8::EpiBf16 E{(bf16*)(ws + P_Y2), 1024, 0};
                pg8::gemm_phase<pg8::EpiBf16, pg8::SchedPlain, false, F8_D2 != 0>(lds, S, E, wave);
                MOE_TAIL(620, 1000);
                SEAM(pb + 9);
            }
            if (PHON(14) && IN(pb + 12)) for (int rep_ = 0; rep_ <= (int)REPON(14); ++rep_) {
            GAS unsigned char* wsq = (GAS unsigned char*)ws0; asm volatile("" : "+s"(wsq)); unsigned char* const ws = (unsigned char*)wsq; const float* const par = (const float*)(ws + WS_PAR); int lnq = lane_id(); asm volatile("" : "+v"(lnq)); const int lane = lnq; (void)par; (void)lane;
                ResidArgs R{}; R.mode = 3; R.y = (const float*)(ws + P_Y2); R.g_post = par + PR_GFFNPOST; R.gate_chunk = 5; R.g_pre = par + PR_GMIXPRE + 1024; R.shift_chunk = 0;
                R.hout = (bf16*)(ws + P_H); R.l_mod = 1; R.l_gate = 0; R.route = false; R.hout8 = ws + P_H8; R.ysc = F8_D2 ? 1.0f / (F8_ASCALE * F8_WSCALE) : 1.0f;
                { int row = gw; for (; row + ngw < MALL; row += 2 * ngw) { resid_row(ws, outp, nullptr, nullptr, Rd(R, rep_), row, lane, tb); resid_row(ws, outp, nullptr, nullptr, Rd(R, rep_), row + ngw, lane, tb); } if (row < MALL) resid_row(ws, outp, nullptr, nullptr, Rd(R, rep_), row, lane, tb); }
                SEAM(pb + 12);
            }
        } else {
            for (int ch = 0; ch < 1; ++ch) {
                if (IN(pb + 8 + 2 * ch) || IN(pb + 9 + 2 * ch)) {
                    __syncthreads();
                    if (tid == 0) { const unsigned* cnt = (const unsigned*)(ws + WS_CTL) + CW_CNT; int acc = 0;
                        for (int e = 0; e < 8; ++e) { const int c = (int)__hip_atomic_load(cnt + e, __ATOMIC_RELAXED, __HIP_MEMORY_SCOPE_AGENT); tb[e] = c; tb[8 + e] = acc; acc += (c + 255) >> 8; }
                        tb[16] = acc; }
                    __syncthreads();
                }
                const int ntot = __builtin_amdgcn_readfirstlane(tb[16]), t0 = 0, t1 = ntot;
                if (PHON(12) && IN(pb + 8 + 2 * ch)) for (int rep_ = 0; rep_ <= (int)REPON(12); ++rep_) {
            GAS unsigned char* wsq = (GAS unsigned char*)ws0; asm volatile("" : "+s"(wsq)); unsigned char* const ws = (unsigned char*)wsq; const float* const par = (const float*)(ws + WS_PAR); int lnq = lane_id(); asm volatile("" : "+v"(lnq)); const int lane = lnq; (void)par; (void)lane;
                    constexpr unsigned kbm = F8_M1 ? 1024u : 2048u;
                    pg8::SchedMoe1 S{(const char*)(ws + P_H), (const char*)(ws + WS_WM1T), kbm, kbm, F8_M1 ? 8 : 16, (const int*)(ws + WS_LIST), tb, t1, G, bx, nullptr};
                    if (S.units() <= 16) { LAS unsigned* rtab = (LAS unsigned*)(lds + 131072); S.fill(rtab, wave * 64 + lane); S.rt = rtab; }
                    __syncthreads();
                    pg8::EpiPairS<true> E{ws + P_ACT, DFF, 0, F8_M1 ? 1.0f / (F8_HSCALE * F8_WSCALE) : 1.0f, F8_ASCALE};
                    pg8::gemm_phase<pg8::EpiPairS<true>, pg8::SchedMoe1, true, F8_M1 != 0>(lds, S, E, wave);
                    SEAM(pb + 8 + 2 * ch);
                }
                if (PHON(13) && IN(pb + 9 + 2 * ch)) for (int rep_ = 0; rep_ <= (int)REPON(13); ++rep_) {
            GAS unsigned char* wsq = (GAS unsigned char*)ws0; asm volatile("" : "+s"(wsq)); unsigned char* const ws = (unsigned char*)wsq; const float* const par = (const float*)(ws + WS_PAR); int lnq = lane_id(); asm volatile("" : "+v"(lnq)); const int lane = lnq; (void)par; (void)lane;
                    pg8::SchedMoe2 S{(const char*)(ws + P_ACT), (const char*)(ws + WS_WM2T), 2816u, 2816u, 22, tb, t1, G, bx};
                    pg8::EpiBf16 E{(bf16*)(ws + P_Y2), 1024, 0};
                    pg8::gemm_phase<pg8::EpiBf16, pg8::SchedMoe2, false, true>(lds, S, E, wave);
                    SEAM(pb + 9 + 2 * ch);
                }
            }
            if (PHON(14) && IN(pb + 12)) for (int rep_ = 0; rep_ <= (int)REPON(14); ++rep_) {
            GAS unsigned char* wsq = (GAS unsigned char*)ws0; asm volatile("" : "+s"(wsq)); unsigned char* const ws = (unsigned char*)wsq; const float* const par = (const float*)(ws + WS_PAR); int lnq = lane_id(); asm volatile("" : "+v"(lnq)); const int lane = lnq; (void)par; (void)lane;
                __syncthreads();
                if (tid == 0) { const unsigned* cnt = (const unsigned*)(ws + WS_CTL) + CW_CNT; int acc = 0;
                    for (int e = 0; e < 8; ++e) { const int c = (int)__hip_atomic_load(cnt + e, __ATOMIC_RELAXED, __HIP_MEMORY_SCOPE_AGENT); tb[e] = c; tb[8 + e] = acc; acc += (c + 255) >> 8; }
                    tb[16] = acc; }
                __syncthreads();
                ResidArgs R{}; R.mode = 2; R.g_post = par + PR_GFFNPOST + 1024; R.gate_chunk = 5; R.hout = nullptr; R.l_gate = 1; R.route = false; R.ysc = 1.0f / (F8_ASCALE * F8_WSCALE);
                { int row = gw; for (; row + ngw < NLAT; row += 2 * ngw) { resid_row(ws, outp, nullptr, nullptr, Rd(R, rep_), row, lane, tb); resid_row(ws, outp, nullptr, nullptr, Rd(R, rep_), row + ngw, lane, tb); } if (row < NLAT) resid_row(ws, outp, nullptr, nullptr, Rd(R, rep_), row, lane, tb); }
            }
        }
    }
#undef IN
#undef SEAM
#undef tid
}

extern "C" void kernel_launch(void* const* d_in, const int* in_sizes, int n_in, void* d_out, int out_size, void* d_ws, size_t ws_size, hipStream_t stream) {
    static int grid = 0;
    if (grid == 0) {
        if (n_in != 38 || out_size != NLAT * D || ws_size < WS_END) { fprintf(stderr, "kernel_launch: unexpected problem (n_in %d out %d ws %zu, need %zu)\n", n_in, out_size, ws_size, (size_t)WS_END); grid = -1; return; }
        int dev = 0, cus = 0, per_cu = 0;
        if (hipGetDevice(&dev) != hipSuccess || hipDeviceGetAttribute(&cus, hipDeviceAttributeMultiprocessorCount, dev) != hipSuccess) { grid = -1; return; }
        if (hipFuncSetAttribute((const void*)mk_fwd, hipFuncAttributeMaxDynamicSharedMemorySize, LDS_BYTES) != hipSuccess) { fprintf(stderr, "kernel_launch: hipFuncSetAttribute failed\n"); grid = -1; return; }
        if (hipOccupancyMaxActiveBlocksPerMultiprocessor(&per_cu, (const void*)mk_fwd, NTHREADS, LDS_BYTES) != hipSuccess || per_cu < 1) { fprintf(stderr, "kernel_launch: occupancy query says %d\n", per_cu); }
        (void)hipGetLastError();
        grid = cus;
    }
    if (grid < 0) return;
    (void)hipMemsetAsync((char*)d_ws + WS_CTL, 0, CTL_BYTES, stream);
    Args a{};
    for (int i = 0; i < 38; ++i) a.in[i] = (const float*)d_in[i];
    a.out = (float*)d_out; a.ws = (unsigned char*)d_ws;
#if MK_MULTI
    for (int ph = 0; ph < NPH; ++ph) {
        const int rel = ph < PH_L0 ? -1 : (ph - PH_L0) % PH_PER_L, l = ph < PH_L0 ? 0 : (ph - PH_L0) / PH_PER_L;
        if (rel > 12 || (l == 0 && (rel == 10 || rel == 11))) continue;
        a.ph_lo = ph; a.ph_hi = ph + 1;
        hipLaunchKernelGGL(mk_fwd, dim3(grid), dim3(NTHREADS), LDS_BYTES, stream, a);
#if MK_DEBUG
        hipLaunchKernelGGL(dbg_fwd, dim3(grid), dim3(NTHREADS), 0, stream, a, ph);
#endif
    }
#if MK_DEBUG
    hipLaunchKernelGGL(dbg_fwd, dim3(grid), dim3(NTHREADS), 0, stream, a, 1000);
#endif
#else
    a.ph_lo = 0; a.ph_hi = NPH;
    hipLaunchKernelGGL(mk_fwd, dim3(grid), dim3(NTHREADS), LDS_BYTES, stream, a);
#endif
}
```

```cpp
#include <hip/hip_runtime.h>
#include <cstdio>
#include <cstdint>

#ifndef MK_DEBUG
#define MK_DEBUG 0
#endif
#ifndef MK_MULTI
#define MK_MULTI 0
#endif

#define GAS __attribute__((address_space(1)))
#define LAS __attribute__((address_space(3)))
typedef unsigned short bf16;
typedef short bf16x8 __attribute__((ext_vector_type(8)));
typedef short s16x4 __attribute__((ext_vector_type(4)));
typedef float f32x2 __attribute__((ext_vector_type(2)));
typedef float f32x4 __attribute__((ext_vector_type(4)));
typedef float f32x16 __attribute__((ext_vector_type(16)));
typedef unsigned u32x2 __attribute__((ext_vector_type(2)));
typedef unsigned u32x4 __attribute__((ext_vector_type(4)));

constexpr int D = 1024, NB = 4, SEQ = 4096, CTXL = 256, GRIDW = 64;
constexpr int NLAT = NB * SEQ, NCTX = NB * CTXL, MALL = NLAT + NCTX;
constexpr int LPOS = CTXL + SEQ;
constexpr int NIN = 1952, ZW = 2048;
constexpr int DFF = 2816, NEXP = 8;
constexpr float EPS = 1e-6f;
constexpr float LOG2E = 1.4426950408889634f;
#ifndef F8_G1L1
#define F8_G1L1 1
#endif
constexpr float F8_WSCALE = 256.f, F8_HSCALE = 16.f, F8_ASCALE = 8.f;
#ifndef F8_D1
#define F8_D1 0
#endif
#ifndef F8_D2
#define F8_D2 0
#endif
#ifndef F8_M1
#define F8_M1 1
#endif
constexpr int ZC_QG = 0, ZC_KG = 512, ZC_VG = 640, ZC_CQ = 768, ZC_CKV = 1152, ZC_KR = 1408, ZC_U = 1536;

constexpr size_t MiB = 1u << 20;
constexpr size_t WS_CTL = 0, CTL_BYTES = 1 * MiB;
constexpr size_t WS_MOD = 1 * MiB;
constexpr size_t WS_ROPE = 2 * MiB;
constexpr size_t WS_PAR = 3 * MiB + 512 * 1024;
constexpr int PR_GMIXPRE = 0, PR_GMIXPOST = 2048, PR_GFFNPRE = 4096, PR_GFFNPOST = 6144, PR_GQ = 8192, PR_GK = 8320, PR_GCQ = 8448, PR_GCKV = 9216, PR_BMG = 9728, PR_RW = 15872, PR_RB = 24064,
              PR_A16 = 24080, PR_END = PR_A16 + 2 * 2 * 32 * 64 * 2;
constexpr size_t WS_LIST = 4 * MiB;
constexpr size_t WS_LATC = 5 * MiB;
constexpr size_t WS_W1T = 9 * MiB;
constexpr size_t WS_WMGT = 17 * MiB;
constexpr size_t WS_WUQT = 29 * MiB;
constexpr size_t WS_WUKVT = 31 * MiB;
constexpr size_t WS_S5M = 32 * MiB;
constexpr size_t WS_WGLUT = 56 * MiB;
constexpr size_t WS_WBT = 58 * MiB;
constexpr size_t WS_WOUTT = 64 * MiB;
constexpr size_t WS_WF1T = 68 * MiB;
constexpr size_t WS_WF2T = 79 * MiB;
constexpr size_t WS_WM1T = 85 * MiB;
constexpr size_t WS_WM2T = 173 * MiB;
constexpr size_t WS_POOL = 217 * MiB;
constexpr size_t P_H = WS_POOL + 0 * MiB;
constexpr size_t P_Z = WS_POOL + 34 * MiB;
constexpr size_t P_QB = WS_POOL + 34 * MiB;
constexpr size_t P_KB = WS_POOL + 60 * MiB;
constexpr size_t P_VB = WS_POOL + 77 * MiB;
constexpr size_t P_QA = WS_POOL + 102 * MiB;
constexpr size_t P_KA = WS_POOL + 119 * MiB;
constexpr size_t P_VA = WS_POOL + 124 * MiB;
constexpr size_t P_KRR = WS_POOL + 129 * MiB;
constexpr size_t P_UG = WS_POOL + 131 * MiB;
constexpr size_t P_CQN = WS_POOL + 148 * MiB;
constexpr size_t P_CKVN = WS_POOL + 161 * MiB;
constexpr size_t P_AGLU = WS_POOL + 170 * MiB;
constexpr size_t P_YBR = WS_POOL + 187 * MiB;
constexpr size_t P_MRG = WS_POOL + 34 * MiB;
constexpr size_t P_GSCR = WS_POOL + 68 * MiB;
constexpr size_t P_Y = WS_POOL + 102 * MiB;
constexpr size_t P_ACT = WS_POOL + 34 * MiB;
constexpr size_t P_Y2 = WS_POOL + 136 * MiB;
constexpr size_t P_H8 = WS_POOL + 240 * MiB;
constexpr size_t WS_END = WS_POOL + 257 * MiB;
static_assert(P_YBR + (size_t)MALL * 1536 * 2 <= WS_END && P_Y2 + (size_t)MALL * 1024 * 4 <= WS_END && P_ACT + (size_t)MALL * DFF * 2 <= P_Y2, "pool map");
static_assert(P_GSCR + 256 * 3 * 131072 <= P_AGLU && P_VB + (size_t)MALL * 512 * 2 <= P_QA && P_Y + (size_t)MALL * 4096 <= P_AGLU, "pool map 2");

constexpr int CW_BAR = 4096;
constexpr int CW_Q = 8320;
constexpr int CW_CNT = 12288, CNT_STRIDE = 64;
constexpr int CW_MFLAG = 9216;
constexpr int CW_DBG = 16384;

constexpr int LDS_MISC = 147456;
constexpr int LDS_BYTES = 151552;
constexpr int NWAVES = 8, NTHREADS = 512;

__device__ __forceinline__ int lane_id() { unsigned m_ = ~0u; asm volatile("" : "+s"(m_)); return (int)__builtin_amdgcn_mbcnt_hi(m_, __builtin_amdgcn_mbcnt_lo(m_, 0u)); }
__device__ __forceinline__ float bf2f(unsigned v) { return __uint_as_float(v << 16); }
__device__ __forceinline__ unsigned f2bf(float f) { unsigned u = __float_as_uint(f); return (u + 0x7fffu + ((u >> 16) & 1u)) >> 16; }
typedef __bf16 bf16x2_t __attribute__((ext_vector_type(2)));
__device__ __forceinline__ unsigned pk2(float lo, float hi) { const f32x2 v = {lo, hi}; return __builtin_bit_cast(unsigned, __builtin_convertvector(v, bf16x2_t)); }
__device__ __forceinline__ float shfl_xor_l(float v, int mask, int lane) { return __int_as_float(__builtin_amdgcn_ds_bpermute((lane ^ mask) << 2, __float_as_int(v))); }
__device__ __forceinline__ float wave_sum(float v) {
    const int lane = lane_id();
#pragma unroll
    for (int o = 1; o < 64; o <<= 1) v += shfl_xor_l(v, o, lane);
    return v;
}
__device__ __forceinline__ float fsigmoid(float x) { return __builtin_amdgcn_rcpf(1.0f + __builtin_amdgcn_exp2f(-x * LOG2E)); }
__device__ __forceinline__ float fsilu(float x) { return x * fsigmoid(x); }
__device__ __forceinline__ float fgelu_tanh(float x) { const float u = 0.7978845608028654f * (x + 0.044715f * x * x * x); return x * fsigmoid(2.0f * u); }
__device__ __forceinline__ void unpack8(const u32x4 v, float (&f)[8]) {
    f[0] = bf2f(v.x & 0xffffu); f[1] = bf2f(v.x >> 16); f[2] = bf2f(v.y & 0xffffu); f[3] = bf2f(v.y >> 16);
    f[4] = bf2f(v.z & 0xffffu); f[5] = bf2f(v.z >> 16); f[6] = bf2f(v.w & 0xffffu); f[7] = bf2f(v.w >> 16);
}
__device__ __forceinline__ u32x4 pack8(const float (&f)[8]) { u32x4 w; w.x = pk2(f[0], f[1]); w.y = pk2(f[2], f[3]); w.z = pk2(f[4], f[5]); w.w = pk2(f[6], f[7]); return w; }
__device__ __forceinline__ int pos_row(int b, int p) { return p < CTXL ? NLAT + b * CTXL + p : b * SEQ + (p - CTXL); }

#define XB_TMO      128
#define XB_XCNT(j)  (256  + 64 * (j))
#define XB_XSUB(j)  (1280 + 64 * (j))
#define XB_XGEN(j)  (2304 + 64 * (j))
#define XB_TOP      3328
#define XB_TOPGEN   3392
#define XCD_BAR_WORDS 3456
#define XB_SPIN_CAP (1u << 18)
__device__ __forceinline__ unsigned xb_ld(unsigned* p)              { return __hip_atomic_load(p, __ATOMIC_RELAXED, __HIP_MEMORY_SCOPE_AGENT); }
__device__ __forceinline__ unsigned xb_add(unsigned* p, unsigned v) { return __hip_atomic_fetch_add(p, v, __ATOMIC_RELAXED, __HIP_MEMORY_SCOPE_AGENT); }
__device__ __forceinline__ unsigned xb_xcc_id() { return (unsigned)__builtin_amdgcn_s_getreg((3 << 11) | 20) & 0xFu; }
#define XB_SPIN(cond, bar) do { unsigned _sp = 0; while (cond) { __builtin_amdgcn_s_sleep(1); \
    if ((++_sp & 255u) == 0u) { if (xb_ld(&(bar)[XB_TMO])) break; if (_sp > XB_SPIN_CAP) { atomicAdd(&(bar)[XB_TMO], 1u); break; } } } } while (0)
struct XcdBarrier { unsigned* bar; unsigned x; volatile LAS unsigned* st; int wave; };
__device__ __forceinline__ XcdBarrier xcd_barrier_post(unsigned* bar, volatile LAS unsigned* st, int wave) {
    XcdBarrier b; b.bar = bar; b.x = xb_xcc_id(); b.st = st; b.wave = wave;
    if (wave == 0 && lane_id() == 0) (void)xb_add(&bar[XB_XCNT(b.x)], 1u);
    return b;
}
__device__ __forceinline__ void xcd_barrier_complete(unsigned* bar, unsigned x, unsigned& nloc, unsigned& nx) {
    const unsigned G = gridDim.x * gridDim.y * gridDim.z;
    unsigned sum, cnt, mine, sp = 0u;
    for (;;) {
        sum = 0u; cnt = 0u; mine = 0u;
#pragma unroll
        for (unsigned j = 0; j < 16; ++j) { const unsigned c = xb_ld(&bar[XB_XCNT(j)]); sum += c; cnt += (c > 0u) ? 1u : 0u; mine = (j == x) ? c : mine; }
        if (sum == G) break;
        __builtin_amdgcn_s_sleep(1);
        if ((++sp & 255u) == 0u) { if (xb_ld(&bar[XB_TMO])) break; if (sp > XB_SPIN_CAP) { atomicAdd(&bar[XB_TMO], 1u); break; } }
    }
    nloc = mine > 0u ? mine : 1u; nx = cnt > 0u ? cnt : 1u;
}
__device__ __forceinline__ void xcd_barrier(const XcdBarrier& b) {
    asm volatile("s_waitcnt vmcnt(0)" ::: "memory");
    __syncthreads();
    if (b.wave == 0 && lane_id() == 0) {
        unsigned* bar = b.bar;
        __builtin_amdgcn_s_waitcnt(0);
        unsigned nloc = b.st[0], nx = b.st[1];
        if (nloc == 0u) { xcd_barrier_complete(bar, b.x, nloc, nx); b.st[0] = nloc; b.st[1] = nx; }
        const unsigned old = xb_add(&bar[XB_XSUB(b.x)], 1u);
        const unsigned gen = old / nloc;
        if (old + 1u == (gen + 1u) * nloc) {
            __builtin_amdgcn_fence(__ATOMIC_RELEASE, "agent");
            asm volatile("s_waitcnt vmcnt(0)" ::: "memory");
            const unsigned og = xb_add(&bar[XB_TOP], 1u);
            const unsigned tg = og / nx;
            if (og + 1u == (tg + 1u) * nx) xb_add(&bar[XB_TOPGEN], 1u);
            else XB_SPIN(xb_ld(&bar[XB_TOPGEN]) == tg, bar);
            __builtin_amdgcn_fence(__ATOMIC_ACQUIRE, "agent");
            xb_add(&bar[XB_XGEN(b.x)], 1u);
            asm volatile("s_waitcnt vmcnt(0)" ::: "memory");
        } else {
            XB_SPIN(xb_ld(&bar[XB_XGEN(b.x)]) == gen, bar);
            __builtin_amdgcn_fence(__ATOMIC_ACQUIRE, "agent");
            asm volatile("s_waitcnt vmcnt(0)" ::: "memory");
        }
    }
    __syncthreads();
}

namespace pg8 {
typedef int v4i __attribute__((ext_vector_type(4)));
typedef int v8i __attribute__((ext_vector_type(8)));
constexpr int BM = 256, BK = 64, HALF = 128, HTB = HALF * BK * 2, STAGE_BYTES = 8 * HTB;
__host__ __device__ __forceinline__ int lds_byte(int r, int c) { const int st = (r >> 4) * 2 + (c >> 5), rr = r & 15, cc = c & 31, ob = rr * 64 + cc * 2; return st * 1024 + (ob ^ (((ob >> 9) & 1) << 5)); }
__host__ __device__ __forceinline__ void stage_rc(int b, int& R, int& C) { const int st = b / 1024, sb = b % 1024, swz = sb ^ (((sb >> 9) & 1) << 5); R = (st >> 1) * 16 + swz / 64; C = (st & 1) * 32 + (swz % 64) / 2; }
__host__ __device__ __forceinline__ int perm32(int rho) { const int n = rho >> 4, i = rho & 15; return 8 * (i >> 2) + 4 * n + (i & 3); }

struct GUnit { const char* a; const char* b; unsigned lda, ldb; int nt; int pm, pn, z; };

__device__ __forceinline__ void tile_of(int L, int nM, int nN, int& pm, int& pn) {
    const int nwg = nM * nN; int wgid = L;
    { const int q = nwg / 8, r = nwg % 8, xcd = wgid % 8, off = wgid / 8; wgid = (xcd < r ? xcd * (q + 1) : r * (q + 1) + (xcd - r) * q) + off; }
    const int nig = 8 * nN, gid = wgid / nig, fm = gid * 8, gsz = (nM - fm) < 8 ? (nM - fm) : 8;
    pm = fm + ((wgid % nig) % gsz); pn = (wgid % nig) / gsz;
}

template <class Epi, class Sched, bool GATHER, bool F8 = false>
__device__ __forceinline__ void gemm_phase(LAS unsigned char* lds, const Sched& S, const Epi& E, int wave_) {
    int tid = wave_ * 64 + lane_id(); asm volatile("" : "+v"(tid));
    const int wid = __builtin_amdgcn_readfirstlane(tid >> 6), lane = tid & 63, wr = wid >> 2, wc = wid & 3, fr = lane & 15, fq = lane >> 4;
    int Rr[2], Cc[2], Rb[2];
#pragma unroll
    for (int i = 0; i < 2; ++i) { stage_rc(tid * 16 + i * 8192, Rr[i], Cc[i]); Rb[i] = Epi::PERM ? ((Rr[i] & ~31) + perm32(Rr[i] & 31)) : Rr[i]; }
    const size_t kstep = (size_t)(BK * 2);
    const unsigned ldsw = (unsigned)wid * 1024u;
    const int aoff = lds_byte(wr * 64 + fr, fq * 8), boff = lds_byte(wc * 32 + fr, fq * 8);
#define PG8_SA(b, h) (((b) * 2 + (h)) * HTB)
#define PG8_SB(b, h) ((4 + (b) * 2 + (h)) * HTB)
#define PG8_STAGE(bufoff, gbase, v0, v1) do { \
        __builtin_amdgcn_global_load_lds((const unsigned*)((const char*)(gbase) + (v0)), (LAS unsigned*)(lds + (bufoff) + ldsw), 16, 0, 0); \
        __builtin_amdgcn_global_load_lds((const unsigned*)((const char*)(gbase) + (v1)), (LAS unsigned*)(lds + (bufoff) + ldsw + 8192), 16, 0, 0); } while (0)
#define PG8_LD16(p) __builtin_bit_cast(v4i, *(const LAS bf16x8*)(p))
#define PG8_LDA(dst, b, h) do { _Pragma("unroll") for (int m = 0; m < 4; ++m) dst[m] = __builtin_shufflevector(PG8_LD16(lds + PG8_SA(b, h) + aoff + m * 2048), PG8_LD16(lds + PG8_SA(b, h) + aoff + m * 2048 + 1024), 0, 1, 2, 3, 4, 5, 6, 7); } while (0)
#define PG8_LDB(dst, b, h) do { _Pragma("unroll") for (int n = 0; n < 2; ++n) dst[n] = __builtin_shufflevector(PG8_LD16(lds + PG8_SB(b, h) + boff + n * 2048), PG8_LD16(lds + PG8_SB(b, h) + boff + n * 2048 + 1024), 0, 1, 2, 3, 4, 5, 6, 7); } while (0)
#define PG8_LO(x) __builtin_bit_cast(bf16x8, __builtin_shufflevector(x, x, 0, 1, 2, 3))
#define PG8_HI(x) __builtin_bit_cast(bf16x8, __builtin_shufflevector(x, x, 4, 5, 6, 7))
#define PG8_MMA(ai, bj, At, Bt) do { __builtin_amdgcn_s_setprio(1); \
        _Pragma("unroll") for (int m = 0; m < 4; ++m) _Pragma("unroll") for (int n = 0; n < 2; ++n) { \
            if constexpr (F8) acc[ai][bj][m][n] = __builtin_amdgcn_mfma_scale_f32_16x16x128_f8f6f4(Bt[n], At[m], acc[ai][bj][m][n], 0, 0, 0, 0, 0, 0); \
            else { acc[ai][bj][m][n] = __builtin_amdgcn_mfma_f32_16x16x32_bf16(PG8_LO(Bt[n]), PG8_LO(At[m]), acc[ai][bj][m][n], 0, 0, 0); \
                   acc[ai][bj][m][n] = __builtin_amdgcn_mfma_f32_16x16x32_bf16(PG8_HI(Bt[n]), PG8_HI(At[m]), acc[ai][bj][m][n], 0, 0, 0); } } \
        __builtin_amdgcn_s_setprio(0); } while (0)
#define PG8_WAIT_V(n) asm volatile("s_waitcnt vmcnt(" #n ")" ::: "memory")
#define PG8_WAIT_L(n) asm volatile("s_waitcnt lgkmcnt(" #n ")" ::: "memory")
#define PG8_BAR __builtin_amdgcn_s_barrier()
#define PG8_SCHED __builtin_amdgcn_sched_barrier(0)
#define PG8_OFFS(u) do { \
        _Pragma("unroll") for (int i_ = 0; i_ < 2; ++i_) { \
            if constexpr (GATHER) { oA0[i_] = S.arow(u, Rr[i_]) + (unsigned)Cc[i_] * 2u; oA1[i_] = S.arow(u, HALF + Rr[i_]) + (unsigned)Cc[i_] * 2u; } \
            else { oA0[i_] = (unsigned)Rr[i_] * (u).lda + (unsigned)Cc[i_] * 2u; } \
            oB[i_] = (unsigned)Rb[i_] * (u).ldb + (unsigned)Cc[i_] * 2u; } \
        hA = GATHER ? (size_t)0 : (size_t)HALF * (u).lda; hB = (size_t)HALF * (u).ldb; } while (0)
#define PG8_A1(i) (GATHER ? oA1[i] : oA0[i])
    GUnit cur, nxt; int ui = 0;
    if (!S.next(0, cur)) return;
    f32x4 acc[2][2][4][2];
#pragma unroll
    for (int a = 0; a < 2; ++a)
#pragma unroll
        for (int b = 0; b < 2; ++b)
#pragma unroll
            for (int m = 0; m < 4; ++m)
#pragma unroll
                for (int n = 0; n < 2; ++n) acc[a][b][m][n] = (f32x4){0.f, 0.f, 0.f, 0.f};
    v8i At[4], B0[2], B1[2];
    unsigned oA0[2], oA1[2], oB[2]; size_t hA, hB;
    oA1[0] = 0u; oA1[1] = 0u;
    PG8_OFFS(cur);
    const char* cA = cur.a; const char* cBp = cur.b;
    PG8_STAGE(PG8_SB(0, 0), cBp, oB[0], oB[1]); PG8_STAGE(PG8_SB(0, 1), cBp + hB, oB[0], oB[1]); PG8_STAGE(PG8_SA(0, 0), cA, oA0[0], oA0[1]); PG8_STAGE(PG8_SA(0, 1), cA + hA, PG8_A1(0), PG8_A1(1));
    if (wr == 1) PG8_BAR;
    PG8_WAIT_V(2); PG8_BAR;
    PG8_STAGE(PG8_SB(1, 0), cBp + kstep, oB[0], oB[1]); PG8_STAGE(PG8_SA(1, 0), cA + kstep, oA0[0], oA0[1]); PG8_STAGE(PG8_SB(1, 1), cBp + hB + kstep, oB[0], oB[1]);
    PG8_WAIT_V(6); PG8_BAR;
    for (;;) {
        const bool has_next = S.next(ui + 1, nxt);
        const char* nA = has_next ? nxt.a : cA; const char* nBp = has_next ? nxt.b : cBp;
        int nt = cur.nt; asm volatile("" : "+s"(nt));
        for (int t = 0; t < nt; t += 2) {
            const bool last = (t == nt - 2);
            const char* a1 = cA + (size_t)(t + 1) * kstep;
            const char* a2 = last ? nA : cA + (size_t)(t + 2) * kstep; const char* b2 = last ? nBp : cBp + (size_t)(t + 2) * kstep;
            const char* a3 = a2 + kstep; const char* b3 = b2 + kstep;
            PG8_LDB(B0, 0, 0); PG8_LDB(B1, 0, 1); PG8_SCHED; PG8_LDA(At, 0, 0); PG8_STAGE(PG8_SA(1, 1), a1 + hA, PG8_A1(0), PG8_A1(1));
            if (last && has_next) PG8_OFFS(nxt);
            PG8_WAIT_V(8); PG8_WAIT_L(0); PG8_BAR; PG8_MMA(0, 0, At, B0); PG8_MMA(0, 1, At, B1); PG8_BAR; PG8_SCHED;
            PG8_LDA(At, 0, 1); PG8_STAGE(PG8_SB(0, 0), b2, oB[0], oB[1]); PG8_STAGE(PG8_SB(0, 1), b2 + hB, oB[0], oB[1]); PG8_STAGE(PG8_SA(0, 0), a2, oA0[0], oA0[1]);
            PG8_WAIT_V(8); PG8_WAIT_L(0); PG8_BAR; PG8_MMA(1, 0, At, B0); PG8_MMA(1, 1, At, B1); PG8_BAR; PG8_SCHED;
            PG8_LDB(B0, 1, 0); PG8_LDB(B1, 1, 1); PG8_SCHED; PG8_LDA(At, 1, 0); PG8_STAGE(PG8_SA(0, 1), a2 + hA, PG8_A1(0), PG8_A1(1));
            PG8_WAIT_V(8); PG8_WAIT_L(0); PG8_BAR; PG8_MMA(0, 0, At, B0); PG8_MMA(0, 1, At, B1); PG8_BAR; PG8_SCHED;
            PG8_LDA(At, 1, 1); PG8_STAGE(PG8_SB(1, 0), b3, oB[0], oB[1]); PG8_STAGE(PG8_SB(1, 1), b3 + hB, oB[0], oB[1]); PG8_STAGE(PG8_SA(1, 0), a3, oA0[0], oA0[1]);
            PG8_WAIT_V(8); PG8_WAIT_L(0); PG8_BAR; PG8_MMA(1, 0, At, B0); PG8_MMA(1, 1, At, B1); PG8_BAR; PG8_SCHED;
        }
        if (wr == 0) PG8_BAR;
        E(acc, cur, wr, wc, fr, fq);
        if (!has_next) break;
#pragma unroll
        for (int a = 0; a < 2; ++a)
#pragma unroll
            for (int b = 0; b < 2; ++b)
#pragma unroll
                for (int m = 0; m < 4; ++m)
#pragma unroll
                    for (int n = 0; n < 2; ++n) acc[a][b][m][n] = (f32x4){0.f, 0.f, 0.f, 0.f};
        cur = nxt; cA = nA; cBp = nBp; ++ui;
        if (wr == 1) PG8_BAR;
    }
    PG8_WAIT_V(0);
    PG8_BAR;
#undef PG8_SA
#undef PG8_SB
#undef PG8_STAGE
#undef PG8_LDA
#undef PG8_LDB
#undef PG8_LD16
#undef PG8_LO
#undef PG8_HI
#undef PG8_MMA
#undef PG8_WAIT_V
#undef PG8_WAIT_L
#undef PG8_BAR
#undef PG8_SCHED
#undef PG8_OFFS
#undef PG8_A1
}
}

namespace pg8 {
__device__ __forceinline__ unsigned pk_fp8x4(float a, float b, float c, float d) {
    a = __builtin_amdgcn_fmed3f(a, -448.f, 448.f); b = __builtin_amdgcn_fmed3f(b, -448.f, 448.f); c = __builtin_amdgcn_fmed3f(c, -448.f, 448.f); d = __builtin_amdgcn_fmed3f(d, -448.f, 448.f);
    unsigned w = 0; w = __builtin_amdgcn_cvt_pk_fp8_f32(a, b, w, false); w = __builtin_amdgcn_cvt_pk_fp8_f32(c, d, w, true); return w; }
struct SchedPlain {
    const char* A; const char* B; unsigned lda, ldb; int nt, nM, nN, G, c;
    __device__ __forceinline__ bool next(int i, GUnit& u) const {
        const int L = i * G + c; if (L >= nM * nN) return false;
        int pm, pn; tile_of(L, nM, nN, pm, pn);
        u.a = A + (size_t)pm * 256 * lda; u.b = B + (size_t)pn * 256 * ldb; u.lda = lda; u.ldb = ldb; u.nt = nt; u.pm = pm; u.pn = pn; u.z = 0; return true;
    }
};
struct SchedUp {
    const char* Aq; const char* Bq; const char* Akv; const char* Bkv; int nMq, nMall, G, c;
    __device__ __forceinline__ bool next(int i, GUnit& u) const {
        int L = i * G + c; const int nq = nMq * 3; int pm, pn;
        if (L < nq) { tile_of(L, nMq, 3, pm, pn); u.a = Aq + (size_t)pm * 256 * 768; u.b = Bq + (size_t)pn * 256 * 768; u.lda = 768u; u.ldb = 768u; u.nt = 6; u.pm = pm; u.pn = pn; u.z = 0; return true; }
        L -= nq; if (L >= nMall * 4) return false;
        tile_of(L, nMall, 4, pm, pn); u.a = Akv + (size_t)pm * 256 * 512; u.b = Bkv + (size_t)pn * 256 * 512; u.lda = 512u; u.ldb = 512u; u.nt = 4; u.pm = pm; u.pn = pn; u.z = 1; return true;
    }
};
struct SchedMergeG {
    const char* A; const char* B; unsigned lda, ldb; int nt, nM, L; int only = -1;
    __device__ __forceinline__ bool next(int i_, GUnit& u) const {
        if ((only >= 0 ? i_ >= 1 : i_ >= 3) || L >= nM * 4) return false;
        const int i = only >= 0 ? only : i_;
        int pm, pn; tile_of(L, nM, 4, pm, pn);
        u.a = A + (size_t)pm * 256 * lda; u.lda = lda; u.b = B + ((size_t)i * 1024 + pn * 256) * ldb; u.ldb = ldb; u.nt = nt; u.pm = pm; u.pn = pn; u.z = i; return true;
    }
};
struct SchedMergeP {
    const char* A; const char* B; unsigned lda, ldb; int nt, nM, L; int only = -1;
    __device__ __forceinline__ bool next(int i_, GUnit& u) const {
        if ((only >= 0 ? i_ >= 1 : i_ >= 3) || L >= nM * 4) return false;
        const int i = only >= 0 ? only : i_;
        int pm, pn; tile_of(L, nM, 4, pm, pn);
        u.a = A + (size_t)pm * 256 * lda + i * 1024; u.lda = lda; u.b = B + ((size_t)i * 1024 + pn * 256) * ldb; u.ldb = ldb; u.nt = nt; u.pm = pm; u.pn = pn; u.z = i; return true;
    }
};
struct SchedMoe1 {
    const char* H2; const char* W; unsigned lda, ldb; int nt; const int* list; const LAS int* tb; int nM, G, c;
    const LAS unsigned* rt;
    __device__ __forceinline__ bool next(int i, GUnit& u) const {
        const int L = i * G + c; if (L >= nM * 22) return false;
        const int mt = L / 22, pn = L % 22; int e = 0;
#pragma unroll
        for (int j = 1; j < 8; ++j) e += (mt >= tb[8 + j]) ? 1 : 0;
        e = __builtin_amdgcn_readfirstlane(e);
        u.a = H2; u.lda = lda; u.b = W + ((size_t)e * 5632 + pn * 256) * ldb; u.ldb = ldb; u.nt = nt; u.pm = mt; u.pn = pn; u.z = e | (i << 8); return true;
    }
    __device__ __forceinline__ unsigned arow(const GUnit& u, int r) const {
        if (rt) return rt[(u.z >> 8) * 256 + r];
        const int e = u.z & 255, li = (u.pm - tb[8 + e]) * 256 + r; const int tok = (li < tb[e]) ? list[e * 16384 + li] : 0;
        return (unsigned)tok * lda;
    }
    __device__ __forceinline__ int units() const { const int tot = nM * 22; return c < tot ? (tot - c + G - 1) / G : 0; }
    __device__ __forceinline__ void fill(LAS unsigned* w, int tid) const {
        const int n = units() * 256;
        for (int base = tid; base < n; base += 4 * NTHREADS) { int tokv[4];
#pragma unroll
            for (int k = 0; k < 4; ++k) { const int idx = base + NTHREADS * k; tokv[k] = 0;
                if (idx < n) { const int i = idx >> 8, r = idx & 255, mt = (i * G + c) / 22; int e = 0;
#pragma unroll
                    for (int j = 1; j < 8; ++j) e += (mt >= tb[8 + j]) ? 1 : 0;
                    const int li = (mt - tb[8 + e]) * 256 + r; if (li < tb[e]) tokv[k] = list[e * 16384 + li]; } }
#pragma unroll
            for (int k = 0; k < 4; ++k) { const int idx = base + NTHREADS * k; if (idx < n) w[idx] = (unsigned)tokv[k] * lda; } }
    }
};
struct SchedMoe2 {
    const char* A; const char* B; unsigned lda, ldb; int nt; const LAS int* tb; int nM, G, c;
    __device__ __forceinline__ bool next(int i, GUnit& u) const {
        const int L = i * G + c; if (L >= nM * 4) return false;
        int pm, pn; tile_of(L, nM, 4, pm, pn); int e = 0;
#pragma unroll
        for (int j = 1; j < 8; ++j) e += (pm >= tb[8 + j]) ? 1 : 0;
        e = __builtin_amdgcn_readfirstlane(e);
        u.a = A + (size_t)pm * 256 * lda; u.b = B + (size_t)(e * 4 + pn) * 256 * ldb; u.lda = lda; u.ldb = ldb; u.nt = nt; u.pm = pm; u.pn = pn; u.z = e; return true;
    }
};

#define EPI_ROWS_BEGIN _Pragma("unroll") for (int ai = 0; ai < 2; ++ai) _Pragma("unroll") for (int m = 0; m < 4; ++m) { const int row = u.pm * BM + ai * HALF + wr * 64 + m * 16 + fr;
#define EPI_ROWS_END }
__device__ __forceinline__ u32x4 pack_f4f4(const f32x4 a, const f32x4 b) { u32x4 w; w.x = pk2(a[0], a[1]); w.y = pk2(a[2], a[3]); w.z = pk2(b[0], b[1]); w.w = pk2(b[2], b[3]); return w; }

struct EpiBf16 {
    static constexpr bool PERM = true;
    bf16* O; int ldc; int rsub;
    __device__ __forceinline__ void operator()(const f32x4 (&acc)[2][2][4][2], const GUnit& u, int wr, int wc, int fr, int fq) const {
        const int col0 = u.pn * BM + wc * 32 + 8 * fq;
        EPI_ROWS_BEGIN
            bf16* rowp = O + (size_t)(row - rsub) * ldc + col0;
#pragma unroll
            for (int bj = 0; bj < 2; ++bj) *(u32x4*)(rowp + bj * HALF) = pack_f4f4(acc[ai][bj][m][0], acc[ai][bj][m][1]);
        EPI_ROWS_END
    }
};
struct EpiF32 {
    static constexpr bool PERM = false;
    float* C; int ldc;
    __device__ __forceinline__ void operator()(const f32x4 (&acc)[2][2][4][2], const GUnit& u, int wr, int wc, int fr, int fq) const {
        const int col0 = u.pn * BM + wc * 32 + 4 * fq;
        EPI_ROWS_BEGIN
            float* rowp = C + (size_t)row * ldc + col0;
#pragma unroll
            for (int bj = 0; bj < 2; ++bj)
#pragma unroll
                for (int n = 0; n < 2; ++n) *(f32x4*)(rowp + bj * HALF + n * 16) = acc[ai][bj][m][n];
        EPI_ROWS_END
    }
};
struct EpiUq {
    static constexpr bool PERM = true;
    bf16* Qb; const float* cosB; const float* sinB; float scale;
    __device__ __forceinline__ void operator()(const f32x4 (&acc)[2][2][4][2], const GUnit& u, int wr, int wc, int fr, int fq) const {
        const bool lat = u.pm < 64;
        EPI_ROWS_BEGIN
            const int t = row & (SEQ - 1);
#pragma unroll
            for (int bj = 0; bj < 2; ++bj) {
                const int gidx = u.pn * 8 + bj * 4 + wc, head = gidx / 3, part = gidx - head * 3;
                bf16* dst = Qb + (size_t)row * 768 + head * 96 + part * 32;
                f32x4 a = acc[ai][bj][m][0] * scale, b = acc[ai][bj][m][1] * scale;
                if (part == 2) {
                    if (lat) { const f32x4 c = *(const f32x4*)(cosB + t * 16 + 4 * fq), s = *(const f32x4*)(sinB + t * 16 + 4 * fq);
                        const f32x4 x1 = a * c - b * s, x2 = a * s + b * c; a = x1; b = x2; }
                    u32x2 w0, w1; w0.x = pk2(a[0], a[1]); w0.y = pk2(a[2], a[3]); w1.x = pk2(b[0], b[1]); w1.y = pk2(b[2], b[3]);
                    *(u32x2*)(dst + 4 * fq) = w0; *(u32x2*)(dst + 16 + 4 * fq) = w1;
                } else *(u32x4*)(dst + 8 * fq) = pack_f4f4(a, b);
            }
        EPI_ROWS_END
    }
};
struct EpiUkv {
    static constexpr bool PERM = true;
    bf16* Kb; bf16* Vb;
    __device__ __forceinline__ void operator()(const f32x4 (&acc)[2][2][4][2], const GUnit& u, int wr, int wc, int fr, int fq) const {
        bf16* base = (wc < 2) ? Kb : Vb;
        EPI_ROWS_BEGIN
#pragma unroll
            for (int bj = 0; bj < 2; ++bj) { const int head = u.pn * 2 + bj;
                *(u32x4*)(base + (size_t)row * 512 + head * 64 + (wc & 1) * 32 + 8 * fq) = pack_f4f4(acc[ai][bj][m][0], acc[ai][bj][m][1]); }
        EPI_ROWS_END
    }
};
struct EpiUp {
    static constexpr bool PERM = true;
    EpiUq q; EpiUkv kv;
    __device__ __forceinline__ void operator()(const f32x4 (&acc)[2][2][4][2], const GUnit& u, int wr, int wc, int fr, int fq) const { if (u.z == 0) q(acc, u, wr, wc, fr, fq); else kv(acc, u, wr, wc, fr, fq); }
};
template <int MODE> struct EpiPair {
    static constexpr bool PERM = true;
    bf16* O; int ldc; int cbase; int rsub;
    __device__ __forceinline__ void operator()(const f32x4 (&acc)[2][2][4][2], const GUnit& u, int wr, int wc, int fr, int fq) const {
        const int col0 = cbase + u.pn * 128 + wc * 32 + 8 * fq;
        EPI_ROWS_BEGIN
            f32x4 o[2];
#pragma unroll
            for (int n = 0; n < 2; ++n)
#pragma unroll
                for (int j = 0; j < 4; ++j) { const float a = acc[ai][0][m][n][j], b = acc[ai][1][m][n][j]; o[n][j] = MODE == 0 ? a * fsigmoid(b) : fsilu(a) * b; }
            *(u32x4*)(O + (size_t)(row - rsub) * ldc + col0) = pack_f4f4(o[0], o[1]);
        EPI_ROWS_END
    }
};
struct EpiGate {
    static constexpr bool PERM = true;
    const float* bmg; u32x4* gscr; float ds;
    __device__ __forceinline__ void operator()(const f32x4 (&acc)[2][2][4][2], const GUnit& u, int wr, int wc, int fr, int fq) const {
        const int n = u.z, tid = (wr * 4 + wc) * 64 + fq * 16 + fr;
#pragma unroll
        for (int bj = 0; bj < 2; ++bj) {
            const float* bp = bmg + n * 1024 + u.pn * BM + bj * HALF + wc * 32 + 8 * fq;
            const f32x4 b0 = *(const f32x4*)bp, b1 = *(const f32x4*)(bp + 4);
#pragma unroll
            for (int ai = 0; ai < 2; ++ai)
#pragma unroll
                for (int m = 0; m < 4; ++m) { f32x4 g0 = acc[ai][bj][m][0] * ds + b0, g1 = acc[ai][bj][m][1] * ds + b1;
#pragma unroll
                    for (int j = 0; j < 4; ++j) { g0[j] = fsigmoid(g0[j]); g1[j] = fsigmoid(g1[j]); }
                    gscr[((n * 8 + (tid >> 6)) * 16 + (ai * 4 + m) * 2 + bj) * 64 + (tid & 63)] = pack_f4f4(g0, g1); asm volatile("" ::: "memory"); }
        }
    }
};
struct EpiMergeP {
    static constexpr bool PERM = true;
    bf16* M; const u32x4* gscr;
    unsigned* flag = nullptr; unsigned want = 0u;
    __device__ __forceinline__ void operator()(const f32x4 (&acc)[2][2][4][2], const GUnit& u, int wr, int wc, int fr, int fq) const {
        const int n = u.z, tid = (wr * 4 + wc) * 64 + fq * 16 + fr;
        const int col0 = u.pn * BM + wc * 32 + 8 * fq;
        if (flag && n > 0) { unsigned sp = 0u; while (xb_ld(flag) < want) { __builtin_amdgcn_s_sleep(1); if (++sp > (1u << 22)) break; }
            __builtin_amdgcn_fence(__ATOMIC_ACQUIRE, "agent"); asm volatile("s_waitcnt vmcnt(0)" ::: "memory"); }
        EPI_ROWS_BEGIN
#pragma unroll
            for (int bj = 0; bj < 2; ++bj) {
                float g[8], p[8]; unpack8(gscr[((n * 8 + (tid >> 6)) * 16 + (ai * 4 + m) * 2 + bj) * 64 + (tid & 63)], g);
                bf16* dst = M + (size_t)row * 1024 + col0 + bj * HALF;
                if (n > 0) unpack8(*(const u32x4*)dst, p);
#pragma unroll
                for (int j = 0; j < 8; ++j) { const float v = g[j] * acc[ai][bj][m][j >> 2][j & 3]; p[j] = n > 0 ? p[j] + v : v; }
                *(u32x4*)dst = pack8(p);
            }
            asm volatile("" ::: "memory");
        EPI_ROWS_END
    }
};
template <bool OUT8> struct EpiPairS {
    static constexpr bool PERM = true;
    unsigned char* O; int ldc; int rsub; float ds, os;
    __device__ __forceinline__ void operator()(const f32x4 (&acc)[2][2][4][2], const GUnit& u, int wr, int wc, int fr, int fq) const {
        const int col0 = u.pn * 128 + wc * 32 + 8 * fq;
        EPI_ROWS_BEGIN
            float o[8];
#pragma unroll
            for (int n = 0; n < 2; ++n)
#pragma unroll
                for (int j = 0; j < 4; ++j) { const float a = acc[ai][0][m][n][j] * ds, b = acc[ai][1][m][n][j]; o[4 * n + j] = fsilu(a) * b * (ds * os); }
            if constexpr (OUT8) *(u32x2*)(O + (size_t)(row - rsub) * ldc + col0) = (u32x2){pk_fp8x4(o[0], o[1], o[2], o[3]), pk_fp8x4(o[4], o[5], o[6], o[7])};
            else *(u32x4*)((bf16*)O + (size_t)(row - rsub) * ldc + col0) = pack8(o);
            asm volatile("" ::: "memory");
        EPI_ROWS_END
    }
};
struct EpiF32S {
    static constexpr bool PERM = false;
    float* C; int ldc; float ds;
    __device__ __forceinline__ void operator()(const f32x4 (&acc)[2][2][4][2], const GUnit& u, int wr, int wc, int fr, int fq) const {
        const int col0 = u.pn * BM + wc * 32 + 4 * fq;
        EPI_ROWS_BEGIN
            float* rowp = C + (size_t)row * ldc + col0;
#pragma unroll
            for (int bj = 0; bj < 2; ++bj)
#pragma unroll
                for (int n = 0; n < 2; ++n) *(f32x4*)(rowp + bj * HALF + n * 16) = acc[ai][bj][m][n] * ds;
        EPI_ROWS_END
    }
};
struct EpiBf16S {
    static constexpr bool PERM = true;
    bf16* O; int ldc; float ds;
    __device__ __forceinline__ void operator()(const f32x4 (&acc)[2][2][4][2], const GUnit& u, int wr, int wc, int fr, int fq) const {
        const int col0 = u.pn * BM + wc * 32 + 8 * fq;
        EPI_ROWS_BEGIN
            bf16* rowp = O + (size_t)row * ldc + col0;
#pragma unroll
            for (int bj = 0; bj < 2; ++bj) *(u32x4*)(rowp + bj * HALF) = pack_f4f4(acc[ai][bj][m][0] * ds, acc[ai][bj][m][1] * ds);
        EPI_ROWS_END
    }
};
#undef EPI_ROWS_BEGIN
#undef EPI_ROWS_END
}

namespace att {
__device__ __forceinline__ float swap32_max(float v) { const auto rr = __builtin_amdgcn_permlane32_swap(__float_as_uint(v), __float_as_uint(v), false, false); return __builtin_fmaxf(__uint_as_float(rr[0]), __uint_as_float(rr[1])); }
__device__ __forceinline__ float swap32_sum(float v) { const auto rr = __builtin_amdgcn_permlane32_swap(__float_as_uint(v), __float_as_uint(v), false, false); return __uint_as_float(rr[0]) + __uint_as_float(rr[1]); }
constexpr int VSLOT = 8192, NSLOT = 3;
__device__ __forceinline__ int crow(int r, int hi) { return (r & 3) + 8 * (r >> 2) + 4 * hi; }
__device__ __forceinline__ void glds16(const void* gsrc, unsigned lds_dst) { unsigned keep;
    asm volatile("s_mov_b32 %0, m0\n\ts_mov_b32 m0, %2\n\ts_nop 0\n\tglobal_load_lds_dwordx4 %1, off\n\ts_mov_b32 m0, %0" : "=&s"(keep) : "v"(gsrc), "s"(lds_dst) : "memory"); }
typedef short v4i16_t __attribute__((ext_vector_type(4)));
__device__ __forceinline__ s16x4 vtr(const LAS unsigned char* p) { return __builtin_bit_cast(s16x4, __builtin_amdgcn_ds_read_tr16_b64_v4i16((LAS v4i16_t*)p)); }

struct AttnArgs {
    const bf16* Q; int qpitch, qcol; long qrow0;
    const bf16* K1; int k1pitch, k1col;
    const bf16* K2; int k2pitch;
    const bf16* V; int vpitch, vcol;
    bf16* O; int opitch, ocol;
    int b, ntiles;
};
template <int DK> __device__ __forceinline__ void attn_unit(const AttnArgs& A, LAS unsigned char* lds, int wave_) {
    constexpr int NKS = DK / 16, KSLOT = (DK / 8) * 1024, NKSLOT = 4, NVSLOT = 4; constexpr float THR = 8.f;
    constexpr bool NOMAX = (DK == 64);
    constexpr int LDS_K = 0, LDS_V = NKSLOT * KSLOT, LDS_WS = LDS_V + NVSLOT * VSLOT;
    int tid = wave_ * 64 + lane_id(); asm volatile("" : "+v"(tid));
    const int lane = tid & 63, r32 = lane & 31, hi = lane >> 5; const int wid = __builtin_amdgcn_readfirstlane(tid >> 6);
    const unsigned lds0 = (unsigned)(uintptr_t)lds;
    LAS float* wsf = (LAS float*)(lds + LDS_WS) + wid * 64;
    const int NT = A.ntiles, b = A.b;
#define TILE_ROW(j) ((j) < 4 ? (long)(NLAT + b * CTXL + 64 * (j)) : (long)(b * SEQ + 64 * ((j) - 4)))
#define DMA_K(j) do { const long r0_ = TILE_ROW(j); const int s_ = (j) & 3; \
        glds16(A.K1 + (r0_ + lane) * A.k1pitch + A.k1col + wid * 8, (unsigned)__builtin_amdgcn_readfirstlane(lds0 + LDS_K + s_ * KSLOT + wid * 1024)); \
        if (DK == 96 && wid < 4) glds16(A.K2 + (r0_ + lane) * A.k2pitch + wid * 8, (unsigned)__builtin_amdgcn_readfirstlane(lds0 + LDS_K + s_ * KSLOT + (8 + wid) * 1024)); } while (0)
#define DMA_V(j) do { const long r0_ = TILE_ROW(j); const int s_ = (j) & 3; \
        glds16(A.V + (r0_ + 16 * (wid & 3) + (lane >> 2)) * A.vpitch + A.vcol + (wid >> 2) * 32 + (lane & 3) * 8, (unsigned)__builtin_amdgcn_readfirstlane(lds0 + LDS_V + (s_) * VSLOT + wid * 1024)); } while (0)
#define WAITBAR(n) asm volatile("s_waitcnt vmcnt(" #n ") lgkmcnt(0)\n\ts_barrier" ::: "memory")
#define WAIT_CNT(cnt) do { const int c_ = (cnt); if (c_ >= 3) WAITBAR(3); else if (c_ == 2) WAITBAR(2); else if (c_ == 1) WAITBAR(1); else WAITBAR(0); } while (0)
#define QK(S0, S1, slot) do { const LAS unsigned char* Ks_ = lds + LDS_K + (slot) * KSLOT + hi * 1024 + r32 * 16; \
        _Pragma("unroll") for (int ks = 0; ks < NKS; ++ks) { const bf16x8 k0_ = *(const LAS bf16x8*)(Ks_ + ks * 2048), k1_ = *(const LAS bf16x8*)(Ks_ + ks * 2048 + 512); \
            S0 = __builtin_amdgcn_mfma_f32_32x32x16_bf16(k0_, qr[ks], ks == 0 ? (NOMAX ? f32x16{} : negm) : S0, 0, 0, 0); S1 = __builtin_amdgcn_mfma_f32_32x32x16_bf16(k1_, qr[ks], ks == 0 ? (NOMAX ? f32x16{} : negm) : S1, 0, 0, 0); } } while (0)
    const int nK = (DK == 96 && wid < 4) ? 2 : 1;
    bf16x8 qr[NKS];
    { const bf16* Qw = A.Q + (A.qrow0 + wid * 32 + r32) * A.qpitch + A.qcol + hi * 8;
#pragma unroll
      for (int ks = 0; ks < NKS; ++ks) qr[ks] = *(const bf16x8*)(Qw + ks * 16); }
    asm volatile("s_waitcnt vmcnt(0)" ::: "memory");
    DMA_K(0); DMA_V(0); DMA_K(1); DMA_K(2); DMA_V(1);
    float mref = 0.f, lsum = 0.f; f32x16 o[2]; o[0] = f32x16{}; o[1] = f32x16{};
    f32x16 negm = f32x16{};
    const int vb = (4 * hi + ((lane & 15) >> 2)) * 64 + ((lane >> 4) & 1) * 32 + (lane & 3) * 8;
    f32x16 s0, s1;
    WAITBAR(0);
    QK(s0, s1, 0);
    if constexpr (!NOMAX) { float rm = __builtin_fmaxf(s0[0], s1[0]);
#pragma unroll
      for (int r = 1; r < 16; ++r) rm = __builtin_fmaxf(__builtin_fmaxf(rm, s0[r]), s1[r]);
      rm = swap32_max(rm); mref = rm;
#pragma unroll
      for (int r = 0; r < 16; ++r) { s0[r] -= rm; s1[r] -= rm; negm[r] = -rm; } }
    int vslot = 0;
#define HEAD(t) do { WAITBAR(0);        \
        if ((t) + 3 < NT) DMA_K((t) + 3); if ((t) + 4 < NT) DMA_K((t) + 4); \
        if ((t) + 2 < NT) DMA_V((t) + 2); if ((t) + 3 < NT) DMA_V((t) + 3); } while (0)
#define QKP(N0, N1, t) do { if ((t) + 1 < NT) { const LAS unsigned char* Ks_ = lds + LDS_K + (((t) + 1) & 3) * KSLOT + hi * 1024 + r32 * 16; \
            _Pragma("unroll") for (int kh = 0; kh < 2; ++kh) { bf16x8 kf[NKS]; \
                _Pragma("unroll") for (int k2 = 0; k2 < NKS / 2; ++k2) { const int ks = kh * (NKS / 2) + k2; kf[2 * k2] = *(const LAS bf16x8*)(Ks_ + ks * 2048); kf[2 * k2 + 1] = *(const LAS bf16x8*)(Ks_ + ks * 2048 + 512); } \
                __builtin_amdgcn_s_setprio(1); \
                _Pragma("unroll") for (int k2 = 0; k2 < NKS / 2; ++k2) { const int ks = kh * (NKS / 2) + k2; \
                    N0 = __builtin_amdgcn_mfma_f32_32x32x16_bf16(kf[2 * k2], qr[ks], ks == 0 ? (NOMAX ? f32x16{} : negm) : N0, 0, 0, 0); N1 = __builtin_amdgcn_mfma_f32_32x32x16_bf16(kf[2 * k2 + 1], qr[ks], ks == 0 ? (NOMAX ? f32x16{} : negm) : N1, 0, 0, 0); } \
                __builtin_amdgcn_s_setprio(0); } } } while (0)
#define SMP(C0, C1, N0, N1, t, NREADY) do { if constexpr (!NOMAX) { \
        float rm = __builtin_fmaxf(C0[0], C1[0]); \
        _Pragma("unroll") for (int r = 1; r < 16; ++r) rm = __builtin_fmaxf(__builtin_fmaxf(rm, C0[r]), C1[r]); \
        rm = swap32_max(rm); \
        if (__builtin_expect(__any(rm > THR), 0)) { \
            const float dl = __builtin_fmaxf(rm, 0.f), al = __builtin_amdgcn_exp2f(-dl); \
            mref += dl; lsum *= al; \
            _Pragma("unroll") for (int r = 0; r < 16; ++r) { C0[r] -= dl; C1[r] -= dl; negm[r] = -mref; } \
            if (NREADY && (t) + 1 < NT) { _Pragma("unroll") for (int r = 0; r < 16; ++r) { N0[r] -= dl; N1[r] -= dl; } } \
            if (hi == 0) wsf[r32] = al; \
            asm volatile("s_waitcnt lgkmcnt(0)" ::: "memory"); \
            _Pragma("unroll") for (int rq = 0; rq < 4; ++rq) { const f32x4 a4 = *(const LAS f32x4*)(wsf + 8 * rq + 4 * hi); \
                _Pragma("unroll") for (int j = 0; j < 4; ++j) { o[0][4 * rq + j] *= a4[j]; o[1][4 * rq + j] *= a4[j]; } } \
        } } \
        float ps0 = 0.f, ps1 = 0.f, ps2 = 0.f, ps3 = 0.f; \
        _Pragma("unroll") for (int r = 0; r < 16; r += 2) { C0[r] = __builtin_amdgcn_exp2f(C0[r]); C1[r] = __builtin_amdgcn_exp2f(C1[r]); C0[r + 1] = __builtin_amdgcn_exp2f(C0[r + 1]); C1[r + 1] = __builtin_amdgcn_exp2f(C1[r + 1]); \
            ps0 += C0[r]; ps1 += C1[r]; ps2 += C0[r + 1]; ps3 += C1[r + 1]; } \
        lsum += (ps0 + ps1) + (ps2 + ps3); \
        pw[0] = (u32x4){pk2(C0[0], C0[1]), pk2(C0[2], C0[3]), pk2(C0[4], C0[5]), pk2(C0[6], C0[7])}; \
        pw[1] = (u32x4){pk2(C0[8], C0[9]), pk2(C0[10], C0[11]), pk2(C0[12], C0[13]), pk2(C0[14], C0[15])}; \
        pw[2] = (u32x4){pk2(C1[0], C1[1]), pk2(C1[2], C1[3]), pk2(C1[4], C1[5]), pk2(C1[6], C1[7])}; \
        pw[3] = (u32x4){pk2(C1[8], C1[9]), pk2(C1[10], C1[11]), pk2(C1[12], C1[13]), pk2(C1[14], C1[15])}; } while (0)
#define PVP() do { const LAS unsigned char* Vs = lds + LDS_V + vslot * VSLOT + vb; \
        _Pragma("unroll") for (int d0 = 0; d0 < 2; ++d0) { s16x4 vlo[4], vhh[4]; \
            _Pragma("unroll") for (int i = 0; i < 4; ++i) { vlo[i] = vtr(Vs + d0 * 4096 + i * 1024); vhh[i] = vtr(Vs + d0 * 4096 + i * 1024 + 512); } \
            __builtin_amdgcn_s_setprio(1); \
            _Pragma("unroll") for (int ks = 0; ks < 4; ++ks) { \
                const bf16x8 vf = (bf16x8){vlo[ks][0], vlo[ks][1], vlo[ks][2], vlo[ks][3], vhh[ks][0], vhh[ks][1], vhh[ks][2], vhh[ks][3]}; \
                o[d0] = __builtin_amdgcn_mfma_f32_32x32x16_bf16(__builtin_bit_cast(bf16x8, pw[ks]), vf, o[d0], 0, 0, 0); } \
            __builtin_amdgcn_s_setprio(0); } \
        vslot = (vslot + 1) & 3; } while (0)
    f32x16 n0, n1; u32x4 pw[4];
    if (wid < 8) {
        for (int t = 0; t < NT; t += 2) {
            HEAD(t); QKP(n0, n1, t); SMP(s0, s1, n0, n1, t, 1); PVP();
            QKP(s0, s1, t + 1); SMP(n0, n1, s0, s1, t + 1, 1); PVP(); }
    } else {
        for (int t = 0; t < NT; t += 2) {
            HEAD(t); SMP(s0, s1, n0, n1, t, 0); PVP(); QKP(n0, n1, t);
            SMP(n0, n1, s0, s1, t + 1, 0); PVP(); QKP(s0, s1, t + 1); }
    }
#undef HEAD
#undef QKP
#undef SMP
#undef PVP
    lsum = swap32_sum(lsum);
    if (hi == 0) wsf[32 + r32] = __builtin_amdgcn_rcpf(lsum);
    asm volatile("s_waitcnt vmcnt(0) lgkmcnt(0)\n\ts_barrier" ::: "memory");
    { LAS bf16* stg = (LAS bf16*)(lds + wid * 4096);
#pragma unroll
      for (int rq = 0; rq < 4; ++rq) { const f32x4 i4 = *(const LAS f32x4*)(wsf + 32 + 8 * rq + 4 * hi);
#pragma unroll
          for (int j = 0; j < 4; ++j) { const int q = 8 * rq + 4 * hi + j;
              stg[q * 64 + r32] = (bf16)f2bf(o[0][4 * rq + j] * i4[j]); stg[q * 64 + 32 + r32] = (bf16)f2bf(o[1][4 * rq + j] * i4[j]); } }
      asm volatile("s_waitcnt lgkmcnt(0)" ::: "memory");
      bf16* Ow = A.O + (A.qrow0 + wid * 32) * A.opitch + A.ocol;
#pragma unroll
      for (int i = 0; i < 4; ++i) { const int row = i * 8 + (lane >> 3), ch = lane & 7; *(u32x4*)(Ow + (long)row * A.opitch + ch * 8) = *(const LAS u32x4*)(stg + row * 64 + ch * 8); } }
    asm volatile("s_waitcnt vmcnt(0) lgkmcnt(0)\n\ts_barrier" ::: "memory");
#undef TILE_ROW
#undef DMA_K
#undef DMA_V
#undef WAITBAR
#undef WAIT_CNT
#undef QK
}

template <int DK> __device__ __forceinline__ void attn_unit3(const AttnArgs& A, LAS unsigned char* lds, int wave_) {
    constexpr int NKS = DK / 16, KSLOT = (DK / 8) * 1024, NKSLOT = 4, NVSLOT = 4;
    constexpr int LDS_K = 0, LDS_V = NKSLOT * KSLOT, LDS_WS = LDS_V + NVSLOT * VSLOT;
    int tid = wave_ * 64 + lane_id(); asm volatile("" : "+v"(tid));
    const int lane = tid & 63, r32 = lane & 31, hi = lane >> 5; const int wid = __builtin_amdgcn_readfirstlane(tid >> 6);
    const unsigned lds0 = (unsigned)(uintptr_t)lds;
    LAS float* wsf = (LAS float*)(lds + LDS_WS) + wid * 64;
    const int NT = A.ntiles, b = A.b;
#define TILE_ROW(j) ((j) < 4 ? (long)(NLAT + b * CTXL + 64 * (j)) : (long)(b * SEQ + 64 * ((j) - 4)))
#define DMA_K(j) do { const long r0_ = TILE_ROW(j); const int s_ = (j) & 3; \
        glds16(A.K1 + (r0_ + lane) * A.k1pitch + A.k1col + wid * 8, (unsigned)__builtin_amdgcn_readfirstlane(lds0 + LDS_K + s_ * KSLOT + wid * 1024)); \
        if (DK == 96 && wid < 4) glds16(A.K2 + (r0_ + lane) * A.k2pitch + wid * 8, (unsigned)__builtin_amdgcn_readfirstlane(lds0 + LDS_K + s_ * KSLOT + (8 + wid) * 1024)); } while (0)
#define DMA_V(j) do { const long r0_ = TILE_ROW(j); const int s_ = (j) & 3; \
        glds16(A.V + (r0_ + 16 * (wid & 3) + (lane >> 2)) * A.vpitch + A.vcol + (wid >> 2) * 32 + (lane & 3) * 8, (unsigned)__builtin_amdgcn_readfirstlane(lds0 + LDS_V + (s_) * VSLOT + wid * 1024)); } while (0)
#define WAITBAR(n) asm volatile("s_waitcnt vmcnt(" #n ") lgkmcnt(0)\n\ts_barrier" ::: "memory")
    bf16x8 qr[NKS];
    { const bf16* Qw = A.Q + (A.qrow0 + wid * 32 + r32) * A.qpitch + A.qcol + hi * 8;
#pragma unroll
      for (int ks = 0; ks < NKS; ++ks) qr[ks] = *(const bf16x8*)(Qw + ks * 16); }
    asm volatile("s_waitcnt vmcnt(0)" ::: "memory");
    DMA_K(0); DMA_K(1); DMA_V(0); DMA_K(2); DMA_K(3); DMA_V(1);
    float ls0 = 0.f, ls1 = 0.f, ls2 = 0.f, ls3 = 0.f; f32x16 o[2]; o[0] = f32x16{}; o[1] = f32x16{};
    const int vb = (4 * hi + ((lane & 15) >> 2)) * 64 + ((lane >> 4) & 1) * 32 + (lane & 3) * 8;
    const LAS unsigned char* Kb = lds + LDS_K + hi * 1024 + r32 * 16;
    const LAS unsigned char* Vb = lds + LDS_V + vb;
#define QKH(S0, S1, j, kh) do { const LAS unsigned char* Ks_ = Kb + ((j) & 3) * KSLOT; bf16x8 kf[NKS]; \
        _Pragma("unroll") for (int k2 = 0; k2 < NKS / 2; ++k2) { const int ks = (kh) * (NKS / 2) + k2; kf[2 * k2] = *(const LAS bf16x8*)(Ks_ + ks * 2048); kf[2 * k2 + 1] = *(const LAS bf16x8*)(Ks_ + ks * 2048 + 512); } \
        _Pragma("unroll") for (int k2 = 0; k2 < NKS / 2; ++k2) { const int ks = (kh) * (NKS / 2) + k2; \
            S0 = __builtin_amdgcn_mfma_f32_32x32x16_bf16(kf[2 * k2], qr[ks], ks == 0 ? f32x16{} : S0, 0, 0, 0); S1 = __builtin_amdgcn_mfma_f32_32x32x16_bf16(kf[2 * k2 + 1], qr[ks], ks == 0 ? f32x16{} : S1, 0, 0, 0); } } while (0)
#define PVH(PW, j, d0) do { const LAS unsigned char* Vs_ = Vb + ((j) & 3) * VSLOT + (d0) * 4096; s16x4 vlo[4], vhh[4]; \
        _Pragma("unroll") for (int i = 0; i < 4; ++i) { vlo[i] = vtr(Vs_ + i * 1024); vhh[i] = vtr(Vs_ + i * 1024 + 512); } \
        _Pragma("unroll") for (int ks = 0; ks < 4; ++ks) { const bf16x8 vf = (bf16x8){vlo[ks][0], vlo[ks][1], vlo[ks][2], vlo[ks][3], vhh[ks][0], vhh[ks][1], vhh[ks][2], vhh[ks][3]}; \
            o[d0] = __builtin_amdgcn_mfma_f32_32x32x16_bf16(__builtin_bit_cast(bf16x8, PW[ks]), vf, o[d0], 0, 0, 0); } } while (0)
#define SOFT(C0, C1, PW) do { \
        _Pragma("unroll") for (int r = 0; r < 16; r += 2) { C0[r] = __builtin_amdgcn_exp2f(C0[r]); C1[r] = __builtin_amdgcn_exp2f(C1[r]); C0[r + 1] = __builtin_amdgcn_exp2f(C0[r + 1]); C1[r + 1] = __builtin_amdgcn_exp2f(C1[r + 1]); \
            ls0 += C0[r]; ls1 += C1[r]; ls2 += C0[r + 1]; ls3 += C1[r + 1]; } \
        PW[0] = (u32x4){pk2(C0[0], C0[1]), pk2(C0[2], C0[3]), pk2(C0[4], C0[5]), pk2(C0[6], C0[7])}; \
        PW[1] = (u32x4){pk2(C0[8], C0[9]), pk2(C0[10], C0[11]), pk2(C0[12], C0[13]), pk2(C0[14], C0[15])}; \
        PW[2] = (u32x4){pk2(C1[0], C1[1]), pk2(C1[2], C1[3]), pk2(C1[4], C1[5]), pk2(C1[6], C1[7])}; \
        PW[3] = (u32x4){pk2(C1[8], C1[9]), pk2(C1[10], C1[11]), pk2(C1[12], C1[13]), pk2(C1[14], C1[15])}; } while (0)
#define HINTS() do { _Pragma("unroll") for (int h_ = 0; h_ < 2; ++h_) { __builtin_amdgcn_sched_group_barrier(0x100, NKS + 8, 0); \
            _Pragma("unroll") for (int g_ = 0; g_ < NKS + 4; ++g_) { __builtin_amdgcn_sched_group_barrier(0x008, 1, 0); __builtin_amdgcn_sched_group_barrier(0x400, 2, 0); __builtin_amdgcn_sched_group_barrier(0x002, 3, 0); } } } while (0)
#define STEP3(N0, N1, C0, C1, PN, PC, t) do { __builtin_amdgcn_sched_barrier(0); \
        QKH(N0, N1, (t) + 2, 0); PVH(PC, t, 0); QKH(N0, N1, (t) + 2, 1); PVH(PC, t, 1); SOFT(C0, C1, PN); HINTS(); __builtin_amdgcn_sched_barrier(0); } while (0)
    f32x16 sA0, sA1, sB0, sB1; u32x4 pA[4], pB[4];
    WAITBAR(0);
    QKH(sA0, sA1, 0, 0); QKH(sA0, sA1, 0, 1); QKH(sB0, sB1, 1, 0); QKH(sB0, sB1, 1, 1);
    SOFT(sA0, sA1, pA);
    int t = 0;
    for (; t + 3 < NT; t += 2) {
        WAITBAR(0);
        if (t + 4 < NT) DMA_K(t + 4); if (t + 5 < NT) DMA_K(t + 5); if (t + 2 < NT) DMA_V(t + 2); if (t + 3 < NT) DMA_V(t + 3);
        STEP3(sA0, sA1, sB0, sB1, pB, pA, t);
        STEP3(sB0, sB1, sA0, sA1, pA, pB, t + 1);
    }
    WAITBAR(0);
    __builtin_amdgcn_sched_barrier(0);
    PVH(pA, t, 0); PVH(pA, t, 1); SOFT(sB0, sB1, pB);
    __builtin_amdgcn_sched_barrier(0);
    PVH(pB, t + 1, 0); PVH(pB, t + 1, 1);
    float lsum = (ls0 + ls1) + (ls2 + ls3);
    lsum = swap32_sum(lsum);
    if (hi == 0) wsf[32 + r32] = __builtin_amdgcn_rcpf(lsum);
    asm volatile("s_waitcnt vmcnt(0) lgkmcnt(0)\n\ts_barrier" ::: "memory");
    { LAS bf16* stg = (LAS bf16*)(lds + wid * 4096);
#pragma unroll
      for (int rq = 0; rq < 4; ++rq) { const f32x4 i4 = *(const LAS f32x4*)(wsf + 32 + 8 * rq + 4 * hi);
#pragma unroll
          for (int j = 0; j < 4; ++j) { const int q = 8 * rq + 4 * hi + j;
              stg[q * 64 + r32] = (bf16)f2bf(o[0][4 * rq + j] * i4[j]); stg[q * 64 + 32 + r32] = (bf16)f2bf(o[1][4 * rq + j] * i4[j]); } }
      asm volatile("s_waitcnt lgkmcnt(0)" ::: "memory");
      bf16* Ow = A.O + (A.qrow0 + wid * 32) * A.opitch + A.ocol;
#pragma unroll
      for (int i = 0; i < 4; ++i) { const int row = i * 8 + (lane >> 3), ch = lane & 7; *(u32x4*)(Ow + (long)row * A.opitch + ch * 8) = *(const LAS u32x4*)(stg + row * 64 + ch * 8); } }
    asm volatile("s_waitcnt vmcnt(0) lgkmcnt(0)\n\ts_barrier" ::: "memory");
#undef TILE_ROW
#undef DMA_K
#undef DMA_V
#undef WAITBAR
#undef QKH
#undef PVH
#undef SOFT
#undef HINTS
#undef STEP3
}

#define ASBAR() __builtin_amdgcn_sched_barrier(0)
#define APIN(x) asm volatile("" : "+v"(x))
template <int DK> __device__ __forceinline__ void attn_unit4(const AttnArgs& A, LAS unsigned char* lds, int wave_) {
    constexpr int NKS = DK / 16, KSLOT = (DK / 8) * 1024, NKSLOT = 4, NVSLOT = 4;
    constexpr int LDS_K = 0, LDS_V = NKSLOT * KSLOT, LDS_WS = LDS_V + NVSLOT * VSLOT;
    int tid = wave_ * 64 + lane_id(); asm volatile("" : "+v"(tid));
    const int lane = tid & 63, r32 = lane & 31, hi = lane >> 5; const int wid = __builtin_amdgcn_readfirstlane(tid >> 6);
    const unsigned lds0 = (unsigned)(uintptr_t)lds;
    LAS float* wsf = (LAS float*)(lds + LDS_WS) + wid * 64;
    const int NT = A.ntiles, b = A.b;
#define TILE_ROW(j) ((j) < 4 ? (long)(NLAT + b * CTXL + 64 * (j)) : (long)(b * SEQ + 64 * ((j) - 4)))
#define DMA_K(j) do { const long r0_ = TILE_ROW(j); const int s_ = (j) & 3; \
        glds16(A.K1 + (r0_ + lane) * A.k1pitch + A.k1col + wid * 8, (unsigned)__builtin_amdgcn_readfirstlane(lds0 + LDS_K + s_ * KSLOT + wid * 1024)); \
        if (DK == 96 && wid < 4) glds16(A.K2 + (r0_ + lane) * A.k2pitch + wid * 8, (unsigned)__builtin_amdgcn_readfirstlane(lds0 + LDS_K + s_ * KSLOT + (8 + wid) * 1024)); } while (0)
#define DMA_V(j) do { const long r0_ = TILE_ROW(j); const int s_ = (j) & 3; \
        glds16(A.V + (r0_ + 16 * (wid & 3) + (lane >> 2)) * A.vpitch + A.vcol + (wid >> 2) * 32 + (lane & 3) * 8, (unsigned)__builtin_amdgcn_readfirstlane(lds0 + LDS_V + (s_) * VSLOT + wid * 1024)); } while (0)
#define WAITBAR(n) asm volatile("s_waitcnt vmcnt(" #n ") lgkmcnt(0)\n\ts_barrier" ::: "memory")
    bf16x8 qr[NKS];
    { const bf16* Qw = A.Q + (A.qrow0 + wid * 32 + r32) * A.qpitch + A.qcol + hi * 8;
#pragma unroll
      for (int ks = 0; ks < NKS; ++ks) qr[ks] = *(const bf16x8*)(Qw + ks * 16); }
    DMA_K(0); DMA_K(1); DMA_V(0); DMA_K(2); DMA_K(3); DMA_V(1);
    float lsum = 0.f; f32x16 o[2]; o[0] = f32x16{}; o[1] = f32x16{};
    const LAS unsigned char* Kb = lds + LDS_K + hi * 1024 + r32 * 16;
    const LAS unsigned char* Vb = lds + LDS_V + (4 * hi + ((lane & 15) >> 2)) * 64 + ((lane >> 4) & 1) * 32 + (lane & 3) * 8;
    f32x16 pA0, pA1, pB0, pB1; bf16x8 kf[2 * NKS]; s16x4 vlo[8], vhi[8]; u32x4 pw0, pw1, pw2, pw3;
#define MF(a, b, c) __builtin_amdgcn_mfma_f32_32x32x16_bf16(a, b, c, 0, 0, 0)
#define KLD2(kp, d0) do { kf[2 * (d0)] = *(const LAS bf16x8*)((kp) + (d0) * 2048); kf[2 * (d0) + 1] = *(const LAS bf16x8*)((kp) + (d0) * 2048 + 512); } while (0)
#define PKW(P, i) pk2(P[i], P[(i) + 1])
#define PAF(k) __builtin_bit_cast(bf16x8, pw##k)
#define VFR(i) (bf16x8){vlo[i][0], vlo[i][1], vlo[i][2], vlo[i][3], vhi[i][0], vhi[i][1], vhi[i][2], vhi[i][3]}
#define VRD(i) do { vlo[i] = vtr(vp_ + (((i) >> 2) * 4096 + ((i) & 3) * 1024)); vhi[i] = vtr(vp_ + (((i) >> 2) * 4096 + ((i) & 3) * 1024 + 512)); } while (0)
#define KRD(G, d0) do { if (G) { KLD2(kn_, d0); ASBAR(); } } while (0)
#define EX(v) __builtin_amdgcn_exp2f(v)
#define GAPA(MFS, a0, a1, a2, a3, W0, W1, PW) do { MFS; sacc += a0; sacc += a1; sacc += a2; sacc += a3; W0; W1; APIN(PW); APIN(sacc); ASBAR(); } while (0)
#define GAPB(MFS, X, i) do { MFS; X[i] = EX(X[i]); X[(i) + 1] = EX(X[(i) + 1]); X[(i) + 2] = EX(X[(i) + 2]); X[(i) + 3] = EX(X[(i) + 3]); APIN(X); ASBAR(); } while (0)
#define STEP4(C0, C1, P0, P1, t, GL) do { ASBAR(); \
    const LAS unsigned char* vp_ = Vb + (((t) - 1) & 3) * VSLOT; const LAS unsigned char* kn_ = Kb + (((t) + 1) & 3) * KSLOT; \
    VRD(0); ASBAR(); float sacc = P0[0] + P0[1]; \
                     GAPA(C0 = MF(kf[0], qr[0], f32x16{}), P0[2], P0[3], P0[4], P0[5],     pw0[0] = PKW(P0, 0),  pw0[1] = PKW(P0, 2),  pw0); \
    VRD(4); ASBAR(); GAPA(C1 = MF(kf[1], qr[0], f32x16{}), P0[6], P0[7], P0[8], P0[9],     pw0[2] = PKW(P0, 4),  pw0[3] = PKW(P0, 6),  pw0); \
    VRD(1); ASBAR(); GAPA(C0 = MF(kf[2], qr[1], C0),       P0[10], P0[11], P0[12], P0[13], pw1[0] = PKW(P0, 8),  pw1[1] = PKW(P0, 10), pw1); \
    VRD(5); ASBAR(); GAPA(C1 = MF(kf[3], qr[1], C1),       P0[14], P0[15], P1[0], P1[1],   pw1[2] = PKW(P0, 12), pw1[3] = PKW(P0, 14), pw1); \
    VRD(2); ASBAR(); GAPA(C0 = MF(kf[4], qr[2], C0),       P1[2], P1[3], P1[4], P1[5],     pw2[0] = PKW(P1, 0),  pw2[1] = PKW(P1, 2),  pw2); \
    VRD(6); ASBAR(); GAPA(C1 = MF(kf[5], qr[2], C1),       P1[6], P1[7], P1[8], P1[9],     pw2[2] = PKW(P1, 4),  pw2[3] = PKW(P1, 6),  pw2); \
    VRD(3); ASBAR(); GAPA(C0 = MF(kf[6], qr[3], C0),       P1[10], P1[11], P1[12], P1[13], pw3[0] = PKW(P1, 8),  pw3[1] = PKW(P1, 10), pw3); \
    VRD(7); ASBAR(); GAPA(C1 = MF(kf[7], qr[3], C1),       P1[14], P1[15], 0.f, 0.f,       pw3[2] = PKW(P1, 12), pw3[3] = PKW(P1, 14), pw3); \
    if (NKS == 6) { C0 = MF(kf[2 * (NKS - 2)], qr[NKS - 2], C0); C1 = MF(kf[2 * (NKS - 2) + 1], qr[NKS - 2], C1); C0 = MF(kf[2 * (NKS - 1)], qr[NKS - 1], C0); C1 = MF(kf[2 * (NKS - 1) + 1], qr[NKS - 1], C1); ASBAR(); } \
    lsum += sacc; ASBAR(); \
    GAPB(o[0] = MF(PAF(0), VFR(0), o[0]), C0, 0);               KRD((GL) && NKS == 6, 4); GAPB(o[1] = MF(PAF(0), VFR(4), o[1]), C0, 4); \
    KRD(GL, 0); GAPB(o[0] = MF(PAF(1), VFR(1), o[0]), C0, 8);   KRD(GL, 1); GAPB(o[1] = MF(PAF(1), VFR(5), o[1]), C0, 12); \
    KRD(GL, 2); GAPB(o[0] = MF(PAF(2), VFR(2), o[0]), C1, 0);   KRD(GL, 3); GAPB(o[1] = MF(PAF(2), VFR(6), o[1]), C1, 4); \
    KRD((GL) && NKS == 6, 5); GAPB(o[0] = MF(PAF(3), VFR(3), o[0]), C1, 8);   GAPB(o[1] = MF(PAF(3), VFR(7), o[1]), C1, 12); \
    } while (0)
    WAITBAR(0);
#pragma unroll
    for (int d0 = 0; d0 < NKS; ++d0) KLD2(Kb, d0);
#pragma unroll
    for (int d0 = 0; d0 < NKS; ++d0) { pA0 = MF(kf[2 * d0], qr[d0], d0 == 0 ? f32x16{} : pA0); pA1 = MF(kf[2 * d0 + 1], qr[d0], d0 == 0 ? f32x16{} : pA1); }
#pragma unroll
    for (int r = 0; r < 16; ++r) { pA0[r] = EX(pA0[r]); pA1[r] = EX(pA1[r]); }
#pragma unroll
    for (int d0 = 0; d0 < NKS; ++d0) KLD2(Kb + KSLOT, d0);
    int t = 1;
    for (; t + 2 < NT; t += 2) {
        WAITBAR(0);
        if (t + 3 < NT) DMA_K(t + 3); if (t + 4 < NT) DMA_K(t + 4); if (t + 1 < NT) DMA_V(t + 1); if (t + 2 < NT) DMA_V(t + 2);
        STEP4(pB0, pB1, pA0, pA1, t, true);
        STEP4(pA0, pA1, pB0, pB1, t + 1, true);
    }
    WAITBAR(0);
    STEP4(pB0, pB1, pA0, pA1, t, false);
    { ASBAR(); float sacc = pB0[0] + pB0[1];
#pragma unroll
      for (int r = 2; r < 16; ++r) sacc += pB0[r];
#pragma unroll
      for (int r = 0; r < 16; ++r) sacc += pB1[r];
      lsum += sacc;
      pw0 = (u32x4){PKW(pB0, 0), PKW(pB0, 2), PKW(pB0, 4), PKW(pB0, 6)}; pw1 = (u32x4){PKW(pB0, 8), PKW(pB0, 10), PKW(pB0, 12), PKW(pB0, 14)};
      pw2 = (u32x4){PKW(pB1, 0), PKW(pB1, 2), PKW(pB1, 4), PKW(pB1, 6)}; pw3 = (u32x4){PKW(pB1, 8), PKW(pB1, 10), PKW(pB1, 12), PKW(pB1, 14)};
      const LAS unsigned char* vp_ = Vb + (t & 3) * VSLOT;
#pragma unroll
      for (int i = 0; i < 8; ++i) VRD(i);
      o[0] = MF(PAF(0), VFR(0), o[0]); o[1] = MF(PAF(0), VFR(4), o[1]); o[0] = MF(PAF(1), VFR(1), o[0]); o[1] = MF(PAF(1), VFR(5), o[1]);
      o[0] = MF(PAF(2), VFR(2), o[0]); o[1] = MF(PAF(2), VFR(6), o[1]); o[0] = MF(PAF(3), VFR(3), o[0]); o[1] = MF(PAF(3), VFR(7), o[1]); }
    lsum = swap32_sum(lsum);
    if (hi == 0) wsf[32 + r32] = __builtin_amdgcn_rcpf(lsum);
    asm volatile("s_waitcnt vmcnt(0) lgkmcnt(0)\n\ts_barrier" ::: "memory");
    { LAS bf16* stg = (LAS bf16*)(lds + wid * 4096);
#pragma unroll
      for (int rq = 0; rq < 4; ++rq) { const f32x4 i4 = *(const LAS f32x4*)(wsf + 32 + 8 * rq + 4 * hi);
#pragma unroll
          for (int j = 0; j < 4; ++j) { const int q = 8 * rq + 4 * hi + j;
              stg[q * 64 + r32] = (bf16)f2bf(o[0][4 * rq + j] * i4[j]); stg[q * 64 + 32 + r32] = (bf16)f2bf(o[1][4 * rq + j] * i4[j]); } }
      asm volatile("s_waitcnt lgkmcnt(0)" ::: "memory");
      bf16* Ow = A.O + (A.qrow0 + wid * 32) * A.opitch + A.ocol;
#pragma unroll
      for (int i = 0; i < 4; ++i) { const int row = i * 8 + (lane >> 3), ch = lane & 7; *(u32x4*)(Ow + (long)row * A.opitch + ch * 8) = *(const LAS u32x4*)(stg + row * 64 + ch * 8); } }
    asm volatile("s_waitcnt vmcnt(0) lgkmcnt(0)\n\ts_barrier" ::: "memory");
#undef TILE_ROW
#undef DMA_K
#undef DMA_V
#undef WAITBAR
#undef MF
#undef KLD2
#undef PKW
#undef PAF
#undef VFR
#undef VRD
#undef KRD
#undef EX
#undef GAPA
#undef GAPB
#undef STEP4
}
#undef ASBAR
#undef APIN
}

namespace s5 {
constexpr int NCH = LPOS / 16;
constexpr int M_MC = 0, M_WCF = 65536, M_WCB = 65536 + 32768, M_WSF = 131072, M_WSB = 131072 + 32768, M_TOTAL = 196608;
constexpr int LDS_E = 18 * 4096;

struct Params { const float *lam_re, *lam_im, *log_dt, *b_re, *b_im, *c_re, *c_im, *dsk; };

__device__ __forceinline__ void build_mats(const Params& P, int l, int g, bf16* out, LAS unsigned char* lds, int wave_, int skipmask = 0) {
    LAS f32x2* apow = (LAS f32x2*)lds;
    LAS f32x2* Bb = apow + 2 * 64 * 17;
    LAS f32x2* Cc = Bb + 2 * 64 * 16;
    LAS float* Kt = (LAS float*)(Cc + 2 * 16 * 64);
    constexpr int KTL = 260, KTD = 16 * KTL;
    const int tid = wave_ * 64 + lane_id();
    LAS float* lamv = Kt + 2 * KTD;
    LAS float* dskv = lamv + 512;
    f32x2 cv[4], bv[4];
#pragma unroll
    for (int m = 0; m < 4; ++m) { const int i = tid + NTHREADS * m; { const int dir = i >> 10, hp = (i >> 6) & 15, p = i & 63; const size_t ci = ((size_t)((l * 2 + dir) * 32 + g) * 16 + hp) * 64 + p; cv[m] = (f32x2){P.c_re[ci], P.c_im[ci]}; }
        { const int dir = i >> 10, p = (i >> 4) & 63, h = i & 15, pi = ((l * 2 + dir) * 32 + g) * 64 + p; bv[m] = (f32x2){P.b_re[(size_t)pi * 16 + h], P.b_im[(size_t)pi * 16 + h]}; } }
    if (tid < 128) { const int dir = tid >> 6, p = tid & 63, pi = ((l * 2 + dir) * 32 + g) * 64 + p;
        lamv[4 * tid] = fminf(P.lam_re[pi], -1e-4f); lamv[4 * tid + 1] = P.lam_im[pi]; lamv[4 * tid + 2] = expf(P.log_dt[(l * 2 + dir) * 32 + g]); }
    else if (tid < 144) dskv[tid - 128] = P.dsk[(l * 32 + g) * 16 + tid - 128];
#pragma unroll
    for (int m = 0; m < 4; ++m) Cc[tid + NTHREADS * m] = cv[m];
    __syncthreads();
    for (int i = tid; i < 2 * 64 * 17; i += NTHREADS) {
        const int dir = i / (64 * 17), r = i - dir * (64 * 17), p = r / 17, j = r - p * 17;
        const float lr = lamv[4 * (dir * 64 + p)], li = lamv[4 * (dir * 64 + p) + 1], dt = lamv[4 * (dir * 64 + p) + 2];
        const float mag = expf((float)j * lr * dt), ang = (float)j * li * dt; apow[i] = (f32x2){mag * cosf(ang), mag * sinf(ang)}; }
#pragma unroll
    for (int m = 0; m < 4; ++m) {
        const int i = tid + NTHREADS * m, dir = i >> 10, p = (i >> 4) & 63;
        const float lr = lamv[4 * (dir * 64 + p)], li = lamv[4 * (dir * 64 + p) + 1], dt = lamv[4 * (dir * 64 + p) + 2];
        const float abr = expf(lr * dt) * cosf(li * dt), abi = expf(lr * dt) * sinf(li * dt), den = lr * lr + li * li;
        const float fr = ((abr - 1.0f) * lr + abi * li) / den, fi = (abi * lr - (abr - 1.0f) * li) / den;
        const float br = bv[m].x, bi = bv[m].y; Bb[i] = (f32x2){fr * br - fi * bi, fr * bi + fi * br}; }
    __syncthreads();
    if (!(skipmask & 1)) {
        const int dir = tid >> 8, j = (tid >> 4) & 15, hp0 = ((tid >> 2) & 3) * 4, h0 = (tid & 3) * 4; float sacc[4][4];
#pragma unroll
        for (int x = 0; x < 4; ++x)
#pragma unroll
            for (int y = 0; y < 4; ++y) sacc[x][y] = 0.f;
        for (int p = 0; p < 64; ++p) { const f32x2 a = apow[(dir * 64 + p) * 17 + j];
            const f32x2 c0_ = Cc[(dir * 16 + hp0) * 64 + p], c1_ = Cc[(dir * 16 + hp0 + 1) * 64 + p], c2_ = Cc[(dir * 16 + hp0 + 2) * 64 + p], c3_ = Cc[(dir * 16 + hp0 + 3) * 64 + p];
            const f32x4 c01 = {c0_.x, c0_.y, c1_.x, c1_.y}, c23 = {c2_.x, c2_.y, c3_.x, c3_.y};
            const f32x4 b01 = *(const LAS f32x4*)(Bb + (dir * 64 + p) * 16 + h0), b23 = *(const LAS f32x4*)(Bb + (dir * 64 + p) * 16 + h0 + 2);
            const float cx[4] = {c01[0], c01[2], c23[0], c23[2]}, cy[4] = {c01[1], c01[3], c23[1], c23[3]}, bx[4] = {b01[0], b01[2], b23[0], b23[2]}, by[4] = {b01[1], b01[3], b23[1], b23[3]};
#pragma unroll
            for (int x = 0; x < 4; ++x) { const float tr = cx[x] * a.x - cy[x] * a.y, ti = cx[x] * a.y + cy[x] * a.x;
#pragma unroll
                for (int y = 0; y < 4; ++y) sacc[x][y] += tr * bx[y] - ti * by[y]; } }
#pragma unroll
        for (int x = 0; x < 4; ++x) *(LAS f32x4*)(Kt + dir * KTD + j * KTL + (hp0 + x) * 16 + h0) = (f32x4){sacc[x][0], sacc[x][1], sacc[x][2], sacc[x][3]};
    }
    __syncthreads();
    if (!(skipmask & 2))
#pragma unroll 4
    for (int i = tid; i < 65536 / 8; i += NTHREADS) {
        const int row = i >> 5, c0 = (i & 31) * 8, t = row >> 4, hp = row & 15, s = c0 >> 4, h0 = c0 & 15; float v[8];
        const int lf = s <= t ? t - s : 0, lb = s >= t ? s - t : 0;
        const f32x4 f0 = *(const LAS f32x4*)(Kt + lf * KTL + hp * 16 + h0), f1 = *(const LAS f32x4*)(Kt + lf * KTL + hp * 16 + h0 + 4);
        const f32x4 b0 = *(const LAS f32x4*)(Kt + KTD + lb * KTL + hp * 16 + h0), b1 = *(const LAS f32x4*)(Kt + KTD + lb * KTL + hp * 16 + h0 + 4);
        const float wf = s <= t ? 1.f : 0.f, wb = s >= t ? 1.f : 0.f;
#pragma unroll
        for (int e = 0; e < 8; ++e) { const int h = h0 + e; float x = 0.f;
            if (s <= t) x += (e < 4 ? f0[e & 3] : f1[e & 3]);
            if (s >= t) x += (e < 4 ? b0[e & 3] : b1[e & 3]);
            if (s == t && h == hp) x += dskv[h];
            v[e] = x; }
        (void)wf; (void)wb;
        *(u32x4*)(out + M_MC + (size_t)row * 256 + c0) = pack8(v);
    }
    if (!(skipmask & 4))
#pragma unroll 4
    for (int i = tid; i < 2 * 32768 / 8; i += NTHREADS) {
        const int dir = i >> 12, ii = i & 4095, row = ii >> 4, c0 = (ii & 15) * 8, t = row >> 4, hp = row & 15, ex = dir == 0 ? t + 1 : 16 - t; float v[8];
#pragma unroll
        for (int e = 0; e < 8; e += 2) { const int p = (c0 + e) >> 1; const f32x2 c = Cc[(dir * 16 + hp) * 64 + p], a = apow[(dir * 64 + p) * 17 + ex];
            v[e] = c.x * a.x - c.y * a.y; v[e + 1] = -(c.x * a.y + c.y * a.x); }
        *(u32x4*)(out + (dir == 0 ? M_WCF : M_WCB) + (size_t)row * 128 + c0) = pack8(v);
    }
    if (!(skipmask & 8))
#pragma unroll 4
    for (int i = tid; i < 2 * 32768 / 8; i += NTHREADS) {
        const int dir = i >> 12, ii = i & 4095, row = ii >> 5, c0 = (ii & 31) * 8, p = row >> 1, im = row & 1, s = c0 >> 4, h0 = c0 & 15, ex = dir == 0 ? 15 - s : s; float v[8];
        const f32x2 a = apow[(dir * 64 + p) * 17 + ex];
#pragma unroll
        for (int e = 0; e < 8; ++e) { const f32x2 bb = Bb[(dir * 64 + p) * 16 + h0 + e]; v[e] = im ? (a.x * bb.y + a.y * bb.x) : (a.x * bb.x - a.y * bb.y); }
        *(u32x4*)(out + (dir == 0 ? M_WSF : M_WSB) + (size_t)row * 256 + c0) = pack8(v);
    }
    __syncthreads();
}

__device__ __forceinline__ void build_a16(const Params& P, float* a16, int gt, int ngt) {
    for (int pi = gt; pi < 2 * 2 * 32 * 64; pi += ngt) {
        const float lr = fminf(P.lam_re[pi], -1e-4f), li = P.lam_im[pi], dt = expf(P.log_dt[pi >> 6]);
        const float mag = expf(16.f * lr * dt), ang = 16.f * li * dt; a16[2 * pi] = mag * cosf(ang); a16[2 * pi + 1] = mag * sinf(ang); }
}
__device__ __forceinline__ void unit(const float* a16, int l, int b, int g, const bf16* Ug, const bf16* mats, bf16* Aglu, bool skip_ctx, LAS unsigned char* lds, int wave_, int half) {
    int tid = wave_ * 64 + lane_id(); asm volatile("" : "+v"(tid));
    const int lane = tid & 63, n = lane & 15, q = lane >> 4; const int wid = __builtin_amdgcn_readfirstlane(tid >> 6);
    LAS unsigned char* Ef = lds; LAS unsigned char* Eb = lds + LDS_E;
    const bf16* U = Ug + (size_t)(b * 32 + g) * LPOS * 16;
    const int rt = 8 * half + wid;
    f32x4 yi[17];
    {
        bf16x8 af[8], ab[8], am[8]; u32x4 st[4]; unsigned uoff[8];
#pragma unroll
        for (int ks = 0; ks < 8; ++ks) { af[ks] = *(const bf16x8*)(mats + M_WSF + (size_t)(16 * wid + n) * 256 + 32 * ks + 8 * q); ab[ks] = *(const bf16x8*)(mats + M_WSB + (size_t)(16 * wid + n) * 256 + 32 * ks + 8 * q);
            am[ks] = *(const bf16x8*)(mats + M_MC + (size_t)(16 * rt + n) * 256 + 32 * ks + 8 * q); }
        const bf16* ug = U + wid * 512 + lane * 8;
        const int ns = 2 * wid + (lane >> 5), js = lane & 31;
        const unsigned sdst = (ns < 8 ? 0u : (unsigned)LDS_E) + (ns & 7) * 512 + ((js ^ ns) << 4);
#pragma unroll
        for (int i = 0; i < 4; ++i) st[i] = *(const u32x4*)(ug + i * 4096);
#pragma unroll
        for (int ks = 0; ks < 8; ++ks) uoff[ks] = (n < 8 ? 0u : (unsigned)LDS_E) + (n & 7) * 512 + (((4 * ks + q) ^ n) << 4);
        *(LAS u32x4*)(lds + sdst + 4096) = st[0]; st[0] = *(const u32x4*)(ug + 4 * 4096);
        __syncthreads();
#pragma unroll
        for (int t = 0; t < 17; ++t) {
            bf16x8 ub[8];
#pragma unroll
            for (int ks = 0; ks < 8; ++ks) ub[ks] = *(const LAS bf16x8*)(lds + 4096 * (t + 1) + uoff[ks]);
            if (t + 1 < 17) { *(LAS u32x4*)(lds + sdst + 4096 * (t + 2)) = st[(t + 1) & 3]; if (t + 5 < 17) st[(t + 1) & 3] = *(const u32x4*)(ug + (t + 5) * 4096); }
            f32x4 cf = {0.f, 0.f, 0.f, 0.f}, cb = {0.f, 0.f, 0.f, 0.f}, cy = {0.f, 0.f, 0.f, 0.f};
#pragma unroll
            for (int ks = 0; ks < 8; ++ks) { cf = __builtin_amdgcn_mfma_f32_16x16x32_bf16(af[ks], ub[ks], cf, 0, 0, 0); cb = __builtin_amdgcn_mfma_f32_16x16x32_bf16(ab[ks], ub[ks], cb, 0, 0, 0);
                if (!(t == 0 && skip_ctx)) cy = __builtin_amdgcn_mfma_f32_16x16x32_bf16(am[ks], ub[ks], cy, 0, 0, 0); }
            yi[t] = cy;
            const int eo = (16 * t + n) * 256 + (((2 * wid + (q >> 1)) ^ n) << 4) + (q & 1) * 8;
            *(LAS u32x2*)(Ef + eo) = (u32x2){pk2(cf[0], cf[1]), pk2(cf[2], cf[3])};
            *(LAS u32x2*)(Eb + eo) = (u32x2){pk2(cb[0], cb[1]), pk2(cb[2], cb[3])};
            __syncthreads();
        }
    }
    bf16x8 wf[4], wb[4];
#pragma unroll
    for (int ks = 0; ks < 4; ++ks) { wf[ks] = *(const bf16x8*)(mats + M_WCF + (size_t)(16 * rt + n) * 128 + 32 * ks + 8 * q); wb[ks] = *(const bf16x8*)(mats + M_WCB + (size_t)(16 * rt + n) * 128 + 32 * ks + 8 * q); }
    if (wid < 2) {
        const int dir = wid, p = lane, pi = ((l * 2 + dir) * 32 + g) * 64 + p;
        const float ar = a16[2 * pi], ai = a16[2 * pi + 1];
        LAS unsigned* E32 = (LAS unsigned*)(dir ? Eb : Ef);
        float xr = 0.f, xi = 0.f;
#define S5_CH(st) (dir == 0 ? (st) : ((st) < 16 ? 15 - (st) : NCH + 15 - (st)))
#define S5_EW(k, j) (S5_CH(16 * (k) + (j)) * 64 + ((((p >> 2) ^ (dir == 0 ? (j) : 15 - (j))) << 2) | (p & 3)))
        unsigned ea[16], eb[16];
#pragma unroll
        for (int j = 0; j < 16; ++j) ea[j] = E32[S5_EW(0, j)];
        for (int k = 0; k < 17; k += 2) {
#pragma unroll
            for (int j = 0; j < 16; ++j) eb[j] = E32[S5_EW(k + 1 < 17 ? k + 1 : k, j)];
#pragma unroll
            for (int j = 0; j < 16; ++j) { const unsigned e = ea[j]; E32[S5_EW(k, j)] = pk2(xr, xi);
                const float er = bf2f(e & 0xffffu), ei = bf2f(e >> 16); const float nr = ar * xr - ai * xi + er, ni = ar * xi + ai * xr + ei; xr = nr; xi = ni; }
            if (k + 1 < 17) {
#pragma unroll
                for (int j = 0; j < 16; ++j) ea[j] = E32[S5_EW(k + 2 < 17 ? k + 2 : k + 1, j)];
#pragma unroll
                for (int j = 0; j < 16; ++j) { const unsigned e = eb[j]; E32[S5_EW(k + 1, j)] = pk2(xr, xi);
                    const float er = bf2f(e & 0xffffu), ei = bf2f(e >> 16); const float nr = ar * xr - ai * xi + er, ni = ar * xi + ai * xr + ei; xr = nr; xi = ni; }
            }
        }
#undef S5_EW
#undef S5_CH
    }
    __syncthreads();
    {
        unsigned xoff[4];
#pragma unroll
        for (int ks = 0; ks < 4; ++ks) xoff[ks] = n * 256 + (((q + 4 * ks) ^ n) << 4);
#pragma unroll
        for (int ct = 0; ct < 17; ++ct) {
            if (ct == 0 && skip_ctx) continue;
            int cto = ct; asm volatile("" : "+s"(cto));
            f32x4 acc = yi[ct];
#pragma unroll
            for (int ks = 0; ks < 4; ++ks) { acc = __builtin_amdgcn_mfma_f32_16x16x32_bf16(wf[ks], *(const LAS bf16x8*)(Ef + 4096 * cto + xoff[ks]), acc, 0, 0, 0);
                acc = __builtin_amdgcn_mfma_f32_16x16x32_bf16(wb[ks], *(const LAS bf16x8*)(Eb + 4096 * cto + xoff[ks]), acc, 0, 0, 0); }
            const int pos = (16 * cto + n) * 16 + rt;
            *(u32x2*)(Aglu + (size_t)pos_row(b, pos) * 512 + g * 16 + 4 * q) = (u32x2){pk2(fgelu_tanh(acc[0]), fgelu_tanh(acc[1])), pk2(fgelu_tanh(acc[2]), fgelu_tanh(acc[3]))};
        }
    }
    __syncthreads();
}
}

struct Ptrs {
    const float *x, *c, *ctx, *c_ctx, *w_mod, *b_mod, *g_mix_pre, *g_mix_post, *g_ffn_pre, *g_ffn_post, *w_in, *g_q, *g_k, *g_cq, *g_ckv, *w_uq, *w_ukv;
    s5::Params s5p;
    const float *w_glu, *w_branch, *w_mg, *b_mg, *w_out, *ffn_w1, *ffn_w3, *ffn_w2, *router_w, *router_b, *moe_w1, *moe_w3, *moe_w2;
    float* out; unsigned char* ws;
};

template <int MAP  >
__device__ __forceinline__ void transpose_item(const float* W, int K, int N, bf16* WT, int kb, int n0, int drow0, LAS float* scr, int lane) {
    const int k0 = 64 * kb;
#pragma unroll
    for (int i = 0; i < 8; ++i) { const int kk = 8 * i + (lane >> 3), c4 = 4 * (lane & 7); const f32x4 v = *(const f32x4*)(W + (size_t)(k0 + kk) * N + n0 + c4);
        LAS float* d = scr + kk * 33 + c4; d[0] = v[0]; d[1] = v[1]; d[2] = v[2]; d[3] = v[3]; }
    asm volatile("s_waitcnt lgkmcnt(0)" ::: "memory");
    const int c = lane & 7;
#pragma unroll
    for (int j = 0; j < 4; ++j) { const int n = (lane >> 3) + 8 * j; const LAS float* s = scr + (8 * c) * 33 + n;
        u32x4 o; o.x = pk2(s[0 * 33], s[1 * 33]); o.y = pk2(s[2 * 33], s[3 * 33]); o.z = pk2(s[4 * 33], s[5 * 33]); o.w = pk2(s[6 * 33], s[7 * 33]);
        int dr = n; if (MAP == 1) { const int i2 = n & 15; dr = 8 * (i2 >> 2) + (i2 & 3) + ((n >> 4) << 2); }
        *(u32x4*)(WT + (size_t)(drow0 + dr) * K + k0 + 8 * c) = o; }
    asm volatile("s_waitcnt lgkmcnt(0)" ::: "memory");
}

__device__ __forceinline__ void transpose_item_f8(const float* W, int K, int N, unsigned char* WT, int kb, int n0, int drow0, float wscale, LAS float* scr, int lane) {
    const int k0 = 64 * kb;
#pragma unroll
    for (int i = 0; i < 8; ++i) { const int kk = 8 * i + (lane >> 3), c4 = 4 * (lane & 7); const f32x4 v = *(const f32x4*)(W + (size_t)(k0 + kk) * N + n0 + c4);
        LAS float* d = scr + kk * 33 + c4; d[0] = v[0]; d[1] = v[1]; d[2] = v[2]; d[3] = v[3]; }
    asm volatile("s_waitcnt lgkmcnt(0)" ::: "memory");
    const int c = lane & 7;
#pragma unroll
    for (int j = 0; j < 4; ++j) { const int n = (lane >> 3) + 8 * j; const LAS float* s = scr + (8 * c) * 33 + n;
        u32x2 o; o.x = pg8::pk_fp8x4(s[0 * 33] * wscale, s[1 * 33] * wscale, s[2 * 33] * wscale, s[3 * 33] * wscale); o.y = pg8::pk_fp8x4(s[4 * 33] * wscale, s[5 * 33] * wscale, s[6 * 33] * wscale, s[7 * 33] * wscale);
        *(u32x2*)(WT + (size_t)(drow0 + n) * K + k0 + 8 * c) = o; }
    asm volatile("s_waitcnt lgkmcnt(0)" ::: "memory");
}
__device__ __forceinline__ int zmap(int n0) { return n0 < 512 ? n0 : n0 < 896 ? ZC_CQ + (n0 - 512) : n0 < 1024 ? ZC_KG + (n0 - 896) : n0 < 1152 ? ZC_VG + (n0 - 1024) : n0 < 1440 ? n0 : ZC_U + (n0 - 1440); }
__device__ __forceinline__ int pairmap(int n0, int second) { return 256 * (n0 >> 7) + (second ? 128 : 0) + (n0 & 127); }

__device__ __forceinline__ void transposes(const Ptrs& P, int gw, int ngw, LAS float* scr, int lane, int qsel = 0) {
    unsigned char* ws = P.ws;
    constexpr int I_WIN = 16 * 61, I_MG = 16 * 96, I_UQ = 6 * 24, I_UKV = 4 * 32, I_GLU = 8 * 32, I_BR = 8 * 32, I_OUT = 16 * 32, I_F13 = 16 * 88, I_F2 = 44 * 32;
    constexpr int PER_L = I_WIN + I_MG + I_UQ + I_UKV + I_GLU + 3 * I_BR + I_OUT;
    constexpr int N_L = 2 * PER_L, N_F = 2 * I_F13 + I_F2, N_M = 8 * (2 * I_F13 + I_F2), NITEMS = N_L + N_F + N_M;
    const int qx = (int)blockIdx.x & 7;
    unsigned* q = (unsigned*)(ws + WS_CTL) + CW_Q + 256 * qsel + 32 * qx; (void)gw; (void)ngw;
    for (;;) { int base = 0; if (lane == 0) base = (int)atomicAdd(q, 4u); base = __builtin_amdgcn_readfirstlane(base); if (base * 8 + qx + N_M >= NITEMS) break;
    for (int it_ = base; it_ < base + 4; ++it_) { const int it = it_ * 8 + qx + N_M; if (it >= NITEMS) break;
        int r = it;
        if (r < N_M) {
            const int e = r / (2 * I_F13 + I_F2); r -= e * (2 * I_F13 + I_F2);
            unsigned char* W1T = ws + WS_WM1T + (size_t)e * 5632 * 1024; unsigned char* W2T = ws + WS_WM2T + (size_t)e * 1024 * 2816;
            if (r < I_F13) { const int kb = r / 88, nb = r % 88; if (F8_M1) transpose_item_f8(P.moe_w1 + (size_t)e * 1024 * DFF, 1024, DFF, W1T, kb, 32 * nb, pairmap(32 * nb, 0), F8_WSCALE, scr, lane); else transpose_item<0>(P.moe_w1 + (size_t)e * 1024 * DFF, 1024, DFF, (bf16*)(ws + WS_WM1T) + (size_t)e * 5632 * 1024, kb, 32 * nb, pairmap(32 * nb, 0), scr, lane); continue; } r -= I_F13;
            if (r < I_F13) { const int kb = r / 88, nb = r % 88; if (F8_M1) transpose_item_f8(P.moe_w3 + (size_t)e * 1024 * DFF, 1024, DFF, W1T, kb, 32 * nb, pairmap(32 * nb, 1), F8_WSCALE, scr, lane); else transpose_item<0>(P.moe_w3 + (size_t)e * 1024 * DFF, 1024, DFF, (bf16*)(ws + WS_WM1T) + (size_t)e * 5632 * 1024, kb, 32 * nb, pairmap(32 * nb, 1), scr, lane); continue; } r -= I_F13;
            { const int kb = r / 32, nb = r % 32; transpose_item_f8(P.moe_w2 + (size_t)e * DFF * 1024, DFF, 1024, W2T, kb, 32 * nb, 32 * nb, F8_WSCALE, scr, lane); continue; }
        }
        r -= N_M;
        if (r < N_F) {
            unsigned char* W1T = ws + WS_WF1T; unsigned char* W2T = ws + WS_WF2T;
            if (r < I_F13) { const int kb = r / 88, nb = r % 88; if (F8_D1) transpose_item_f8(P.ffn_w1, 1024, DFF, W1T, kb, 32 * nb, pairmap(32 * nb, 0), F8_WSCALE, scr, lane); else transpose_item<0>(P.ffn_w1, 1024, DFF, (bf16*)W1T, kb, 32 * nb, pairmap(32 * nb, 0), scr, lane); continue; } r -= I_F13;
            if (r < I_F13) { const int kb = r / 88, nb = r % 88; if (F8_D1) transpose_item_f8(P.ffn_w3, 1024, DFF, W1T, kb, 32 * nb, pairmap(32 * nb, 1), F8_WSCALE, scr, lane); else transpose_item<0>(P.ffn_w3, 1024, DFF, (bf16*)W1T, kb, 32 * nb, pairmap(32 * nb, 1), scr, lane); continue; } r -= I_F13;
            { const int kb = r / 32, nb = r % 32; if (F8_D2) transpose_item_f8(P.ffn_w2, DFF, 1024, W2T, kb, 32 * nb, 32 * nb, F8_WSCALE, scr, lane); else transpose_item<0>(P.ffn_w2, DFF, 1024, (bf16*)W2T, kb, 32 * nb, 32 * nb, scr, lane); continue; }
        }
        r -= N_F;
        const int l = r / PER_L; r -= l * PER_L;
        if (r < I_WIN) { const int kb = r / 61, nb = r % 61; if (F8_G1L1 && l == 1) transpose_item_f8(P.w_in + (size_t)l * 1024 * NIN, 1024, NIN, ws + WS_W1T + (size_t)l * ZW * 2048, kb, 32 * nb, zmap(32 * nb), F8_WSCALE, scr, lane);
            else transpose_item<0>(P.w_in + (size_t)l * 1024 * NIN, 1024, NIN, (bf16*)(ws + WS_W1T) + (size_t)l * ZW * 1024, kb, 32 * nb, zmap(32 * nb), scr, lane); continue; } r -= I_WIN;
        if (r < I_MG) { const int kb = r / 96, nb = r % 96; transpose_item_f8(P.w_mg + (size_t)l * 1024 * 3072, 1024, 3072, ws + WS_WMGT + (size_t)l * 3072 * 1024, kb, 32 * nb, 32 * nb, F8_WSCALE, scr, lane); continue; } r -= I_MG;
        if (r < I_UQ) { const int kb = r / 24, nb = r % 24; bf16* T = (bf16*)(ws + WS_WUQT) + (size_t)l * 768 * 384;
            if (nb % 3 == 2) transpose_item<1>(P.w_uq + (size_t)l * 384 * 768, 384, 768, T, kb, 32 * nb, 32 * nb, scr, lane); else transpose_item<0>(P.w_uq + (size_t)l * 384 * 768, 384, 768, T, kb, 32 * nb, 32 * nb, scr, lane); continue; } r -= I_UQ;
        if (r < I_UKV) { const int kb = r / 32, nb = r % 32; transpose_item<0>(P.w_ukv + (size_t)l * 256 * 1024, 256, 1024, (bf16*)(ws + WS_WUKVT) + (size_t)l * 1024 * 256, kb, 32 * nb, 32 * nb, scr, lane); continue; } r -= I_UKV;
        if (r < I_GLU) { const int kb = r / 32, nb = r % 32, n0 = 32 * nb; transpose_item<0>(P.w_glu + (size_t)l * 512 * 1024, 512, 1024, (bf16*)(ws + WS_WGLUT) + (size_t)l * 1024 * 512, kb, n0, n0 < 512 ? pairmap(n0, 0) : pairmap(n0 - 512, 1), scr, lane); continue; } r -= I_GLU;
        if (r < 3 * I_BR) { const int n = r / I_BR; r -= n * I_BR; const int kb = r / 32, nb = r % 32;
            transpose_item<0>(P.w_branch + ((size_t)l * 3 + n) * 512 * 1024, 512, 1024, (bf16*)(ws + WS_WBT) + ((size_t)l * 3 + n) * 1024 * 512, kb, 32 * nb, 32 * nb, scr, lane); continue; } r -= 3 * I_BR;
        { const int kb = r / 32, nb = r % 32; transpose_item<0>(P.w_out + (size_t)l * 1024 * 1024, 1024, 1024, (bf16*)(ws + WS_WOUTT) + (size_t)l * 1024 * 1024, kb, 32 * nb, 32 * nb, scr, lane); }
    } }
}


constexpr int MOE_ITEMS_PER_E = 2 * 16 * 88 + 44 * 32, MOE_ITEMS = 8 * MOE_ITEMS_PER_E;
__device__ __forceinline__ void moe_transposes(const float* w1, const float* w3, const float* w2, unsigned char* ws, int lo, int hi, int giw, int ngiw, LAS float* scr, int lane) {
    constexpr int I_F13 = 16 * 88;
    for (int it = lo + giw; it < hi; it += ngiw) {
        const int e = it / MOE_ITEMS_PER_E; int r = it - e * MOE_ITEMS_PER_E;
        unsigned char* W1T = ws + WS_WM1T + (size_t)e * 5632 * 1024; unsigned char* W2T = ws + WS_WM2T + (size_t)e * 1024 * 2816;
        if (r < I_F13) { const int kb = r / 88, nb = r % 88; if (F8_M1) transpose_item_f8(w1 + (size_t)e * 1024 * DFF, 1024, DFF, W1T, kb, 32 * nb, pairmap(32 * nb, 0), F8_WSCALE, scr, lane); else transpose_item<0>(w1 + (size_t)e * 1024 * DFF, 1024, DFF, (bf16*)(ws + WS_WM1T) + (size_t)e * 5632 * 1024, kb, 32 * nb, pairmap(32 * nb, 0), scr, lane); continue; } r -= I_F13;
        if (r < I_F13) { const int kb = r / 88, nb = r % 88; if (F8_M1) transpose_item_f8(w3 + (size_t)e * 1024 * DFF, 1024, DFF, W1T, kb, 32 * nb, pairmap(32 * nb, 1), F8_WSCALE, scr, lane); else transpose_item<0>(w3 + (size_t)e * 1024 * DFF, 1024, DFF, (bf16*)(ws + WS_WM1T) + (size_t)e * 5632 * 1024, kb, 32 * nb, pairmap(32 * nb, 1), scr, lane); continue; } r -= I_F13;
        { const int kb = r / 32, nb = r % 32; transpose_item_f8(w2 + (size_t)e * DFF * 1024, DFF, 1024, W2T, kb, 32 * nb, 32 * nb, F8_WSCALE, scr, lane); }
    }
}
__device__ __forceinline__ void mod_item(const Ptrs& P, int item, LAS unsigned char* lds, int wave_) {
    LAS float* sc = (LAS float*)lds;
    LAS float* part = sc + 5 * 1024;
    const int lane = lane_id(), wid = wave_, tid = wid * 64 + lane, l = item / 96, n0 = (item % 96) * 64;
    for (int i = tid; i < 5 * 1024; i += NTHREADS) { const float v = i < 4096 ? P.c[i] : P.c_ctx[i - 4096]; sc[i] = v / (1.0f + expf(-v)); }
    __syncthreads();
    float a[5] = {0.f, 0.f, 0.f, 0.f, 0.f};
    const float* W = P.w_mod + (size_t)l * 1024 * 6144 + n0 + lane;
    for (int k0 = wid; k0 < 1024; k0 += 256) {
        float w[32];
#pragma unroll
        for (int j = 0; j < 32; ++j) w[j] = W[(size_t)(k0 + 8 * j) * 6144];
#pragma unroll
        for (int j = 0; j < 32; ++j)
#pragma unroll
            for (int r = 0; r < 5; ++r) a[r] += sc[r * 1024 + k0 + 8 * j] * w[j]; }
#pragma unroll
    for (int r = 0; r < 5; ++r) part[(wid * 5 + r) * 64 + lane] = a[r];
    __syncthreads();
    if (tid < 320) { const int r = tid >> 6; float s = 0.f;
#pragma unroll
        for (int w = 0; w < 8; ++w) s += part[(w * 5 + r) * 64 + lane];
        ((float*)(P.ws + WS_MOD))[((size_t)l * 5 + r) * 6144 + n0 + lane] = s + P.b_mod[l * 6144 + n0 + lane]; }
    __syncthreads();
}
__device__ __forceinline__ void copy_params(const Ptrs& P, int gt, int ngt) {
    float* par = (float*)(P.ws + WS_PAR);
    for (int i = gt; i < 2048; i += ngt) { par[PR_GMIXPRE + i] = P.g_mix_pre[i]; par[PR_GMIXPOST + i] = P.g_mix_post[i]; par[PR_GFFNPRE + i] = P.g_ffn_pre[i]; par[PR_GFFNPOST + i] = P.g_ffn_post[i]; }
    for (int i = gt; i < 128; i += ngt) { par[PR_GQ + i] = P.g_q[i]; par[PR_GK + i] = P.g_k[i]; }
    for (int i = gt; i < 768; i += ngt) par[PR_GCQ + i] = P.g_cq[i];
    for (int i = gt; i < 512; i += ngt) par[PR_GCKV + i] = P.g_ckv[i];
    for (int i = gt; i < 6144; i += ngt) par[PR_BMG + i] = P.b_mg[i];
    for (int i = gt; i < 8192; i += ngt) par[PR_RW + i] = P.router_w[i];
    for (int i = gt; i < 8; i += ngt) par[PR_RB + i] = P.router_b[i];
    s5::build_a16(P.s5p, par + PR_A16, gt, ngt);
}
__device__ __forceinline__ void rope_tables(const Ptrs& P, int gt, int ngt) {
    float* ca = (float*)(P.ws + WS_ROPE); float* sa = ca + 4096 * 32; float* cb = sa + 4096 * 32; float* sb = cb + 4096 * 16;
    for (int i = gt; i < 4096 * 32; i += ngt) { const int pos = i >> 5, j = i & 31; const float f = expf(-9.210340371976184f * (float)(j & 15) * (1.0f / 16.0f));
        const float ang = (float)(j < 16 ? pos / GRIDW : pos % GRIDW) * f; ca[i] = cosf(ang); sa[i] = sinf(ang); }
    for (int i = gt; i < 4096 * 16; i += ngt) { const int pos = i >> 4, j = i & 15; const float f = expf(-9.210340371976184f * (float)(j & 7) * (1.0f / 8.0f));
        const float ang = (float)(j < 8 ? pos / GRIDW : pos % GRIDW) * f; cb[i] = cosf(ang); sb[i] = sinf(ang); }
}

__device__ __forceinline__ void ld8(const float* p, float (&o)[8]) { const f32x4 a = *(const f32x4*)p, b = *(const f32x4*)(p + 4); o[0] = a[0]; o[1] = a[1]; o[2] = a[2]; o[3] = a[3]; o[4] = b[0]; o[5] = b[1]; o[6] = b[2]; o[7] = b[3]; }
struct TokParams { float gq[8], gk[8], g1[8], g2[8], g3[8]; };
__device__ __forceinline__ TokParams load_tok_params(const unsigned char* ws, int l, int lane) {
    const float* par = (const float*)(ws + WS_PAR); TokParams T; const int d0 = 8 * (lane & 7);
    const int i1 = lane >= 32 ? 8 * (lane - 32) : 0, i2 = lane < 16 ? 256 + 8 * lane : 0, i3 = (lane >= 16 && lane < 48) ? 8 * (lane - 16) : 0;
    ld8(par + PR_GQ + l * 64 + d0, T.gq); ld8(par + PR_GK + l * 64 + d0, T.gk); ld8(par + PR_GCQ + l * 384 + i1, T.g1); ld8(par + PR_GCQ + l * 384 + i2, T.g2); ld8(par + PR_GCKV + l * 256 + i3, T.g3);
    return T;
}
__device__ __forceinline__ void token_row(unsigned char* ws, int l, int row, int lane, const TokParams TP) {
    const float* par = (const float*)(ws + WS_PAR); (void)par;
    const bf16* z = (const bf16*)(ws + P_Z) + (size_t)row * ZW;
    const bool lat = row < NLAT; const int t = row & (SEQ - 1);
    const float* cosA = (const float*)(ws + WS_ROPE) + t * 32; const float* sinA = cosA + 4096 * 32;
    const float* cosB = (const float*)(ws + WS_ROPE) + 2 * 4096 * 32 + t * 16; const float* sinB = cosB + 4096 * 16;
    float v0[8], v1[8], v2[8];
    unpack8(*(const u32x4*)(z + 8 * lane), v0); unpack8(*(const u32x4*)(z + 512 + 8 * lane), v1); unpack8(*(const u32x4*)(z + 1024 + 8 * lane), v2);
    const u32x4 uraw = *(const u32x4*)(z + ZC_U + 8 * lane);
    float ca[8], sa[8], cb8[8], sb8[8];
    ld8(cosA + ((8 * (lane & 7)) & 31), ca); ld8(sinA + ((8 * (lane & 7)) & 31), sa); ld8(cosB + ((8 * ((lane - 48) & 3)) & 15), cb8); ld8(sinB + ((8 * ((lane - 48) & 3)) & 15), sb8);
    { float ss = 0.f;
#pragma unroll
      for (int j = 0; j < 8; ++j) ss += v0[j] * v0[j];
      ss += shfl_xor_l(ss, 1, lane); ss += shfl_xor_l(ss, 2, lane); ss += shfl_xor_l(ss, 4, lane);
      const float rs = rsqrtf(ss * (1.0f / 64.0f) + EPS); const int d0 = 8 * (lane & 7); float o[8]; const float (&gq)[8] = TP.gq;
#pragma unroll
      for (int j = 0; j < 8; ++j) v0[j] = v0[j] * rs * gq[j];
#pragma unroll
      for (int j = 0; j < 8; ++j) { const float other = shfl_xor_l(v0[j], 4, lane); const float c = ca[j], s = sa[j];
          o[j] = lat ? ((d0 < 32) ? v0[j] * c - other * s : other * s + v0[j] * c) : v0[j];
          o[j] *= 0.125f * LOG2E; }
      *(u32x4*)((bf16*)(ws + P_QA) + (size_t)row * 512 + 8 * lane) = pack8(o); }
    { float ss = 0.f;
#pragma unroll
      for (int j = 0; j < 8; ++j) ss += v1[j] * v1[j];
      float ssk = ss; ssk += shfl_xor_l(ssk, 1, lane); ssk += shfl_xor_l(ssk, 2, lane); ssk += shfl_xor_l(ssk, 4, lane);
      float ss2 = 0.f;
#pragma unroll
      for (int j = 0; j < 8; ++j) ss2 += v2[j] * v2[j];
      const float sq = wave_sum((lane >= 32 ? ss : 0.f) + (lane < 16 ? ss2 : 0.f));
      const float skv = wave_sum((lane >= 16 && lane < 48) ? ss2 : 0.f);
      const float rq = rsqrtf(sq * (1.0f / 384.0f) + EPS), rkv = rsqrtf(skv * (1.0f / 256.0f) + EPS);
      { const float rs = rsqrtf(ssk * (1.0f / 64.0f) + EPS); const int d0 = 8 * (lane & 7); float kk[8], o[8]; const float (&gk)[8] = TP.gk;
#pragma unroll
        for (int j = 0; j < 8; ++j) kk[j] = v1[j] * rs * gk[j];
#pragma unroll
        for (int j = 0; j < 8; ++j) { const float other = shfl_xor_l(kk[j], 4, lane); const float c = ca[j], s = sa[j];
            o[j] = lat ? ((d0 < 32) ? kk[j] * c - other * s : other * s + kk[j] * c) : kk[j]; }
        if (lane < 16) *(u32x4*)((bf16*)(ws + P_KA) + (size_t)row * 128 + 8 * lane) = pack8(o); }
      if (lane >= 16 && lane < 32) *(u32x4*)((bf16*)(ws + P_VA) + (size_t)row * 128 + 8 * (lane - 16)) = pack8(v1);
      { float o[8]; const float (&g1)[8] = TP.g1; const float (&g2)[8] = TP.g2; const float (&g3)[8] = TP.g3;
        const int i1 = lane >= 32 ? 8 * (lane - 32) : 0, i2 = lane < 16 ? 256 + 8 * lane : 0, i3 = (lane >= 16 && lane < 48) ? 8 * (lane - 16) : 0;
#pragma unroll
        for (int j = 0; j < 8; ++j) o[j] = v1[j] * rq * g1[j];
        if (lane >= 32) *(u32x4*)((bf16*)(ws + P_CQN) + (size_t)row * 384 + i1) = pack8(o);
#pragma unroll
        for (int j = 0; j < 8; ++j) o[j] = v2[j] * rq * g2[j];
        if (lane < 16) *(u32x4*)((bf16*)(ws + P_CQN) + (size_t)row * 384 + i2) = pack8(o);
#pragma unroll
        for (int j = 0; j < 8; ++j) o[j] = v2[j] * rkv * g3[j];
        if (lane >= 16 && lane < 48) *(u32x4*)((bf16*)(ws + P_CKVN) + (size_t)row * 256 + i3) = pack8(o); }
      { float o[8]; const int i0 = 8 * ((lane - 48) & 3);
#pragma unroll
        for (int j = 0; j < 8; ++j) { const float other = shfl_xor_l(v2[j], 2, lane); const float c = cb8[j], s = sb8[j];
            o[j] = lat ? ((i0 < 16) ? v2[j] * c - other * s : other * s + v2[j] * c) : v2[j]; }
        if (lane >= 48 && lane < 52) *(u32x4*)((bf16*)(ws + P_KRR) + (size_t)row * 32 + i0) = pack8(o); }
    }
    { const int b = lat ? row >> 12 : (row - NLAT) >> 8, pos = lat ? CTXL + t : (row - NLAT) & 255, g = lane >> 1;
      *(u32x4*)((bf16*)(ws + P_UG) + ((size_t)(b * 32 + g) * LPOS + pos) * 16 + 8 * (lane & 1)) = uraw; }
}

struct ResidArgs {
    int mode;
    const float* y; const float* g_post; int gate_chunk;
    const float* g_pre; int shift_chunk;
    bool dry;
    float ysc;
    bf16* hout; int l_mod; bool h8; unsigned char* hout8;
    int l_gate; bool route;
};
struct RowParams { f32x4 gp[4], gt[4], gq[4], sh[4], sc[4]; };
__device__ __forceinline__ void load_row_params(RowParams& Q, const unsigned char* ws, const ResidArgs& R, int b, int lane) {
    const float* mod = (const float*)(ws + WS_MOD);
    const float* gate = mod + ((size_t)R.l_gate * 5 + b) * 6144 + R.gate_chunk * 1024; const float* shift = mod + ((size_t)R.l_mod * 5 + b) * 6144 + R.shift_chunk * 1024; const float* scale = shift + 1024;
#pragma unroll
    for (int j = 0; j < 4; ++j) { const int c = 4 * lane + 256 * j; const f32x4 z = {0.f, 0.f, 0.f, 0.f};
        Q.gp[j] = R.mode != 0 ? *(const f32x4*)(R.g_post + c) : z; Q.gt[j] = R.mode != 0 ? *(const f32x4*)(gate + c) : z;
        Q.gq[j] = R.hout ? *(const f32x4*)(R.g_pre + c) : z; Q.sh[j] = R.hout ? *(const f32x4*)(shift + c) : z; Q.sc[j] = R.hout ? *(const f32x4*)(scale + c) : z; }
}
template <bool USEQ> __device__ __forceinline__ void resid_row_impl(unsigned char* ws, float* outp, const float* xin, const float* ctxin, const ResidArgs R, int row, int lane, const LAS int* tb, const RowParams Q) {
    const float* par = (const float*)(ws + WS_PAR);
    const bool lat = row < NLAT; const int b = lat ? row >> 12 : (row - NLAT) >> 8, mr = lat ? b : 4;
    const float* mod = (const float*)(ws + WS_MOD);
    float* latp = lat ? outp + (size_t)row * 1024 : (float*)(ws + WS_LATC) + (size_t)(row - NLAT) * 1024;
    f32x4 v[4];
    if (R.mode == 0) { const float* src = lat ? xin + (size_t)row * 1024 : ctxin + (size_t)(row - NLAT) * 1024;
#pragma unroll
        for (int j = 0; j < 4; ++j) v[j] = *(const f32x4*)(src + 4 * lane + 256 * j);
    } else {
        f32x4 yv[4];
        if (R.mode == 1) {
#pragma unroll
            for (int j = 0; j < 4; ++j) yv[j] = *(const f32x4*)(R.y + (size_t)row * 1024 + 4 * lane + 256 * j) * R.ysc;
        } else if (R.mode == 3) {
            const bf16* yb = (const bf16*)R.y + (size_t)row * 1024;
#pragma unroll
            for (int j = 0; j < 4; ++j) { const u32x2 a = *(const u32x2*)(yb + 4 * lane + 256 * j);
                yv[j] = (f32x4){bf2f(a.x & 0xffffu), bf2f(a.x >> 16), bf2f(a.y & 0xffffu), bf2f(a.y >> 16)} * R.ysc; }
        } else {
            const int* ti = (const int*)(ws + WS_LIST) + 8 * 16384 + row * 8;
            const int e0 = ti[0], p0 = ti[1], e1 = ti[2], p1 = ti[3]; const float w0 = __int_as_float(ti[4]) * R.ysc, w1 = __int_as_float(ti[5]) * R.ysc;
            const bf16* f0 = (const bf16*)(ws + P_Y2) + ((size_t)tb[8 + e0] * 256 + p0) * 1024; const bf16* f1 = (const bf16*)(ws + P_Y2) + ((size_t)tb[8 + e1] * 256 + p1) * 1024;
#pragma unroll
            for (int j = 0; j < 4; ++j) { const u32x2 a = *(const u32x2*)(f0 + 4 * lane + 256 * j), c = *(const u32x2*)(f1 + 4 * lane + 256 * j);
                yv[j][0] = w0 * bf2f(a.x & 0xffffu) + w1 * bf2f(c.x & 0xffffu); yv[j][1] = w0 * bf2f(a.x >> 16) + w1 * bf2f(c.x >> 16);
                yv[j][2] = w0 * bf2f(a.y & 0xffffu) + w1 * bf2f(c.y & 0xffffu); yv[j][3] = w0 * bf2f(a.y >> 16) + w1 * bf2f(c.y >> 16); }
        }
        float ss = 0.f;
#pragma unroll
        for (int j = 0; j < 4; ++j) ss += (yv[j][0] * yv[j][0] + yv[j][1] * yv[j][1]) + (yv[j][2] * yv[j][2] + yv[j][3] * yv[j][3]);
        const float rs = rsqrtf(wave_sum(ss) * (1.0f / 1024.0f) + EPS);
        const float* gate = mod + ((size_t)R.l_gate * 5 + mr) * 6144 + R.gate_chunk * 1024;
#pragma unroll
        for (int j = 0; j < 4; ++j) { const int c = 4 * lane + 256 * j; const f32x4 lv = *(const f32x4*)(latp + c), gp = USEQ ? Q.gp[j] : *(const f32x4*)(R.g_post + c), gt = USEQ ? Q.gt[j] : *(const f32x4*)(gate + c);
            v[j] = lv + gt * (yv[j] * rs * gp); }
    }
    if (!R.dry) {
#pragma unroll
    for (int j = 0; j < 4; ++j) *(f32x4*)(latp + 4 * lane + 256 * j) = v[j]; }
    if (R.hout == nullptr) return;
    float ss = 0.f;
#pragma unroll
    for (int j = 0; j < 4; ++j) ss += (v[j][0] * v[j][0] + v[j][1] * v[j][1]) + (v[j][2] * v[j][2] + v[j][3] * v[j][3]);
    const float rs = rsqrtf(wave_sum(ss) * (1.0f / 1024.0f) + EPS);
    const float* shift = mod + ((size_t)R.l_mod * 5 + mr) * 6144 + R.shift_chunk * 1024; const float* scale = shift + 1024;
    f32x4 hv[4];
#pragma unroll
    for (int j = 0; j < 4; ++j) { const int c = 4 * lane + 256 * j; const f32x4 gp = USEQ ? Q.gq[j] : *(const f32x4*)(R.g_pre + c), sh = USEQ ? Q.sh[j] : *(const f32x4*)(shift + c), sc = USEQ ? Q.sc[j] : *(const f32x4*)(scale + c);
        hv[j] = (v[j] * rs * gp) * (1.0f + sc) + sh;
        if (R.dry) { if (hv[j][0] == 123.456f) *(float*)(ws + WS_CTL + 64) = 1.f; continue; }
        if (R.hout8) *(unsigned*)(R.hout8 + (size_t)row * 1024 + c) = pg8::pk_fp8x4(hv[j][0] * F8_HSCALE, hv[j][1] * F8_HSCALE, hv[j][2] * F8_HSCALE, hv[j][3] * F8_HSCALE);
        if (R.h8) *(unsigned*)((unsigned char*)R.hout + (size_t)row * 1024 + c) = pg8::pk_fp8x4(hv[j][0] * F8_HSCALE, hv[j][1] * F8_HSCALE, hv[j][2] * F8_HSCALE, hv[j][3] * F8_HSCALE);
        else *(u32x2*)(R.hout + (size_t)row * 1024 + c) = (u32x2){pk2(hv[j][0], hv[j][1]), pk2(hv[j][2], hv[j][3])}; }
    if (R.route) {
        float lg[8];
#pragma unroll
        for (int e = 0; e < 8; ++e) lg[e] = 0.f;
#pragma unroll
        for (int j = 0; j < 4; ++j)
#pragma unroll
            for (int i = 0; i < 4; ++i) { const float* rw = par + PR_RW + (size_t)(4 * lane + 256 * j + i) * 8; const f32x4 r0 = *(const f32x4*)rw, r1 = *(const f32x4*)(rw + 4); const float hvv = hv[j][i];
                lg[0] += hvv * r0[0]; lg[1] += hvv * r0[1]; lg[2] += hvv * r0[2]; lg[3] += hvv * r0[3]; lg[4] += hvv * r1[0]; lg[5] += hvv * r1[1]; lg[6] += hvv * r1[2]; lg[7] += hvv * r1[3]; }
        { const bool b0_ = lane & 1, b1_ = lane & 2, b2_ = lane & 4; float x[4], y[2], z;
#pragma unroll
          for (int k = 0; k < 4; ++k) x[k] = (b0_ ? lg[2 * k + 1] : lg[2 * k]) + shfl_xor_l(b0_ ? lg[2 * k] : lg[2 * k + 1], 1, lane);
#pragma unroll
          for (int k = 0; k < 2; ++k) y[k] = (b1_ ? x[2 * k + 1] : x[2 * k]) + shfl_xor_l(b1_ ? x[2 * k] : x[2 * k + 1], 2, lane);
          z = (b2_ ? y[1] : y[0]) + shfl_xor_l(b2_ ? y[0] : y[1], 4, lane);
          z += shfl_xor_l(z, 8, lane); z += shfl_xor_l(z, 16, lane); z += shfl_xor_l(z, 32, lane);
#pragma unroll
          for (int e = 0; e < 8; ++e) lg[e] = __int_as_float(__builtin_amdgcn_readlane(__float_as_int(z), e)) + par[PR_RB + e]; }
        int e0 = 0; float b0 = lg[0];
#pragma unroll
        for (int e = 1; e < 8; ++e) if (lg[e] > b0) { b0 = lg[e]; e0 = e; }
        int e1 = -1; float b1 = -3.0e38f;
#pragma unroll
        for (int e = 0; e < 8; ++e) if (e != e0 && lg[e] > b1) { b1 = lg[e]; e1 = e; }
        if (lane == 0 && !R.dry) {
            const float w0 = 1.0f / (1.0f + expf(b1 - b0)), w1 = 1.0f - w0;
            unsigned* cnt = (unsigned*)(ws + WS_CTL) + CW_CNT;
            const int p0 = (int)atomicAdd(cnt + CNT_STRIDE * e0, 1u), p1 = (int)atomicAdd(cnt + CNT_STRIDE * e1, 1u);
            int* list = (int*)(ws + WS_LIST); list[e0 * 16384 + p0] = row; list[e1 * 16384 + p1] = row;
            int* ti = list + 8 * 16384 + row * 8; ti[0] = e0; ti[1] = p0; ti[2] = e1; ti[3] = p1; ti[4] = __float_as_int(w0); ti[5] = __float_as_int(w1);
        }
    }
}
__device__ __forceinline__ void resid_row(unsigned char* ws, float* outp, const float* xin, const float* ctxin, const ResidArgs R, int row, int lane, const LAS int* tb) {
    resid_row_impl<false>(ws, outp, xin, ctxin, R, row, lane, tb, RowParams{}); }
__device__ __forceinline__ void resid_row(unsigned char* ws, float* outp, const float* xin, const float* ctxin, const ResidArgs R, int row, int lane, const LAS int* tb, const RowParams& Q) {
    resid_row_impl<true>(ws, outp, xin, ctxin, R, row, lane, tb, Q); }

#if MK_DEBUG
namespace dbg {
__device__ __forceinline__ unsigned hash(unsigned a, unsigned b) { unsigned x = a * 0x9E3779B1u ^ (b + 0x7F4A7C15u) * 0x85EBCA77u; x ^= x >> 15; x *= 0xC2B2AE3Du; x ^= x >> 13; x *= 0x27D4EB2Fu; x ^= x >> 16; return x; }
__device__ __forceinline__ float rbf(float f) { return bf2f(f2bf(f)); }
__device__ __forceinline__ void add(unsigned char* ws, int k, float got, float ref, int lane) {
    if (lane == 0) { float* d = (float*)(ws + WS_CTL) + CW_DBG + 2 * k; const float df = got - ref; atomicAdd(d, (df == df && fabsf(df) < 1e18f) ? df * df : 1e30f); atomicAdd(d + 1, ref * ref); }
}
__device__ __forceinline__ float dot_aw(const bf16* a, const float* w, size_t wstride, int K, int lane) { float s = 0.f; for (int k = lane; k < K; k += 64) s += bf2f(a[k]) * rbf(w[(size_t)k * wstride]); return wave_sum(s); }

__device__ __forceinline__ float angA(int t, int i) { return (float)(i < 16 ? t / 64 : t % 64) * powf(10000.f, -(float)(2 * (i & 15)) / 32.f); }
__device__ __forceinline__ float angB(int t, int i) { return (float)(i < 8 ? t / 64 : t % 64) * powf(10000.f, -(float)(2 * (i & 7)) / 16.f); }
__device__ __forceinline__ void chk_mod(unsigned char* ws, const float* const* in, int gw, int ngw, int lane) {
    for (int s = gw; s < 1024; s += ngw) { const unsigned hh = hash(s, 1); const int l = hh & 1, r = (hh >> 1) % 5, n = (hh >> 8) % 6144; float a = 0.f;
        for (int k = lane; k < 1024; k += 64) { const float c = r < 4 ? in[1][r * 1024 + k] : in[3][k]; a += c / (1.f + expf(-c)) * in[4][((size_t)l * 1024 + k) * 6144 + n]; }
        a = wave_sum(a) + in[5][l * 6144 + n]; add(ws, 0, ((const float*)(ws + WS_MOD))[((size_t)l * 5 + r) * 6144 + n], a, lane); }
}
__device__ __forceinline__ void chk_weights(unsigned char* ws, const float* const* in, int gw, int ngw, int lane) {
    for (int s = gw * 64 + lane; s < 65536; s += ngw * 64) { const unsigned hh = hash(s, 2), h2 = hash(s, 3); const int l = hh & 1; float got = 0.f, ref = 0.f; const int which = (hh >> 1) % 12;
        if (which == 0) { const int j = (hh >> 8) % 1952, k = h2 % 1024; int dr = j < 512 ? j : j < 896 ? 768 + (j - 512) : j < 1024 ? 512 + (j - 896) : j < 1152 ? 640 + (j - 1024) : j < 1440 ? j : 1536 + (j - 1440);
            got = bf2f(((const bf16*)(ws + WS_W1T))[((size_t)l * 2048 + dr) * 1024 + k]); ref = rbf(in[10][((size_t)l * 1024 + k) * 1952 + j]); }
        else if (which == 1) { const int j = (hh >> 8) % 3072, k = h2 % 1024; got = bf2f(((const bf16*)(ws + WS_WMGT))[((size_t)l * 3072 + j) * 1024 + k]); ref = rbf(in[27][((size_t)l * 1024 + k) * 3072 + j]); }
        else if (which == 2) { const int j = (hh >> 8) % 768, k = h2 % 384, hd = j / 96, e = j % 96; int de = e; if (e >= 64) { const int i = e - 64; de = 64 + (i < 16 ? 8 * (i >> 2) + (i & 3) : 8 * ((i - 16) >> 2) + 4 + ((i - 16) & 3)); }
            got = bf2f(((const bf16*)(ws + WS_WUQT))[((size_t)l * 768 + hd * 96 + de) * 384 + k]); ref = rbf(in[15][((size_t)l * 384 + k) * 768 + j]); }
        else if (which == 3) { const int j = (hh >> 8) % 1024, k = h2 % 256; got = bf2f(((const bf16*)(ws + WS_WUKVT))[((size_t)l * 1024 + j) * 256 + k]); ref = rbf(in[16][((size_t)l * 256 + k) * 1024 + j]); }
        else if (which == 4) { const int j = (hh >> 8) % 1024, k = h2 % 512; const int jj = j < 512 ? j : j - 512; const int dr = 256 * (jj / 128) + (j < 512 ? 0 : 128) + jj % 128;
            got = bf2f(((const bf16*)(ws + WS_WGLUT))[((size_t)l * 1024 + dr) * 512 + k]); ref = rbf(in[25][((size_t)l * 512 + k) * 1024 + j]); }
        else if (which == 5) { const int n = (hh >> 4) % 3, j = (hh >> 8) % 1024, k = h2 % 512; got = bf2f(((const bf16*)(ws + WS_WBT))[(((size_t)l * 3 + n) * 1024 + j) * 512 + k]); ref = rbf(in[26][(((size_t)l * 3 + n) * 512 + k) * 1024 + j]); }
        else if (which == 6) { const int j = (hh >> 8) % 1024, k = h2 % 1024; got = bf2f(((const bf16*)(ws + WS_WOUTT))[((size_t)l * 1024 + j) * 1024 + k]); ref = rbf(in[29][((size_t)l * 1024 + k) * 1024 + j]); }
        else if (which == 7) { const int j = (hh >> 8) % 2816, k = h2 % 1024, sec = (hh >> 5) & 1; const int dr = 256 * (j / 128) + sec * 128 + j % 128;
            got = bf2f(((const bf16*)(ws + WS_WF1T))[(size_t)dr * 1024 + k]); ref = rbf(in[sec ? 31 : 30][(size_t)k * 2816 + j]); }
        else if (which == 8) { const int j = (hh >> 8) % 1024, k = h2 % 2816; got = bf2f(((const bf16*)(ws + WS_WF2T))[(size_t)j * 2816 + k]); ref = rbf(in[32][(size_t)k * 1024 + j]); }
        else if (which <= 10) { const int e = (hh >> 5) & 7, j = (hh >> 8) % 2816, k = h2 % 1024, sec = which - 9; const int dr = 256 * (j / 128) + sec * 128 + j % 128;
            got = bf2f(((const bf16*)(ws + WS_WM1T))[((size_t)e * 5632 + dr) * 1024 + k]); ref = rbf(in[sec ? 36 : 35][((size_t)e * 1024 + k) * 2816 + j]); }
        else { const int e = (hh >> 5) & 7, j = (hh >> 8) % 1024, k = h2 % 2816; got = bf2f(((const bf16*)(ws + WS_WM2T))[((size_t)e * 1024 + j) * 2816 + k]); ref = rbf(in[37][((size_t)e * 2816 + k) * 1024 + j]); }
        float* d = (float*)(ws + WS_CTL) + CW_DBG + 2 * 1; const float df = got - ref; atomicAdd(d, (df == df) ? df * df : 1e30f); atomicAdd(d + 1, ref * ref); }
}
__device__ __forceinline__ void chk_h(unsigned char* ws, const float* const* in, const float* outp, int k, int l_mod, int shift_chunk, const float* g_pre, int nrows, int gw, int ngw, int lane) {
    for (int s = gw; s < 512; s += ngw) { const int row = hash(s, 10 + k) % nrows; const bool lat = row < NLAT; const int mr = lat ? row >> 12 : 4;
        const float* latp = lat ? outp + (size_t)row * 1024 : (const float*)(ws + WS_LATC) + (size_t)(row - NLAT) * 1024; float ss = 0.f;
        for (int c = lane; c < 1024; c += 64) ss += latp[c] * latp[c];
        const float rs = rsqrtf(wave_sum(ss) / 1024.f + EPS); const float* mod = (const float*)(ws + WS_MOD) + ((size_t)l_mod * 5 + mr) * 6144 + shift_chunk * 1024;
        const int c = hash(s, 77) % 1024; const float ref = latp[c] * rs * g_pre[c] * (1.f + mod[1024 + c]) + mod[c];
        add(ws, k, bf2f(((const bf16*)(ws + P_H))[(size_t)row * 1024 + c]), ref, lane); }
}
template <class F> __device__ __forceinline__ void chk_gemm(unsigned char* ws, int k, const bf16* A, int lda, const float* W, int N, int K, int nrows, int ncols, F fin, int gw, int ngw, int lane) {
    for (int s = gw; s < 1024; s += ngw) { const unsigned hh = hash(s, 20 + k); const int row = hh % nrows, col = (hh >> 16) % ncols;
        const float ref = dot_aw(A + (size_t)row * lda, W + col, N, K, lane); float got, rr; fin(row, col, ref, got, rr); add(ws, k, got, rr, lane); }
}
__device__ __forceinline__ void chk_tok(unsigned char* ws, int k, int l, int gw, int ngw, int lane) {
    const float* par = (const float*)(ws + WS_PAR);
    for (int s = gw; s < 1024; s += ngw) { const unsigned hh = hash(s, 40 + k); const int row = hh % MALL; const bool lat = row < NLAT; const int t = row & 4095; const bf16* z = (const bf16*)(ws + P_Z) + (size_t)row * ZW;
        const int which = (hh >> 20) % 6; float got = 0.f, ref = 0.f;
        if (which == 0 || which == 1) { const int nh = which == 0 ? 8 : 2, hd = (hh >> 24) % nh, d = (hh >> 14) & 63; const bf16* x = z + (which == 0 ? 0 : ZC_KG) + hd * 64; const float* g = par + (which == 0 ? PR_GQ : PR_GK) + l * 64;
            float ss = 0.f; for (int i = 0; i < 64; ++i) ss += bf2f(x[i]) * bf2f(x[i]); const float rs = rsqrtf(ss / 64.f + EPS);
            const int i = d & 31; const float x1 = bf2f(x[i]) * rs * g[i], x2 = bf2f(x[i + 32]) * rs * g[i + 32]; float o = d < 32 ? x1 : x2;
            if (lat) { const float an = angA(t, i), c = cosf(an), sn = sinf(an); o = d < 32 ? x1 * c - x2 * sn : x1 * sn + x2 * c; }
            if (which == 0) { o *= 0.125f * LOG2E; got = bf2f(((const bf16*)(ws + P_QA))[(size_t)row * 512 + hd * 64 + d]); } else got = bf2f(((const bf16*)(ws + P_KA))[(size_t)row * 128 + hd * 64 + d]);
            ref = o; }
        else if (which == 2) { const int i = (hh >> 8) % 384; float ss = 0.f; for (int j = 0; j < 384; ++j) ss += bf2f(z[ZC_CQ + j]) * bf2f(z[ZC_CQ + j]);
            ref = bf2f(z[ZC_CQ + i]) * rsqrtf(ss / 384.f + EPS) * par[PR_GCQ + l * 384 + i]; got = bf2f(((const bf16*)(ws + P_CQN))[(size_t)row * 384 + i]); }
        else if (which == 3) { const int i = (hh >> 8) % 256; float ss = 0.f; for (int j = 0; j < 256; ++j) ss += bf2f(z[ZC_CKV + j]) * bf2f(z[ZC_CKV + j]);
            ref = bf2f(z[ZC_CKV + i]) * rsqrtf(ss / 256.f + EPS) * par[PR_GCKV + l * 256 + i]; got = bf2f(((const bf16*)(ws + P_CKVN))[(size_t)row * 256 + i]); }
        else if (which == 4) { const int d = (hh >> 8) & 31, i = d & 15; const float x1 = bf2f(z[ZC_KR + i]), x2 = bf2f(z[ZC_KR + 16 + i]); float o = d < 16 ? x1 : x2;
            if (lat) { const float an = angB(t, i), c = cosf(an), sn = sinf(an); o = d < 16 ? x1 * c - x2 * sn : x1 * sn + x2 * c; } ref = o; got = bf2f(((const bf16*)(ws + P_KRR))[(size_t)row * 32 + d]); }
        else { const int c = (hh >> 8) & 511, b = lat ? row >> 12 : (row - NLAT) >> 8, pos = lat ? 256 + t : (row - NLAT) & 255; const int wv = (hh >> 19) & 1;
            if (wv) { ref = bf2f(z[ZC_U + c]); got = bf2f(((const bf16*)(ws + P_UG))[((size_t)(b * 32 + (c >> 4)) * LPOS + pos) * 16 + (c & 15)]); }
            else { ref = bf2f(z[ZC_VG + (c & 127)]); got = bf2f(((const bf16*)(ws + P_VA))[(size_t)row * 128 + (c & 127)]); } }
        add(ws, k, got, ref, lane); }
}
__device__ __forceinline__ void chk_attn(unsigned char* ws, int k, bool lastl, int gw, int ngw, int lane) {
    for (int s = gw; s < 256; s += ngw) { const unsigned hh = hash(s, 60 + k); const int typ = hh & 1, b = (hh >> 1) & 3, h = (hh >> 3) & 7, d = (hh >> 6) & 63; const bool cq = !lastl && ((hh >> 12) & 7) == 0;
        const int qrow = cq ? NLAT + b * 256 + ((hh >> 16) & 255) : b * 4096 + ((hh >> 16) & 4095); const int nk = cq ? 256 : LPOS, DKK = typ ? 96 : 64;
        const bf16* q = typ ? (const bf16*)(ws + P_QB) + (size_t)qrow * 768 + h * 96 : (const bf16*)(ws + P_QA) + (size_t)qrow * 512 + h * 64;
        float m = -1e30f, l = 0.f, o = 0.f;
        for (int p = lane; p < nk; p += 64) { const int kr = pos_row(b, p); float sc = 0.f;
            if (typ) { const bf16* kk = (const bf16*)(ws + P_KB) + (size_t)kr * 512 + h * 64; const bf16* k2 = (const bf16*)(ws + P_KRR) + (size_t)kr * 32;
                for (int i = 0; i < 64; ++i) sc += bf2f(q[i]) * bf2f(kk[i]); for (int i = 0; i < 32; ++i) sc += bf2f(q[64 + i]) * bf2f(k2[i]); }
            else { const bf16* kk = (const bf16*)(ws + P_KA) + (size_t)kr * 128 + (h >> 2) * 64; for (int i = 0; i < 64; ++i) sc += bf2f(q[i]) * bf2f(kk[i]); }
            const float v = typ ? bf2f(((const bf16*)(ws + P_VB))[(size_t)kr * 512 + h * 64 + d]) : bf2f(((const bf16*)(ws + P_VA))[(size_t)kr * 128 + (h >> 2) * 64 + d]);
            const float mn = fmaxf(m, sc), al = exp2f(m - mn), pp = exp2f(sc - mn); l = l * al + pp; o = o * al + pp * v; m = mn; (void)DKK; }
        float mg = m; for (int x = 1; x < 64; x <<= 1) mg = fmaxf(mg, __shfl_xor(mg, x));
        const float f = exp2f(m - mg); l = wave_sum(l * f); o = wave_sum(o * f);
        add(ws, k, bf2f(((const bf16*)(ws + P_YBR))[(size_t)qrow * 1536 + typ * 512 + h * 64 + d]), o / l, lane); }
}
__device__ __forceinline__ void chk_s5(unsigned char* ws, const float* const* in, int k, int l, bool lastl, int gw, int ngw, int lane) {
    for (int s = gw; s < 512; s += ngw) { const unsigned hh = hash(s, 80 + k); const int b = hh & 3, g = (hh >> 2) & 31, hp = (hh >> 7) & 15; int psel = (hh >> 12) % LPOS; if (lastl && psel < 256) psel += 256;
        const bf16* U = (const bf16*)(ws + P_UG) + (size_t)(b * 32 + g) * LPOS * 16; float yf[2], yl[2];
        for (int dir = 0; dir < 2; ++dir) { const int pi = ((l * 2 + dir) * 32 + g) * 64 + lane;
            const float lr = fminf(in[17][pi], -1e-4f), li = in[18][pi], dt = expf(in[19][(l * 2 + dir) * 32 + g]); const float mag = expf(lr * dt), abr = mag * cosf(li * dt), abi = mag * sinf(li * dt), den = lr * lr + li * li;
            const float fr = ((abr - 1.f) * lr + abi * li) / den, fi = (abi * lr - (abr - 1.f) * li) / den; float bbr[16], bbi[16];
            _Pragma("unroll") for (int h = 0; h < 16; ++h) { const float br = in[20][(size_t)pi * 16 + h], bi = in[21][(size_t)pi * 16 + h]; bbr[h] = fr * br - fi * bi; bbi[h] = fr * bi + fi * br; }
            float xr = 0.f, xi = 0.f, zr = 0.f, zi = 0.f;
            for (int st = 0; st < LPOS; ++st) { const int p = dir == 0 ? st : (st < 256 ? 255 - st : LPOS + 255 - st); float vr = 0.f, vi = 0.f;
                _Pragma("unroll") for (int h = 0; h < 16; ++h) { const float u = bf2f(U[(size_t)p * 16 + h]); vr += bbr[h] * u; vi += bbi[h] * u; }
                if ((dir == 0 && (p & 15) == 0) || (dir == 1 && (p & 15) == 15)) { zr = 0.f; zi = 0.f; }
                const float nr = abr * xr - abi * xi + vr, ni = abr * xi + abi * xr + vi; xr = nr; xi = ni;
                const float mr = abr * zr - abi * zi + vr, mi = abr * zi + abi * zr + vi; zr = mr; zi = mi;
                if (p == psel) break; }
            const size_t ci = ((size_t)((l * 2 + dir) * 32 + g) * 16 + hp) * 64 + lane; yf[dir] = wave_sum(in[22][ci] * xr - in[23][ci] * xi); yl[dir] = wave_sum(in[22][ci] * zr - in[23][ci] * zi); }
        const float du = in[24][(l * 32 + g) * 16 + hp] * bf2f(U[(size_t)psel * 16 + hp]); const float got = bf2f(((const bf16*)(ws + P_AGLU))[(size_t)pos_row(b, psel) * 512 + g * 16 + hp]);
        auto ge = [](float y) { const float u2 = 0.7978845608028654f * (y + 0.044715f * y * y * y); return 0.5f * y * (1.f + tanhf(u2)); };
        add(ws, k, got, ge(du + yf[0] + yf[1]), lane);
        if (l == 0) { add(ws, 30, got, ge(du + yf[0] + yl[1]), lane); add(ws, 31, got, ge(du + yl[0] + yf[1]), lane); add(ws, 32, got, ge(du + yl[0] + yl[1]), lane); add(ws, 33, got, ge(du), lane); } }
}
__device__ __forceinline__ void chk_s5m(unsigned char* ws, const float* const* in, int k, int gw, int ngw, int lane) {
    for (int s = gw; s < 2048; s += ngw) { const unsigned hh = hash(s, 700), h2 = hash(s, 701); const int l = hh & 1, g = (hh >> 1) & 31, which = (hh >> 6) % 5;
        const bf16* M = (const bf16*)(ws + WS_S5M) + (size_t)(l * 32 + g) * 196608; float got = 0.f, ref = 0.f;
        const int t = (h2 >> 0) & 15, hp = (h2 >> 4) & 15, sx = (h2 >> 8) & 15, h = (h2 >> 12) & 15, p2 = (h2 >> 16) & 63, im = (h2 >> 22) & 1, dsel = (h2 >> 23) & 1;
        float cre[2], cim[2], are[2], aim[2], bre[2], bim[2], lrr[2], lii[2], dtt[2];
        _Pragma("unroll") for (int dir = 0; dir < 2; ++dir) { const int pi = ((l * 2 + dir) * 32 + g) * 64 + lane; lrr[dir] = fminf(in[17][pi], -1e-4f); lii[dir] = in[18][pi]; dtt[dir] = expf(in[19][(l * 2 + dir) * 32 + g]);
            const float mag = expf(lrr[dir] * dtt[dir]); are[dir] = mag * cosf(lii[dir] * dtt[dir]); aim[dir] = mag * sinf(lii[dir] * dtt[dir]);
            const float den = lrr[dir] * lrr[dir] + lii[dir] * lii[dir], fr = ((are[dir] - 1.f) * lrr[dir] + aim[dir] * lii[dir]) / den, fi = (aim[dir] * lrr[dir] - (are[dir] - 1.f) * lii[dir]) / den;
            const float br = in[20][(size_t)pi * 16 + h], bi = in[21][(size_t)pi * 16 + h]; bre[dir] = fr * br - fi * bi; bim[dir] = fr * bi + fi * br;
            const size_t ci = ((size_t)((l * 2 + dir) * 32 + g) * 16 + hp) * 64 + lane; cre[dir] = in[22][ci]; cim[dir] = in[23][ci]; }
        if (which == 0) {
            float acc = 0.f;
            _Pragma("unroll") for (int dir = 0; dir < 2; ++dir) { const int j = dir == 0 ? t - sx : sx - t; if (j >= 0) { float pr = 1.f, pq = 0.f; for (int e = 0; e < j; ++e) { const float nr = pr * are[dir] - pq * aim[dir], nq = pr * aim[dir] + pq * are[dir]; pr = nr; pq = nq; }
                    const float tr = cre[dir] * pr - cim[dir] * pq, tq = cre[dir] * pq + cim[dir] * pr; acc += tr * bre[dir] - tq * bim[dir]; } }
            ref = wave_sum(acc) + ((t == sx && h == hp) ? in[24][(l * 32 + g) * 16 + h] : 0.f); got = bf2f(M[(size_t)(16 * t + hp) * 256 + 16 * sx + h]); }
        else if (which <= 2) {
            const int dir = which - 1, ex = dir == 0 ? t + 1 : 16 - t; float pr = 1.f, pq = 0.f; for (int e = 0; e < ex; ++e) { const float nr = pr * are[dir] - pq * aim[dir], nq = pr * aim[dir] + pq * are[dir]; pr = nr; pq = nq; }
            const float tr = cre[dir] * pr - cim[dir] * pq, tq = cre[dir] * pq + cim[dir] * pr; const float mine = im ? -tq : tr; ref = __shfl(mine, p2); got = bf2f(M[(dir == 0 ? 65536 : 98304) + (size_t)(16 * t + hp) * 128 + 2 * p2 + im]); }
        else {
            const int dir = which - 3, ex = dir == 0 ? 15 - sx : sx; float pr = 1.f, pq = 0.f; for (int e = 0; e < ex; ++e) { const float nr = pr * are[dir] - pq * aim[dir], nq = pr * aim[dir] + pq * are[dir]; pr = nr; pq = nq; }
            const float tr = pr * bre[dir] - pq * bim[dir], tq = pr * bim[dir] + pq * bre[dir]; const float mine = im ? tq : tr; ref = __shfl(mine, p2); got = bf2f(M[(dir == 0 ? 131072 : 163840) + (size_t)(2 * p2 + im) * 256 + 16 * sx + h]); }
        (void)dsel; add(ws, which == 0 ? ((t == sx && h == hp) ? k : 35) : which <= 2 ? 36 : 37, got, ref, lane); }
}

__device__ __forceinline__ void chk_s5x(unsigned char* ws, const float* const* in, int gw, int ngw, int lane) {
    const int l = 0, b = 0;
    for (int s = gw; s < 512; s += ngw) { const unsigned hh = hash(s, 900); const int g = hh & 15, dir = (hh >> 5) & 1, c = (hh >> 8) % 272, im = (hh >> 20) & 1, psel = (hh >> 24) & 63;
        const bf16* U = (const bf16*)(ws + P_UG) + (size_t)(b * 32 + g) * LPOS * 16; const int pi = ((l * 2 + dir) * 32 + g) * 64 + lane;
        const float lr = fminf(in[17][pi], -1e-4f), li = in[18][pi], dt = expf(in[19][(l * 2 + dir) * 32 + g]); const float mag = expf(lr * dt), abr = mag * cosf(li * dt), abi = mag * sinf(li * dt), den = lr * lr + li * li;
        const float fr = ((abr - 1.f) * lr + abi * li) / den, fi = (abi * lr - (abr - 1.f) * li) / den; float bbr[16], bbi[16];
        _Pragma("unroll") for (int h = 0; h < 16; ++h) { const float br = in[20][(size_t)pi * 16 + h], bi = in[21][(size_t)pi * 16 + h]; bbr[h] = fr * br - fi * bi; bbi[h] = fr * bi + fi * br; }
        float xr = 0.f, xi = 0.f;
        for (int st = 0; st < LPOS; ++st) { const int p = dir == 0 ? st : (st < 256 ? 255 - st : LPOS + 255 - st);
            if ((p >> 4) == c) break;
            float vr = 0.f, vi = 0.f;
            _Pragma("unroll") for (int h = 0; h < 16; ++h) { const float u = bf2f(U[(size_t)p * 16 + h]); vr += bbr[h] * u; vi += bbi[h] * u; }
            const float nr = abr * xr - abi * xi + vr, ni = abr * xi + abi * xr + vi; xr = nr; xi = ni; }
        const float mine = im ? xi : xr; const float ref = __shfl(mine, psel);
        {
          float er = 0.f, ei = 0.f;
          for (int q = 0; q < 16; ++q) { const int sx = dir == 0 ? q : 15 - q, p = 16 * c + sx; float vr = 0.f, vi = 0.f;
              _Pragma("unroll") for (int h = 0; h < 16; ++h) { const float u = bf2f(U[(size_t)p * 16 + h]); vr += bbr[h] * u; vi += bbi[h] * u; }
              const float nr = abr * er - abi * ei + vr, ni = abr * ei + abi * er + vi; er = nr; ei = ni; }
          const float m2 = im ? ei : er; const float r2 = __shfl(m2, psel);
          const bf16* E = (const bf16*)(ws + WS_POOL + 98 * MiB) + (size_t)g * 69632 + (size_t)dir * 34816;
          add(ws, 39, bf2f(E[c * 128 + 2 * psel + im]), r2, lane); }
        const bf16* X = (const bf16*)(ws + WS_POOL + 94 * MiB) + (size_t)g * 69632 + (size_t)dir * 34816;
        add(ws, 38, bf2f(X[c * 128 + 2 * psel + im]), ref, lane); }
}
__device__ __forceinline__ void encode(unsigned char* ws, const float* x, float* outp, int nchk, int gt, int ngt) {
    const float* d = (const float*)(ws + WS_CTL) + CW_DBG; int bad = -1; float eb = 0.f;
#ifdef DBG_REPORT
    { const int k = DBG_REPORT; const float e = sqrtf(d[2 * k] / fmaxf(d[2 * k + 1], 1e-30f)); const float F = 1.f + 1e14f * fminf(e * e, 1e4f) + 1e3f;
      for (size_t i = gt; i < (size_t)NLAT * 1024; i += ngt) outp[i] = x[i] * F; return; }
#endif
    for (int k = 0; k < 30; ++k) { const float e = sqrtf(d[2 * k] / fmaxf(d[2 * k + 1], 1e-30f)); const bool unused = d[2 * k + 1] == 0.f && d[2 * k] == 0.f; if (!unused && !(e < 0.02f)) { bad = k; eb = e; break; } }
    if (bad < 0) return;
    float F = 1.f; for (int i = 0; i <= bad; ++i) F *= 4.f; F = 1.f + F * (1.f + fminf(eb, 0.99f));
    for (size_t i = gt; i < (size_t)NLAT * 1024; i += ngt) outp[i] = x[i] * F;
}
}
struct Args;
#endif

struct Args { const float* in[38]; float* out; unsigned char* ws; int ph_lo, ph_hi; };
constexpr int PH_PRO = 0, PH_R0 = 1, PH_L0 = 2, PH_PER_L = 16, NPH = PH_L0 + 2 * PH_PER_L;


#if MK_DEBUG
constexpr int DBG_NCHK = 40;
__global__ void __launch_bounds__(NTHREADS, 2) dbg_fwd(Args args, int ph) {
    unsigned char* ws = args.ws; float* outp = args.out; const float* const* in = args.in;
    const int tid = threadIdx.x, lane = tid & 63, wave = tid >> 6, gw = blockIdx.x * NWAVES + wave, ngw = gridDim.x * NWAVES;
    const float* par = (const float*)(ws + WS_PAR);
    if (ph == 1000) { dbg::encode(ws, in[0], outp, DBG_NCHK, blockIdx.x * NTHREADS + tid, gridDim.x * NTHREADS); return; }
    if (ph == PH_PRO) { dbg::chk_mod(ws, in, gw, ngw, lane); dbg::chk_weights(ws, in, gw, ngw, lane); dbg::chk_s5m(ws, in, 16, gw, ngw, lane); return; }
    if (ph == PH_R0) { dbg::chk_h(ws, in, outp, 2, 0, 0, par + PR_GMIXPRE, MALL, gw, ngw, lane); return; }
    const int l = (ph - PH_L0) / PH_PER_L, rel = (ph - PH_L0) % PH_PER_L, kb = 3 + 14 * l; const bool lastl = l == 1; const int nrq = lastl ? NLAT : MALL;
    if (rel == 0) { const bf16* Z = (const bf16*)(ws + P_Z);
        dbg::chk_gemm(ws, kb + 0, (const bf16*)(ws + P_H), 1024, in[10] + (size_t)l * 1024 * NIN, NIN, 1024, MALL, NIN, [=](int row, int col, float ref, float& got, float& rr) {
            const int j = col, dr = j < 512 ? j : j < 896 ? 768 + (j - 512) : j < 1024 ? 512 + (j - 896) : j < 1152 ? 640 + (j - 1024) : j < 1440 ? j : 1536 + (j - 1440); got = bf2f(Z[(size_t)row * ZW + dr]); rr = ref; }, gw, ngw, lane); }
    if (rel == 1) dbg::chk_tok(ws, kb + 1, l, gw, ngw, lane);
    if (rel == 2) {
        const bf16* QB = (const bf16*)(ws + P_QB); const bf16* CQ = (const bf16*)(ws + P_CQN); const float* Wq = in[15] + (size_t)l * 384 * 768; const float scale = 0.10206207261596575f * LOG2E;
        dbg::chk_gemm(ws, kb + 2, CQ, 384, Wq, 768, 384, nrq, 768, [=](int row, int col, float ref, float& got, float& rr) {
            const int hd = col / 96, e = col % 96; float v = ref;
            if (e >= 64 && row < NLAT) { const int i = (e - 64) & 15; const float x1 = dbg::dot_aw(CQ + (size_t)row * 384, Wq + hd * 96 + 64 + i, 768, 384, lane), x2 = dbg::dot_aw(CQ + (size_t)row * 384, Wq + hd * 96 + 80 + i, 768, 384, lane);
                const float an = dbg::angB(row & 4095, i), c = cosf(an), sn = sinf(an); v = e < 80 ? x1 * c - x2 * sn : x1 * sn + x2 * c; }
            got = bf2f(QB[(size_t)row * 768 + col]); rr = v * scale; }, gw, ngw, lane);
        const bf16* KB = (const bf16*)(ws + P_KB); const bf16* VB = (const bf16*)(ws + P_VB);
        dbg::chk_gemm(ws, kb + 3, (const bf16*)(ws + P_CKVN), 256, in[16] + (size_t)l * 256 * 1024, 1024, 256, MALL, 1024, [=](int row, int col, float ref, float& got, float& rr) {
            const int hd = col / 128, e = col % 128; got = e < 64 ? bf2f(KB[(size_t)row * 512 + hd * 64 + e]) : bf2f(VB[(size_t)row * 512 + hd * 64 + e - 64]); rr = ref; }, gw, ngw, lane); }
    if (rel == 3) { dbg::chk_attn(ws, kb + 4, lastl, gw, ngw, lane); dbg::chk_s5(ws, in, kb + 5, l, lastl, gw, ngw, lane); if (l == 0) dbg::chk_s5x(ws, in, gw, ngw, lane); }
    if (rel == 4) { const bf16* AG = (const bf16*)(ws + P_AGLU); const bf16* YB = (const bf16*)(ws + P_YBR); const float* Wg = in[25] + (size_t)l * 512 * 1024;
        dbg::chk_gemm(ws, kb + 6, AG, 512, Wg, 1024, 512, nrq, 512, [=](int row, int col, float ref, float& got, float& rr) {
            const float g = dbg::dot_aw(AG + (size_t)row * 512, Wg + 512 + col, 1024, 512, lane); got = bf2f(YB[(size_t)row * 1536 + 1024 + col]); rr = ref / (1.f + expf(-g)); }, gw, ngw, lane); }
    if (rel == 5) { const bf16* H = (const bf16*)(ws + P_H); const bf16* YB = (const bf16*)(ws + P_YBR); const bf16* MG = (const bf16*)(ws + P_MRG);
        const float* Wm = in[27] + (size_t)l * 1024 * 3072; const float* Wb = in[26] + (size_t)l * 3 * 512 * 1024; const float* bm = in[28] + l * 3072;
        for (int s = gw; s < 512; s += ngw) { const unsigned hh = dbg::hash(s, 333 + l); const int row = hh % nrq, col = (hh >> 16) % 1024; float acc = 0.f;
            for (int n = 0; n < 3; ++n) { const float g = dbg::dot_aw(H + (size_t)row * 1024, Wm + n * 1024 + col, 3072, 1024, lane) + bm[n * 1024 + col];
                const float p = dbg::dot_aw(YB + (size_t)row * 1536 + n * 512, Wb + (size_t)n * 512 * 1024 + col, 1024, 512, lane); acc += p / (1.f + expf(-g)); }
            dbg::add(ws, kb + 7, bf2f(MG[(size_t)row * 1024 + col]), acc, lane); } }
    if (rel == 6) { const float* Y = (const float*)(ws + P_Y);
        dbg::chk_gemm(ws, kb + 8, (const bf16*)(ws + P_MRG), 1024, in[29] + (size_t)l * 1024 * 1024, 1024, 1024, nrq, 1024, [=](int row, int col, float ref, float& got, float& rr) { got = Y[(size_t)row * 1024 + col]; rr = ref; }, gw, ngw, lane); }
    if (rel == 7) dbg::chk_h(ws, in, outp, kb + 9, l, 3, par + PR_GFFNPRE + l * 1024, nrq, gw, ngw, lane);
    if (!lastl) {
        if (rel == 8) { const bf16* H = (const bf16*)(ws + P_H); const bf16* ACT = (const bf16*)(ws + P_ACT);
            dbg::chk_gemm(ws, kb + 10, H, 1024, in[30], DFF, 1024, MALL, DFF, [=](int row, int col, float ref, float& got, float& rr) {
                const float b = dbg::dot_aw(H + (size_t)row * 1024, in[31] + col, DFF, 1024, lane); got = bf2f(ACT[(size_t)row * DFF + col]); rr = ref / (1.f + expf(-ref)) * b; }, gw, ngw, lane); }
        if (rel == 9) { const float* Y2 = (const float*)(ws + P_Y2);
            dbg::chk_gemm(ws, kb + 11, (const bf16*)(ws + P_ACT), DFF, in[32], 1024, DFF, MALL, 1024, [=](int row, int col, float ref, float& got, float& rr) { got = Y2[(size_t)row * 1024 + col]; rr = ref; }, gw, ngw, lane); }
        if (rel == 12) dbg::chk_h(ws, in, outp, kb + 12, 1, 0, par + PR_GMIXPRE + 1024, MALL, gw, ngw, lane);
    } else if (rel == 11) {
        const bf16* H = (const bf16*)(ws + P_H); const bf16* FO = (const bf16*)(ws + P_Y2); const unsigned* cnt = (const unsigned*)(ws + WS_CTL) + CW_CNT; const int* ti = (const int*)(ws + WS_LIST) + 8 * 16384;
        for (int s = gw; s < 64; s += ngw) { const unsigned hh = dbg::hash(s, 555); const int tok = hh % NLAT, kk = (hh >> 16) & 1, c = (hh >> 17) % 1024; const int e = ti[tok * 8 + 2 * kk], pos = ti[tok * 8 + 2 * kk + 1];
            int base = 0; for (int q = 0; q < e; ++q) base += ((int)cnt[CNT_STRIDE * q] + 255) >> 8;
            float acc = 0.f;
            for (int j = 0; j < DFF; ++j) { const float a = dbg::dot_aw(H + (size_t)tok * 1024, in[35] + (size_t)e * 1024 * DFF + j, DFF, 1024, lane), b = dbg::dot_aw(H + (size_t)tok * 1024, in[36] + (size_t)e * 1024 * DFF + j, DFF, 1024, lane);
                acc += dbg::rbf(a / (1.f + expf(-a)) * b) * dbg::rbf(in[37][((size_t)e * DFF + j) * 1024 + c]); }
            dbg::add(ws, kb + 10, bf2f(FO[((size_t)base * 256 + pos) * 1024 + c]), acc, lane); } }
}
#endif

#ifndef PHMASK
#define PHMASK 0xFFFFFFFFu
#endif
#define PHON(k) (((PHMASK) >> (k)) & 1u)
#ifndef REPMASK
#define REPMASK 0u
#endif
#define REPON(k) (((REPMASK) >> (k)) & 1u)

__device__ __forceinline__ ResidArgs Rd(ResidArgs R, int rep) { R.dry = rep > 0; return R; }
__global__ void __launch_bounds__(NTHREADS, 2) mk_fwd(Args args) {
    extern __shared__ __attribute__((aligned(16))) unsigned char lds_raw[];
    LAS unsigned char* lds = (LAS unsigned char*)lds_raw;
    const int wave = __builtin_amdgcn_readfirstlane((int)threadIdx.x >> 6);
#define tid (wave * 64 + lane_id())
    const int G = gridDim.x, bx = blockIdx.x; const int vcu = (G % 8 == 0) ? (bx % 8) * (G / 8) + bx / 8 : bx;
    unsigned char* ws0 = args.ws; float* outp = args.out;
    unsigned char* ws = ws0;
    volatile LAS unsigned* misc = (volatile LAS unsigned*)(lds + LDS_MISC);
    LAS int* tb; { unsigned tba_ = (unsigned)(uintptr_t)(lds + LDS_MISC + 64); asm volatile("" : "+s"(tba_)); tb = (LAS int*)(uintptr_t)tba_; }
    if (tid < 64) misc[tid] = 0u;
    __syncthreads();
    const int lo = args.ph_lo, hi = args.ph_hi;
    XcdBarrier bar; bar.bar = (unsigned*)(ws + WS_CTL) + CW_BAR; bar.x = 0; bar.st = misc; bar.wave = wave;
    if (hi - lo > 1) bar = xcd_barrier_post((unsigned*)(ws + WS_CTL) + CW_BAR, misc, wave);
#define IN(k) (lo <= (k) && (k) < hi)
#define SEAM(k) do { if ((k) + 1 < hi) xcd_barrier(bar); } while (0)
    const int gw = vcu * NWAVES + wave, ngw = G * NWAVES;

    if (PHON(0) && IN(PH_PRO)) for (int rep_ = 0; rep_ <= (int)REPON(0); ++rep_) {
            GAS unsigned char* wsq = (GAS unsigned char*)ws0; asm volatile("" : "+s"(wsq)); unsigned char* const ws = (unsigned char*)wsq; const float* const par = (const float*)(ws + WS_PAR); int lnq = lane_id(); asm volatile("" : "+v"(lnq)); const int lane = lnq; (void)par; (void)lane;
        Ptrs P;
        { const float* const* in = args.in;
          P.x = in[0]; P.c = in[1]; P.ctx = in[2]; P.c_ctx = in[3]; P.w_mod = in[4]; P.b_mod = in[5]; P.g_mix_pre = in[6]; P.g_mix_post = in[7]; P.g_ffn_pre = in[8]; P.g_ffn_post = in[9];
          P.w_in = in[10]; P.g_q = in[11]; P.g_k = in[12]; P.g_cq = in[13]; P.g_ckv = in[14]; P.w_uq = in[15]; P.w_ukv = in[16];
          P.s5p.lam_re = in[17]; P.s5p.lam_im = in[18]; P.s5p.log_dt = in[19]; P.s5p.b_re = in[20]; P.s5p.b_im = in[21]; P.s5p.c_re = in[22]; P.s5p.c_im = in[23]; P.s5p.dsk = in[24];
          P.w_glu = in[25]; P.w_branch = in[26]; P.w_mg = in[27]; P.b_mg = in[28]; P.w_out = in[29]; P.ffn_w1 = in[30]; P.ffn_w3 = in[31]; P.ffn_w2 = in[32];
          P.router_w = in[33]; P.router_b = in[34]; P.moe_w1 = in[35]; P.moe_w3 = in[36]; P.moe_w2 = in[37]; P.out = args.out; P.ws = args.ws; }
#ifndef PRO_ONLYT
#define PRO_ONLYT 0
#endif
        if (!(PRO_ONLYT && rep_ > 0)) {
        copy_params(P, bx * NTHREADS + tid, G * NTHREADS);
        for (int it = bx; it < 192 + 64; it += G) {
            if (it < 192) mod_item(P, it, lds, wave);
#ifndef PRO_SKIPB
#define PRO_SKIPB 0
#endif
#ifndef BM_SKIP
#define BM_SKIP 0
#endif
            else if (!(PRO_SKIPB && rep_ > 0)) { const int q = it - 192, l = q >> 5, g = q & 31; s5::build_mats(P.s5p, l, g, (bf16*)(ws + WS_S5M) + (size_t)(l * 32 + g) * s5::M_TOTAL, lds, wave, rep_ > 0 ? BM_SKIP : 0); }
        }
        rope_tables(P, bx * NTHREADS + tid, G * NTHREADS);
        }
        __syncthreads();
#ifndef PRO_NOT
#define PRO_NOT 0
#endif
        if (!(PRO_NOT && rep_ > 0)) transposes(P, gw, ngw, (LAS float*)(lds + wave * 16384), lane, rep_);
        SEAM(PH_PRO);
    }
    if (PHON(1) && IN(PH_R0)) for (int rep_ = 0; rep_ <= (int)REPON(1); ++rep_) {
            GAS unsigned char* wsq = (GAS unsigned char*)ws0; asm volatile("" : "+s"(wsq)); unsigned char* const ws = (unsigned char*)wsq; const float* const par = (const float*)(ws + WS_PAR); int lnq = lane_id(); asm volatile("" : "+v"(lnq)); const int lane = lnq; (void)par; (void)lane;
        ResidArgs R{}; R.mode = 0; R.g_pre = par + PR_GMIXPRE; R.shift_chunk = 0; R.hout = (bf16*)(ws + P_H); R.l_mod = 0; R.route = false; R.hout8 = ws + P_H8;
        const float* xin = args.in[0]; const float* ctxin = args.in[2];
        if (ngw == 2048) {
            const int b_ = gw >> 9, i_ = gw & 511; RowParams Q; load_row_params(Q, ws, R, b_, lane); const int nl_ = (MALL) < NLAT ? (MALL) : NLAT;
            for (int k = 0; k < 8; k += 2) { const int row = b_ * 4096 + i_ + 512 * k; if (row < nl_) { resid_row(ws, outp, xin, ctxin, Rd(R, rep_), row, lane, tb, Q); resid_row(ws, outp, xin, ctxin, Rd(R, rep_), row + 512, lane, tb, Q); } }
            for (int row = NLAT + gw; row < (MALL); row += ngw) resid_row(ws, outp, xin, ctxin, Rd(R, rep_), row, lane, tb);
        } else
        { int row = gw; for (; row + ngw < MALL; row += 2 * ngw) { resid_row(ws, outp, xin, ctxin, Rd(R, rep_), row, lane, tb); resid_row(ws, outp, xin, ctxin, Rd(R, rep_), row + ngw, lane, tb); } if (row < MALL) resid_row(ws, outp, xin, ctxin, Rd(R, rep_), row, lane, tb); }
        SEAM(PH_R0);
    }
#define MOE_TAIL_FROM(lo_pm, hi_pm, first) do { if (l == 0 && bx >= (first)) { const int lane_ = lane_id(); \
            moe_transposes(args.in[35], args.in[36], args.in[37], ws, (int)((long)MOE_ITEMS * (lo_pm) / 1000), (int)((long)MOE_ITEMS * (hi_pm) / 1000), (bx - (first)) * NWAVES + wave, (G - (first)) * NWAVES, (LAS float*)(lds + wave * 16384), lane_); } } while (0)
#define MOE_TAIL(lo_pm, hi_pm) MOE_TAIL_FROM(lo_pm, hi_pm, 16)
    for (int l = 0; l < 2; ++l) {
        const int pb = PH_L0 + l * PH_PER_L; const bool lastl = (l == 1);
        const int nMall = 68, nMq = lastl ? 64 : 68;
        if (PHON(2) && IN(pb + 0)) for (int rep_ = 0; rep_ <= (int)REPON(2); ++rep_) {
            GAS unsigned char* wsq = (GAS unsigned char*)ws0; asm volatile("" : "+s"(wsq)); unsigned char* const ws = (unsigned char*)wsq; const float* const par = (const float*)(ws + WS_PAR); int lnq = lane_id(); asm volatile("" : "+v"(lnq)); const int lane = lnq; (void)par; (void)lane;
            if (F8_G1L1 && lastl) {
                pg8::SchedPlain S{(const char*)(ws + P_H8), (const char*)(ws + WS_W1T) + (size_t)l * ZW * 2048, 1024u, 1024u, 8, nMall, 8, G, bx};
                pg8::EpiBf16S E{(bf16*)(ws + P_Z), ZW, 1.0f / (F8_HSCALE * F8_WSCALE)};
                pg8::gemm_phase<pg8::EpiBf16S, pg8::SchedPlain, false, true>(lds, S, E, wave);
            } else {
            pg8::SchedPlain S{(const char*)(ws + P_H), (const char*)(ws + WS_W1T) + (size_t)l * ZW * 2048, 2048u, 2048u, 16, nMall, 8, G, bx};
            pg8::EpiBf16 E{(bf16*)(ws + P_Z), ZW, 0};
            pg8::gemm_phase<pg8::EpiBf16, pg8::SchedPlain, false>(lds, S, E, wave); }
            SEAM(pb + 0);
        }
        if (PHON(3) && IN(pb + 1)) for (int rep_ = 0; rep_ <= (int)REPON(3); ++rep_) {
            GAS unsigned char* wsq = (GAS unsigned char*)ws0; asm volatile("" : "+s"(wsq)); unsigned char* const ws = (unsigned char*)wsq; const float* const par = (const float*)(ws + WS_PAR); int lnq = lane_id(); asm volatile("" : "+v"(lnq)); const int lane = lnq; (void)par; (void)lane;
            { const TokParams TP = load_tok_params(ws, l, lane); int row = gw; for (; row + ngw < MALL; row += 2 * ngw) { token_row(ws, l, row, lane, TP); token_row(ws, l, row + ngw, lane, TP); } if (row < MALL) token_row(ws, l, row, lane, TP); }
            SEAM(pb + 1);
        }
        if (PHON(4) && IN(pb + 2)) for (int rep_ = 0; rep_ <= (int)REPON(4); ++rep_) {
            GAS unsigned char* wsq = (GAS unsigned char*)ws0; asm volatile("" : "+s"(wsq)); unsigned char* const ws = (unsigned char*)wsq; const float* const par = (const float*)(ws + WS_PAR); int lnq = lane_id(); asm volatile("" : "+v"(lnq)); const int lane = lnq; (void)par; (void)lane;
            { pg8::SchedUp S{(const char*)(ws + P_CQN), (const char*)(ws + WS_WUQT) + (size_t)l * 768 * 768, (const char*)(ws + P_CKVN), (const char*)(ws + WS_WUKVT) + (size_t)l * 1024 * 512, nMq, nMall, G, bx};
              pg8::EpiUp E{pg8::EpiUq{(bf16*)(ws + P_QB), (const float*)(ws + WS_ROPE) + 2 * 4096 * 32, (const float*)(ws + WS_ROPE) + 2 * 4096 * 32 + 4096 * 16, 0.10206207261596575f * LOG2E}, pg8::EpiUkv{(bf16*)(ws + P_KB), (bf16*)(ws + P_VB)}};
              pg8::gemm_phase<pg8::EpiUp, pg8::SchedUp, false>(lds, S, E, wave); }
            SEAM(pb + 2);
        }
        if (PHON(5) && IN(pb + 3)) for (int rep_ = 0; rep_ <= (int)REPON(5); ++rep_) {
            GAS unsigned char* wsq = (GAS unsigned char*)ws0; asm volatile("" : "+s"(wsq)); unsigned char* const ws = (unsigned char*)wsq; const float* const par = (const float*)(ws + WS_PAR); int lnq = lane_id(); asm volatile("" : "+v"(lnq)); const int lane = lnq; (void)par; (void)lane;
            const int nlatu = 1024, nctxu = lastl ? 0 : 64;
            for (int it = vcu; it < nlatu + nctxu; it += G) {
                att::AttnArgs A; int typ, b, h;
                if (it < nlatu) { const int u = it >> 1; typ = (it ^ (it >> 8)) & 1;
                    b = u >> 7; h = (u >> 4) & 7; const int qb = u & 15; A.qrow0 = (long)b * SEQ + qb * 256; A.ntiles = 68; }
                else { const int u = it - nlatu; typ = u & 1; b = (u >> 1) >> 3; h = (u >> 1) & 7; A.qrow0 = NLAT + (long)b * CTXL; A.ntiles = 4; }
                A.b = b; A.O = (bf16*)(ws + P_YBR); A.opitch = 1536;
                if (typ == 0) { A.Q = (const bf16*)(ws + P_QA); A.qpitch = 512; A.qcol = h * 64; A.K1 = (const bf16*)(ws + P_KA); A.k1pitch = 128; A.k1col = (h >> 2) * 64; A.K2 = nullptr; A.k2pitch = 0;
                    A.V = (const bf16*)(ws + P_VA); A.vpitch = 128; A.vcol = (h >> 2) * 64; A.ocol = h * 64; att::attn_unit4<64>(A, lds, wave); }
                else { A.Q = (const bf16*)(ws + P_QB); A.qpitch = 768; A.qcol = h * 96; A.K1 = (const bf16*)(ws + P_KB); A.k1pitch = 512; A.k1col = h * 64; A.K2 = (const bf16*)(ws + P_KRR); A.k2pitch = 32;
                    A.V = (const bf16*)(ws + P_VB); A.vpitch = 512; A.vcol = h * 64; A.ocol = 512 + h * 64; att::attn_unit4<96>(A, lds, wave); }
            }
            __syncthreads();
#ifndef S5REP
#define S5REP 1
#endif
            for (int s5r_ = 0; s5r_ < S5REP; ++s5r_)
            for (int it = G - 1 - vcu; it < 256; it += G) { const int b = it >> 6, g = (it >> 1) & 31, half = it & 1;
                s5::unit(par + PR_A16, l, b, g, (const bf16*)(ws + P_UG), (const bf16*)(ws + WS_S5M) + (size_t)(l * 32 + g) * s5::M_TOTAL, (bf16*)(ws + P_AGLU), lastl, lds, wave, half); }
            SEAM(pb + 3);
        }
        if (PHON(6) && IN(pb + 4)) for (int rep_ = 0; rep_ <= (int)REPON(6); ++rep_) {
            GAS unsigned char* wsq = (GAS unsigned char*)ws0; asm volatile("" : "+s"(wsq)); unsigned char* const ws = (unsigned char*)wsq; const float* const par = (const float*)(ws + WS_PAR); int lnq = lane_id(); asm volatile("" : "+v"(lnq)); const int lane = lnq; (void)par; (void)lane;
            pg8::SchedPlain S{(const char*)(ws + P_AGLU), (const char*)(ws + WS_WGLUT) + (size_t)l * 1024 * 1024, 1024u, 1024u, 8, nMq, 4, G, bx};
            pg8::EpiPair<0> E{(bf16*)(ws + P_YBR), 1536, 1024, 0};
            pg8::gemm_phase<pg8::EpiPair<0>, pg8::SchedPlain, false>(lds, S, E, wave);
            SEAM(pb + 4);
        }
        if (PHON(7) && IN(pb + 5)) for (int rep_ = 0; rep_ <= (int)REPON(7); ++rep_) {
            GAS unsigned char* wsq = (GAS unsigned char*)ws0; asm volatile("" : "+s"(wsq)); unsigned char* const ws = (unsigned char*)wsq; const float* const par = (const float*)(ws + WS_PAR); int lnq = lane_id(); asm volatile("" : "+v"(lnq)); const int lane = lnq; (void)par; (void)lane;
#define MRG_ROUND(r) do { \
                { pg8::SchedMergeG S{(const char*)(ws + P_H8), (const char*)(ws + WS_WMGT) + (size_t)l * 3072 * 1024, 1024u, 1024u, 8, nMq, (r) * G + bx}; \
                  pg8::EpiGate E{par + PR_BMG + l * 3072, (u32x4*)(ws + P_GSCR + (size_t)bx * 3 * 131072), 1.0f / (F8_HSCALE * F8_WSCALE)}; \
                  pg8::gemm_phase<pg8::EpiGate, pg8::SchedMergeG, false, true>(lds, S, E, wave); } \
                { pg8::SchedMergeP S{(const char*)(ws + P_YBR), (const char*)(ws + WS_WBT) + (size_t)l * 3 * 1024 * 1024, 3072u, 1024u, 8, nMq, (r) * G + bx}; \
                  pg8::EpiMergeP E{(bf16*)(ws + P_MRG), (const u32x4*)(ws + P_GSCR + (size_t)bx * 3 * 131072)}; \
                  pg8::gemm_phase<pg8::EpiMergeP, pg8::SchedMergeP, false, false>(lds, S, E, wave); } } while (0)
            MRG_ROUND(0);
            const int nx = nMq * 4 - G; int mfirst = 16;
            if (nx > 0 && 3 * nx <= G) { mfirst = 3 * nx;
                if (bx < 3 * nx) { const int j = bx % nx, n = bx / nx; unsigned* flag = (unsigned*)(ws + WS_CTL) + CW_MFLAG + 64 * j; const unsigned want = (unsigned)(rep_ * 3 + n);
                    { pg8::SchedMergeG S{(const char*)(ws + P_H8), (const char*)(ws + WS_WMGT) + (size_t)l * 3072 * 1024, 1024u, 1024u, 8, nMq, G + j, n};
                      pg8::EpiGate E{par + PR_BMG + l * 3072, (u32x4*)(ws + P_GSCR + (size_t)bx * 3 * 131072), 1.0f / (F8_HSCALE * F8_WSCALE)};
                      pg8::gemm_phase<pg8::EpiGate, pg8::SchedMergeG, false, true>(lds, S, E, wave); }
                    { pg8::SchedMergeP S{(const char*)(ws + P_YBR), (const char*)(ws + WS_WBT) + (size_t)l * 3 * 1024 * 1024, 3072u, 1024u, 8, nMq, G + j, n};
                      pg8::EpiMergeP E{(bf16*)(ws + P_MRG), (const u32x4*)(ws + P_GSCR + (size_t)bx * 3 * 131072), flag, want};
                      pg8::gemm_phase<pg8::EpiMergeP, pg8::SchedMergeP, false, false>(lds, S, E, wave); }
                    asm volatile("s_waitcnt vmcnt(0)" ::: "memory");
                    __syncthreads();
                    if (wave == 0 && lane_id() == 0) { __builtin_amdgcn_fence(__ATOMIC_RELEASE, "agent"); asm volatile("s_waitcnt vmcnt(0)" ::: "memory"); __hip_atomic_store(flag, want + 1u, __ATOMIC_RELAXED, __HIP_MEMORY_SCOPE_AGENT); }
                }
            } else if (nx > 0) MRG_ROUND(1);
#undef MRG_ROUND
            MOE_TAIL_FROM(0, 480, mfirst);
            SEAM(pb + 5);
        }
        if (PHON(8) && IN(pb + 6)) for (int rep_ = 0; rep_ <= (int)REPON(8); ++rep_) {
            GAS unsigned char* wsq = (GAS unsigned char*)ws0; asm volatile("" : "+s"(wsq)); unsigned char* const ws = (unsigned char*)wsq; const float* const par = (const float*)(ws + WS_PAR); int lnq = lane_id(); asm volatile("" : "+v"(lnq)); const int lane = lnq; (void)par; (void)lane;
            pg8::SchedPlain S{(const char*)(ws + P_MRG), (const char*)(ws + WS_WOUTT) + (size_t)l * 1024 * 2048, 2048u, 2048u, 16, nMq, 4, G, bx};
            pg8::EpiBf16 E{(bf16*)(ws + P_Y), 1024, 0};
            pg8::gemm_phase<pg8::EpiBf16, pg8::SchedPlain, false>(lds, S, E, wave);
            MOE_TAIL(480, 620);
            SEAM(pb + 6);
        }
        if (PHON(9) && IN(pb + 7)) for (int rep_ = 0; rep_ <= (int)REPON(9); ++rep_) {
            GAS unsigned char* wsq = (GAS unsigned char*)ws0; asm volatile("" : "+s"(wsq)); unsigned char* const ws = (unsigned char*)wsq; const float* const par = (const float*)(ws + WS_PAR); int lnq = lane_id(); asm volatile("" : "+v"(lnq)); const int lane = lnq; (void)par; (void)lane;
            ResidArgs R{}; R.mode = 3; R.y = (const float*)(ws + P_Y); R.g_post = par + PR_GMIXPOST + l * 1024; R.gate_chunk = 2; R.g_pre = par + PR_GFFNPRE + l * 1024; R.shift_chunk = 3;
            R.hout = (bf16*)(ws + P_H); R.l_mod = l; R.l_gate = l; R.route = lastl; R.h8 = lastl ? (F8_M1 != 0) : (F8_D1 != 0); R.ysc = 1.0f;
            if (ngw == 2048) {
                const int b_ = gw >> 9, i_ = gw & 511; RowParams Q; load_row_params(Q, ws, R, b_, lane); const int nl_ = (nMq * 256) < NLAT ? (nMq * 256) : NLAT;
                for (int k = 0; k < 8; k += 2) { const int row = b_ * 4096 + i_ + 512 * k; if (row < nl_) { resid_row(ws, outp, nullptr, nullptr, Rd(R, rep_), row, lane, tb, Q); resid_row(ws, outp, nullptr, nullptr, Rd(R, rep_), row + 512, lane, tb, Q); } }
                for (int row = NLAT + gw; row < (nMq * 256); row += ngw) resid_row(ws, outp, nullptr, nullptr, Rd(R, rep_), row, lane, tb);
            } else
            { int row = gw; for (; row + ngw < nMq * 256; row += 2 * ngw) { resid_row(ws, outp, nullptr, nullptr, Rd(R, rep_), row, lane, tb); resid_row(ws, outp, nullptr, nullptr, Rd(R, rep_), row + ngw, lane, tb); } if (row < nMq * 256) resid_row(ws, outp, nullptr, nullptr, Rd(R, rep_), row, lane, tb); }
            SEAM(pb + 7);
        }
        if (!lastl) {
            if (PHON(10) && IN(pb + 8)) for (int rep_ = 0; rep_ <= (int)REPON(10); ++rep_) {
            GAS unsigned char* wsq = (GAS unsigned char*)ws0; asm volatile("" : "+s"(wsq)); unsigned char* const ws = (unsigned char*)wsq; const float* const par = (const float*)(ws + WS_PAR); int lnq = lane_id(); asm volatile("" : "+v"(lnq)); const int lane = lnq; (void)par; (void)lane;
                constexpr unsigned kb1 = F8_D1 ? 1024u : 2048u;
                pg8::SchedPlain S{(const char*)(ws + P_H), (const char*)(ws + WS_WF1T), kb1, kb1, F8_D1 ? 8 : 16, nMall, 22, G, bx};
                pg8::EpiPairS<F8_D2 != 0> E{ws + P_ACT, DFF, 0, F8_D1 ? 1.0f / (F8_HSCALE * F8_WSCALE) : 1.0f, F8_D2 ? F8_ASCALE : 1.0f};
                pg8::gemm_phase<pg8::EpiPairS<F8_D2 != 0>, pg8::SchedPlain, false, F8_D1 != 0>(lds, S, E, wave);
                SEAM(pb + 8);
            }
            if (PHON(11) && IN(pb + 9)) for (int rep_ = 0; rep_ <= (int)REPON(11); ++rep_) {
            GAS unsigned char* wsq = (GAS unsigned char*)ws0; asm volatile("" : "+s"(wsq)); unsigned char* const ws = (unsigned char*)wsq; const float* const par = (const float*)(ws + WS_PAR); int lnq = lane_id(); asm volatile("" : "+v"(lnq)); const int lane = lnq; (void)par; (void)lane;
                constexpr unsigned kb2 = F8_D2 ? 2816u : 5632u;
                pg8::SchedPlain S{(const char*)(ws + P_ACT), (const char*)(ws + WS_WF2T), kb2, kb2, F8_D2 ? 22 : 44, nMall, 4, G, bx};
                pg8::EpiBf16 E{(bf16*)(ws + P_Y2), 1024, 0};
                pg8::gemm_phase<pg8::EpiBf16, pg8::SchedPlain, false, F8_D2 != 0>(lds, S, E, wave);
                MOE_TAIL(620, 1000);
                SEAM(pb + 9);
            }
            if (PHON(14) && IN(pb + 12)) for (int rep_ = 0; rep_ <= (int)REPON(14); ++rep_) {
            GAS unsigned char* wsq = (GAS unsigned char*)ws0; asm volatile("" : "+s"(wsq)); unsigned char* const ws = (unsigned char*)wsq; const float* const par = (const float*)(ws + WS_PAR); int lnq = lane_id(); asm volatile("" : "+v"(lnq)); const int lane = lnq; (void)par; (void)lane;
                ResidArgs R{}; R.mode = 3; R.y = (const float*)(ws + P_Y2); R.g_post = par + PR_GFFNPOST; R.gate_chunk = 5; R.g_pre = par + PR_GMIXPRE + 1024; R.shift_chunk = 0;
                R.hout = (bf16*)(ws + P_H); R.l_mod = 1; R.l_gate = 0; R.route = false; R.hout8 = ws + P_H8; R.ysc = F8_D2 ? 1.0f / (F8_ASCALE * F8_WSCALE) : 1.0f;
                if (ngw == 2048) {
                    const int b_ = gw >> 9, i_ = gw & 511; RowParams Q; load_row_params(Q, ws, R, b_, lane); const int nl_ = (MALL) < NLAT ? (MALL) : NLAT;
                    for (int k = 0; k < 8; k += 2) { const int row = b_ * 4096 + i_ + 512 * k; if (row < nl_) { resid_row(ws, outp, nullptr, nullptr, Rd(R, rep_), row, lane, tb, Q); resid_row(ws, outp, nullptr, nullptr, Rd(R, rep_), row + 512, lane, tb, Q); } }
                    for (int row = NLAT + gw; row < (MALL); row += ngw) resid_row(ws, outp, nullptr, nullptr, Rd(R, rep_), row, lane, tb);
                } else
                { int row = gw; for (; row + ngw < MALL; row += 2 * ngw) { resid_row(ws, outp, nullptr, nullptr, Rd(R, rep_), row, lane, tb); resid_row(ws, outp, nullptr, nullptr, Rd(R, rep_), row + ngw, lane, tb); } if (row < MALL) resid_row(ws, outp, nullptr, nullptr, Rd(R, rep_), row, lane, tb); }
                SEAM(pb + 12);
            }
        } else {
            for (int ch = 0; ch < 1; ++ch) {
                if (IN(pb + 8 + 2 * ch) || IN(pb + 9 + 2 * ch)) {
                    __syncthreads();
                    if (tid == 0) { const unsigned* cnt = (const unsigned*)(ws + WS_CTL) + CW_CNT; int acc = 0;
                        for (int e = 0; e < 8; ++e) { const int c = (int)__hip_atomic_load(cnt + CNT_STRIDE * e, __ATOMIC_RELAXED, __HIP_MEMORY_SCOPE_AGENT); tb[e] = c; tb[8 + e] = acc; acc += (c + 255) >> 8; }
                        tb[16] = acc; }
                    __syncthreads();
                }
                const int ntot = __builtin_amdgcn_readfirstlane(tb[16]), t0 = 0, t1 = ntot;
                if (PHON(12) && IN(pb + 8 + 2 * ch)) for (int rep_ = 0; rep_ <= (int)REPON(12); ++rep_) {
            GAS unsigned char* wsq = (GAS unsigned char*)ws0; asm volatile("" : "+s"(wsq)); unsigned char* const ws = (unsigned char*)wsq; const float* const par = (const float*)(ws + WS_PAR); int lnq = lane_id(); asm volatile("" : "+v"(lnq)); const int lane = lnq; (void)par; (void)lane;
                    constexpr unsigned kbm = F8_M1 ? 1024u : 2048u;
                    pg8::SchedMoe1 S{(const char*)(ws + P_H), (const char*)(ws + WS_WM1T), kbm, kbm, F8_M1 ? 8 : 16, (const int*)(ws + WS_LIST), tb, t1, G, bx, nullptr};
                    if (S.units() <= 16) { LAS unsigned* rtab = (LAS unsigned*)(lds + 131072); S.fill(rtab, wave * 64 + lane); S.rt = rtab; }
                    __syncthreads();
                    pg8::EpiPairS<true> E{ws + P_ACT, DFF, 0, F8_M1 ? 1.0f / (F8_HSCALE * F8_WSCALE) : 1.0f, F8_ASCALE};
                    pg8::gemm_phase<pg8::EpiPairS<true>, pg8::SchedMoe1, true, F8_M1 != 0>(lds, S, E, wave);
                    SEAM(pb + 8 + 2 * ch);
                }
                if (PHON(13) && IN(pb + 9 + 2 * ch)) for (int rep_ = 0; rep_ <= (int)REPON(13); ++rep_) {
            GAS unsigned char* wsq = (GAS unsigned char*)ws0; asm volatile("" : "+s"(wsq)); unsigned char* const ws = (unsigned char*)wsq; const float* const par = (const float*)(ws + WS_PAR); int lnq = lane_id(); asm volatile("" : "+v"(lnq)); const int lane = lnq; (void)par; (void)lane;
                    pg8::SchedMoe2 S{(const char*)(ws + P_ACT), (const char*)(ws + WS_WM2T), 2816u, 2816u, 22, tb, t1, G, bx};
                    pg8::EpiBf16 E{(bf16*)(ws + P_Y2), 1024, 0};
                    pg8::gemm_phase<pg8::EpiBf16, pg8::SchedMoe2, false, true>(lds, S, E, wave);
                    SEAM(pb + 9 + 2 * ch);
                }
            }
            if (PHON(14) && IN(pb + 12)) for (int rep_ = 0; rep_ <= (int)REPON(14); ++rep_) {
            GAS unsigned char* wsq = (GAS unsigned char*)ws0; asm volatile("" : "+s"(wsq)); unsigned char* const ws = (unsigned char*)wsq; const float* const par = (const float*)(ws + WS_PAR); int lnq = lane_id(); asm volatile("" : "+v"(lnq)); const int lane = lnq; (void)par; (void)lane;
                __syncthreads();
                if (tid == 0) { const unsigned* cnt = (const unsigned*)(ws + WS_CTL) + CW_CNT; int acc = 0;
                    for (int e = 0; e < 8; ++e) { const int c = (int)__hip_atomic_load(cnt + CNT_STRIDE * e, __ATOMIC_RELAXED, __HIP_MEMORY_SCOPE_AGENT); tb[e] = c; tb[8 + e] = acc; acc += (c + 255) >> 8; }
                    tb[16] = acc; }
                __syncthreads();
                ResidArgs R{}; R.mode = 2; R.g_post = par + PR_GFFNPOST + 1024; R.gate_chunk = 5; R.hout = nullptr; R.l_gate = 1; R.route = false; R.ysc = 1.0f / (F8_ASCALE * F8_WSCALE);
                if (ngw == 2048) {
                    const int b_ = gw >> 9, i_ = gw & 511; RowParams Q; load_row_params(Q, ws, R, b_, lane); const int nl_ = (NLAT) < NLAT ? (NLAT) : NLAT;
                    for (int k = 0; k < 8; k += 2) { const int row = b_ * 4096 + i_ + 512 * k; if (row < nl_) { resid_row(ws, outp, nullptr, nullptr, Rd(R, rep_), row, lane, tb, Q); resid_row(ws, outp, nullptr, nullptr, Rd(R, rep_), row + 512, lane, tb, Q); } }
                    for (int row = NLAT + gw; row < (NLAT); row += ngw) resid_row(ws, outp, nullptr, nullptr, Rd(R, rep_), row, lane, tb);
                } else
                { int row = gw; for (; row + ngw < NLAT; row += 2 * ngw) { resid_row(ws, outp, nullptr, nullptr, Rd(R, rep_), row, lane, tb); resid_row(ws, outp, nullptr, nullptr, Rd(R, rep_), row + ngw, lane, tb); } if (row < NLAT) resid_row(ws, outp, nullptr, nullptr, Rd(R, rep_), row, lane, tb); }
            }
        }
    }
#undef IN
#undef SEAM
#undef tid
}

extern "C" void kernel_launch(void* const* d_in, const int* in_sizes, int n_in, void* d_out, int out_size, void* d_ws, size_t ws_size, hipStream_t stream) {
    static int grid = 0;
    if (grid == 0) {
        if (n_in != 38 || out_size != NLAT * D || ws_size < WS_END) { fprintf(stderr, "kernel_launch: unexpected problem (n_in %d out %d ws %zu, need %zu)\n", n_in, out_size, ws_size, (size_t)WS_END); grid = -1; return; }
        int dev = 0, cus = 0, per_cu = 0;
        if (hipGetDevice(&dev) != hipSuccess || hipDeviceGetAttribute(&cus, hipDeviceAttributeMultiprocessorCount, dev) != hipSuccess) { grid = -1; return; }
        if (hipFuncSetAttribute((const void*)mk_fwd, hipFuncAttributeMaxDynamicSharedMemorySize, LDS_BYTES) != hipSuccess) { fprintf(stderr, "kernel_launch: hipFuncSetAttribute failed\n"); grid = -1; return; }
        if (hipOccupancyMaxActiveBlocksPerMultiprocessor(&per_cu, (const void*)mk_fwd, NTHREADS, LDS_BYTES) != hipSuccess || per_cu < 1) { fprintf(stderr, "kernel_launch: occupancy query says %d\n", per_cu); }
        (void)hipGetLastError();
        grid = cus;
    }
    if (grid < 0) return;
    (void)hipMemsetAsync((char*)d_ws + WS_CTL, 0, CTL_BYTES, stream);
    Args a{};
    for (int i = 0; i < 38; ++i) a.in[i] = (const float*)d_in[i];
    a.out = (float*)d_out; a.ws = (unsigned char*)d_ws;
#if MK_MULTI
    for (int ph = 0; ph < NPH; ++ph) {
        const int rel = ph < PH_L0 ? -1 : (ph - PH_L0) % PH_PER_L, l = ph < PH_L0 ? 0 : (ph - PH_L0) / PH_PER_L;
        if (rel > 12 || (l == 0 && (rel == 10 || rel == 11))) continue;
        a.ph_lo = ph; a.ph_hi = ph + 1;
        hipLaunchKernelGGL(mk_fwd, dim3(grid), dim3(NTHREADS), LDS_BYTES, stream, a);
#if MK_DEBUG
        hipLaunchKernelGGL(dbg_fwd, dim3(grid), dim3(NTHREADS), 0, stream, a, ph);
#endif
    }
#if MK_DEBUG
    hipLaunchKernelGGL(dbg_fwd, dim3(grid), dim3(NTHREADS), 0, stream, a, 1000);
#endif
#else
    a.ph_lo = 0; a.ph_hi = NPH;
    hipLaunchKernelGGL(mk_fwd, dim3(grid), dim3(NTHREADS), LDS_BYTES, stream, a);
#endif
}
```
